# Optimizing an MI355X kernel written in HIP

```python
import math
import jax, jax.numpy as jnp
from jax import lax
import numpy as np

D_MODEL = 1024
BATCH = 2
SEQ = 8192
DEPTH = 1

CHUNK = 64

D_MIX = D_MODEL
SB_WIDTH = D_MIX // 2
SB_HEAD_DIM = 64
SB_HEADS = SB_WIDTH // SB_HEAD_DIM
Q_BLOCK = 128
SSM_WIDTH = D_MIX - SB_WIDTH
SSM_GROUP = 16
SSM_GROUPS = SSM_WIDTH // SSM_GROUP
SSM_STATE = 64
DT_MIN = 1e-3
DT_MAX = 1e-1
N_EXPERTS = 32
TOP_K = 4
D_FF = D_MODEL
SWIGLU_LIMIT = 7.0
SWIGLU_ALPHA = 1.702
EXPERT_BLOCK = 128
EPS = 1e-5

kernel_name = "hybrid_sb_s5_moe_block"


def rmsnorm(x, g):
    x32 = x.astype(jnp.float32)
    y = x32 * lax.rsqrt(jnp.mean(x32 * x32, axis=-1, keepdims=True) + EPS)
    return (y * g.astype(jnp.float32)).astype(x.dtype)


def stick_breaking_attention(q, k, v):
    bsz, seq, _ = q.shape
    def heads(a):
        return a.astype(jnp.float32).reshape(bsz, seq, SB_HEADS, SB_HEAD_DIM).transpose(0, 2, 1, 3)
    qh, kh, vh = heads(q), heads(k), heads(v)
    n_blk = seq // Q_BLOCK
    q_blocks = qh.reshape(bsz, SB_HEADS, n_blk, Q_BLOCK, SB_HEAD_DIM).transpose(2, 0, 1, 3, 4)
    starts = jnp.arange(n_blk, dtype=jnp.int32) * Q_BLOCK
    key_pos = jnp.arange(seq, dtype=jnp.int32)
    scale = 1.0 / math.sqrt(SB_HEAD_DIM)

    def one_block(args):
        qb, t0 = args
        z = jnp.einsum('bhqd,bhkd->bhqk', qb, kh) * scale
        t = t0 + jnp.arange(Q_BLOCK, dtype=jnp.int32)
        causal = key_pos[None, :] < t[:, None]
        log_keep = jnp.where(causal, -jax.nn.softplus(z), 0.0)
        between = lax.cumsum(log_keep, axis=3, reverse=True) - log_keep
        a = jnp.where(causal, jnp.exp(jax.nn.log_sigmoid(z) + between), 0.0)
        return jnp.einsum('bhqk,bhkd->bhqd', a, vh)

    out = lax.map(one_block, (q_blocks, starts))
    return out.transpose(1, 0, 3, 2, 4).reshape(bsz, seq, SB_WIDTH)


def s5_mixer(u, lam_re, lam_im, log_dt, b_re, b_im, c_re, c_im, d_skip, w_glu):
    bsz, seq, _ = u.shape
    u32 = u.astype(jnp.float32).reshape(bsz, seq, SSM_GROUPS, SSM_GROUP)
    lam = lax.complex(lam_re.astype(jnp.float32), lam_im.astype(jnp.float32))
    dt = jnp.exp(log_dt.astype(jnp.float32))[:, None]
    lam_bar = jnp.exp(lam * dt)
    b_mat = lax.complex(b_re.astype(jnp.float32), b_im.astype(jnp.float32))
    c_mat = lax.complex(c_re.astype(jnp.float32), c_im.astype(jnp.float32))
    b_bar = ((lam_bar - 1.0) / lam)[:, :, None] * b_mat
    bu = jnp.einsum('gpc,bsgc->bsgp', b_bar, u32.astype(jnp.complex64))
    a = jnp.broadcast_to(lam_bar, bu.shape)

    def combine(left, right):
        a_l, b_l = left
        a_r, b_r = right
        return a_r * a_l, a_r * b_l + b_r

    _, states = lax.associative_scan(combine, (a, bu), axis=1)
    y = jnp.real(jnp.einsum('gcp,bsgp->bsgc', c_mat, states))
    y = y + d_skip.astype(jnp.float32).reshape(SSM_GROUPS, SSM_GROUP) * u32
    y = jax.nn.gelu(y.reshape(bsz, seq, SSM_WIDTH))
    ab = y @ w_glu.astype(jnp.float32)
    y_a, y_b = jnp.split(ab, 2, axis=-1)
    return y_a * jax.nn.sigmoid(y_b)


def moe_ffn(xn, w_router, b_router, w_gate, b_gate, w_up, b_up, w_down, b_down):
    bsz, seq, d = xn.shape
    n_tok = bsz * seq
    xt = xn.reshape(n_tok, d)
    logits = (xt @ w_router + b_router).astype(jnp.float32)
    top_val, top_idx = lax.top_k(logits, TOP_K)
    gates = jax.nn.softmax(top_val, axis=-1)
    n_assign = n_tok * TOP_K
    e_flat = top_idx.reshape(n_assign)
    tok_flat = jnp.repeat(jnp.arange(n_tok, dtype=jnp.int32), TOP_K)
    g_flat = gates.reshape(n_assign)
    order = jnp.argsort(e_flat)
    e_sorted, tok_sorted, g_sorted = e_flat[order], tok_flat[order], g_flat[order]
    counts = jnp.bincount(e_flat, length=N_EXPERTS)
    starts = jnp.cumsum(counts) - counts
    padded = ((counts + EXPERT_BLOCK - 1) // EXPERT_BLOCK) * EXPERT_BLOCK
    pad_starts = jnp.cumsum(padded) - padded
    pad_ends = pad_starts + padded
    rank = jnp.arange(n_assign, dtype=jnp.int32) - starts[e_sorted]
    dest = pad_starts[e_sorted] + rank
    n_rows = n_assign + N_EXPERTS * EXPERT_BLOCK
    n_blocks = n_rows // EXPERT_BLOCK
    row_tok = jnp.full((n_rows,), n_tok, dtype=jnp.int32).at[dest].set(tok_sorted)
    x_pad = jnp.concatenate([xt, jnp.zeros((1, d), xt.dtype)], axis=0)
    x_rows = x_pad[row_tok].reshape(n_blocks, EXPERT_BLOCK, d)
    block_start = jnp.arange(n_blocks, dtype=jnp.int32) * EXPERT_BLOCK
    block_expert = jnp.minimum(jnp.searchsorted(pad_ends, block_start, side='right'), N_EXPERTS - 1)

    def expert_block(args):
        xb, e = args
        gate = xb @ w_gate[e] + b_gate[e]
        up = xb @ w_up[e] + b_up[e]
        gate = jnp.minimum(gate, SWIGLU_LIMIT)
        up = jnp.clip(up, -SWIGLU_LIMIT, SWIGLU_LIMIT)
        glu = gate * jax.nn.sigmoid(SWIGLU_ALPHA * gate)
        return ((up + 1.0) * glu) @ w_down[e] + b_down[e]

    y_rows = lax.map(expert_block, (x_rows, block_expert)).reshape(n_rows, d)
    y_assign = y_rows[dest].astype(jnp.float32) * g_sorted[:, None]
    out = jax.ops.segment_sum(y_assign, tok_sorted, num_segments=n_tok)
    return out.reshape(bsz, seq, d).astype(xn.dtype)


def setup_inputs(seed: int = 0) -> dict:
    key = jax.random.key(seed)
    ks = jax.random.split(key, 26)
    L, D, W, G, C, P, E, F = DEPTH, D_MODEL, SSM_WIDTH, SSM_GROUPS, SSM_GROUP, SSM_STATE, N_EXPERTS, D_FF
    n_in = 3 * SB_WIDTH + SSM_WIDTH
    nrm = lambda k, shape: jax.random.normal(k, shape, jnp.float32)
    return {
        "x": nrm(ks[0], (BATCH, SEQ, D)),
        "ln1_g": 1.0 + 0.01 * nrm(ks[1], (L, D)),
        "w_in": nrm(ks[2], (L, D, n_in)) * D ** -0.5,
        "lam_re": -0.5 + 0.01 * nrm(ks[3], (L, G, P)),
        "lam_im": jnp.pi * jnp.arange(P, dtype=jnp.float32) + 0.01 * nrm(ks[4], (L, G, P)),
        "log_dt": jax.random.uniform(ks[5], (L, G), jnp.float32, math.log(DT_MIN), math.log(DT_MAX)),
        "ssm_b_re": nrm(ks[6], (L, G, P, C)) * (2.0 * C) ** -0.5,
        "ssm_b_im": nrm(ks[7], (L, G, P, C)) * (2.0 * C) ** -0.5,
        "ssm_c_re": nrm(ks[8], (L, G, C, P)) * (2.0 * P) ** -0.5,
        "ssm_c_im": nrm(ks[9], (L, G, C, P)) * (2.0 * P) ** -0.5,
        "ssm_d": nrm(ks[10], (L, W)),
        "w_glu": nrm(ks[11], (L, W, 2 * W)) * W ** -0.5,
        "g_sb": 1.0 + 0.01 * nrm(ks[12], (L, SB_WIDTH)),
        "g_ssm": 1.0 + 0.01 * nrm(ks[13], (L, SSM_WIDTH)),
        "w_out": nrm(ks[14], (L, D_MIX, D)) * D_MIX ** -0.5,
        "ln2_g": 1.0 + 0.01 * nrm(ks[15], (L, D)),
        "w_router": nrm(ks[16], (L, D, E)) * D ** -0.5,
        "b_router": 0.01 * nrm(ks[17], (L, E)),
        "w_gate": nrm(ks[18], (L, E, D, F)) * D ** -0.5,
        "b_gate": 0.01 * nrm(ks[19], (L, E, F)),
        "w_up": nrm(ks[20], (L, E, D, F)) * D ** -0.5,
        "b_up": 0.01 * nrm(ks[21], (L, E, F)),
        "w_down": nrm(ks[22], (L, E, F, D)) * F ** -0.5,
        "b_down": 0.01 * nrm(ks[23], (L, E, D)),
        "ln_f_g": 1.0 + 0.01 * nrm(ks[24], (D,)),
    }


def reference(x, ln1_g, w_in, lam_re, lam_im, log_dt, ssm_b_re, ssm_b_im, ssm_c_re, ssm_c_im,
              ssm_d, w_glu, g_sb, g_ssm, w_out, ln2_g, w_router, b_router, w_gate, b_gate,
              w_up, b_up, w_down, b_down, ln_f_g):
    for l in range(DEPTH):
        h = rmsnorm(x, ln1_g[l])
        proj = h @ w_in[l]
        q = proj[..., 0:SB_WIDTH]
        k = proj[..., SB_WIDTH:2 * SB_WIDTH]
        v = proj[..., 2 * SB_WIDTH:3 * SB_WIDTH]
        u = proj[..., 3 * SB_WIDTH:]
        y_sb = stick_breaking_attention(q, k, v)
        y_ssm = s5_mixer(u, lam_re[l], lam_im[l], log_dt[l], ssm_b_re[l], ssm_b_im[l],
                         ssm_c_re[l], ssm_c_im[l], ssm_d[l], w_glu[l])
        mixed = jnp.concatenate([rmsnorm(y_sb, g_sb[l]), rmsnorm(y_ssm, g_ssm[l])], axis=-1)
        x = x + (mixed @ w_out[l].astype(jnp.float32)).astype(x.dtype)
        x = x + moe_ffn(rmsnorm(x, ln2_g[l]), w_router[l], b_router[l], w_gate[l], b_gate[l],
                        w_up[l], b_up[l], w_down[l], b_down[l])
    return rmsnorm(x, ln_f_g)
```

```cpp
#include <hip/hip_runtime.h>
#include <cstdio>
#include <cstdint>
namespace pg8 {
#define PG8_LAS __attribute__((address_space(3)))
typedef unsigned short bf16_t;
typedef short bf16x8 __attribute__((ext_vector_type(8)));
typedef float f32x4 __attribute__((ext_vector_type(4)));
typedef unsigned u32x4 __attribute__((ext_vector_type(4)));
constexpr int BM = 256, BK = 64, HALF = 128, HTB = HALF * BK * 2  , STAGE_BYTES = 8 * HTB, NXCD = 8, WGM = 8;

__host__ __device__ __forceinline__ int lds_byte(int r, int c) { const int st = (r >> 4) * 2 + (c >> 5), rr = r & 15, cc = c & 31, ob = rr * 64 + cc * 2; return st * 1024 + (ob ^ (((ob >> 9) & 1) << 5)); }
__host__ __device__ __forceinline__ void stage_rc(int b, int& R, int& C) { const int st = b / 1024, sb = b % 1024, swz = sb ^ (((sb >> 9) & 1) << 5); R = (st >> 1) * 16 + swz / 64; C = (st & 1) * 32 + (swz % 64) / 2; }
__host__ __device__ __forceinline__ int perm32(int rho) { const int n = rho >> 4, i = rho & 15; return 8 * (i >> 2) + 4 * n + (i & 3); }

struct Unit { int pm, pn, e; long offA, offB; };
struct Gemm { const bf16_t* A; const bf16_t* Bt; int lda, ldb, K; };

__host__ __device__ __forceinline__ int xcd_remap(int wgid, int nwg) { const int q = nwg / NXCD, r = nwg % NXCD, xcd = wgid % NXCD, off = wgid / NXCD; return (xcd < r ? xcd * (q + 1) : r * (q + 1) + (xcd - r) * q) + off; }

struct StaticOrder {
    int nM, nN, nwg, G, c, lda, ldb;
    __host__ __device__ void init(int M, int N, int G_, int c_, int lda_, int ldb_) { nM = M / BM; nN = N / BM; nwg = nM * nN; G = G_; c = c_; lda = lda_; ldb = ldb_; }
    __host__ __device__ bool next(int i, Unit& u) const {
        const long L = (long)i * G + c; if (L >= nwg) return false;
        const int wgid = xcd_remap((int)L, nwg);
        const int nig = WGM * nN, gid = wgid / nig, fm = gid * WGM, gsz = (nM - fm) < WGM ? (nM - fm) : WGM;
        u.pm = fm + ((wgid % nig) % gsz); u.pn = (wgid % nig) / gsz; u.e = 0;
        u.offA = (long)u.pm * BM * lda * 2; u.offB = (long)u.pn * BM * ldb * 2; return true;
    }
    __device__ __forceinline__ void a_ready(const Unit&) const {}
    __device__ __forceinline__ void done(const Unit&) const {}
};

__device__ __forceinline__ unsigned cvt_pk_bf16(float lo, float hi) { unsigned r; asm volatile("v_cvt_pk_bf16_f32 %0, %1, %2" : "=v"(r) : "v"(lo), "v"(hi)); return r; }
typedef float f32x2 __attribute__((ext_vector_type(2)));

template <class Epi, class Sched, bool ALIGN_EPI = false, bool SP2 = false>
__device__ __forceinline__ void gemm_phase(PG8_LAS unsigned char* lds, const Gemm g, const Sched& S, const Epi& E) {
    const int tid = threadIdx.x, wid = __builtin_amdgcn_readfirstlane(tid >> 6), lane = tid & 63, wr = wid >> 2, wc = wid & 3, fr = lane & 15, fq = lane >> 4;
    const int K = g.K, nt = K / BK;
    unsigned voffA[2], voffB[2];
#pragma unroll
    for (int i = 0; i < 2; ++i) { int R, C; stage_rc(tid * 16 + i * 8192, R, C); const int Rb = Epi::PERM ? ((R & ~31) + perm32(R & 31)) : R;
        voffA[i] = (unsigned)(R * g.lda + C) * 2u; voffB[i] = (unsigned)(Rb * g.ldb + C) * 2u; }
    const size_t kstep = (size_t)(BK * 2);
    const size_t hstepA = (size_t)HALF * g.lda * 2, hstepB = (size_t)HALF * g.ldb * 2;
    const unsigned ldsw = (unsigned)wid * 1024u;
    const int aoff = lds_byte(wr * 64 + fr, fq * 8), boff = lds_byte(wc * 32 + fr, fq * 8);
#define PG8_SA(b, h) (((b) * 2 + (h)) * HTB)
#define PG8_SB(b, h) ((4 + (b) * 2 + (h)) * HTB)
#define PG8_STAGE(bufoff, gbase, voff) do { _Pragma("unroll") for (int _i = 0; _i < 2; ++_i) \
        __builtin_amdgcn_global_load_lds((const unsigned*)((const char*)(gbase) + (voff)[_i]), (PG8_LAS unsigned*)(lds + (bufoff) + ldsw + _i * 8192), 16, 0, 0); } while (0)
#define PG8_LDA(dst, b, h) do { _Pragma("unroll") for (int m = 0; m < 4; ++m) _Pragma("unroll") for (int k = 0; k < 2; ++k) dst[m][k] = *(const PG8_LAS bf16x8*)(lds + PG8_SA(b, h) + aoff + m * 2048 + k * 1024); } while (0)
#define PG8_LDB(dst, b, h) do { _Pragma("unroll") for (int n = 0; n < 2; ++n) _Pragma("unroll") for (int k = 0; k < 2; ++k) dst[n][k] = *(const PG8_LAS bf16x8*)(lds + PG8_SB(b, h) + boff + n * 2048 + k * 1024); } while (0)
#define PG8_MMA(ai, bj, At, Bt) do { __builtin_amdgcn_s_setprio(1); _Pragma("unroll") for (int m = 0; m < 4; ++m) _Pragma("unroll") for (int n = 0; n < 2; ++n) _Pragma("unroll") for (int k = 0; k < 2; ++k) \
        acc[ai][bj][m][n] = __builtin_amdgcn_mfma_f32_16x16x32_bf16(Bt[n][k], At[m][k], acc[ai][bj][m][n], 0, 0, 0); __builtin_amdgcn_s_setprio(0); } while (0)
#define PG8_WAIT_V(n) asm volatile("s_waitcnt vmcnt(" #n ")" ::: "memory")
#define PG8_WAIT_L(n) asm volatile("s_waitcnt lgkmcnt(" #n ")" ::: "memory")
#define PG8_BAR __builtin_amdgcn_s_barrier()
#define PG8_SCHED __builtin_amdgcn_sched_barrier(0)
    Unit cur, nxt; int ui = 0;
    if (!S.next(0, cur)) return;
    f32x4 acc[2][2][4][2];
#pragma unroll
    for (int a = 0; a < 2; ++a)
#pragma unroll
        for (int b = 0; b < 2; ++b)
#pragma unroll
            for (int m = 0; m < 4; ++m)
#pragma unroll
                for (int n = 0; n < 2; ++n) acc[a][b][m][n] = (f32x4){0.f, 0.f, 0.f, 0.f};
    bf16x8 At[4][2], B0[2][2], B1[2][2];
    const char* cA = (const char*)g.A + cur.offA; const char* cB = (const char*)g.Bt + cur.offB;
    S.a_ready(cur);
    if constexpr (SP2) {
        PG8_STAGE(PG8_SB(0, 0), cB, voffB); PG8_STAGE(PG8_SB(0, 1), cB + hstepB, voffB); PG8_STAGE(PG8_SA(0, 0), cA, voffA); PG8_STAGE(PG8_SA(0, 1), cA + hstepA, voffA);
        if (wr == 1) PG8_BAR;
        PG8_WAIT_V(2); PG8_BAR;
        PG8_STAGE(PG8_SB(1, 0), cB + kstep, voffB); PG8_STAGE(PG8_SA(1, 0), cA + kstep, voffA); PG8_STAGE(PG8_SB(1, 1), cB + hstepB + kstep, voffB);
        PG8_WAIT_V(6); PG8_BAR;
    } else {
        PG8_STAGE(PG8_SB(0, 0), cB, voffB); PG8_STAGE(PG8_SA(0, 0), cA, voffA); PG8_STAGE(PG8_SB(0, 1), cB + hstepB, voffB); PG8_STAGE(PG8_SA(0, 1), cA + hstepA, voffA);
        if (wr == 1) PG8_BAR;
        PG8_WAIT_V(4); PG8_BAR;
        PG8_STAGE(PG8_SB(1, 0), cB + kstep, voffB); PG8_STAGE(PG8_SA(1, 0), cA + kstep, voffA); PG8_STAGE(PG8_SB(1, 1), cB + hstepB + kstep, voffB);
        PG8_WAIT_V(6); PG8_BAR;
    }
    for (;;) {
        const bool has_next = S.next(ui + 1, nxt);
        const char* nA = has_next ? (const char*)g.A + nxt.offA : cA; const char* nB = has_next ? (const char*)g.Bt + nxt.offB : cB;
        for (int t = 0; t < nt; t += 2) {
            const bool last = (t == nt - 2);
            const char* a1 = cA + (size_t)(t + 1) * kstep;
            const char* a2 = last ? nA : cA + (size_t)(t + 2) * kstep; const char* b2 = last ? nB : cB + (size_t)(t + 2) * kstep;
            const char* a3 = a2 + kstep; const char* b3 = b2 + kstep;
            if (last && has_next) S.a_ready(nxt);
            if constexpr (SP2) {
            PG8_LDB(B0, 0, 0); PG8_LDB(B1, 0, 1); PG8_SCHED; PG8_LDA(At, 0, 0); PG8_STAGE(PG8_SA(1, 1), a1 + hstepA, voffA);
            PG8_WAIT_V(8); PG8_WAIT_L(0); PG8_BAR; PG8_MMA(0, 0, At, B0); PG8_MMA(0, 1, At, B1); PG8_BAR; PG8_SCHED;
            PG8_LDA(At, 0, 1); PG8_STAGE(PG8_SB(0, 0), b2, voffB); PG8_STAGE(PG8_SB(0, 1), b2 + hstepB, voffB); PG8_STAGE(PG8_SA(0, 0), a2, voffA);
            PG8_WAIT_V(8); PG8_WAIT_L(0); PG8_BAR; PG8_MMA(1, 0, At, B0); PG8_MMA(1, 1, At, B1); PG8_BAR; PG8_SCHED;
            PG8_LDB(B0, 1, 0); PG8_LDB(B1, 1, 1); PG8_SCHED; PG8_LDA(At, 1, 0); PG8_STAGE(PG8_SA(0, 1), a2 + hstepA, voffA);
            PG8_WAIT_V(8); PG8_WAIT_L(0); PG8_BAR; PG8_MMA(0, 0, At, B0); PG8_MMA(0, 1, At, B1); PG8_BAR; PG8_SCHED;
            PG8_LDA(At, 1, 1); PG8_STAGE(PG8_SB(1, 0), b3, voffB); PG8_STAGE(PG8_SB(1, 1), b3 + hstepB, voffB); PG8_STAGE(PG8_SA(1, 0), a3, voffA);
            PG8_WAIT_V(8); PG8_WAIT_L(0); PG8_BAR; PG8_MMA(1, 0, At, B0); PG8_MMA(1, 1, At, B1); PG8_BAR; PG8_SCHED;
            } else {
            PG8_LDB(B0, 0, 0); PG8_SCHED; PG8_LDA(At, 0, 0); PG8_STAGE(PG8_SA(1, 1), a1 + hstepA, voffA);
            PG8_WAIT_L(8); PG8_BAR; PG8_WAIT_L(0); PG8_MMA(0, 0, At, B0); PG8_BAR; PG8_SCHED;
            PG8_LDB(B1, 0, 1); PG8_STAGE(PG8_SB(0, 0), b2, voffB);
            PG8_BAR; PG8_WAIT_L(0); PG8_MMA(0, 1, At, B1); PG8_BAR;
            PG8_LDA(At, 0, 1); PG8_STAGE(PG8_SA(0, 0), a2, voffA);
            PG8_BAR; PG8_WAIT_L(0); PG8_MMA(1, 0, At, B0); PG8_BAR; PG8_SCHED;
            PG8_STAGE(PG8_SB(0, 1), b2 + hstepB, voffB);
            PG8_WAIT_V(6); PG8_BAR; PG8_MMA(1, 1, At, B1); PG8_BAR;
            PG8_LDB(B0, 1, 0); PG8_SCHED; PG8_LDA(At, 1, 0); PG8_STAGE(PG8_SA(0, 1), a2 + hstepA, voffA);
            PG8_WAIT_L(8); PG8_BAR; PG8_WAIT_L(0); PG8_MMA(0, 0, At, B0); PG8_BAR; PG8_SCHED;
            PG8_LDB(B1, 1, 1); PG8_STAGE(PG8_SB(1, 0), b3, voffB);
            PG8_BAR; PG8_WAIT_L(0); PG8_MMA(0, 1, At, B1); PG8_BAR;
            PG8_LDA(At, 1, 1); PG8_STAGE(PG8_SA(1, 0), a3, voffA);
            PG8_BAR; PG8_WAIT_L(0); PG8_MMA(1, 0, At, B0); PG8_BAR; PG8_SCHED;
            PG8_STAGE(PG8_SB(1, 1), b3 + hstepB, voffB);
            PG8_WAIT_V(6); PG8_BAR; PG8_MMA(1, 1, At, B1); PG8_BAR;
            }
        }
        if constexpr (ALIGN_EPI) { if (wr == 0) PG8_BAR; }
        if constexpr (!Epi::AFTER_DRAIN) { E(acc, cur, wr, wc, fr, fq); S.done(cur); }
        if (!has_next) break;
#pragma unroll
        for (int a = 0; a < 2; ++a)
#pragma unroll
            for (int b = 0; b < 2; ++b)
#pragma unroll
                for (int m = 0; m < 4; ++m)
#pragma unroll
                    for (int n = 0; n < 2; ++n) acc[a][b][m][n] = (f32x4){0.f, 0.f, 0.f, 0.f};
        cur = nxt; cA = nA; cB = nB; ++ui;
        if constexpr (ALIGN_EPI) { if (wr == 1) PG8_BAR; }
    }
    PG8_WAIT_V(0);
    if constexpr (!ALIGN_EPI) { if (wr == 0) PG8_BAR; }
    PG8_BAR;
    if constexpr (Epi::AFTER_DRAIN) { E.fused(acc, cur, wr, wc, fr, fq, lds, wid, lane); S.done(cur); }
#undef PG8_SA
#undef PG8_SB
#undef PG8_STAGE
#undef PG8_LDA
#undef PG8_LDB
#undef PG8_MMA
#undef PG8_WAIT_V
#undef PG8_WAIT_L
#undef PG8_BAR
#undef PG8_SCHED
}
}

#ifndef PG8_SP2
#define PG8_SP2 true
#endif
#ifndef PG8_ALIGN
#define PG8_ALIGN true
#endif

constexpr int NWAVES = 8;
#ifndef MK_N_LAUNCHES
#define MK_N_LAUNCHES 1
#endif
#ifndef DBG_MODE
#define DBG_MODE 0
#endif
constexpr int PER_PHASE = 13;
constexpr int N_LAUNCHES = MK_N_LAUNCHES;

constexpr int BATCH = 2, SEQ = 8192, D = 1024, M = BATCH * SEQ;
constexpr int SBW = 512, NH = 8, HD = 64;
constexpr int SSW = 512, NG = 32, GC = 16, NP = 64;
constexpr int NPROJ = 3 * SBW + SSW;
constexpr int LC = 32, NCHUNK = M / LC, CPB = SEQ / LC;
constexpr int UK = LC * GC + 2 * NP;
constexpr int NE = 32, TOPK = 4, FF = 1024, NASSIGN = M * TOPK;
constexpr int MAXTILES = (NASSIGN + NE * 255) / 256 + 1;
constexpr float EPS = 1e-5f;
constexpr float LOG2E = 1.4426950408889634f;

constexpr size_t MiB = 1u << 20;
constexpr size_t WS_CTL = 0, CTL_ZERO_BYTES = 1 * MiB;
constexpr size_t WS_LAML = 1 * MiB;
constexpr size_t WS_GATES = 1 * MiB + 64 * 1024;
constexpr size_t WS_ROWINFO = 1 * MiB + 384 * 1024;
constexpr size_t WS_LISTS = 2 * MiB;
constexpr size_t WS_WINT = 4 * MiB, WS_WGLUT = 8 * MiB, WS_WOUTT = 9 * MiB, WS_W1T = 11 * MiB, WS_W2T = 139 * MiB;
constexpr size_t WS_R1 = 203 * MiB, WS_R2 = 347 * MiB, WS_END = 491 * MiB;
constexpr size_t WS_HN = WS_R1, WS_Q = WS_R1 + 32 * MiB, WS_K = WS_R1 + 48 * MiB, WS_V = WS_R1 + 64 * MiB, WS_UCAT = WS_R1 + 80 * MiB,
                 WS_SLOC = WS_R1 + 100 * MiB, WS_YSB = WS_R1 + 108 * MiB, WS_YG = WS_R1 + 124 * MiB;
constexpr size_t WS_XS = WS_R1, WS_YBUF = WS_R1;
constexpr size_t WS_YSSM = WS_R2, WS_MIXED = WS_R2 + 16 * MiB, WS_XN = WS_R2 + 48 * MiB, WS_WE = WS_R2 + 80 * MiB, WS_TW = WS_R2 + 85 * MiB;
constexpr size_t WS_H = WS_R2;
static_assert(WS_K == WS_Q + (size_t)M * SBW * 2 && WS_V == WS_K + (size_t)M * SBW * 2 && WS_YG + (size_t)M * SSW * 2 <= WS_R2 && WS_TW + (size_t)NG * 512 * UK * 2 <= WS_END, "ws map");
static_assert(WS_XS + (size_t)MAXTILES * 256 * D * 2 <= WS_R2 + 2 * MiB && WS_H + (size_t)(MAXTILES - 1) * 256 * FF * 2 <= WS_END, "ws map 2");
static_assert(WS_ROWINFO + (size_t)MAXTILES * 256 * 8 <= WS_LISTS, "ws map 3");
constexpr int CW_TMO = 0, CW_CODE = 1;
constexpr int CW_BAR = 4096;
constexpr int CW_CNT = 16384;

constexpr int RING_OFF = 0, RING_BYTES = 131072;
constexpr int RT_W_BYTES = D * 33 * 4;
constexpr int RT_SCR_OFF = RT_W_BYTES;
constexpr int LDSCTL_OFF = 139264, MISC_OFF = LDSCTL_OFF + 320;
constexpr int TAB_OFF = LDSCTL_OFF + 512;
constexpr int UNITS_OFF = LDSCTL_OFF + 1024;
constexpr int TILEE_OFF = LDSCTL_OFF + 1536;
constexpr int LDS_BYTES = LDSCTL_OFF + 4096;
static_assert(TILEE_OFF + MAXTILES * 4 <= LDS_BYTES && RT_SCR_OFF + 4096 <= LDSCTL_OFF, "LDS map");

#define GAS __attribute__((address_space(1)))
#define LAS __attribute__((address_space(3)))
typedef unsigned short bf16;
typedef unsigned v4u __attribute__((ext_vector_type(4)));
typedef unsigned v2u __attribute__((ext_vector_type(2)));
typedef float f32x4 __attribute__((ext_vector_type(4)));
typedef float f32x2 __attribute__((ext_vector_type(2)));
typedef _Float16 h16x2 __attribute__((ext_vector_type(2)));
typedef GAS unsigned gu32;
#define RLX_AGENT __ATOMIC_RELAXED, __HIP_MEMORY_SCOPE_AGENT
#define LDS_WAIT() asm volatile("s_waitcnt lgkmcnt(0)" ::: "memory")
#define VM_WAIT() asm volatile("s_waitcnt vmcnt(0)" ::: "memory")
__device__ __forceinline__ unsigned f2bf(float f) { unsigned u = __builtin_bit_cast(unsigned, f); return (u + 0x7fffu + ((u >> 16) & 1u)) >> 16; }
__device__ __forceinline__ unsigned pk2(float lo, float hi) { return f2bf(lo) | (f2bf(hi) << 16); }
__device__ __forceinline__ float bf2f(unsigned short b) { return __builtin_bit_cast(float, (unsigned)b << 16); }
__device__ __forceinline__ float bflo(unsigned w) { return __builtin_bit_cast(float, w << 16); }
__device__ __forceinline__ float bfhi(unsigned w) { return __builtin_bit_cast(float, w & 0xffff0000u); }
__device__ __forceinline__ unsigned pkh2(float lo, float hi) { h16x2 v; v.x = (_Float16)lo; v.y = (_Float16)hi; return __builtin_bit_cast(unsigned, v); }
__device__ __forceinline__ float fexp2(float x) { return __builtin_amdgcn_exp2f(x); }
__device__ __forceinline__ float flog2(float x) { return __builtin_amdgcn_logf(x); }
__device__ __forceinline__ float frcp(float x) { return __builtin_amdgcn_rcpf(x); }
__device__ __forceinline__ float sigmoidf_(float x) { return frcp(1.0f + fexp2(-LOG2E * x)); }
__device__ __forceinline__ float gelu_tanh(float v) { const float u = 0.7978845608028654f * (v + 0.044715f * v * v * v); return v * frcp(1.0f + fexp2(-2.0f * LOG2E * u)); }

#define XB_TMO      128
#define XB_XCNT(j)  (256  + 64 * (j))
#define XB_XSUB(j)  (1280 + 64 * (j))
#define XB_XGEN(j)  (2304 + 64 * (j))
#define XB_TOP      3328
#define XB_TOPGEN   3392
#define XCD_BAR_WORDS 3456
#define XB_SPIN_CAP (1u << 18)
__device__ __forceinline__ unsigned xb_ld(unsigned* p)              { return __hip_atomic_load(p, __ATOMIC_RELAXED, __HIP_MEMORY_SCOPE_AGENT); }
__device__ __forceinline__ unsigned xb_add(unsigned* p, unsigned v) { return __hip_atomic_fetch_add(p, v, __ATOMIC_RELAXED, __HIP_MEMORY_SCOPE_AGENT); }
__device__ __forceinline__ unsigned xb_xcc_id() { return (unsigned)__builtin_amdgcn_s_getreg((3 << 11) | 20) & 0xFu; }
#define XB_SPIN(cond, bar) do { unsigned _sp = 0; while (cond) { __builtin_amdgcn_s_sleep(1); \
    if ((++_sp & 255u) == 0u) { if (xb_ld(&(bar)[XB_TMO])) break; if (_sp > XB_SPIN_CAP) { atomicAdd(&(bar)[XB_TMO], 1u); break; } } } } while (0)
struct XcdBarrier { unsigned* bar; unsigned x; volatile LAS unsigned* st; };
__device__ __forceinline__ XcdBarrier xcd_barrier_post(unsigned* bar, volatile LAS unsigned* st) {
    XcdBarrier b; b.bar = bar; b.x = xb_xcc_id(); b.st = st;
    if (threadIdx.x == 0) (void)xb_add(&bar[XB_XCNT(b.x)], 1u);
    return b;
}
__device__ __forceinline__ void xcd_barrier_complete(unsigned* bar, unsigned x, unsigned& nloc, unsigned& nx) {
    const unsigned G = gridDim.x * gridDim.y * gridDim.z;
    unsigned sum, cnt, mine, sp = 0u;
    for (;;) {
        sum = 0u; cnt = 0u; mine = 0u;
#pragma unroll
        for (unsigned j = 0; j < 16; ++j) { const unsigned c = xb_ld(&bar[XB_XCNT(j)]); sum += c; cnt += (c > 0u) ? 1u : 0u; mine = (j == x) ? c : mine; }
        if (sum == G) break;
        __builtin_amdgcn_s_sleep(1);
        if ((++sp & 255u) == 0u) { if (xb_ld(&bar[XB_TMO])) break; if (sp > XB_SPIN_CAP) { atomicAdd(&bar[XB_TMO], 1u); break; } }
    }
    nloc = mine > 0u ? mine : 1u; nx = cnt > 0u ? cnt : 1u;
}
__device__ __forceinline__ void xcd_barrier(const XcdBarrier& b) {
    asm volatile("s_waitcnt vmcnt(0)" ::: "memory");
    __syncthreads();
    if (threadIdx.x == 0) {
        unsigned* bar = b.bar;
        __builtin_amdgcn_s_waitcnt(0);
        unsigned nloc = b.st[0], nx = b.st[1];
        if (nloc == 0u) { xcd_barrier_complete(bar, b.x, nloc, nx); b.st[0] = nloc; b.st[1] = nx; }
        const unsigned old = xb_add(&bar[XB_XSUB(b.x)], 1u);
        const unsigned gen = old / nloc;
        if (old + 1u == (gen + 1u) * nloc) {
            __builtin_amdgcn_fence(__ATOMIC_RELEASE, "agent");
            asm volatile("s_waitcnt vmcnt(0)" ::: "memory");
            const unsigned og = xb_add(&bar[XB_TOP], 1u);
            const unsigned tg = og / nx;
            if (og + 1u == (tg + 1u) * nx) xb_add(&bar[XB_TOPGEN], 1u);
            else XB_SPIN(xb_ld(&bar[XB_TOPGEN]) == tg, bar);
            __builtin_amdgcn_fence(__ATOMIC_ACQUIRE, "agent");
            xb_add(&bar[XB_XGEN(b.x)], 1u);
            asm volatile("s_waitcnt vmcnt(0)" ::: "memory");
        } else {
            XB_SPIN(xb_ld(&bar[XB_XGEN(b.x)]) == gen, bar);
            __builtin_amdgcn_fence(__ATOMIC_ACQUIRE, "agent");
            asm volatile("s_waitcnt vmcnt(0)" ::: "memory");
        }
    }
    __syncthreads();
}

struct Frame {
    LAS unsigned char* lds;
    volatile LAS unsigned* MISC;
    gu32* ctl;
    int tid, lane, wave;
    int vcu, G;
    unsigned char* ws;
    const float* in[25];
    float* out;
};

__device__ __forceinline__ float wave_sum(float v) {
#pragma unroll
    for (int o = 1; o < 64; o <<= 1) v += __shfl_xor(v, o);
    return v;
}

using pg8::Unit;
typedef pg8::f32x4 accv;
struct EpiInProj {
    static constexpr bool PERM = true, AFTER_DRAIN = false;
    unsigned short* QKV; bf16* U; float qscale;
    __device__ __forceinline__ void operator()(const accv (&acc)[2][2][4][2], const Unit& u, int wr, int wc, int fr, int fq) const {
        const int kind = u.pn >> 1; const int colt = (u.pn & 1) * 256 + wc * 32 + 8 * fq; const int row0 = u.pm * 256 + wr * 64 + fr;
        unsigned short* T = QKV + (size_t)(kind < 3 ? kind : 0) * ((size_t)M * SBW); const float sc = kind == 0 ? qscale : 1.0f;
#pragma unroll
        for (int ai = 0; ai < 2; ++ai)
#pragma unroll
            for (int m = 0; m < 4; ++m) { const int row = row0 + ai * 128 + m * 16;
#pragma unroll
                for (int bj = 0; bj < 2; ++bj) { const int col = colt + bj * 128; const accv v0 = acc[ai][bj][m][0] * sc, v1 = acc[ai][bj][m][1] * sc; v4u w;
                    if (kind < 3) { w.x = pkh2(v0[0], v0[1]); w.y = pkh2(v0[2], v0[3]); w.z = pkh2(v1[0], v1[1]); w.w = pkh2(v1[2], v1[3]);
                        *(v4u*)(T + (size_t)row * SBW + col) = w; }
                    else { w.x = pg8::cvt_pk_bf16(v0[0], v0[1]); w.y = pg8::cvt_pk_bf16(v0[2], v0[3]); w.z = pg8::cvt_pk_bf16(v1[0], v1[1]); w.w = pg8::cvt_pk_bf16(v1[2], v1[3]);
                        *(v4u*)(U + ((size_t)(row >> 5) * NG + (col >> 4)) * UK + (row & 31) * GC + (col & 15)) = w; } } }
    }
};
struct EpiSloc {
    static constexpr bool PERM = false, AFTER_DRAIN = false;
    float* S;
    __device__ __forceinline__ void operator()(const accv (&acc)[2][2][4][2], const Unit& u, int wr, int wc, int fr, int fq) const {
        const int row0 = u.pm * 256 + wr * 64 + fr; const int col0 = wc * 32 + 4 * fq;
#pragma unroll
        for (int ai = 0; ai < 2; ++ai)
#pragma unroll
            for (int m = 0; m < 4; ++m) { const int row = row0 + ai * 128 + m * 16;
#pragma unroll
                for (int n = 0; n < 2; ++n) *(accv*)(S + ((size_t)row * NG + u.e) * 128 + col0 + 16 * n) = acc[ai][0][m][n]; }
    }
};
struct EpiS3 {
    static constexpr bool PERM = true, AFTER_DRAIN = false;
    bf16* YG;
    __device__ __forceinline__ void operator()(const accv (&acc)[2][2][4][2], const Unit& u, int wr, int wc, int fr, int fq) const {
        const int row0 = u.pm * 256 + wr * 64 + fr; const int colt = u.pn * 256 + wc * 32 + 8 * fq;
#pragma unroll
        for (int ai = 0; ai < 2; ++ai)
#pragma unroll
            for (int m = 0; m < 4; ++m) { const int row = row0 + ai * 128 + m * 16;
#pragma unroll
                for (int bj = 0; bj < 2; ++bj) { const int col = colt + bj * 128; const accv v0 = acc[ai][bj][m][0], v1 = acc[ai][bj][m][1]; v4u w;
                    w.x = pg8::cvt_pk_bf16(gelu_tanh(v0[0]), gelu_tanh(v0[1])); w.y = pg8::cvt_pk_bf16(gelu_tanh(v0[2]), gelu_tanh(v0[3]));
                    w.z = pg8::cvt_pk_bf16(gelu_tanh(v1[0]), gelu_tanh(v1[1])); w.w = pg8::cvt_pk_bf16(gelu_tanh(v1[2]), gelu_tanh(v1[3]));
                    *(v4u*)(YG + ((size_t)row * LC + (col >> 4)) * SSW + u.e * GC + (col & 15)) = w; } }
    }
};
struct EpiGlu {
    static constexpr bool PERM = true, AFTER_DRAIN = false;
    bf16* Y;
    __device__ __forceinline__ void operator()(const accv (&acc)[2][2][4][2], const Unit& u, int wr, int wc, int fr, int fq) const {
        const int row0 = u.pm * 256 + wr * 64 + fr; const int col = u.pn * 128 + wc * 32 + 8 * fq;
#pragma unroll
        for (int ai = 0; ai < 2; ++ai)
#pragma unroll
            for (int m = 0; m < 4; ++m) { const int row = row0 + ai * 128 + m * 16; float r[8];
#pragma unroll
                for (int n = 0; n < 2; ++n)
#pragma unroll
                    for (int j = 0; j < 4; ++j) r[4 * n + j] = acc[ai][0][m][n][j] * sigmoidf_(acc[ai][1][m][n][j]);
                v4u w; w.x = pg8::cvt_pk_bf16(r[0], r[1]); w.y = pg8::cvt_pk_bf16(r[2], r[3]); w.z = pg8::cvt_pk_bf16(r[4], r[5]); w.w = pg8::cvt_pk_bf16(r[6], r[7]);
                *(v4u*)(Y + (size_t)row * SSW + col) = w; }
    }
};
struct EpiOutProj {
    static constexpr bool PERM = false, AFTER_DRAIN = false;
    const float* X; float* O;
    __device__ __forceinline__ void operator()(const accv (&acc)[2][2][4][2], const Unit& u, int wr, int wc, int fr, int fq) const {
        const int row0 = u.pm * 256 + wr * 64 + fr; const int col0 = u.pn * 256 + wc * 32 + 4 * fq;
#pragma unroll
        for (int ai = 0; ai < 2; ++ai)
#pragma unroll
            for (int m = 0; m < 4; ++m) { const size_t off = (size_t)(row0 + ai * 128 + m * 16) * D + col0;
#pragma unroll
                for (int bj = 0; bj < 2; ++bj)
#pragma unroll
                    for (int n = 0; n < 2; ++n) { const accv xv = *(const accv*)(X + off + bj * 128 + n * 16); *(accv*)(O + off + bj * 128 + n * 16) = xv + acc[ai][bj][m][n]; }
                if (m & 1) asm volatile("" ::: "memory"); }
    }
};
struct EpiMoe1 {
    static constexpr bool PERM = true, AFTER_DRAIN = false;
    bf16* H; const float* bg; const float* bu;
    __device__ __forceinline__ void operator()(const accv (&acc)[2][2][4][2], const Unit& u, int wr, int wc, int fr, int fq) const {
        const int row0 = u.pm * 256 + wr * 64 + fr; const int col = u.pn * 128 + wc * 32 + 8 * fq;
        float bgv[8], buv[8];
#pragma unroll
        for (int n = 0; n < 2; ++n) { const accv a = *(const accv*)(bg + u.e * FF + col + 4 * n), b = *(const accv*)(bu + u.e * FF + col + 4 * n);
#pragma unroll
            for (int j = 0; j < 4; ++j) { bgv[4 * n + j] = a[j]; buv[4 * n + j] = b[j]; } }
#pragma unroll
        for (int ai = 0; ai < 2; ++ai)
#pragma unroll
            for (int m = 0; m < 4; ++m) { const int row = row0 + ai * 128 + m * 16; float r[8];
#pragma unroll
                for (int n = 0; n < 2; ++n)
#pragma unroll
                    for (int j = 0; j < 4; ++j) { const float g = fminf(acc[ai][0][m][n][j] + bgv[4 * n + j], 7.0f); const float up = fminf(fmaxf(acc[ai][1][m][n][j] + buv[4 * n + j], -7.0f), 7.0f);
                        r[4 * n + j] = (up + 1.0f) * g * frcp(1.0f + fexp2(-1.702f * LOG2E * g)); }
                v4u w; w.x = pg8::cvt_pk_bf16(r[0], r[1]); w.y = pg8::cvt_pk_bf16(r[2], r[3]); w.z = pg8::cvt_pk_bf16(r[4], r[5]); w.w = pg8::cvt_pk_bf16(r[6], r[7]);
                *(v4u*)(H + (size_t)row * FF + col) = w; }
    }
};
struct EpiMoe2 {
    static constexpr bool PERM = true, AFTER_DRAIN = false;
    bf16* Y; const float* bd; const int* rowinfo;
    __device__ __forceinline__ void operator()(const accv (&acc)[2][2][4][2], const Unit& u, int wr, int wc, int fr, int fq) const {
        const int row0 = u.pm * 256 + wr * 64 + fr; const int colt = u.pn * 256 + wc * 32 + 8 * fq;
        float bv[2][8];
#pragma unroll
        for (int bj = 0; bj < 2; ++bj)
#pragma unroll
            for (int n = 0; n < 2; ++n) { const accv a = *(const accv*)(bd + u.e * D + colt + bj * 128 + 4 * n);
#pragma unroll
                for (int j = 0; j < 4; ++j) bv[bj][4 * n + j] = a[j]; }
#pragma unroll
        for (int ai = 0; ai < 2; ++ai)
#pragma unroll
            for (int m = 0; m < 4; ++m) { const int row = row0 + ai * 128 + m * 16; const int slot = rowinfo[2 * row]; const float gate = __builtin_bit_cast(float, rowinfo[2 * row + 1]);
                if (slot >= 0) {
#pragma unroll
                    for (int bj = 0; bj < 2; ++bj) { float r[8];
#pragma unroll
                        for (int n = 0; n < 2; ++n)
#pragma unroll
                            for (int j = 0; j < 4; ++j) r[4 * n + j] = (acc[ai][bj][m][n][j] + bv[bj][4 * n + j]) * gate;
                        v4u w; w.x = pg8::cvt_pk_bf16(r[0], r[1]); w.y = pg8::cvt_pk_bf16(r[2], r[3]); w.z = pg8::cvt_pk_bf16(r[4], r[5]); w.w = pg8::cvt_pk_bf16(r[6], r[7]);
                        *(v4u*)(Y + (size_t)slot * D + colt + bj * 128) = w; } } }
    }
};

struct SsmOrder {
    int nwg, G, c, npn, rows_per_g, ldb;
    __device__ bool next(int i, Unit& u) const {
        const int L = i * G + c; if (L >= nwg) return false;
        const int per_g = 2 * npn; const int g = L / per_g, r = L % per_g;
        u.e = g; u.pm = r / npn; u.pn = r % npn;
        u.offA = ((long)u.pm * 256 * NG * UK + (long)g * UK) * 2; u.offB = ((long)g * rows_per_g + (long)u.pn * 256) * ldb * 2; return true;
    }
    __device__ __forceinline__ void a_ready(const Unit&) const {}
    __device__ __forceinline__ void done(const Unit&) const {}
};
struct MoeOrder {
    const LAS int* units; int ldb_rows_per_e; int ldb;
    __device__ bool next(int i, Unit& u) const {
        if (i >= 32) return false;
        const int v = __builtin_amdgcn_readfirstlane(units[4 * i + 3]); if (!v) return false;
        u.pm = __builtin_amdgcn_readfirstlane(units[4 * i + 0]); u.pn = __builtin_amdgcn_readfirstlane(units[4 * i + 1]); u.e = __builtin_amdgcn_readfirstlane(units[4 * i + 2]);
        u.offA = (long)u.pm * 256 * D * 2; u.offB = ((long)u.e * ldb_rows_per_e + (long)u.pn * 256) * ldb * 2; return true;
    }
    __device__ __forceinline__ void a_ready(const Unit&) const {}
    __device__ __forceinline__ void done(const Unit&) const {}
};

__device__ __forceinline__ void p0_transpose_item(const float* W, int ldw, int K, int N, bf16* WT, int rmul, int radd, LAS float* scr, int item, int lane) {
    const int nblk = N / 32, kb = item / nblk, nb = item % nblk, k0 = 64 * kb, n0 = 32 * nb;
#pragma unroll 8
    for (int i = 0; i < 32; ++i) { const int kk = 2 * i + (lane >> 5); scr[kk * 33 + (lane & 31)] = W[(size_t)(k0 + kk) * ldw + n0 + (lane & 31)]; }
    LDS_WAIT(); asm volatile("" ::: "memory");
    const int c = lane & 7;
#pragma unroll
    for (int j = 0; j < 4; ++j) { const int nl = (lane >> 3) + 8 * j; const int n = n0 + nl; const int drow = (n >> 7) * 128 * rmul + radd + (n & 127); const LAS float* s = scr + (8 * c) * 33 + nl;
        v4u o; o.x = pk2(s[0 * 33], s[1 * 33]); o.y = pk2(s[2 * 33], s[3 * 33]); o.z = pk2(s[4 * 33], s[5 * 33]); o.w = pk2(s[6 * 33], s[7 * 33]);
        *(GAS v4u*)(WT + (size_t)drow * K + k0 + 8 * c) = o; }
    LDS_WAIT(); asm volatile("" ::: "memory");
}
__device__ __forceinline__ void rms_row_to_bf16(int lane, const float* xrow, const float* g, bf16* orow) {
    const GAS f32x4* xr = (const GAS f32x4*)xrow + lane; const GAS f32x4* gr = (const GAS f32x4*)g + lane;
    f32x4 v[4]; float s = 0.f;
#pragma unroll
    for (int j = 0; j < 4; ++j) { v[j] = xr[64 * j]; s += (v[j].x * v[j].x + v[j].y * v[j].y) + (v[j].z * v[j].z + v[j].w * v[j].w); }
    const float rstd = 1.0f / sqrtf(wave_sum(s) * (1.f / D) + EPS);
    GAS unsigned long long* o8 = (GAS unsigned long long*)orow + lane;
#pragma unroll
    for (int j = 0; j < 4; ++j) { const f32x4 gg = gr[64 * j]; o8[64 * j] = (unsigned long long)pk2(v[j].x * rstd * gg.x, v[j].y * rstd * gg.y) | ((unsigned long long)pk2(v[j].z * rstd * gg.z, v[j].w * rstd * gg.w) << 32); }
}
__device__ __forceinline__ void sincos_acc(float th, float& s, float& c) {
    const float k = rintf(th * 0.15915494309189535f);
    float r = fmaf(-k, 6.28125f, th); r = fmaf(-k, 1.9353071795864769e-3f, r);
    const float x = 0.25f * r, x2 = x * x;
    float sn = x * (1.0f + x2 * (-1.0f / 6 + x2 * (1.0f / 120 + x2 * (-1.0f / 5040 + x2 * (1.0f / 362880 + x2 * (-1.0f / 39916800))))));
    float cs = 1.0f + x2 * (-0.5f + x2 * (1.0f / 24 + x2 * (-1.0f / 720 + x2 * (1.0f / 40320 + x2 * (-1.0f / 3628800 + x2 * (1.0f / 479001600))))));
#pragma unroll
    for (int i = 0; i < 2; ++i) { const float s2 = 2.0f * sn * cs, c2 = 1.0f - 2.0f * sn * sn; sn = s2; cs = c2; }
    s = sn; c = cs;
}
__device__ __forceinline__ void ssm_tables(Frame& F, int g) {
    LAS float* pwr = (LAS float*)(F.lds);
    LAS float* pwi = pwr + 33 * 64;
    LAS float* bbr = pwi + 33 * 64;
    LAS float* bbi = bbr + 1024;
    LAS float* ccr = bbi + 1024;
    LAS float* cci = ccr + 1024;
    LAS float* km = cci + 1024;
    const float* lam_re = F.in[3]; const float* lam_im = F.in[4]; const float* log_dt = F.in[5];
    const float* b_re = F.in[6]; const float* b_im = F.in[7]; const float* c_re = F.in[8]; const float* c_im = F.in[9]; const float* dsk = F.in[10];
    float* lamL = (float*)(F.ws + WS_LAML); bf16* WE = (bf16*)(F.ws + WS_WE); bf16* TW = (bf16*)(F.ws + WS_TW);
    const int tid = F.tid;
    if (tid < 64) { const int p = tid;
        const float lr = lam_re[g * NP + p], li = lam_im[g * NP + p], dt = expf(log_dt[g]);
        const float er = expf(lr * dt); float sn, cs; sincos_acc(li * dt, sn, cs);
        const float br = er * cs, bi = er * sn;
        const float nr = br - 1.0f, ni = bi, den = 1.0f / (lr * lr + li * li);
        const float fr = (nr * lr + ni * li) * den, fi = (ni * lr - nr * li) * den;
        float pr = 1.0f, pi = 0.0f;
        for (int n = 0; n <= 32; ++n) { pwr[n * 64 + p] = pr; pwi[n * 64 + p] = pi; const float t = pr * br - pi * bi; pi = pr * bi + pi * br; pr = t; }
        lamL[(g * 2 + 0) * NP + p] = pwr[32 * 64 + p]; lamL[(g * 2 + 1) * NP + p] = pwi[32 * 64 + p];
        for (int c = 0; c < GC; ++c) { const float xr = b_re[(g * NP + p) * GC + c], xi = b_im[(g * NP + p) * GC + c]; bbr[p * 16 + c] = fr * xr - fi * xi; bbi[p * 16 + c] = fr * xi + fi * xr; }
    }
    for (int i = tid; i < 1024; i += NWAVES * 64) { ccr[i] = c_re[g * 1024 + i]; cci[i] = c_im[g * 1024 + i]; }
    __syncthreads();
    {
        const int pair = tid & 255, co = pair >> 4, ci = pair & 15, t0 = (tid >> 8) * 16;
        float acc[16];
#pragma unroll
        for (int t = 0; t < 16; ++t) acc[t] = 0.f;
        for (int p = 0; p < NP; ++p) { const float cr = ccr[co * 64 + p], cim = cci[co * 64 + p], xr = bbr[p * 16 + ci], xi = bbi[p * 16 + ci];
            const float gr = cr * xr - cim * xi, gi = cr * xi + cim * xr;
#pragma unroll
            for (int t = 0; t < 16; ++t) acc[t] += gr * pwr[(t0 + t) * 64 + p] - gi * pwi[(t0 + t) * 64 + p]; }
#pragma unroll
        for (int t = 0; t < 16; ++t) km[(t0 + t) * 256 + co * 16 + ci] = acc[t];
    }
    __syncthreads();
    {
        const int n = tid, i = n >> 4, co = n & 15; const float dv = dsk[g * GC + co];
        bf16* dst = TW + ((size_t)g * 512 + n) * UK;
        for (int k8 = 0; k8 < UK / 8; ++k8) { float v[8];
#pragma unroll
            for (int e = 0; e < 8; ++e) { const int k = k8 * 8 + e; float val;
                if (k < 512) { const int j = k >> 4, ci = k & 15; val = (j <= i) ? km[(i - j) * 256 + co * 16 + ci] : 0.f; if (j == i && ci == co) val += dv; }
                else { const int ri = (k - 512) >> 6, p = (k - 512) & 63; const float cr = ccr[co * 64 + p], cim = cci[co * 64 + p], pr = pwr[(i + 1) * 64 + p], pi = pwi[(i + 1) * 64 + p];
                    val = ri == 0 ? (cr * pr - cim * pi) : -(cr * pi + cim * pr); }
                v[e] = val; }
            v4u o; o.x = pk2(v[0], v[1]); o.y = pk2(v[2], v[3]); o.z = pk2(v[4], v[5]); o.w = pk2(v[6], v[7]);
            *(GAS v4u*)(dst + k8 * 8) = o; }
    }
    {
        const int row = tid & 127, ri = row >> 6, p = row & 63, kq = tid >> 7;
        bf16* dst = WE + ((size_t)g * 128 + row) * 512 + kq * 128;
        for (int k8 = 0; k8 < 16; ++k8) { float v[8];
#pragma unroll
            for (int e = 0; e < 8; ++e) { const int k = kq * 128 + k8 * 8 + e, j = k >> 4, c = k & 15; const float pr = pwr[(31 - j) * 64 + p], pi = pwi[(31 - j) * 64 + p], xr = bbr[p * 16 + c], xi = bbi[p * 16 + c];
                v[e] = ri == 0 ? (pr * xr - pi * xi) : (pr * xi + pi * xr); }
            v4u o; o.x = pk2(v[0], v[1]); o.y = pk2(v[2], v[3]); o.z = pk2(v[4], v[5]); o.w = pk2(v[6], v[7]);
            *(GAS v4u*)(dst + k8 * 8) = o; }
    }
    __syncthreads();
}
__device__ __forceinline__ void p0_prologue(Frame& F) {
    if (blockIdx.x < NG) ssm_tables(F, (int)blockIdx.x);
    if (blockIdx.x == NG && F.tid < 128) {
        bf16* WE = (bf16*)(F.ws + WS_WE) + (size_t)NG * 128 * 512;
        for (int i = 0; i < 512 / 8; ++i) *(GAS v4u*)(WE + (size_t)F.tid * 512 + i * 8) = (v4u){0u, 0u, 0u, 0u};
    }
    LAS float* scr = (LAS float*)(F.lds + RING_OFF + F.wave * 16384);
    const int gw = F.vcu * NWAVES + F.wave, NGW = F.G * NWAVES;
    constexpr int I_IN = (D / 64) * (NPROJ / 32), I_GLU = (SSW / 64) * (SSW / 32), I_OUT = (D / 64) * (D / 32), I_E = (D / 64) * (FF / 32);
    constexpr int NITEMS = I_IN + 2 * I_GLU + I_OUT + 3 * NE * I_E;
    bf16* WinT = (bf16*)(F.ws + WS_WINT); bf16* WgluT = (bf16*)(F.ws + WS_WGLUT); bf16* WoutT = (bf16*)(F.ws + WS_WOUTT); bf16* W1T = (bf16*)(F.ws + WS_W1T); bf16* W2T = (bf16*)(F.ws + WS_W2T);
    for (int it = gw; it < NITEMS; it += NGW) {
        int r = it;
        if (r < I_IN) { p0_transpose_item(F.in[2], NPROJ, D, NPROJ, WinT, 1, 0, scr, r, F.lane); continue; } r -= I_IN;
        if (r < I_GLU) { p0_transpose_item(F.in[11], 2 * SSW, SSW, SSW, WgluT, 2, 0, scr, r, F.lane); continue; } r -= I_GLU;
        if (r < I_GLU) { p0_transpose_item(F.in[11] + SSW, 2 * SSW, SSW, SSW, WgluT, 2, 128, scr, r, F.lane); continue; } r -= I_GLU;
        if (r < I_OUT) { p0_transpose_item(F.in[14], D, D, D, WoutT, 1, 0, scr, r, F.lane); continue; } r -= I_OUT;
        const int mat = r / I_E, sub = r % I_E, kind = mat / NE, e = mat % NE;
        if (kind == 0) p0_transpose_item(F.in[18] + (size_t)e * D * FF, FF, D, FF, W1T + (size_t)e * 2 * FF * D, 2, 0, scr, sub, F.lane);
        else if (kind == 1) p0_transpose_item(F.in[20] + (size_t)e * D * FF, FF, D, FF, W1T + (size_t)e * 2 * FF * D, 2, 128, scr, sub, F.lane);
        else p0_transpose_item(F.in[22] + (size_t)e * FF * D, D, FF, D, W2T + (size_t)e * D * FF, 1, 0, scr, sub, F.lane);
    }
    bf16* HN = (bf16*)(F.ws + WS_HN);
    for (int m = gw; m < M; m += NGW) rms_row_to_bf16(F.lane, F.in[0] + (size_t)m * D, F.in[1], HN + (size_t)m * D);
}

__device__ __forceinline__ void attn_simple_unit(const unsigned short* Qh, const unsigned short* Kh, const unsigned short* Vh, bf16* Y, int b, int h, int qb, int lane) {
    const int t = qb * 64 + lane; const size_t row = (size_t)b * SEQ + t;
    float q[64], o[64];
    { const v4u* qp = (const v4u*)(Qh + row * SBW + h * HD);
#pragma unroll
      for (int i = 0; i < 8; ++i) { const v4u w = qp[i];
#pragma unroll
          for (int j = 0; j < 4; ++j) { const unsigned wj = w[j]; const h16x2 hv = __builtin_bit_cast(h16x2, wj); q[8 * i + 2 * j] = (float)hv.x; q[8 * i + 2 * j + 1] = (float)hv.y; } } }
#pragma unroll
    for (int d = 0; d < 64; ++d) o[d] = 0.f;
    float cum = 0.f;
    for (int s = qb * 64 + 62; s >= 0; --s) {
        const size_t krow = ((size_t)b * SEQ + s) * SBW + h * HD;
        const v4u* kp = (const v4u*)(Kh + krow); const v4u* vp = (const v4u*)(Vh + krow);
        float z = 0.f;
#pragma unroll
        for (int i = 0; i < 8; ++i) { const v4u w = kp[i];
#pragma unroll
            for (int j = 0; j < 4; ++j) { const unsigned wj = w[j]; const h16x2 hv = __builtin_bit_cast(h16x2, wj); z = fmaf(q[8 * i + 2 * j], (float)hv.x, z); z = fmaf(q[8 * i + 2 * j + 1], (float)hv.y, z); } }
        const bool act = s < t;
        const float t1 = flog2(1.0f + fexp2(-fabsf(z)));
        const float L = act ? -(fmaxf(z, 0.f) + t1) : 0.f;
        const float ls = fminf(z, 0.f) - t1;
        const float p = act ? fexp2(ls + cum) : 0.f;
        cum += L;
#pragma unroll
        for (int i = 0; i < 8; ++i) { const v4u w = vp[i];
#pragma unroll
            for (int j = 0; j < 4; ++j) { const unsigned wj = w[j]; const h16x2 hv = __builtin_bit_cast(h16x2, wj); o[8 * i + 2 * j] = fmaf(p, (float)hv.x, o[8 * i + 2 * j]); o[8 * i + 2 * j + 1] = fmaf(p, (float)hv.y, o[8 * i + 2 * j + 1]); } }
        if (__all(cum < -150.0f)) break;
    }
    bf16* yp = Y + row * SBW + h * HD;
#pragma unroll
    for (int i = 0; i < 8; ++i) { v4u w; w.x = pk2(o[8 * i], o[8 * i + 1]); w.y = pk2(o[8 * i + 2], o[8 * i + 3]); w.z = pk2(o[8 * i + 4], o[8 * i + 5]); w.w = pk2(o[8 * i + 6], o[8 * i + 7]); *(v4u*)(yp + 8 * i) = w; }
}
__device__ __forceinline__ void attn_phase(Frame& F) {
    const unsigned short* Qh = (const unsigned short*)(F.ws + WS_Q); const unsigned short* Kh = (const unsigned short*)(F.ws + WS_K); const unsigned short* Vh = (const unsigned short*)(F.ws + WS_V);
    bf16* Y = (bf16*)(F.ws + WS_YSB);
    constexpr int NQB = SEQ / 64, NUNITS = BATCH * NH * NQB;
    const int gw = F.vcu * NWAVES + F.wave, NGW = F.G * NWAVES;
    for (int u = gw; u < NUNITS; u += NGW) { const int qb = u % NQB, bh = u / NQB; attn_simple_unit(Qh, Kh, Vh, Y, bh / NH, bh % NH, qb, F.lane); }
}

__device__ __forceinline__ void scan_phase(Frame& F) {
    const int gw = F.vcu * NWAVES + F.wave;
    if (F.wave != 0) return;
    const int task = F.vcu; if (task >= BATCH * NG) return;
    const int b = task / NG, g = task % NG, p = F.lane; (void)gw;
    const float* lamL = (const float*)(F.ws + WS_LAML); const float* S = (const float*)(F.ws + WS_SLOC); bf16* U = (bf16*)(F.ws + WS_UCAT);
    const float lr = lamL[(g * 2 + 0) * NP + p], li = lamL[(g * 2 + 1) * NP + p];
    float xr = 0.f, xi = 0.f;
    for (int c0 = 0; c0 < CPB; c0 += 8) {
        float sr[8], si[8];
#pragma unroll
        for (int j = 0; j < 8; ++j) { const size_t base = ((size_t)(b * CPB + c0 + j) * NG + g) * 128; sr[j] = S[base + p]; si[j] = S[base + 64 + p]; }
#pragma unroll
        for (int j = 0; j < 8; ++j) { bf16* dst = U + ((size_t)(b * CPB + c0 + j) * NG + g) * UK + 512;
            dst[p] = (bf16)f2bf(xr); dst[64 + p] = (bf16)f2bf(xi);
            const float nr = lr * xr - li * xi + sr[j], ni = lr * xi + li * xr + si[j]; xr = nr; xi = ni; }
    }
}

__device__ __forceinline__ void mix_phase(Frame& F) {
    const bf16* YSB = (const bf16*)(F.ws + WS_YSB); const bf16* YSSM = (const bf16*)(F.ws + WS_YSSM); bf16* MX = (bf16*)(F.ws + WS_MIXED);
    const float* g_sb = F.in[12]; const float* g_ssm = F.in[13];
    const int gw = F.vcu * NWAVES + F.wave, NGW = F.G * NWAVES, lane = F.lane;
    f32x4 ga[2], gb[2];
#pragma unroll
    for (int j = 0; j < 2; ++j) { ga[j] = *(const f32x4*)(g_sb + 8 * lane + 4 * j); gb[j] = *(const f32x4*)(g_ssm + 8 * lane + 4 * j); }
    for (int m = gw; m < M; m += NGW) {
        const v4u a = *(const v4u*)(YSB + (size_t)m * SBW + 8 * lane), c = *(const v4u*)(YSSM + (size_t)m * SSW + 8 * lane);
        float av[8], cv[8]; float sa = 0.f, sc = 0.f;
#pragma unroll
        for (int j = 0; j < 4; ++j) { av[2 * j] = bflo(a[j]); av[2 * j + 1] = bfhi(a[j]); cv[2 * j] = bflo(c[j]); cv[2 * j + 1] = bfhi(c[j]); }
#pragma unroll
        for (int j = 0; j < 8; ++j) { sa += av[j] * av[j]; sc += cv[j] * cv[j]; }
        const float ra = 1.0f / sqrtf(wave_sum(sa) * (1.f / SBW) + EPS), rc = 1.0f / sqrtf(wave_sum(sc) * (1.f / SSW) + EPS);
        v4u oa, oc;
#pragma unroll
        for (int j = 0; j < 4; ++j) { oa[j] = pk2(av[2 * j] * ra * ga[j >> 1][(2 * j) & 3], av[2 * j + 1] * ra * ga[j >> 1][(2 * j + 1) & 3]);
                                      oc[j] = pk2(cv[2 * j] * rc * gb[j >> 1][(2 * j) & 3], cv[2 * j + 1] * rc * gb[j >> 1][(2 * j + 1) & 3]); }
        if (DBG_MODE == 3) oa = (v4u){0u, 0u, 0u, 0u};
        if (DBG_MODE == 2) oc = (v4u){0u, 0u, 0u, 0u};
        *(v4u*)(MX + (size_t)m * D + 8 * lane) = oa; *(v4u*)(MX + (size_t)m * D + SBW + 8 * lane) = oc;
    }
}

__device__ __forceinline__ void router_phase(Frame& F) {
    LAS float* wl = (LAS float*)(F.lds);
    LAS int* lcnt = (LAS int*)(F.lds + RT_SCR_OFF); LAS int* lbase = lcnt + 32; LAS int* asg = lbase + 32;
    const float* wr = F.in[16]; const float* br = F.in[17]; const float* g2 = F.in[15];
    const float* X1 = F.out; bf16* XN = (bf16*)(F.ws + WS_XN); float* gates = (float*)(F.ws + WS_GATES); int* lists = (int*)(F.ws + WS_LISTS);
    unsigned* gcnt = (unsigned*)(F.ctl + CW_CNT);
    const int tid = F.tid, lane = F.lane;
    for (int idx = tid; idx < D * NE; idx += NWAVES * 64) wl[(idx >> 5) * 33 + (idx & 31)] = wr[idx];
    if (tid < 32) lcnt[tid] = 0;
    __syncthreads();
    const int my_e = ((lane >> 5) & 1) * 16 + ((lane >> 4) & 1) * 8 + ((lane >> 3) & 1) * 4 + ((lane >> 2) & 1) * 2 + ((lane >> 1) & 1);
    const float my_b = br[my_e];
    float gv[16];
#pragma unroll
    for (int i = 0; i < 16; ++i) gv[i] = g2[lane + 64 * i];
    const int tok_per_wg = M / F.G;
    const int tok_per_wave = tok_per_wg / NWAVES;
    for (int ti = 0; ti < tok_per_wave; ++ti) {
        const int tok = F.vcu * tok_per_wg + F.wave * tok_per_wave + ti;
        float xv[16]; float ss = 0.f;
#pragma unroll
        for (int i = 0; i < 16; ++i) { xv[i] = X1[(size_t)tok * D + lane + 64 * i]; ss += xv[i] * xv[i]; }
        const float rstd = 1.0f / sqrtf(wave_sum(ss) * (1.f / D) + EPS);
#pragma unroll
        for (int i = 0; i < 16; ++i) { xv[i] = xv[i] * rstd * gv[i]; XN[(size_t)tok * D + lane + 64 * i] = (bf16)f2bf(xv[i]); }
        float acc[32];
#pragma unroll
        for (int e = 0; e < 32; ++e) acc[e] = 0.f;
#pragma unroll
        for (int i = 0; i < 16; ++i) { const LAS float* wrow = wl + (lane + 64 * i) * 33;
#pragma unroll
            for (int e = 0; e < 32; ++e) acc[e] = fmaf(xv[i], wrow[e], acc[e]); }
#pragma unroll
        for (int e = 0; e < 16; ++e) { const bool hi = (lane & 32) != 0; const float keep = hi ? acc[e + 16] : acc[e], send = hi ? acc[e] : acc[e + 16]; acc[e] = keep + __shfl_xor(send, 32); }
#pragma unroll
        for (int e = 0; e < 8; ++e) { const bool hi = (lane & 16) != 0; const float keep = hi ? acc[e + 8] : acc[e], send = hi ? acc[e] : acc[e + 8]; acc[e] = keep + __shfl_xor(send, 16); }
#pragma unroll
        for (int e = 0; e < 4; ++e) { const bool hi = (lane & 8) != 0; const float keep = hi ? acc[e + 4] : acc[e], send = hi ? acc[e] : acc[e + 4]; acc[e] = keep + __shfl_xor(send, 8); }
#pragma unroll
        for (int e = 0; e < 2; ++e) { const bool hi = (lane & 4) != 0; const float keep = hi ? acc[e + 2] : acc[e], send = hi ? acc[e] : acc[e + 2]; acc[e] = keep + __shfl_xor(send, 4); }
        { const bool hi = (lane & 2) != 0; const float keep = hi ? acc[1] : acc[0], send = hi ? acc[0] : acc[1]; acc[0] = keep + __shfl_xor(send, 2); }
        const float logit = acc[0] + __shfl_xor(acc[0], 1) + my_b;
        int rank = 0; float mx = -INFINITY;
#pragma unroll
        for (int e2 = 0; e2 < 32; ++e2) { const int src = ((e2 >> 4) & 1) * 32 + ((e2 >> 3) & 1) * 16 + ((e2 >> 2) & 1) * 8 + ((e2 >> 1) & 1) * 4 + (e2 & 1) * 2;
            const float v = __builtin_bit_cast(float, __builtin_amdgcn_readlane(__builtin_bit_cast(int, logit), src));
            rank += (v > logit || (v == logit && e2 < my_e)) ? 1 : 0; mx = fmaxf(mx, v); }
        const bool sel = rank < TOPK && (lane & 1) == 0;
        const float ex = sel ? fexp2((logit - mx) * LOG2E) : 0.f;
        const float gate = ex / wave_sum(ex);
        if (sel) { gates[tok * TOPK + rank] = gate; const int pos = __hip_atomic_fetch_add(lcnt + my_e, 1, __ATOMIC_RELAXED, __HIP_MEMORY_SCOPE_WORKGROUP); asg[F.wave * 32 + ti * 4 + rank] = my_e | (pos << 8); }
    }
    __syncthreads();
    if (tid < 32) lbase[tid] = (int)__hip_atomic_fetch_add(gcnt + tid, (unsigned)lcnt[tid], RLX_AGENT);
    __syncthreads();
    if (tid < tok_per_wg * TOPK) { const int a = asg[tid], e = a & 255, pos = a >> 8; const int w = tid >> 5, r = tid & 31; const int tok = F.vcu * tok_per_wg + w * tok_per_wave + (r >> 2);
        lists[e * M + lbase[e] + pos] = tok * TOPK + (r & 3); }
    __syncthreads();
}

__device__ __forceinline__ void moe_tables(Frame& F) {
    LAS int* tab = (LAS int*)(F.lds + TAB_OFF); LAS int* cnt = tab, * mt = tab + 32, * tbase = tab + 64;
    unsigned* gcnt = (unsigned*)(F.ctl + CW_CNT);
    if (F.tid < 32) { const int c = (int)__hip_atomic_load(gcnt + F.tid, RLX_AGENT); cnt[F.tid] = c; mt[F.tid] = (c + 255) >> 8; }
    __syncthreads();
    if (F.tid == 0) { int s = 0; for (int e = 0; e < NE; ++e) { tbase[e] = s; s += mt[e]; } tbase[NE] = s; }
    __syncthreads();
}
__device__ __forceinline__ void moe_units(Frame& F, int npn, int gpn) {
    LAS int* tab = (LAS int*)(F.lds + TAB_OFF); LAS int* mt = tab + 32, * tbase = tab + 64; LAS int* units = (LAS int*)(F.lds + UNITS_OFF);
    if (F.tid < 32) {
        const int nU = tbase[NE] * npn; const int L = F.tid * F.G + (int)blockIdx.x; int pm = 0, pn = 0, e = 0, valid = 0;
        if (L < nU) { const int seq = pg8::xcd_remap(L, nU); int ee = 0; while (ee < NE - 1 && seq >= tbase[ee + 1] * npn) ++ee;
            const int r = seq - tbase[ee] * npn, m = mt[ee]; const int grp = r / (m * gpn), r2 = r % (m * gpn);
            e = ee; pn = grp * gpn + r2 / m; pm = tbase[ee] + r2 % m; valid = 1; }
        units[4 * F.tid + 0] = pm; units[4 * F.tid + 1] = pn; units[4 * F.tid + 2] = e; units[4 * F.tid + 3] = valid;
    }
    __syncthreads();
}

__device__ __forceinline__ void gather_phase(Frame& F) {
    LAS int* tab = (LAS int*)(F.lds + TAB_OFF); LAS int* cnt = tab, * tbase = tab + 64; LAS int* tile_e = (LAS int*)(F.lds + TILEE_OFF);
    const int ntiles = tbase[NE];
    for (int t = F.tid; t < ntiles; t += NWAVES * 64) { int ee = 0; while (ee < NE - 1 && t >= tbase[ee + 1]) ++ee; tile_e[t] = ee; }
    __syncthreads();
    const bf16* XN = (const bf16*)(F.ws + WS_XN); bf16* XS = (bf16*)(F.ws + WS_XS); const float* gates = (const float*)(F.ws + WS_GATES); const int* lists = (const int*)(F.ws + WS_LISTS);
    int* rowinfo = (int*)(F.ws + WS_ROWINFO);
    const int gw = F.vcu * NWAVES + F.wave, NGW = F.G * NWAVES, lane = F.lane;
    for (int r = gw; r < ntiles * 256; r += NGW) {
        const int e = tile_e[r >> 8], i = r - tbase[e] * 256;
        v4u a0 = (v4u){0u, 0u, 0u, 0u}, a1 = a0; int slot = -1; float gate = 0.f;
        if (i < cnt[e]) { slot = lists[e * M + i]; gate = gates[slot]; const v4u* src = (const v4u*)(XN + (size_t)(slot >> 2) * D); a0 = src[lane]; a1 = src[64 + lane]; }
        v4u* dst = (v4u*)(XS + (size_t)r * D); dst[lane] = a0; dst[64 + lane] = a1;
        if (lane == 0) { rowinfo[2 * r] = slot; rowinfo[2 * r + 1] = __builtin_bit_cast(int, gate); }
    }
}

__device__ __forceinline__ void final_phase(Frame& F) {
    const bf16* YB = (const bf16*)(F.ws + WS_YBUF); const float* gf = F.in[24]; float* O = F.out;
    const int gw = F.vcu * NWAVES + F.wave, NGW = F.G * NWAVES, lane = F.lane;
    f32x4 gg[4];
#pragma unroll
    for (int j = 0; j < 4; ++j) gg[j] = *(const f32x4*)(gf + 4 * lane + 256 * j);
    for (int m = gw; m < M; m += NGW) {
        f32x4 v[4]; float ss = 0.f;
#pragma unroll
        for (int j = 0; j < 4; ++j) { v[j] = *(const f32x4*)(O + (size_t)m * D + 4 * lane + 256 * j);
#pragma unroll
            for (int k = 0; k < (DBG_MODE ? 0 : TOPK); ++k) { const v2u w = *(const v2u*)(YB + ((size_t)m * TOPK + k) * D + 4 * lane + 256 * j); v[j].x += bflo(w.x); v[j].y += bfhi(w.x); v[j].z += bflo(w.y); v[j].w += bfhi(w.y); }
            ss += (v[j].x * v[j].x + v[j].y * v[j].y) + (v[j].z * v[j].z + v[j].w * v[j].w); }
        const float rstd = 1.0f / sqrtf(wave_sum(ss) * (1.f / D) + EPS);
#pragma unroll
        for (int j = 0; j < 4; ++j) *(f32x4*)(O + (size_t)m * D + 4 * lane + 256 * j) = v[j] * rstd * gg[j];
    }
}

struct Args { const float* in[25]; float* out; unsigned char* ws; int ph_lo, ph_hi, li, pad; };
__global__ void __launch_bounds__(NWAVES * 64, 2) hyb_fwd(Args args) {
    extern __shared__ __attribute__((aligned(16))) unsigned char lds[];
    Frame F;
    F.lds = (LAS unsigned char*)lds;
    F.MISC = (volatile LAS unsigned*)(F.lds + MISC_OFF);
    F.tid = threadIdx.x; F.lane = F.tid & 63; F.wave = __builtin_amdgcn_readfirstlane(F.tid >> 6);
    F.G = gridDim.x; { const int bx = blockIdx.x; F.vcu = (F.G % 8 == 0) ? (bx % 8) * (F.G / 8) + bx / 8 : bx; }
    F.ws = args.ws; F.ctl = (gu32*)(args.ws + WS_CTL); F.out = args.out;
#pragma unroll
    for (int i = 0; i < 25; ++i) F.in[i] = args.in[i];
    for (int u = F.tid; u < (LDS_BYTES - LDSCTL_OFF) / 4; u += NWAVES * 64) ((LAS unsigned*)(F.lds + LDSCTL_OFF))[u] = 0u;
    __syncthreads();
    XcdBarrier bar; bar.bar = (unsigned*)(F.ctl + CW_BAR); bar.x = 0; bar.st = nullptr;
    if (N_LAUNCHES != PER_PHASE) bar = xcd_barrier_post((unsigned*)(F.ctl + CW_BAR), F.MISC + 8);
#define GRID_BAR(seam) do { if (N_LAUNCHES == PER_PHASE) { if (F.tid == 0) __hip_atomic_store(F.ctl + CW_TMO, 0xBADBA0u | (unsigned)(seam), RLX_AGENT); } else { xcd_barrier(bar); } } while (0)
    const int lo = args.ph_lo, hi = args.ph_hi;
#define IN(k) (lo <= (k) && (k) < hi)
#define BOTH(k) (IN(k) && IN((k) + 1))
    const pg8::bf16_t* wsb = (const pg8::bf16_t*)args.ws;
#define WSB(off) ((const pg8::bf16_t*)(args.ws + (off)))

    if (IN(0)) { p0_prologue(F); if (BOTH(0)) GRID_BAR(0); }

    if (IN(1)) {
        pg8::Gemm g{WSB(WS_HN), WSB(WS_WINT), D, D, D}; pg8::StaticOrder S; S.init(M, NPROJ, F.G, (int)blockIdx.x, D, D);
        EpiInProj E{(unsigned short*)(args.ws + WS_Q), (bf16*)(args.ws + WS_UCAT), LOG2E * 0.125f};
        pg8::gemm_phase<EpiInProj, pg8::StaticOrder, PG8_ALIGN, PG8_SP2>(F.lds + RING_OFF, g, S, E);
        if (BOTH(1)) GRID_BAR(1);
    }
    if (IN(2)) {
        pg8::Gemm g{WSB(WS_UCAT), WSB(WS_WE), NG * UK, 512, 512}; SsmOrder S{NG * 2, F.G, (int)blockIdx.x, 1, 128, 512};
        EpiSloc E{(float*)(args.ws + WS_SLOC)};
        pg8::gemm_phase<EpiSloc, SsmOrder, PG8_ALIGN, PG8_SP2>(F.lds + RING_OFF, g, S, E);
        attn_phase(F);
        if (BOTH(2)) GRID_BAR(2);
    }
    if (IN(3)) { scan_phase(F); if (BOTH(3)) GRID_BAR(3); }
    if (IN(4)) {
        pg8::Gemm g{WSB(WS_UCAT), WSB(WS_TW), NG * UK, UK, UK}; SsmOrder S{NG * 4, F.G, (int)blockIdx.x, 2, 512, UK};
        EpiS3 E{(bf16*)(args.ws + WS_YG)};
        pg8::gemm_phase<EpiS3, SsmOrder, PG8_ALIGN, PG8_SP2>(F.lds + RING_OFF, g, S, E);
        if (BOTH(4)) GRID_BAR(4);
    }
    if (IN(5)) {
        pg8::Gemm g{WSB(WS_YG), WSB(WS_WGLUT), SSW, SSW, SSW}; pg8::StaticOrder S; S.init(M, 2 * SSW, F.G, (int)blockIdx.x, SSW, SSW);
        EpiGlu E{(bf16*)(args.ws + WS_YSSM)};
        pg8::gemm_phase<EpiGlu, pg8::StaticOrder, PG8_ALIGN, PG8_SP2>(F.lds + RING_OFF, g, S, E);
        if (BOTH(5)) GRID_BAR(5);
    }
    if (IN(6)) { mix_phase(F); if (BOTH(6)) GRID_BAR(6); }
    if (IN(7)) {
        pg8::Gemm g{WSB(WS_MIXED), WSB(WS_WOUTT), D, D, D}; pg8::StaticOrder S; S.init(M, D, F.G, (int)blockIdx.x, D, D);
        EpiOutProj E{F.in[0], F.out};
        pg8::gemm_phase<EpiOutProj, pg8::StaticOrder, PG8_ALIGN, PG8_SP2>(F.lds + RING_OFF, g, S, E);
        if (BOTH(7)) GRID_BAR(7);
    }
    if (IN(8) && !DBG_MODE) { router_phase(F); if (BOTH(8)) GRID_BAR(8); }
    if (IN(9) && !DBG_MODE) { moe_tables(F); gather_phase(F); if (BOTH(9)) GRID_BAR(9); }
    if (IN(10) && !DBG_MODE) {
        moe_tables(F); moe_units(F, 8, 4);
        pg8::Gemm g{WSB(WS_XS), WSB(WS_W1T), D, D, D}; MoeOrder S{(const LAS int*)(F.lds + UNITS_OFF), 2 * FF, D};
        EpiMoe1 E{(bf16*)(args.ws + WS_H), F.in[19], F.in[21]};
        pg8::gemm_phase<EpiMoe1, MoeOrder, PG8_ALIGN, PG8_SP2>(F.lds + RING_OFF, g, S, E);
        if (BOTH(10)) GRID_BAR(10);
    }
    if (IN(11) && !DBG_MODE) {
        moe_tables(F); moe_units(F, 4, 4);
        pg8::Gemm g{WSB(WS_H), WSB(WS_W2T), FF, FF, FF}; MoeOrder S{(const LAS int*)(F.lds + UNITS_OFF), D, FF};
        EpiMoe2 E{(bf16*)(args.ws + WS_YBUF), F.in[23], (const int*)(args.ws + WS_ROWINFO)};
        pg8::gemm_phase<EpiMoe2, MoeOrder, PG8_ALIGN, PG8_SP2>(F.lds + RING_OFF, g, S, E);
        if (BOTH(11)) GRID_BAR(11);
    }
    if (IN(12)) { final_phase(F); }
    (void)wsb;
#undef IN
#undef BOTH
}

extern "C" void kernel_launch(void* const* d_in, const int* in_sizes, int n_in, void* d_out, int out_size, void* d_ws, size_t ws_size, hipStream_t stream) {
    static int grid = 0;
    if (grid == 0) {
        if (n_in != 25 || in_sizes[0] != M * D || out_size != M * D || ws_size < WS_END) { fprintf(stderr, "kernel_launch: unexpected shapes: n_in %d in0 %d out %d ws %zu (need %zu); nothing launched\n", n_in, n_in > 0 ? in_sizes[0] : -1, out_size, ws_size, (size_t)WS_END); grid = -1; return; }
        int dev = 0, cus = 0, per_cu = 0;
        if (hipGetDevice(&dev) != hipSuccess || hipDeviceGetAttribute(&cus, hipDeviceAttributeMultiprocessorCount, dev) != hipSuccess) { grid = -1; return; }
        if (hipFuncSetAttribute((const void*)hyb_fwd, hipFuncAttributeMaxDynamicSharedMemorySize, LDS_BYTES) != hipSuccess) { fprintf(stderr, "kernel_launch: hipFuncSetAttribute failed\n"); grid = -1; return; }
        if (hipOccupancyMaxActiveBlocksPerMultiprocessor(&per_cu, (const void*)hyb_fwd, NWAVES * 64, LDS_BYTES) != hipSuccess || per_cu < 1)
            fprintf(stderr, "kernel_launch: note: occupancy query reports %d workgroups per CU\n", per_cu);
        (void)hipGetLastError();
        grid = cus;
        if (grid != 256) fprintf(stderr, "kernel_launch: note: %d CUs (built for 256)\n", grid);
    }
    if (grid < 0) return;
    if (hipMemsetAsync((char*)d_ws + WS_CTL, 0, CTL_ZERO_BYTES, stream) != hipSuccess) { fprintf(stderr, "kernel_launch: memset failed\n"); return; }
    Args a{};
    for (int i = 0; i < 25; ++i) a.in[i] = (const float*)d_in[i];
    a.out = (float*)d_out; a.ws = (unsigned char*)d_ws;
    for (int li = 0; li < N_LAUNCHES; ++li) {
        a.ph_lo = (N_LAUNCHES == PER_PHASE) ? li : 0; a.ph_hi = (N_LAUNCHES == PER_PHASE) ? li + 1 : PER_PHASE; a.li = li;
        hipLaunchKernelGGL(hyb_fwd, dim3(grid), dim3(NWAVES * 64), LDS_BYTES, stream, a);
        const hipError_t le = hipPeekAtLastError();
        if (le != hipSuccess) { fprintf(stderr, "kernel_launch: launch %d failed: %s\n", li, hipGetErrorName(le)); break; }
    }
}
```

```cpp
#include <hip/hip_runtime.h>
#include <cstdio>
#include <cstdint>
namespace pg8 {
#define PG8_LAS __attribute__((address_space(3)))
typedef unsigned short bf16_t;
typedef short bf16x8 __attribute__((ext_vector_type(8)));
typedef float f32x4 __attribute__((ext_vector_type(4)));
typedef unsigned u32x4 __attribute__((ext_vector_type(4)));
constexpr int BM = 256, BK = 64, HALF = 128, HTB = HALF * BK * 2  , STAGE_BYTES = 8 * HTB, NXCD = 8, WGM = 8;

__host__ __device__ __forceinline__ int lds_byte(int r, int c) { const int st = (r >> 4) * 2 + (c >> 5), rr = r & 15, cc = c & 31, ob = rr * 64 + cc * 2; return st * 1024 + (ob ^ (((ob >> 9) & 1) << 5)); }
__host__ __device__ __forceinline__ void stage_rc(int b, int& R, int& C) { const int st = b / 1024, sb = b % 1024, swz = sb ^ (((sb >> 9) & 1) << 5); R = (st >> 1) * 16 + swz / 64; C = (st & 1) * 32 + (swz % 64) / 2; }
__host__ __device__ __forceinline__ int perm32(int rho) { const int n = rho >> 4, i = rho & 15; return 8 * (i >> 2) + 4 * n + (i & 3); }

struct Unit { int pm, pn, e; long offA, offB; };
struct Gemm { const bf16_t* A; const bf16_t* Bt; int lda, K; unsigned brs, bks; };
__host__ __device__ __forceinline__ Gemm make_gemm(const bf16_t* A, const bf16_t* Bt, int lda, int ldb, int K) { Gemm g; g.A = A; g.Bt = Bt; g.lda = lda; g.K = K; g.brs = (unsigned)ldb * 2u; g.bks = 16u; return g; }

__host__ __device__ __forceinline__ int xcd_remap(int wgid, int nwg) { const int q = nwg / NXCD, r = nwg % NXCD, xcd = wgid % NXCD, off = wgid / NXCD; return (xcd < r ? xcd * (q + 1) : r * (q + 1) + (xcd - r) * q) + off; }

struct StaticOrder {
    int nM, nN, nwg, G, c, lda, ldb;
    __host__ __device__ void init(int M, int N, int G_, int c_, int lda_, int ldb_) { nM = M / BM; nN = N / BM; nwg = nM * nN; G = G_; c = c_; lda = lda_; ldb = ldb_; }
    __host__ __device__ bool next(int i, Unit& u) const {
        const long L = (long)i * G + c; if (L >= nwg) return false;
        const int wgid = xcd_remap((int)L, nwg);
        const int nig = WGM * nN, gid = wgid / nig, fm = gid * WGM, gsz = (nM - fm) < WGM ? (nM - fm) : WGM;
        u.pm = fm + ((wgid % nig) % gsz); u.pn = (wgid % nig) / gsz; u.e = 0;
        u.offA = (long)u.pm * BM * lda * 2; u.offB = (long)u.pn * BM * ldb * 2; return true;
    }
    __device__ __forceinline__ void a_ready(const Unit&) const {}
    __device__ __forceinline__ void done(const Unit&) const {}
};

__device__ __forceinline__ unsigned cvt_pk_bf16(float lo, float hi) { unsigned r; asm volatile("v_cvt_pk_bf16_f32 %0, %1, %2" : "=v"(r) : "v"(lo), "v"(hi)); return r; }
typedef float f32x2 __attribute__((ext_vector_type(2)));

template <class Epi, class Sched, bool ALIGN_EPI = false, bool SP2 = false>
__device__ __forceinline__ void gemm_phase(PG8_LAS unsigned char* lds, const Gemm g, const Sched& S, const Epi& E) {
    const int tid = threadIdx.x, wid = __builtin_amdgcn_readfirstlane(tid >> 6), lane = tid & 63, wr = wid >> 2, wc = wid & 3, fr = lane & 15, fq = lane >> 4;
    const int K = g.K, nt = K / BK;
    unsigned voffA[2], voffB[2];
#pragma unroll
    for (int i = 0; i < 2; ++i) { int R, C; stage_rc(tid * 16 + i * 8192, R, C); const int Rb = Epi::PERM ? ((R & ~31) + perm32(R & 31)) : R;
        voffA[i] = (unsigned)(R * g.lda + C) * 2u; voffB[i] = (unsigned)Rb * g.brs + (unsigned)(C >> 3) * g.bks; }
    const size_t kstepA = (size_t)(BK * 2), kstepB = (size_t)8 * g.bks;
    const size_t hstepA = (size_t)HALF * g.lda * 2, hstepB = (size_t)HALF * g.brs;
    const unsigned ldsw = (unsigned)wid * 1024u;
    const int aoff = lds_byte(wr * 64 + fr, fq * 8), boff = lds_byte(wc * 32 + fr, fq * 8);
#define PG8_SA(b, h) (((b) * 2 + (h)) * HTB)
#define PG8_SB(b, h) ((4 + (b) * 2 + (h)) * HTB)
#define PG8_STAGE(bufoff, gbase, voff) do { _Pragma("unroll") for (int _i = 0; _i < 2; ++_i) \
        __builtin_amdgcn_global_load_lds((const unsigned*)((const char*)(gbase) + (voff)[_i]), (PG8_LAS unsigned*)(lds + (bufoff) + ldsw + _i * 8192), 16, 0, 0); } while (0)
#define PG8_LDA(dst, b, h) do { _Pragma("unroll") for (int m = 0; m < 4; ++m) _Pragma("unroll") for (int k = 0; k < 2; ++k) dst[m][k] = *(const PG8_LAS bf16x8*)(lds + PG8_SA(b, h) + aoff + m * 2048 + k * 1024); } while (0)
#define PG8_LDB(dst, b, h) do { _Pragma("unroll") for (int n = 0; n < 2; ++n) _Pragma("unroll") for (int k = 0; k < 2; ++k) dst[n][k] = *(const PG8_LAS bf16x8*)(lds + PG8_SB(b, h) + boff + n * 2048 + k * 1024); } while (0)
#define PG8_MMA(ai, bj, At, Bt) do { __builtin_amdgcn_s_setprio(1); _Pragma("unroll") for (int m = 0; m < 4; ++m) _Pragma("unroll") for (int n = 0; n < 2; ++n) _Pragma("unroll") for (int k = 0; k < 2; ++k) \
        acc[ai][bj][m][n] = __builtin_amdgcn_mfma_f32_16x16x32_bf16(Bt[n][k], At[m][k], acc[ai][bj][m][n], 0, 0, 0); __builtin_amdgcn_s_setprio(0); } while (0)
#define PG8_WAIT_V(n) asm volatile("s_waitcnt vmcnt(" #n ")" ::: "memory")
#define PG8_WAIT_L(n) asm volatile("s_waitcnt lgkmcnt(" #n ")" ::: "memory")
#define PG8_BAR __builtin_amdgcn_s_barrier()
#define PG8_SCHED __builtin_amdgcn_sched_barrier(0)
    Unit cur, nxt; int ui = 0;
    if (!S.next(0, cur)) return;
    f32x4 acc[2][2][4][2];
#pragma unroll
    for (int a = 0; a < 2; ++a)
#pragma unroll
        for (int b = 0; b < 2; ++b)
#pragma unroll
            for (int m = 0; m < 4; ++m)
#pragma unroll
                for (int n = 0; n < 2; ++n) acc[a][b][m][n] = (f32x4){0.f, 0.f, 0.f, 0.f};
    bf16x8 At[4][2], B0[2][2], B1[2][2];
    const char* cA = (const char*)g.A + cur.offA; const char* cB = (const char*)g.Bt + cur.offB;
    S.a_ready(cur);
    if constexpr (SP2) {
        PG8_STAGE(PG8_SB(0, 0), cB, voffB); PG8_STAGE(PG8_SB(0, 1), cB + hstepB, voffB); PG8_STAGE(PG8_SA(0, 0), cA, voffA); PG8_STAGE(PG8_SA(0, 1), cA + hstepA, voffA);
        if (wr == 1) PG8_BAR;
        PG8_WAIT_V(2); PG8_BAR;
        PG8_STAGE(PG8_SB(1, 0), cB + kstepB, voffB); PG8_STAGE(PG8_SA(1, 0), cA + kstepA, voffA); PG8_STAGE(PG8_SB(1, 1), cB + hstepB + kstepB, voffB);
        PG8_WAIT_V(6); PG8_BAR;
    } else {
        PG8_STAGE(PG8_SB(0, 0), cB, voffB); PG8_STAGE(PG8_SA(0, 0), cA, voffA); PG8_STAGE(PG8_SB(0, 1), cB + hstepB, voffB); PG8_STAGE(PG8_SA(0, 1), cA + hstepA, voffA);
        if (wr == 1) PG8_BAR;
        PG8_WAIT_V(4); PG8_BAR;
        PG8_STAGE(PG8_SB(1, 0), cB + kstepB, voffB); PG8_STAGE(PG8_SA(1, 0), cA + kstepA, voffA); PG8_STAGE(PG8_SB(1, 1), cB + hstepB + kstepB, voffB);
        PG8_WAIT_V(6); PG8_BAR;
    }
    for (;;) {
        const bool has_next = S.next(ui + 1, nxt);
        const char* nA = has_next ? (const char*)g.A + nxt.offA : cA; const char* nB = has_next ? (const char*)g.Bt + nxt.offB : cB;
        for (int t = 0; t < nt; t += 2) {
            const bool last = (t == nt - 2);
            const char* a1 = cA + (size_t)(t + 1) * kstepA;
            const char* a2 = last ? nA : cA + (size_t)(t + 2) * kstepA; const char* b2 = last ? nB : cB + (size_t)(t + 2) * kstepB;
            const char* a3 = a2 + kstepA; const char* b3 = b2 + kstepB;
            if (last && has_next) S.a_ready(nxt);
            if constexpr (SP2) {
            PG8_LDB(B0, 0, 0); PG8_LDB(B1, 0, 1); PG8_SCHED; PG8_LDA(At, 0, 0); PG8_STAGE(PG8_SA(1, 1), a1 + hstepA, voffA);
            PG8_WAIT_V(8); PG8_WAIT_L(0); PG8_BAR; PG8_MMA(0, 0, At, B0); PG8_MMA(0, 1, At, B1); PG8_BAR; PG8_SCHED;
            PG8_LDA(At, 0, 1); PG8_STAGE(PG8_SB(0, 0), b2, voffB); PG8_STAGE(PG8_SB(0, 1), b2 + hstepB, voffB); PG8_STAGE(PG8_SA(0, 0), a2, voffA);
            PG8_WAIT_V(8); PG8_WAIT_L(0); PG8_BAR; PG8_MMA(1, 0, At, B0); PG8_MMA(1, 1, At, B1); PG8_BAR; PG8_SCHED;
            PG8_LDB(B0, 1, 0); PG8_LDB(B1, 1, 1); PG8_SCHED; PG8_LDA(At, 1, 0); PG8_STAGE(PG8_SA(0, 1), a2 + hstepA, voffA);
            PG8_WAIT_V(8); PG8_WAIT_L(0); PG8_BAR; PG8_MMA(0, 0, At, B0); PG8_MMA(0, 1, At, B1); PG8_BAR; PG8_SCHED;
            PG8_LDA(At, 1, 1); PG8_STAGE(PG8_SB(1, 0), b3, voffB); PG8_STAGE(PG8_SB(1, 1), b3 + hstepB, voffB); PG8_STAGE(PG8_SA(1, 0), a3, voffA);
            PG8_WAIT_V(8); PG8_WAIT_L(0); PG8_BAR; PG8_MMA(1, 0, At, B0); PG8_MMA(1, 1, At, B1); PG8_BAR; PG8_SCHED;
            } else {
            PG8_LDB(B0, 0, 0); PG8_SCHED; PG8_LDA(At, 0, 0); PG8_STAGE(PG8_SA(1, 1), a1 + hstepA, voffA);
            PG8_WAIT_L(8); PG8_BAR; PG8_WAIT_L(0); PG8_MMA(0, 0, At, B0); PG8_BAR; PG8_SCHED;
            PG8_LDB(B1, 0, 1); PG8_STAGE(PG8_SB(0, 0), b2, voffB);
            PG8_BAR; PG8_WAIT_L(0); PG8_MMA(0, 1, At, B1); PG8_BAR;
            PG8_LDA(At, 0, 1); PG8_STAGE(PG8_SA(0, 0), a2, voffA);
            PG8_BAR; PG8_WAIT_L(0); PG8_MMA(1, 0, At, B0); PG8_BAR; PG8_SCHED;
            PG8_STAGE(PG8_SB(0, 1), b2 + hstepB, voffB);
            PG8_WAIT_V(6); PG8_BAR; PG8_MMA(1, 1, At, B1); PG8_BAR;
            PG8_LDB(B0, 1, 0); PG8_SCHED; PG8_LDA(At, 1, 0); PG8_STAGE(PG8_SA(0, 1), a2 + hstepA, voffA);
            PG8_WAIT_L(8); PG8_BAR; PG8_WAIT_L(0); PG8_MMA(0, 0, At, B0); PG8_BAR; PG8_SCHED;
            PG8_LDB(B1, 1, 1); PG8_STAGE(PG8_SB(1, 0), b3, voffB);
            PG8_BAR; PG8_WAIT_L(0); PG8_MMA(0, 1, At, B1); PG8_BAR;
            PG8_LDA(At, 1, 1); PG8_STAGE(PG8_SA(1, 0), a3, voffA);
            PG8_BAR; PG8_WAIT_L(0); PG8_MMA(1, 0, At, B0); PG8_BAR; PG8_SCHED;
            PG8_STAGE(PG8_SB(1, 1), b3 + hstepB, voffB);
            PG8_WAIT_V(6); PG8_BAR; PG8_MMA(1, 1, At, B1); PG8_BAR;
            }
        }
        if constexpr (ALIGN_EPI) { if (wr == 0) PG8_BAR; }
        if constexpr (!Epi::AFTER_DRAIN) { E(acc, cur, wr, wc, fr, fq); S.done(cur); }
        if (!has_next) break;
#pragma unroll
        for (int a = 0; a < 2; ++a)
#pragma unroll
            for (int b = 0; b < 2; ++b)
#pragma unroll
                for (int m = 0; m < 4; ++m)
#pragma unroll
                    for (int n = 0; n < 2; ++n) acc[a][b][m][n] = (f32x4){0.f, 0.f, 0.f, 0.f};
        cur = nxt; cA = nA; cB = nB; ++ui;
        if constexpr (ALIGN_EPI) { if (wr == 1) PG8_BAR; }
    }
    PG8_WAIT_V(0);
    if constexpr (!ALIGN_EPI) { if (wr == 0) PG8_BAR; }
    PG8_BAR;
    if constexpr (Epi::AFTER_DRAIN) { E.fused(acc, cur, wr, wc, fr, fq, lds, wid, lane); S.done(cur); }
#undef PG8_SA
#undef PG8_SB
#undef PG8_STAGE
#undef PG8_LDA
#undef PG8_LDB
#undef PG8_MMA
#undef PG8_WAIT_V
#undef PG8_WAIT_L
#undef PG8_BAR
#undef PG8_SCHED
}
}

#ifndef PG8_SP2
#define PG8_SP2 true
#endif
#ifndef PG8_ALIGN
#define PG8_ALIGN true
#endif

constexpr int NWAVES = 8;
#ifndef MK_N_LAUNCHES
#define MK_N_LAUNCHES 1
#endif
#ifndef DBG_MODE
#define DBG_MODE 0
#endif
#ifndef REP_PHASE
#define REP_PHASE -1
#endif
#define NREP(k) ((REP_PHASE) == (k) ? 2 : 1)
#ifndef TIME_LO
#define TIME_LO -1
#endif
#ifndef TIME_HI
#define TIME_HI -1
#endif
#ifndef TIME_BLK
#define TIME_BLK 0
#endif
#define TMARK(j) do { if ((TIME_LO) >= 0 && blockIdx.x == (TIME_BLK) && F.tid == 0) { if ((j) == (TIME_LO)) t_lo_ = __builtin_amdgcn_s_memrealtime(); if ((j) == (TIME_HI)) t_hi_ = __builtin_amdgcn_s_memrealtime(); } } while (0)
constexpr int PER_PHASE = 13;
constexpr int N_LAUNCHES = MK_N_LAUNCHES;

constexpr int BATCH = 2, SEQ = 8192, D = 1024, M = BATCH * SEQ;
constexpr int SBW = 512, NH = 8, HD = 64;
constexpr int SSW = 512, NG = 32, GC = 16, NP = 64;
constexpr int NPROJ = 3 * SBW + SSW;
constexpr int LC = 32, NCHUNK = M / LC, CPB = SEQ / LC;
constexpr int UK = LC * GC + 2 * NP;
constexpr int NE = 32, TOPK = 4, FF = 1024, NASSIGN = M * TOPK;
constexpr int MAXTILES = (NASSIGN + NE * 255) / 256 + 1;
constexpr float EPS = 1e-5f;
constexpr float LOG2E = 1.4426950408889634f;

constexpr size_t MiB = 1u << 20;
constexpr size_t WS_CTL = 0, CTL_ZERO_BYTES = 1 * MiB;
constexpr size_t WS_LAML = 1 * MiB;
constexpr size_t WS_RSTD = 1 * MiB + 32 * 1024;
constexpr size_t WS_GATES = 1 * MiB + 128 * 1024;
constexpr size_t WS_ROWINFO = 1 * MiB + 512 * 1024;
constexpr size_t WS_LISTS = 347 * MiB + 110 * MiB;
constexpr size_t WS_WINT = 4 * MiB, WS_WGLUT = 8 * MiB, WS_WOUTT = 9 * MiB, WS_W1T = 11 * MiB, WS_W2T = 139 * MiB;
constexpr size_t WS_R1 = 203 * MiB, WS_R2 = 347 * MiB, WS_END = 491 * MiB;
constexpr size_t WS_HN = WS_R1, WS_Q = WS_R1 + 32 * MiB, WS_K = WS_R1 + 48 * MiB, WS_V = WS_R1 + 64 * MiB, WS_UCAT = WS_R1 + 80 * MiB,
                 WS_SLOC = WS_R1 + 100 * MiB, WS_YSB = WS_R1 + 108 * MiB, WS_YG = WS_R1 + 124 * MiB;
constexpr size_t WS_XS = WS_R1, WS_YBUF = WS_R1;
constexpr size_t WS_YSSM = WS_R2, WS_MIXED = WS_R2 + 16 * MiB, WS_XN = WS_R2 + 48 * MiB, WS_WE = WS_R2 + 80 * MiB, WS_TW = WS_R2 + 85 * MiB;
constexpr size_t WS_H = WS_R2;
static_assert(WS_K == WS_Q + (size_t)M * SBW * 2 && WS_V == WS_K + (size_t)M * SBW * 2 && WS_YG + (size_t)M * SSW * 2 <= WS_R2 && WS_TW + (size_t)NG * 512 * UK * 2 <= WS_END, "ws map");
static_assert(WS_XS + (size_t)MAXTILES * 256 * D * 2 <= WS_R2 + 2 * MiB && WS_H + (size_t)(MAXTILES - 1) * 256 * FF * 2 <= WS_END, "ws map 2");
static_assert(WS_ROWINFO + (size_t)MAXTILES * 256 * 16 <= 4 * MiB && WS_LISTS >= WS_R2 + 106 * MiB && WS_LISTS + (size_t)NE * M * 4 <= WS_END, "ws map 3");
constexpr int CW_TMO = 0, CW_CODE = 1;
constexpr int CW_BAR = 4096;
constexpr int CW_CNT = 16384;
constexpr int CW_Q0 = 16384 + 256;

constexpr int RING_OFF = 0, RING_BYTES = 131072;
constexpr int RT_WSTR = 1028;
constexpr int RT_W_BYTES = 2 * NE * RT_WSTR * 2;
constexpr int RT_SCR_OFF = RT_W_BYTES;
constexpr int LDSCTL_OFF = 139264, MISC_OFF = LDSCTL_OFF + 320;
constexpr int TAB_OFF = LDSCTL_OFF + 512;
constexpr int UNITS_OFF = LDSCTL_OFF + 1024;
constexpr int TILEE_OFF = LDSCTL_OFF + 1536;
constexpr int LDS_BYTES = LDSCTL_OFF + 4096;
static_assert(TILEE_OFF + MAXTILES * 4 <= LDS_BYTES && RT_SCR_OFF + 4096 <= LDSCTL_OFF, "LDS map");

#define GAS __attribute__((address_space(1)))
#define LAS __attribute__((address_space(3)))
typedef unsigned short bf16;
typedef unsigned v4u __attribute__((ext_vector_type(4)));
typedef unsigned v2u __attribute__((ext_vector_type(2)));
typedef float f32x4 __attribute__((ext_vector_type(4)));
typedef float f32x2 __attribute__((ext_vector_type(2)));
typedef _Float16 h16x2 __attribute__((ext_vector_type(2)));
typedef GAS unsigned gu32;
#define RLX_AGENT __ATOMIC_RELAXED, __HIP_MEMORY_SCOPE_AGENT
#define LDS_WAIT() asm volatile("s_waitcnt lgkmcnt(0)" ::: "memory")
#define VM_WAIT() asm volatile("s_waitcnt vmcnt(0)" ::: "memory")
__device__ __forceinline__ unsigned f2bf(float f) { unsigned u = __builtin_bit_cast(unsigned, f); return (u + 0x7fffu + ((u >> 16) & 1u)) >> 16; }
__device__ __forceinline__ unsigned pk2(float lo, float hi) { return f2bf(lo) | (f2bf(hi) << 16); }
__device__ __forceinline__ float bf2f(unsigned short b) { return __builtin_bit_cast(float, (unsigned)b << 16); }
__device__ __forceinline__ float bflo(unsigned w) { return __builtin_bit_cast(float, w << 16); }
__device__ __forceinline__ float bfhi(unsigned w) { return __builtin_bit_cast(float, w & 0xffff0000u); }
__device__ __forceinline__ unsigned pkh2(float lo, float hi) { h16x2 v; v.x = (_Float16)lo; v.y = (_Float16)hi; return __builtin_bit_cast(unsigned, v); }
__device__ __forceinline__ float fexp2(float x) { return __builtin_amdgcn_exp2f(x); }
__device__ __forceinline__ float flog2(float x) { return __builtin_amdgcn_logf(x); }
__device__ __forceinline__ float frcp(float x) { return __builtin_amdgcn_rcpf(x); }
__device__ __forceinline__ float sigmoidf_(float x) { return frcp(1.0f + fexp2(-LOG2E * x)); }
__device__ __forceinline__ float gelu_tanh(float v) { const float u = 0.7978845608028654f * (v + 0.044715f * v * v * v); return v * frcp(1.0f + fexp2(-2.0f * LOG2E * u)); }

#define XB_TMO      128
#define XB_XCNT(j)  (256  + 64 * (j))
#define XB_XSUB(j)  (1280 + 64 * (j))
#define XB_XGEN(j)  (2304 + 64 * (j))
#define XB_TOP      3328
#define XB_TOPGEN   3392
#define XCD_BAR_WORDS 3456
#define XB_SPIN_CAP (1u << 18)
__device__ __forceinline__ unsigned xb_ld(unsigned* p)              { return __hip_atomic_load(p, __ATOMIC_RELAXED, __HIP_MEMORY_SCOPE_AGENT); }
__device__ __forceinline__ unsigned xb_add(unsigned* p, unsigned v) { return __hip_atomic_fetch_add(p, v, __ATOMIC_RELAXED, __HIP_MEMORY_SCOPE_AGENT); }
__device__ __forceinline__ unsigned xb_xcc_id() { return (unsigned)__builtin_amdgcn_s_getreg((3 << 11) | 20) & 0xFu; }
#define XB_SPIN(cond, bar) do { unsigned _sp = 0; while (cond) { __builtin_amdgcn_s_sleep(1); \
    if ((++_sp & 255u) == 0u) { if (xb_ld(&(bar)[XB_TMO])) break; if (_sp > XB_SPIN_CAP) { atomicAdd(&(bar)[XB_TMO], 1u); break; } } } } while (0)
struct XcdBarrier { unsigned* bar; unsigned x; volatile LAS unsigned* st; };
__device__ __forceinline__ XcdBarrier xcd_barrier_post(unsigned* bar, volatile LAS unsigned* st) {
    XcdBarrier b; b.bar = bar; b.x = xb_xcc_id(); b.st = st;
    if (threadIdx.x == 0) (void)xb_add(&bar[XB_XCNT(b.x)], 1u);
    return b;
}
__device__ __forceinline__ void xcd_barrier_complete(unsigned* bar, unsigned x, unsigned& nloc, unsigned& nx) {
    const unsigned G = gridDim.x * gridDim.y * gridDim.z;
    unsigned sum, cnt, mine, sp = 0u;
    for (;;) {
        sum = 0u; cnt = 0u; mine = 0u;
#pragma unroll
        for (unsigned j = 0; j < 16; ++j) { const unsigned c = xb_ld(&bar[XB_XCNT(j)]); sum += c; cnt += (c > 0u) ? 1u : 0u; mine = (j == x) ? c : mine; }
        if (sum == G) break;
        __builtin_amdgcn_s_sleep(1);
        if ((++sp & 255u) == 0u) { if (xb_ld(&bar[XB_TMO])) break; if (sp > XB_SPIN_CAP) { atomicAdd(&bar[XB_TMO], 1u); break; } }
    }
    nloc = mine > 0u ? mine : 1u; nx = cnt > 0u ? cnt : 1u;
}
__device__ __forceinline__ void xcd_barrier(const XcdBarrier& b) {
    asm volatile("s_waitcnt vmcnt(0)" ::: "memory");
    __syncthreads();
    if (threadIdx.x == 0) {
        unsigned* bar = b.bar;
        __builtin_amdgcn_s_waitcnt(0);
        unsigned nloc = b.st[0], nx = b.st[1];
        if (nloc == 0u) { xcd_barrier_complete(bar, b.x, nloc, nx); b.st[0] = nloc; b.st[1] = nx; }
        const unsigned old = xb_add(&bar[XB_XSUB(b.x)], 1u);
        const unsigned gen = old / nloc;
        if (old + 1u == (gen + 1u) * nloc) {
            __builtin_amdgcn_fence(__ATOMIC_RELEASE, "agent");
            asm volatile("s_waitcnt vmcnt(0)" ::: "memory");
            const unsigned og = xb_add(&bar[XB_TOP], 1u);
            const unsigned tg = og / nx;
            if (og + 1u == (tg + 1u) * nx) xb_add(&bar[XB_TOPGEN], 1u);
            else XB_SPIN(xb_ld(&bar[XB_TOPGEN]) == tg, bar);
            __builtin_amdgcn_fence(__ATOMIC_ACQUIRE, "agent");
            xb_add(&bar[XB_XGEN(b.x)], 1u);
            asm volatile("s_waitcnt vmcnt(0)" ::: "memory");
        } else {
            XB_SPIN(xb_ld(&bar[XB_XGEN(b.x)]) == gen, bar);
            __builtin_amdgcn_fence(__ATOMIC_ACQUIRE, "agent");
            asm volatile("s_waitcnt vmcnt(0)" ::: "memory");
        }
    }
    __syncthreads();
}

struct Frame {
    LAS unsigned char* lds;
    volatile LAS unsigned* MISC;
    gu32* ctl;
    int tid, lane, wave;
    int vcu, G;
    unsigned char* ws;
    const float* in[25];
    float* out;
};

__device__ __forceinline__ float wave_sum(float v) {
#pragma unroll
    for (int o = 1; o < 64; o <<= 1) v += __shfl_xor(v, o);
    return v;
}

using pg8::Unit;
typedef pg8::f32x4 accv;
struct EpiInProj {
    static constexpr bool PERM = true, AFTER_DRAIN = false;
    unsigned short* QKV; bf16* U; float qscale;
    __device__ __forceinline__ void operator()(const accv (&acc)[2][2][4][2], const Unit& u, int wr, int wc, int fr, int fq) const {
        if (u.e == 1) {
            const int row0 = u.pm * 256 + wr * 64 + fr; const int colt = u.pn * 256 + wc * 32 + 8 * fq;
            _Float16* VT = (_Float16*)(QKV + (size_t)2 * M * SBW);
#pragma unroll
            for (int ai = 0; ai < 2; ++ai)
#pragma unroll
                for (int m = 0; m < 4; ++m) { const int row = row0 + ai * 128 + m * 16;
#pragma unroll
                    for (int bj = 0; bj < 2; ++bj) { const int tok = colt + bj * 128; const accv v0 = acc[ai][bj][m][0], v1 = acc[ai][bj][m][1];
                        const int bb = tok >> 13, sq = tok & (SEQ - 1); const int o = sq & 15;
                        _Float16* p = VT + ((size_t)bb * SBW + row) * SEQ + (sq & ~15) + (o >> 1);
                        v2u w0, w1; w0.x = pkh2(v0[0], v0[1]); w0.y = pkh2(v0[2], v0[3]); w1.x = pkh2(v1[0], v1[1]); w1.y = pkh2(v1[2], v1[3]);
                        *(v2u*)p = w0; *(v2u*)(p + 8) = w1; } }
            return;
        }
        const int kind = u.pn >> 1; const int colt = (u.pn & 1) * 256 + wc * 32 + 8 * fq; const int row0 = u.pm * 256 + wr * 64 + fr;
        unsigned short* T = QKV + (size_t)(kind < 2 ? kind : 0) * ((size_t)M * SBW); const float sc = kind == 0 ? qscale : 1.0f;
#pragma unroll
        for (int ai = 0; ai < 2; ++ai)
#pragma unroll
            for (int m = 0; m < 4; ++m) { const int row = row0 + ai * 128 + m * 16;
#pragma unroll
                for (int bj = 0; bj < 2; ++bj) { const int col = colt + bj * 128; const accv v0 = acc[ai][bj][m][0] * sc, v1 = acc[ai][bj][m][1] * sc; v4u w;
                    if (kind < 2) { w.x = pkh2(v0[0], v0[1]); w.y = pkh2(v0[2], v0[3]); w.z = pkh2(v1[0], v1[1]); w.w = pkh2(v1[2], v1[3]);
                        *(v4u*)(T + (size_t)row * SBW + col) = w; }
                    else { w.x = pg8::cvt_pk_bf16(v0[0], v0[1]); w.y = pg8::cvt_pk_bf16(v0[2], v0[3]); w.z = pg8::cvt_pk_bf16(v1[0], v1[1]); w.w = pg8::cvt_pk_bf16(v1[2], v1[3]);
                        *(v4u*)(U + ((size_t)(row >> 5) * NG + (col >> 4)) * UK + (row & 31) * GC + (col & 15)) = w; } } }
    }
};
struct EpiSloc {
    static constexpr bool PERM = false, AFTER_DRAIN = false;
    float* S;
    __device__ __forceinline__ void operator()(const accv (&acc)[2][2][4][2], const Unit& u, int wr, int wc, int fr, int fq) const {
        const int row0 = u.pm * 256 + wr * 64 + fr; const int col0 = wc * 32 + 4 * fq;
#pragma unroll
        for (int ai = 0; ai < 2; ++ai)
#pragma unroll
            for (int m = 0; m < 4; ++m) { const int row = row0 + ai * 128 + m * 16;
#pragma unroll
                for (int n = 0; n < 2; ++n) *(accv*)(S + ((size_t)row * NG + u.e) * 128 + col0 + 16 * n) = acc[ai][0][m][n]; }
    }
};
struct EpiS3 {
    static constexpr bool PERM = true, AFTER_DRAIN = false;
    bf16* YG;
    __device__ __forceinline__ void operator()(const accv (&acc)[2][2][4][2], const Unit& u, int wr, int wc, int fr, int fq) const {
        const int row0 = u.pm * 256 + wr * 64 + fr; const int colt = u.pn * 256 + wc * 32 + 8 * fq;
#pragma unroll
        for (int ai = 0; ai < 2; ++ai)
#pragma unroll
            for (int m = 0; m < 4; ++m) { const int row = row0 + ai * 128 + m * 16;
#pragma unroll
                for (int bj = 0; bj < 2; ++bj) { const int col = colt + bj * 128; const accv v0 = acc[ai][bj][m][0], v1 = acc[ai][bj][m][1]; v4u w;
                    w.x = pg8::cvt_pk_bf16(gelu_tanh(v0[0]), gelu_tanh(v0[1])); w.y = pg8::cvt_pk_bf16(gelu_tanh(v0[2]), gelu_tanh(v0[3]));
                    w.z = pg8::cvt_pk_bf16(gelu_tanh(v1[0]), gelu_tanh(v1[1])); w.w = pg8::cvt_pk_bf16(gelu_tanh(v1[2]), gelu_tanh(v1[3]));
                    *(v4u*)(YG + ((size_t)row * LC + (col >> 4)) * SSW + u.e * GC + (col & 15)) = w; } }
    }
};
struct EpiGlu {
    static constexpr bool PERM = true, AFTER_DRAIN = false;
    bf16* Y;
    __device__ __forceinline__ void operator()(const accv (&acc)[2][2][4][2], const Unit& u, int wr, int wc, int fr, int fq) const {
        const int row0 = u.pm * 256 + wr * 64 + fr; const int col = u.pn * 128 + wc * 32 + 8 * fq;
#pragma unroll
        for (int ai = 0; ai < 2; ++ai)
#pragma unroll
            for (int m = 0; m < 4; ++m) { const int row = row0 + ai * 128 + m * 16; float r[8];
#pragma unroll
                for (int n = 0; n < 2; ++n)
#pragma unroll
                    for (int j = 0; j < 4; ++j) r[4 * n + j] = acc[ai][0][m][n][j] * sigmoidf_(acc[ai][1][m][n][j]);
                v4u w; w.x = pg8::cvt_pk_bf16(r[0], r[1]); w.y = pg8::cvt_pk_bf16(r[2], r[3]); w.z = pg8::cvt_pk_bf16(r[4], r[5]); w.w = pg8::cvt_pk_bf16(r[6], r[7]);
                *(v4u*)(Y + (size_t)row * SSW + col) = w; }
    }
};
struct EpiOutProj {
    static constexpr bool PERM = false, AFTER_DRAIN = false;
    const float* X; float* O;
    __device__ __forceinline__ void operator()(const accv (&acc)[2][2][4][2], const Unit& u, int wr, int wc, int fr, int fq) const {
        const int row0 = u.pm * 256 + wr * 64 + fr; const int col0 = u.pn * 256 + wc * 32 + 4 * fq;
#pragma unroll
        for (int ai = 0; ai < 2; ++ai)
#pragma unroll
            for (int m = 0; m < 4; ++m) { const size_t off = (size_t)(row0 + ai * 128 + m * 16) * D + col0;
#pragma unroll
                for (int bj = 0; bj < 2; ++bj)
#pragma unroll
                    for (int n = 0; n < 2; ++n) { const accv xv = *(const accv*)(X + off + bj * 128 + n * 16); *(accv*)(O + off + bj * 128 + n * 16) = xv + acc[ai][bj][m][n]; }
                if (m & 1) asm volatile("" ::: "memory"); }
    }
};
struct EpiMoe1 {
    static constexpr bool PERM = true, AFTER_DRAIN = false;
    bf16* H; const float* bg; const float* bu; const int* rowinfo;
    __device__ __forceinline__ void operator()(const accv (&acc)[2][2][4][2], const Unit& u, int wr, int wc, int fr, int fq) const {
        const int row0 = u.pm * 256 + wr * 64 + fr; const int col = u.pn * 128 + wc * 32 + 8 * fq;
        float bgv[8], buv[8];
#pragma unroll
        for (int n = 0; n < 2; ++n) { const accv a = *(const accv*)(bg + u.e * FF + col + 4 * n), b = *(const accv*)(bu + u.e * FF + col + 4 * n);
#pragma unroll
            for (int j = 0; j < 4; ++j) { bgv[4 * n + j] = a[j]; buv[4 * n + j] = b[j]; } }
#pragma unroll
        for (int ai = 0; ai < 2; ++ai)
#pragma unroll
            for (int m = 0; m < 4; ++m) { const int row = row0 + ai * 128 + m * 16; float r[8]; const float rs = __builtin_bit_cast(float, rowinfo[4 * row + 2]);
#pragma unroll
                for (int n = 0; n < 2; ++n)
#pragma unroll
                    for (int j = 0; j < 4; ++j) { const float g = fminf(acc[ai][0][m][n][j] * rs + bgv[4 * n + j], 7.0f); const float up = fminf(fmaxf(acc[ai][1][m][n][j] * rs + buv[4 * n + j], -7.0f), 7.0f);
                        r[4 * n + j] = (up + 1.0f) * g * frcp(1.0f + fexp2(-1.702f * LOG2E * g)); }
                v4u w; w.x = pg8::cvt_pk_bf16(r[0], r[1]); w.y = pg8::cvt_pk_bf16(r[2], r[3]); w.z = pg8::cvt_pk_bf16(r[4], r[5]); w.w = pg8::cvt_pk_bf16(r[6], r[7]);
                *(v4u*)(H + (size_t)row * FF + col) = w; }
    }
};
struct EpiMoe2 {
    static constexpr bool PERM = true, AFTER_DRAIN = false;
    bf16* Y; const float* bd; const int* rowinfo;
    __device__ __forceinline__ void operator()(const accv (&acc)[2][2][4][2], const Unit& u, int wr, int wc, int fr, int fq) const {
        const int row0 = u.pm * 256 + wr * 64 + fr; const int colt = u.pn * 256 + wc * 32 + 8 * fq;
        float bv[2][8];
#pragma unroll
        for (int bj = 0; bj < 2; ++bj)
#pragma unroll
            for (int n = 0; n < 2; ++n) { const accv a = *(const accv*)(bd + u.e * D + colt + bj * 128 + 4 * n);
#pragma unroll
                for (int j = 0; j < 4; ++j) bv[bj][4 * n + j] = a[j]; }
#pragma unroll
        for (int ai = 0; ai < 2; ++ai)
#pragma unroll
            for (int m = 0; m < 4; ++m) { const int row = row0 + ai * 128 + m * 16; const int slot = rowinfo[4 * row]; const float gate = __builtin_bit_cast(float, rowinfo[4 * row + 1]);
                if (slot >= 0) {
#pragma unroll
                    for (int bj = 0; bj < 2; ++bj) { float r[8];
#pragma unroll
                        for (int n = 0; n < 2; ++n)
#pragma unroll
                            for (int j = 0; j < 4; ++j) r[4 * n + j] = (acc[ai][bj][m][n][j] + bv[bj][4 * n + j]) * gate;
                        v4u w; w.x = pg8::cvt_pk_bf16(r[0], r[1]); w.y = pg8::cvt_pk_bf16(r[2], r[3]); w.z = pg8::cvt_pk_bf16(r[4], r[5]); w.w = pg8::cvt_pk_bf16(r[6], r[7]);
                        *(v4u*)(Y + (size_t)slot * D + colt + bj * 128) = w; } } }
    }
};

struct InProjOrder {
    int G, c;
    __device__ bool next(int i, Unit& u) const {
        const int L = i * G + c; if (L >= 512) return false;
        const int s = pg8::xcd_remap(L, 512);
        if (s < 384) { const int grp = s / 48, r = s % 48; u.pm = grp * 8 + (r & 7); const int pi = r >> 3; u.pn = pi < 4 ? pi : pi + 2; u.e = 0;
            u.offA = (long)u.pm * 256 * D * 2; u.offB = (long)u.pn * 256 * D * 2; }
        else { const int r = s - 384; u.pm = r & 1; u.pn = r >> 1; u.e = 1;
            u.offA = (long)(WS_WINT - WS_HN) + (long)(1024 + u.pm * 256) * D * 2; u.offB = (long)(WS_HN - WS_WINT) + (long)u.pn * 256 * D * 2; }
        return true;
    }
    __device__ __forceinline__ void a_ready(const Unit&) const {}
    __device__ __forceinline__ void done(const Unit&) const {}
};
struct SsmOrder {
    int nwg, G, c, npn, rows_per_g, ldb;
    __device__ bool next(int i, Unit& u) const {
        const int L = i * G + c; if (L >= nwg) return false;
        const int per_g = 2 * npn; const int g = L / per_g, r = L % per_g;
        u.e = g; u.pm = r / npn; u.pn = r % npn;
        u.offA = ((long)u.pm * 256 * NG * UK + (long)g * UK) * 2; u.offB = ((long)g * rows_per_g + (long)u.pn * 256) * ldb * 2; return true;
    }
    __device__ __forceinline__ void a_ready(const Unit&) const {}
    __device__ __forceinline__ void done(const Unit&) const {}
};
struct MoeOrder {
    const LAS int* units; long ebytes;
    __device__ bool next(int i, Unit& u) const {
        if (i >= 32) return false;
        const int v = __builtin_amdgcn_readfirstlane(units[4 * i + 3]); if (!v) return false;
        u.pm = __builtin_amdgcn_readfirstlane(units[4 * i + 0]); u.pn = __builtin_amdgcn_readfirstlane(units[4 * i + 1]); u.e = __builtin_amdgcn_readfirstlane(units[4 * i + 2]);
        u.offA = (long)u.pm * 256 * D * 2; u.offB = (long)u.e * ebytes + (long)u.pn * 256 * 16; return true;
    }
    __device__ __forceinline__ void a_ready(const Unit&) const {}
    __device__ __forceinline__ void done(const Unit&) const {}
};

struct CvItem { const float* src; bf16* dst; int ldw, K, rmul, radd, k0, n0; };
constexpr int CV_I_IN = (D / 64) * (NPROJ / 32), CV_I_GLU = (SSW / 64) * (SSW / 32), CV_I_OUT = (D / 64) * (D / 32), CV_I_E = (D / 64) * (FF / 32);
constexpr int CV_N_EARLY = CV_I_IN + 2 * CV_I_GLU + CV_I_OUT, CV_N_EXP = 3 * NE * (D / 8);
__device__ __forceinline__ void cv_set(CvItem& c, const float* W, int ldw, int K, int N, bf16* WT, int rmul, int radd, int item) {
    const int nblk = N / 32, kb = item / nblk, nb = item % nblk; c.src = W; c.dst = WT; c.ldw = ldw; c.K = K; c.rmul = rmul; c.radd = radd; c.k0 = 64 * kb; c.n0 = 32 * nb;
}
__device__ __forceinline__ void cv_decode_early(Frame& F, int r, CvItem& c) {
    bf16* WinT = (bf16*)(F.ws + WS_WINT); bf16* WgluT = (bf16*)(F.ws + WS_WGLUT); bf16* WoutT = (bf16*)(F.ws + WS_WOUTT);
    if (r < CV_I_IN) { cv_set(c, F.in[2], NPROJ, D, NPROJ, WinT, 1, 0, r); return; } r -= CV_I_IN;
    if (r < CV_I_GLU) { cv_set(c, F.in[11], 2 * SSW, SSW, SSW, WgluT, 2, 0, r); return; } r -= CV_I_GLU;
    if (r < CV_I_GLU) { cv_set(c, F.in[11] + SSW, 2 * SSW, SSW, SSW, WgluT, 2, 128, r); return; } r -= CV_I_GLU;
    cv_set(c, F.in[14], D, D, D, WoutT, 1, 0, r);
}
__device__ __forceinline__ void cv_decode_exp(Frame& F, int r, CvItem& c) {
    bf16* W1T = (bf16*)(F.ws + WS_W1T); bf16* W2T = (bf16*)(F.ws + WS_W2T);
    const int mat = r / CV_I_E, sub = r % CV_I_E, kind = mat / NE, e = mat % NE;
    if (kind == 0) cv_set(c, F.in[18] + (size_t)e * D * FF, FF, D, FF, W1T + (size_t)e * 2 * FF * D, 2, 0, sub);
    else if (kind == 1) cv_set(c, F.in[20] + (size_t)e * D * FF, FF, D, FF, W1T + (size_t)e * 2 * FF * D, 2, 128, sub);
    else cv_set(c, F.in[22] + (size_t)e * FF * D, D, FF, D, W2T + (size_t)e * D * FF, 1, 0, sub);
}
__device__ __forceinline__ void cv_load(const CvItem& c, int lane, float (&v)[32]) {
    const float* p = c.src + (size_t)(c.k0 + (lane >> 5)) * c.ldw + c.n0 + (lane & 31);
#pragma unroll
    for (int i = 0; i < 32; ++i) v[i] = p[(size_t)(2 * i) * c.ldw];
}
__device__ __forceinline__ void cv_store(const CvItem& c, int lane, const float (&v)[32], LAS float* scr) {
#pragma unroll
    for (int i = 0; i < 32; ++i) scr[(2 * i + (lane >> 5)) * 33 + (lane & 31)] = v[i];
    LDS_WAIT(); asm volatile("" ::: "memory");
    const int cc = lane & 7;
#pragma unroll
    for (int j = 0; j < 4; ++j) { const int nl = (lane >> 3) + 8 * j; const int n = c.n0 + nl; const int drow = (n >> 7) * 128 * c.rmul + c.radd + (n & 127); const LAS float* s = scr + (8 * cc) * 33 + nl;
        v4u o; o.x = pg8::cvt_pk_bf16(s[0 * 33], s[1 * 33]); o.y = pg8::cvt_pk_bf16(s[2 * 33], s[3 * 33]); o.z = pg8::cvt_pk_bf16(s[4 * 33], s[5 * 33]); o.w = pg8::cvt_pk_bf16(s[6 * 33], s[7 * 33]);
        *(GAS v4u*)(c.dst + (size_t)drow * c.K + c.k0 + 8 * cc) = o; }
    LDS_WAIT(); asm volatile("" ::: "memory");
}
__device__ __forceinline__ void cv_item_early(Frame& F, int it, LAS float* scr) { CvItem c; float v[32]; cv_decode_early(F, it, c); cv_load(c, F.lane, v); cv_store(c, F.lane, v, scr); }
__device__ __forceinline__ void cv_run_early(Frame& F, int first, int stride, int n, LAS float* scr) {
    CvItem ca, cb; float va[32], vb[32];
    int it = first; if (it >= n) return;
    cv_decode_early(F, it, ca);
    cv_load(ca, F.lane, va);
    for (;;) {
        const int nit = it + stride; const bool more = nit < n;
        if (more) { cv_decode_early(F, nit, cb); cv_load(cb, F.lane, vb); }
        cv_store(ca, F.lane, va, scr);
        if (!more) break;
        ca = cb;
#pragma unroll
        for (int i = 0; i < 32; ++i) va[i] = vb[i];
        it = nit;
    }
}
__device__ __forceinline__ void xv_item(Frame& F, int it) {
    bf16* W1T = (bf16*)(F.ws + WS_W1T); bf16* W2T = (bf16*)(F.ws + WS_W2T);
    const float* w0 = F.in[18]; const float* w1 = F.in[20]; const float* w2 = F.in[22];
    asm volatile("" : "+s"(w0), "+s"(w1), "+s"(w2));
    const int lane = F.lane;
    {
        const int mat = it >> 7, kb = it & 127, kind = mat / NE, e = mat % NE;
        const float* src = (kind == 0 ? w0 : (kind == 1 ? w1 : w2)) + (size_t)e * D * FF + (size_t)(kb * 8) * FF + 4 * lane;
        f32x4 v[8][4];
#pragma unroll
        for (int rr = 0; rr < 8; ++rr)
#pragma unroll
            for (int j = 0; j < 4; ++j) v[rr][j] = *(const GAS f32x4*)(src + (size_t)rr * FF + 256 * j);
        bf16* dst; int cstride;
        if (kind < 2) { dst = W1T + (size_t)e * 2 * FF * D + ((size_t)kb * 2 * FF + (size_t)(lane >> 5) * 256 + (kind == 1 ? 128 : 0) + 4 * (lane & 31)) * 8; cstride = 512 * 8; }
        else { dst = W2T + (size_t)e * D * FF + ((size_t)kb * D + 4 * lane) * 8; cstride = 256 * 8; }
#pragma unroll
        for (int j = 0; j < 4; ++j)
#pragma unroll
            for (int c = 0; c < 4; ++c) { v4u o; o.x = pg8::cvt_pk_bf16(v[0][j][c], v[1][j][c]); o.y = pg8::cvt_pk_bf16(v[2][j][c], v[3][j][c]); o.z = pg8::cvt_pk_bf16(v[4][j][c], v[5][j][c]); o.w = pg8::cvt_pk_bf16(v[6][j][c], v[7][j][c]);
                *(GAS v4u*)(dst + (size_t)j * cstride + c * 8) = o; }
    }
}
__device__ __forceinline__ void rms_row_to_bf16(int lane, const float* xrow, const float* g, bf16* orow) {
    const GAS f32x4* xr = (const GAS f32x4*)xrow + lane; const GAS f32x4* gr = (const GAS f32x4*)g + lane;
    f32x4 v[4]; float s = 0.f;
#pragma unroll
    for (int j = 0; j < 4; ++j) { v[j] = xr[64 * j]; s += (v[j].x * v[j].x + v[j].y * v[j].y) + (v[j].z * v[j].z + v[j].w * v[j].w); }
    const float rstd = 1.0f / sqrtf(wave_sum(s) * (1.f / D) + EPS);
    GAS unsigned long long* o8 = (GAS unsigned long long*)orow + lane;
#pragma unroll
    for (int j = 0; j < 4; ++j) { const f32x4 gg = gr[64 * j]; o8[64 * j] = (unsigned long long)pk2(v[j].x * rstd * gg.x, v[j].y * rstd * gg.y) | ((unsigned long long)pk2(v[j].z * rstd * gg.z, v[j].w * rstd * gg.w) << 32); }
}
__device__ __forceinline__ void sincos_acc(float th, float& s, float& c) {
    const float k = rintf(th * 0.15915494309189535f);
    float r = fmaf(-k, 6.28125f, th); r = fmaf(-k, 1.9353071795864769e-3f, r);
    const float x = 0.25f * r, x2 = x * x;
    float sn = x * (1.0f + x2 * (-1.0f / 6 + x2 * (1.0f / 120 + x2 * (-1.0f / 5040 + x2 * (1.0f / 362880 + x2 * (-1.0f / 39916800))))));
    float cs = 1.0f + x2 * (-0.5f + x2 * (1.0f / 24 + x2 * (-1.0f / 720 + x2 * (1.0f / 40320 + x2 * (-1.0f / 3628800 + x2 * (1.0f / 479001600))))));
#pragma unroll
    for (int i = 0; i < 2; ++i) { const float s2 = 2.0f * sn * cs, c2 = 1.0f - 2.0f * sn * sn; sn = s2; cs = c2; }
    s = sn; c = cs;
}
__device__ __forceinline__ void ssm_tables(Frame& F, int g) {
    constexpr int PS = 65, BS = 17, CS = 65, KT = 273, KC = 17;
    LAS float* pwr = (LAS float*)(F.lds);
    LAS float* pwi = pwr + 33 * PS;
    LAS float* bbr = pwi + 33 * PS;
    LAS float* bbi = bbr + 64 * BS;
    LAS float* ccr = bbi + 64 * BS;
    LAS float* cci = ccr + 16 * CS;
    LAS float* km = cci + 16 * CS;
    const float* lam_re = F.in[3]; const float* lam_im = F.in[4]; const float* log_dt = F.in[5];
    const float* b_re = F.in[6]; const float* b_im = F.in[7]; const float* c_re = F.in[8]; const float* c_im = F.in[9]; const float* dsk = F.in[10];
    float* lamL = (float*)(F.ws + WS_LAML); bf16* WE = (bf16*)(F.ws + WS_WE); bf16* TW = (bf16*)(F.ws + WS_TW);
    const int tid = F.tid;
    if (tid < 64) { const int p = tid;
        const float lr = lam_re[g * NP + p], li = lam_im[g * NP + p], dt = expf(log_dt[g]);
        const float er = expf(lr * dt); float sn, cs; sincos_acc(li * dt, sn, cs);
        const float br = er * cs, bi = er * sn;
        const float nr = br - 1.0f, ni = bi, den = 1.0f / (lr * lr + li * li);
        const float fr = (nr * lr + ni * li) * den, fi = (ni * lr - nr * li) * den;
        float pr = 1.0f, pi = 0.0f;
        for (int n = 0; n <= 32; ++n) { pwr[n * PS + p] = pr; pwi[n * PS + p] = pi; const float t = pr * br - pi * bi; pi = pr * bi + pi * br; pr = t; }
        lamL[(g * 2 + 0) * NP + p] = pwr[32 * PS + p]; lamL[(g * 2 + 1) * NP + p] = pwi[32 * PS + p];
        float xr[GC], xi[GC];
#pragma unroll
        for (int c = 0; c < GC; ++c) { xr[c] = b_re[(g * NP + p) * GC + c]; xi[c] = b_im[(g * NP + p) * GC + c]; }
#pragma unroll
        for (int c = 0; c < GC; ++c) { bbr[p * BS + c] = fr * xr[c] - fi * xi[c]; bbi[p * BS + c] = fr * xi[c] + fi * xr[c]; }
    }
    for (int i = tid; i < 1024; i += NWAVES * 64) { ccr[(i >> 6) * CS + (i & 63)] = c_re[g * 1024 + i]; cci[(i >> 6) * CS + (i & 63)] = c_im[g * 1024 + i]; }
    __syncthreads();
    {
        const int pair = tid & 255, co = pair >> 4, ci = pair & 15, t0 = (tid >> 8) * 16;
        float acc[16];
#pragma unroll
        for (int t = 0; t < 16; ++t) acc[t] = 0.f;
        for (int p = 0; p < NP; ++p) { const float cr = ccr[co * CS + p], cim = cci[co * CS + p], xr = bbr[p * BS + ci], xi = bbi[p * BS + ci];
            const float gr = cr * xr - cim * xi, gi = cr * xi + cim * xr;
#pragma unroll
            for (int t = 0; t < 16; ++t) acc[t] += gr * pwr[(t0 + t) * PS + p] - gi * pwi[(t0 + t) * PS + p]; }
#pragma unroll
        for (int t = 0; t < 16; ++t) km[(t0 + t) * KT + co * KC + ci] = acc[t];
    }
    __syncthreads();
    {
        const int n = tid, i = n >> 4, co = n & 15; const float dv = dsk[g * GC + co];
        bf16* dst = TW + ((size_t)g * 512 + n) * UK;
        for (int j = 0; j < LC; ++j) {
            float v[16];
#pragma unroll
            for (int ci = 0; ci < 16; ++ci) { float val = (j <= i) ? km[(j <= i ? i - j : 0) * KT + co * KC + ci] : 0.f; if (j == i && ci == co) val += dv; v[ci] = val; }
            v4u o0, o1; o0.x = pg8::cvt_pk_bf16(v[0], v[1]); o0.y = pg8::cvt_pk_bf16(v[2], v[3]); o0.z = pg8::cvt_pk_bf16(v[4], v[5]); o0.w = pg8::cvt_pk_bf16(v[6], v[7]);
            o1.x = pg8::cvt_pk_bf16(v[8], v[9]); o1.y = pg8::cvt_pk_bf16(v[10], v[11]); o1.z = pg8::cvt_pk_bf16(v[12], v[13]); o1.w = pg8::cvt_pk_bf16(v[14], v[15]);
            *(GAS v4u*)(dst + j * 16) = o0; *(GAS v4u*)(dst + j * 16 + 8) = o1; }
        for (int k8 = 0; k8 < 16; ++k8) { float v[8];
#pragma unroll
            for (int e = 0; e < 8; ++e) { const int k = k8 * 8 + e, ri = k >> 6, p = k & 63; const float cr = ccr[co * CS + p], cim = cci[co * CS + p], pr = pwr[(i + 1) * PS + p], pi = pwi[(i + 1) * PS + p];
                v[e] = ri == 0 ? (cr * pr - cim * pi) : -(cr * pi + cim * pr); }
            v4u o; o.x = pg8::cvt_pk_bf16(v[0], v[1]); o.y = pg8::cvt_pk_bf16(v[2], v[3]); o.z = pg8::cvt_pk_bf16(v[4], v[5]); o.w = pg8::cvt_pk_bf16(v[6], v[7]);
            *(GAS v4u*)(dst + 512 + k8 * 8) = o; }
    }
    {
        const int row = tid & 127, ri = row >> 6, p = row & 63, kq = tid >> 7;
        bf16* dst = WE + ((size_t)g * 128 + row) * 512 + kq * 128;
        for (int k8 = 0; k8 < 16; ++k8) { float v[8];
#pragma unroll
            for (int e = 0; e < 8; ++e) { const int k = kq * 128 + k8 * 8 + e, j = k >> 4, c = k & 15; const float pr = pwr[(31 - j) * PS + p], pi = pwi[(31 - j) * PS + p], xr = bbr[p * BS + c], xi = bbi[p * BS + c];
                v[e] = ri == 0 ? (pr * xr - pi * xi) : (pr * xi + pi * xr); }
            v4u o; o.x = pg8::cvt_pk_bf16(v[0], v[1]); o.y = pg8::cvt_pk_bf16(v[2], v[3]); o.z = pg8::cvt_pk_bf16(v[4], v[5]); o.w = pg8::cvt_pk_bf16(v[6], v[7]);
            *(GAS v4u*)(dst + k8 * 8) = o; }
    }
    __syncthreads();
}
__device__ __forceinline__ void rms_rows2_to_bf16(int lane, const float* x0, const float* x1, const float* g, bf16* o0, bf16* o1) {
    const GAS f32x4* xa = (const GAS f32x4*)x0 + lane; const GAS f32x4* xb = (const GAS f32x4*)x1 + lane; const GAS f32x4* gr = (const GAS f32x4*)g + lane;
    f32x4 va[4], vb[4]; float sa = 0.f, sb = 0.f;
#pragma unroll
    for (int j = 0; j < 4; ++j) { va[j] = xa[64 * j]; vb[j] = xb[64 * j]; }
#pragma unroll
    for (int j = 0; j < 4; ++j) { sa += (va[j].x * va[j].x + va[j].y * va[j].y) + (va[j].z * va[j].z + va[j].w * va[j].w); sb += (vb[j].x * vb[j].x + vb[j].y * vb[j].y) + (vb[j].z * vb[j].z + vb[j].w * vb[j].w); }
#pragma unroll
    for (int o = 1; o < 64; o <<= 1) { sa += __shfl_xor(sa, o); sb += __shfl_xor(sb, o); }
    const float ra = 1.0f / sqrtf(sa * (1.f / D) + EPS), rb = 1.0f / sqrtf(sb * (1.f / D) + EPS);
    GAS v2u* pa = (GAS v2u*)o0 + lane; GAS v2u* pb = (GAS v2u*)o1 + lane;
#pragma unroll
    for (int j = 0; j < 4; ++j) { const f32x4 gg = gr[64 * j];
        v2u wa, wb; wa.x = pg8::cvt_pk_bf16(va[j].x * ra * gg.x, va[j].y * ra * gg.y); wa.y = pg8::cvt_pk_bf16(va[j].z * ra * gg.z, va[j].w * ra * gg.w);
        wb.x = pg8::cvt_pk_bf16(vb[j].x * rb * gg.x, vb[j].y * rb * gg.y); wb.y = pg8::cvt_pk_bf16(vb[j].z * rb * gg.z, vb[j].w * rb * gg.w);
        pa[64 * j] = wa; pb[64 * j] = wb; }
}
constexpr int Q0_EXP = CV_N_EXP, Q0_HN = Q0_EXP + M / 8, Q0_END = Q0_HN + CV_N_EARLY / 4;
static_assert(Q0_END % 8 == 0 && CV_N_EARLY % 4 == 0, "P0 queue");
__device__ __forceinline__ void p0_prologue(Frame& F, unsigned long long& t_lo_, unsigned long long& t_hi_) {
    TMARK(100);
    const bool tabler = (F.vcu & 7) == 0 && (F.vcu >> 3) < NG;
    if (tabler) { ssm_tables(F, F.vcu >> 3);
        if ((F.vcu >> 3) == 0 && F.tid < 128) {
            bf16* WE = (bf16*)(F.ws + WS_WE) + (size_t)NG * 128 * 512;
            for (int i = 0; i < 512 / 8; ++i) *(GAS v4u*)(WE + (size_t)F.tid * 512 + i * 8) = (v4u){0u, 0u, 0u, 0u}; } }
    TMARK(101);
    LAS float* scr = (LAS float*)(F.lds + RING_OFF + F.wave * 16384);
    unsigned* q = (unsigned*)(F.ctl + CW_Q0); volatile LAS unsigned* slot = F.MISC + 16;
    bf16* HN = (bf16*)(F.ws + WS_HN);
    for (;;) {
        __syncthreads();
        if (F.tid == 0) *slot = __hip_atomic_fetch_add(q, 8u, RLX_AGENT);
        __syncthreads();
        const int base = (int)__builtin_amdgcn_readfirstlane(*slot); if (base >= Q0_END) break;
        const int idx = base + F.wave;
        if (idx < Q0_EXP) xv_item(F, idx);
        else if (idx < Q0_HN) { const int m0 = (idx - Q0_EXP) * 8;
#pragma unroll 1
            for (int j = 0; j < 4; ++j) { const int m = m0 + 2 * j; rms_rows2_to_bf16(F.lane, F.in[0] + (size_t)m * D, F.in[0] + (size_t)(m + 1) * D, F.in[1], HN + (size_t)m * D, HN + (size_t)(m + 1) * D); } }
        else { const int g4 = (idx - Q0_HN) * 4;
#pragma unroll 1
            for (int j = 0; j < 4; ++j) cv_item_early(F, g4 + j, scr); }
    }
    TMARK(104);
}

__device__ __forceinline__ void attn_simple_unit(const unsigned short* Qh, const unsigned short* Kh, const unsigned short* Vh, bf16* Y, int b, int h, int qb, int lane) {
    const int t = qb * 64 + lane; const size_t row = (size_t)b * SEQ + t;
    float q[64], o[64];
    { const v4u* qp = (const v4u*)(Qh + row * SBW + h * HD);
#pragma unroll
      for (int i = 0; i < 8; ++i) { const v4u w = qp[i];
#pragma unroll
          for (int j = 0; j < 4; ++j) { const unsigned wj = w[j]; const h16x2 hv = __builtin_bit_cast(h16x2, wj); q[8 * i + 2 * j] = (float)hv.x; q[8 * i + 2 * j + 1] = (float)hv.y; } } }
#pragma unroll
    for (int d = 0; d < 64; ++d) o[d] = 0.f;
    float cum = 0.f;
    for (int s = qb * 64 + 62; s >= 0; --s) {
        const size_t krow = ((size_t)b * SEQ + s) * SBW + h * HD;
        const v4u* kp = (const v4u*)(Kh + krow); const v4u* vp = (const v4u*)(Vh + krow);
        float z = 0.f;
#pragma unroll
        for (int i = 0; i < 8; ++i) { const v4u w = kp[i];
#pragma unroll
            for (int j = 0; j < 4; ++j) { const unsigned wj = w[j]; const h16x2 hv = __builtin_bit_cast(h16x2, wj); z = fmaf(q[8 * i + 2 * j], (float)hv.x, z); z = fmaf(q[8 * i + 2 * j + 1], (float)hv.y, z); } }
        const bool act = s < t;
        const float t1 = flog2(1.0f + fexp2(-fabsf(z)));
        const float L = act ? -(fmaxf(z, 0.f) + t1) : 0.f;
        const float ls = fminf(z, 0.f) - t1;
        const float p = act ? fexp2(ls + cum) : 0.f;
        cum += L;
#pragma unroll
        for (int i = 0; i < 8; ++i) { const v4u w = vp[i];
#pragma unroll
            for (int j = 0; j < 4; ++j) { const unsigned wj = w[j]; const h16x2 hv = __builtin_bit_cast(h16x2, wj); o[8 * i + 2 * j] = fmaf(p, (float)hv.x, o[8 * i + 2 * j]); o[8 * i + 2 * j + 1] = fmaf(p, (float)hv.y, o[8 * i + 2 * j + 1]); } }
        if (__all(cum < -150.0f)) break;
    }
    bf16* yp = Y + row * SBW + h * HD;
#pragma unroll
    for (int i = 0; i < 8; ++i) { v4u w; w.x = pk2(o[8 * i], o[8 * i + 1]); w.y = pk2(o[8 * i + 2], o[8 * i + 3]); w.z = pk2(o[8 * i + 4], o[8 * i + 5]); w.w = pk2(o[8 * i + 6], o[8 * i + 7]); *(v4u*)(yp + 8 * i) = w; }
}
typedef _Float16 h8v __attribute__((ext_vector_type(8)));
typedef float f16v __attribute__((ext_vector_type(16)));
__device__ __forceinline__ void attn_mfma_unit(const _Float16* Qh, const _Float16* Kh, const _Float16* VT, bf16* Y, int b, int hd, int qb, int lane, h8v tri0, h8v tri1) {
    const int r = lane & 31, hh = lane >> 5, q0 = qb * 32;
    const _Float16* qrow = Qh + ((size_t)b * SEQ + q0 + r) * SBW + hd * HD + 8 * hh;
    h8v qf[4];
#pragma unroll
    for (int kd = 0; kd < 4; ++kd) qf[kd] = *(const h8v*)(qrow + 16 * kd);
    f16v o0, o1;
#pragma unroll
    for (int i = 0; i < 16; ++i) { o0[i] = 0.f; o1[i] = 0.f; }
    float carry = 0.f;
    const _Float16* kbase = Kh + ((size_t)b * SEQ + r) * SBW + hd * HD + 8 * hh;
    const _Float16* vbase = VT + ((size_t)b * SBW + hd * HD + r) * SEQ + 8 * hh;
    for (int key0 = q0; key0 >= 0; key0 -= 32) {
        h8v kf[4], vf[2][2];
#pragma unroll
        for (int kd = 0; kd < 4; ++kd) kf[kd] = *(const h8v*)(kbase + (size_t)key0 * SBW + 16 * kd);
#pragma unroll
        for (int db = 0; db < 2; ++db)
#pragma unroll
            for (int ss = 0; ss < 2; ++ss) vf[db][ss] = *(const h8v*)(vbase + (size_t)(32 * db) * SEQ + key0 + 16 * ss);
        f16v z;
#pragma unroll
        for (int i = 0; i < 16; ++i) z[i] = 0.f;
#pragma unroll
        for (int kd = 0; kd < 4; ++kd) z = __builtin_amdgcn_mfma_f32_32x32x16_f16(kf[kd], qf[kd], z, 0, 0, 0);
        const bool diag = key0 == q0;
        h8v lh[2], ll[2];
#pragma unroll
        for (int i = 0; i < 16; ++i) { const int koff = (i & 3) + 8 * (i >> 2) + 4 * hh; const bool act = !diag || koff < r;
            const float zi = z[i]; const float t1 = flog2(1.0f + fexp2(-fabsf(zi)));
            const float L = act ? fmaxf(-(fmaxf(zi, 0.f) + t1), -60000.0f) : 0.f;
            const _Float16 hi = (_Float16)L; const _Float16 lo = (_Float16)(L - (float)hi);
            lh[i >> 3][i & 7] = hi; ll[i >> 3][i & 7] = lo; }
        f16v cum;
#pragma unroll
        for (int i = 0; i < 16; ++i) cum[i] = carry;
        cum = __builtin_amdgcn_mfma_f32_32x32x16_f16(tri0, lh[0], cum, 0, 0, 0);
        cum = __builtin_amdgcn_mfma_f32_32x32x16_f16(tri1, lh[1], cum, 0, 0, 0);
        cum = __builtin_amdgcn_mfma_f32_32x32x16_f16(tri0, ll[0], cum, 0, 0, 0);
        cum = __builtin_amdgcn_mfma_f32_32x32x16_f16(tri1, ll[1], cum, 0, 0, 0);
        h8v pf[2];
#pragma unroll
        for (int i = 0; i < 16; ++i) { const int koff = (i & 3) + 8 * (i >> 2) + 4 * hh; const bool act = !diag || koff < r;
            const float p = act ? fexp2(z[i] + cum[i]) : 0.f; pf[i >> 3][i & 7] = (_Float16)p; }
        o0 = __builtin_amdgcn_mfma_f32_32x32x16_f16(vf[0][0], pf[0], o0, 0, 0, 0);
        o0 = __builtin_amdgcn_mfma_f32_32x32x16_f16(vf[0][1], pf[1], o0, 0, 0, 0);
        o1 = __builtin_amdgcn_mfma_f32_32x32x16_f16(vf[1][0], pf[0], o1, 0, 0, 0);
        o1 = __builtin_amdgcn_mfma_f32_32x32x16_f16(vf[1][1], pf[1], o1, 0, 0, 0);
        carry = __shfl(cum[0], r);
        if (__all(carry < -150.0f)) break;
    }
    bf16* yp = Y + ((size_t)b * SEQ + q0 + r) * SBW + hd * HD + 4 * hh;
#pragma unroll
    for (int g4 = 0; g4 < 4; ++g4) { v2u w0, w1; w0.x = pk2(o0[4 * g4], o0[4 * g4 + 1]); w0.y = pk2(o0[4 * g4 + 2], o0[4 * g4 + 3]); w1.x = pk2(o1[4 * g4], o1[4 * g4 + 1]); w1.y = pk2(o1[4 * g4 + 2], o1[4 * g4 + 3]);
        *(v2u*)(yp + 8 * g4) = w0; *(v2u*)(yp + 32 + 8 * g4) = w1; }
}
__device__ __forceinline__ void attn_phase(Frame& F) {
    const _Float16* Qh = (const _Float16*)(F.ws + WS_Q); const _Float16* Kh = (const _Float16*)(F.ws + WS_K); const _Float16* VT = (const _Float16*)(F.ws + WS_V);
    bf16* Y = (bf16*)(F.ws + WS_YSB);
    constexpr int NQB = SEQ / 32, NUNITS = BATCH * NH * NQB;
    const int gw = F.vcu * NWAVES + F.wave, NGW = F.G * NWAVES, lane = F.lane, r = lane & 31, hh = lane >> 5;
    h8v tri0, tri1;
#pragma unroll
    for (int e = 0; e < 8; ++e) { const int k0 = 8 * (e >> 2) + 4 * hh + (e & 3); tri0[e] = (k0 >= r) ? (_Float16)1.0f : (_Float16)0.0f; tri1[e] = (16 + k0 >= r) ? (_Float16)1.0f : (_Float16)0.0f; }
    for (int u = gw; u < NUNITS; u += NGW) { const int qb = u % NQB, bh = u / NQB; attn_mfma_unit(Qh, Kh, VT, Y, bh / NH, bh % NH, qb, lane, tri0, tri1); }
}

__device__ __forceinline__ void scan_phase(Frame& F) {
    const int gw = F.vcu * NWAVES + F.wave;
    if (F.wave != 0) return;
    const int task = F.vcu; if (task >= BATCH * NG) return;
    const int b = task / NG, g = task % NG, p = F.lane; (void)gw;
    const float* lamL = (const float*)(F.ws + WS_LAML); const float* S = (const float*)(F.ws + WS_SLOC); bf16* U = (bf16*)(F.ws + WS_UCAT);
    const float lr = lamL[(g * 2 + 0) * NP + p], li = lamL[(g * 2 + 1) * NP + p];
    float xr = 0.f, xi = 0.f;
    for (int c0 = 0; c0 < CPB; c0 += 8) {
        float sr[8], si[8];
#pragma unroll
        for (int j = 0; j < 8; ++j) { const size_t base = ((size_t)(b * CPB + c0 + j) * NG + g) * 128; sr[j] = S[base + p]; si[j] = S[base + 64 + p]; }
#pragma unroll
        for (int j = 0; j < 8; ++j) { bf16* dst = U + ((size_t)(b * CPB + c0 + j) * NG + g) * UK + 512;
            dst[p] = (bf16)f2bf(xr); dst[64 + p] = (bf16)f2bf(xi);
            const float nr = lr * xr - li * xi + sr[j], ni = lr * xi + li * xr + si[j]; xr = nr; xi = ni; }
    }
}

__device__ __forceinline__ void mix_phase(Frame& F) {
    const bf16* YSB = (const bf16*)(F.ws + WS_YSB); const bf16* YSSM = (const bf16*)(F.ws + WS_YSSM); bf16* MX = (bf16*)(F.ws + WS_MIXED);
    const float* g_sb = F.in[12]; const float* g_ssm = F.in[13];
    const int gw = F.vcu * NWAVES + F.wave, NGW = F.G * NWAVES, lane = F.lane;
    f32x4 ga[2], gb[2];
#pragma unroll
    for (int j = 0; j < 2; ++j) { ga[j] = *(const f32x4*)(g_sb + 8 * lane + 4 * j); gb[j] = *(const f32x4*)(g_ssm + 8 * lane + 4 * j); }
    for (int m = gw; m < M; m += NGW) {
        const v4u a = *(const v4u*)(YSB + (size_t)m * SBW + 8 * lane), c = *(const v4u*)(YSSM + (size_t)m * SSW + 8 * lane);
        float av[8], cv[8]; float sa = 0.f, sc = 0.f;
#pragma unroll
        for (int j = 0; j < 4; ++j) { av[2 * j] = bflo(a[j]); av[2 * j + 1] = bfhi(a[j]); cv[2 * j] = bflo(c[j]); cv[2 * j + 1] = bfhi(c[j]); }
#pragma unroll
        for (int j = 0; j < 8; ++j) { sa += av[j] * av[j]; sc += cv[j] * cv[j]; }
        const float ra = 1.0f / sqrtf(wave_sum(sa) * (1.f / SBW) + EPS), rc = 1.0f / sqrtf(wave_sum(sc) * (1.f / SSW) + EPS);
        v4u oa, oc;
#pragma unroll
        for (int j = 0; j < 4; ++j) { oa[j] = pk2(av[2 * j] * ra * ga[j >> 1][(2 * j) & 3], av[2 * j + 1] * ra * ga[j >> 1][(2 * j + 1) & 3]);
                                      oc[j] = pk2(cv[2 * j] * rc * gb[j >> 1][(2 * j) & 3], cv[2 * j + 1] * rc * gb[j >> 1][(2 * j + 1) & 3]); }
        if (DBG_MODE == 3) oa = (v4u){0u, 0u, 0u, 0u};
        if (DBG_MODE == 2) oc = (v4u){0u, 0u, 0u, 0u};
        *(v4u*)(MX + (size_t)m * D + 8 * lane) = oa; *(v4u*)(MX + (size_t)m * D + SBW + 8 * lane) = oc;
    }
}

__device__ __forceinline__ void router_phase(Frame& F) {
    typedef short s8v __attribute__((ext_vector_type(8)));
    typedef float f16v __attribute__((ext_vector_type(16)));
    LAS bf16* wh = (LAS bf16*)F.lds; LAS bf16* wl = wh + NE * RT_WSTR;
    LAS int* lcnt = (LAS int*)(F.lds + RT_SCR_OFF); LAS int* lbase = lcnt + 32; LAS int* asg = lbase + 32;
    const float* wr = F.in[16]; const float* br = F.in[17]; const float* g2 = F.in[15];
    const float* X1 = F.out; bf16* XG = (bf16*)(F.ws + WS_XN); float* gates = (float*)(F.ws + WS_GATES); int* lists = (int*)(F.ws + WS_LISTS); float* RS = (float*)(F.ws + WS_RSTD);
    unsigned* gcnt = (unsigned*)(F.ctl + CW_CNT);
    const int tid = F.tid, lane = F.lane, r = lane & 31, hh = lane >> 5;
    for (int idx = tid; idx < D * NE; idx += NWAVES * 64) { const float w = wr[idx]; const unsigned h = f2bf(w); const unsigned l = f2bf(w - bf2f((unsigned short)h)); const int k = idx >> 5, e = idx & 31;
        wh[e * RT_WSTR + k] = (bf16)h; wl[e * RT_WSTR + k] = (bf16)l; }
    if (tid < 32) lcnt[tid] = 0;
    __syncthreads();
    const int task = F.wave >> 2, kq = F.wave & 3; const int tok = F.vcu * 64 + task * 32 + r;
    f16v acc;
#pragma unroll
    for (int i = 0; i < 16; ++i) acc[i] = 0.f;
    float ss = 0.f;
    const float* xp = X1 + (size_t)tok * D + kq * 256 + 8 * hh; const float* gp = g2 + kq * 256 + 8 * hh; bf16* xo = XG + (size_t)tok * D + kq * 256 + 8 * hh;
    const LAS bf16* whp = wh + r * RT_WSTR + kq * 256 + 8 * hh; const LAS bf16* wlp = wl + r * RT_WSTR + kq * 256 + 8 * hh;
#pragma unroll 4
    for (int ks = 0; ks < 16; ++ks) {
        const f32x4 x0 = *(const f32x4*)(xp + 16 * ks), x1 = *(const f32x4*)(xp + 16 * ks + 4), g0 = *(const f32x4*)(gp + 16 * ks), g1 = *(const f32x4*)(gp + 16 * ks + 4);
        ss += (x0.x * x0.x + x0.y * x0.y) + (x0.z * x0.z + x0.w * x0.w) + (x1.x * x1.x + x1.y * x1.y) + (x1.z * x1.z + x1.w * x1.w);
        const f32x4 a0 = x0 * g0, a1 = x1 * g1;
        v4u hv, lv;
        hv.x = pg8::cvt_pk_bf16(a0.x, a0.y); hv.y = pg8::cvt_pk_bf16(a0.z, a0.w); hv.z = pg8::cvt_pk_bf16(a1.x, a1.y); hv.w = pg8::cvt_pk_bf16(a1.z, a1.w);
        lv.x = pg8::cvt_pk_bf16(a0.x - bflo(hv.x), a0.y - bfhi(hv.x)); lv.y = pg8::cvt_pk_bf16(a0.z - bflo(hv.y), a0.w - bfhi(hv.y));
        lv.z = pg8::cvt_pk_bf16(a1.x - bflo(hv.z), a1.y - bfhi(hv.z)); lv.w = pg8::cvt_pk_bf16(a1.z - bflo(hv.w), a1.w - bfhi(hv.w));
        *(v4u*)(xo + 16 * ks) = hv;
        const s8v xh = __builtin_bit_cast(s8v, hv), xl = __builtin_bit_cast(s8v, lv);
        v4u ah, al; { const LAS v2u* p = (const LAS v2u*)(whp + 16 * ks); const v2u q0 = p[0], q1 = p[1]; ah.x = q0.x; ah.y = q0.y; ah.z = q1.x; ah.w = q1.y; }
        { const LAS v2u* p = (const LAS v2u*)(wlp + 16 * ks); const v2u q0 = p[0], q1 = p[1]; al.x = q0.x; al.y = q0.y; al.z = q1.x; al.w = q1.y; }
        const s8v wa = __builtin_bit_cast(s8v, ah), wb = __builtin_bit_cast(s8v, al);
        acc = __builtin_amdgcn_mfma_f32_32x32x16_bf16(wa, xh, acc, 0, 0, 0);
        acc = __builtin_amdgcn_mfma_f32_32x32x16_bf16(wb, xh, acc, 0, 0, 0);
        acc = __builtin_amdgcn_mfma_f32_32x32x16_bf16(wa, xl, acc, 0, 0, 0);
    }
    __syncthreads();
    LAS float* part = (LAS float*)F.lds;
#pragma unroll
    for (int i = 0; i < 16; ++i) part[(F.wave * 17 + i) * 64 + lane] = acc[i];
    part[(F.wave * 17 + 16) * 64 + lane] = ss;
    __syncthreads();
    if (kq == 0) {
        float v[32]; float st = 0.f;
#pragma unroll
        for (int w = 0; w < 4; ++w) { const LAS float* pw = part + (size_t)((task * 4 + w) * 17) * 64;
#pragma unroll
            for (int i = 0; i < 16; ++i) { const float t = pw[i * 64 + lane]; v[i] = w == 0 ? t : v[i] + t; }
            st += pw[16 * 64 + lane] + pw[16 * 64 + (lane ^ 32)]; }
        const float rstd = 1.0f / sqrtf(st * (1.f / D) + EPS);
        if (hh == 0) RS[tok] = rstd;
#pragma unroll
        for (int i = 0; i < 16; ++i) { const int e = (i & 3) + 8 * (i >> 2) + 4 * hh; v[i] = v[i] * rstd + br[e]; }
#pragma unroll
        for (int i = 0; i < 16; ++i) v[16 + i] = __shfl_xor(v[i], 32);
        float mx = v[0];
#pragma unroll
        for (int i = 1; i < 32; ++i) mx = fmaxf(mx, v[i]);
        int rk[16]; float es = 0.f;
#pragma unroll
        for (int i = 0; i < 16; ++i) { const int ei = (i & 3) + 8 * (i >> 2) + 4 * hh; int rank = 0;
#pragma unroll
            for (int j = 0; j < 32; ++j) { if (j == i) continue; const int ej = (j & 3) + 8 * ((j & 15) >> 2) + 4 * (j < 16 ? hh : 1 - hh);
                rank += (v[j] > v[i] || (v[j] == v[i] && ej < ei)) ? 1 : 0; }
            rk[i] = rank; if (rank < TOPK) es += fexp2((v[i] - mx) * LOG2E); }
        es += __shfl_xor(es, 32);
        const float inv = 1.0f / es;
#pragma unroll
        for (int i = 0; i < 16; ++i) if (rk[i] < TOPK) { const int ei = (i & 3) + 8 * (i >> 2) + 4 * hh;
            gates[tok * TOPK + rk[i]] = fexp2((v[i] - mx) * LOG2E) * inv;
            const int pos = __hip_atomic_fetch_add(lcnt + ei, 1, __ATOMIC_RELAXED, __HIP_MEMORY_SCOPE_WORKGROUP);
            asg[(task * 32 + r) * 4 + rk[i]] = ei | (pos << 8); }
    }
    __syncthreads();
    if (tid < 32) lbase[tid] = (int)__hip_atomic_fetch_add(gcnt + tid, (unsigned)lcnt[tid], RLX_AGENT);
    __syncthreads();
    if (tid < 64 * TOPK) { const int a = asg[tid], e = a & 255, pos = a >> 8; const int tk = F.vcu * 64 + (tid >> 2);
        lists[e * M + lbase[e] + pos] = tk * TOPK + (tid & 3); }
    __syncthreads();
}

__device__ __forceinline__ void moe_tables(Frame& F) {
    LAS int* tab = (LAS int*)(F.lds + TAB_OFF); LAS int* cnt = tab, * mt = tab + 32, * tbase = tab + 64;
    unsigned* gcnt = (unsigned*)(F.ctl + CW_CNT);
    if (F.tid < 32) { const int c = (int)__hip_atomic_load(gcnt + F.tid, RLX_AGENT); cnt[F.tid] = c; mt[F.tid] = (c + 255) >> 8; }
    __syncthreads();
    if (F.tid == 0) { int s = 0; for (int e = 0; e < NE; ++e) { tbase[e] = s; s += mt[e]; } tbase[NE] = s; }
    __syncthreads();
}
__device__ __forceinline__ void moe_units(Frame& F, int npn, int gpn) {
    LAS int* tab = (LAS int*)(F.lds + TAB_OFF); LAS int* mt = tab + 32, * tbase = tab + 64; LAS int* units = (LAS int*)(F.lds + UNITS_OFF);
    if (F.tid < 32) {
        const int nU = tbase[NE] * npn; const int L = F.tid * F.G + (int)blockIdx.x; int pm = 0, pn = 0, e = 0, valid = 0;
        if (L < nU) { const int seq = pg8::xcd_remap(L, nU); int ee = 0; while (ee < NE - 1 && seq >= tbase[ee + 1] * npn) ++ee;
            const int r = seq - tbase[ee] * npn, m = mt[ee]; const int grp = r / (m * gpn), r2 = r % (m * gpn);
            e = ee; pn = grp * gpn + r2 / m; pm = tbase[ee] + r2 % m; valid = 1; }
        units[4 * F.tid + 0] = pm; units[4 * F.tid + 1] = pn; units[4 * F.tid + 2] = e; units[4 * F.tid + 3] = valid;
    }
    __syncthreads();
}

__device__ __forceinline__ void gather_phase(Frame& F) {
    LAS int* tab = (LAS int*)(F.lds + TAB_OFF); LAS int* cnt = tab, * tbase = tab + 64; LAS int* tile_e = (LAS int*)(F.lds + TILEE_OFF);
    const int ntiles = tbase[NE];
    for (int t = F.tid; t < ntiles; t += NWAVES * 64) { int ee = 0; while (ee < NE - 1 && t >= tbase[ee + 1]) ++ee; tile_e[t] = ee; }
    __syncthreads();
    const bf16* XN = (const bf16*)(F.ws + WS_XN); bf16* XS = (bf16*)(F.ws + WS_XS); const float* gates = (const float*)(F.ws + WS_GATES); const int* lists = (const int*)(F.ws + WS_LISTS);
    int* rowinfo = (int*)(F.ws + WS_ROWINFO); const float* RS = (const float*)(F.ws + WS_RSTD);
    const int gw = F.vcu * NWAVES + F.wave, NGW = F.G * NWAVES, lane = F.lane;
    for (int r = gw; r < ntiles * 256; r += NGW) {
        const int e = tile_e[r >> 8], i = r - tbase[e] * 256;
        v4u a0 = (v4u){0u, 0u, 0u, 0u}, a1 = a0; int slot = -1; float gate = 0.f, rs = 0.f;
        if (i < cnt[e]) { slot = lists[e * M + i]; gate = gates[slot]; rs = RS[slot >> 2]; const v4u* src = (const v4u*)(XN + (size_t)(slot >> 2) * D); a0 = src[lane]; a1 = src[64 + lane]; }
        v4u* dst = (v4u*)(XS + (size_t)r * D); dst[lane] = a0; dst[64 + lane] = a1;
        if (lane == 0) { *(v4u*)(rowinfo + 4 * r) = (v4u){(unsigned)slot, __builtin_bit_cast(unsigned, gate), __builtin_bit_cast(unsigned, rs), 0u}; }
    }
}

__device__ __forceinline__ void final_phase(Frame& F) {
    const bf16* YB = (const bf16*)(F.ws + WS_YBUF); const float* gf = F.in[24]; float* O = F.out;
    const int gw = F.vcu * NWAVES + F.wave, NGW = F.G * NWAVES, lane = F.lane;
    f32x4 gg[4];
#pragma unroll
    for (int j = 0; j < 4; ++j) gg[j] = *(const f32x4*)(gf + 4 * lane + 256 * j);
    for (int m = gw; m < M; m += NGW) {
        f32x4 v[4]; float ss = 0.f;
#pragma unroll
        for (int j = 0; j < 4; ++j) { v[j] = *(const f32x4*)(O + (size_t)m * D + 4 * lane + 256 * j);
#pragma unroll
            for (int k = 0; k < (DBG_MODE ? 0 : TOPK); ++k) { const v2u w = *(const v2u*)(YB + ((size_t)m * TOPK + k) * D + 4 * lane + 256 * j); v[j].x += bflo(w.x); v[j].y += bfhi(w.x); v[j].z += bflo(w.y); v[j].w += bfhi(w.y); }
            ss += (v[j].x * v[j].x + v[j].y * v[j].y) + (v[j].z * v[j].z + v[j].w * v[j].w); }
        const float rstd = 1.0f / sqrtf(wave_sum(ss) * (1.f / D) + EPS);
#pragma unroll
        for (int j = 0; j < 4; ++j) *(f32x4*)(O + (size_t)m * D + 4 * lane + 256 * j) = v[j] * rstd * gg[j];
    }
}

struct Args { const float* in[25]; float* out; unsigned char* ws; int ph_lo, ph_hi, li, pad; };
__global__ void __launch_bounds__(NWAVES * 64, 2) hyb_fwd(Args args) {
    extern __shared__ __attribute__((aligned(16))) unsigned char lds[];
    Frame F;
    F.lds = (LAS unsigned char*)lds;
    F.MISC = (volatile LAS unsigned*)(F.lds + MISC_OFF);
    F.tid = threadIdx.x; F.lane = F.tid & 63; F.wave = __builtin_amdgcn_readfirstlane(F.tid >> 6);
    F.G = gridDim.x; { const int bx = blockIdx.x; F.vcu = (F.G % 8 == 0) ? (bx % 8) * (F.G / 8) + bx / 8 : bx; }
    F.ws = args.ws; F.ctl = (gu32*)(args.ws + WS_CTL); F.out = args.out;
#pragma unroll
    for (int i = 0; i < 25; ++i) F.in[i] = args.in[i];
    for (int u = F.tid; u < (LDS_BYTES - LDSCTL_OFF) / 4; u += NWAVES * 64) ((LAS unsigned*)(F.lds + LDSCTL_OFF))[u] = 0u;
    __syncthreads();
    XcdBarrier bar; bar.bar = (unsigned*)(F.ctl + CW_BAR); bar.x = 0; bar.st = nullptr;
    if (N_LAUNCHES != PER_PHASE) bar = xcd_barrier_post((unsigned*)(F.ctl + CW_BAR), F.MISC + 8);
#define GRID_BAR(seam) do { if (N_LAUNCHES == PER_PHASE) { if (F.tid == 0) __hip_atomic_store(F.ctl + CW_TMO, 0xBADBA0u | (unsigned)(seam), RLX_AGENT); } else { xcd_barrier(bar); } } while (0)
    const int lo = args.ph_lo, hi = args.ph_hi;
#define IN(k) (lo <= (k) && (k) < hi)
#define BOTH(k) (IN(k) && IN((k) + 1))
    const pg8::bf16_t* wsb = (const pg8::bf16_t*)args.ws;
#define WSB(off) ((const pg8::bf16_t*)(args.ws + (off)))

    unsigned long long t_lo_ = 0, t_hi_ = 0;
    TMARK(0);
    if (IN(0)) for (int rep_ = 0; rep_ < NREP(0); ++rep_) { p0_prologue(F, t_lo_, t_hi_); if (BOTH(0)) GRID_BAR(0); }

    TMARK(1);
    if (IN(1)) for (int rep_ = 0; rep_ < NREP(1); ++rep_) {
        pg8::Gemm g = pg8::make_gemm(WSB(WS_HN), WSB(WS_WINT), D, D, D); InProjOrder S{F.G, (int)blockIdx.x};
        EpiInProj E{(unsigned short*)(args.ws + WS_Q), (bf16*)(args.ws + WS_UCAT), LOG2E * 0.125f};
        pg8::gemm_phase<EpiInProj, InProjOrder, PG8_ALIGN, PG8_SP2>(F.lds + RING_OFF, g, S, E);
        if (BOTH(1)) GRID_BAR(1);
    }
    TMARK(2);
    if (IN(2)) for (int rep_ = 0; rep_ < NREP(2); ++rep_) {
        pg8::Gemm g = pg8::make_gemm(WSB(WS_UCAT), WSB(WS_WE), NG * UK, 512, 512); SsmOrder S{NG * 2, F.G, (int)blockIdx.x, 1, 128, 512};
        EpiSloc E{(float*)(args.ws + WS_SLOC)};
        pg8::gemm_phase<EpiSloc, SsmOrder, PG8_ALIGN, PG8_SP2>(F.lds + RING_OFF, g, S, E);
        attn_phase(F);
        if (BOTH(2)) GRID_BAR(2);
    }
    TMARK(3);
    if (IN(3)) for (int rep_ = 0; rep_ < NREP(3); ++rep_) { scan_phase(F); if (BOTH(3)) GRID_BAR(3); }
    TMARK(4);
    if (IN(4)) for (int rep_ = 0; rep_ < NREP(4); ++rep_) {
        pg8::Gemm g = pg8::make_gemm(WSB(WS_UCAT), WSB(WS_TW), NG * UK, UK, UK); SsmOrder S{NG * 4, F.G, (int)blockIdx.x, 2, 512, UK};
        EpiS3 E{(bf16*)(args.ws + WS_YG)};
        pg8::gemm_phase<EpiS3, SsmOrder, PG8_ALIGN, PG8_SP2>(F.lds + RING_OFF, g, S, E);
        if (BOTH(4)) GRID_BAR(4);
    }
    TMARK(5);
    if (IN(5)) for (int rep_ = 0; rep_ < NREP(5); ++rep_) {
        pg8::Gemm g = pg8::make_gemm(WSB(WS_YG), WSB(WS_WGLUT), SSW, SSW, SSW); pg8::StaticOrder S; S.init(M, 2 * SSW, F.G, (int)blockIdx.x, SSW, SSW);
        EpiGlu E{(bf16*)(args.ws + WS_YSSM)};
        pg8::gemm_phase<EpiGlu, pg8::StaticOrder, PG8_ALIGN, PG8_SP2>(F.lds + RING_OFF, g, S, E);
        if (BOTH(5)) GRID_BAR(5);
    }
    TMARK(6);
    if (IN(6)) for (int rep_ = 0; rep_ < NREP(6); ++rep_) { mix_phase(F); if (BOTH(6)) GRID_BAR(6); }
    TMARK(7);
    if (IN(7)) for (int rep_ = 0; rep_ < NREP(7); ++rep_) {
        pg8::Gemm g = pg8::make_gemm(WSB(WS_MIXED), WSB(WS_WOUTT), D, D, D); pg8::StaticOrder S; S.init(M, D, F.G, (int)blockIdx.x, D, D);
        EpiOutProj E{F.in[0], F.out};
        pg8::gemm_phase<EpiOutProj, pg8::StaticOrder, PG8_ALIGN, PG8_SP2>(F.lds + RING_OFF, g, S, E);
        if (BOTH(7)) GRID_BAR(7);
    }
    TMARK(8);
    if (IN(8) && !DBG_MODE) for (int rep_ = 0; rep_ < NREP(8); ++rep_) { router_phase(F); if (BOTH(8)) GRID_BAR(8); }
    TMARK(9);
    if (IN(9) && !DBG_MODE) for (int rep_ = 0; rep_ < NREP(9); ++rep_) { moe_tables(F); gather_phase(F); if (BOTH(9)) GRID_BAR(9); }
    TMARK(10);
    if (IN(10) && !DBG_MODE) for (int rep_ = 0; rep_ < NREP(10); ++rep_) {
        moe_tables(F); moe_units(F, 8, 4);
        pg8::Gemm g = pg8::make_gemm(WSB(WS_XS), WSB(WS_W1T), D, D, D); g.brs = 16u; g.bks = 2u * FF * 16u; MoeOrder S{(const LAS int*)(F.lds + UNITS_OFF), (long)2 * FF * D * 2};
        EpiMoe1 E{(bf16*)(args.ws + WS_H), F.in[19], F.in[21], (const int*)(args.ws + WS_ROWINFO)};
        pg8::gemm_phase<EpiMoe1, MoeOrder, PG8_ALIGN, PG8_SP2>(F.lds + RING_OFF, g, S, E);
        if (BOTH(10)) GRID_BAR(10);
    }
    TMARK(11);
    if (IN(11) && !DBG_MODE) for (int rep_ = 0; rep_ < NREP(11); ++rep_) {
        moe_tables(F); moe_units(F, 4, 4);
        pg8::Gemm g = pg8::make_gemm(WSB(WS_H), WSB(WS_W2T), FF, FF, FF); g.brs = 16u; g.bks = (unsigned)D * 16u; MoeOrder S{(const LAS int*)(F.lds + UNITS_OFF), (long)D * FF * 2};
        EpiMoe2 E{(bf16*)(args.ws + WS_YBUF), F.in[23], (const int*)(args.ws + WS_ROWINFO)};
        pg8::gemm_phase<EpiMoe2, MoeOrder, PG8_ALIGN, PG8_SP2>(F.lds + RING_OFF, g, S, E);
        if (BOTH(11)) GRID_BAR(11);
    }
    TMARK(12);
    if (IN(12)) for (int rep_ = 0; rep_ < NREP(12); ++rep_) { final_phase(F); }
    TMARK(13);
    if ((TIME_LO) >= 0 && blockIdx.x == (TIME_BLK) && F.tid == 0) { const unsigned long long te = __builtin_amdgcn_s_memrealtime(), dt = 4ull * (t_hi_ - t_lo_); while (__builtin_amdgcn_s_memrealtime() - te < dt) __builtin_amdgcn_s_sleep(32); }
    (void)wsb;
#undef IN
#undef BOTH
}

extern "C" void kernel_launch(void* const* d_in, const int* in_sizes, int n_in, void* d_out, int out_size, void* d_ws, size_t ws_size, hipStream_t stream) {
    static int grid = 0;
    if (grid == 0) {
        if (n_in != 25 || in_sizes[0] != M * D || out_size != M * D || ws_size < WS_END) { fprintf(stderr, "kernel_launch: unexpected shapes: n_in %d in0 %d out %d ws %zu (need %zu); nothing launched\n", n_in, n_in > 0 ? in_sizes[0] : -1, out_size, ws_size, (size_t)WS_END); grid = -1; return; }
        int dev = 0, cus = 0, per_cu = 0;
        if (hipGetDevice(&dev) != hipSuccess || hipDeviceGetAttribute(&cus, hipDeviceAttributeMultiprocessorCount, dev) != hipSuccess) { grid = -1; return; }
        if (hipFuncSetAttribute((const void*)hyb_fwd, hipFuncAttributeMaxDynamicSharedMemorySize, LDS_BYTES) != hipSuccess) { fprintf(stderr, "kernel_launch: hipFuncSetAttribute failed\n"); grid = -1; return; }
        if (hipOccupancyMaxActiveBlocksPerMultiprocessor(&per_cu, (const void*)hyb_fwd, NWAVES * 64, LDS_BYTES) != hipSuccess || per_cu < 1)
            fprintf(stderr, "kernel_launch: note: occupancy query reports %d workgroups per CU\n", per_cu);
        (void)hipGetLastError();
        grid = cus;
        if (grid != 256) fprintf(stderr, "kernel_launch: note: %d CUs (built for 256)\n", grid);
    }
    if (grid < 0) return;
    if (hipMemsetAsync((char*)d_ws + WS_CTL, 0, CTL_ZERO_BYTES, stream) != hipSuccess) { fprintf(stderr, "kernel_launch: memset failed\n"); return; }
    Args a{};
    for (int i = 0; i < 25; ++i) a.in[i] = (const float*)d_in[i];
    a.out = (float*)d_out; a.ws = (unsigned char*)d_ws;
    for (int li = 0; li < N_LAUNCHES; ++li) {
        a.ph_lo = (N_LAUNCHES == PER_PHASE) ? li : 0; a.ph_hi = (N_LAUNCHES == PER_PHASE) ? li + 1 : PER_PHASE; a.li = li;
        hipLaunchKernelGGL(hyb_fwd, dim3(grid), dim3(NWAVES * 64), LDS_BYTES, stream, a);
        const hipError_t le = hipPeekAtLastError();
        if (le != hipSuccess) { fprintf(stderr, "kernel_launch: launch %d failed: %s\n", li, hipGetErrorName(le)); break; }
    }
}
```

```cpp
#include <hip/hip_runtime.h>
#include <cstdio>
#include <cstdint>
namespace pg8 {
#define PG8_LAS __attribute__((address_space(3)))
typedef unsigned short bf16_t;
typedef short bf16x8 __attribute__((ext_vector_type(8)));
typedef float f32x4 __attribute__((ext_vector_type(4)));
typedef unsigned u32x4 __attribute__((ext_vector_type(4)));
constexpr int BM = 256, BK = 64, HALF = 128, HTB = HALF * BK * 2  , STAGE_BYTES = 8 * HTB, NXCD = 8, WGM = 8;

__host__ __device__ __forceinline__ int lds_byte(int r, int c) { const int st = (r >> 4) * 2 + (c >> 5), rr = r & 15, cc = c & 31, ob = rr * 64 + cc * 2; return st * 1024 + (ob ^ (((ob >> 9) & 1) << 5)); }
__host__ __device__ __forceinline__ void stage_rc(int b, int& R, int& C) { const int st = b / 1024, sb = b % 1024, swz = sb ^ (((sb >> 9) & 1) << 5); R = (st >> 1) * 16 + swz / 64; C = (st & 1) * 32 + (swz % 64) / 2; }
__host__ __device__ __forceinline__ int perm32(int rho) { const int n = rho >> 4, i = rho & 15; return 8 * (i >> 2) + 4 * n + (i & 3); }

struct Unit { int pm, pn, e; long offA, offB; };
struct Gemm { const bf16_t* A; const bf16_t* Bt; int lda, K; unsigned brs, bks; };
__host__ __device__ __forceinline__ Gemm make_gemm(const bf16_t* A, const bf16_t* Bt, int lda, int ldb, int K) { Gemm g; g.A = A; g.Bt = Bt; g.lda = lda; g.K = K; g.brs = (unsigned)ldb * 2u; g.bks = 16u; return g; }

__host__ __device__ __forceinline__ int xcd_remap(int wgid, int nwg) { const int q = nwg / NXCD, r = nwg % NXCD, xcd = wgid % NXCD, off = wgid / NXCD; return (xcd < r ? xcd * (q + 1) : r * (q + 1) + (xcd - r) * q) + off; }

struct StaticOrder {
    int nM, nN, nwg, G, c, lda, ldb;
    __host__ __device__ void init(int M, int N, int G_, int c_, int lda_, int ldb_) { nM = M / BM; nN = N / BM; nwg = nM * nN; G = G_; c = c_; lda = lda_; ldb = ldb_; }
    __host__ __device__ bool next(int i, Unit& u) const {
        const long L = (long)i * G + c; if (L >= nwg) return false;
        const int wgid = xcd_remap((int)L, nwg);
        const int nig = WGM * nN, gid = wgid / nig, fm = gid * WGM, gsz = (nM - fm) < WGM ? (nM - fm) : WGM;
        u.pm = fm + ((wgid % nig) % gsz); u.pn = (wgid % nig) / gsz; u.e = 0;
        u.offA = (long)u.pm * BM * lda * 2; u.offB = (long)u.pn * BM * ldb * 2; return true;
    }
    __device__ __forceinline__ void a_ready(const Unit&) const {}
    __device__ __forceinline__ void done(const Unit&) const {}
};

__device__ __forceinline__ unsigned cvt_pk_bf16(float lo, float hi) { unsigned r; asm volatile("v_cvt_pk_bf16_f32 %0, %1, %2" : "=v"(r) : "v"(lo), "v"(hi)); return r; }
typedef float f32x2 __attribute__((ext_vector_type(2)));

template <class Epi, class Sched, bool ALIGN_EPI = false, bool SP2 = false>
__device__ __forceinline__ void gemm_phase(PG8_LAS unsigned char* lds, const Gemm g, const Sched& S, const Epi& E) {
    const int tid = threadIdx.x, wid = __builtin_amdgcn_readfirstlane(tid >> 6), lane = tid & 63, wr = wid >> 2, wc = wid & 3, fr = lane & 15, fq = lane >> 4;
    const int K = g.K, nt = K / BK;
    unsigned voffA[2], voffB[2];
#pragma unroll
    for (int i = 0; i < 2; ++i) { int R, C; stage_rc(tid * 16 + i * 8192, R, C); const int Rb = Epi::PERM ? ((R & ~31) + perm32(R & 31)) : R;
        voffA[i] = (unsigned)(R * g.lda + C) * 2u; voffB[i] = (unsigned)Rb * g.brs + (unsigned)(C >> 3) * g.bks; }
    const size_t kstepA = (size_t)(BK * 2), kstepB = (size_t)8 * g.bks;
    const size_t hstepA = (size_t)HALF * g.lda * 2, hstepB = (size_t)HALF * g.brs;
    const unsigned ldsw = (unsigned)wid * 1024u;
    const int aoff = lds_byte(wr * 64 + fr, fq * 8), boff = lds_byte(wc * 32 + fr, fq * 8);
#define PG8_SA(b, h) (((b) * 2 + (h)) * HTB)
#define PG8_SB(b, h) ((4 + (b) * 2 + (h)) * HTB)
#define PG8_STAGE(bufoff, gbase, voff) do { _Pragma("unroll") for (int _i = 0; _i < 2; ++_i) \
        __builtin_amdgcn_global_load_lds((const unsigned*)((const char*)(gbase) + (voff)[_i]), (PG8_LAS unsigned*)(lds + (bufoff) + ldsw + _i * 8192), 16, 0, 0); } while (0)
#define PG8_LDA(dst, b, h) do { _Pragma("unroll") for (int m = 0; m < 4; ++m) _Pragma("unroll") for (int k = 0; k < 2; ++k) dst[m][k] = *(const PG8_LAS bf16x8*)(lds + PG8_SA(b, h) + aoff + m * 2048 + k * 1024); } while (0)
#define PG8_LDB(dst, b, h) do { _Pragma("unroll") for (int n = 0; n < 2; ++n) _Pragma("unroll") for (int k = 0; k < 2; ++k) dst[n][k] = *(const PG8_LAS bf16x8*)(lds + PG8_SB(b, h) + boff + n * 2048 + k * 1024); } while (0)
#define PG8_MMA(ai, bj, At, Bt) do { __builtin_amdgcn_s_setprio(1); _Pragma("unroll") for (int m = 0; m < 4; ++m) _Pragma("unroll") for (int n = 0; n < 2; ++n) _Pragma("unroll") for (int k = 0; k < 2; ++k) \
        acc[ai][bj][m][n] = __builtin_amdgcn_mfma_f32_16x16x32_bf16(Bt[n][k], At[m][k], acc[ai][bj][m][n], 0, 0, 0); __builtin_amdgcn_s_setprio(0); } while (0)
#define PG8_WAIT_V(n) asm volatile("s_waitcnt vmcnt(" #n ")" ::: "memory")
#define PG8_WAIT_L(n) asm volatile("s_waitcnt lgkmcnt(" #n ")" ::: "memory")
#define PG8_BAR __builtin_amdgcn_s_barrier()
#define PG8_SCHED __builtin_amdgcn_sched_barrier(0)
    Unit cur, nxt; int ui = 0;
    if (!S.next(0, cur)) return;
    f32x4 acc[2][2][4][2];
#pragma unroll
    for (int a = 0; a < 2; ++a)
#pragma unroll
        for (int b = 0; b < 2; ++b)
#pragma unroll
            for (int m = 0; m < 4; ++m)
#pragma unroll
                for (int n = 0; n < 2; ++n) acc[a][b][m][n] = (f32x4){0.f, 0.f, 0.f, 0.f};
    bf16x8 At[4][2], B0[2][2], B1[2][2];
    const char* cA = (const char*)g.A + cur.offA; const char* cB = (const char*)g.Bt + cur.offB;
    S.a_ready(cur);
    if constexpr (SP2) {
        PG8_STAGE(PG8_SB(0, 0), cB, voffB); PG8_STAGE(PG8_SB(0, 1), cB + hstepB, voffB); PG8_STAGE(PG8_SA(0, 0), cA, voffA); PG8_STAGE(PG8_SA(0, 1), cA + hstepA, voffA);
        if (wr == 1) PG8_BAR;
        PG8_WAIT_V(2); PG8_BAR;
        PG8_STAGE(PG8_SB(1, 0), cB + kstepB, voffB); PG8_STAGE(PG8_SA(1, 0), cA + kstepA, voffA); PG8_STAGE(PG8_SB(1, 1), cB + hstepB + kstepB, voffB);
        PG8_WAIT_V(6); PG8_BAR;
    } else {
        PG8_STAGE(PG8_SB(0, 0), cB, voffB); PG8_STAGE(PG8_SA(0, 0), cA, voffA); PG8_STAGE(PG8_SB(0, 1), cB + hstepB, voffB); PG8_STAGE(PG8_SA(0, 1), cA + hstepA, voffA);
        if (wr == 1) PG8_BAR;
        PG8_WAIT_V(4); PG8_BAR;
        PG8_STAGE(PG8_SB(1, 0), cB + kstepB, voffB); PG8_STAGE(PG8_SA(1, 0), cA + kstepA, voffA); PG8_STAGE(PG8_SB(1, 1), cB + hstepB + kstepB, voffB);
        PG8_WAIT_V(6); PG8_BAR;
    }
    for (;;) {
        const bool has_next = S.next(ui + 1, nxt);
        const char* nA = has_next ? (const char*)g.A + nxt.offA : cA; const char* nB = has_next ? (const char*)g.Bt + nxt.offB : cB;
        for (int t = 0; t < nt; t += 2) {
            const bool last = (t == nt - 2);
            const char* a1 = cA + (size_t)(t + 1) * kstepA;
            const char* a2 = last ? nA : cA + (size_t)(t + 2) * kstepA; const char* b2 = last ? nB : cB + (size_t)(t + 2) * kstepB;
            const char* a3 = a2 + kstepA; const char* b3 = b2 + kstepB;
            if (last && has_next) S.a_ready(nxt);
            if constexpr (SP2) {
            PG8_LDB(B0, 0, 0); PG8_LDB(B1, 0, 1); PG8_SCHED; PG8_LDA(At, 0, 0); PG8_STAGE(PG8_SA(1, 1), a1 + hstepA, voffA);
            PG8_WAIT_V(8); PG8_WAIT_L(0); PG8_BAR; PG8_MMA(0, 0, At, B0); PG8_MMA(0, 1, At, B1); PG8_BAR; PG8_SCHED;
            PG8_LDA(At, 0, 1); PG8_STAGE(PG8_SB(0, 0), b2, voffB); PG8_STAGE(PG8_SB(0, 1), b2 + hstepB, voffB); PG8_STAGE(PG8_SA(0, 0), a2, voffA);
            PG8_WAIT_V(8); PG8_WAIT_L(0); PG8_BAR; PG8_MMA(1, 0, At, B0); PG8_MMA(1, 1, At, B1); PG8_BAR; PG8_SCHED;
            PG8_LDB(B0, 1, 0); PG8_LDB(B1, 1, 1); PG8_SCHED; PG8_LDA(At, 1, 0); PG8_STAGE(PG8_SA(0, 1), a2 + hstepA, voffA);
            PG8_WAIT_V(8); PG8_WAIT_L(0); PG8_BAR; PG8_MMA(0, 0, At, B0); PG8_MMA(0, 1, At, B1); PG8_BAR; PG8_SCHED;
            PG8_LDA(At, 1, 1); PG8_STAGE(PG8_SB(1, 0), b3, voffB); PG8_STAGE(PG8_SB(1, 1), b3 + hstepB, voffB); PG8_STAGE(PG8_SA(1, 0), a3, voffA);
            PG8_WAIT_V(8); PG8_WAIT_L(0); PG8_BAR; PG8_MMA(1, 0, At, B0); PG8_MMA(1, 1, At, B1); PG8_BAR; PG8_SCHED;
            } else {
            PG8_LDB(B0, 0, 0); PG8_SCHED; PG8_LDA(At, 0, 0); PG8_STAGE(PG8_SA(1, 1), a1 + hstepA, voffA);
            PG8_WAIT_L(8); PG8_BAR; PG8_WAIT_L(0); PG8_MMA(0, 0, At, B0); PG8_BAR; PG8_SCHED;
            PG8_LDB(B1, 0, 1); PG8_STAGE(PG8_SB(0, 0), b2, voffB);
            PG8_BAR; PG8_WAIT_L(0); PG8_MMA(0, 1, At, B1); PG8_BAR;
            PG8_LDA(At, 0, 1); PG8_STAGE(PG8_SA(0, 0), a2, voffA);
            PG8_BAR; PG8_WAIT_L(0); PG8_MMA(1, 0, At, B0); PG8_BAR; PG8_SCHED;
            PG8_STAGE(PG8_SB(0, 1), b2 + hstepB, voffB);
            PG8_WAIT_V(6); PG8_BAR; PG8_MMA(1, 1, At, B1); PG8_BAR;
            PG8_LDB(B0, 1, 0); PG8_SCHED; PG8_LDA(At, 1, 0); PG8_STAGE(PG8_SA(0, 1), a2 + hstepA, voffA);
            PG8_WAIT_L(8); PG8_BAR; PG8_WAIT_L(0); PG8_MMA(0, 0, At, B0); PG8_BAR; PG8_SCHED;
            PG8_LDB(B1, 1, 1); PG8_STAGE(PG8_SB(1, 0), b3, voffB);
            PG8_BAR; PG8_WAIT_L(0); PG8_MMA(0, 1, At, B1); PG8_BAR;
            PG8_LDA(At, 1, 1); PG8_STAGE(PG8_SA(1, 0), a3, voffA);
            PG8_BAR; PG8_WAIT_L(0); PG8_MMA(1, 0, At, B0); PG8_BAR; PG8_SCHED;
            PG8_STAGE(PG8_SB(1, 1), b3 + hstepB, voffB);
            PG8_WAIT_V(6); PG8_BAR; PG8_MMA(1, 1, At, B1); PG8_BAR;
            }
        }
        if constexpr (ALIGN_EPI) { if (wr == 0) PG8_BAR; }
        if constexpr (!Epi::AFTER_DRAIN) { E(acc, cur, wr, wc, fr, fq); S.done(cur); }
        if (!has_next) break;
#pragma unroll
        for (int a = 0; a < 2; ++a)
#pragma unroll
            for (int b = 0; b < 2; ++b)
#pragma unroll
                for (int m = 0; m < 4; ++m)
#pragma unroll
                    for (int n = 0; n < 2; ++n) acc[a][b][m][n] = (f32x4){0.f, 0.f, 0.f, 0.f};
        cur = nxt; cA = nA; cB = nB; ++ui;
        if constexpr (ALIGN_EPI) { if (wr == 1) PG8_BAR; }
    }
    PG8_WAIT_V(0);
    if constexpr (!ALIGN_EPI) { if (wr == 0) PG8_BAR; }
    PG8_BAR;
    if constexpr (Epi::AFTER_DRAIN) { E.fused(acc, cur, wr, wc, fr, fq, lds, wid, lane); S.done(cur); }
#undef PG8_SA
#undef PG8_SB
#undef PG8_STAGE
#undef PG8_LDA
#undef PG8_LDB
#undef PG8_MMA
#undef PG8_WAIT_V
#undef PG8_WAIT_L
#undef PG8_BAR
#undef PG8_SCHED
}
}

#ifndef PG8_SP2
#define PG8_SP2 true
#endif
#ifndef PG8_ALIGN
#define PG8_ALIGN true
#endif

constexpr int NWAVES = 8;
#ifndef MK_N_LAUNCHES
#define MK_N_LAUNCHES 1
#endif
#ifndef DBG_MODE
#define DBG_MODE 0
#endif
#ifndef REP_PHASE
#define REP_PHASE -1
#endif
#define NREP(k) ((REP_PHASE) == (k) ? 2 : 1)
#ifndef TIME_LO
#define TIME_LO -1
#endif
#ifndef TIME_HI
#define TIME_HI -1
#endif
#ifndef TIME_BLK
#define TIME_BLK 0
#endif
#define TMARK(j) do { if ((TIME_LO) >= 0 && blockIdx.x == (TIME_BLK) && F.tid == 0) { if ((j) == (TIME_LO)) t_lo_ = __builtin_amdgcn_s_memrealtime(); if ((j) == (TIME_HI)) t_hi_ = __builtin_amdgcn_s_memrealtime(); } } while (0)
constexpr int PER_PHASE = 13;
constexpr int N_LAUNCHES = MK_N_LAUNCHES;

constexpr int BATCH = 2, SEQ = 8192, D = 1024, M = BATCH * SEQ;
constexpr int SBW = 512, NH = 8, HD = 64;
constexpr int SSW = 512, NG = 32, GC = 16, NP = 64;
constexpr int NPROJ = 3 * SBW + SSW;
constexpr int LC = 32, NCHUNK = M / LC, CPB = SEQ / LC;
constexpr int UK = LC * GC + 2 * NP;
constexpr int NE = 32, TOPK = 4, FF = 1024, NASSIGN = M * TOPK;
constexpr int MAXTILES = (NASSIGN + NE * 255) / 256 + 1;
constexpr float EPS = 1e-5f;
constexpr float LOG2E = 1.4426950408889634f;

constexpr size_t MiB = 1u << 20;
constexpr size_t WS_CTL = 0, CTL_ZERO_BYTES = 1 * MiB;
constexpr size_t WS_LAML = 1 * MiB;
constexpr size_t WS_RSTD = 1 * MiB + 32 * 1024;
constexpr size_t WS_GATES = 1 * MiB + 128 * 1024;
constexpr size_t WS_ROWINFO = 1 * MiB + 512 * 1024;
constexpr size_t WS_LISTS = 347 * MiB + 110 * MiB;
constexpr size_t WS_WINT = 4 * MiB, WS_WGLUT = 8 * MiB, WS_WOUTT = 9 * MiB, WS_W1T = 11 * MiB, WS_W2T = 139 * MiB;
constexpr size_t WS_R1 = 203 * MiB, WS_R2 = 347 * MiB, WS_END = 491 * MiB;
constexpr size_t WS_HN = WS_R1, WS_Q = WS_R1 + 32 * MiB, WS_K = WS_R1 + 48 * MiB, WS_V = WS_R1 + 64 * MiB, WS_UCAT = WS_R1 + 80 * MiB,
                 WS_SLOC = WS_R1 + 100 * MiB, WS_YSB = WS_R1 + 108 * MiB, WS_YG = WS_R1 + 124 * MiB;
constexpr size_t WS_XS = WS_R1, WS_YBUF = WS_R1;
constexpr size_t WS_YSSM = WS_R2, WS_MIXED = WS_R2 + 16 * MiB, WS_XN = WS_R2 + 48 * MiB, WS_WE = WS_R2 + 80 * MiB, WS_TW = WS_R2 + 85 * MiB;
constexpr size_t WS_H = WS_R2;
static_assert(WS_K == WS_Q + (size_t)M * SBW * 2 && WS_V == WS_K + (size_t)M * SBW * 2 && WS_YG + (size_t)M * SSW * 2 <= WS_R2 && WS_TW + (size_t)NG * 512 * UK * 2 <= WS_END, "ws map");
static_assert(WS_XS + (size_t)MAXTILES * 256 * D * 2 <= WS_R2 + 2 * MiB && WS_H + (size_t)(MAXTILES - 1) * 256 * FF * 2 <= WS_END, "ws map 2");
static_assert(WS_ROWINFO + (size_t)MAXTILES * 256 * 16 <= 4 * MiB && WS_LISTS >= WS_R2 + 106 * MiB && WS_LISTS + (size_t)NE * M * 4 <= WS_END, "ws map 3");
constexpr int CW_TMO = 0, CW_CODE = 1;
constexpr int CW_BAR = 4096;
constexpr int CW_CNT = 16384;
constexpr int CW_Q0 = 16384 + 256;
constexpr int CW_AQ = 16384 + 320, CW_DONE2 = 16384 + 384, CW_DONE3 = 16384 + 448;

constexpr int RING_OFF = 0, RING_BYTES = 131072;
constexpr int RT_WSTR = 1028;
constexpr int RT_W_BYTES = 2 * NE * RT_WSTR * 2;
constexpr int RT_SCR_OFF = RT_W_BYTES;
constexpr int LDSCTL_OFF = 139264, MISC_OFF = LDSCTL_OFF + 320;
constexpr int TAB_OFF = LDSCTL_OFF + 512;
constexpr int UNITS_OFF = LDSCTL_OFF + 1024;
constexpr int TILEE_OFF = LDSCTL_OFF + 1536;
constexpr int LDS_BYTES = LDSCTL_OFF + 4096;
static_assert(TILEE_OFF + MAXTILES * 4 <= LDS_BYTES && RT_SCR_OFF + 4096 <= LDSCTL_OFF, "LDS map");

#define GAS __attribute__((address_space(1)))
#define LAS __attribute__((address_space(3)))
typedef unsigned short bf16;
typedef unsigned v4u __attribute__((ext_vector_type(4)));
typedef unsigned v2u __attribute__((ext_vector_type(2)));
typedef float f32x4 __attribute__((ext_vector_type(4)));
typedef float f32x2 __attribute__((ext_vector_type(2)));
typedef _Float16 h16x2 __attribute__((ext_vector_type(2)));
typedef GAS unsigned gu32;
#define RLX_AGENT __ATOMIC_RELAXED, __HIP_MEMORY_SCOPE_AGENT
#define LDS_WAIT() asm volatile("s_waitcnt lgkmcnt(0)" ::: "memory")
#define VM_WAIT() asm volatile("s_waitcnt vmcnt(0)" ::: "memory")
__device__ __forceinline__ unsigned f2bf(float f) { unsigned u = __builtin_bit_cast(unsigned, f); return (u + 0x7fffu + ((u >> 16) & 1u)) >> 16; }
__device__ __forceinline__ unsigned pk2(float lo, float hi) { return f2bf(lo) | (f2bf(hi) << 16); }
__device__ __forceinline__ float bf2f(unsigned short b) { return __builtin_bit_cast(float, (unsigned)b << 16); }
__device__ __forceinline__ float bflo(unsigned w) { return __builtin_bit_cast(float, w << 16); }
__device__ __forceinline__ float bfhi(unsigned w) { return __builtin_bit_cast(float, w & 0xffff0000u); }
__device__ __forceinline__ unsigned pkh2(float lo, float hi) { h16x2 v; v.x = (_Float16)lo; v.y = (_Float16)hi; return __builtin_bit_cast(unsigned, v); }
__device__ __forceinline__ float fexp2(float x) { return __builtin_amdgcn_exp2f(x); }
__device__ __forceinline__ float flog2(float x) { return __builtin_amdgcn_logf(x); }
__device__ __forceinline__ float frcp(float x) { return __builtin_amdgcn_rcpf(x); }
__device__ __forceinline__ float sigmoidf_(float x) { return frcp(1.0f + fexp2(-LOG2E * x)); }
__device__ __forceinline__ float gelu_tanh(float v) { const float u = 0.7978845608028654f * (v + 0.044715f * v * v * v); return v * frcp(1.0f + fexp2(-2.0f * LOG2E * u)); }

#define XB_TMO      128
#define XB_XCNT(j)  (256  + 64 * (j))
#define XB_XSUB(j)  (1280 + 64 * (j))
#define XB_XGEN(j)  (2304 + 64 * (j))
#define XB_TOP      3328
#define XB_TOPGEN   3392
#define XCD_BAR_WORDS 3456
#define XB_SPIN_CAP (1u << 18)
__device__ __forceinline__ unsigned xb_ld(unsigned* p)              { return __hip_atomic_load(p, __ATOMIC_RELAXED, __HIP_MEMORY_SCOPE_AGENT); }
__device__ __forceinline__ unsigned xb_add(unsigned* p, unsigned v) { return __hip_atomic_fetch_add(p, v, __ATOMIC_RELAXED, __HIP_MEMORY_SCOPE_AGENT); }
__device__ __forceinline__ unsigned xb_xcc_id() { return (unsigned)__builtin_amdgcn_s_getreg((3 << 11) | 20) & 0xFu; }
#define XB_SPIN(cond, bar) do { unsigned _sp = 0; while (cond) { __builtin_amdgcn_s_sleep(1); \
    if ((++_sp & 255u) == 0u) { if (xb_ld(&(bar)[XB_TMO])) break; if (_sp > XB_SPIN_CAP) { atomicAdd(&(bar)[XB_TMO], 1u); break; } } } } while (0)
struct XcdBarrier { unsigned* bar; unsigned x; volatile LAS unsigned* st; };
__device__ __forceinline__ XcdBarrier xcd_barrier_post(unsigned* bar, volatile LAS unsigned* st) {
    XcdBarrier b; b.bar = bar; b.x = xb_xcc_id(); b.st = st;
    if (threadIdx.x == 0) (void)xb_add(&bar[XB_XCNT(b.x)], 1u);
    return b;
}
__device__ __forceinline__ void xcd_barrier_complete(unsigned* bar, unsigned x, unsigned& nloc, unsigned& nx) {
    const unsigned G = gridDim.x * gridDim.y * gridDim.z;
    unsigned sum, cnt, mine, sp = 0u;
    for (;;) {
        sum = 0u; cnt = 0u; mine = 0u;
#pragma unroll
        for (unsigned j = 0; j < 16; ++j) { const unsigned c = xb_ld(&bar[XB_XCNT(j)]); sum += c; cnt += (c > 0u) ? 1u : 0u; mine = (j == x) ? c : mine; }
        if (sum == G) break;
        __builtin_amdgcn_s_sleep(1);
        if ((++sp & 255u) == 0u) { if (xb_ld(&bar[XB_TMO])) break; if (sp > XB_SPIN_CAP) { atomicAdd(&bar[XB_TMO], 1u); break; } }
    }
    nloc = mine > 0u ? mine : 1u; nx = cnt > 0u ? cnt : 1u;
}
__device__ __forceinline__ void xcd_barrier(const XcdBarrier& b) {
    asm volatile("s_waitcnt vmcnt(0)" ::: "memory");
    __syncthreads();
    if (threadIdx.x == 0) {
        unsigned* bar = b.bar;
        __builtin_amdgcn_s_waitcnt(0);
        unsigned nloc = b.st[0], nx = b.st[1];
        if (nloc == 0u) { xcd_barrier_complete(bar, b.x, nloc, nx); b.st[0] = nloc; b.st[1] = nx; }
        const unsigned old = xb_add(&bar[XB_XSUB(b.x)], 1u);
        const unsigned gen = old / nloc;
        if (old + 1u == (gen + 1u) * nloc) {
            __builtin_amdgcn_fence(__ATOMIC_RELEASE, "agent");
            asm volatile("s_waitcnt vmcnt(0)" ::: "memory");
            const unsigned og = xb_add(&bar[XB_TOP], 1u);
            const unsigned tg = og / nx;
            if (og + 1u == (tg + 1u) * nx) xb_add(&bar[XB_TOPGEN], 1u);
            else XB_SPIN(xb_ld(&bar[XB_TOPGEN]) == tg, bar);
            __builtin_amdgcn_fence(__ATOMIC_ACQUIRE, "agent");
            xb_add(&bar[XB_XGEN(b.x)], 1u);
            asm volatile("s_waitcnt vmcnt(0)" ::: "memory");
        } else {
            XB_SPIN(xb_ld(&bar[XB_XGEN(b.x)]) == gen, bar);
            __builtin_amdgcn_fence(__ATOMIC_ACQUIRE, "agent");
            asm volatile("s_waitcnt vmcnt(0)" ::: "memory");
        }
    }
    __syncthreads();
}

struct Frame {
    LAS unsigned char* lds;
    volatile LAS unsigned* MISC;
    gu32* ctl;
    int tid, lane, wave;
    int vcu, G;
    unsigned char* ws;
    const float* in[25];
    float* out;
};

__device__ __forceinline__ float wave_sum(float v) {
#pragma unroll
    for (int o = 1; o < 64; o <<= 1) v += __shfl_xor(v, o);
    return v;
}

using pg8::Unit;
typedef pg8::f32x4 accv;
struct EpiInProj {
    static constexpr bool PERM = true, AFTER_DRAIN = false;
    unsigned short* QKV; bf16* U; float qscale;
    __device__ __forceinline__ void operator()(const accv (&acc)[2][2][4][2], const Unit& u, int wr, int wc, int fr, int fq) const {
        if (u.e == 1) {
            const int row0 = u.pm * 256 + wr * 64 + fr; const int colt = u.pn * 256 + wc * 32 + 8 * fq;
            _Float16* VT = (_Float16*)(QKV + (size_t)2 * M * SBW);
#pragma unroll
            for (int ai = 0; ai < 2; ++ai)
#pragma unroll
                for (int m = 0; m < 4; ++m) { const int row = row0 + ai * 128 + m * 16;
#pragma unroll
                    for (int bj = 0; bj < 2; ++bj) { const int tok = colt + bj * 128; const accv v0 = acc[ai][bj][m][0], v1 = acc[ai][bj][m][1];
                        const int bb = tok >> 13, sq = tok & (SEQ - 1); const int o = sq & 15;
                        _Float16* p = VT + ((size_t)bb * SBW + row) * SEQ + (sq & ~15) + (o >> 1);
                        v2u w0, w1; w0.x = pkh2(v0[0], v0[1]); w0.y = pkh2(v0[2], v0[3]); w1.x = pkh2(v1[0], v1[1]); w1.y = pkh2(v1[2], v1[3]);
                        *(v2u*)p = w0; *(v2u*)(p + 8) = w1; } }
            return;
        }
        const int kind = u.pn >> 1; const int colt = (u.pn & 1) * 256 + wc * 32 + 8 * fq; const int row0 = u.pm * 256 + wr * 64 + fr;
        unsigned short* T = QKV + (size_t)(kind < 2 ? kind : 0) * ((size_t)M * SBW); const float sc = kind == 0 ? qscale : 1.0f;
#pragma unroll
        for (int ai = 0; ai < 2; ++ai)
#pragma unroll
            for (int m = 0; m < 4; ++m) { const int row = row0 + ai * 128 + m * 16;
#pragma unroll
                for (int bj = 0; bj < 2; ++bj) { const int col = colt + bj * 128; const accv v0 = acc[ai][bj][m][0] * sc, v1 = acc[ai][bj][m][1] * sc; v4u w;
                    if (kind < 2) { w.x = pkh2(v0[0], v0[1]); w.y = pkh2(v0[2], v0[3]); w.z = pkh2(v1[0], v1[1]); w.w = pkh2(v1[2], v1[3]);
                        *(v4u*)(T + (size_t)row * SBW + col) = w; }
                    else { w.x = pg8::cvt_pk_bf16(v0[0], v0[1]); w.y = pg8::cvt_pk_bf16(v0[2], v0[3]); w.z = pg8::cvt_pk_bf16(v1[0], v1[1]); w.w = pg8::cvt_pk_bf16(v1[2], v1[3]);
                        *(v4u*)(U + ((size_t)(row >> 5) * NG + (col >> 4)) * UK + (row & 31) * GC + (col & 15)) = w; } } }
    }
};
struct EpiSloc {
    static constexpr bool PERM = false, AFTER_DRAIN = false;
    float* S;
    __device__ __forceinline__ void operator()(const accv (&acc)[2][2][4][2], const Unit& u, int wr, int wc, int fr, int fq) const {
        const int row0 = u.pm * 256 + wr * 64 + fr; const int col0 = wc * 32 + 4 * fq;
#pragma unroll
        for (int ai = 0; ai < 2; ++ai)
#pragma unroll
            for (int m = 0; m < 4; ++m) { const int row = row0 + ai * 128 + m * 16;
#pragma unroll
                for (int n = 0; n < 2; ++n) *(accv*)(S + ((size_t)row * NG + u.e) * 128 + col0 + 16 * n) = acc[ai][0][m][n]; }
    }
};
struct EpiS3 {
    static constexpr bool PERM = true, AFTER_DRAIN = false;
    bf16* YG;
    __device__ __forceinline__ void operator()(const accv (&acc)[2][2][4][2], const Unit& u, int wr, int wc, int fr, int fq) const {
        const int row0 = u.pm * 256 + wr * 64 + fr; const int colt = u.pn * 256 + wc * 32 + 8 * fq;
#pragma unroll
        for (int ai = 0; ai < 2; ++ai)
#pragma unroll
            for (int m = 0; m < 4; ++m) { const int row = row0 + ai * 128 + m * 16;
#pragma unroll
                for (int bj = 0; bj < 2; ++bj) { const int col = colt + bj * 128; const accv v0 = acc[ai][bj][m][0], v1 = acc[ai][bj][m][1]; v4u w;
                    w.x = pg8::cvt_pk_bf16(gelu_tanh(v0[0]), gelu_tanh(v0[1])); w.y = pg8::cvt_pk_bf16(gelu_tanh(v0[2]), gelu_tanh(v0[3]));
                    w.z = pg8::cvt_pk_bf16(gelu_tanh(v1[0]), gelu_tanh(v1[1])); w.w = pg8::cvt_pk_bf16(gelu_tanh(v1[2]), gelu_tanh(v1[3]));
                    *(v4u*)(YG + ((size_t)row * LC + (col >> 4)) * SSW + u.e * GC + (col & 15)) = w; } }
    }
};
struct EpiGlu {
    static constexpr bool PERM = true, AFTER_DRAIN = false;
    bf16* Y;
    __device__ __forceinline__ void operator()(const accv (&acc)[2][2][4][2], const Unit& u, int wr, int wc, int fr, int fq) const {
        const int row0 = u.pm * 256 + wr * 64 + fr; const int col = u.pn * 128 + wc * 32 + 8 * fq;
#pragma unroll
        for (int ai = 0; ai < 2; ++ai)
#pragma unroll
            for (int m = 0; m < 4; ++m) { const int row = row0 + ai * 128 + m * 16; float r[8];
#pragma unroll
                for (int n = 0; n < 2; ++n)
#pragma unroll
                    for (int j = 0; j < 4; ++j) r[4 * n + j] = acc[ai][0][m][n][j] * sigmoidf_(acc[ai][1][m][n][j]);
                v4u w; w.x = pg8::cvt_pk_bf16(r[0], r[1]); w.y = pg8::cvt_pk_bf16(r[2], r[3]); w.z = pg8::cvt_pk_bf16(r[4], r[5]); w.w = pg8::cvt_pk_bf16(r[6], r[7]);
                *(v4u*)(Y + (size_t)row * SSW + col) = w; }
    }
};
struct EpiOutProj {
    static constexpr bool PERM = false, AFTER_DRAIN = false;
    const float* X; float* O;
    __device__ __forceinline__ void operator()(const accv (&acc)[2][2][4][2], const Unit& u, int wr, int wc, int fr, int fq) const {
        const int row0 = u.pm * 256 + wr * 64 + fr; const int col0 = u.pn * 256 + wc * 32 + 4 * fq;
#pragma unroll
        for (int ai = 0; ai < 2; ++ai)
#pragma unroll
            for (int m = 0; m < 4; ++m) { const size_t off = (size_t)(row0 + ai * 128 + m * 16) * D + col0;
#pragma unroll
                for (int bj = 0; bj < 2; ++bj)
#pragma unroll
                    for (int n = 0; n < 2; ++n) { const accv xv = *(const accv*)(X + off + bj * 128 + n * 16); *(accv*)(O + off + bj * 128 + n * 16) = xv + acc[ai][bj][m][n]; }
                if (m & 1) asm volatile("" ::: "memory"); }
    }
};
struct EpiMoe1 {
    static constexpr bool PERM = true, AFTER_DRAIN = false;
    bf16* H; const float* bg; const float* bu; const int* rowinfo;
    __device__ __forceinline__ void operator()(const accv (&acc)[2][2][4][2], const Unit& u, int wr, int wc, int fr, int fq) const {
        const int row0 = u.pm * 256 + wr * 64 + fr; const int col = u.pn * 128 + wc * 32 + 8 * fq;
        float bgv[8], buv[8];
#pragma unroll
        for (int n = 0; n < 2; ++n) { const accv a = *(const accv*)(bg + u.e * FF + col + 4 * n), b = *(const accv*)(bu + u.e * FF + col + 4 * n);
#pragma unroll
            for (int j = 0; j < 4; ++j) { bgv[4 * n + j] = a[j]; buv[4 * n + j] = b[j]; } }
#pragma unroll
        for (int ai = 0; ai < 2; ++ai)
#pragma unroll
            for (int m = 0; m < 4; ++m) { const int row = row0 + ai * 128 + m * 16; float r[8]; const float rs = __builtin_bit_cast(float, rowinfo[4 * row + 2]);
#pragma unroll
                for (int n = 0; n < 2; ++n)
#pragma unroll
                    for (int j = 0; j < 4; ++j) { const float g = fminf(acc[ai][0][m][n][j] * rs + bgv[4 * n + j], 7.0f); const float up = fminf(fmaxf(acc[ai][1][m][n][j] * rs + buv[4 * n + j], -7.0f), 7.0f);
                        r[4 * n + j] = (up + 1.0f) * g * frcp(1.0f + fexp2(-1.702f * LOG2E * g)); }
                v4u w; w.x = pg8::cvt_pk_bf16(r[0], r[1]); w.y = pg8::cvt_pk_bf16(r[2], r[3]); w.z = pg8::cvt_pk_bf16(r[4], r[5]); w.w = pg8::cvt_pk_bf16(r[6], r[7]);
                *(v4u*)(H + (size_t)row * FF + col) = w; }
    }
};
struct EpiMoe2 {
    static constexpr bool PERM = true, AFTER_DRAIN = false;
    bf16* Y; const float* bd; const int* rowinfo;
    __device__ __forceinline__ void operator()(const accv (&acc)[2][2][4][2], const Unit& u, int wr, int wc, int fr, int fq) const {
        const int row0 = u.pm * 256 + wr * 64 + fr; const int colt = u.pn * 256 + wc * 32 + 8 * fq;
        float bv[2][8];
#pragma unroll
        for (int bj = 0; bj < 2; ++bj)
#pragma unroll
            for (int n = 0; n < 2; ++n) { const accv a = *(const accv*)(bd + u.e * D + colt + bj * 128 + 4 * n);
#pragma unroll
                for (int j = 0; j < 4; ++j) bv[bj][4 * n + j] = a[j]; }
#pragma unroll
        for (int ai = 0; ai < 2; ++ai)
#pragma unroll
            for (int m = 0; m < 4; ++m) { const int row = row0 + ai * 128 + m * 16; const int slot = rowinfo[4 * row]; const float gate = __builtin_bit_cast(float, rowinfo[4 * row + 1]);
                if (slot >= 0) {
#pragma unroll
                    for (int bj = 0; bj < 2; ++bj) { float r[8];
#pragma unroll
                        for (int n = 0; n < 2; ++n)
#pragma unroll
                            for (int j = 0; j < 4; ++j) r[4 * n + j] = (acc[ai][bj][m][n][j] + bv[bj][4 * n + j]) * gate;
                        v4u w; w.x = pg8::cvt_pk_bf16(r[0], r[1]); w.y = pg8::cvt_pk_bf16(r[2], r[3]); w.z = pg8::cvt_pk_bf16(r[4], r[5]); w.w = pg8::cvt_pk_bf16(r[6], r[7]);
                        *(v4u*)(Y + (size_t)slot * D + colt + bj * 128) = w; } } }
    }
};

struct InProjOrder {
    int G, c;
    __device__ bool next(int i, Unit& u) const {
        const int L = i * G + c; if (L >= 512) return false;
        const int s = pg8::xcd_remap(L, 512);
        if (s < 384) { const int grp = s / 48, r = s % 48; u.pm = grp * 8 + (r & 7); const int pi = r >> 3; u.pn = pi < 4 ? pi : pi + 2; u.e = 0;
            u.offA = (long)u.pm * 256 * D * 2; u.offB = (long)u.pn * 256 * D * 2; }
        else { const int r = s - 384; u.pm = r & 1; u.pn = r >> 1; u.e = 1;
            u.offA = (long)(WS_WINT - WS_HN) + (long)(1024 + u.pm * 256) * D * 2; u.offB = (long)(WS_HN - WS_WINT) + (long)u.pn * 256 * D * 2; }
        return true;
    }
    __device__ __forceinline__ void a_ready(const Unit&) const {}
    __device__ __forceinline__ void done(const Unit&) const {}
};
struct SsmOrder {
    int nwg, G, c, npn, rows_per_g, ldb;
    __device__ bool next(int i, Unit& u) const {
        const int L = i * G + c; if (L >= nwg) return false;
        const int per_g = 2 * npn; const int g = L / per_g, r = L % per_g;
        u.e = g; u.pm = r / npn; u.pn = r % npn;
        u.offA = ((long)u.pm * 256 * NG * UK + (long)g * UK) * 2; u.offB = ((long)g * rows_per_g + (long)u.pn * 256) * ldb * 2; return true;
    }
    __device__ __forceinline__ void a_ready(const Unit&) const {}
    __device__ __forceinline__ void done(const Unit&) const {}
};
struct MoeOrder {
    const LAS int* units; long ebytes;
    __device__ bool next(int i, Unit& u) const {
        if (i >= 32) return false;
        const int v = __builtin_amdgcn_readfirstlane(units[4 * i + 3]); if (!v) return false;
        u.pm = __builtin_amdgcn_readfirstlane(units[4 * i + 0]); u.pn = __builtin_amdgcn_readfirstlane(units[4 * i + 1]); u.e = __builtin_amdgcn_readfirstlane(units[4 * i + 2]);
        u.offA = (long)u.pm * 256 * D * 2; u.offB = (long)u.e * ebytes + (long)u.pn * 256 * 16; return true;
    }
    __device__ __forceinline__ void a_ready(const Unit&) const {}
    __device__ __forceinline__ void done(const Unit&) const {}
};

struct CvItem { const float* src; bf16* dst; int ldw, K, rmul, radd, k0, n0; };
constexpr int CV_I_IN = (D / 64) * (NPROJ / 32), CV_I_GLU = (SSW / 64) * (SSW / 32), CV_I_OUT = (D / 64) * (D / 32), CV_I_E = (D / 64) * (FF / 32);
constexpr int CV_N_EARLY = CV_I_IN + 2 * CV_I_GLU + CV_I_OUT, CV_N_EXP = 3 * NE * (D / 8);
__device__ __forceinline__ void cv_set(CvItem& c, const float* W, int ldw, int K, int N, bf16* WT, int rmul, int radd, int item) {
    const int nblk = N / 32, kb = item / nblk, nb = item % nblk; c.src = W; c.dst = WT; c.ldw = ldw; c.K = K; c.rmul = rmul; c.radd = radd; c.k0 = 64 * kb; c.n0 = 32 * nb;
}
__device__ __forceinline__ void cv_decode_early(Frame& F, int r, CvItem& c) {
    bf16* WinT = (bf16*)(F.ws + WS_WINT); bf16* WgluT = (bf16*)(F.ws + WS_WGLUT); bf16* WoutT = (bf16*)(F.ws + WS_WOUTT);
    if (r < CV_I_IN) { cv_set(c, F.in[2], NPROJ, D, NPROJ, WinT, 1, 0, r); return; } r -= CV_I_IN;
    if (r < CV_I_GLU) { cv_set(c, F.in[11], 2 * SSW, SSW, SSW, WgluT, 2, 0, r); return; } r -= CV_I_GLU;
    if (r < CV_I_GLU) { cv_set(c, F.in[11] + SSW, 2 * SSW, SSW, SSW, WgluT, 2, 128, r); return; } r -= CV_I_GLU;
    cv_set(c, F.in[14], D, D, D, WoutT, 1, 0, r);
}
__device__ __forceinline__ void cv_decode_exp(Frame& F, int r, CvItem& c) {
    bf16* W1T = (bf16*)(F.ws + WS_W1T); bf16* W2T = (bf16*)(F.ws + WS_W2T);
    const int mat = r / CV_I_E, sub = r % CV_I_E, kind = mat / NE, e = mat % NE;
    if (kind == 0) cv_set(c, F.in[18] + (size_t)e * D * FF, FF, D, FF, W1T + (size_t)e * 2 * FF * D, 2, 0, sub);
    else if (kind == 1) cv_set(c, F.in[20] + (size_t)e * D * FF, FF, D, FF, W1T + (size_t)e * 2 * FF * D, 2, 128, sub);
    else cv_set(c, F.in[22] + (size_t)e * FF * D, D, FF, D, W2T + (size_t)e * D * FF, 1, 0, sub);
}
__device__ __forceinline__ void cv_load(const CvItem& c, int lane, float (&v)[32]) {
    const float* p = c.src + (size_t)(c.k0 + (lane >> 5)) * c.ldw + c.n0 + (lane & 31);
#pragma unroll
    for (int i = 0; i < 32; ++i) v[i] = p[(size_t)(2 * i) * c.ldw];
}
__device__ __forceinline__ void cv_store(const CvItem& c, int lane, const float (&v)[32], LAS float* scr) {
#pragma unroll
    for (int i = 0; i < 32; ++i) scr[(2 * i + (lane >> 5)) * 33 + (lane & 31)] = v[i];
    LDS_WAIT(); asm volatile("" ::: "memory");
    const int cc = lane & 7;
#pragma unroll
    for (int j = 0; j < 4; ++j) { const int nl = (lane >> 3) + 8 * j; const int n = c.n0 + nl; const int drow = (n >> 7) * 128 * c.rmul + c.radd + (n & 127); const LAS float* s = scr + (8 * cc) * 33 + nl;
        v4u o; o.x = pg8::cvt_pk_bf16(s[0 * 33], s[1 * 33]); o.y = pg8::cvt_pk_bf16(s[2 * 33], s[3 * 33]); o.z = pg8::cvt_pk_bf16(s[4 * 33], s[5 * 33]); o.w = pg8::cvt_pk_bf16(s[6 * 33], s[7 * 33]);
        *(GAS v4u*)(c.dst + (size_t)drow * c.K + c.k0 + 8 * cc) = o; }
    LDS_WAIT(); asm volatile("" ::: "memory");
}
__device__ __forceinline__ void cv_item_early(Frame& F, int it, LAS float* scr) { CvItem c; float v[32]; cv_decode_early(F, it, c); cv_load(c, F.lane, v); cv_store(c, F.lane, v, scr); }
__device__ __forceinline__ void cv_run_early(Frame& F, int first, int stride, int n, LAS float* scr) {
    CvItem ca, cb; float va[32], vb[32];
    int it = first; if (it >= n) return;
    cv_decode_early(F, it, ca);
    cv_load(ca, F.lane, va);
    for (;;) {
        const int nit = it + stride; const bool more = nit < n;
        if (more) { cv_decode_early(F, nit, cb); cv_load(cb, F.lane, vb); }
        cv_store(ca, F.lane, va, scr);
        if (!more) break;
        ca = cb;
#pragma unroll
        for (int i = 0; i < 32; ++i) va[i] = vb[i];
        it = nit;
    }
}
__device__ __forceinline__ void xv_item(Frame& F, int it) {
    bf16* W1T = (bf16*)(F.ws + WS_W1T); bf16* W2T = (bf16*)(F.ws + WS_W2T);
    const float* w0 = F.in[18]; const float* w1 = F.in[20]; const float* w2 = F.in[22];
    asm volatile("" : "+s"(w0), "+s"(w1), "+s"(w2));
    const int lane = F.lane;
    {
        const int mat = it >> 7, kb = it & 127, kind = mat / NE, e = mat % NE;
        const float* src = (kind == 0 ? w0 : (kind == 1 ? w1 : w2)) + (size_t)e * D * FF + (size_t)(kb * 8) * FF + 4 * lane;
        f32x4 v[8][4];
#pragma unroll
        for (int rr = 0; rr < 8; ++rr)
#pragma unroll
            for (int j = 0; j < 4; ++j) v[rr][j] = *(const GAS f32x4*)(src + (size_t)rr * FF + 256 * j);
        bf16* dst; int cstride;
        if (kind < 2) { dst = W1T + (size_t)e * 2 * FF * D + ((size_t)kb * 2 * FF + (size_t)(lane >> 5) * 256 + (kind == 1 ? 128 : 0) + 4 * (lane & 31)) * 8; cstride = 512 * 8; }
        else { dst = W2T + (size_t)e * D * FF + ((size_t)kb * D + 4 * lane) * 8; cstride = 256 * 8; }
#pragma unroll
        for (int j = 0; j < 4; ++j)
#pragma unroll
            for (int c = 0; c < 4; ++c) { v4u o; o.x = pg8::cvt_pk_bf16(v[0][j][c], v[1][j][c]); o.y = pg8::cvt_pk_bf16(v[2][j][c], v[3][j][c]); o.z = pg8::cvt_pk_bf16(v[4][j][c], v[5][j][c]); o.w = pg8::cvt_pk_bf16(v[6][j][c], v[7][j][c]);
                *(GAS v4u*)(dst + (size_t)j * cstride + c * 8) = o; }
    }
}
__device__ __forceinline__ void rms_row_to_bf16(int lane, const float* xrow, const float* g, bf16* orow) {
    const GAS f32x4* xr = (const GAS f32x4*)xrow + lane; const GAS f32x4* gr = (const GAS f32x4*)g + lane;
    f32x4 v[4]; float s = 0.f;
#pragma unroll
    for (int j = 0; j < 4; ++j) { v[j] = xr[64 * j]; s += (v[j].x * v[j].x + v[j].y * v[j].y) + (v[j].z * v[j].z + v[j].w * v[j].w); }
    const float rstd = 1.0f / sqrtf(wave_sum(s) * (1.f / D) + EPS);
    GAS unsigned long long* o8 = (GAS unsigned long long*)orow + lane;
#pragma unroll
    for (int j = 0; j < 4; ++j) { const f32x4 gg = gr[64 * j]; o8[64 * j] = (unsigned long long)pk2(v[j].x * rstd * gg.x, v[j].y * rstd * gg.y) | ((unsigned long long)pk2(v[j].z * rstd * gg.z, v[j].w * rstd * gg.w) << 32); }
}
__device__ __forceinline__ void sincos_acc(float th, float& s, float& c) {
    const float k = rintf(th * 0.15915494309189535f);
    float r = fmaf(-k, 6.28125f, th); r = fmaf(-k, 1.9353071795864769e-3f, r);
    const float x = 0.25f * r, x2 = x * x;
    float sn = x * (1.0f + x2 * (-1.0f / 6 + x2 * (1.0f / 120 + x2 * (-1.0f / 5040 + x2 * (1.0f / 362880 + x2 * (-1.0f / 39916800))))));
    float cs = 1.0f + x2 * (-0.5f + x2 * (1.0f / 24 + x2 * (-1.0f / 720 + x2 * (1.0f / 40320 + x2 * (-1.0f / 3628800 + x2 * (1.0f / 479001600))))));
#pragma unroll
    for (int i = 0; i < 2; ++i) { const float s2 = 2.0f * sn * cs, c2 = 1.0f - 2.0f * sn * sn; sn = s2; cs = c2; }
    s = sn; c = cs;
}
__device__ __forceinline__ void ssm_tables(Frame& F, int g) {
    constexpr int PS = 65, BS = 17, CS = 65, KT = 273, KC = 17;
    LAS float* pwr = (LAS float*)(F.lds);
    LAS float* pwi = pwr + 33 * PS;
    LAS float* bbr = pwi + 33 * PS;
    LAS float* bbi = bbr + 64 * BS;
    LAS float* ccr = bbi + 64 * BS;
    LAS float* cci = ccr + 16 * CS;
    LAS float* km = cci + 16 * CS;
    const float* lam_re = F.in[3]; const float* lam_im = F.in[4]; const float* log_dt = F.in[5];
    const float* b_re = F.in[6]; const float* b_im = F.in[7]; const float* c_re = F.in[8]; const float* c_im = F.in[9]; const float* dsk = F.in[10];
    float* lamL = (float*)(F.ws + WS_LAML); bf16* WE = (bf16*)(F.ws + WS_WE); bf16* TW = (bf16*)(F.ws + WS_TW);
    const int tid = F.tid;
    if (tid < 64) { const int p = tid;
        const float lr = lam_re[g * NP + p], li = lam_im[g * NP + p], dt = expf(log_dt[g]);
        const float er = expf(lr * dt); float sn, cs; sincos_acc(li * dt, sn, cs);
        const float br = er * cs, bi = er * sn;
        const float nr = br - 1.0f, ni = bi, den = 1.0f / (lr * lr + li * li);
        const float fr = (nr * lr + ni * li) * den, fi = (ni * lr - nr * li) * den;
        float pr = 1.0f, pi = 0.0f;
        for (int n = 0; n <= 32; ++n) { pwr[n * PS + p] = pr; pwi[n * PS + p] = pi; const float t = pr * br - pi * bi; pi = pr * bi + pi * br; pr = t; }
        lamL[(g * 2 + 0) * NP + p] = pwr[32 * PS + p]; lamL[(g * 2 + 1) * NP + p] = pwi[32 * PS + p];
        float xr[GC], xi[GC];
#pragma unroll
        for (int c = 0; c < GC; ++c) { xr[c] = b_re[(g * NP + p) * GC + c]; xi[c] = b_im[(g * NP + p) * GC + c]; }
#pragma unroll
        for (int c = 0; c < GC; ++c) { bbr[p * BS + c] = fr * xr[c] - fi * xi[c]; bbi[p * BS + c] = fr * xi[c] + fi * xr[c]; }
    }
    for (int i = tid; i < 1024; i += NWAVES * 64) { ccr[(i >> 6) * CS + (i & 63)] = c_re[g * 1024 + i]; cci[(i >> 6) * CS + (i & 63)] = c_im[g * 1024 + i]; }
    __syncthreads();
    {
        const int pair = tid & 255, co = pair >> 4, ci = pair & 15, t0 = (tid >> 8) * 16;
        float acc[16];
#pragma unroll
        for (int t = 0; t < 16; ++t) acc[t] = 0.f;
        for (int p = 0; p < NP; ++p) { const float cr = ccr[co * CS + p], cim = cci[co * CS + p], xr = bbr[p * BS + ci], xi = bbi[p * BS + ci];
            const float gr = cr * xr - cim * xi, gi = cr * xi + cim * xr;
#pragma unroll
            for (int t = 0; t < 16; ++t) acc[t] += gr * pwr[(t0 + t) * PS + p] - gi * pwi[(t0 + t) * PS + p]; }
#pragma unroll
        for (int t = 0; t < 16; ++t) km[(t0 + t) * KT + co * KC + ci] = acc[t];
    }
    __syncthreads();
    {
        const int n = tid, i = n >> 4, co = n & 15; const float dv = dsk[g * GC + co];
        bf16* dst = TW + ((size_t)g * 512 + n) * UK;
        for (int j = 0; j < LC; ++j) {
            float v[16];
#pragma unroll
            for (int ci = 0; ci < 16; ++ci) { float val = (j <= i) ? km[(j <= i ? i - j : 0) * KT + co * KC + ci] : 0.f; if (j == i && ci == co) val += dv; v[ci] = val; }
            v4u o0, o1; o0.x = pg8::cvt_pk_bf16(v[0], v[1]); o0.y = pg8::cvt_pk_bf16(v[2], v[3]); o0.z = pg8::cvt_pk_bf16(v[4], v[5]); o0.w = pg8::cvt_pk_bf16(v[6], v[7]);
            o1.x = pg8::cvt_pk_bf16(v[8], v[9]); o1.y = pg8::cvt_pk_bf16(v[10], v[11]); o1.z = pg8::cvt_pk_bf16(v[12], v[13]); o1.w = pg8::cvt_pk_bf16(v[14], v[15]);
            *(GAS v4u*)(dst + j * 16) = o0; *(GAS v4u*)(dst + j * 16 + 8) = o1; }
        for (int k8 = 0; k8 < 16; ++k8) { float v[8];
#pragma unroll
            for (int e = 0; e < 8; ++e) { const int k = k8 * 8 + e, ri = k >> 6, p = k & 63; const float cr = ccr[co * CS + p], cim = cci[co * CS + p], pr = pwr[(i + 1) * PS + p], pi = pwi[(i + 1) * PS + p];
                v[e] = ri == 0 ? (cr * pr - cim * pi) : -(cr * pi + cim * pr); }
            v4u o; o.x = pg8::cvt_pk_bf16(v[0], v[1]); o.y = pg8::cvt_pk_bf16(v[2], v[3]); o.z = pg8::cvt_pk_bf16(v[4], v[5]); o.w = pg8::cvt_pk_bf16(v[6], v[7]);
            *(GAS v4u*)(dst + 512 + k8 * 8) = o; }
    }
    {
        const int row = tid & 127, ri = row >> 6, p = row & 63, kq = tid >> 7;
        bf16* dst = WE + ((size_t)g * 128 + row) * 512 + kq * 128;
        for (int k8 = 0; k8 < 16; ++k8) { float v[8];
#pragma unroll
            for (int e = 0; e < 8; ++e) { const int k = kq * 128 + k8 * 8 + e, j = k >> 4, c = k & 15; const float pr = pwr[(31 - j) * PS + p], pi = pwi[(31 - j) * PS + p], xr = bbr[p * BS + c], xi = bbi[p * BS + c];
                v[e] = ri == 0 ? (pr * xr - pi * xi) : (pr * xi + pi * xr); }
            v4u o; o.x = pg8::cvt_pk_bf16(v[0], v[1]); o.y = pg8::cvt_pk_bf16(v[2], v[3]); o.z = pg8::cvt_pk_bf16(v[4], v[5]); o.w = pg8::cvt_pk_bf16(v[6], v[7]);
            *(GAS v4u*)(dst + k8 * 8) = o; }
    }
    __syncthreads();
}
__device__ __forceinline__ void rms_rows2_to_bf16(int lane, const float* x0, const float* x1, const float* g, bf16* o0, bf16* o1) {
    const GAS f32x4* xa = (const GAS f32x4*)x0 + lane; const GAS f32x4* xb = (const GAS f32x4*)x1 + lane; const GAS f32x4* gr = (const GAS f32x4*)g + lane;
    f32x4 va[4], vb[4]; float sa = 0.f, sb = 0.f;
#pragma unroll
    for (int j = 0; j < 4; ++j) { va[j] = xa[64 * j]; vb[j] = xb[64 * j]; }
#pragma unroll
    for (int j = 0; j < 4; ++j) { sa += (va[j].x * va[j].x + va[j].y * va[j].y) + (va[j].z * va[j].z + va[j].w * va[j].w); sb += (vb[j].x * vb[j].x + vb[j].y * vb[j].y) + (vb[j].z * vb[j].z + vb[j].w * vb[j].w); }
#pragma unroll
    for (int o = 1; o < 64; o <<= 1) { sa += __shfl_xor(sa, o); sb += __shfl_xor(sb, o); }
    const float ra = 1.0f / sqrtf(sa * (1.f / D) + EPS), rb = 1.0f / sqrtf(sb * (1.f / D) + EPS);
    GAS v2u* pa = (GAS v2u*)o0 + lane; GAS v2u* pb = (GAS v2u*)o1 + lane;
#pragma unroll
    for (int j = 0; j < 4; ++j) { const f32x4 gg = gr[64 * j];
        v2u wa, wb; wa.x = pg8::cvt_pk_bf16(va[j].x * ra * gg.x, va[j].y * ra * gg.y); wa.y = pg8::cvt_pk_bf16(va[j].z * ra * gg.z, va[j].w * ra * gg.w);
        wb.x = pg8::cvt_pk_bf16(vb[j].x * rb * gg.x, vb[j].y * rb * gg.y); wb.y = pg8::cvt_pk_bf16(vb[j].z * rb * gg.z, vb[j].w * rb * gg.w);
        pa[64 * j] = wa; pb[64 * j] = wb; }
}
constexpr int Q0_EXP = CV_N_EXP, Q0_HN = Q0_EXP + M / 8, Q0_END = Q0_HN + CV_N_EARLY / 4;
static_assert(Q0_END % 8 == 0 && CV_N_EARLY % 4 == 0, "P0 queue");
__device__ __forceinline__ void p0_prologue(Frame& F, unsigned long long& t_lo_, unsigned long long& t_hi_) {
    TMARK(100);
    const bool tabler = (F.vcu & 7) == 0 && (F.vcu >> 3) < NG;
    if (tabler) { ssm_tables(F, F.vcu >> 3);
        if ((F.vcu >> 3) == 0 && F.tid < 128) {
            bf16* WE = (bf16*)(F.ws + WS_WE) + (size_t)NG * 128 * 512;
            for (int i = 0; i < 512 / 8; ++i) *(GAS v4u*)(WE + (size_t)F.tid * 512 + i * 8) = (v4u){0u, 0u, 0u, 0u}; } }
    TMARK(101);
    LAS float* scr = (LAS float*)(F.lds + RING_OFF + F.wave * 16384);
    unsigned* q = (unsigned*)(F.ctl + CW_Q0); volatile LAS unsigned* slot = F.MISC + 16;
    bf16* HN = (bf16*)(F.ws + WS_HN);
    for (;;) {
        __syncthreads();
        if (F.tid == 0) *slot = __hip_atomic_fetch_add(q, 8u, RLX_AGENT);
        __syncthreads();
        const int base = (int)__builtin_amdgcn_readfirstlane(*slot); if (base >= Q0_END) break;
        const int idx = base + F.wave;
        if (idx < Q0_EXP) xv_item(F, idx);
        else if (idx < Q0_HN) { const int m0 = (idx - Q0_EXP) * 8;
#pragma unroll 1
            for (int j = 0; j < 4; ++j) { const int m = m0 + 2 * j; rms_rows2_to_bf16(F.lane, F.in[0] + (size_t)m * D, F.in[0] + (size_t)(m + 1) * D, F.in[1], HN + (size_t)m * D, HN + (size_t)(m + 1) * D); } }
        else { const int g4 = (idx - Q0_HN) * 4;
#pragma unroll 1
            for (int j = 0; j < 4; ++j) cv_item_early(F, g4 + j, scr); }
    }
    TMARK(104);
}

__device__ __forceinline__ void attn_simple_unit(const unsigned short* Qh, const unsigned short* Kh, const unsigned short* Vh, bf16* Y, int b, int h, int qb, int lane) {
    const int t = qb * 64 + lane; const size_t row = (size_t)b * SEQ + t;
    float q[64], o[64];
    { const v4u* qp = (const v4u*)(Qh + row * SBW + h * HD);
#pragma unroll
      for (int i = 0; i < 8; ++i) { const v4u w = qp[i];
#pragma unroll
          for (int j = 0; j < 4; ++j) { const unsigned wj = w[j]; const h16x2 hv = __builtin_bit_cast(h16x2, wj); q[8 * i + 2 * j] = (float)hv.x; q[8 * i + 2 * j + 1] = (float)hv.y; } } }
#pragma unroll
    for (int d = 0; d < 64; ++d) o[d] = 0.f;
    float cum = 0.f;
    for (int s = qb * 64 + 62; s >= 0; --s) {
        const size_t krow = ((size_t)b * SEQ + s) * SBW + h * HD;
        const v4u* kp = (const v4u*)(Kh + krow); const v4u* vp = (const v4u*)(Vh + krow);
        float z = 0.f;
#pragma unroll
        for (int i = 0; i < 8; ++i) { const v4u w = kp[i];
#pragma unroll
            for (int j = 0; j < 4; ++j) { const unsigned wj = w[j]; const h16x2 hv = __builtin_bit_cast(h16x2, wj); z = fmaf(q[8 * i + 2 * j], (float)hv.x, z); z = fmaf(q[8 * i + 2 * j + 1], (float)hv.y, z); } }
        const bool act = s < t;
        const float t1 = flog2(1.0f + fexp2(-fabsf(z)));
        const float L = act ? -(fmaxf(z, 0.f) + t1) : 0.f;
        const float ls = fminf(z, 0.f) - t1;
        const float p = act ? fexp2(ls + cum) : 0.f;
        cum += L;
#pragma unroll
        for (int i = 0; i < 8; ++i) { const v4u w = vp[i];
#pragma unroll
            for (int j = 0; j < 4; ++j) { const unsigned wj = w[j]; const h16x2 hv = __builtin_bit_cast(h16x2, wj); o[8 * i + 2 * j] = fmaf(p, (float)hv.x, o[8 * i + 2 * j]); o[8 * i + 2 * j + 1] = fmaf(p, (float)hv.y, o[8 * i + 2 * j + 1]); } }
        if (__all(cum < -150.0f)) break;
    }
    bf16* yp = Y + row * SBW + h * HD;
#pragma unroll
    for (int i = 0; i < 8; ++i) { v4u w; w.x = pk2(o[8 * i], o[8 * i + 1]); w.y = pk2(o[8 * i + 2], o[8 * i + 3]); w.z = pk2(o[8 * i + 4], o[8 * i + 5]); w.w = pk2(o[8 * i + 6], o[8 * i + 7]); *(v4u*)(yp + 8 * i) = w; }
}
typedef _Float16 h8v __attribute__((ext_vector_type(8)));
typedef float f16v __attribute__((ext_vector_type(16)));
__device__ __forceinline__ void attn_mfma_unit(const _Float16* Qh, const _Float16* Kh, const _Float16* VT, bf16* Y, int b, int hd, int qb, int lane, h8v tri0, h8v tri1) {
    const int r = lane & 31, hh = lane >> 5, q0 = qb * 32;
    const _Float16* qrow = Qh + ((size_t)b * SEQ + q0 + r) * SBW + hd * HD + 8 * hh;
    h8v qf[4];
#pragma unroll
    for (int kd = 0; kd < 4; ++kd) qf[kd] = *(const h8v*)(qrow + 16 * kd);
    f16v o0, o1;
#pragma unroll
    for (int i = 0; i < 16; ++i) { o0[i] = 0.f; o1[i] = 0.f; }
    float carry = 0.f;
    const _Float16* kbase = Kh + ((size_t)b * SEQ + r) * SBW + hd * HD + 8 * hh;
    const _Float16* vbase = VT + ((size_t)b * SBW + hd * HD + r) * SEQ + 8 * hh;
    h8v kf[4], vf[2][2], kn[4], vn[2][2];
#pragma unroll
    for (int kd = 0; kd < 4; ++kd) kf[kd] = *(const h8v*)(kbase + (size_t)q0 * SBW + 16 * kd);
#pragma unroll
    for (int db = 0; db < 2; ++db)
#pragma unroll
        for (int ss = 0; ss < 2; ++ss) vf[db][ss] = *(const h8v*)(vbase + (size_t)(32 * db) * SEQ + q0 + 16 * ss);
    for (int key0 = q0; key0 >= 0; key0 -= 32) {
        { const int kn0 = key0 >= 32 ? key0 - 32 : key0;
#pragma unroll
          for (int kd = 0; kd < 4; ++kd) kn[kd] = *(const h8v*)(kbase + (size_t)kn0 * SBW + 16 * kd);
#pragma unroll
          for (int db = 0; db < 2; ++db)
#pragma unroll
              for (int ss = 0; ss < 2; ++ss) vn[db][ss] = *(const h8v*)(vbase + (size_t)(32 * db) * SEQ + kn0 + 16 * ss); }
        f16v z;
#pragma unroll
        for (int i = 0; i < 16; ++i) z[i] = 0.f;
#pragma unroll
        for (int kd = 0; kd < 4; ++kd) z = __builtin_amdgcn_mfma_f32_32x32x16_f16(kf[kd], qf[kd], z, 0, 0, 0);
        const bool diag = key0 == q0;
        h8v lh[2], ll[2];
#pragma unroll
        for (int i = 0; i < 16; ++i) { const int koff = (i & 3) + 8 * (i >> 2) + 4 * hh; const bool act = !diag || koff < r;
            const float zi = z[i]; const float t1 = flog2(1.0f + fexp2(-fabsf(zi)));
            const float L = act ? fmaxf(-(fmaxf(zi, 0.f) + t1), -60000.0f) : 0.f;
            const _Float16 hi = (_Float16)L; const _Float16 lo = (_Float16)(L - (float)hi);
            lh[i >> 3][i & 7] = hi; ll[i >> 3][i & 7] = lo; }
        f16v cum;
#pragma unroll
        for (int i = 0; i < 16; ++i) cum[i] = carry;
        cum = __builtin_amdgcn_mfma_f32_32x32x16_f16(tri0, lh[0], cum, 0, 0, 0);
        cum = __builtin_amdgcn_mfma_f32_32x32x16_f16(tri1, lh[1], cum, 0, 0, 0);
        cum = __builtin_amdgcn_mfma_f32_32x32x16_f16(tri0, ll[0], cum, 0, 0, 0);
        cum = __builtin_amdgcn_mfma_f32_32x32x16_f16(tri1, ll[1], cum, 0, 0, 0);
        h8v pf[2];
#pragma unroll
        for (int i = 0; i < 16; ++i) { const int koff = (i & 3) + 8 * (i >> 2) + 4 * hh; const bool act = !diag || koff < r;
            const float p = act ? fexp2(z[i] + cum[i]) : 0.f; pf[i >> 3][i & 7] = (_Float16)p; }
        o0 = __builtin_amdgcn_mfma_f32_32x32x16_f16(vf[0][0], pf[0], o0, 0, 0, 0);
        o0 = __builtin_amdgcn_mfma_f32_32x32x16_f16(vf[0][1], pf[1], o0, 0, 0, 0);
        o1 = __builtin_amdgcn_mfma_f32_32x32x16_f16(vf[1][0], pf[0], o1, 0, 0, 0);
        o1 = __builtin_amdgcn_mfma_f32_32x32x16_f16(vf[1][1], pf[1], o1, 0, 0, 0);
        carry = __shfl(cum[0], r);
        if (__all(carry < -150.0f)) break;
#pragma unroll
        for (int kd = 0; kd < 4; ++kd) kf[kd] = kn[kd];
#pragma unroll
        for (int db = 0; db < 2; ++db)
#pragma unroll
            for (int ss = 0; ss < 2; ++ss) vf[db][ss] = vn[db][ss];
    }
    bf16* yp = Y + ((size_t)b * SEQ + q0 + r) * SBW + hd * HD + 4 * hh;
#pragma unroll
    for (int g4 = 0; g4 < 4; ++g4) { v2u w0, w1; w0.x = pk2(o0[4 * g4], o0[4 * g4 + 1]); w0.y = pk2(o0[4 * g4 + 2], o0[4 * g4 + 3]); w1.x = pk2(o1[4 * g4], o1[4 * g4 + 1]); w1.y = pk2(o1[4 * g4 + 2], o1[4 * g4 + 3]);
        *(v2u*)(yp + 8 * g4) = w0; *(v2u*)(yp + 32 + 8 * g4) = w1; }
}
__device__ __forceinline__ void attn_one(Frame& F, int u) {
    const _Float16* Qh = (const _Float16*)(F.ws + WS_Q); const _Float16* Kh = (const _Float16*)(F.ws + WS_K); const _Float16* VT = (const _Float16*)(F.ws + WS_V);
    bf16* Y = (bf16*)(F.ws + WS_YSB);
    constexpr int NQB = SEQ / 32;
    const int lane = F.lane, r = lane & 31, hh = lane >> 5;
    h8v tri0, tri1;
#pragma unroll
    for (int e = 0; e < 8; ++e) { const int k0 = 8 * (e >> 2) + 4 * hh + (e & 3); tri0[e] = (k0 >= r) ? (_Float16)1.0f : (_Float16)0.0f; tri1[e] = (16 + k0 >= r) ? (_Float16)1.0f : (_Float16)0.0f; }
    const int qb = u % NQB, bh = u / NQB; attn_mfma_unit(Qh, Kh, VT, Y, bh / NH, bh % NH, qb, lane, tri0, tri1);
}

__device__ __forceinline__ void scan_phase(Frame& F) {
    const int task = F.vcu;
    const int b = task / NG, g = task % NG, p = F.lane;
    const float* lamL = (const float*)(F.ws + WS_LAML); const float* S = (const float*)(F.ws + WS_SLOC); bf16* U = (bf16*)(F.ws + WS_UCAT);
    const float lr = lamL[(g * 2 + 0) * NP + p], li = lamL[(g * 2 + 1) * NP + p];
    float xr = 0.f, xi = 0.f;
    for (int c0 = 0; c0 < CPB; c0 += 8) {
        float sr[8], si[8];
#pragma unroll
        for (int j = 0; j < 8; ++j) { const size_t base = ((size_t)(b * CPB + c0 + j) * NG + g) * 128; sr[j] = S[base + p]; si[j] = S[base + 64 + p]; }
#pragma unroll
        for (int j = 0; j < 8; ++j) { bf16* dst = U + ((size_t)(b * CPB + c0 + j) * NG + g) * UK + 512;
            dst[p] = (bf16)f2bf(xr); dst[64 + p] = (bf16)f2bf(xi);
            const float nr = lr * xr - li * xi + sr[j], ni = lr * xi + li * xr + si[j]; xr = nr; xi = ni; }
    }
}

__device__ __forceinline__ void mix_phase(Frame& F) {
    const bf16* YSB = (const bf16*)(F.ws + WS_YSB); const bf16* YSSM = (const bf16*)(F.ws + WS_YSSM); bf16* MX = (bf16*)(F.ws + WS_MIXED);
    const float* g_sb = F.in[12]; const float* g_ssm = F.in[13];
    const int gw = F.vcu * NWAVES + F.wave, NGW = F.G * NWAVES, lane = F.lane;
    f32x4 ga[2], gb[2];
#pragma unroll
    for (int j = 0; j < 2; ++j) { ga[j] = *(const f32x4*)(g_sb + 8 * lane + 4 * j); gb[j] = *(const f32x4*)(g_ssm + 8 * lane + 4 * j); }
    for (int m = gw; m < M; m += NGW) {
        const v4u a = *(const v4u*)(YSB + (size_t)m * SBW + 8 * lane), c = *(const v4u*)(YSSM + (size_t)m * SSW + 8 * lane);
        float av[8], cv[8]; float sa = 0.f, sc = 0.f;
#pragma unroll
        for (int j = 0; j < 4; ++j) { av[2 * j] = bflo(a[j]); av[2 * j + 1] = bfhi(a[j]); cv[2 * j] = bflo(c[j]); cv[2 * j + 1] = bfhi(c[j]); }
#pragma unroll
        for (int j = 0; j < 8; ++j) { sa += av[j] * av[j]; sc += cv[j] * cv[j]; }
        const float ra = 1.0f / sqrtf(wave_sum(sa) * (1.f / SBW) + EPS), rc = 1.0f / sqrtf(wave_sum(sc) * (1.f / SSW) + EPS);
        v4u oa, oc;
#pragma unroll
        for (int j = 0; j < 4; ++j) { oa[j] = pk2(av[2 * j] * ra * ga[j >> 1][(2 * j) & 3], av[2 * j + 1] * ra * ga[j >> 1][(2 * j + 1) & 3]);
                                      oc[j] = pk2(cv[2 * j] * rc * gb[j >> 1][(2 * j) & 3], cv[2 * j + 1] * rc * gb[j >> 1][(2 * j + 1) & 3]); }
        if (DBG_MODE == 3) oa = (v4u){0u, 0u, 0u, 0u};
        if (DBG_MODE == 2) oc = (v4u){0u, 0u, 0u, 0u};
        *(v4u*)(MX + (size_t)m * D + 8 * lane) = oa; *(v4u*)(MX + (size_t)m * D + SBW + 8 * lane) = oc;
    }
}

__device__ __forceinline__ void router_phase(Frame& F) {
    typedef short s8v __attribute__((ext_vector_type(8)));
    typedef float f16v __attribute__((ext_vector_type(16)));
    LAS bf16* wh = (LAS bf16*)F.lds; LAS bf16* wl = wh + NE * RT_WSTR;
    LAS int* lcnt = (LAS int*)(F.lds + RT_SCR_OFF); LAS int* lbase = lcnt + 32; LAS int* asg = lbase + 32;
    const float* wr = F.in[16]; const float* br = F.in[17]; const float* g2 = F.in[15];
    const float* X1 = F.out; bf16* XG = (bf16*)(F.ws + WS_XN); float* gates = (float*)(F.ws + WS_GATES); int* lists = (int*)(F.ws + WS_LISTS); float* RS = (float*)(F.ws + WS_RSTD);
    unsigned* gcnt = (unsigned*)(F.ctl + CW_CNT);
    const int tid = F.tid, lane = F.lane, r = lane & 31, hh = lane >> 5;
    for (int idx = tid; idx < D * NE; idx += NWAVES * 64) { const float w = wr[idx]; const unsigned h = f2bf(w); const unsigned l = f2bf(w - bf2f((unsigned short)h)); const int k = idx >> 5, e = idx & 31;
        wh[e * RT_WSTR + k] = (bf16)h; wl[e * RT_WSTR + k] = (bf16)l; }
    if (tid < 32) lcnt[tid] = 0;
    __syncthreads();
    const int task = F.wave >> 2, kq = F.wave & 3; const int tok = F.vcu * 64 + task * 32 + r;
    f16v acc;
#pragma unroll
    for (int i = 0; i < 16; ++i) acc[i] = 0.f;
    float ss = 0.f;
    const float* xp = X1 + (size_t)tok * D + kq * 256 + 8 * hh; const float* gp = g2 + kq * 256 + 8 * hh; bf16* xo = XG + (size_t)tok * D + kq * 256 + 8 * hh;
    const LAS bf16* whp = wh + r * RT_WSTR + kq * 256 + 8 * hh; const LAS bf16* wlp = wl + r * RT_WSTR + kq * 256 + 8 * hh;
#pragma unroll 4
    for (int ks = 0; ks < 16; ++ks) {
        const f32x4 x0 = *(const f32x4*)(xp + 16 * ks), x1 = *(const f32x4*)(xp + 16 * ks + 4), g0 = *(const f32x4*)(gp + 16 * ks), g1 = *(const f32x4*)(gp + 16 * ks + 4);
        ss += (x0.x * x0.x + x0.y * x0.y) + (x0.z * x0.z + x0.w * x0.w) + (x1.x * x1.x + x1.y * x1.y) + (x1.z * x1.z + x1.w * x1.w);
        const f32x4 a0 = x0 * g0, a1 = x1 * g1;
        v4u hv, lv;
        hv.x = pg8::cvt_pk_bf16(a0.x, a0.y); hv.y = pg8::cvt_pk_bf16(a0.z, a0.w); hv.z = pg8::cvt_pk_bf16(a1.x, a1.y); hv.w = pg8::cvt_pk_bf16(a1.z, a1.w);
        lv.x = pg8::cvt_pk_bf16(a0.x - bflo(hv.x), a0.y - bfhi(hv.x)); lv.y = pg8::cvt_pk_bf16(a0.z - bflo(hv.y), a0.w - bfhi(hv.y));
        lv.z = pg8::cvt_pk_bf16(a1.x - bflo(hv.z), a1.y - bfhi(hv.z)); lv.w = pg8::cvt_pk_bf16(a1.z - bflo(hv.w), a1.w - bfhi(hv.w));
        *(v4u*)(xo + 16 * ks) = hv;
        const s8v xh = __builtin_bit_cast(s8v, hv), xl = __builtin_bit_cast(s8v, lv);
        v4u ah, al; { const LAS v2u* p = (const LAS v2u*)(whp + 16 * ks); const v2u q0 = p[0], q1 = p[1]; ah.x = q0.x; ah.y = q0.y; ah.z = q1.x; ah.w = q1.y; }
        { const LAS v2u* p = (const LAS v2u*)(wlp + 16 * ks); const v2u q0 = p[0], q1 = p[1]; al.x = q0.x; al.y = q0.y; al.z = q1.x; al.w = q1.y; }
        const s8v wa = __builtin_bit_cast(s8v, ah), wb = __builtin_bit_cast(s8v, al);
        acc = __builtin_amdgcn_mfma_f32_32x32x16_bf16(wa, xh, acc, 0, 0, 0);
        acc = __builtin_amdgcn_mfma_f32_32x32x16_bf16(wb, xh, acc, 0, 0, 0);
        acc = __builtin_amdgcn_mfma_f32_32x32x16_bf16(wa, xl, acc, 0, 0, 0);
    }
    __syncthreads();
    LAS float* part = (LAS float*)F.lds;
#pragma unroll
    for (int i = 0; i < 16; ++i) part[(F.wave * 17 + i) * 64 + lane] = acc[i];
    part[(F.wave * 17 + 16) * 64 + lane] = ss;
    __syncthreads();
    if (kq == 0) {
        float v[32]; float st = 0.f;
#pragma unroll
        for (int w = 0; w < 4; ++w) { const LAS float* pw = part + (size_t)((task * 4 + w) * 17) * 64;
#pragma unroll
            for (int i = 0; i < 16; ++i) { const float t = pw[i * 64 + lane]; v[i] = w == 0 ? t : v[i] + t; }
            st += pw[16 * 64 + lane] + pw[16 * 64 + (lane ^ 32)]; }
        const float rstd = 1.0f / sqrtf(st * (1.f / D) + EPS);
        if (hh == 0) RS[tok] = rstd;
#pragma unroll
        for (int i = 0; i < 16; ++i) { const int e = (i & 3) + 8 * (i >> 2) + 4 * hh; v[i] = v[i] * rstd + br[e]; }
#pragma unroll
        for (int i = 0; i < 16; ++i) v[16 + i] = __shfl_xor(v[i], 32);
        float mx = v[0];
#pragma unroll
        for (int i = 1; i < 32; ++i) mx = fmaxf(mx, v[i]);
        int rk[16]; float es = 0.f;
#pragma unroll
        for (int i = 0; i < 16; ++i) { const int ei = (i & 3) + 8 * (i >> 2) + 4 * hh; int rank = 0;
#pragma unroll
            for (int j = 0; j < 32; ++j) { if (j == i) continue; const int ej = (j & 3) + 8 * ((j & 15) >> 2) + 4 * (j < 16 ? hh : 1 - hh);
                rank += (v[j] > v[i] || (v[j] == v[i] && ej < ei)) ? 1 : 0; }
            rk[i] = rank; if (rank < TOPK) es += fexp2((v[i] - mx) * LOG2E); }
        es += __shfl_xor(es, 32);
        const float inv = 1.0f / es;
#pragma unroll
        for (int i = 0; i < 16; ++i) if (rk[i] < TOPK) { const int ei = (i & 3) + 8 * (i >> 2) + 4 * hh;
            gates[tok * TOPK + rk[i]] = fexp2((v[i] - mx) * LOG2E) * inv;
            const int pos = __hip_atomic_fetch_add(lcnt + ei, 1, __ATOMIC_RELAXED, __HIP_MEMORY_SCOPE_WORKGROUP);
            asg[(task * 32 + r) * 4 + rk[i]] = ei | (pos << 8); }
    }
    __syncthreads();
    if (tid < 32) lbase[tid] = (int)__hip_atomic_fetch_add(gcnt + tid, (unsigned)lcnt[tid], RLX_AGENT);
    __syncthreads();
    if (tid < 64 * TOPK) { const int a = asg[tid], e = a & 255, pos = a >> 8; const int tk = F.vcu * 64 + (tid >> 2);
        lists[e * M + lbase[e] + pos] = tk * TOPK + (tid & 3); }
    __syncthreads();
}

__device__ __forceinline__ void moe_tables(Frame& F) {
    LAS int* tab = (LAS int*)(F.lds + TAB_OFF); LAS int* cnt = tab, * mt = tab + 32, * tbase = tab + 64;
    unsigned* gcnt = (unsigned*)(F.ctl + CW_CNT);
    if (F.tid < 32) { const int c = (int)__hip_atomic_load(gcnt + F.tid, RLX_AGENT); cnt[F.tid] = c; mt[F.tid] = (c + 255) >> 8; }
    __syncthreads();
    if (F.tid == 0) { int s = 0; for (int e = 0; e < NE; ++e) { tbase[e] = s; s += mt[e]; } tbase[NE] = s; }
    __syncthreads();
}
__device__ __forceinline__ void moe_units(Frame& F, int npn, int gpn) {
    LAS int* tab = (LAS int*)(F.lds + TAB_OFF); LAS int* mt = tab + 32, * tbase = tab + 64; LAS int* units = (LAS int*)(F.lds + UNITS_OFF);
    if (F.tid < 32) {
        const int nU = tbase[NE] * npn; const int L = F.tid * F.G + (int)blockIdx.x; int pm = 0, pn = 0, e = 0, valid = 0;
        if (L < nU) { const int seq = pg8::xcd_remap(L, nU); int ee = 0; while (ee < NE - 1 && seq >= tbase[ee + 1] * npn) ++ee;
            const int r = seq - tbase[ee] * npn, m = mt[ee]; const int grp = r / (m * gpn), r2 = r % (m * gpn);
            e = ee; pn = grp * gpn + r2 / m; pm = tbase[ee] + r2 % m; valid = 1; }
        units[4 * F.tid + 0] = pm; units[4 * F.tid + 1] = pn; units[4 * F.tid + 2] = e; units[4 * F.tid + 3] = valid;
    }
    __syncthreads();
}

__device__ __forceinline__ void gather_phase(Frame& F) {
    LAS int* tab = (LAS int*)(F.lds + TAB_OFF); LAS int* cnt = tab, * tbase = tab + 64; LAS int* tile_e = (LAS int*)(F.lds + TILEE_OFF);
    const int ntiles = tbase[NE];
    for (int t = F.tid; t < ntiles; t += NWAVES * 64) { int ee = 0; while (ee < NE - 1 && t >= tbase[ee + 1]) ++ee; tile_e[t] = ee; }
    __syncthreads();
    const bf16* XN = (const bf16*)(F.ws + WS_XN); bf16* XS = (bf16*)(F.ws + WS_XS); const float* gates = (const float*)(F.ws + WS_GATES); const int* lists = (const int*)(F.ws + WS_LISTS);
    int* rowinfo = (int*)(F.ws + WS_ROWINFO); const float* RS = (const float*)(F.ws + WS_RSTD);
    const int gw = F.vcu * NWAVES + F.wave, NGW = F.G * NWAVES, lane = F.lane;
    for (int r = gw; r < ntiles * 256; r += NGW) {
        const int e = tile_e[r >> 8], i = r - tbase[e] * 256;
        v4u a0 = (v4u){0u, 0u, 0u, 0u}, a1 = a0; int slot = -1; float gate = 0.f, rs = 0.f;
        if (i < cnt[e]) { slot = lists[e * M + i]; gate = gates[slot]; rs = RS[slot >> 2]; const v4u* src = (const v4u*)(XN + (size_t)(slot >> 2) * D); a0 = src[lane]; a1 = src[64 + lane]; }
        v4u* dst = (v4u*)(XS + (size_t)r * D); dst[lane] = a0; dst[64 + lane] = a1;
        if (lane == 0) { *(v4u*)(rowinfo + 4 * r) = (v4u){(unsigned)slot, __builtin_bit_cast(unsigned, gate), __builtin_bit_cast(unsigned, rs), 0u}; }
    }
}

__device__ __forceinline__ void final_phase(Frame& F) {
    const bf16* YB = (const bf16*)(F.ws + WS_YBUF); const float* gf = F.in[24]; float* O = F.out;
    const int gw = F.vcu * NWAVES + F.wave, NGW = F.G * NWAVES, lane = F.lane;
    f32x4 gg[4];
#pragma unroll
    for (int j = 0; j < 4; ++j) gg[j] = *(const f32x4*)(gf + 4 * lane + 256 * j);
    for (int m = gw; m < M; m += NGW) {
        f32x4 v[4]; float ss = 0.f;
#pragma unroll
        for (int j = 0; j < 4; ++j) { v[j] = *(const f32x4*)(O + (size_t)m * D + 4 * lane + 256 * j);
#pragma unroll
            for (int k = 0; k < (DBG_MODE ? 0 : TOPK); ++k) { const v2u w = *(const v2u*)(YB + ((size_t)m * TOPK + k) * D + 4 * lane + 256 * j); v[j].x += bflo(w.x); v[j].y += bfhi(w.x); v[j].z += bflo(w.y); v[j].w += bfhi(w.y); }
            ss += (v[j].x * v[j].x + v[j].y * v[j].y) + (v[j].z * v[j].z + v[j].w * v[j].w); }
        const float rstd = 1.0f / sqrtf(wave_sum(ss) * (1.f / D) + EPS);
#pragma unroll
        for (int j = 0; j < 4; ++j) *(f32x4*)(O + (size_t)m * D + 4 * lane + 256 * j) = v[j] * rstd * gg[j];
    }
}

struct Args { const float* in[25]; float* out; unsigned char* ws; int ph_lo, ph_hi, li, pad; };
__global__ void __launch_bounds__(NWAVES * 64, 2) hyb_fwd(Args args) {
    extern __shared__ __attribute__((aligned(16))) unsigned char lds[];
    Frame F;
    F.lds = (LAS unsigned char*)lds;
    F.MISC = (volatile LAS unsigned*)(F.lds + MISC_OFF);
    F.tid = threadIdx.x; F.lane = F.tid & 63; F.wave = __builtin_amdgcn_readfirstlane(F.tid >> 6);
    F.G = gridDim.x; { const int bx = blockIdx.x; F.vcu = (F.G % 8 == 0) ? (bx % 8) * (F.G / 8) + bx / 8 : bx; }
    F.ws = args.ws; F.ctl = (gu32*)(args.ws + WS_CTL); F.out = args.out;
#pragma unroll
    for (int i = 0; i < 25; ++i) F.in[i] = args.in[i];
    for (int u = F.tid; u < (LDS_BYTES - LDSCTL_OFF) / 4; u += NWAVES * 64) ((LAS unsigned*)(F.lds + LDSCTL_OFF))[u] = 0u;
    __syncthreads();
    XcdBarrier bar; bar.bar = (unsigned*)(F.ctl + CW_BAR); bar.x = 0; bar.st = nullptr;
    if (N_LAUNCHES != PER_PHASE) bar = xcd_barrier_post((unsigned*)(F.ctl + CW_BAR), F.MISC + 8);
#define GRID_BAR(seam) do { if (N_LAUNCHES == PER_PHASE) { if (F.tid == 0) __hip_atomic_store(F.ctl + CW_TMO, 0xBADBA0u | (unsigned)(seam), RLX_AGENT); } else { xcd_barrier(bar); } } while (0)
    const int lo = args.ph_lo, hi = args.ph_hi;
#define IN(k) (lo <= (k) && (k) < hi)
#define BOTH(k) (IN(k) && IN((k) + 1))
    const pg8::bf16_t* wsb = (const pg8::bf16_t*)args.ws;
#define WSB(off) ((const pg8::bf16_t*)(args.ws + (off)))

    unsigned long long t_lo_ = 0, t_hi_ = 0;
    TMARK(0);
    if (IN(0)) for (int rep_ = 0; rep_ < NREP(0); ++rep_) { p0_prologue(F, t_lo_, t_hi_); if (BOTH(0)) GRID_BAR(0); }

    TMARK(1);
    if (IN(1)) for (int rep_ = 0; rep_ < NREP(1); ++rep_) {
        pg8::Gemm g = pg8::make_gemm(WSB(WS_HN), WSB(WS_WINT), D, D, D); InProjOrder S{F.G, (int)blockIdx.x};
        EpiInProj E{(unsigned short*)(args.ws + WS_Q), (bf16*)(args.ws + WS_UCAT), LOG2E * 0.125f};
        pg8::gemm_phase<EpiInProj, InProjOrder, PG8_ALIGN, PG8_SP2>(F.lds + RING_OFF, g, S, E);
        if (BOTH(1)) GRID_BAR(1);
    }
    TMARK(2);
    if (IN(2)) for (int rep_ = 0; rep_ < NREP(2); ++rep_) {
        pg8::Gemm g = pg8::make_gemm(WSB(WS_UCAT), WSB(WS_WE), NG * UK, 512, 512); SsmOrder S{NG * 2, F.G, (int)blockIdx.x, 1, 128, 512};
        EpiSloc E{(float*)(args.ws + WS_SLOC)};
        pg8::gemm_phase<EpiSloc, SsmOrder, PG8_ALIGN, PG8_SP2>(F.lds + RING_OFF, g, S, E);
        if (blockIdx.x >= NG * 2) attn_one(F, ((int)blockIdx.x - NG * 2) * 8 + F.wave);
        if (BOTH(2)) GRID_BAR(2);
    }
    TMARK(3);
    if (IN(3)) for (int rep_ = 0; rep_ < NREP(3); ++rep_) {
        if (F.vcu < BATCH * NG) { if (F.wave == 0) scan_phase(F); else attn_one(F, 3072 + F.vcu * 7 + F.wave - 1); }
        else attn_one(F, 1536 + (F.vcu - BATCH * NG) * 8 + F.wave);
        if (BOTH(3)) GRID_BAR(3); }
    TMARK(4);
    if (IN(4)) for (int rep_ = 0; rep_ < NREP(4); ++rep_) {
        pg8::Gemm g = pg8::make_gemm(WSB(WS_UCAT), WSB(WS_TW), NG * UK, UK, UK); SsmOrder S{NG * 4, F.G, (int)blockIdx.x, 2, 512, UK};
        EpiS3 E{(bf16*)(args.ws + WS_YG)};
        pg8::gemm_phase<EpiS3, SsmOrder, PG8_ALIGN, PG8_SP2>(F.lds + RING_OFF, g, S, E);
        if (blockIdx.x >= NG * 4 && blockIdx.x < NG * 4 + 72) attn_one(F, 3520 + ((int)blockIdx.x - NG * 4) * 8 + F.wave);
        if (BOTH(4)) GRID_BAR(4);
    }
    TMARK(5);
    if (IN(5)) for (int rep_ = 0; rep_ < NREP(5); ++rep_) {
        pg8::Gemm g = pg8::make_gemm(WSB(WS_YG), WSB(WS_WGLUT), SSW, SSW, SSW); pg8::StaticOrder S; S.init(M, 2 * SSW, F.G, (int)blockIdx.x, SSW, SSW);
        EpiGlu E{(bf16*)(args.ws + WS_YSSM)};
        pg8::gemm_phase<EpiGlu, pg8::StaticOrder, PG8_ALIGN, PG8_SP2>(F.lds + RING_OFF, g, S, E);
        if (BOTH(5)) GRID_BAR(5);
    }
    TMARK(6);
    if (IN(6)) for (int rep_ = 0; rep_ < NREP(6); ++rep_) { mix_phase(F); if (BOTH(6)) GRID_BAR(6); }
    TMARK(7);
    if (IN(7)) for (int rep_ = 0; rep_ < NREP(7); ++rep_) {
        pg8::Gemm g = pg8::make_gemm(WSB(WS_MIXED), WSB(WS_WOUTT), D, D, D); pg8::StaticOrder S; S.init(M, D, F.G, (int)blockIdx.x, D, D);
        EpiOutProj E{F.in[0], F.out};
        pg8::gemm_phase<EpiOutProj, pg8::StaticOrder, PG8_ALIGN, PG8_SP2>(F.lds + RING_OFF, g, S, E);
        if (BOTH(7)) GRID_BAR(7);
    }
    TMARK(8);
    if (IN(8) && !DBG_MODE) for (int rep_ = 0; rep_ < NREP(8); ++rep_) { router_phase(F); if (BOTH(8)) GRID_BAR(8); }
    TMARK(9);
    if (IN(9) && !DBG_MODE) for (int rep_ = 0; rep_ < NREP(9); ++rep_) { moe_tables(F); gather_phase(F); if (BOTH(9)) GRID_BAR(9); }
    TMARK(10);
    if (IN(10) && !DBG_MODE) for (int rep_ = 0; rep_ < NREP(10); ++rep_) {
        moe_tables(F); moe_units(F, 8, 4);
        pg8::Gemm g = pg8::make_gemm(WSB(WS_XS), WSB(WS_W1T), D, D, D); g.brs = 16u; g.bks = 2u * FF * 16u; MoeOrder S{(const LAS int*)(F.lds + UNITS_OFF), (long)2 * FF * D * 2};
        EpiMoe1 E{(bf16*)(args.ws + WS_H), F.in[19], F.in[21], (const int*)(args.ws + WS_ROWINFO)};
        pg8::gemm_phase<EpiMoe1, MoeOrder, PG8_ALIGN, PG8_SP2>(F.lds + RING_OFF, g, S, E);
        if (BOTH(10)) GRID_BAR(10);
    }
    TMARK(11);
    if (IN(11) && !DBG_MODE) for (int rep_ = 0; rep_ < NREP(11); ++rep_) {
        moe_tables(F); moe_units(F, 4, 4);
        pg8::Gemm g = pg8::make_gemm(WSB(WS_H), WSB(WS_W2T), FF, FF, FF); g.brs = 16u; g.bks = (unsigned)D * 16u; MoeOrder S{(const LAS int*)(F.lds + UNITS_OFF), (long)D * FF * 2};
        EpiMoe2 E{(bf16*)(args.ws + WS_YBUF), F.in[23], (const int*)(args.ws + WS_ROWINFO)};
        pg8::gemm_phase<EpiMoe2, MoeOrder, PG8_ALIGN, PG8_SP2>(F.lds + RING_OFF, g, S, E);
        if (BOTH(11)) GRID_BAR(11);
    }
    TMARK(12);
    if (IN(12)) for (int rep_ = 0; rep_ < NREP(12); ++rep_) { final_phase(F); }
    TMARK(13);
    if ((TIME_LO) >= 0 && blockIdx.x == (TIME_BLK) && F.tid == 0) { const unsigned long long te = __builtin_amdgcn_s_memrealtime(), dt = 4ull * (t_hi_ - t_lo_); while (__builtin_amdgcn_s_memrealtime() - te < dt) __builtin_amdgcn_s_sleep(32); }
    (void)wsb;
#undef IN
#undef BOTH
}

extern "C" void kernel_launch(void* const* d_in, const int* in_sizes, int n_in, void* d_out, int out_size, void* d_ws, size_t ws_size, hipStream_t stream) {
    static int grid = 0;
    if (grid == 0) {
        if (n_in != 25 || in_sizes[0] != M * D || out_size != M * D || ws_size < WS_END) { fprintf(stderr, "kernel_launch: unexpected shapes: n_in %d in0 %d out %d ws %zu (need %zu); nothing launched\n", n_in, n_in > 0 ? in_sizes[0] : -1, out_size, ws_size, (size_t)WS_END); grid = -1; return; }
        int dev = 0, cus = 0, per_cu = 0;
        if (hipGetDevice(&dev) != hipSuccess || hipDeviceGetAttribute(&cus, hipDeviceAttributeMultiprocessorCount, dev) != hipSuccess) { grid = -1; return; }
        if (hipFuncSetAttribute((const void*)hyb_fwd, hipFuncAttributeMaxDynamicSharedMemorySize, LDS_BYTES) != hipSuccess) { fprintf(stderr, "kernel_launch: hipFuncSetAttribute failed\n"); grid = -1; return; }
        if (hipOccupancyMaxActiveBlocksPerMultiprocessor(&per_cu, (const void*)hyb_fwd, NWAVES * 64, LDS_BYTES) != hipSuccess || per_cu < 1)
            fprintf(stderr, "kernel_launch: note: occupancy query reports %d workgroups per CU\n", per_cu);
        (void)hipGetLastError();
        grid = cus;
        if (grid != 256) fprintf(stderr, "kernel_launch: note: %d CUs (built for 256)\n", grid);
    }
    if (grid < 0) return;
    if (hipMemsetAsync((char*)d_ws + WS_CTL, 0, CTL_ZERO_BYTES, stream) != hipSuccess) { fprintf(stderr, "kernel_launch: memset failed\n"); return; }
    Args a{};
    for (int i = 0; i < 25; ++i) a.in[i] = (const float*)d_in[i];
    a.out = (float*)d_out; a.ws = (unsigned char*)d_ws;
    for (int li = 0; li < N_LAUNCHES; ++li) {
        a.ph_lo = (N_LAUNCHES == PER_PHASE) ? li : 0; a.ph_hi = (N_LAUNCHES == PER_PHASE) ? li + 1 : PER_PHASE; a.li = li;
        hipLaunchKernelGGL(hyb_fwd, dim3(grid), dim3(NWAVES * 64), LDS_BYTES, stream, a);
        const hipError_t le = hipPeekAtLastError();
        if (le != hipSuccess) { fprintf(stderr, "kernel_launch: launch %d failed: %s\n", li, hipGetErrorName(le)); break; }
    }
}
```

```cpp
#include <hip/hip_runtime.h>
#include <cstdio>
#include <cstdint>
namespace pg8 {
#define PG8_LAS __attribute__((address_space(3)))
typedef unsigned short bf16_t;
typedef short bf16x8 __attribute__((ext_vector_type(8)));
typedef float f32x4 __attribute__((ext_vector_type(4)));
typedef unsigned u32x4 __attribute__((ext_vector_type(4)));
constexpr int BM = 256, BK = 64, HALF = 128, HTB = HALF * BK * 2  , STAGE_BYTES = 8 * HTB, NXCD = 8, WGM = 8;

__host__ __device__ __forceinline__ int lds_byte(int r, int c) { const int st = (r >> 4) * 2 + (c >> 5), rr = r & 15, cc = c & 31, ob = rr * 64 + cc * 2; return st * 1024 + (ob ^ (((ob >> 9) & 1) << 5)); }
__host__ __device__ __forceinline__ void stage_rc(int b, int& R, int& C) { const int st = b / 1024, sb = b % 1024, swz = sb ^ (((sb >> 9) & 1) << 5); R = (st >> 1) * 16 + swz / 64; C = (st & 1) * 32 + (swz % 64) / 2; }
__host__ __device__ __forceinline__ int perm32(int rho) { const int n = rho >> 4, i = rho & 15; return 8 * (i >> 2) + 4 * n + (i & 3); }

struct Unit { int pm, pn, e; long offA, offB; };
struct Gemm { const bf16_t* A; const bf16_t* Bt; int lda, K; unsigned brs, bks; };
__host__ __device__ __forceinline__ Gemm make_gemm(const bf16_t* A, const bf16_t* Bt, int lda, int ldb, int K) { Gemm g; g.A = A; g.Bt = Bt; g.lda = lda; g.K = K; g.brs = (unsigned)ldb * 2u; g.bks = 16u; return g; }

__host__ __device__ __forceinline__ int xcd_remap(int wgid, int nwg) { const int q = nwg / NXCD, r = nwg % NXCD, xcd = wgid % NXCD, off = wgid / NXCD; return (xcd < r ? xcd * (q + 1) : r * (q + 1) + (xcd - r) * q) + off; }

struct StaticOrder {
    int nM, nN, nwg, G, c, lda, ldb;
    __host__ __device__ void init(int M, int N, int G_, int c_, int lda_, int ldb_) { nM = M / BM; nN = N / BM; nwg = nM * nN; G = G_; c = c_; lda = lda_; ldb = ldb_; }
    __host__ __device__ bool next(int i, Unit& u) const {
        const long L = (long)i * G + c; if (L >= nwg) return false;
        const int wgid = xcd_remap((int)L, nwg);
        const int nig = WGM * nN, gid = wgid / nig, fm = gid * WGM, gsz = (nM - fm) < WGM ? (nM - fm) : WGM;
        u.pm = fm + ((wgid % nig) % gsz); u.pn = (wgid % nig) / gsz; u.e = 0;
        u.offA = (long)u.pm * BM * lda * 2; u.offB = (long)u.pn * BM * ldb * 2; return true;
    }
    __device__ __forceinline__ void a_ready(const Unit&) const {}
    __device__ __forceinline__ void done(const Unit&) const {}
};

__device__ __forceinline__ unsigned cvt_pk_bf16(float lo, float hi) { unsigned r; asm volatile("v_cvt_pk_bf16_f32 %0, %1, %2" : "=v"(r) : "v"(lo), "v"(hi)); return r; }
typedef float f32x2 __attribute__((ext_vector_type(2)));

template <class Epi, class Sched, bool ALIGN_EPI = false, bool SP2 = false>
__device__ __forceinline__ void gemm_phase(PG8_LAS unsigned char* lds, const Gemm g, const Sched& S, const Epi& E) {
    const int tid = threadIdx.x, wid = __builtin_amdgcn_readfirstlane(tid >> 6), lane = tid & 63, wr = wid >> 2, wc = wid & 3, fr = lane & 15, fq = lane >> 4;
    const int K = g.K, nt = K / BK;
    unsigned voffA[2], voffB[2];
#pragma unroll
    for (int i = 0; i < 2; ++i) { int R, C; stage_rc(tid * 16 + i * 8192, R, C); const int Rb = Epi::PERM ? ((R & ~31) + perm32(R & 31)) : R;
        voffA[i] = (unsigned)(R * g.lda + C) * 2u; voffB[i] = (unsigned)Rb * g.brs + (unsigned)(C >> 3) * g.bks; }
    const size_t kstepA = (size_t)(BK * 2), kstepB = (size_t)8 * g.bks;
    const size_t hstepA = (size_t)HALF * g.lda * 2, hstepB = (size_t)HALF * g.brs;
    const unsigned ldsw = (unsigned)wid * 1024u;
    const int aoff = lds_byte(wr * 64 + fr, fq * 8), boff = lds_byte(wc * 32 + fr, fq * 8);
#define PG8_SA(b, h) (((b) * 2 + (h)) * HTB)
#define PG8_SB(b, h) ((4 + (b) * 2 + (h)) * HTB)
#define PG8_STAGE(bufoff, gbase, voff) do { _Pragma("unroll") for (int _i = 0; _i < 2; ++_i) \
        __builtin_amdgcn_global_load_lds((const unsigned*)((const char*)(gbase) + (voff)[_i]), (PG8_LAS unsigned*)(lds + (bufoff) + ldsw + _i * 8192), 16, 0, 0); } while (0)
#define PG8_LDA(dst, b, h) do { _Pragma("unroll") for (int m = 0; m < 4; ++m) _Pragma("unroll") for (int k = 0; k < 2; ++k) dst[m][k] = *(const PG8_LAS bf16x8*)(lds + PG8_SA(b, h) + aoff + m * 2048 + k * 1024); } while (0)
#define PG8_LDB(dst, b, h) do { _Pragma("unroll") for (int n = 0; n < 2; ++n) _Pragma("unroll") for (int k = 0; k < 2; ++k) dst[n][k] = *(const PG8_LAS bf16x8*)(lds + PG8_SB(b, h) + boff + n * 2048 + k * 1024); } while (0)
#define PG8_MMA(ai, bj, At, Bt) do { __builtin_amdgcn_s_setprio(1); _Pragma("unroll") for (int m = 0; m < 4; ++m) _Pragma("unroll") for (int n = 0; n < 2; ++n) _Pragma("unroll") for (int k = 0; k < 2; ++k) \
        acc[ai][bj][m][n] = __builtin_amdgcn_mfma_f32_16x16x32_bf16(Bt[n][k], At[m][k], acc[ai][bj][m][n], 0, 0, 0); __builtin_amdgcn_s_setprio(0); } while (0)
#define PG8_WAIT_V(n) asm volatile("s_waitcnt vmcnt(" #n ")" ::: "memory")
#define PG8_WAIT_L(n) asm volatile("s_waitcnt lgkmcnt(" #n ")" ::: "memory")
#define PG8_BAR __builtin_amdgcn_s_barrier()
#define PG8_SCHED __builtin_amdgcn_sched_barrier(0)
    Unit cur, nxt; int ui = 0;
    if (!S.next(0, cur)) return;
    f32x4 acc[2][2][4][2];
#pragma unroll
    for (int a = 0; a < 2; ++a)
#pragma unroll
        for (int b = 0; b < 2; ++b)
#pragma unroll
            for (int m = 0; m < 4; ++m)
#pragma unroll
                for (int n = 0; n < 2; ++n) acc[a][b][m][n] = (f32x4){0.f, 0.f, 0.f, 0.f};
    bf16x8 At[4][2], B0[2][2], B1[2][2];
    const char* cA = (const char*)g.A + cur.offA; const char* cB = (const char*)g.Bt + cur.offB;
    S.a_ready(cur);
    if constexpr (SP2) {
        PG8_STAGE(PG8_SB(0, 0), cB, voffB); PG8_STAGE(PG8_SB(0, 1), cB + hstepB, voffB); PG8_STAGE(PG8_SA(0, 0), cA, voffA); PG8_STAGE(PG8_SA(0, 1), cA + hstepA, voffA);
        if (wr == 1) PG8_BAR;
        PG8_WAIT_V(2); PG8_BAR;
        PG8_STAGE(PG8_SB(1, 0), cB + kstepB, voffB); PG8_STAGE(PG8_SA(1, 0), cA + kstepA, voffA); PG8_STAGE(PG8_SB(1, 1), cB + hstepB + kstepB, voffB);
        PG8_WAIT_V(6); PG8_BAR;
    } else {
        PG8_STAGE(PG8_SB(0, 0), cB, voffB); PG8_STAGE(PG8_SA(0, 0), cA, voffA); PG8_STAGE(PG8_SB(0, 1), cB + hstepB, voffB); PG8_STAGE(PG8_SA(0, 1), cA + hstepA, voffA);
        if (wr == 1) PG8_BAR;
        PG8_WAIT_V(4); PG8_BAR;
        PG8_STAGE(PG8_SB(1, 0), cB + kstepB, voffB); PG8_STAGE(PG8_SA(1, 0), cA + kstepA, voffA); PG8_STAGE(PG8_SB(1, 1), cB + hstepB + kstepB, voffB);
        PG8_WAIT_V(6); PG8_BAR;
    }
    for (;;) {
        const bool has_next = S.next(ui + 1, nxt);
        const char* nA = has_next ? (const char*)g.A + nxt.offA : cA; const char* nB = has_next ? (const char*)g.Bt + nxt.offB : cB;
        for (int t = 0; t < nt; t += 2) {
            const bool last = (t == nt - 2);
            const char* a1 = cA + (size_t)(t + 1) * kstepA;
            const char* a2 = last ? nA : cA + (size_t)(t + 2) * kstepA; const char* b2 = last ? nB : cB + (size_t)(t + 2) * kstepB;
            const char* a3 = a2 + kstepA; const char* b3 = b2 + kstepB;
            if (last && has_next) S.a_ready(nxt);
            if constexpr (SP2) {
            PG8_LDB(B0, 0, 0); PG8_LDB(B1, 0, 1); PG8_SCHED; PG8_LDA(At, 0, 0); PG8_STAGE(PG8_SA(1, 1), a1 + hstepA, voffA);
            PG8_WAIT_V(8); PG8_WAIT_L(0); PG8_BAR; PG8_MMA(0, 0, At, B0); PG8_MMA(0, 1, At, B1); PG8_BAR; PG8_SCHED;
            PG8_LDA(At, 0, 1); PG8_STAGE(PG8_SB(0, 0), b2, voffB); PG8_STAGE(PG8_SB(0, 1), b2 + hstepB, voffB); PG8_STAGE(PG8_SA(0, 0), a2, voffA);
            PG8_WAIT_V(8); PG8_WAIT_L(0); PG8_BAR; PG8_MMA(1, 0, At, B0); PG8_MMA(1, 1, At, B1); PG8_BAR; PG8_SCHED;
            PG8_LDB(B0, 1, 0); PG8_LDB(B1, 1, 1); PG8_SCHED; PG8_LDA(At, 1, 0); PG8_STAGE(PG8_SA(0, 1), a2 + hstepA, voffA);
            PG8_WAIT_V(8); PG8_WAIT_L(0); PG8_BAR; PG8_MMA(0, 0, At, B0); PG8_MMA(0, 1, At, B1); PG8_BAR; PG8_SCHED;
            PG8_LDA(At, 1, 1); PG8_STAGE(PG8_SB(1, 0), b3, voffB); PG8_STAGE(PG8_SB(1, 1), b3 + hstepB, voffB); PG8_STAGE(PG8_SA(1, 0), a3, voffA);
            PG8_WAIT_V(8); PG8_WAIT_L(0); PG8_BAR; PG8_MMA(1, 0, At, B0); PG8_MMA(1, 1, At, B1); PG8_BAR; PG8_SCHED;
            } else {
            PG8_LDB(B0, 0, 0); PG8_SCHED; PG8_LDA(At, 0, 0); PG8_STAGE(PG8_SA(1, 1), a1 + hstepA, voffA);
            PG8_WAIT_L(8); PG8_BAR; PG8_WAIT_L(0); PG8_MMA(0, 0, At, B0); PG8_BAR; PG8_SCHED;
            PG8_LDB(B1, 0, 1); PG8_STAGE(PG8_SB(0, 0), b2, voffB);
            PG8_BAR; PG8_WAIT_L(0); PG8_MMA(0, 1, At, B1); PG8_BAR;
            PG8_LDA(At, 0, 1); PG8_STAGE(PG8_SA(0, 0), a2, voffA);
            PG8_BAR; PG8_WAIT_L(0); PG8_MMA(1, 0, At, B0); PG8_BAR; PG8_SCHED;
            PG8_STAGE(PG8_SB(0, 1), b2 + hstepB, voffB);
            PG8_WAIT_V(6); PG8_BAR; PG8_MMA(1, 1, At, B1); PG8_BAR;
            PG8_LDB(B0, 1, 0); PG8_SCHED; PG8_LDA(At, 1, 0); PG8_STAGE(PG8_SA(0, 1), a2 + hstepA, voffA);
            PG8_WAIT_L(8); PG8_BAR; PG8_WAIT_L(0); PG8_MMA(0, 0, At, B0); PG8_BAR; PG8_SCHED;
            PG8_LDB(B1, 1, 1); PG8_STAGE(PG8_SB(1, 0), b3, voffB);
            PG8_BAR; PG8_WAIT_L(0); PG8_MMA(0, 1, At, B1); PG8_BAR;
            PG8_LDA(At, 1, 1); PG8_STAGE(PG8_SA(1, 0), a3, voffA);
            PG8_BAR; PG8_WAIT_L(0); PG8_MMA(1, 0, At, B0); PG8_BAR; PG8_SCHED;
            PG8_STAGE(PG8_SB(1, 1), b3 + hstepB, voffB);
            PG8_WAIT_V(6); PG8_BAR; PG8_MMA(1, 1, At, B1); PG8_BAR;
            }
        }
        if constexpr (ALIGN_EPI) { if (wr == 0) PG8_BAR; }
        if constexpr (!Epi::AFTER_DRAIN) { E(acc, cur, wr, wc, fr, fq); S.done(cur); }
        if (!has_next) break;
#pragma unroll
        for (int a = 0; a < 2; ++a)
#pragma unroll
            for (int b = 0; b < 2; ++b)
#pragma unroll
                for (int m = 0; m < 4; ++m)
#pragma unroll
                    for (int n = 0; n < 2; ++n) acc[a][b][m][n] = (f32x4){0.f, 0.f, 0.f, 0.f};
        cur = nxt; cA = nA; cB = nB; ++ui;
        if constexpr (ALIGN_EPI) { if (wr == 1) PG8_BAR; }
    }
    PG8_WAIT_V(0);
    if constexpr (!ALIGN_EPI) { if (wr == 0) PG8_BAR; }
    PG8_BAR;
    if constexpr (Epi::AFTER_DRAIN) { E.fused(acc, cur, wr, wc, fr, fq, lds, wid, lane); S.done(cur); }
#undef PG8_SA
#undef PG8_SB
#undef PG8_STAGE
#undef PG8_LDA
#undef PG8_LDB
#undef PG8_MMA
#undef PG8_WAIT_V
#undef PG8_WAIT_L
#undef PG8_BAR
#undef PG8_SCHED
}
}

#ifndef PG8_SP2
#define PG8_SP2 true
#endif
#ifndef PG8_ALIGN
#define PG8_ALIGN true
#endif

constexpr int NWAVES = 8;
#ifndef MK_N_LAUNCHES
#define MK_N_LAUNCHES 1
#endif
#ifndef DBG_MODE
#define DBG_MODE 0
#endif
#ifndef REP_PHASE
#define REP_PHASE -1
#endif
#define NREP(k) ((REP_PHASE) == (k) ? 2 : 1)
#ifndef TIME_LO
#define TIME_LO -1
#endif
#ifndef TIME_HI
#define TIME_HI -1
#endif
#ifndef TIME_BLK
#define TIME_BLK 0
#endif
#define TMARK(j) do { if ((TIME_LO) >= 0 && blockIdx.x == (TIME_BLK) && F.tid == 0) { if ((j) == (TIME_LO)) t_lo_ = __builtin_amdgcn_s_memrealtime(); if ((j) == (TIME_HI)) t_hi_ = __builtin_amdgcn_s_memrealtime(); } } while (0)
constexpr int PER_PHASE = 13;
constexpr int N_LAUNCHES = MK_N_LAUNCHES;

constexpr int BATCH = 2, SEQ = 8192, D = 1024, M = BATCH * SEQ;
constexpr int SBW = 512, NH = 8, HD = 64;
constexpr int SSW = 512, NG = 32, GC = 16, NP = 64;
constexpr int NPROJ = 3 * SBW + SSW;
constexpr int LC = 32, NCHUNK = M / LC, CPB = SEQ / LC;
constexpr int UK = LC * GC + 2 * NP;
constexpr int NE = 32, TOPK = 4, FF = 1024, NASSIGN = M * TOPK;
constexpr int MAXTILES = (NASSIGN + NE * 255) / 256 + 1;
constexpr float EPS = 1e-5f;
constexpr float LOG2E = 1.4426950408889634f;

constexpr size_t MiB = 1u << 20;
constexpr size_t WS_CTL = 0, CTL_ZERO_BYTES = 1 * MiB;
constexpr size_t WS_LAML = 1 * MiB;
constexpr size_t WS_RSTD = 1 * MiB + 32 * 1024;
constexpr size_t WS_GATES = 1 * MiB + 128 * 1024;
constexpr size_t WS_ROWINFO = 1 * MiB + 512 * 1024;
constexpr size_t WS_RWIMG = 3 * MiB;
constexpr size_t WS_LISTS = 347 * MiB + 110 * MiB;
constexpr size_t WS_WINT = 4 * MiB, WS_WGLUT = 8 * MiB, WS_WOUTT = 9 * MiB, WS_W1T = 11 * MiB, WS_W2T = 139 * MiB;
constexpr size_t WS_R1 = 203 * MiB, WS_R2 = 347 * MiB, WS_END = 491 * MiB;
constexpr size_t WS_HN = WS_R1, WS_Q = WS_R1 + 32 * MiB, WS_K = WS_R1 + 48 * MiB, WS_V = WS_R1 + 64 * MiB, WS_UCAT = WS_R1 + 80 * MiB,
                 WS_SLOC = WS_R1 + 100 * MiB, WS_YSB = WS_R1 + 108 * MiB, WS_YG = WS_R1 + 124 * MiB;
constexpr size_t WS_XS = WS_R1, WS_YBUF = WS_R1;
constexpr size_t WS_YSSM = WS_R2, WS_MIXED = WS_R2 + 16 * MiB, WS_XN = WS_R2 + 48 * MiB, WS_WE = WS_R2 + 80 * MiB, WS_TW = WS_R2 + 85 * MiB;
constexpr size_t WS_H = WS_R2;
static_assert(WS_K == WS_Q + (size_t)M * SBW * 2 && WS_V == WS_K + (size_t)M * SBW * 2 && WS_YG + (size_t)M * SSW * 2 <= WS_R2 && WS_TW + (size_t)NG * 512 * UK * 2 <= WS_END, "ws map");
static_assert(WS_XS + (size_t)MAXTILES * 256 * D * 2 <= WS_R2 + 2 * MiB && WS_H + (size_t)(MAXTILES - 1) * 256 * FF * 2 <= WS_END, "ws map 2");
static_assert(WS_ROWINFO + (size_t)MAXTILES * 256 * 16 <= 3 * MiB && WS_LISTS >= WS_R2 + 106 * MiB && WS_LISTS + (size_t)NE * M * 4 <= WS_END, "ws map 3");
constexpr int CW_TMO = 0, CW_CODE = 1;
constexpr int CW_BAR = 4096;
constexpr int CW_CNT = 16384;
constexpr int CW_Q0 = 16384 + 256;
constexpr int CW_AQ = 16384 + 320, CW_DONE2 = 16384 + 384, CW_DONE3 = 16384 + 448;

constexpr int RING_OFF = 0, RING_BYTES = 131072;
constexpr int RT_WSTR = 1028;
constexpr int RT_W_BYTES = 2 * NE * RT_WSTR * 2;
constexpr int RT_SCR_OFF = RT_W_BYTES;
constexpr int LDSCTL_OFF = 139264, MISC_OFF = LDSCTL_OFF + 320;
constexpr int TAB_OFF = LDSCTL_OFF + 512;
constexpr int UNITS_OFF = LDSCTL_OFF + 1024;
constexpr int TILEE_OFF = LDSCTL_OFF + 1536;
constexpr int LDS_BYTES = LDSCTL_OFF + 4096;
static_assert(TILEE_OFF + MAXTILES * 4 <= LDS_BYTES && RT_SCR_OFF + 4096 <= LDSCTL_OFF, "LDS map");

#define GAS __attribute__((address_space(1)))
#define LAS __attribute__((address_space(3)))
typedef unsigned short bf16;
typedef unsigned v4u __attribute__((ext_vector_type(4)));
typedef unsigned v2u __attribute__((ext_vector_type(2)));
typedef float f32x4 __attribute__((ext_vector_type(4)));
typedef float f32x2 __attribute__((ext_vector_type(2)));
typedef _Float16 h16x2 __attribute__((ext_vector_type(2)));
typedef GAS unsigned gu32;
#define RLX_AGENT __ATOMIC_RELAXED, __HIP_MEMORY_SCOPE_AGENT
#define LDS_WAIT() asm volatile("s_waitcnt lgkmcnt(0)" ::: "memory")
#define VM_WAIT() asm volatile("s_waitcnt vmcnt(0)" ::: "memory")
__device__ __forceinline__ unsigned f2bf(float f) { unsigned u = __builtin_bit_cast(unsigned, f); return (u + 0x7fffu + ((u >> 16) & 1u)) >> 16; }
__device__ __forceinline__ unsigned pk2(float lo, float hi) { return f2bf(lo) | (f2bf(hi) << 16); }
__device__ __forceinline__ float bf2f(unsigned short b) { return __builtin_bit_cast(float, (unsigned)b << 16); }
__device__ __forceinline__ float bflo(unsigned w) { return __builtin_bit_cast(float, w << 16); }
__device__ __forceinline__ float bfhi(unsigned w) { return __builtin_bit_cast(float, w & 0xffff0000u); }
__device__ __forceinline__ unsigned pkh2(float lo, float hi) { h16x2 v; v.x = (_Float16)lo; v.y = (_Float16)hi; return __builtin_bit_cast(unsigned, v); }
__device__ __forceinline__ float fexp2(float x) { return __builtin_amdgcn_exp2f(x); }
__device__ __forceinline__ float flog2(float x) { return __builtin_amdgcn_logf(x); }
__device__ __forceinline__ float frcp(float x) { return __builtin_amdgcn_rcpf(x); }
__device__ __forceinline__ float sigmoidf_(float x) { return frcp(1.0f + fexp2(-LOG2E * x)); }
__device__ __forceinline__ float gelu_tanh(float v) { const float u = 0.7978845608028654f * (v + 0.044715f * v * v * v); return v * frcp(1.0f + fexp2(-2.0f * LOG2E * u)); }

#define XB_TMO      128
#define XB_XCNT(j)  (256  + 64 * (j))
#define XB_XSUB(j)  (1280 + 64 * (j))
#define XB_XGEN(j)  (2304 + 64 * (j))
#define XB_TOP      3328
#define XB_TOPGEN   3392
#define XCD_BAR_WORDS 3456
#define XB_SPIN_CAP (1u << 18)
__device__ __forceinline__ unsigned xb_ld(unsigned* p)              { return __hip_atomic_load(p, __ATOMIC_RELAXED, __HIP_MEMORY_SCOPE_AGENT); }
__device__ __forceinline__ unsigned xb_add(unsigned* p, unsigned v) { return __hip_atomic_fetch_add(p, v, __ATOMIC_RELAXED, __HIP_MEMORY_SCOPE_AGENT); }
__device__ __forceinline__ unsigned xb_xcc_id() { return (unsigned)__builtin_amdgcn_s_getreg((3 << 11) | 20) & 0xFu; }
#define XB_SPIN(cond, bar) do { unsigned _sp = 0; while (cond) { __builtin_amdgcn_s_sleep(1); \
    if ((++_sp & 255u) == 0u) { if (xb_ld(&(bar)[XB_TMO])) break; if (_sp > XB_SPIN_CAP) { atomicAdd(&(bar)[XB_TMO], 1u); break; } } } } while (0)
struct XcdBarrier { unsigned* bar; unsigned x; volatile LAS unsigned* st; };
__device__ __forceinline__ XcdBarrier xcd_barrier_post(unsigned* bar, volatile LAS unsigned* st) {
    XcdBarrier b; b.bar = bar; b.x = xb_xcc_id(); b.st = st;
    if (threadIdx.x == 0) (void)xb_add(&bar[XB_XCNT(b.x)], 1u);
    return b;
}
__device__ __forceinline__ void xcd_barrier_complete(unsigned* bar, unsigned x, unsigned& nloc, unsigned& nx) {
    const unsigned G = gridDim.x * gridDim.y * gridDim.z;
    unsigned sum, cnt, mine, sp = 0u;
    for (;;) {
        sum = 0u; cnt = 0u; mine = 0u;
#pragma unroll
        for (unsigned j = 0; j < 16; ++j) { const unsigned c = xb_ld(&bar[XB_XCNT(j)]); sum += c; cnt += (c > 0u) ? 1u : 0u; mine = (j == x) ? c : mine; }
        if (sum == G) break;
        __builtin_amdgcn_s_sleep(1);
        if ((++sp & 255u) == 0u) { if (xb_ld(&bar[XB_TMO])) break; if (sp > XB_SPIN_CAP) { atomicAdd(&bar[XB_TMO], 1u); break; } }
    }
    nloc = mine > 0u ? mine : 1u; nx = cnt > 0u ? cnt : 1u;
}
__device__ __forceinline__ void xcd_barrier(const XcdBarrier& b) {
    asm volatile("s_waitcnt vmcnt(0)" ::: "memory");
    __syncthreads();
    if (threadIdx.x == 0) {
        unsigned* bar = b.bar;
        __builtin_amdgcn_s_waitcnt(0);
        unsigned nloc = b.st[0], nx = b.st[1];
        if (nloc == 0u) { xcd_barrier_complete(bar, b.x, nloc, nx); b.st[0] = nloc; b.st[1] = nx; }
        const unsigned old = xb_add(&bar[XB_XSUB(b.x)], 1u);
        const unsigned gen = old / nloc;
        if (old + 1u == (gen + 1u) * nloc) {
            __builtin_amdgcn_fence(__ATOMIC_RELEASE, "agent");
            asm volatile("s_waitcnt vmcnt(0)" ::: "memory");
            const unsigned og = xb_add(&bar[XB_TOP], 1u);
            const unsigned tg = og / nx;
            if (og + 1u == (tg + 1u) * nx) xb_add(&bar[XB_TOPGEN], 1u);
            else XB_SPIN(xb_ld(&bar[XB_TOPGEN]) == tg, bar);
            __builtin_amdgcn_fence(__ATOMIC_ACQUIRE, "agent");
            xb_add(&bar[XB_XGEN(b.x)], 1u);
            asm volatile("s_waitcnt vmcnt(0)" ::: "memory");
        } else {
            XB_SPIN(xb_ld(&bar[XB_XGEN(b.x)]) == gen, bar);
            __builtin_amdgcn_fence(__ATOMIC_ACQUIRE, "agent");
            asm volatile("s_waitcnt vmcnt(0)" ::: "memory");
        }
    }
    __syncthreads();
}

struct Frame {
    LAS unsigned char* lds;
    volatile LAS unsigned* MISC;
    gu32* ctl;
    int tid, lane, wave;
    int vcu, G;
    unsigned char* ws;
    const float* in[25];
    float* out;
};

__device__ __forceinline__ float wave_sum(float v) {
#pragma unroll
    for (int o = 1; o < 64; o <<= 1) v += __shfl_xor(v, o);
    return v;
}

using pg8::Unit;
typedef pg8::f32x4 accv;
struct EpiInProj {
    static constexpr bool PERM = true, AFTER_DRAIN = false;
    unsigned short* QKV; bf16* U; float qscale;
    __device__ __forceinline__ void operator()(const accv (&acc)[2][2][4][2], const Unit& u, int wr, int wc, int fr, int fq) const {
        if (u.e == 1) {
            const int row0 = u.pm * 256 + wr * 64 + fr; const int colt = u.pn * 256 + wc * 32 + 8 * fq;
            _Float16* VT = (_Float16*)(QKV + (size_t)2 * M * SBW);
#pragma unroll
            for (int ai = 0; ai < 2; ++ai)
#pragma unroll
                for (int m = 0; m < 4; ++m) { const int row = row0 + ai * 128 + m * 16;
#pragma unroll
                    for (int bj = 0; bj < 2; ++bj) { const int tok = colt + bj * 128; const accv v0 = acc[ai][bj][m][0], v1 = acc[ai][bj][m][1];
                        const int bb = tok >> 13, sq = tok & (SEQ - 1); const int o = sq & 15;
                        _Float16* p = VT + ((size_t)bb * SBW + row) * SEQ + (sq & ~15) + (o >> 1);
                        v2u w0, w1; w0.x = pkh2(v0[0], v0[1]); w0.y = pkh2(v0[2], v0[3]); w1.x = pkh2(v1[0], v1[1]); w1.y = pkh2(v1[2], v1[3]);
                        *(v2u*)p = w0; *(v2u*)(p + 8) = w1; } }
            return;
        }
        const int kind = u.pn >> 1; const int colt = (u.pn & 1) * 256 + wc * 32 + 8 * fq; const int row0 = u.pm * 256 + wr * 64 + fr;
        unsigned short* T = QKV + (size_t)(kind < 2 ? kind : 0) * ((size_t)M * SBW); const float sc = kind == 0 ? qscale : 1.0f;
#pragma unroll
        for (int ai = 0; ai < 2; ++ai)
#pragma unroll
            for (int m = 0; m < 4; ++m) { const int row = row0 + ai * 128 + m * 16;
#pragma unroll
                for (int bj = 0; bj < 2; ++bj) { const int col = colt + bj * 128; const accv v0 = acc[ai][bj][m][0] * sc, v1 = acc[ai][bj][m][1] * sc; v4u w;
                    if (kind < 2) { w.x = pkh2(v0[0], v0[1]); w.y = pkh2(v0[2], v0[3]); w.z = pkh2(v1[0], v1[1]); w.w = pkh2(v1[2], v1[3]);
                        *(v4u*)(T + (size_t)row * SBW + col) = w; }
                    else { w.x = pg8::cvt_pk_bf16(v0[0], v0[1]); w.y = pg8::cvt_pk_bf16(v0[2], v0[3]); w.z = pg8::cvt_pk_bf16(v1[0], v1[1]); w.w = pg8::cvt_pk_bf16(v1[2], v1[3]);
                        *(v4u*)(U + ((size_t)(row >> 5) * NG + (col >> 4)) * UK + (row & 31) * GC + (col & 15)) = w; } } }
    }
};
struct EpiSloc {
    static constexpr bool PERM = false, AFTER_DRAIN = false;
    float* S;
    __device__ __forceinline__ void operator()(const accv (&acc)[2][2][4][2], const Unit& u, int wr, int wc, int fr, int fq) const {
        const int row0 = u.pm * 256 + wr * 64 + fr; const int col0 = wc * 32 + 4 * fq;
#pragma unroll
        for (int ai = 0; ai < 2; ++ai)
#pragma unroll
            for (int m = 0; m < 4; ++m) { const int row = row0 + ai * 128 + m * 16;
#pragma unroll
                for (int n = 0; n < 2; ++n) *(accv*)(S + ((size_t)row * NG + u.e) * 128 + col0 + 16 * n) = acc[ai][0][m][n]; }
    }
};
struct EpiS3 {
    static constexpr bool PERM = true, AFTER_DRAIN = false;
    bf16* YG;
    __device__ __forceinline__ void operator()(const accv (&acc)[2][2][4][2], const Unit& u, int wr, int wc, int fr, int fq) const {
        const int row0 = u.pm * 256 + wr * 64 + fr; const int colt = u.pn * 256 + wc * 32 + 8 * fq;
#pragma unroll
        for (int ai = 0; ai < 2; ++ai)
#pragma unroll
            for (int m = 0; m < 4; ++m) { const int row = row0 + ai * 128 + m * 16;
#pragma unroll
                for (int bj = 0; bj < 2; ++bj) { const int col = colt + bj * 128; const accv v0 = acc[ai][bj][m][0], v1 = acc[ai][bj][m][1]; v4u w;
                    w.x = pg8::cvt_pk_bf16(gelu_tanh(v0[0]), gelu_tanh(v0[1])); w.y = pg8::cvt_pk_bf16(gelu_tanh(v0[2]), gelu_tanh(v0[3]));
                    w.z = pg8::cvt_pk_bf16(gelu_tanh(v1[0]), gelu_tanh(v1[1])); w.w = pg8::cvt_pk_bf16(gelu_tanh(v1[2]), gelu_tanh(v1[3]));
                    *(v4u*)(YG + ((size_t)row * LC + (col >> 4)) * SSW + u.e * GC + (col & 15)) = w; } }
    }
};
struct EpiGlu {
    static constexpr bool PERM = true, AFTER_DRAIN = false;
    bf16* Y;
    __device__ __forceinline__ void operator()(const accv (&acc)[2][2][4][2], const Unit& u, int wr, int wc, int fr, int fq) const {
        const int row0 = u.pm * 256 + wr * 64 + fr; const int col = u.pn * 128 + wc * 32 + 8 * fq;
#pragma unroll
        for (int ai = 0; ai < 2; ++ai)
#pragma unroll
            for (int m = 0; m < 4; ++m) { const int row = row0 + ai * 128 + m * 16; float r[8];
#pragma unroll
                for (int n = 0; n < 2; ++n)
#pragma unroll
                    for (int j = 0; j < 4; ++j) r[4 * n + j] = acc[ai][0][m][n][j] * sigmoidf_(acc[ai][1][m][n][j]);
                v4u w; w.x = pg8::cvt_pk_bf16(r[0], r[1]); w.y = pg8::cvt_pk_bf16(r[2], r[3]); w.z = pg8::cvt_pk_bf16(r[4], r[5]); w.w = pg8::cvt_pk_bf16(r[6], r[7]);
                *(v4u*)(Y + (size_t)row * SSW + col) = w; }
    }
};
struct EpiOutProj {
    static constexpr bool PERM = false, AFTER_DRAIN = false;
    const float* X; float* O;
    __device__ __forceinline__ void operator()(const accv (&acc)[2][2][4][2], const Unit& u, int wr, int wc, int fr, int fq) const {
        const int row0 = u.pm * 256 + wr * 64 + fr; const int col0 = u.pn * 256 + wc * 32 + 4 * fq;
#pragma unroll
        for (int ai = 0; ai < 2; ++ai)
#pragma unroll
            for (int m = 0; m < 4; ++m) { const size_t off = (size_t)(row0 + ai * 128 + m * 16) * D + col0;
#pragma unroll
                for (int bj = 0; bj < 2; ++bj)
#pragma unroll
                    for (int n = 0; n < 2; ++n) { const accv xv = *(const accv*)(X + off + bj * 128 + n * 16); *(accv*)(O + off + bj * 128 + n * 16) = xv + acc[ai][bj][m][n]; }
                if (m & 1) asm volatile("" ::: "memory"); }
    }
};
struct EpiMoe1 {
    static constexpr bool PERM = true, AFTER_DRAIN = false;
    bf16* H; const float* bg; const float* bu; const int* rowinfo;
    __device__ __forceinline__ void operator()(const accv (&acc)[2][2][4][2], const Unit& u, int wr, int wc, int fr, int fq) const {
        const int row0 = u.pm * 256 + wr * 64 + fr; const int col = u.pn * 128 + wc * 32 + 8 * fq;
        float bgv[8], buv[8];
#pragma unroll
        for (int n = 0; n < 2; ++n) { const accv a = *(const accv*)(bg + u.e * FF + col + 4 * n), b = *(const accv*)(bu + u.e * FF + col + 4 * n);
#pragma unroll
            for (int j = 0; j < 4; ++j) { bgv[4 * n + j] = a[j]; buv[4 * n + j] = b[j]; } }
#pragma unroll
        for (int ai = 0; ai < 2; ++ai)
#pragma unroll
            for (int m = 0; m < 4; ++m) { const int row = row0 + ai * 128 + m * 16; float r[8]; const float rs = __builtin_bit_cast(float, rowinfo[4 * row + 2]);
#pragma unroll
                for (int n = 0; n < 2; ++n)
#pragma unroll
                    for (int j = 0; j < 4; ++j) { const float g = fminf(acc[ai][0][m][n][j] * rs + bgv[4 * n + j], 7.0f); const float up = fminf(fmaxf(acc[ai][1][m][n][j] * rs + buv[4 * n + j], -7.0f), 7.0f);
                        r[4 * n + j] = (up + 1.0f) * g * frcp(1.0f + fexp2(-1.702f * LOG2E * g)); }
                v4u w; w.x = pg8::cvt_pk_bf16(r[0], r[1]); w.y = pg8::cvt_pk_bf16(r[2], r[3]); w.z = pg8::cvt_pk_bf16(r[4], r[5]); w.w = pg8::cvt_pk_bf16(r[6], r[7]);
                *(v4u*)(H + (size_t)row * FF + col) = w; }
    }
};
struct EpiMoe2 {
    static constexpr bool PERM = true, AFTER_DRAIN = false;
    bf16* Y; const float* bd; const int* rowinfo;
    __device__ __forceinline__ void operator()(const accv (&acc)[2][2][4][2], const Unit& u, int wr, int wc, int fr, int fq) const {
        const int row0 = u.pm * 256 + wr * 64 + fr; const int colt = u.pn * 256 + wc * 32 + 8 * fq;
        float bv[2][8];
#pragma unroll
        for (int bj = 0; bj < 2; ++bj)
#pragma unroll
            for (int n = 0; n < 2; ++n) { const accv a = *(const accv*)(bd + u.e * D + colt + bj * 128 + 4 * n);
#pragma unroll
                for (int j = 0; j < 4; ++j) bv[bj][4 * n + j] = a[j]; }
#pragma unroll
        for (int ai = 0; ai < 2; ++ai)
#pragma unroll
            for (int m = 0; m < 4; ++m) { const int row = row0 + ai * 128 + m * 16; const int slot = rowinfo[4 * row]; const float gate = __builtin_bit_cast(float, rowinfo[4 * row + 1]);
                if (slot >= 0) {
#pragma unroll
                    for (int bj = 0; bj < 2; ++bj) { float r[8];
#pragma unroll
                        for (int n = 0; n < 2; ++n)
#pragma unroll
                            for (int j = 0; j < 4; ++j) r[4 * n + j] = (acc[ai][bj][m][n][j] + bv[bj][4 * n + j]) * gate;
                        v4u w; w.x = pg8::cvt_pk_bf16(r[0], r[1]); w.y = pg8::cvt_pk_bf16(r[2], r[3]); w.z = pg8::cvt_pk_bf16(r[4], r[5]); w.w = pg8::cvt_pk_bf16(r[6], r[7]);
                        *(v4u*)(Y + (size_t)slot * D + colt + bj * 128) = w; } } }
    }
};

struct InProjOrder {
    int G, c;
    __device__ bool next(int i, Unit& u) const {
        const int L = i * G + c; if (L >= 512) return false;
        const int s = pg8::xcd_remap(L, 512);
        if (s < 384) { const int grp = s / 48, r = s % 48; u.pm = grp * 8 + (r & 7); const int pi = r >> 3; u.pn = pi < 4 ? pi : pi + 2; u.e = 0;
            u.offA = (long)u.pm * 256 * D * 2; u.offB = (long)u.pn * 256 * D * 2; }
        else { const int r = s - 384; u.pm = r & 1; u.pn = r >> 1; u.e = 1;
            u.offA = (long)(WS_WINT - WS_HN) + (long)(1024 + u.pm * 256) * D * 2; u.offB = (long)(WS_HN - WS_WINT) + (long)u.pn * 256 * D * 2; }
        return true;
    }
    __device__ __forceinline__ void a_ready(const Unit&) const {}
    __device__ __forceinline__ void done(const Unit&) const {}
};
struct SsmOrder {
    int nwg, G, c, npn, rows_per_g, ldb;
    __device__ bool next(int i, Unit& u) const {
        const int L = i * G + c; if (L >= nwg) return false;
        const int per_g = 2 * npn; const int g = L / per_g, r = L % per_g;
        u.e = g; u.pm = r / npn; u.pn = r % npn;
        u.offA = ((long)u.pm * 256 * NG * UK + (long)g * UK) * 2; u.offB = ((long)g * rows_per_g + (long)u.pn * 256) * ldb * 2; return true;
    }
    __device__ __forceinline__ void a_ready(const Unit&) const {}
    __device__ __forceinline__ void done(const Unit&) const {}
};
struct MoeOrder {
    const LAS int* units; long ebytes;
    __device__ bool next(int i, Unit& u) const {
        if (i >= 32) return false;
        const int v = __builtin_amdgcn_readfirstlane(units[4 * i + 3]); if (!v) return false;
        u.pm = __builtin_amdgcn_readfirstlane(units[4 * i + 0]); u.pn = __builtin_amdgcn_readfirstlane(units[4 * i + 1]); u.e = __builtin_amdgcn_readfirstlane(units[4 * i + 2]);
        u.offA = (long)u.pm * 256 * D * 2; u.offB = (long)u.e * ebytes + (long)u.pn * 256 * 16; return true;
    }
    __device__ __forceinline__ void a_ready(const Unit&) const {}
    __device__ __forceinline__ void done(const Unit&) const {}
};

struct CvItem { const float* src; bf16* dst; int ldw, K, rmul, radd, k0, n0; };
constexpr int CV_I_IN = (D / 64) * (NPROJ / 32), CV_I_GLU = (SSW / 64) * (SSW / 32), CV_I_OUT = (D / 64) * (D / 32), CV_I_E = (D / 64) * (FF / 32);
constexpr int CV_N_EARLY = CV_I_IN + 2 * CV_I_GLU + CV_I_OUT, CV_N_EXP = 3 * NE * (D / 8);
__device__ __forceinline__ void cv_set(CvItem& c, const float* W, int ldw, int K, int N, bf16* WT, int rmul, int radd, int item) {
    const int nblk = N / 32, kb = item / nblk, nb = item % nblk; c.src = W; c.dst = WT; c.ldw = ldw; c.K = K; c.rmul = rmul; c.radd = radd; c.k0 = 64 * kb; c.n0 = 32 * nb;
}
__device__ __forceinline__ void cv_decode_early(Frame& F, int r, CvItem& c) {
    bf16* WinT = (bf16*)(F.ws + WS_WINT); bf16* WgluT = (bf16*)(F.ws + WS_WGLUT); bf16* WoutT = (bf16*)(F.ws + WS_WOUTT);
    if (r < CV_I_IN) { cv_set(c, F.in[2], NPROJ, D, NPROJ, WinT, 1, 0, r); return; } r -= CV_I_IN;
    if (r < CV_I_GLU) { cv_set(c, F.in[11], 2 * SSW, SSW, SSW, WgluT, 2, 0, r); return; } r -= CV_I_GLU;
    if (r < CV_I_GLU) { cv_set(c, F.in[11] + SSW, 2 * SSW, SSW, SSW, WgluT, 2, 128, r); return; } r -= CV_I_GLU;
    cv_set(c, F.in[14], D, D, D, WoutT, 1, 0, r);
}
__device__ __forceinline__ void cv_decode_exp(Frame& F, int r, CvItem& c) {
    bf16* W1T = (bf16*)(F.ws + WS_W1T); bf16* W2T = (bf16*)(F.ws + WS_W2T);
    const int mat = r / CV_I_E, sub = r % CV_I_E, kind = mat / NE, e = mat % NE;
    if (kind == 0) cv_set(c, F.in[18] + (size_t)e * D * FF, FF, D, FF, W1T + (size_t)e * 2 * FF * D, 2, 0, sub);
    else if (kind == 1) cv_set(c, F.in[20] + (size_t)e * D * FF, FF, D, FF, W1T + (size_t)e * 2 * FF * D, 2, 128, sub);
    else cv_set(c, F.in[22] + (size_t)e * FF * D, D, FF, D, W2T + (size_t)e * D * FF, 1, 0, sub);
}
__device__ __forceinline__ void cv_load(const CvItem& c, int lane, float (&v)[32]) {
    const float* p = c.src + (size_t)(c.k0 + (lane >> 5)) * c.ldw + c.n0 + (lane & 31);
#pragma unroll
    for (int i = 0; i < 32; ++i) v[i] = p[(size_t)(2 * i) * c.ldw];
}
__device__ __forceinline__ void cv_store(const CvItem& c, int lane, const float (&v)[32], LAS float* scr) {
#pragma unroll
    for (int i = 0; i < 32; ++i) scr[(2 * i + (lane >> 5)) * 33 + (lane & 31)] = v[i];
    LDS_WAIT(); asm volatile("" ::: "memory");
    const int cc = lane & 7;
#pragma unroll
    for (int j = 0; j < 4; ++j) { const int nl = (lane >> 3) + 8 * j; const int n = c.n0 + nl; const int drow = (n >> 7) * 128 * c.rmul + c.radd + (n & 127); const LAS float* s = scr + (8 * cc) * 33 + nl;
        v4u o; o.x = pg8::cvt_pk_bf16(s[0 * 33], s[1 * 33]); o.y = pg8::cvt_pk_bf16(s[2 * 33], s[3 * 33]); o.z = pg8::cvt_pk_bf16(s[4 * 33], s[5 * 33]); o.w = pg8::cvt_pk_bf16(s[6 * 33], s[7 * 33]);
        *(GAS v4u*)(c.dst + (size_t)drow * c.K + c.k0 + 8 * cc) = o; }
    LDS_WAIT(); asm volatile("" ::: "memory");
}
__device__ __forceinline__ void cv_item_early(Frame& F, int it, LAS float* scr) { CvItem c; float v[32]; cv_decode_early(F, it, c); cv_load(c, F.lane, v); cv_store(c, F.lane, v, scr); }
__device__ __forceinline__ void cv_run_early(Frame& F, int first, int stride, int n, LAS float* scr) {
    CvItem ca, cb; float va[32], vb[32];
    int it = first; if (it >= n) return;
    cv_decode_early(F, it, ca);
    cv_load(ca, F.lane, va);
    for (;;) {
        const int nit = it + stride; const bool more = nit < n;
        if (more) { cv_decode_early(F, nit, cb); cv_load(cb, F.lane, vb); }
        cv_store(ca, F.lane, va, scr);
        if (!more) break;
        ca = cb;
#pragma unroll
        for (int i = 0; i < 32; ++i) va[i] = vb[i];
        it = nit;
    }
}
__device__ __forceinline__ void xv_item(Frame& F, int it) {
    bf16* W1T = (bf16*)(F.ws + WS_W1T); bf16* W2T = (bf16*)(F.ws + WS_W2T);
    const float* w0 = F.in[18]; const float* w1 = F.in[20]; const float* w2 = F.in[22];
    asm volatile("" : "+s"(w0), "+s"(w1), "+s"(w2));
    const int lane = F.lane;
    {
        const int mat = it >> 7, kb = it & 127, kind = mat / NE, e = mat % NE;
        const float* src = (kind == 0 ? w0 : (kind == 1 ? w1 : w2)) + (size_t)e * D * FF + (size_t)(kb * 8) * FF + 4 * lane;
        f32x4 v[8][4];
#pragma unroll
        for (int rr = 0; rr < 8; ++rr)
#pragma unroll
            for (int j = 0; j < 4; ++j) v[rr][j] = *(const GAS f32x4*)(src + (size_t)rr * FF + 256 * j);
        bf16* dst; int cstride;
        if (kind < 2) { dst = W1T + (size_t)e * 2 * FF * D + ((size_t)kb * 2 * FF + (size_t)(lane >> 5) * 256 + (kind == 1 ? 128 : 0) + 4 * (lane & 31)) * 8; cstride = 512 * 8; }
        else { dst = W2T + (size_t)e * D * FF + ((size_t)kb * D + 4 * lane) * 8; cstride = 256 * 8; }
#pragma unroll
        for (int j = 0; j < 4; ++j)
#pragma unroll
            for (int c = 0; c < 4; ++c) { v4u o; o.x = pg8::cvt_pk_bf16(v[0][j][c], v[1][j][c]); o.y = pg8::cvt_pk_bf16(v[2][j][c], v[3][j][c]); o.z = pg8::cvt_pk_bf16(v[4][j][c], v[5][j][c]); o.w = pg8::cvt_pk_bf16(v[6][j][c], v[7][j][c]);
                *(GAS v4u*)(dst + (size_t)j * cstride + c * 8) = o; }
    }
}
__device__ __forceinline__ void rms_row_to_bf16(int lane, const float* xrow, const float* g, bf16* orow) {
    const GAS f32x4* xr = (const GAS f32x4*)xrow + lane; const GAS f32x4* gr = (const GAS f32x4*)g + lane;
    f32x4 v[4]; float s = 0.f;
#pragma unroll
    for (int j = 0; j < 4; ++j) { v[j] = xr[64 * j]; s += (v[j].x * v[j].x + v[j].y * v[j].y) + (v[j].z * v[j].z + v[j].w * v[j].w); }
    const float rstd = 1.0f / sqrtf(wave_sum(s) * (1.f / D) + EPS);
    GAS unsigned long long* o8 = (GAS unsigned long long*)orow + lane;
#pragma unroll
    for (int j = 0; j < 4; ++j) { const f32x4 gg = gr[64 * j]; o8[64 * j] = (unsigned long long)pk2(v[j].x * rstd * gg.x, v[j].y * rstd * gg.y) | ((unsigned long long)pk2(v[j].z * rstd * gg.z, v[j].w * rstd * gg.w) << 32); }
}
__device__ __forceinline__ void sincos_acc(float th, float& s, float& c) {
    const float k = rintf(th * 0.15915494309189535f);
    float r = fmaf(-k, 6.28125f, th); r = fmaf(-k, 1.9353071795864769e-3f, r);
    const float x = 0.25f * r, x2 = x * x;
    float sn = x * (1.0f + x2 * (-1.0f / 6 + x2 * (1.0f / 120 + x2 * (-1.0f / 5040 + x2 * (1.0f / 362880 + x2 * (-1.0f / 39916800))))));
    float cs = 1.0f + x2 * (-0.5f + x2 * (1.0f / 24 + x2 * (-1.0f / 720 + x2 * (1.0f / 40320 + x2 * (-1.0f / 3628800 + x2 * (1.0f / 479001600))))));
#pragma unroll
    for (int i = 0; i < 2; ++i) { const float s2 = 2.0f * sn * cs, c2 = 1.0f - 2.0f * sn * sn; sn = s2; cs = c2; }
    s = sn; c = cs;
}
__device__ __forceinline__ void ssm_tables(Frame& F, int g) {
    constexpr int PS = 65, BS = 17, CS = 65, KT = 273, KC = 17;
    LAS float* pwr = (LAS float*)(F.lds);
    LAS float* pwi = pwr + 33 * PS;
    LAS float* bbr = pwi + 33 * PS;
    LAS float* bbi = bbr + 64 * BS;
    LAS float* ccr = bbi + 64 * BS;
    LAS float* cci = ccr + 16 * CS;
    LAS float* km = cci + 16 * CS;
    const float* lam_re = F.in[3]; const float* lam_im = F.in[4]; const float* log_dt = F.in[5];
    const float* b_re = F.in[6]; const float* b_im = F.in[7]; const float* c_re = F.in[8]; const float* c_im = F.in[9]; const float* dsk = F.in[10];
    float* lamL = (float*)(F.ws + WS_LAML); bf16* WE = (bf16*)(F.ws + WS_WE); bf16* TW = (bf16*)(F.ws + WS_TW);
    const int tid = F.tid;
    if (tid < 64) { const int p = tid;
        const float lr = lam_re[g * NP + p], li = lam_im[g * NP + p], dt = expf(log_dt[g]);
        const float er = expf(lr * dt); float sn, cs; sincos_acc(li * dt, sn, cs);
        const float br = er * cs, bi = er * sn;
        const float nr = br - 1.0f, ni = bi, den = 1.0f / (lr * lr + li * li);
        const float fr = (nr * lr + ni * li) * den, fi = (ni * lr - nr * li) * den;
        float pr = 1.0f, pi = 0.0f;
        for (int n = 0; n <= 32; ++n) { pwr[n * PS + p] = pr; pwi[n * PS + p] = pi; const float t = pr * br - pi * bi; pi = pr * bi + pi * br; pr = t; }
        lamL[(g * 2 + 0) * NP + p] = pwr[32 * PS + p]; lamL[(g * 2 + 1) * NP + p] = pwi[32 * PS + p];
        float xr[GC], xi[GC];
#pragma unroll
        for (int c = 0; c < GC; ++c) { xr[c] = b_re[(g * NP + p) * GC + c]; xi[c] = b_im[(g * NP + p) * GC + c]; }
#pragma unroll
        for (int c = 0; c < GC; ++c) { bbr[p * BS + c] = fr * xr[c] - fi * xi[c]; bbi[p * BS + c] = fr * xi[c] + fi * xr[c]; }
    }
    for (int i = tid; i < 1024; i += NWAVES * 64) { ccr[(i >> 6) * CS + (i & 63)] = c_re[g * 1024 + i]; cci[(i >> 6) * CS + (i & 63)] = c_im[g * 1024 + i]; }
    __syncthreads();
    {
        const int pair = tid & 255, co = pair >> 4, ci = pair & 15, t0 = (tid >> 8) * 16;
        float acc[16];
#pragma unroll
        for (int t = 0; t < 16; ++t) acc[t] = 0.f;
        for (int p = 0; p < NP; ++p) { const float cr = ccr[co * CS + p], cim = cci[co * CS + p], xr = bbr[p * BS + ci], xi = bbi[p * BS + ci];
            const float gr = cr * xr - cim * xi, gi = cr * xi + cim * xr;
#pragma unroll
            for (int t = 0; t < 16; ++t) acc[t] += gr * pwr[(t0 + t) * PS + p] - gi * pwi[(t0 + t) * PS + p]; }
#pragma unroll
        for (int t = 0; t < 16; ++t) km[(t0 + t) * KT + co * KC + ci] = acc[t];
    }
    __syncthreads();
    {
        const int n = tid, i = n >> 4, co = n & 15; const float dv = dsk[g * GC + co];
        bf16* dst = TW + ((size_t)g * 512 + n) * UK;
        for (int j = 0; j < LC; ++j) {
            float v[16];
#pragma unroll
            for (int ci = 0; ci < 16; ++ci) { float val = (j <= i) ? km[(j <= i ? i - j : 0) * KT + co * KC + ci] : 0.f; if (j == i && ci == co) val += dv; v[ci] = val; }
            v4u o0, o1; o0.x = pg8::cvt_pk_bf16(v[0], v[1]); o0.y = pg8::cvt_pk_bf16(v[2], v[3]); o0.z = pg8::cvt_pk_bf16(v[4], v[5]); o0.w = pg8::cvt_pk_bf16(v[6], v[7]);
            o1.x = pg8::cvt_pk_bf16(v[8], v[9]); o1.y = pg8::cvt_pk_bf16(v[10], v[11]); o1.z = pg8::cvt_pk_bf16(v[12], v[13]); o1.w = pg8::cvt_pk_bf16(v[14], v[15]);
            *(GAS v4u*)(dst + j * 16) = o0; *(GAS v4u*)(dst + j * 16 + 8) = o1; }
        for (int k8 = 0; k8 < 16; ++k8) { float v[8];
#pragma unroll
            for (int e = 0; e < 8; ++e) { const int k = k8 * 8 + e, ri = k >> 6, p = k & 63; const float cr = ccr[co * CS + p], cim = cci[co * CS + p], pr = pwr[(i + 1) * PS + p], pi = pwi[(i + 1) * PS + p];
                v[e] = ri == 0 ? (cr * pr - cim * pi) : -(cr * pi + cim * pr); }
            v4u o; o.x = pg8::cvt_pk_bf16(v[0], v[1]); o.y = pg8::cvt_pk_bf16(v[2], v[3]); o.z = pg8::cvt_pk_bf16(v[4], v[5]); o.w = pg8::cvt_pk_bf16(v[6], v[7]);
            *(GAS v4u*)(dst + 512 + k8 * 8) = o; }
    }
    {
        const int row = tid & 127, ri = row >> 6, p = row & 63, kq = tid >> 7;
        bf16* dst = WE + ((size_t)g * 128 + row) * 512 + kq * 128;
        for (int k8 = 0; k8 < 16; ++k8) { float v[8];
#pragma unroll
            for (int e = 0; e < 8; ++e) { const int k = kq * 128 + k8 * 8 + e, j = k >> 4, c = k & 15; const float pr = pwr[(31 - j) * PS + p], pi = pwi[(31 - j) * PS + p], xr = bbr[p * BS + c], xi = bbi[p * BS + c];
                v[e] = ri == 0 ? (pr * xr - pi * xi) : (pr * xi + pi * xr); }
            v4u o; o.x = pg8::cvt_pk_bf16(v[0], v[1]); o.y = pg8::cvt_pk_bf16(v[2], v[3]); o.z = pg8::cvt_pk_bf16(v[4], v[5]); o.w = pg8::cvt_pk_bf16(v[6], v[7]);
            *(GAS v4u*)(dst + k8 * 8) = o; }
    }
    __syncthreads();
}
__device__ __forceinline__ void rms_rows2_to_bf16(int lane, const float* x0, const float* x1, const float* g, bf16* o0, bf16* o1) {
    const GAS f32x4* xa = (const GAS f32x4*)x0 + lane; const GAS f32x4* xb = (const GAS f32x4*)x1 + lane; const GAS f32x4* gr = (const GAS f32x4*)g + lane;
    f32x4 va[4], vb[4]; float sa = 0.f, sb = 0.f;
#pragma unroll
    for (int j = 0; j < 4; ++j) { va[j] = xa[64 * j]; vb[j] = xb[64 * j]; }
#pragma unroll
    for (int j = 0; j < 4; ++j) { sa += (va[j].x * va[j].x + va[j].y * va[j].y) + (va[j].z * va[j].z + va[j].w * va[j].w); sb += (vb[j].x * vb[j].x + vb[j].y * vb[j].y) + (vb[j].z * vb[j].z + vb[j].w * vb[j].w); }
#pragma unroll
    for (int o = 1; o < 64; o <<= 1) { sa += __shfl_xor(sa, o); sb += __shfl_xor(sb, o); }
    const float ra = 1.0f / sqrtf(sa * (1.f / D) + EPS), rb = 1.0f / sqrtf(sb * (1.f / D) + EPS);
    GAS v2u* pa = (GAS v2u*)o0 + lane; GAS v2u* pb = (GAS v2u*)o1 + lane;
#pragma unroll
    for (int j = 0; j < 4; ++j) { const f32x4 gg = gr[64 * j];
        v2u wa, wb; wa.x = pg8::cvt_pk_bf16(va[j].x * ra * gg.x, va[j].y * ra * gg.y); wa.y = pg8::cvt_pk_bf16(va[j].z * ra * gg.z, va[j].w * ra * gg.w);
        wb.x = pg8::cvt_pk_bf16(vb[j].x * rb * gg.x, vb[j].y * rb * gg.y); wb.y = pg8::cvt_pk_bf16(vb[j].z * rb * gg.z, vb[j].w * rb * gg.w);
        pa[64 * j] = wa; pb[64 * j] = wb; }
}
constexpr int Q0_EXP = CV_N_EXP, Q0_HN = Q0_EXP + M / 8, Q0_END = Q0_HN + CV_N_EARLY / 4;
static_assert(Q0_END % 8 == 0 && CV_N_EARLY % 4 == 0, "P0 queue");
__device__ __forceinline__ void p0_prologue(Frame& F, unsigned long long& t_lo_, unsigned long long& t_hi_) {
    TMARK(100);
    const bool tabler = (F.vcu & 7) == 0 && (F.vcu >> 3) < NG;
    if (tabler) { ssm_tables(F, F.vcu >> 3);
        if ((F.vcu >> 3) == 0 && F.tid < 128) {
            bf16* WE = (bf16*)(F.ws + WS_WE) + (size_t)NG * 128 * 512;
            for (int i = 0; i < 512 / 8; ++i) *(GAS v4u*)(WE + (size_t)F.tid * 512 + i * 8) = (v4u){0u, 0u, 0u, 0u}; } }
    if (tabler && (F.vcu >> 3) == 1) {
        const float* wr = F.in[16]; bf16* img = (bf16*)(F.ws + WS_RWIMG);
        for (int idx = F.tid; idx < D * NE; idx += NWAVES * 64) { const float w = wr[idx]; const unsigned h = f2bf(w); const unsigned l = f2bf(w - bf2f((unsigned short)h)); const int k = idx >> 5, e = idx & 31;
            img[e * RT_WSTR + k] = (bf16)h; img[(NE + e) * RT_WSTR + k] = (bf16)l; }
        if (F.tid < 2 * NE) for (int k = D; k < RT_WSTR; ++k) img[F.tid * RT_WSTR + k] = 0; }
    TMARK(101);
    LAS float* scr = (LAS float*)(F.lds + RING_OFF + F.wave * 16384);
    unsigned* q = (unsigned*)(F.ctl + CW_Q0); volatile LAS unsigned* slot = F.MISC + 16;
    bf16* HN = (bf16*)(F.ws + WS_HN);
    for (;;) {
        __syncthreads();
        if (F.tid == 0) *slot = __hip_atomic_fetch_add(q, 8u, RLX_AGENT);
        __syncthreads();
        const int base = (int)__builtin_amdgcn_readfirstlane(*slot); if (base >= Q0_END) break;
        const int idx = base + F.wave;
        if (idx < Q0_EXP) xv_item(F, idx);
        else if (idx < Q0_HN) { const int m0 = (idx - Q0_EXP) * 8;
#pragma unroll 1
            for (int j = 0; j < 4; ++j) { const int m = m0 + 2 * j; rms_rows2_to_bf16(F.lane, F.in[0] + (size_t)m * D, F.in[0] + (size_t)(m + 1) * D, F.in[1], HN + (size_t)m * D, HN + (size_t)(m + 1) * D); } }
        else { const int g4 = (idx - Q0_HN) * 4;
#pragma unroll 1
            for (int j = 0; j < 4; ++j) cv_item_early(F, g4 + j, scr); }
    }
    TMARK(104);
}

__device__ __forceinline__ void attn_simple_unit(const unsigned short* Qh, const unsigned short* Kh, const unsigned short* Vh, bf16* Y, int b, int h, int qb, int lane) {
    const int t = qb * 64 + lane; const size_t row = (size_t)b * SEQ + t;
    float q[64], o[64];
    { const v4u* qp = (const v4u*)(Qh + row * SBW + h * HD);
#pragma unroll
      for (int i = 0; i < 8; ++i) { const v4u w = qp[i];
#pragma unroll
          for (int j = 0; j < 4; ++j) { const unsigned wj = w[j]; const h16x2 hv = __builtin_bit_cast(h16x2, wj); q[8 * i + 2 * j] = (float)hv.x; q[8 * i + 2 * j + 1] = (float)hv.y; } } }
#pragma unroll
    for (int d = 0; d < 64; ++d) o[d] = 0.f;
    float cum = 0.f;
    for (int s = qb * 64 + 62; s >= 0; --s) {
        const size_t krow = ((size_t)b * SEQ + s) * SBW + h * HD;
        const v4u* kp = (const v4u*)(Kh + krow); const v4u* vp = (const v4u*)(Vh + krow);
        float z = 0.f;
#pragma unroll
        for (int i = 0; i < 8; ++i) { const v4u w = kp[i];
#pragma unroll
            for (int j = 0; j < 4; ++j) { const unsigned wj = w[j]; const h16x2 hv = __builtin_bit_cast(h16x2, wj); z = fmaf(q[8 * i + 2 * j], (float)hv.x, z); z = fmaf(q[8 * i + 2 * j + 1], (float)hv.y, z); } }
        const bool act = s < t;
        const float t1 = flog2(1.0f + fexp2(-fabsf(z)));
        const float L = act ? -(fmaxf(z, 0.f) + t1) : 0.f;
        const float ls = fminf(z, 0.f) - t1;
        const float p = act ? fexp2(ls + cum) : 0.f;
        cum += L;
#pragma unroll
        for (int i = 0; i < 8; ++i) { const v4u w = vp[i];
#pragma unroll
            for (int j = 0; j < 4; ++j) { const unsigned wj = w[j]; const h16x2 hv = __builtin_bit_cast(h16x2, wj); o[8 * i + 2 * j] = fmaf(p, (float)hv.x, o[8 * i + 2 * j]); o[8 * i + 2 * j + 1] = fmaf(p, (float)hv.y, o[8 * i + 2 * j + 1]); } }
        if (__all(cum < -150.0f)) break;
    }
    bf16* yp = Y + row * SBW + h * HD;
#pragma unroll
    for (int i = 0; i < 8; ++i) { v4u w; w.x = pk2(o[8 * i], o[8 * i + 1]); w.y = pk2(o[8 * i + 2], o[8 * i + 3]); w.z = pk2(o[8 * i + 4], o[8 * i + 5]); w.w = pk2(o[8 * i + 6], o[8 * i + 7]); *(v4u*)(yp + 8 * i) = w; }
}
typedef _Float16 h8v __attribute__((ext_vector_type(8)));
typedef float f16v __attribute__((ext_vector_type(16)));
__device__ __forceinline__ void attn_mfma_unit(const _Float16* Qh, const _Float16* Kh, const _Float16* VT, bf16* Y, int b, int hd, int qb, int lane, h8v tri0, h8v tri1) {
    const int r = lane & 31, hh = lane >> 5, q0 = qb * 32;
    const _Float16* qrow = Qh + ((size_t)b * SEQ + q0 + r) * SBW + hd * HD + 8 * hh;
    h8v qf[4];
#pragma unroll
    for (int kd = 0; kd < 4; ++kd) qf[kd] = *(const h8v*)(qrow + 16 * kd);
    f16v o0, o1;
#pragma unroll
    for (int i = 0; i < 16; ++i) { o0[i] = 0.f; o1[i] = 0.f; }
    float carry = 0.f;
    const _Float16* kbase = Kh + ((size_t)b * SEQ + r) * SBW + hd * HD + 8 * hh;
    const _Float16* vbase = VT + ((size_t)b * SBW + hd * HD + r) * SEQ + 8 * hh;
    h8v kf[4], vf[2][2], kn[4], vn[2][2];
#pragma unroll
    for (int kd = 0; kd < 4; ++kd) kf[kd] = *(const h8v*)(kbase + (size_t)q0 * SBW + 16 * kd);
#pragma unroll
    for (int db = 0; db < 2; ++db)
#pragma unroll
        for (int ss = 0; ss < 2; ++ss) vf[db][ss] = *(const h8v*)(vbase + (size_t)(32 * db) * SEQ + q0 + 16 * ss);
    for (int key0 = q0; key0 >= 0; key0 -= 32) {
        { const int kn0 = key0 >= 32 ? key0 - 32 : key0;
#pragma unroll
          for (int kd = 0; kd < 4; ++kd) kn[kd] = *(const h8v*)(kbase + (size_t)kn0 * SBW + 16 * kd);
#pragma unroll
          for (int db = 0; db < 2; ++db)
#pragma unroll
              for (int ss = 0; ss < 2; ++ss) vn[db][ss] = *(const h8v*)(vbase + (size_t)(32 * db) * SEQ + kn0 + 16 * ss); }
        f16v z;
#pragma unroll
        for (int i = 0; i < 16; ++i) z[i] = 0.f;
#pragma unroll
        for (int kd = 0; kd < 4; ++kd) z = __builtin_amdgcn_mfma_f32_32x32x16_f16(kf[kd], qf[kd], z, 0, 0, 0);
        const bool diag = key0 == q0;
        h8v lh[2], ll[2];
#pragma unroll
        for (int i = 0; i < 16; ++i) { const int koff = (i & 3) + 8 * (i >> 2) + 4 * hh; const bool act = !diag || koff < r;
            const float zi = z[i]; const float t1 = flog2(1.0f + fexp2(-fabsf(zi)));
            const float L = act ? fmaxf(-(fmaxf(zi, 0.f) + t1), -60000.0f) : 0.f;
            const _Float16 hi = (_Float16)L; const _Float16 lo = (_Float16)(L - (float)hi);
            lh[i >> 3][i & 7] = hi; ll[i >> 3][i & 7] = lo; }
        f16v cum;
#pragma unroll
        for (int i = 0; i < 16; ++i) cum[i] = carry;
        cum = __builtin_amdgcn_mfma_f32_32x32x16_f16(tri0, lh[0], cum, 0, 0, 0);
        cum = __builtin_amdgcn_mfma_f32_32x32x16_f16(tri1, lh[1], cum, 0, 0, 0);
        cum = __builtin_amdgcn_mfma_f32_32x32x16_f16(tri0, ll[0], cum, 0, 0, 0);
        cum = __builtin_amdgcn_mfma_f32_32x32x16_f16(tri1, ll[1], cum, 0, 0, 0);
        h8v pf[2];
#pragma unroll
        for (int i = 0; i < 16; ++i) { const int koff = (i & 3) + 8 * (i >> 2) + 4 * hh; const bool act = !diag || koff < r;
            const float p = act ? fexp2(z[i] + cum[i]) : 0.f; pf[i >> 3][i & 7] = (_Float16)p; }
        o0 = __builtin_amdgcn_mfma_f32_32x32x16_f16(vf[0][0], pf[0], o0, 0, 0, 0);
        o0 = __builtin_amdgcn_mfma_f32_32x32x16_f16(vf[0][1], pf[1], o0, 0, 0, 0);
        o1 = __builtin_amdgcn_mfma_f32_32x32x16_f16(vf[1][0], pf[0], o1, 0, 0, 0);
        o1 = __builtin_amdgcn_mfma_f32_32x32x16_f16(vf[1][1], pf[1], o1, 0, 0, 0);
        carry = __shfl(cum[0], r);
        if (__all(carry < -150.0f)) break;
#pragma unroll
        for (int kd = 0; kd < 4; ++kd) kf[kd] = kn[kd];
#pragma unroll
        for (int db = 0; db < 2; ++db)
#pragma unroll
            for (int ss = 0; ss < 2; ++ss) vf[db][ss] = vn[db][ss];
    }
    bf16* yp = Y + ((size_t)b * SEQ + q0 + r) * SBW + hd * HD + 4 * hh;
#pragma unroll
    for (int g4 = 0; g4 < 4; ++g4) { v2u w0, w1; w0.x = pk2(o0[4 * g4], o0[4 * g4 + 1]); w0.y = pk2(o0[4 * g4 + 2], o0[4 * g4 + 3]); w1.x = pk2(o1[4 * g4], o1[4 * g4 + 1]); w1.y = pk2(o1[4 * g4 + 2], o1[4 * g4 + 3]);
        *(v2u*)(yp + 8 * g4) = w0; *(v2u*)(yp + 32 + 8 * g4) = w1; }
}
__device__ __forceinline__ void attn_one(Frame& F, int u) {
    const _Float16* Qh = (const _Float16*)(F.ws + WS_Q); const _Float16* Kh = (const _Float16*)(F.ws + WS_K); const _Float16* VT = (const _Float16*)(F.ws + WS_V);
    bf16* Y = (bf16*)(F.ws + WS_YSB);
    constexpr int NQB = SEQ / 32;
    const int lane = F.lane, r = lane & 31, hh = lane >> 5;
    h8v tri0, tri1;
#pragma unroll
    for (int e = 0; e < 8; ++e) { const int k0 = 8 * (e >> 2) + 4 * hh + (e & 3); tri0[e] = (k0 >= r) ? (_Float16)1.0f : (_Float16)0.0f; tri1[e] = (16 + k0 >= r) ? (_Float16)1.0f : (_Float16)0.0f; }
    const int qb = u % NQB, bh = u / NQB; attn_mfma_unit(Qh, Kh, VT, Y, bh / NH, bh % NH, qb, lane, tri0, tri1);
}

__device__ __forceinline__ void scan_phase(Frame& F) {
    const int task = F.vcu;
    const int b = task / NG, g = task % NG, p = F.lane;
    const float* lamL = (const float*)(F.ws + WS_LAML); const float* S = (const float*)(F.ws + WS_SLOC); bf16* U = (bf16*)(F.ws + WS_UCAT);
    const float lr = lamL[(g * 2 + 0) * NP + p], li = lamL[(g * 2 + 1) * NP + p];
    float xr = 0.f, xi = 0.f;
    for (int c0 = 0; c0 < CPB; c0 += 8) {
        float sr[8], si[8];
#pragma unroll
        for (int j = 0; j < 8; ++j) { const size_t base = ((size_t)(b * CPB + c0 + j) * NG + g) * 128; sr[j] = S[base + p]; si[j] = S[base + 64 + p]; }
#pragma unroll
        for (int j = 0; j < 8; ++j) { bf16* dst = U + ((size_t)(b * CPB + c0 + j) * NG + g) * UK + 512;
            dst[p] = (bf16)f2bf(xr); dst[64 + p] = (bf16)f2bf(xi);
            const float nr = lr * xr - li * xi + sr[j], ni = lr * xi + li * xr + si[j]; xr = nr; xi = ni; }
    }
}

__device__ __forceinline__ void mix_phase(Frame& F) {
    const bf16* YSB = (const bf16*)(F.ws + WS_YSB); const bf16* YSSM = (const bf16*)(F.ws + WS_YSSM); bf16* MX = (bf16*)(F.ws + WS_MIXED);
    const float* g_sb = F.in[12]; const float* g_ssm = F.in[13];
    const int gw = F.vcu * NWAVES + F.wave, NGW = F.G * NWAVES, lane = F.lane;
    f32x4 ga[2], gb[2];
#pragma unroll
    for (int j = 0; j < 2; ++j) { ga[j] = *(const f32x4*)(g_sb + 8 * lane + 4 * j); gb[j] = *(const f32x4*)(g_ssm + 8 * lane + 4 * j); }
    for (int m = gw; m < M; m += NGW) {
        const v4u a = *(const v4u*)(YSB + (size_t)m * SBW + 8 * lane), c = *(const v4u*)(YSSM + (size_t)m * SSW + 8 * lane);
        float av[8], cv[8]; float sa = 0.f, sc = 0.f;
#pragma unroll
        for (int j = 0; j < 4; ++j) { av[2 * j] = bflo(a[j]); av[2 * j + 1] = bfhi(a[j]); cv[2 * j] = bflo(c[j]); cv[2 * j + 1] = bfhi(c[j]); }
#pragma unroll
        for (int j = 0; j < 8; ++j) { sa += av[j] * av[j]; sc += cv[j] * cv[j]; }
        const float ra = 1.0f / sqrtf(wave_sum(sa) * (1.f / SBW) + EPS), rc = 1.0f / sqrtf(wave_sum(sc) * (1.f / SSW) + EPS);
        v4u oa, oc;
#pragma unroll
        for (int j = 0; j < 4; ++j) { oa[j] = pk2(av[2 * j] * ra * ga[j >> 1][(2 * j) & 3], av[2 * j + 1] * ra * ga[j >> 1][(2 * j + 1) & 3]);
                                      oc[j] = pk2(cv[2 * j] * rc * gb[j >> 1][(2 * j) & 3], cv[2 * j + 1] * rc * gb[j >> 1][(2 * j + 1) & 3]); }
        if (DBG_MODE == 3) oa = (v4u){0u, 0u, 0u, 0u};
        if (DBG_MODE == 2) oc = (v4u){0u, 0u, 0u, 0u};
        *(v4u*)(MX + (size_t)m * D + 8 * lane) = oa; *(v4u*)(MX + (size_t)m * D + SBW + 8 * lane) = oc;
    }
}

__device__ __forceinline__ void router_phase(Frame& F) {
    typedef short s8v __attribute__((ext_vector_type(8)));
    typedef float f16v __attribute__((ext_vector_type(16)));
    LAS bf16* wh = (LAS bf16*)F.lds; LAS bf16* wl = wh + NE * RT_WSTR;
    LAS int* lcnt = (LAS int*)(F.lds + RT_SCR_OFF); LAS int* lbase = lcnt + 32; LAS int* asg = lbase + 32;
    const float* wr = F.in[16]; const float* br = F.in[17]; const float* g2 = F.in[15];
    const float* X1 = F.out; bf16* XG = (bf16*)(F.ws + WS_XN); float* gates = (float*)(F.ws + WS_GATES); int* lists = (int*)(F.ws + WS_LISTS); float* RS = (float*)(F.ws + WS_RSTD);
    unsigned* gcnt = (unsigned*)(F.ctl + CW_CNT);
    const int tid = F.tid, lane = F.lane, r = lane & 31, hh = lane >> 5;
    const int task = F.wave >> 2, kq = F.wave & 3; const int tok = F.vcu * 64 + task * 32 + r;
    const float* xp = X1 + (size_t)tok * D + kq * 256 + 8 * hh; bf16* xo = XG + (size_t)tok * D + kq * 256 + 8 * hh;
    f32x4 xa[16], xb[16];
#pragma unroll
    for (int ks = 0; ks < 16; ++ks) { xa[ks] = *(const f32x4*)(xp + 16 * ks); xb[ks] = *(const f32x4*)(xp + 16 * ks + 4); }
    { const v4u* src = (const v4u*)(F.ws + WS_RWIMG); LAS v4u* dst = (LAS v4u*)F.lds;
      for (int i = tid; i < RT_W_BYTES / 16; i += NWAVES * 64) dst[i] = src[i]; }
    LAS float* gl = (LAS float*)(F.lds + RT_SCR_OFF + 2048);
    for (int i = tid; i < D / 4; i += NWAVES * 64) ((LAS f32x4*)gl)[i] = ((const f32x4*)g2)[i];
    if (tid < 32) lcnt[tid] = 0;
    __syncthreads();
    f16v acc;
#pragma unroll
    for (int i = 0; i < 16; ++i) acc[i] = 0.f;
    float ss = 0.f;
    const LAS float* gp = gl + kq * 256 + 8 * hh;
    const LAS bf16* whp = wh + r * RT_WSTR + kq * 256 + 8 * hh; const LAS bf16* wlp = wl + r * RT_WSTR + kq * 256 + 8 * hh;
#pragma unroll
    for (int ks = 0; ks < 16; ++ks) {
        const f32x4 x0 = xa[ks], x1 = xb[ks], g0 = *(const LAS f32x4*)(gp + 16 * ks), g1 = *(const LAS f32x4*)(gp + 16 * ks + 4);
        ss += (x0.x * x0.x + x0.y * x0.y) + (x0.z * x0.z + x0.w * x0.w) + (x1.x * x1.x + x1.y * x1.y) + (x1.z * x1.z + x1.w * x1.w);
        const f32x4 a0 = x0 * g0, a1 = x1 * g1;
        v4u hv, lv;
        hv.x = pg8::cvt_pk_bf16(a0.x, a0.y); hv.y = pg8::cvt_pk_bf16(a0.z, a0.w); hv.z = pg8::cvt_pk_bf16(a1.x, a1.y); hv.w = pg8::cvt_pk_bf16(a1.z, a1.w);
        lv.x = pg8::cvt_pk_bf16(a0.x - bflo(hv.x), a0.y - bfhi(hv.x)); lv.y = pg8::cvt_pk_bf16(a0.z - bflo(hv.y), a0.w - bfhi(hv.y));
        lv.z = pg8::cvt_pk_bf16(a1.x - bflo(hv.z), a1.y - bfhi(hv.z)); lv.w = pg8::cvt_pk_bf16(a1.z - bflo(hv.w), a1.w - bfhi(hv.w));
        *(v4u*)(xo + 16 * ks) = hv;
        const s8v xh = __builtin_bit_cast(s8v, hv), xl = __builtin_bit_cast(s8v, lv);
        v4u ah, al; { const LAS v2u* p = (const LAS v2u*)(whp + 16 * ks); const v2u q0 = p[0], q1 = p[1]; ah.x = q0.x; ah.y = q0.y; ah.z = q1.x; ah.w = q1.y; }
        { const LAS v2u* p = (const LAS v2u*)(wlp + 16 * ks); const v2u q0 = p[0], q1 = p[1]; al.x = q0.x; al.y = q0.y; al.z = q1.x; al.w = q1.y; }
        const s8v wa = __builtin_bit_cast(s8v, ah), wb = __builtin_bit_cast(s8v, al);
        acc = __builtin_amdgcn_mfma_f32_32x32x16_bf16(wa, xh, acc, 0, 0, 0);
        acc = __builtin_amdgcn_mfma_f32_32x32x16_bf16(wb, xh, acc, 0, 0, 0);
        acc = __builtin_amdgcn_mfma_f32_32x32x16_bf16(wa, xl, acc, 0, 0, 0);
    }
    __syncthreads();
    LAS float* part = (LAS float*)F.lds;
#pragma unroll
    for (int i = 0; i < 16; ++i) part[(F.wave * 17 + i) * 64 + lane] = acc[i];
    part[(F.wave * 17 + 16) * 64 + lane] = ss;
    __syncthreads();
    if (kq == 0) {
        float v[32]; float st = 0.f;
#pragma unroll
        for (int w = 0; w < 4; ++w) { const LAS float* pw = part + (size_t)((task * 4 + w) * 17) * 64;
#pragma unroll
            for (int i = 0; i < 16; ++i) { const float t = pw[i * 64 + lane]; v[i] = w == 0 ? t : v[i] + t; }
            st += pw[16 * 64 + lane] + pw[16 * 64 + (lane ^ 32)]; }
        const float rstd = 1.0f / sqrtf(st * (1.f / D) + EPS);
        if (hh == 0) RS[tok] = rstd;
#pragma unroll
        for (int i = 0; i < 16; ++i) { const int e = (i & 3) + 8 * (i >> 2) + 4 * hh; v[i] = v[i] * rstd + br[e]; }
#pragma unroll
        for (int i = 0; i < 16; ++i) v[16 + i] = __shfl_xor(v[i], 32);
        float mx = v[0];
#pragma unroll
        for (int i = 1; i < 32; ++i) mx = fmaxf(mx, v[i]);
        int rk[16]; float es = 0.f;
#pragma unroll
        for (int i = 0; i < 16; ++i) { const int ei = (i & 3) + 8 * (i >> 2) + 4 * hh; int rank = 0;
#pragma unroll
            for (int j = 0; j < 32; ++j) { if (j == i) continue; const int ej = (j & 3) + 8 * ((j & 15) >> 2) + 4 * (j < 16 ? hh : 1 - hh);
                rank += (v[j] > v[i] || (v[j] == v[i] && ej < ei)) ? 1 : 0; }
            rk[i] = rank; if (rank < TOPK) es += fexp2((v[i] - mx) * LOG2E); }
        es += __shfl_xor(es, 32);
        const float inv = 1.0f / es;
#pragma unroll
        for (int i = 0; i < 16; ++i) if (rk[i] < TOPK) { const int ei = (i & 3) + 8 * (i >> 2) + 4 * hh;
            gates[tok * TOPK + rk[i]] = fexp2((v[i] - mx) * LOG2E) * inv;
            const int pos = __hip_atomic_fetch_add(lcnt + ei, 1, __ATOMIC_RELAXED, __HIP_MEMORY_SCOPE_WORKGROUP);
            asg[(task * 32 + r) * 4 + rk[i]] = ei | (pos << 8); }
    }
    __syncthreads();
    if (tid < 32) lbase[tid] = (int)__hip_atomic_fetch_add(gcnt + tid, (unsigned)lcnt[tid], RLX_AGENT);
    __syncthreads();
    if (tid < 64 * TOPK) { const int a = asg[tid], e = a & 255, pos = a >> 8; const int tk = F.vcu * 64 + (tid >> 2);
        lists[e * M + lbase[e] + pos] = tk * TOPK + (tid & 3); }
    __syncthreads();
}

__device__ __forceinline__ void moe_tables(Frame& F) {
    LAS int* tab = (LAS int*)(F.lds + TAB_OFF); LAS int* cnt = tab, * mt = tab + 32, * tbase = tab + 64;
    unsigned* gcnt = (unsigned*)(F.ctl + CW_CNT);
    if (F.tid < 32) { const int c = (int)__hip_atomic_load(gcnt + F.tid, RLX_AGENT); cnt[F.tid] = c; mt[F.tid] = (c + 255) >> 8; }
    __syncthreads();
    if (F.tid == 0) { int s = 0; for (int e = 0; e < NE; ++e) { tbase[e] = s; s += mt[e]; } tbase[NE] = s; }
    __syncthreads();
}
__device__ __forceinline__ void moe_units(Frame& F, int npn, int gpn) {
    LAS int* tab = (LAS int*)(F.lds + TAB_OFF); LAS int* mt = tab + 32, * tbase = tab + 64; LAS int* units = (LAS int*)(F.lds + UNITS_OFF);
    if (F.tid < 32) {
        const int nU = tbase[NE] * npn; const int L = F.tid * F.G + (int)blockIdx.x; int pm = 0, pn = 0, e = 0, valid = 0;
        if (L < nU) { const int seq = pg8::xcd_remap(L, nU); int ee = 0; while (ee < NE - 1 && seq >= tbase[ee + 1] * npn) ++ee;
            const int r = seq - tbase[ee] * npn, m = mt[ee]; const int grp = r / (m * gpn), r2 = r % (m * gpn);
            e = ee; pn = grp * gpn + r2 / m; pm = tbase[ee] + r2 % m; valid = 1; }
        units[4 * F.tid + 0] = pm; units[4 * F.tid + 1] = pn; units[4 * F.tid + 2] = e; units[4 * F.tid + 3] = valid;
    }
    __syncthreads();
}

__device__ __forceinline__ void gather_phase(Frame& F) {
    LAS int* tab = (LAS int*)(F.lds + TAB_OFF); LAS int* cnt = tab, * tbase = tab + 64; LAS int* tile_e = (LAS int*)(F.lds + TILEE_OFF);
    const int ntiles = tbase[NE];
    for (int t = F.tid; t < ntiles; t += NWAVES * 64) { int ee = 0; while (ee < NE - 1 && t >= tbase[ee + 1]) ++ee; tile_e[t] = ee; }
    __syncthreads();
    const bf16* XN = (const bf16*)(F.ws + WS_XN); bf16* XS = (bf16*)(F.ws + WS_XS); const float* gates = (const float*)(F.ws + WS_GATES); const int* lists = (const int*)(F.ws + WS_LISTS);
    int* rowinfo = (int*)(F.ws + WS_ROWINFO); const float* RS = (const float*)(F.ws + WS_RSTD);
    const int gw = F.vcu * NWAVES + F.wave, NGW = F.G * NWAVES, lane = F.lane;
    for (int r = gw; r < ntiles * 256; r += NGW) {
        const int e = tile_e[r >> 8], i = r - tbase[e] * 256;
        v4u a0 = (v4u){0u, 0u, 0u, 0u}, a1 = a0; int slot = -1; float gate = 0.f, rs = 0.f;
        if (i < cnt[e]) { slot = lists[e * M + i]; gate = gates[slot]; rs = RS[slot >> 2]; const v4u* src = (const v4u*)(XN + (size_t)(slot >> 2) * D); a0 = src[lane]; a1 = src[64 + lane]; }
        v4u* dst = (v4u*)(XS + (size_t)r * D); dst[lane] = a0; dst[64 + lane] = a1;
        if (lane == 0) { *(v4u*)(rowinfo + 4 * r) = (v4u){(unsigned)slot, __builtin_bit_cast(unsigned, gate), __builtin_bit_cast(unsigned, rs), 0u}; }
    }
}

__device__ __forceinline__ void final_phase(Frame& F) {
    const bf16* YB = (const bf16*)(F.ws + WS_YBUF); const float* gf = F.in[24]; float* O = F.out;
    const int gw = F.vcu * NWAVES + F.wave, NGW = F.G * NWAVES, lane = F.lane;
    f32x4 gg[4];
#pragma unroll
    for (int j = 0; j < 4; ++j) gg[j] = *(const f32x4*)(gf + 4 * lane + 256 * j);
    for (int m = gw; m < M; m += NGW) {
        f32x4 v[4]; float ss = 0.f;
#pragma unroll
        for (int j = 0; j < 4; ++j) { v[j] = *(const f32x4*)(O + (size_t)m * D + 4 * lane + 256 * j);
#pragma unroll
            for (int k = 0; k < (DBG_MODE ? 0 : TOPK); ++k) { const v2u w = *(const v2u*)(YB + ((size_t)m * TOPK + k) * D + 4 * lane + 256 * j); v[j].x += bflo(w.x); v[j].y += bfhi(w.x); v[j].z += bflo(w.y); v[j].w += bfhi(w.y); }
            ss += (v[j].x * v[j].x + v[j].y * v[j].y) + (v[j].z * v[j].z + v[j].w * v[j].w); }
        const float rstd = 1.0f / sqrtf(wave_sum(ss) * (1.f / D) + EPS);
#pragma unroll
        for (int j = 0; j < 4; ++j) *(f32x4*)(O + (size_t)m * D + 4 * lane + 256 * j) = v[j] * rstd * gg[j];
    }
}

struct Args { const float* in[25]; float* out; unsigned char* ws; int ph_lo, ph_hi, li, pad; };
__global__ void __launch_bounds__(NWAVES * 64, 2) hyb_fwd(Args args) {
    extern __shared__ __attribute__((aligned(16))) unsigned char lds[];
    Frame F;
    F.lds = (LAS unsigned char*)lds;
    F.MISC = (volatile LAS unsigned*)(F.lds + MISC_OFF);
    F.tid = threadIdx.x; F.lane = F.tid & 63; F.wave = __builtin_amdgcn_readfirstlane(F.tid >> 6);
    F.G = gridDim.x; { const int bx = blockIdx.x; F.vcu = (F.G % 8 == 0) ? (bx % 8) * (F.G / 8) + bx / 8 : bx; }
    F.ws = args.ws; F.ctl = (gu32*)(args.ws + WS_CTL); F.out = args.out;
#pragma unroll
    for (int i = 0; i < 25; ++i) F.in[i] = args.in[i];
    for (int u = F.tid; u < (LDS_BYTES - LDSCTL_OFF) / 4; u += NWAVES * 64) ((LAS unsigned*)(F.lds + LDSCTL_OFF))[u] = 0u;
    __syncthreads();
    XcdBarrier bar; bar.bar = (unsigned*)(F.ctl + CW_BAR); bar.x = 0; bar.st = nullptr;
    if (N_LAUNCHES != PER_PHASE) bar = xcd_barrier_post((unsigned*)(F.ctl + CW_BAR), F.MISC + 8);
#define GRID_BAR(seam) do { if (N_LAUNCHES == PER_PHASE) { if (F.tid == 0) __hip_atomic_store(F.ctl + CW_TMO, 0xBADBA0u | (unsigned)(seam), RLX_AGENT); } else { xcd_barrier(bar); } } while (0)
    const int lo = args.ph_lo, hi = args.ph_hi;
#define IN(k) (lo <= (k) && (k) < hi)
#define BOTH(k) (IN(k) && IN((k) + 1))
    const pg8::bf16_t* wsb = (const pg8::bf16_t*)args.ws;
#define WSB(off) ((const pg8::bf16_t*)(args.ws + (off)))

    unsigned long long t_lo_ = 0, t_hi_ = 0;
    TMARK(0);
    if (IN(0)) for (int rep_ = 0; rep_ < NREP(0); ++rep_) { p0_prologue(F, t_lo_, t_hi_); if (BOTH(0)) GRID_BAR(0); }

    TMARK(1);
    if (IN(1)) for (int rep_ = 0; rep_ < NREP(1); ++rep_) {
        pg8::Gemm g = pg8::make_gemm(WSB(WS_HN), WSB(WS_WINT), D, D, D); InProjOrder S{F.G, (int)blockIdx.x};
        EpiInProj E{(unsigned short*)(args.ws + WS_Q), (bf16*)(args.ws + WS_UCAT), LOG2E * 0.125f};
        pg8::gemm_phase<EpiInProj, InProjOrder, PG8_ALIGN, PG8_SP2>(F.lds + RING_OFF, g, S, E);
        if (BOTH(1)) GRID_BAR(1);
    }
    TMARK(2);
    if (IN(2)) for (int rep_ = 0; rep_ < NREP(2); ++rep_) {
        pg8::Gemm g = pg8::make_gemm(WSB(WS_UCAT), WSB(WS_WE), NG * UK, 512, 512); SsmOrder S{NG * 2, F.G, (int)blockIdx.x, 1, 128, 512};
        EpiSloc E{(float*)(args.ws + WS_SLOC)};
        pg8::gemm_phase<EpiSloc, SsmOrder, PG8_ALIGN, PG8_SP2>(F.lds + RING_OFF, g, S, E);
        if (blockIdx.x >= NG * 2) attn_one(F, ((int)blockIdx.x - NG * 2) * 8 + F.wave);
        if (BOTH(2)) GRID_BAR(2);
    }
    TMARK(3);
    if (IN(3)) for (int rep_ = 0; rep_ < NREP(3); ++rep_) {
        if (F.vcu < BATCH * NG) { if (F.wave == 0) scan_phase(F); else attn_one(F, 3072 + F.vcu * 7 + F.wave - 1); }
        else attn_one(F, 1536 + (F.vcu - BATCH * NG) * 8 + F.wave);
        if (BOTH(3)) GRID_BAR(3); }
    TMARK(4);
    if (IN(4)) for (int rep_ = 0; rep_ < NREP(4); ++rep_) {
        pg8::Gemm g = pg8::make_gemm(WSB(WS_UCAT), WSB(WS_TW), NG * UK, UK, UK); SsmOrder S{NG * 4, F.G, (int)blockIdx.x, 2, 512, UK};
        EpiS3 E{(bf16*)(args.ws + WS_YG)};
        pg8::gemm_phase<EpiS3, SsmOrder, PG8_ALIGN, PG8_SP2>(F.lds + RING_OFF, g, S, E);
        if (blockIdx.x >= NG * 4 && blockIdx.x < NG * 4 + 72) attn_one(F, 3520 + ((int)blockIdx.x - NG * 4) * 8 + F.wave);
        if (BOTH(4)) GRID_BAR(4);
    }
    TMARK(5);
    if (IN(5)) for (int rep_ = 0; rep_ < NREP(5); ++rep_) {
        pg8::Gemm g = pg8::make_gemm(WSB(WS_YG), WSB(WS_WGLUT), SSW, SSW, SSW); pg8::StaticOrder S; S.init(M, 2 * SSW, F.G, (int)blockIdx.x, SSW, SSW);
        EpiGlu E{(bf16*)(args.ws + WS_YSSM)};
        pg8::gemm_phase<EpiGlu, pg8::StaticOrder, PG8_ALIGN, PG8_SP2>(F.lds + RING_OFF, g, S, E);
        if (BOTH(5)) GRID_BAR(5);
    }
    TMARK(6);
    if (IN(6)) for (int rep_ = 0; rep_ < NREP(6); ++rep_) { mix_phase(F); if (BOTH(6)) GRID_BAR(6); }
    TMARK(7);
    if (IN(7)) for (int rep_ = 0; rep_ < NREP(7); ++rep_) {
        pg8::Gemm g = pg8::make_gemm(WSB(WS_MIXED), WSB(WS_WOUTT), D, D, D); pg8::StaticOrder S; S.init(M, D, F.G, (int)blockIdx.x, D, D);
        EpiOutProj E{F.in[0], F.out};
        pg8::gemm_phase<EpiOutProj, pg8::StaticOrder, PG8_ALIGN, PG8_SP2>(F.lds + RING_OFF, g, S, E);
        if (BOTH(7)) GRID_BAR(7);
    }
    TMARK(8);
    if (IN(8) && !DBG_MODE) for (int rep_ = 0; rep_ < NREP(8); ++rep_) { router_phase(F); if (BOTH(8)) GRID_BAR(8); }
    TMARK(9);
    if (IN(9) && !DBG_MODE) for (int rep_ = 0; rep_ < NREP(9); ++rep_) { moe_tables(F); gather_phase(F); if (BOTH(9)) GRID_BAR(9); }
    TMARK(10);
    if (IN(10) && !DBG_MODE) for (int rep_ = 0; rep_ < NREP(10); ++rep_) {
        moe_tables(F); moe_units(F, 8, 4);
        pg8::Gemm g = pg8::make_gemm(WSB(WS_XS), WSB(WS_W1T), D, D, D); g.brs = 16u; g.bks = 2u * FF * 16u; MoeOrder S{(const LAS int*)(F.lds + UNITS_OFF), (long)2 * FF * D * 2};
        EpiMoe1 E{(bf16*)(args.ws + WS_H), F.in[19], F.in[21], (const int*)(args.ws + WS_ROWINFO)};
        pg8::gemm_phase<EpiMoe1, MoeOrder, PG8_ALIGN, PG8_SP2>(F.lds + RING_OFF, g, S, E);
        if (BOTH(10)) GRID_BAR(10);
    }
    TMARK(11);
    if (IN(11) && !DBG_MODE) for (int rep_ = 0; rep_ < NREP(11); ++rep_) {
        moe_tables(F); moe_units(F, 4, 4);
        pg8::Gemm g = pg8::make_gemm(WSB(WS_H), WSB(WS_W2T), FF, FF, FF); g.brs = 16u; g.bks = (unsigned)D * 16u; MoeOrder S{(const LAS int*)(F.lds + UNITS_OFF), (long)D * FF * 2};
        EpiMoe2 E{(bf16*)(args.ws + WS_YBUF), F.in[23], (const int*)(args.ws + WS_ROWINFO)};
        pg8::gemm_phase<EpiMoe2, MoeOrder, PG8_ALIGN, PG8_SP2>(F.lds + RING_OFF, g, S, E);
        if (BOTH(11)) GRID_BAR(11);
    }
    TMARK(12);
    if (IN(12)) for (int rep_ = 0; rep_ < NREP(12); ++rep_) { final_phase(F); }
    TMARK(13);
    if ((TIME_LO) >= 0 && blockIdx.x == (TIME_BLK) && F.tid == 0) { const unsigned long long te = __builtin_amdgcn_s_memrealtime(), dt = 4ull * (t_hi_ - t_lo_); while (__builtin_amdgcn_s_memrealtime() - te < dt) __builtin_amdgcn_s_sleep(32); }
    (void)wsb;
#undef IN
#undef BOTH
}

extern "C" void kernel_launch(void* const* d_in, const int* in_sizes, int n_in, void* d_out, int out_size, void* d_ws, size_t ws_size, hipStream_t stream) {
    static int grid = 0;
    if (grid == 0) {
        if (n_in != 25 || in_sizes[0] != M * D || out_size != M * D || ws_size < WS_END) { fprintf(stderr, "kernel_launch: unexpected shapes: n_in %d in0 %d out %d ws %zu (need %zu); nothing launched\n", n_in, n_in > 0 ? in_sizes[0] : -1, out_size, ws_size, (size_t)WS_END); grid = -1; return; }
        int dev = 0, cus = 0, per_cu = 0;
        if (hipGetDevice(&dev) != hipSuccess || hipDeviceGetAttribute(&cus, hipDeviceAttributeMultiprocessorCount, dev) != hipSuccess) { grid = -1; return; }
        if (hipFuncSetAttribute((const void*)hyb_fwd, hipFuncAttributeMaxDynamicSharedMemorySize, LDS_BYTES) != hipSuccess) { fprintf(stderr, "kernel_launch: hipFuncSetAttribute failed\n"); grid = -1; return; }
        if (hipOccupancyMaxActiveBlocksPerMultiprocessor(&per_cu, (const void*)hyb_fwd, NWAVES * 64, LDS_BYTES) != hipSuccess || per_cu < 1)
            fprintf(stderr, "kernel_launch: note: occupancy query reports %d workgroups per CU\n", per_cu);
        (void)hipGetLastError();
        grid = cus;
        if (grid != 256) fprintf(stderr, "kernel_launch: note: %d CUs (built for 256)\n", grid);
    }
    if (grid < 0) return;
    if (hipMemsetAsync((char*)d_ws + WS_CTL, 0, CTL_ZERO_BYTES, stream) != hipSuccess) { fprintf(stderr, "kernel_launch: memset failed\n"); return; }
    Args a{};
    for (int i = 0; i < 25; ++i) a.in[i] = (const float*)d_in[i];
    a.out = (float*)d_out; a.ws = (unsigned char*)d_ws;
    for (int li = 0; li < N_LAUNCHES; ++li) {
        a.ph_lo = (N_LAUNCHES == PER_PHASE) ? li : 0; a.ph_hi = (N_LAUNCHES == PER_PHASE) ? li + 1 : PER_PHASE; a.li = li;
        hipLaunchKernelGGL(hyb_fwd, dim3(grid), dim3(NWAVES * 64), LDS_BYTES, stream, a);
        const hipError_t le = hipPeekAtLastError();
        if (le != hipSuccess) { fprintf(stderr, "kernel_launch: launch %d failed: %s\n", li, hipGetErrorName(le)); break; }
    }
}
```

```cpp
#include <hip/hip_runtime.h>
#include <cstdio>
#include <cstdint>
namespace pg8 {
#define PG8_LAS __attribute__((address_space(3)))
typedef unsigned short bf16_t;
typedef short bf16x8 __attribute__((ext_vector_type(8)));
typedef float f32x4 __attribute__((ext_vector_type(4)));
typedef unsigned u32x4 __attribute__((ext_vector_type(4)));
constexpr int BM = 256, BK = 64, HALF = 128, HTB = HALF * BK * 2  , STAGE_BYTES = 8 * HTB, NXCD = 8, WGM = 8;

__host__ __device__ __forceinline__ int lds_byte(int r, int c) { const int st = (r >> 4) * 2 + (c >> 5), rr = r & 15, cc = c & 31, ob = rr * 64 + cc * 2; return st * 1024 + (ob ^ (((ob >> 9) & 1) << 5)); }
__host__ __device__ __forceinline__ void stage_rc(int b, int& R, int& C) { const int st = b / 1024, sb = b % 1024, swz = sb ^ (((sb >> 9) & 1) << 5); R = (st >> 1) * 16 + swz / 64; C = (st & 1) * 32 + (swz % 64) / 2; }
__host__ __device__ __forceinline__ int perm32(int rho) { const int n = rho >> 4, i = rho & 15; return 8 * (i >> 2) + 4 * n + (i & 3); }

struct Unit { int pm, pn, e, slot; long offA, offB; };
struct Gemm { const bf16_t* A; const bf16_t* Bt; int lda, K; unsigned brs, bks; const PG8_LAS int* tokmap; };
__host__ __device__ __forceinline__ Gemm make_gemm(const bf16_t* A, const bf16_t* Bt, int lda, int ldb, int K) { Gemm g; g.A = A; g.Bt = Bt; g.lda = lda; g.K = K; g.brs = (unsigned)ldb * 2u; g.bks = 16u; g.tokmap = nullptr; return g; }

__host__ __device__ __forceinline__ int xcd_remap(int wgid, int nwg) { const int q = nwg / NXCD, r = nwg % NXCD, xcd = wgid % NXCD, off = wgid / NXCD; return (xcd < r ? xcd * (q + 1) : r * (q + 1) + (xcd - r) * q) + off; }

struct StaticOrder {
    int nM, nN, nwg, G, c, lda, ldb;
    __host__ __device__ void init(int M, int N, int G_, int c_, int lda_, int ldb_) { nM = M / BM; nN = N / BM; nwg = nM * nN; G = G_; c = c_; lda = lda_; ldb = ldb_; }
    __host__ __device__ bool next(int i, Unit& u) const {
        const long L = (long)i * G + c; if (L >= nwg) return false;
        const int wgid = xcd_remap((int)L, nwg);
        const int nig = WGM * nN, gid = wgid / nig, fm = gid * WGM, gsz = (nM - fm) < WGM ? (nM - fm) : WGM;
        u.pm = fm + ((wgid % nig) % gsz); u.pn = (wgid % nig) / gsz; u.e = 0; u.slot = 0;
        u.offA = (long)u.pm * BM * lda * 2; u.offB = (long)u.pn * BM * ldb * 2; return true;
    }
    __device__ __forceinline__ void a_ready(const Unit&) const {}
    __device__ __forceinline__ void done(const Unit&) const {}
};

__device__ __forceinline__ unsigned cvt_pk_bf16(float lo, float hi) { unsigned r; asm volatile("v_cvt_pk_bf16_f32 %0, %1, %2" : "=v"(r) : "v"(lo), "v"(hi)); return r; }
typedef float f32x2 __attribute__((ext_vector_type(2)));

template <class Epi, class Sched, bool ALIGN_EPI = false, bool SP2 = false, bool GATHER = false>
__device__ __forceinline__ void gemm_phase(PG8_LAS unsigned char* lds, const Gemm g, const Sched& S, const Epi& E) {
    static_assert(!GATHER || SP2, "the gather form is written for the two-super-phase loop only");
    const int tid = threadIdx.x, wid = __builtin_amdgcn_readfirstlane(tid >> 6), lane = tid & 63, wr = wid >> 2, wc = wid & 3, fr = lane & 15, fq = lane >> 4;
    const int K = g.K, nt = K / BK;
    unsigned voffA[2], voffB[2]; int RA[2];
#pragma unroll
    for (int i = 0; i < 2; ++i) { int R, C; stage_rc(tid * 16 + i * 8192, R, C); const int Rb = Epi::PERM ? ((R & ~31) + perm32(R & 31)) : R; RA[i] = R;
        voffA[i] = GATHER ? (unsigned)C * 2u : (unsigned)(R * g.lda + C) * 2u; voffB[i] = (unsigned)Rb * g.brs + (unsigned)(C >> 3) * g.bks; }
    const size_t kstepA = (size_t)(BK * 2), kstepB = (size_t)8 * g.bks;
    const size_t hstepA = (size_t)HALF * g.lda * 2, hstepB = (size_t)HALF * g.brs;
    const unsigned ldsw = (unsigned)wid * 1024u;
    const int aoff = lds_byte(wr * 64 + fr, fq * 8), boff = lds_byte(wc * 32 + fr, fq * 8);
#define PG8_SA(b, h) (((b) * 2 + (h)) * HTB)
#define PG8_SB(b, h) ((4 + (b) * 2 + (h)) * HTB)
#define PG8_STAGE(bufoff, gbase, voff) do { _Pragma("unroll") for (int _i = 0; _i < 2; ++_i) \
        __builtin_amdgcn_global_load_lds((const unsigned*)((const char*)(gbase) + (voff)[_i]), (PG8_LAS unsigned*)(lds + (bufoff) + ldsw + _i * 8192), 16, 0, 0); } while (0)
    unsigned ga[2][2], gn[2][2], gw[2][2];
#define PG8_GLOAD(dst, u) do { if constexpr (GATHER) { const PG8_LAS int* _tm = g.tokmap + 256 * (u).slot; _Pragma("unroll") for (int _h = 0; _h < 2; ++_h) _Pragma("unroll") for (int _i = 0; _i < 2; ++_i) \
        dst[_h][_i] = (unsigned)_tm[128 * _h + RA[_i]] * (unsigned)(g.lda * 2) + voffA[_i]; } } while (0)
#define PG8_STAGE_A(bufoff, gbase, half, GX) do { if constexpr (GATHER) { PG8_STAGE(bufoff, gbase, GX[half]); } else { PG8_STAGE(bufoff, (gbase) + (half) * hstepA, voffA); } } while (0)
#define PG8_LDA(dst, b, h) do { _Pragma("unroll") for (int m = 0; m < 4; ++m) _Pragma("unroll") for (int k = 0; k < 2; ++k) dst[m][k] = *(const PG8_LAS bf16x8*)(lds + PG8_SA(b, h) + aoff + m * 2048 + k * 1024); } while (0)
#define PG8_LDB(dst, b, h) do { _Pragma("unroll") for (int n = 0; n < 2; ++n) _Pragma("unroll") for (int k = 0; k < 2; ++k) dst[n][k] = *(const PG8_LAS bf16x8*)(lds + PG8_SB(b, h) + boff + n * 2048 + k * 1024); } while (0)
#define PG8_MMA(ai, bj, At, Bt) do { __builtin_amdgcn_s_setprio(1); _Pragma("unroll") for (int m = 0; m < 4; ++m) _Pragma("unroll") for (int n = 0; n < 2; ++n) _Pragma("unroll") for (int k = 0; k < 2; ++k) \
        acc[ai][bj][m][n] = __builtin_amdgcn_mfma_f32_16x16x32_bf16(Bt[n][k], At[m][k], acc[ai][bj][m][n], 0, 0, 0); __builtin_amdgcn_s_setprio(0); } while (0)
#define PG8_WAIT_V(n) asm volatile("s_waitcnt vmcnt(" #n ")" ::: "memory")
#define PG8_WAIT_L(n) asm volatile("s_waitcnt lgkmcnt(" #n ")" ::: "memory")
#define PG8_BAR __builtin_amdgcn_s_barrier()
#define PG8_SCHED __builtin_amdgcn_sched_barrier(0)
    Unit cur, nxt; int ui = 0;
    if (!S.next(0, cur)) return;
    f32x4 acc[2][2][4][2];
#pragma unroll
    for (int a = 0; a < 2; ++a)
#pragma unroll
        for (int b = 0; b < 2; ++b)
#pragma unroll
            for (int m = 0; m < 4; ++m)
#pragma unroll
                for (int n = 0; n < 2; ++n) acc[a][b][m][n] = (f32x4){0.f, 0.f, 0.f, 0.f};
    bf16x8 At[4][2], B0[2][2], B1[2][2];
    const char* cA = (const char*)g.A + cur.offA; const char* cB = (const char*)g.Bt + cur.offB;
    S.a_ready(cur);
    if constexpr (SP2) {
        PG8_GLOAD(ga, cur);
        PG8_STAGE(PG8_SB(0, 0), cB, voffB); PG8_STAGE(PG8_SB(0, 1), cB + hstepB, voffB); PG8_STAGE_A(PG8_SA(0, 0), cA, 0, ga); PG8_STAGE_A(PG8_SA(0, 1), cA, 1, ga);
        if (wr == 1) PG8_BAR;
        PG8_WAIT_V(2); PG8_BAR;
        PG8_STAGE(PG8_SB(1, 0), cB + kstepB, voffB); PG8_STAGE_A(PG8_SA(1, 0), cA + kstepA, 0, ga); PG8_STAGE(PG8_SB(1, 1), cB + hstepB + kstepB, voffB);
        PG8_WAIT_V(6); PG8_BAR;
    } else {
        PG8_STAGE(PG8_SB(0, 0), cB, voffB); PG8_STAGE(PG8_SA(0, 0), cA, voffA); PG8_STAGE(PG8_SB(0, 1), cB + hstepB, voffB); PG8_STAGE(PG8_SA(0, 1), cA + hstepA, voffA);
        if (wr == 1) PG8_BAR;
        PG8_WAIT_V(4); PG8_BAR;
        PG8_STAGE(PG8_SB(1, 0), cB + kstepB, voffB); PG8_STAGE(PG8_SA(1, 0), cA + kstepA, voffA); PG8_STAGE(PG8_SB(1, 1), cB + hstepB + kstepB, voffB);
        PG8_WAIT_V(6); PG8_BAR;
    }
    for (;;) {
        const bool has_next = S.next(ui + 1, nxt);
        if constexpr (GATHER) { if (has_next) { PG8_GLOAD(gn, nxt); } else { _Pragma("unroll") for (int _h = 0; _h < 2; ++_h) _Pragma("unroll") for (int _i = 0; _i < 2; ++_i) gn[_h][_i] = ga[_h][_i]; } }
        const char* nA = has_next ? (const char*)g.A + nxt.offA : cA; const char* nB = has_next ? (const char*)g.Bt + nxt.offB : cB;
        for (int t = 0; t < nt; t += 2) {
            const bool last = (t == nt - 2);
            const char* a1 = cA + (size_t)(t + 1) * kstepA;
            const char* a2 = last ? nA : cA + (size_t)(t + 2) * kstepA; const char* b2 = last ? nB : cB + (size_t)(t + 2) * kstepB;
            const char* a3 = a2 + kstepA; const char* b3 = b2 + kstepB;
            if (last && has_next) S.a_ready(nxt);
            if constexpr (GATHER) { _Pragma("unroll") for (int _h = 0; _h < 2; ++_h) _Pragma("unroll") for (int _i = 0; _i < 2; ++_i) gw[_h][_i] = last ? gn[_h][_i] : ga[_h][_i]; }
            if constexpr (SP2) {
            PG8_LDB(B0, 0, 0); PG8_LDB(B1, 0, 1); PG8_SCHED; PG8_LDA(At, 0, 0); PG8_STAGE_A(PG8_SA(1, 1), a1, 1, ga);
            PG8_WAIT_V(8); PG8_WAIT_L(0); PG8_BAR; PG8_MMA(0, 0, At, B0); PG8_MMA(0, 1, At, B1); PG8_BAR; PG8_SCHED;
            PG8_LDA(At, 0, 1); PG8_STAGE(PG8_SB(0, 0), b2, voffB); PG8_STAGE(PG8_SB(0, 1), b2 + hstepB, voffB); PG8_STAGE_A(PG8_SA(0, 0), a2, 0, gw);
            PG8_WAIT_V(8); PG8_WAIT_L(0); PG8_BAR; PG8_MMA(1, 0, At, B0); PG8_MMA(1, 1, At, B1); PG8_BAR; PG8_SCHED;
            PG8_LDB(B0, 1, 0); PG8_LDB(B1, 1, 1); PG8_SCHED; PG8_LDA(At, 1, 0); PG8_STAGE_A(PG8_SA(0, 1), a2, 1, gw);
            PG8_WAIT_V(8); PG8_WAIT_L(0); PG8_BAR; PG8_MMA(0, 0, At, B0); PG8_MMA(0, 1, At, B1); PG8_BAR; PG8_SCHED;
            PG8_LDA(At, 1, 1); PG8_STAGE(PG8_SB(1, 0), b3, voffB); PG8_STAGE(PG8_SB(1, 1), b3 + hstepB, voffB); PG8_STAGE_A(PG8_SA(1, 0), a3, 0, gw);
            PG8_WAIT_V(8); PG8_WAIT_L(0); PG8_BAR; PG8_MMA(1, 0, At, B0); PG8_MMA(1, 1, At, B1); PG8_BAR; PG8_SCHED;
            } else {
            PG8_LDB(B0, 0, 0); PG8_SCHED; PG8_LDA(At, 0, 0); PG8_STAGE(PG8_SA(1, 1), a1 + hstepA, voffA);
            PG8_WAIT_L(8); PG8_BAR; PG8_WAIT_L(0); PG8_MMA(0, 0, At, B0); PG8_BAR; PG8_SCHED;
            PG8_LDB(B1, 0, 1); PG8_STAGE(PG8_SB(0, 0), b2, voffB);
            PG8_BAR; PG8_WAIT_L(0); PG8_MMA(0, 1, At, B1); PG8_BAR;
            PG8_LDA(At, 0, 1); PG8_STAGE(PG8_SA(0, 0), a2, voffA);
            PG8_BAR; PG8_WAIT_L(0); PG8_MMA(1, 0, At, B0); PG8_BAR; PG8_SCHED;
            PG8_STAGE(PG8_SB(0, 1), b2 + hstepB, voffB);
            PG8_WAIT_V(6); PG8_BAR; PG8_MMA(1, 1, At, B1); PG8_BAR;
            PG8_LDB(B0, 1, 0); PG8_SCHED; PG8_LDA(At, 1, 0); PG8_STAGE(PG8_SA(0, 1), a2 + hstepA, voffA);
            PG8_WAIT_L(8); PG8_BAR; PG8_WAIT_L(0); PG8_MMA(0, 0, At, B0); PG8_BAR; PG8_SCHED;
            PG8_LDB(B1, 1, 1); PG8_STAGE(PG8_SB(1, 0), b3, voffB);
            PG8_BAR; PG8_WAIT_L(0); PG8_MMA(0, 1, At, B1); PG8_BAR;
            PG8_LDA(At, 1, 1); PG8_STAGE(PG8_SA(1, 0), a3, voffA);
            PG8_BAR; PG8_WAIT_L(0); PG8_MMA(1, 0, At, B0); PG8_BAR; PG8_SCHED;
            PG8_STAGE(PG8_SB(1, 1), b3 + hstepB, voffB);
            PG8_WAIT_V(6); PG8_BAR; PG8_MMA(1, 1, At, B1); PG8_BAR;
            }
        }
        if constexpr (ALIGN_EPI) { if (wr == 0) PG8_BAR; }
        if constexpr (!Epi::AFTER_DRAIN) { E(acc, cur, wr, wc, fr, fq); S.done(cur); }
        if (!has_next) break;
#pragma unroll
        for (int a = 0; a < 2; ++a)
#pragma unroll
            for (int b = 0; b < 2; ++b)
#pragma unroll
                for (int m = 0; m < 4; ++m)
#pragma unroll
                    for (int n = 0; n < 2; ++n) acc[a][b][m][n] = (f32x4){0.f, 0.f, 0.f, 0.f};
        cur = nxt; cA = nA; cB = nB; ++ui;
        if constexpr (GATHER) { _Pragma("unroll") for (int _h = 0; _h < 2; ++_h) _Pragma("unroll") for (int _i = 0; _i < 2; ++_i) ga[_h][_i] = gn[_h][_i]; }
        if constexpr (ALIGN_EPI) { if (wr == 1) PG8_BAR; }
    }
    PG8_WAIT_V(0);
    if constexpr (!ALIGN_EPI) { if (wr == 0) PG8_BAR; }
    PG8_BAR;
    if constexpr (Epi::AFTER_DRAIN) { E.fused(acc, cur, wr, wc, fr, fq, lds, wid, lane); S.done(cur); }
#undef PG8_SA
#undef PG8_SB
#undef PG8_STAGE
#undef PG8_STAGE_A
#undef PG8_GLOAD
#undef PG8_LDA
#undef PG8_LDB
#undef PG8_MMA
#undef PG8_WAIT_V
#undef PG8_WAIT_L
#undef PG8_BAR
#undef PG8_SCHED
}
}

#ifndef PG8_SP2
#define PG8_SP2 true
#endif
#ifndef PG8_ALIGN
#define PG8_ALIGN true
#endif

constexpr int NWAVES = 8;
#ifndef MK_N_LAUNCHES
#define MK_N_LAUNCHES 1
#endif
#ifndef DBG_MODE
#define DBG_MODE 0
#endif
#ifndef REP_PHASE
#define REP_PHASE -1
#endif
#define NREP(k) ((REP_PHASE) == (k) ? 2 : 1)
#ifndef TIME_LO
#define TIME_LO -1
#endif
#ifndef TIME_HI
#define TIME_HI -1
#endif
#ifndef TIME_BLK
#define TIME_BLK 0
#endif
#define TMARK(j) do { if ((TIME_LO) >= 0 && blockIdx.x == (TIME_BLK) && F.tid == 0) { if ((j) == (TIME_LO)) t_lo_ = __builtin_amdgcn_s_memrealtime(); if ((j) == (TIME_HI)) t_hi_ = __builtin_amdgcn_s_memrealtime(); } } while (0)
constexpr int PER_PHASE = 13;
constexpr int N_LAUNCHES = MK_N_LAUNCHES;

constexpr int BATCH = 2, SEQ = 8192, D = 1024, M = BATCH * SEQ;
constexpr int SBW = 512, NH = 8, HD = 64;
constexpr int SSW = 512, NG = 32, GC = 16, NP = 64;
constexpr int NPROJ = 3 * SBW + SSW;
constexpr int LC = 32, NCHUNK = M / LC, CPB = SEQ / LC;
constexpr int UK = LC * GC + 2 * NP;
constexpr int NE = 32, TOPK = 4, FF = 1024, NASSIGN = M * TOPK;
constexpr int MAXTILES = (NASSIGN + NE * 255) / 256 + 1;
constexpr float EPS = 1e-5f;
constexpr float LOG2E = 1.4426950408889634f;

constexpr size_t MiB = 1u << 20;
constexpr size_t WS_CTL = 0, CTL_ZERO_BYTES = 1 * MiB;
constexpr size_t WS_LAML = 1 * MiB;
constexpr size_t WS_RSTD = 1 * MiB + 32 * 1024;
constexpr size_t WS_GATES = 1 * MiB + 128 * 1024;
constexpr size_t WS_ROWINFO = 1 * MiB + 512 * 1024;
constexpr size_t WS_RWIMG = 3 * MiB;
constexpr size_t WS_LISTS = 203 * MiB + 130 * MiB;
constexpr size_t WS_WINT = 4 * MiB, WS_WGLUT = 8 * MiB, WS_WOUTT = 9 * MiB, WS_W1T = 11 * MiB, WS_W2T = 139 * MiB;
constexpr size_t WS_R1 = 203 * MiB, WS_R2 = 347 * MiB, WS_END = 491 * MiB;
constexpr size_t WS_HN = WS_R1, WS_Q = WS_R1 + 32 * MiB, WS_K = WS_R1 + 48 * MiB, WS_V = WS_R1 + 64 * MiB, WS_UCAT = WS_R1 + 80 * MiB,
                 WS_SLOC = WS_R1 + 100 * MiB, WS_YSB = WS_R1 + 108 * MiB, WS_YG = WS_R1 + 124 * MiB;
constexpr size_t WS_YBUF = WS_R1;
constexpr size_t WS_YSSM = WS_R2, WS_MIXED = WS_R2 + 16 * MiB, WS_XN = WS_R1  , WS_WE = WS_R2 + 80 * MiB, WS_TW = WS_R2 + 85 * MiB;
constexpr size_t WS_H = WS_R2;
static_assert(WS_K == WS_Q + (size_t)M * SBW * 2 && WS_V == WS_K + (size_t)M * SBW * 2 && WS_YG + (size_t)M * SSW * 2 <= WS_R2 && WS_TW + (size_t)NG * 512 * UK * 2 <= WS_END, "ws map");
static_assert(WS_YBUF + (size_t)NASSIGN * D * 2 <= WS_LISTS && WS_H + (size_t)(MAXTILES - 1) * 256 * FF * 2 <= WS_END, "ws map 2");
static_assert(WS_ROWINFO + (size_t)MAXTILES * 256 * 16 <= 3 * MiB && WS_LISTS >= WS_R1 + 128 * MiB && WS_LISTS + (size_t)NE * M * 4 <= WS_R2, "ws map 3");
constexpr int CW_TMO = 0, CW_CODE = 1;
constexpr int CW_BAR = 4096;
constexpr int CW_CNT = 16384;
constexpr int CW_Q0 = 16384 + 256;
constexpr int CW_AQ = 16384 + 320, CW_DONE2 = 16384 + 384, CW_DONE3 = 16384 + 448;

constexpr int RING_OFF = 0, RING_BYTES = 131072;
constexpr int RT_WSTR = 1028;
constexpr int RT_W_BYTES = 2 * NE * RT_WSTR * 2;
constexpr int RT_SCR_OFF = RT_W_BYTES;
constexpr int LDSCTL_OFF = 139264, MISC_OFF = LDSCTL_OFF + 320;
constexpr int TAB_OFF = LDSCTL_OFF + 512;
constexpr int UNITS_OFF = LDSCTL_OFF + 1024;
constexpr int TILEE_OFF = LDSCTL_OFF + 1536;
constexpr int TOKMAP_OFF = LDSCTL_OFF + 4096, TOKMAP_SLOTS = 10;
constexpr int LDS_BYTES = TOKMAP_OFF + TOKMAP_SLOTS * 1024;
static_assert(TILEE_OFF + MAXTILES * 4 <= LDS_BYTES && RT_SCR_OFF + 4096 <= LDSCTL_OFF, "LDS map");

#define GAS __attribute__((address_space(1)))
#define LAS __attribute__((address_space(3)))
typedef unsigned short bf16;
typedef unsigned v4u __attribute__((ext_vector_type(4)));
typedef unsigned v2u __attribute__((ext_vector_type(2)));
typedef float f32x4 __attribute__((ext_vector_type(4)));
typedef float f32x2 __attribute__((ext_vector_type(2)));
typedef _Float16 h16x2 __attribute__((ext_vector_type(2)));
typedef GAS unsigned gu32;
#define RLX_AGENT __ATOMIC_RELAXED, __HIP_MEMORY_SCOPE_AGENT
#define LDS_WAIT() asm volatile("s_waitcnt lgkmcnt(0)" ::: "memory")
#define VM_WAIT() asm volatile("s_waitcnt vmcnt(0)" ::: "memory")
__device__ __forceinline__ unsigned f2bf(float f) { unsigned u = __builtin_bit_cast(unsigned, f); return (u + 0x7fffu + ((u >> 16) & 1u)) >> 16; }
__device__ __forceinline__ unsigned pk2(float lo, float hi) { return f2bf(lo) | (f2bf(hi) << 16); }
__device__ __forceinline__ float bf2f(unsigned short b) { return __builtin_bit_cast(float, (unsigned)b << 16); }
__device__ __forceinline__ float bflo(unsigned w) { return __builtin_bit_cast(float, w << 16); }
__device__ __forceinline__ float bfhi(unsigned w) { return __builtin_bit_cast(float, w & 0xffff0000u); }
__device__ __forceinline__ unsigned pkh2(float lo, float hi) { h16x2 v; v.x = (_Float16)lo; v.y = (_Float16)hi; return __builtin_bit_cast(unsigned, v); }
__device__ __forceinline__ float fexp2(float x) { return __builtin_amdgcn_exp2f(x); }
__device__ __forceinline__ float flog2(float x) { return __builtin_amdgcn_logf(x); }
__device__ __forceinline__ float frcp(float x) { return __builtin_amdgcn_rcpf(x); }
__device__ __forceinline__ float sigmoidf_(float x) { return frcp(1.0f + fexp2(-LOG2E * x)); }
__device__ __forceinline__ float gelu_tanh(float v) { const float u = 0.7978845608028654f * (v + 0.044715f * v * v * v); return v * frcp(1.0f + fexp2(-2.0f * LOG2E * u)); }

#define XB_TMO      128
#define XB_XCNT(j)  (256  + 64 * (j))
#define XB_XSUB(j)  (1280 + 64 * (j))
#define XB_XGEN(j)  (2304 + 64 * (j))
#define XB_TOP      3328
#define XB_TOPGEN   3392
#define XCD_BAR_WORDS 3456
#define XB_SPIN_CAP (1u << 18)
__device__ __forceinline__ unsigned xb_ld(unsigned* p)              { return __hip_atomic_load(p, __ATOMIC_RELAXED, __HIP_MEMORY_SCOPE_AGENT); }
__device__ __forceinline__ unsigned xb_add(unsigned* p, unsigned v) { return __hip_atomic_fetch_add(p, v, __ATOMIC_RELAXED, __HIP_MEMORY_SCOPE_AGENT); }
__device__ __forceinline__ unsigned xb_xcc_id() { return (unsigned)__builtin_amdgcn_s_getreg((3 << 11) | 20) & 0xFu; }
#define XB_SPIN(cond, bar) do { unsigned _sp = 0; while (cond) { __builtin_amdgcn_s_sleep(1); \
    if ((++_sp & 255u) == 0u) { if (xb_ld(&(bar)[XB_TMO])) break; if (_sp > XB_SPIN_CAP) { atomicAdd(&(bar)[XB_TMO], 1u); break; } } } } while (0)
struct XcdBarrier { unsigned* bar; unsigned x; volatile LAS unsigned* st; };
__device__ __forceinline__ XcdBarrier xcd_barrier_post(unsigned* bar, volatile LAS unsigned* st) {
    XcdBarrier b; b.bar = bar; b.x = xb_xcc_id(); b.st = st;
    if (threadIdx.x == 0) (void)xb_add(&bar[XB_XCNT(b.x)], 1u);
    return b;
}
__device__ __forceinline__ void xcd_barrier_complete(unsigned* bar, unsigned x, unsigned& nloc, unsigned& nx) {
    const unsigned G = gridDim.x * gridDim.y * gridDim.z;
    unsigned sum, cnt, mine, sp = 0u;
    for (;;) {
        sum = 0u; cnt = 0u; mine = 0u;
#pragma unroll
        for (unsigned j = 0; j < 16; ++j) { const unsigned c = xb_ld(&bar[XB_XCNT(j)]); sum += c; cnt += (c > 0u) ? 1u : 0u; mine = (j == x) ? c : mine; }
        if (sum == G) break;
        __builtin_amdgcn_s_sleep(1);
        if ((++sp & 255u) == 0u) { if (xb_ld(&bar[XB_TMO])) break; if (sp > XB_SPIN_CAP) { atomicAdd(&bar[XB_TMO], 1u); break; } }
    }
    nloc = mine > 0u ? mine : 1u; nx = cnt > 0u ? cnt : 1u;
}
__device__ __forceinline__ void xcd_barrier(const XcdBarrier& b) {
    asm volatile("s_waitcnt vmcnt(0)" ::: "memory");
    __syncthreads();
    if (threadIdx.x == 0) {
        unsigned* bar = b.bar;
        __builtin_amdgcn_s_waitcnt(0);
        unsigned nloc = b.st[0], nx = b.st[1];
        if (nloc == 0u) { xcd_barrier_complete(bar, b.x, nloc, nx); b.st[0] = nloc; b.st[1] = nx; }
        const unsigned old = xb_add(&bar[XB_XSUB(b.x)], 1u);
        const unsigned gen = old / nloc;
        if (old + 1u == (gen + 1u) * nloc) {
            __builtin_amdgcn_fence(__ATOMIC_RELEASE, "agent");
            asm volatile("s_waitcnt vmcnt(0)" ::: "memory");
            const unsigned og = xb_add(&bar[XB_TOP], 1u);
            const unsigned tg = og / nx;
            if (og + 1u == (tg + 1u) * nx) xb_add(&bar[XB_TOPGEN], 1u);
            else XB_SPIN(xb_ld(&bar[XB_TOPGEN]) == tg, bar);
            __builtin_amdgcn_fence(__ATOMIC_ACQUIRE, "agent");
            xb_add(&bar[XB_XGEN(b.x)], 1u);
            asm volatile("s_waitcnt vmcnt(0)" ::: "memory");
        } else {
            XB_SPIN(xb_ld(&bar[XB_XGEN(b.x)]) == gen, bar);
            __builtin_amdgcn_fence(__ATOMIC_ACQUIRE, "agent");
            asm volatile("s_waitcnt vmcnt(0)" ::: "memory");
        }
    }
    __syncthreads();
}

struct Frame {
    LAS unsigned char* lds;
    volatile LAS unsigned* MISC;
    gu32* ctl;
    int tid, lane, wave;
    int vcu, G;
    unsigned char* ws;
    const float* in[25];
    float* out;
};

__device__ __forceinline__ float wave_sum(float v) {
#pragma unroll
    for (int o = 1; o < 64; o <<= 1) v += __shfl_xor(v, o);
    return v;
}

using pg8::Unit;
typedef pg8::f32x4 accv;
struct EpiInProj {
    static constexpr bool PERM = true, AFTER_DRAIN = false;
    unsigned short* QKV; bf16* U; float qscale;
    __device__ __forceinline__ void operator()(const accv (&acc)[2][2][4][2], const Unit& u, int wr, int wc, int fr, int fq) const {
        if (u.e == 1) {
            const int row0 = u.pm * 256 + wr * 64 + fr; const int colt = u.pn * 256 + wc * 32 + 8 * fq;
            _Float16* VT = (_Float16*)(QKV + (size_t)2 * M * SBW);
#pragma unroll
            for (int ai = 0; ai < 2; ++ai)
#pragma unroll
                for (int m = 0; m < 4; ++m) { const int row = row0 + ai * 128 + m * 16;
#pragma unroll
                    for (int bj = 0; bj < 2; ++bj) { const int tok = colt + bj * 128; const accv v0 = acc[ai][bj][m][0], v1 = acc[ai][bj][m][1];
                        const int bb = tok >> 13, sq = tok & (SEQ - 1); const int o = sq & 15;
                        _Float16* p = VT + ((size_t)bb * SBW + row) * SEQ + (sq & ~15) + (o >> 1);
                        v2u w0, w1; w0.x = pkh2(v0[0], v0[1]); w0.y = pkh2(v0[2], v0[3]); w1.x = pkh2(v1[0], v1[1]); w1.y = pkh2(v1[2], v1[3]);
                        *(v2u*)p = w0; *(v2u*)(p + 8) = w1; } }
            return;
        }
        const int kind = u.pn >> 1; const int colt = (u.pn & 1) * 256 + wc * 32 + 8 * fq; const int row0 = u.pm * 256 + wr * 64 + fr;
        unsigned short* T = QKV + (size_t)(kind < 2 ? kind : 0) * ((size_t)M * SBW); const float sc = kind == 0 ? qscale : 1.0f;
#pragma unroll
        for (int ai = 0; ai < 2; ++ai)
#pragma unroll
            for (int m = 0; m < 4; ++m) { const int row = row0 + ai * 128 + m * 16;
#pragma unroll
                for (int bj = 0; bj < 2; ++bj) { const int col = colt + bj * 128; const accv v0 = acc[ai][bj][m][0] * sc, v1 = acc[ai][bj][m][1] * sc; v4u w;
                    if (kind < 2) { w.x = pkh2(v0[0], v0[1]); w.y = pkh2(v0[2], v0[3]); w.z = pkh2(v1[0], v1[1]); w.w = pkh2(v1[2], v1[3]);
                        *(v4u*)(T + (size_t)row * SBW + col) = w; }
                    else { w.x = pg8::cvt_pk_bf16(v0[0], v0[1]); w.y = pg8::cvt_pk_bf16(v0[2], v0[3]); w.z = pg8::cvt_pk_bf16(v1[0], v1[1]); w.w = pg8::cvt_pk_bf16(v1[2], v1[3]);
                        *(v4u*)(U + ((size_t)(row >> 5) * NG + (col >> 4)) * UK + (row & 31) * GC + (col & 15)) = w; } } }
    }
};
struct EpiSloc {
    static constexpr bool PERM = false, AFTER_DRAIN = false;
    float* S;
    __device__ __forceinline__ void operator()(const accv (&acc)[2][2][4][2], const Unit& u, int wr, int wc, int fr, int fq) const {
        const int row0 = u.pm * 256 + wr * 64 + fr; const int col0 = wc * 32 + 4 * fq;
#pragma unroll
        for (int ai = 0; ai < 2; ++ai)
#pragma unroll
            for (int m = 0; m < 4; ++m) { const int row = row0 + ai * 128 + m * 16;
#pragma unroll
                for (int n = 0; n < 2; ++n) *(accv*)(S + ((size_t)row * NG + u.e) * 128 + col0 + 16 * n) = acc[ai][0][m][n]; }
    }
};
struct EpiS3 {
    static constexpr bool PERM = true, AFTER_DRAIN = false;
    bf16* YG;
    __device__ __forceinline__ void operator()(const accv (&acc)[2][2][4][2], const Unit& u, int wr, int wc, int fr, int fq) const {
        const int row0 = u.pm * 256 + wr * 64 + fr; const int colt = u.pn * 256 + wc * 32 + 8 * fq;
#pragma unroll
        for (int ai = 0; ai < 2; ++ai)
#pragma unroll
            for (int m = 0; m < 4; ++m) { const int row = row0 + ai * 128 + m * 16;
#pragma unroll
                for (int bj = 0; bj < 2; ++bj) { const int col = colt + bj * 128; const accv v0 = acc[ai][bj][m][0], v1 = acc[ai][bj][m][1]; v4u w;
                    w.x = pg8::cvt_pk_bf16(gelu_tanh(v0[0]), gelu_tanh(v0[1])); w.y = pg8::cvt_pk_bf16(gelu_tanh(v0[2]), gelu_tanh(v0[3]));
                    w.z = pg8::cvt_pk_bf16(gelu_tanh(v1[0]), gelu_tanh(v1[1])); w.w = pg8::cvt_pk_bf16(gelu_tanh(v1[2]), gelu_tanh(v1[3]));
                    *(v4u*)(YG + ((size_t)row * LC + (col >> 4)) * SSW + u.e * GC + (col & 15)) = w; } }
    }
};
struct EpiGlu {
    static constexpr bool PERM = true, AFTER_DRAIN = false;
    bf16* Y;
    __device__ __forceinline__ void operator()(const accv (&acc)[2][2][4][2], const Unit& u, int wr, int wc, int fr, int fq) const {
        const int row0 = u.pm * 256 + wr * 64 + fr; const int col = u.pn * 128 + wc * 32 + 8 * fq;
#pragma unroll
        for (int ai = 0; ai < 2; ++ai)
#pragma unroll
            for (int m = 0; m < 4; ++m) { const int row = row0 + ai * 128 + m * 16; float r[8];
#pragma unroll
                for (int n = 0; n < 2; ++n)
#pragma unroll
                    for (int j = 0; j < 4; ++j) r[4 * n + j] = acc[ai][0][m][n][j] * sigmoidf_(acc[ai][1][m][n][j]);
                v4u w; w.x = pg8::cvt_pk_bf16(r[0], r[1]); w.y = pg8::cvt_pk_bf16(r[2], r[3]); w.z = pg8::cvt_pk_bf16(r[4], r[5]); w.w = pg8::cvt_pk_bf16(r[6], r[7]);
                *(v4u*)(Y + (size_t)row * SSW + col) = w; }
    }
};
struct EpiOutProj {
    static constexpr bool PERM = false, AFTER_DRAIN = false;
    const float* X; float* O;
    __device__ __forceinline__ void operator()(const accv (&acc)[2][2][4][2], const Unit& u, int wr, int wc, int fr, int fq) const {
        const int row0 = u.pm * 256 + wr * 64 + fr; const int col0 = u.pn * 256 + wc * 32 + 4 * fq;
#pragma unroll
        for (int ai = 0; ai < 2; ++ai)
#pragma unroll
            for (int m = 0; m < 4; ++m) { const size_t off = (size_t)(row0 + ai * 128 + m * 16) * D + col0;
#pragma unroll
                for (int bj = 0; bj < 2; ++bj)
#pragma unroll
                    for (int n = 0; n < 2; ++n) { const accv xv = *(const accv*)(X + off + bj * 128 + n * 16); *(accv*)(O + off + bj * 128 + n * 16) = xv + acc[ai][bj][m][n]; }
                if (m & 1) asm volatile("" ::: "memory"); }
    }
};
struct EpiMoe1 {
    static constexpr bool PERM = true, AFTER_DRAIN = false;
    bf16* H; const float* bg; const float* bu; const int* rowinfo;
    __device__ __forceinline__ void operator()(const accv (&acc)[2][2][4][2], const Unit& u, int wr, int wc, int fr, int fq) const {
        const int row0 = u.pm * 256 + wr * 64 + fr; const int col = u.pn * 128 + wc * 32 + 8 * fq;
        float bgv[8], buv[8];
#pragma unroll
        for (int n = 0; n < 2; ++n) { const accv a = *(const accv*)(bg + u.e * FF + col + 4 * n), b = *(const accv*)(bu + u.e * FF + col + 4 * n);
#pragma unroll
            for (int j = 0; j < 4; ++j) { bgv[4 * n + j] = a[j]; buv[4 * n + j] = b[j]; } }
#pragma unroll
        for (int ai = 0; ai < 2; ++ai)
#pragma unroll
            for (int m = 0; m < 4; ++m) { const int row = row0 + ai * 128 + m * 16; float r[8]; const float rs = __builtin_bit_cast(float, rowinfo[4 * row + 2]);
#pragma unroll
                for (int n = 0; n < 2; ++n)
#pragma unroll
                    for (int j = 0; j < 4; ++j) { const float g = fminf(acc[ai][0][m][n][j] * rs + bgv[4 * n + j], 7.0f); const float up = fminf(fmaxf(acc[ai][1][m][n][j] * rs + buv[4 * n + j], -7.0f), 7.0f);
                        r[4 * n + j] = (up + 1.0f) * g * frcp(1.0f + fexp2(-1.702f * LOG2E * g)); }
                v4u w; w.x = pg8::cvt_pk_bf16(r[0], r[1]); w.y = pg8::cvt_pk_bf16(r[2], r[3]); w.z = pg8::cvt_pk_bf16(r[4], r[5]); w.w = pg8::cvt_pk_bf16(r[6], r[7]);
                *(v4u*)(H + (size_t)row * FF + col) = w; }
    }
};
struct EpiMoe2 {
    static constexpr bool PERM = true, AFTER_DRAIN = false;
    bf16* Y; const float* bd; const int* rowinfo;
    __device__ __forceinline__ void operator()(const accv (&acc)[2][2][4][2], const Unit& u, int wr, int wc, int fr, int fq) const {
        const int row0 = u.pm * 256 + wr * 64 + fr; const int colt = u.pn * 256 + wc * 32 + 8 * fq;
        float bv[2][8];
#pragma unroll
        for (int bj = 0; bj < 2; ++bj)
#pragma unroll
            for (int n = 0; n < 2; ++n) { const accv a = *(const accv*)(bd + u.e * D + colt + bj * 128 + 4 * n);
#pragma unroll
                for (int j = 0; j < 4; ++j) bv[bj][4 * n + j] = a[j]; }
#pragma unroll
        for (int ai = 0; ai < 2; ++ai)
#pragma unroll
            for (int m = 0; m < 4; ++m) { const int row = row0 + ai * 128 + m * 16; const int slot = rowinfo[4 * row]; const float gate = __builtin_bit_cast(float, rowinfo[4 * row + 1]);
                if (slot >= 0) {
#pragma unroll
                    for (int bj = 0; bj < 2; ++bj) { float r[8];
#pragma unroll
                        for (int n = 0; n < 2; ++n)
#pragma unroll
                            for (int j = 0; j < 4; ++j) r[4 * n + j] = (acc[ai][bj][m][n][j] + bv[bj][4 * n + j]) * gate;
                        v4u w; w.x = pg8::cvt_pk_bf16(r[0], r[1]); w.y = pg8::cvt_pk_bf16(r[2], r[3]); w.z = pg8::cvt_pk_bf16(r[4], r[5]); w.w = pg8::cvt_pk_bf16(r[6], r[7]);
                        *(v4u*)(Y + (size_t)slot * D + colt + bj * 128) = w; } } }
    }
};

struct InProjOrder {
    int G, c;
    __device__ bool next(int i, Unit& u) const {
        const int L = i * G + c; if (L >= 512) return false;
        const int s = pg8::xcd_remap(L, 512);
        if (s < 384) { const int grp = s / 48, r = s % 48; u.slot = 0; u.pm = grp * 8 + (r & 7); const int pi = r >> 3; u.pn = pi < 4 ? pi : pi + 2; u.e = 0;
            u.offA = (long)u.pm * 256 * D * 2; u.offB = (long)u.pn * 256 * D * 2; }
        else { const int r = s - 384; u.slot = 0; u.pm = r & 1; u.pn = r >> 1; u.e = 1;
            u.offA = (long)(WS_WINT - WS_HN) + (long)(1024 + u.pm * 256) * D * 2; u.offB = (long)(WS_HN - WS_WINT) + (long)u.pn * 256 * D * 2; }
        return true;
    }
    __device__ __forceinline__ void a_ready(const Unit&) const {}
    __device__ __forceinline__ void done(const Unit&) const {}
};
struct SsmOrder {
    int nwg, G, c, npn, rows_per_g, ldb;
    __device__ bool next(int i, Unit& u) const {
        const int L = i * G + c; if (L >= nwg) return false;
        const int per_g = 2 * npn; const int g = L / per_g, r = L % per_g;
        u.e = g; u.pm = r / npn; u.pn = r % npn; u.slot = 0;
        u.offA = ((long)u.pm * 256 * NG * UK + (long)g * UK) * 2; u.offB = ((long)g * rows_per_g + (long)u.pn * 256) * ldb * 2; return true;
    }
    __device__ __forceinline__ void a_ready(const Unit&) const {}
    __device__ __forceinline__ void done(const Unit&) const {}
};
struct MoeOrder {
    const LAS int* units; long ebytes; int gather;
    __device__ bool next(int i, Unit& u) const {
        if (i >= 32) return false;
        const int v = __builtin_amdgcn_readfirstlane(units[4 * i + 3]); if (!v) return false;
        u.pm = __builtin_amdgcn_readfirstlane(units[4 * i + 0]); u.pn = __builtin_amdgcn_readfirstlane(units[4 * i + 1]); u.e = __builtin_amdgcn_readfirstlane(units[4 * i + 2]);
        u.slot = i; u.offA = gather ? 0l : (long)u.pm * 256 * D * 2; u.offB = (long)u.e * ebytes + (long)u.pn * 256 * 16; return true;
    }
    __device__ __forceinline__ void a_ready(const Unit&) const {}
    __device__ __forceinline__ void done(const Unit&) const {}
};

struct CvItem { const float* src; bf16* dst; int ldw, K, rmul, radd, k0, n0; };
constexpr int CV_I_IN = (D / 64) * (NPROJ / 32), CV_I_GLU = (SSW / 64) * (SSW / 32), CV_I_OUT = (D / 64) * (D / 32), CV_I_E = (D / 64) * (FF / 32);
constexpr int CV_N_EARLY = CV_I_IN + 2 * CV_I_GLU + CV_I_OUT, CV_N_EXP = 3 * NE * (D / 8);
__device__ __forceinline__ void cv_set(CvItem& c, const float* W, int ldw, int K, int N, bf16* WT, int rmul, int radd, int item) {
    const int nblk = N / 32, kb = item / nblk, nb = item % nblk; c.src = W; c.dst = WT; c.ldw = ldw; c.K = K; c.rmul = rmul; c.radd = radd; c.k0 = 64 * kb; c.n0 = 32 * nb;
}
__device__ __forceinline__ void cv_decode_early(Frame& F, int r, CvItem& c) {
    bf16* WinT = (bf16*)(F.ws + WS_WINT); bf16* WgluT = (bf16*)(F.ws + WS_WGLUT); bf16* WoutT = (bf16*)(F.ws + WS_WOUTT);
    if (r < CV_I_IN) { cv_set(c, F.in[2], NPROJ, D, NPROJ, WinT, 1, 0, r); return; } r -= CV_I_IN;
    if (r < CV_I_GLU) { cv_set(c, F.in[11], 2 * SSW, SSW, SSW, WgluT, 2, 0, r); return; } r -= CV_I_GLU;
    if (r < CV_I_GLU) { cv_set(c, F.in[11] + SSW, 2 * SSW, SSW, SSW, WgluT, 2, 128, r); return; } r -= CV_I_GLU;
    cv_set(c, F.in[14], D, D, D, WoutT, 1, 0, r);
}
__device__ __forceinline__ void cv_decode_exp(Frame& F, int r, CvItem& c) {
    bf16* W1T = (bf16*)(F.ws + WS_W1T); bf16* W2T = (bf16*)(F.ws + WS_W2T);
    const int mat = r / CV_I_E, sub = r % CV_I_E, kind = mat / NE, e = mat % NE;
    if (kind == 0) cv_set(c, F.in[18] + (size_t)e * D * FF, FF, D, FF, W1T + (size_t)e * 2 * FF * D, 2, 0, sub);
    else if (kind == 1) cv_set(c, F.in[20] + (size_t)e * D * FF, FF, D, FF, W1T + (size_t)e * 2 * FF * D, 2, 128, sub);
    else cv_set(c, F.in[22] + (size_t)e * FF * D, D, FF, D, W2T + (size_t)e * D * FF, 1, 0, sub);
}
__device__ __forceinline__ void cv_load(const CvItem& c, int lane, float (&v)[32]) {
    const float* p = c.src + (size_t)(c.k0 + (lane >> 5)) * c.ldw + c.n0 + (lane & 31);
#pragma unroll
    for (int i = 0; i < 32; ++i) v[i] = p[(size_t)(2 * i) * c.ldw];
}
__device__ __forceinline__ void cv_store(const CvItem& c, int lane, const float (&v)[32], LAS float* scr) {
#pragma unroll
    for (int i = 0; i < 32; ++i) scr[(2 * i + (lane >> 5)) * 33 + (lane & 31)] = v[i];
    LDS_WAIT(); asm volatile("" ::: "memory");
    const int cc = lane & 7;
#pragma unroll
    for (int j = 0; j < 4; ++j) { const int nl = (lane >> 3) + 8 * j; const int n = c.n0 + nl; const int drow = (n >> 7) * 128 * c.rmul + c.radd + (n & 127); const LAS float* s = scr + (8 * cc) * 33 + nl;
        v4u o; o.x = pg8::cvt_pk_bf16(s[0 * 33], s[1 * 33]); o.y = pg8::cvt_pk_bf16(s[2 * 33], s[3 * 33]); o.z = pg8::cvt_pk_bf16(s[4 * 33], s[5 * 33]); o.w = pg8::cvt_pk_bf16(s[6 * 33], s[7 * 33]);
        *(GAS v4u*)(c.dst + (size_t)drow * c.K + c.k0 + 8 * cc) = o; }
    LDS_WAIT(); asm volatile("" ::: "memory");
}
__device__ __forceinline__ void cv_item_early(Frame& F, int it, LAS float* scr) { CvItem c; float v[32]; cv_decode_early(F, it, c); cv_load(c, F.lane, v); cv_store(c, F.lane, v, scr); }
__device__ __forceinline__ void cv_run_early(Frame& F, int first, int stride, int n, LAS float* scr) {
    CvItem ca, cb; float va[32], vb[32];
    int it = first; if (it >= n) return;
    cv_decode_early(F, it, ca);
    cv_load(ca, F.lane, va);
    for (;;) {
        const int nit = it + stride; const bool more = nit < n;
        if (more) { cv_decode_early(F, nit, cb); cv_load(cb, F.lane, vb); }
        cv_store(ca, F.lane, va, scr);
        if (!more) break;
        ca = cb;
#pragma unroll
        for (int i = 0; i < 32; ++i) va[i] = vb[i];
        it = nit;
    }
}
__device__ __forceinline__ void xv_item(Frame& F, int it) {
    bf16* W1T = (bf16*)(F.ws + WS_W1T); bf16* W2T = (bf16*)(F.ws + WS_W2T);
    const float* w0 = F.in[18]; const float* w1 = F.in[20]; const float* w2 = F.in[22];
    asm volatile("" : "+s"(w0), "+s"(w1), "+s"(w2));
    const int lane = F.lane;
    {
        const int mat = it >> 7, kb = it & 127, kind = mat / NE, e = mat % NE;
        const float* src = (kind == 0 ? w0 : (kind == 1 ? w1 : w2)) + (size_t)e * D * FF + (size_t)(kb * 8) * FF + 4 * lane;
        f32x4 v[8][4];
#pragma unroll
        for (int rr = 0; rr < 8; ++rr)
#pragma unroll
            for (int j = 0; j < 4; ++j) v[rr][j] = *(const GAS f32x4*)(src + (size_t)rr * FF + 256 * j);
        bf16* dst; int cstride;
        if (kind < 2) { dst = W1T + (size_t)e * 2 * FF * D + ((size_t)kb * 2 * FF + (size_t)(lane >> 5) * 256 + (kind == 1 ? 128 : 0) + 4 * (lane & 31)) * 8; cstride = 512 * 8; }
        else { dst = W2T + (size_t)e * D * FF + ((size_t)kb * D + 4 * lane) * 8; cstride = 256 * 8; }
#pragma unroll
        for (int j = 0; j < 4; ++j)
#pragma unroll
            for (int c = 0; c < 4; ++c) { v4u o; o.x = pg8::cvt_pk_bf16(v[0][j][c], v[1][j][c]); o.y = pg8::cvt_pk_bf16(v[2][j][c], v[3][j][c]); o.z = pg8::cvt_pk_bf16(v[4][j][c], v[5][j][c]); o.w = pg8::cvt_pk_bf16(v[6][j][c], v[7][j][c]);
                *(GAS v4u*)(dst + (size_t)j * cstride + c * 8) = o; }
    }
}
__device__ __forceinline__ void rms_row_to_bf16(int lane, const float* xrow, const float* g, bf16* orow) {
    const GAS f32x4* xr = (const GAS f32x4*)xrow + lane; const GAS f32x4* gr = (const GAS f32x4*)g + lane;
    f32x4 v[4]; float s = 0.f;
#pragma unroll
    for (int j = 0; j < 4; ++j) { v[j] = xr[64 * j]; s += (v[j].x * v[j].x + v[j].y * v[j].y) + (v[j].z * v[j].z + v[j].w * v[j].w); }
    const float rstd = 1.0f / sqrtf(wave_sum(s) * (1.f / D) + EPS);
    GAS unsigned long long* o8 = (GAS unsigned long long*)orow + lane;
#pragma unroll
    for (int j = 0; j < 4; ++j) { const f32x4 gg = gr[64 * j]; o8[64 * j] = (unsigned long long)pk2(v[j].x * rstd * gg.x, v[j].y * rstd * gg.y) | ((unsigned long long)pk2(v[j].z * rstd * gg.z, v[j].w * rstd * gg.w) << 32); }
}
__device__ __forceinline__ void sincos_acc(float th, float& s, float& c) {
    const float k = rintf(th * 0.15915494309189535f);
    float r = fmaf(-k, 6.28125f, th); r = fmaf(-k, 1.9353071795864769e-3f, r);
    const float x = 0.25f * r, x2 = x * x;
    float sn = x * (1.0f + x2 * (-1.0f / 6 + x2 * (1.0f / 120 + x2 * (-1.0f / 5040 + x2 * (1.0f / 362880 + x2 * (-1.0f / 39916800))))));
    float cs = 1.0f + x2 * (-0.5f + x2 * (1.0f / 24 + x2 * (-1.0f / 720 + x2 * (1.0f / 40320 + x2 * (-1.0f / 3628800 + x2 * (1.0f / 479001600))))));
#pragma unroll
    for (int i = 0; i < 2; ++i) { const float s2 = 2.0f * sn * cs, c2 = 1.0f - 2.0f * sn * sn; sn = s2; cs = c2; }
    s = sn; c = cs;
}
__device__ __forceinline__ void ssm_tables(Frame& F, int g) {
    constexpr int PS = 65, BS = 17, CS = 65, KT = 273, KC = 17;
    LAS float* pwr = (LAS float*)(F.lds);
    LAS float* pwi = pwr + 33 * PS;
    LAS float* bbr = pwi + 33 * PS;
    LAS float* bbi = bbr + 64 * BS;
    LAS float* ccr = bbi + 64 * BS;
    LAS float* cci = ccr + 16 * CS;
    LAS float* km = cci + 16 * CS;
    const float* lam_re = F.in[3]; const float* lam_im = F.in[4]; const float* log_dt = F.in[5];
    const float* b_re = F.in[6]; const float* b_im = F.in[7]; const float* c_re = F.in[8]; const float* c_im = F.in[9]; const float* dsk = F.in[10];
    float* lamL = (float*)(F.ws + WS_LAML); bf16* WE = (bf16*)(F.ws + WS_WE); bf16* TW = (bf16*)(F.ws + WS_TW);
    const int tid = F.tid;
    if (tid < 64) { const int p = tid;
        const float lr = lam_re[g * NP + p], li = lam_im[g * NP + p], dt = expf(log_dt[g]);
        const float er = expf(lr * dt); float sn, cs; sincos_acc(li * dt, sn, cs);
        const float br = er * cs, bi = er * sn;
        const float nr = br - 1.0f, ni = bi, den = 1.0f / (lr * lr + li * li);
        const float fr = (nr * lr + ni * li) * den, fi = (ni * lr - nr * li) * den;
        float pr = 1.0f, pi = 0.0f;
        for (int n = 0; n <= 32; ++n) { pwr[n * PS + p] = pr; pwi[n * PS + p] = pi; const float t = pr * br - pi * bi; pi = pr * bi + pi * br; pr = t; }
        lamL[(g * 2 + 0) * NP + p] = pwr[32 * PS + p]; lamL[(g * 2 + 1) * NP + p] = pwi[32 * PS + p];
        float xr[GC], xi[GC];
#pragma unroll
        for (int c = 0; c < GC; ++c) { xr[c] = b_re[(g * NP + p) * GC + c]; xi[c] = b_im[(g * NP + p) * GC + c]; }
#pragma unroll
        for (int c = 0; c < GC; ++c) { bbr[p * BS + c] = fr * xr[c] - fi * xi[c]; bbi[p * BS + c] = fr * xi[c] + fi * xr[c]; }
    }
    for (int i = tid; i < 1024; i += NWAVES * 64) { ccr[(i >> 6) * CS + (i & 63)] = c_re[g * 1024 + i]; cci[(i >> 6) * CS + (i & 63)] = c_im[g * 1024 + i]; }
    __syncthreads();
    {
        const int pair = tid & 255, co = pair >> 4, ci = pair & 15, t0 = (tid >> 8) * 16;
        float acc[16];
#pragma unroll
        for (int t = 0; t < 16; ++t) acc[t] = 0.f;
        for (int p = 0; p < NP; ++p) { const float cr = ccr[co * CS + p], cim = cci[co * CS + p], xr = bbr[p * BS + ci], xi = bbi[p * BS + ci];
            const float gr = cr * xr - cim * xi, gi = cr * xi + cim * xr;
#pragma unroll
            for (int t = 0; t < 16; ++t) acc[t] += gr * pwr[(t0 + t) * PS + p] - gi * pwi[(t0 + t) * PS + p]; }
#pragma unroll
        for (int t = 0; t < 16; ++t) km[(t0 + t) * KT + co * KC + ci] = acc[t];
    }
    __syncthreads();
    {
        const int n = tid, i = n >> 4, co = n & 15; const float dv = dsk[g * GC + co];
        bf16* dst = TW + ((size_t)g * 512 + n) * UK;
        for (int j = 0; j < LC; ++j) {
            float v[16];
#pragma unroll
            for (int ci = 0; ci < 16; ++ci) { float val = (j <= i) ? km[(j <= i ? i - j : 0) * KT + co * KC + ci] : 0.f; if (j == i && ci == co) val += dv; v[ci] = val; }
            v4u o0, o1; o0.x = pg8::cvt_pk_bf16(v[0], v[1]); o0.y = pg8::cvt_pk_bf16(v[2], v[3]); o0.z = pg8::cvt_pk_bf16(v[4], v[5]); o0.w = pg8::cvt_pk_bf16(v[6], v[7]);
            o1.x = pg8::cvt_pk_bf16(v[8], v[9]); o1.y = pg8::cvt_pk_bf16(v[10], v[11]); o1.z = pg8::cvt_pk_bf16(v[12], v[13]); o1.w = pg8::cvt_pk_bf16(v[14], v[15]);
            *(GAS v4u*)(dst + j * 16) = o0; *(GAS v4u*)(dst + j * 16 + 8) = o1; }
        for (int k8 = 0; k8 < 16; ++k8) { float v[8];
#pragma unroll
            for (int e = 0; e < 8; ++e) { const int k = k8 * 8 + e, ri = k >> 6, p = k & 63; const float cr = ccr[co * CS + p], cim = cci[co * CS + p], pr = pwr[(i + 1) * PS + p], pi = pwi[(i + 1) * PS + p];
                v[e] = ri == 0 ? (cr * pr - cim * pi) : -(cr * pi + cim * pr); }
            v4u o; o.x = pg8::cvt_pk_bf16(v[0], v[1]); o.y = pg8::cvt_pk_bf16(v[2], v[3]); o.z = pg8::cvt_pk_bf16(v[4], v[5]); o.w = pg8::cvt_pk_bf16(v[6], v[7]);
            *(GAS v4u*)(dst + 512 + k8 * 8) = o; }
    }
    {
        const int row = tid & 127, ri = row >> 6, p = row & 63, kq = tid >> 7;
        bf16* dst = WE + ((size_t)g * 128 + row) * 512 + kq * 128;
        for (int k8 = 0; k8 < 16; ++k8) { float v[8];
#pragma unroll
            for (int e = 0; e < 8; ++e) { const int k = kq * 128 + k8 * 8 + e, j = k >> 4, c = k & 15; const float pr = pwr[(31 - j) * PS + p], pi = pwi[(31 - j) * PS + p], xr = bbr[p * BS + c], xi = bbi[p * BS + c];
                v[e] = ri == 0 ? (pr * xr - pi * xi) : (pr * xi + pi * xr); }
            v4u o; o.x = pg8::cvt_pk_bf16(v[0], v[1]); o.y = pg8::cvt_pk_bf16(v[2], v[3]); o.z = pg8::cvt_pk_bf16(v[4], v[5]); o.w = pg8::cvt_pk_bf16(v[6], v[7]);
            *(GAS v4u*)(dst + k8 * 8) = o; }
    }
    __syncthreads();
}
__device__ __forceinline__ void rms_rows2_to_bf16(int lane, const float* x0, const float* x1, const float* g, bf16* o0, bf16* o1) {
    const GAS f32x4* xa = (const GAS f32x4*)x0 + lane; const GAS f32x4* xb = (const GAS f32x4*)x1 + lane; const GAS f32x4* gr = (const GAS f32x4*)g + lane;
    f32x4 va[4], vb[4]; float sa = 0.f, sb = 0.f;
#pragma unroll
    for (int j = 0; j < 4; ++j) { va[j] = xa[64 * j]; vb[j] = xb[64 * j]; }
#pragma unroll
    for (int j = 0; j < 4; ++j) { sa += (va[j].x * va[j].x + va[j].y * va[j].y) + (va[j].z * va[j].z + va[j].w * va[j].w); sb += (vb[j].x * vb[j].x + vb[j].y * vb[j].y) + (vb[j].z * vb[j].z + vb[j].w * vb[j].w); }
#pragma unroll
    for (int o = 1; o < 64; o <<= 1) { sa += __shfl_xor(sa, o); sb += __shfl_xor(sb, o); }
    const float ra = 1.0f / sqrtf(sa * (1.f / D) + EPS), rb = 1.0f / sqrtf(sb * (1.f / D) + EPS);
    GAS v2u* pa = (GAS v2u*)o0 + lane; GAS v2u* pb = (GAS v2u*)o1 + lane;
#pragma unroll
    for (int j = 0; j < 4; ++j) { const f32x4 gg = gr[64 * j];
        v2u wa, wb; wa.x = pg8::cvt_pk_bf16(va[j].x * ra * gg.x, va[j].y * ra * gg.y); wa.y = pg8::cvt_pk_bf16(va[j].z * ra * gg.z, va[j].w * ra * gg.w);
        wb.x = pg8::cvt_pk_bf16(vb[j].x * rb * gg.x, vb[j].y * rb * gg.y); wb.y = pg8::cvt_pk_bf16(vb[j].z * rb * gg.z, vb[j].w * rb * gg.w);
        pa[64 * j] = wa; pb[64 * j] = wb; }
}
constexpr int Q0_EXP = CV_N_EXP, Q0_HN = Q0_EXP + M / 8, Q0_END = Q0_HN + CV_N_EARLY / 4;
static_assert(Q0_END % 8 == 0 && CV_N_EARLY % 4 == 0, "P0 queue");
__device__ __forceinline__ void p0_prologue(Frame& F, unsigned long long& t_lo_, unsigned long long& t_hi_) {
    TMARK(100);
    const bool tabler = (F.vcu & 7) == 0 && (F.vcu >> 3) < NG;
    if (tabler) { ssm_tables(F, F.vcu >> 3);
        if ((F.vcu >> 3) == 0 && F.tid < 128) {
            bf16* WE = (bf16*)(F.ws + WS_WE) + (size_t)NG * 128 * 512;
            for (int i = 0; i < 512 / 8; ++i) *(GAS v4u*)(WE + (size_t)F.tid * 512 + i * 8) = (v4u){0u, 0u, 0u, 0u}; } }
    if (tabler && (F.vcu >> 3) == 1) {
        const float* wr = F.in[16]; bf16* img = (bf16*)(F.ws + WS_RWIMG);
        for (int idx = F.tid; idx < D * NE; idx += NWAVES * 64) { const float w = wr[idx]; const unsigned h = f2bf(w); const unsigned l = f2bf(w - bf2f((unsigned short)h)); const int k = idx >> 5, e = idx & 31;
            img[e * RT_WSTR + k] = (bf16)h; img[(NE + e) * RT_WSTR + k] = (bf16)l; }
        if (F.tid < 2 * NE) for (int k = D; k < RT_WSTR; ++k) img[F.tid * RT_WSTR + k] = 0; }
    TMARK(101);
    LAS float* scr = (LAS float*)(F.lds + RING_OFF + F.wave * 16384);
    unsigned* q = (unsigned*)(F.ctl + CW_Q0); volatile LAS unsigned* slot = F.MISC + 16;
    bf16* HN = (bf16*)(F.ws + WS_HN);
    for (;;) {
        __syncthreads();
        if (F.tid == 0) *slot = __hip_atomic_fetch_add(q, 8u, RLX_AGENT);
        __syncthreads();
        const int base = (int)__builtin_amdgcn_readfirstlane(*slot); if (base >= Q0_END) break;
        const int idx = base + F.wave;
        if (idx < Q0_EXP) xv_item(F, idx);
        else if (idx < Q0_HN) { const int m0 = (idx - Q0_EXP) * 8;
#pragma unroll 1
            for (int j = 0; j < 4; ++j) { const int m = m0 + 2 * j; rms_rows2_to_bf16(F.lane, F.in[0] + (size_t)m * D, F.in[0] + (size_t)(m + 1) * D, F.in[1], HN + (size_t)m * D, HN + (size_t)(m + 1) * D); } }
        else { const int g4 = (idx - Q0_HN) * 4;
#pragma unroll 1
            for (int j = 0; j < 4; ++j) cv_item_early(F, g4 + j, scr); }
    }
    TMARK(104);
}

__device__ __forceinline__ void attn_simple_unit(const unsigned short* Qh, const unsigned short* Kh, const unsigned short* Vh, bf16* Y, int b, int h, int qb, int lane) {
    const int t = qb * 64 + lane; const size_t row = (size_t)b * SEQ + t;
    float q[64], o[64];
    { const v4u* qp = (const v4u*)(Qh + row * SBW + h * HD);
#pragma unroll
      for (int i = 0; i < 8; ++i) { const v4u w = qp[i];
#pragma unroll
          for (int j = 0; j < 4; ++j) { const unsigned wj = w[j]; const h16x2 hv = __builtin_bit_cast(h16x2, wj); q[8 * i + 2 * j] = (float)hv.x; q[8 * i + 2 * j + 1] = (float)hv.y; } } }
#pragma unroll
    for (int d = 0; d < 64; ++d) o[d] = 0.f;
    float cum = 0.f;
    for (int s = qb * 64 + 62; s >= 0; --s) {
        const size_t krow = ((size_t)b * SEQ + s) * SBW + h * HD;
        const v4u* kp = (const v4u*)(Kh + krow); const v4u* vp = (const v4u*)(Vh + krow);
        float z = 0.f;
#pragma unroll
        for (int i = 0; i < 8; ++i) { const v4u w = kp[i];
#pragma unroll
            for (int j = 0; j < 4; ++j) { const unsigned wj = w[j]; const h16x2 hv = __builtin_bit_cast(h16x2, wj); z = fmaf(q[8 * i + 2 * j], (float)hv.x, z); z = fmaf(q[8 * i + 2 * j + 1], (float)hv.y, z); } }
        const bool act = s < t;
        const float t1 = flog2(1.0f + fexp2(-fabsf(z)));
        const float L = act ? -(fmaxf(z, 0.f) + t1) : 0.f;
        const float ls = fminf(z, 0.f) - t1;
        const float p = act ? fexp2(ls + cum) : 0.f;
        cum += L;
#pragma unroll
        for (int i = 0; i < 8; ++i) { const v4u w = vp[i];
#pragma unroll
            for (int j = 0; j < 4; ++j) { const unsigned wj = w[j]; const h16x2 hv = __builtin_bit_cast(h16x2, wj); o[8 * i + 2 * j] = fmaf(p, (float)hv.x, o[8 * i + 2 * j]); o[8 * i + 2 * j + 1] = fmaf(p, (float)hv.y, o[8 * i + 2 * j + 1]); } }
        if (__all(cum < -150.0f)) break;
    }
    bf16* yp = Y + row * SBW + h * HD;
#pragma unroll
    for (int i = 0; i < 8; ++i) { v4u w; w.x = pk2(o[8 * i], o[8 * i + 1]); w.y = pk2(o[8 * i + 2], o[8 * i + 3]); w.z = pk2(o[8 * i + 4], o[8 * i + 5]); w.w = pk2(o[8 * i + 6], o[8 * i + 7]); *(v4u*)(yp + 8 * i) = w; }
}
typedef _Float16 h8v __attribute__((ext_vector_type(8)));
typedef float f16v __attribute__((ext_vector_type(16)));
__device__ __forceinline__ void attn_mfma_unit(const _Float16* Qh, const _Float16* Kh, const _Float16* VT, bf16* Y, int b, int hd, int qb, int lane, h8v tri0, h8v tri1) {
    const int r = lane & 31, hh = lane >> 5, q0 = qb * 32;
    const _Float16* qrow = Qh + ((size_t)b * SEQ + q0 + r) * SBW + hd * HD + 8 * hh;
    h8v qf[4];
#pragma unroll
    for (int kd = 0; kd < 4; ++kd) qf[kd] = *(const h8v*)(qrow + 16 * kd);
    f16v o0, o1;
#pragma unroll
    for (int i = 0; i < 16; ++i) { o0[i] = 0.f; o1[i] = 0.f; }
    float carry = 0.f;
    const _Float16* kbase = Kh + ((size_t)b * SEQ + r) * SBW + hd * HD + 8 * hh;
    const _Float16* vbase = VT + ((size_t)b * SBW + hd * HD + r) * SEQ + 8 * hh;
    h8v kf[4], vf[2][2], kn[4], vn[2][2];
#pragma unroll
    for (int kd = 0; kd < 4; ++kd) kf[kd] = *(const h8v*)(kbase + (size_t)q0 * SBW + 16 * kd);
#pragma unroll
    for (int db = 0; db < 2; ++db)
#pragma unroll
        for (int ss = 0; ss < 2; ++ss) vf[db][ss] = *(const h8v*)(vbase + (size_t)(32 * db) * SEQ + q0 + 16 * ss);
    for (int key0 = q0; key0 >= 0; key0 -= 32) {
        { const int kn0 = key0 >= 32 ? key0 - 32 : key0;
#pragma unroll
          for (int kd = 0; kd < 4; ++kd) kn[kd] = *(const h8v*)(kbase + (size_t)kn0 * SBW + 16 * kd);
#pragma unroll
          for (int db = 0; db < 2; ++db)
#pragma unroll
              for (int ss = 0; ss < 2; ++ss) vn[db][ss] = *(const h8v*)(vbase + (size_t)(32 * db) * SEQ + kn0 + 16 * ss); }
        f16v z;
#pragma unroll
        for (int i = 0; i < 16; ++i) z[i] = 0.f;
#pragma unroll
        for (int kd = 0; kd < 4; ++kd) z = __builtin_amdgcn_mfma_f32_32x32x16_f16(kf[kd], qf[kd], z, 0, 0, 0);
        const bool diag = key0 == q0;
        h8v lh[2], ll[2];
#pragma unroll
        for (int i = 0; i < 16; ++i) { const int koff = (i & 3) + 8 * (i >> 2) + 4 * hh; const bool act = !diag || koff < r;
            const float zi = z[i]; const float t1 = flog2(1.0f + fexp2(-fabsf(zi)));
            const float L = act ? fmaxf(-(fmaxf(zi, 0.f) + t1), -60000.0f) : 0.f;
            const _Float16 hi = (_Float16)L; const _Float16 lo = (_Float16)(L - (float)hi);
            lh[i >> 3][i & 7] = hi; ll[i >> 3][i & 7] = lo; }
        f16v cum;
#pragma unroll
        for (int i = 0; i < 16; ++i) cum[i] = carry;
        cum = __builtin_amdgcn_mfma_f32_32x32x16_f16(tri0, lh[0], cum, 0, 0, 0);
        cum = __builtin_amdgcn_mfma_f32_32x32x16_f16(tri1, lh[1], cum, 0, 0, 0);
        cum = __builtin_amdgcn_mfma_f32_32x32x16_f16(tri0, ll[0], cum, 0, 0, 0);
        cum = __builtin_amdgcn_mfma_f32_32x32x16_f16(tri1, ll[1], cum, 0, 0, 0);
        h8v pf[2];
#pragma unroll
        for (int i = 0; i < 16; ++i) { const int koff = (i & 3) + 8 * (i >> 2) + 4 * hh; const bool act = !diag || koff < r;
            const float p = act ? fexp2(z[i] + cum[i]) : 0.f; pf[i >> 3][i & 7] = (_Float16)p; }
        o0 = __builtin_amdgcn_mfma_f32_32x32x16_f16(vf[0][0], pf[0], o0, 0, 0, 0);
        o0 = __builtin_amdgcn_mfma_f32_32x32x16_f16(vf[0][1], pf[1], o0, 0, 0, 0);
        o1 = __builtin_amdgcn_mfma_f32_32x32x16_f16(vf[1][0], pf[0], o1, 0, 0, 0);
        o1 = __builtin_amdgcn_mfma_f32_32x32x16_f16(vf[1][1], pf[1], o1, 0, 0, 0);
        carry = __shfl(cum[0], r);
        if (__all(carry < -150.0f)) break;
#pragma unroll
        for (int kd = 0; kd < 4; ++kd) kf[kd] = kn[kd];
#pragma unroll
        for (int db = 0; db < 2; ++db)
#pragma unroll
            for (int ss = 0; ss < 2; ++ss) vf[db][ss] = vn[db][ss];
    }
    bf16* yp = Y + ((size_t)b * SEQ + q0 + r) * SBW + hd * HD + 4 * hh;
#pragma unroll
    for (int g4 = 0; g4 < 4; ++g4) { v2u w0, w1; w0.x = pk2(o0[4 * g4], o0[4 * g4 + 1]); w0.y = pk2(o0[4 * g4 + 2], o0[4 * g4 + 3]); w1.x = pk2(o1[4 * g4], o1[4 * g4 + 1]); w1.y = pk2(o1[4 * g4 + 2], o1[4 * g4 + 3]);
        *(v2u*)(yp + 8 * g4) = w0; *(v2u*)(yp + 32 + 8 * g4) = w1; }
}
__device__ __forceinline__ void attn_one(Frame& F, int u) {
    const _Float16* Qh = (const _Float16*)(F.ws + WS_Q); const _Float16* Kh = (const _Float16*)(F.ws + WS_K); const _Float16* VT = (const _Float16*)(F.ws + WS_V);
    bf16* Y = (bf16*)(F.ws + WS_YSB);
    constexpr int NQB = SEQ / 32;
    const int lane = F.lane, r = lane & 31, hh = lane >> 5;
    h8v tri0, tri1;
#pragma unroll
    for (int e = 0; e < 8; ++e) { const int k0 = 8 * (e >> 2) + 4 * hh + (e & 3); tri0[e] = (k0 >= r) ? (_Float16)1.0f : (_Float16)0.0f; tri1[e] = (16 + k0 >= r) ? (_Float16)1.0f : (_Float16)0.0f; }
    const int qb = u % NQB, bh = u / NQB; attn_mfma_unit(Qh, Kh, VT, Y, bh / NH, bh % NH, qb, lane, tri0, tri1);
}

__device__ __forceinline__ void scan_phase(Frame& F) {
    const int task = F.vcu;
    const int b = task / NG, g = task % NG, p = F.lane;
    const float* lamL = (const float*)(F.ws + WS_LAML); const float* S = (const float*)(F.ws + WS_SLOC); bf16* U = (bf16*)(F.ws + WS_UCAT);
    const float lr = lamL[(g * 2 + 0) * NP + p], li = lamL[(g * 2 + 1) * NP + p];
    float xr = 0.f, xi = 0.f;
    for (int c0 = 0; c0 < CPB; c0 += 8) {
        float sr[8], si[8];
#pragma unroll
        for (int j = 0; j < 8; ++j) { const size_t base = ((size_t)(b * CPB + c0 + j) * NG + g) * 128; sr[j] = S[base + p]; si[j] = S[base + 64 + p]; }
#pragma unroll
        for (int j = 0; j < 8; ++j) { bf16* dst = U + ((size_t)(b * CPB + c0 + j) * NG + g) * UK + 512;
            dst[p] = (bf16)f2bf(xr); dst[64 + p] = (bf16)f2bf(xi);
            const float nr = lr * xr - li * xi + sr[j], ni = lr * xi + li * xr + si[j]; xr = nr; xi = ni; }
    }
}

__device__ __forceinline__ void mix_phase(Frame& F) {
    const bf16* YSB = (const bf16*)(F.ws + WS_YSB); const bf16* YSSM = (const bf16*)(F.ws + WS_YSSM); bf16* MX = (bf16*)(F.ws + WS_MIXED);
    const float* g_sb = F.in[12]; const float* g_ssm = F.in[13];
    const int gw = F.vcu * NWAVES + F.wave, NGW = F.G * NWAVES, lane = F.lane;
    f32x4 ga[2], gb[2];
#pragma unroll
    for (int j = 0; j < 2; ++j) { ga[j] = *(const f32x4*)(g_sb + 8 * lane + 4 * j); gb[j] = *(const f32x4*)(g_ssm + 8 * lane + 4 * j); }
    for (int m = gw; m < M; m += NGW) {
        const v4u a = *(const v4u*)(YSB + (size_t)m * SBW + 8 * lane), c = *(const v4u*)(YSSM + (size_t)m * SSW + 8 * lane);
        float av[8], cv[8]; float sa = 0.f, sc = 0.f;
#pragma unroll
        for (int j = 0; j < 4; ++j) { av[2 * j] = bflo(a[j]); av[2 * j + 1] = bfhi(a[j]); cv[2 * j] = bflo(c[j]); cv[2 * j + 1] = bfhi(c[j]); }
#pragma unroll
        for (int j = 0; j < 8; ++j) { sa += av[j] * av[j]; sc += cv[j] * cv[j]; }
        const float ra = 1.0f / sqrtf(wave_sum(sa) * (1.f / SBW) + EPS), rc = 1.0f / sqrtf(wave_sum(sc) * (1.f / SSW) + EPS);
        v4u oa, oc;
#pragma unroll
        for (int j = 0; j < 4; ++j) { oa[j] = pk2(av[2 * j] * ra * ga[j >> 1][(2 * j) & 3], av[2 * j + 1] * ra * ga[j >> 1][(2 * j + 1) & 3]);
                                      oc[j] = pk2(cv[2 * j] * rc * gb[j >> 1][(2 * j) & 3], cv[2 * j + 1] * rc * gb[j >> 1][(2 * j + 1) & 3]); }
        if (DBG_MODE == 3) oa = (v4u){0u, 0u, 0u, 0u};
        if (DBG_MODE == 2) oc = (v4u){0u, 0u, 0u, 0u};
        *(v4u*)(MX + (size_t)m * D + 8 * lane) = oa; *(v4u*)(MX + (size_t)m * D + SBW + 8 * lane) = oc;
    }
}

__device__ __forceinline__ void router_phase(Frame& F) {
    typedef short s8v __attribute__((ext_vector_type(8)));
    typedef float f16v __attribute__((ext_vector_type(16)));
    LAS bf16* wh = (LAS bf16*)F.lds; LAS bf16* wl = wh + NE * RT_WSTR;
    LAS int* lcnt = (LAS int*)(F.lds + RT_SCR_OFF); LAS int* lbase = lcnt + 32; LAS int* asg = lbase + 32;
    const float* wr = F.in[16]; const float* br = F.in[17]; const float* g2 = F.in[15];
    const float* X1 = F.out; bf16* XG = (bf16*)(F.ws + WS_XN); float* gates = (float*)(F.ws + WS_GATES); int* lists = (int*)(F.ws + WS_LISTS); float* RS = (float*)(F.ws + WS_RSTD);
    unsigned* gcnt = (unsigned*)(F.ctl + CW_CNT);
    const int tid = F.tid, lane = F.lane, r = lane & 31, hh = lane >> 5;
    const int task = F.wave >> 2, kq = F.wave & 3; const int tok = F.vcu * 64 + task * 32 + r;
    const float* xp = X1 + (size_t)tok * D + kq * 256 + 8 * hh; bf16* xo = XG + (size_t)tok * D + kq * 256 + 8 * hh;
    f32x4 xa[16], xb[16];
#pragma unroll
    for (int ks = 0; ks < 16; ++ks) { xa[ks] = *(const f32x4*)(xp + 16 * ks); xb[ks] = *(const f32x4*)(xp + 16 * ks + 4); }
    { const v4u* src = (const v4u*)(F.ws + WS_RWIMG); LAS v4u* dst = (LAS v4u*)F.lds;
      for (int i = tid; i < RT_W_BYTES / 16; i += NWAVES * 64) dst[i] = src[i]; }
    LAS float* gl = (LAS float*)(F.lds + RT_SCR_OFF + 2048);
    for (int i = tid; i < D / 4; i += NWAVES * 64) ((LAS f32x4*)gl)[i] = ((const f32x4*)g2)[i];
    if (tid < 32) lcnt[tid] = 0;
    __syncthreads();
    f16v acc;
#pragma unroll
    for (int i = 0; i < 16; ++i) acc[i] = 0.f;
    float ss = 0.f;
    const LAS float* gp = gl + kq * 256 + 8 * hh;
    const LAS bf16* whp = wh + r * RT_WSTR + kq * 256 + 8 * hh; const LAS bf16* wlp = wl + r * RT_WSTR + kq * 256 + 8 * hh;
#pragma unroll
    for (int ks = 0; ks < 16; ++ks) {
        const f32x4 x0 = xa[ks], x1 = xb[ks], g0 = *(const LAS f32x4*)(gp + 16 * ks), g1 = *(const LAS f32x4*)(gp + 16 * ks + 4);
        ss += (x0.x * x0.x + x0.y * x0.y) + (x0.z * x0.z + x0.w * x0.w) + (x1.x * x1.x + x1.y * x1.y) + (x1.z * x1.z + x1.w * x1.w);
        const f32x4 a0 = x0 * g0, a1 = x1 * g1;
        v4u hv, lv;
        hv.x = pg8::cvt_pk_bf16(a0.x, a0.y); hv.y = pg8::cvt_pk_bf16(a0.z, a0.w); hv.z = pg8::cvt_pk_bf16(a1.x, a1.y); hv.w = pg8::cvt_pk_bf16(a1.z, a1.w);
        lv.x = pg8::cvt_pk_bf16(a0.x - bflo(hv.x), a0.y - bfhi(hv.x)); lv.y = pg8::cvt_pk_bf16(a0.z - bflo(hv.y), a0.w - bfhi(hv.y));
        lv.z = pg8::cvt_pk_bf16(a1.x - bflo(hv.z), a1.y - bfhi(hv.z)); lv.w = pg8::cvt_pk_bf16(a1.z - bflo(hv.w), a1.w - bfhi(hv.w));
        *(v4u*)(xo + 16 * ks) = hv;
        const s8v xh = __builtin_bit_cast(s8v, hv), xl = __builtin_bit_cast(s8v, lv);
        v4u ah, al; { const LAS v2u* p = (const LAS v2u*)(whp + 16 * ks); const v2u q0 = p[0], q1 = p[1]; ah.x = q0.x; ah.y = q0.y; ah.z = q1.x; ah.w = q1.y; }
        { const LAS v2u* p = (const LAS v2u*)(wlp + 16 * ks); const v2u q0 = p[0], q1 = p[1]; al.x = q0.x; al.y = q0.y; al.z = q1.x; al.w = q1.y; }
        const s8v wa = __builtin_bit_cast(s8v, ah), wb = __builtin_bit_cast(s8v, al);
        acc = __builtin_amdgcn_mfma_f32_32x32x16_bf16(wa, xh, acc, 0, 0, 0);
        acc = __builtin_amdgcn_mfma_f32_32x32x16_bf16(wb, xh, acc, 0, 0, 0);
        acc = __builtin_amdgcn_mfma_f32_32x32x16_bf16(wa, xl, acc, 0, 0, 0);
    }
    __syncthreads();
    LAS float* part = (LAS float*)F.lds;
#pragma unroll
    for (int i = 0; i < 16; ++i) part[(F.wave * 17 + i) * 64 + lane] = acc[i];
    part[(F.wave * 17 + 16) * 64 + lane] = ss;
    __syncthreads();
    if (kq == 0) {
        float v[32]; float st = 0.f;
#pragma unroll
        for (int w = 0; w < 4; ++w) { const LAS float* pw = part + (size_t)((task * 4 + w) * 17) * 64;
#pragma unroll
            for (int i = 0; i < 16; ++i) { const float t = pw[i * 64 + lane]; v[i] = w == 0 ? t : v[i] + t; }
            st += pw[16 * 64 + lane] + pw[16 * 64 + (lane ^ 32)]; }
        const float rstd = 1.0f / sqrtf(st * (1.f / D) + EPS);
        if (hh == 0) RS[tok] = rstd;
#pragma unroll
        for (int i = 0; i < 16; ++i) { const int e = (i & 3) + 8 * (i >> 2) + 4 * hh; v[i] = v[i] * rstd + br[e]; }
#pragma unroll
        for (int i = 0; i < 16; ++i) v[16 + i] = __shfl_xor(v[i], 32);
        float mx = v[0];
#pragma unroll
        for (int i = 1; i < 32; ++i) mx = fmaxf(mx, v[i]);
        int rk[16]; float es = 0.f;
#pragma unroll
        for (int i = 0; i < 16; ++i) { const int ei = (i & 3) + 8 * (i >> 2) + 4 * hh; int rank = 0;
#pragma unroll
            for (int j = 0; j < 32; ++j) { if (j == i) continue; const int ej = (j & 3) + 8 * ((j & 15) >> 2) + 4 * (j < 16 ? hh : 1 - hh);
                rank += (v[j] > v[i] || (v[j] == v[i] && ej < ei)) ? 1 : 0; }
            rk[i] = rank; if (rank < TOPK) es += fexp2((v[i] - mx) * LOG2E); }
        es += __shfl_xor(es, 32);
        const float inv = 1.0f / es;
#pragma unroll
        for (int i = 0; i < 16; ++i) if (rk[i] < TOPK) { const int ei = (i & 3) + 8 * (i >> 2) + 4 * hh;
            gates[tok * TOPK + rk[i]] = fexp2((v[i] - mx) * LOG2E) * inv;
            const int pos = __hip_atomic_fetch_add(lcnt + ei, 1, __ATOMIC_RELAXED, __HIP_MEMORY_SCOPE_WORKGROUP);
            asg[(task * 32 + r) * 4 + rk[i]] = ei | (pos << 8); }
    }
    __syncthreads();
    if (tid < 32) lbase[tid] = (int)__hip_atomic_fetch_add(gcnt + tid, (unsigned)lcnt[tid], RLX_AGENT);
    __syncthreads();
    if (tid < 64 * TOPK) { const int a = asg[tid], e = a & 255, pos = a >> 8; const int tk = F.vcu * 64 + (tid >> 2);
        lists[e * M + lbase[e] + pos] = tk * TOPK + (tid & 3); }
    __syncthreads();
}

__device__ __forceinline__ void moe_tables(Frame& F) {
    LAS int* tab = (LAS int*)(F.lds + TAB_OFF); LAS int* cnt = tab, * mt = tab + 32, * tbase = tab + 64;
    unsigned* gcnt = (unsigned*)(F.ctl + CW_CNT);
    if (F.tid < 32) { const int c = (int)__hip_atomic_load(gcnt + F.tid, RLX_AGENT); cnt[F.tid] = c; mt[F.tid] = (c + 255) >> 8; }
    __syncthreads();
    if (F.tid == 0) { int s = 0; for (int e = 0; e < NE; ++e) { tbase[e] = s; s += mt[e]; } tbase[NE] = s; }
    __syncthreads();
}
__device__ __forceinline__ void moe_units(Frame& F, int npn, int gpn) {
    LAS int* tab = (LAS int*)(F.lds + TAB_OFF); LAS int* mt = tab + 32, * tbase = tab + 64; LAS int* units = (LAS int*)(F.lds + UNITS_OFF);
    if (F.tid < 32) {
        const int nU = tbase[NE] * npn; const int L = F.tid * F.G + (int)blockIdx.x; int pm = 0, pn = 0, e = 0, valid = 0;
        if (L < nU) { const int seq = pg8::xcd_remap(L, nU); int ee = 0; while (ee < NE - 1 && seq >= tbase[ee + 1] * npn) ++ee;
            const int r = seq - tbase[ee] * npn, m = mt[ee]; const int grp = r / (m * gpn), r2 = r % (m * gpn);
            e = ee; pn = grp * gpn + r2 / m; pm = tbase[ee] + r2 % m; valid = 1; }
        units[4 * F.tid + 0] = pm; units[4 * F.tid + 1] = pn; units[4 * F.tid + 2] = e; units[4 * F.tid + 3] = valid;
    }
    __syncthreads();
}

__device__ __forceinline__ void moe_gather_tables(Frame& F) {
    LAS int* tab = (LAS int*)(F.lds + TAB_OFF); LAS int* cnt = tab, * tbase = tab + 64; LAS int* units = (LAS int*)(F.lds + UNITS_OFF); LAS int* tokmap = (LAS int*)(F.lds + TOKMAP_OFF);
    const float* gates = (const float*)(F.ws + WS_GATES); const int* lists = (const int*)(F.ws + WS_LISTS); const float* RS = (const float*)(F.ws + WS_RSTD); int* rowinfo = (int*)(F.ws + WS_ROWINFO);
    for (int idx = F.tid; idx < TOKMAP_SLOTS * 256; idx += NWAVES * 64) { const int i = idx >> 8, R = idx & 255; int tk = 0;
        if (units[4 * i + 3]) { const int pm = units[4 * i], e = units[4 * i + 2]; const int li = (pm - tbase[e]) * 256 + R;
            v4u ri = (v4u){0xffffffffu, 0u, 0u, 0u};
            if (li < cnt[e]) { const int slot = lists[e * M + li]; tk = slot >> 2; ri = (v4u){(unsigned)slot, __builtin_bit_cast(unsigned, gates[slot]), __builtin_bit_cast(unsigned, RS[tk]), 0u}; }
            *(v4u*)(rowinfo + 4 * (pm * 256 + R)) = ri; }
        tokmap[idx] = tk; }
    asm volatile("s_waitcnt vmcnt(0)" ::: "memory");
    __syncthreads();
}

__device__ __forceinline__ void final_phase(Frame& F) {
    const bf16* YB = (const bf16*)(F.ws + WS_YBUF); const float* gf = F.in[24]; float* O = F.out;
    const int gw = F.vcu * NWAVES + F.wave, NGW = F.G * NWAVES, lane = F.lane;
    f32x4 gg[4];
#pragma unroll
    for (int j = 0; j < 4; ++j) gg[j] = *(const f32x4*)(gf + 4 * lane + 256 * j);
    for (int m = gw; m < M; m += NGW) {
        f32x4 v[4]; float ss = 0.f;
#pragma unroll
        for (int j = 0; j < 4; ++j) { v[j] = *(const f32x4*)(O + (size_t)m * D + 4 * lane + 256 * j);
#pragma unroll
            for (int k = 0; k < (DBG_MODE ? 0 : TOPK); ++k) { const v2u w = *(const v2u*)(YB + ((size_t)m * TOPK + k) * D + 4 * lane + 256 * j); v[j].x += bflo(w.x); v[j].y += bfhi(w.x); v[j].z += bflo(w.y); v[j].w += bfhi(w.y); }
            ss += (v[j].x * v[j].x + v[j].y * v[j].y) + (v[j].z * v[j].z + v[j].w * v[j].w); }
        const float rstd = 1.0f / sqrtf(wave_sum(ss) * (1.f / D) + EPS);
#pragma unroll
        for (int j = 0; j < 4; ++j) *(f32x4*)(O + (size_t)m * D + 4 * lane + 256 * j) = v[j] * rstd * gg[j];
    }
}

struct Args { const float* in[25]; float* out; unsigned char* ws; int ph_lo, ph_hi, li, pad; };
__global__ void __launch_bounds__(NWAVES * 64, 2) hyb_fwd(Args args) {
    extern __shared__ __attribute__((aligned(16))) unsigned char lds[];
    Frame F;
    F.lds = (LAS unsigned char*)lds;
    F.MISC = (volatile LAS unsigned*)(F.lds + MISC_OFF);
    F.tid = threadIdx.x; F.lane = F.tid & 63; F.wave = __builtin_amdgcn_readfirstlane(F.tid >> 6);
    F.G = gridDim.x; { const int bx = blockIdx.x; F.vcu = (F.G % 8 == 0) ? (bx % 8) * (F.G / 8) + bx / 8 : bx; }
    F.ws = args.ws; F.ctl = (gu32*)(args.ws + WS_CTL); F.out = args.out;
#pragma unroll
    for (int i = 0; i < 25; ++i) F.in[i] = args.in[i];
    for (int u = F.tid; u < (LDS_BYTES - LDSCTL_OFF) / 4; u += NWAVES * 64) ((LAS unsigned*)(F.lds + LDSCTL_OFF))[u] = 0u;
    __syncthreads();
    XcdBarrier bar; bar.bar = (unsigned*)(F.ctl + CW_BAR); bar.x = 0; bar.st = nullptr;
    if (N_LAUNCHES != PER_PHASE) bar = xcd_barrier_post((unsigned*)(F.ctl + CW_BAR), F.MISC + 8);
#define GRID_BAR(seam) do { if (N_LAUNCHES == PER_PHASE) { if (F.tid == 0) __hip_atomic_store(F.ctl + CW_TMO, 0xBADBA0u | (unsigned)(seam), RLX_AGENT); } else { xcd_barrier(bar); } } while (0)
    const int lo = args.ph_lo, hi = args.ph_hi;
#define IN(k) (lo <= (k) && (k) < hi)
#define BOTH(k) (IN(k) && IN((k) + 1))
    const pg8::bf16_t* wsb = (const pg8::bf16_t*)args.ws;
#define WSB(off) ((const pg8::bf16_t*)(args.ws + (off)))

    unsigned long long t_lo_ = 0, t_hi_ = 0;
    TMARK(0);
    if (IN(0)) for (int rep_ = 0; rep_ < NREP(0); ++rep_) { p0_prologue(F, t_lo_, t_hi_); if (BOTH(0)) GRID_BAR(0); }

    TMARK(1);
    if (IN(1)) for (int rep_ = 0; rep_ < NREP(1); ++rep_) {
        pg8::Gemm g = pg8::make_gemm(WSB(WS_HN), WSB(WS_WINT), D, D, D); InProjOrder S{F.G, (int)blockIdx.x};
        EpiInProj E{(unsigned short*)(args.ws + WS_Q), (bf16*)(args.ws + WS_UCAT), LOG2E * 0.125f};
        pg8::gemm_phase<EpiInProj, InProjOrder, PG8_ALIGN, PG8_SP2>(F.lds + RING_OFF, g, S, E);
        if (BOTH(1)) GRID_BAR(1);
    }
    TMARK(2);
    if (IN(2)) for (int rep_ = 0; rep_ < NREP(2); ++rep_) {
        pg8::Gemm g = pg8::make_gemm(WSB(WS_UCAT), WSB(WS_WE), NG * UK, 512, 512); SsmOrder S{NG * 2, F.G, (int)blockIdx.x, 1, 128, 512};
        EpiSloc E{(float*)(args.ws + WS_SLOC)};
        pg8::gemm_phase<EpiSloc, SsmOrder, PG8_ALIGN, PG8_SP2>(F.lds + RING_OFF, g, S, E);
        if (blockIdx.x >= NG * 2) attn_one(F, ((int)blockIdx.x - NG * 2) * 8 + F.wave);
        if (BOTH(2)) GRID_BAR(2);
    }
    TMARK(3);
    if (IN(3)) for (int rep_ = 0; rep_ < NREP(3); ++rep_) {
        if (F.vcu < BATCH * NG) { if (F.wave == 0) scan_phase(F); else attn_one(F, 3072 + F.vcu * 7 + F.wave - 1); }
        else attn_one(F, 1536 + (F.vcu - BATCH * NG) * 8 + F.wave);
        if (BOTH(3)) GRID_BAR(3); }
    TMARK(4);
    if (IN(4)) for (int rep_ = 0; rep_ < NREP(4); ++rep_) {
        pg8::Gemm g = pg8::make_gemm(WSB(WS_UCAT), WSB(WS_TW), NG * UK, UK, UK); SsmOrder S{NG * 4, F.G, (int)blockIdx.x, 2, 512, UK};
        EpiS3 E{(bf16*)(args.ws + WS_YG)};
        pg8::gemm_phase<EpiS3, SsmOrder, PG8_ALIGN, PG8_SP2>(F.lds + RING_OFF, g, S, E);
        if (blockIdx.x >= NG * 4 && blockIdx.x < NG * 4 + 72) attn_one(F, 3520 + ((int)blockIdx.x - NG * 4) * 8 + F.wave);
        if (BOTH(4)) GRID_BAR(4);
    }
    TMARK(5);
    if (IN(5)) for (int rep_ = 0; rep_ < NREP(5); ++rep_) {
        pg8::Gemm g = pg8::make_gemm(WSB(WS_YG), WSB(WS_WGLUT), SSW, SSW, SSW); pg8::StaticOrder S; S.init(M, 2 * SSW, F.G, (int)blockIdx.x, SSW, SSW);
        EpiGlu E{(bf16*)(args.ws + WS_YSSM)};
        pg8::gemm_phase<EpiGlu, pg8::StaticOrder, PG8_ALIGN, PG8_SP2>(F.lds + RING_OFF, g, S, E);
        if (BOTH(5)) GRID_BAR(5);
    }
    TMARK(6);
    if (IN(6)) for (int rep_ = 0; rep_ < NREP(6); ++rep_) { mix_phase(F); if (BOTH(6)) GRID_BAR(6); }
    TMARK(7);
    if (IN(7)) for (int rep_ = 0; rep_ < NREP(7); ++rep_) {
        pg8::Gemm g = pg8::make_gemm(WSB(WS_MIXED), WSB(WS_WOUTT), D, D, D); pg8::StaticOrder S; S.init(M, D, F.G, (int)blockIdx.x, D, D);
        EpiOutProj E{F.in[0], F.out};
        pg8::gemm_phase<EpiOutProj, pg8::StaticOrder, PG8_ALIGN, PG8_SP2>(F.lds + RING_OFF, g, S, E);
        if (BOTH(7)) GRID_BAR(7);
    }
    TMARK(8);
    if (IN(8) && !DBG_MODE) for (int rep_ = 0; rep_ < NREP(8); ++rep_) { router_phase(F); if (BOTH(8)) GRID_BAR(8); }
    TMARK(9);
    if (IN(9) && !DBG_MODE) for (int rep_ = 0; rep_ < NREP(9); ++rep_) {   }
    TMARK(10);
    if (IN(10) && !DBG_MODE) for (int rep_ = 0; rep_ < NREP(10); ++rep_) {
        moe_tables(F); moe_units(F, 8, 4); moe_gather_tables(F);
        pg8::Gemm g = pg8::make_gemm(WSB(WS_XN), WSB(WS_W1T), D, D, D); g.brs = 16u; g.bks = 2u * FF * 16u; g.tokmap = (const PG8_LAS int*)(F.lds + TOKMAP_OFF);
        MoeOrder S{(const LAS int*)(F.lds + UNITS_OFF), (long)2 * FF * D * 2, 1};
        EpiMoe1 E{(bf16*)(args.ws + WS_H), F.in[19], F.in[21], (const int*)(args.ws + WS_ROWINFO)};
        pg8::gemm_phase<EpiMoe1, MoeOrder, PG8_ALIGN, PG8_SP2, true>(F.lds + RING_OFF, g, S, E);
        if (BOTH(10)) GRID_BAR(10);
    }
    TMARK(11);
    if (IN(11) && !DBG_MODE) for (int rep_ = 0; rep_ < NREP(11); ++rep_) {
        moe_tables(F); moe_units(F, 4, 4);
        pg8::Gemm g = pg8::make_gemm(WSB(WS_H), WSB(WS_W2T), FF, FF, FF); g.brs = 16u; g.bks = (unsigned)D * 16u; MoeOrder S{(const LAS int*)(F.lds + UNITS_OFF), (long)D * FF * 2, 0};
        EpiMoe2 E{(bf16*)(args.ws + WS_YBUF), F.in[23], (const int*)(args.ws + WS_ROWINFO)};
        pg8::gemm_phase<EpiMoe2, MoeOrder, PG8_ALIGN, PG8_SP2>(F.lds + RING_OFF, g, S, E);
        if (BOTH(11)) GRID_BAR(11);
    }
    TMARK(12);
    if (IN(12)) for (int rep_ = 0; rep_ < NREP(12); ++rep_) { final_phase(F); }
    TMARK(13);
    if ((TIME_LO) >= 0 && blockIdx.x == (TIME_BLK) && F.tid == 0) { const unsigned long long te = __builtin_amdgcn_s_memrealtime(), dt = 4ull * (t_hi_ - t_lo_); while (__builtin_amdgcn_s_memrealtime() - te < dt) __builtin_amdgcn_s_sleep(32); }
    (void)wsb;
#undef IN
#undef BOTH
}

extern "C" void kernel_launch(void* const* d_in, const int* in_sizes, int n_in, void* d_out, int out_size, void* d_ws, size_t ws_size, hipStream_t stream) {
    static int grid = 0;
    if (grid == 0) {
        if (n_in != 25 || in_sizes[0] != M * D || out_size != M * D || ws_size < WS_END) { fprintf(stderr, "kernel_launch: unexpected shapes: n_in %d in0 %d out %d ws %zu (need %zu); nothing launched\n", n_in, n_in > 0 ? in_sizes[0] : -1, out_size, ws_size, (size_t)WS_END); grid = -1; return; }
        int dev = 0, cus = 0, per_cu = 0;
        if (hipGetDevice(&dev) != hipSuccess || hipDeviceGetAttribute(&cus, hipDeviceAttributeMultiprocessorCount, dev) != hipSuccess) { grid = -1; return; }
        if (hipFuncSetAttribute((const void*)hyb_fwd, hipFuncAttributeMaxDynamicSharedMemorySize, LDS_BYTES) != hipSuccess) { fprintf(stderr, "kernel_launch: hipFuncSetAttribute failed\n"); grid = -1; return; }
        if (hipOccupancyMaxActiveBlocksPerMultiprocessor(&per_cu, (const void*)hyb_fwd, NWAVES * 64, LDS_BYTES) != hipSuccess || per_cu < 1)
            fprintf(stderr, "kernel_launch: note: occupancy query reports %d workgroups per CU\n", per_cu);
        (void)hipGetLastError();
        grid = cus;
        if (grid != 256) fprintf(stderr, "kernel_launch: note: %d CUs (built for 256)\n", grid);
    }
    if (grid < 0) return;
    if (hipMemsetAsync((char*)d_ws + WS_CTL, 0, CTL_ZERO_BYTES, stream) != hipSuccess) { fprintf(stderr, "kernel_launch: memset failed\n"); return; }
    Args a{};
    for (int i = 0; i < 25; ++i) a.in[i] = (const float*)d_in[i];
    a.out = (float*)d_out; a.ws = (unsigned char*)d_ws;
    for (int li = 0; li < N_LAUNCHES; ++li) {
        a.ph_lo = (N_LAUNCHES == PER_PHASE) ? li : 0; a.ph_hi = (N_LAUNCHES == PER_PHASE) ? li + 1 : PER_PHASE; a.li = li;
        hipLaunchKernelGGL(hyb_fwd, dim3(grid), dim3(NWAVES * 64), LDS_BYTES, stream, a);
        const hipError_t le = hipPeekAtLastError();
        if (le != hipSuccess) { fprintf(stderr, "kernel_launch: launch %d failed: %s\n", li, hipGetErrorName(le)); break; }
    }
}
```

```cpp
#include <hip/hip_runtime.h>
#include <cstdio>
#include <cstdint>
namespace pg8 {
#define PG8_LAS __attribute__((address_space(3)))
typedef unsigned short bf16_t;
typedef short bf16x8 __attribute__((ext_vector_type(8)));
typedef float f32x4 __attribute__((ext_vector_type(4)));
typedef unsigned u32x4 __attribute__((ext_vector_type(4)));
constexpr int BM = 256, BK = 64, HALF = 128, HTB = HALF * BK * 2  , STAGE_BYTES = 8 * HTB, NXCD = 8, WGM = 8;

__host__ __device__ __forceinline__ int lds_byte(int r, int c) { const int st = (r >> 4) * 2 + (c >> 5), rr = r & 15, cc = c & 31, ob = rr * 64 + cc * 2; return st * 1024 + (ob ^ (((ob >> 9) & 1) << 5)); }
__host__ __device__ __forceinline__ void stage_rc(int b, int& R, int& C) { const int st = b / 1024, sb = b % 1024, swz = sb ^ (((sb >> 9) & 1) << 5); R = (st >> 1) * 16 + swz / 64; C = (st & 1) * 32 + (swz % 64) / 2; }
__host__ __device__ __forceinline__ int perm32(int rho) { const int n = rho >> 4, i = rho & 15; return 8 * (i >> 2) + 4 * n + (i & 3); }

struct Unit { int pm, pn, e, slot; long offA, offB; };
struct Gemm { const bf16_t* A; const bf16_t* Bt; int lda, K; unsigned brs, bks; const PG8_LAS int* tokmap; };
__host__ __device__ __forceinline__ Gemm make_gemm(const bf16_t* A, const bf16_t* Bt, int lda, int ldb, int K) { Gemm g; g.A = A; g.Bt = Bt; g.lda = lda; g.K = K; g.brs = (unsigned)ldb * 2u; g.bks = 16u; g.tokmap = nullptr; return g; }

__host__ __device__ __forceinline__ int xcd_remap(int wgid, int nwg) { const int q = nwg / NXCD, r = nwg % NXCD, xcd = wgid % NXCD, off = wgid / NXCD; return (xcd < r ? xcd * (q + 1) : r * (q + 1) + (xcd - r) * q) + off; }

struct StaticOrder {
    int nM, nN, nwg, G, c, lda, ldb;
    __host__ __device__ void init(int M, int N, int G_, int c_, int lda_, int ldb_) { nM = M / BM; nN = N / BM; nwg = nM * nN; G = G_; c = c_; lda = lda_; ldb = ldb_; }
    __host__ __device__ bool next(int i, Unit& u) const {
        const long L = (long)i * G + c; if (L >= nwg) return false;
        const int wgid = xcd_remap((int)L, nwg);
        const int nig = WGM * nN, gid = wgid / nig, fm = gid * WGM, gsz = (nM - fm) < WGM ? (nM - fm) : WGM;
        u.pm = fm + ((wgid % nig) % gsz); u.pn = (wgid % nig) / gsz; u.e = 0; u.slot = 0;
        u.offA = (long)u.pm * BM * lda * 2; u.offB = (long)u.pn * BM * ldb * 2; return true;
    }
    __device__ __forceinline__ void a_ready(const Unit&) const {}
    __device__ __forceinline__ void done(const Unit&) const {}
};

__device__ __forceinline__ unsigned cvt_pk_bf16(float lo, float hi) { unsigned r; asm volatile("v_cvt_pk_bf16_f32 %0, %1, %2" : "=v"(r) : "v"(lo), "v"(hi)); return r; }
typedef float f32x2 __attribute__((ext_vector_type(2)));

template <class Epi, class Sched, bool ALIGN_EPI = false, bool SP2 = false, bool GATHER = false>
__device__ __forceinline__ void gemm_phase(PG8_LAS unsigned char* lds, const Gemm g, const Sched& S, const Epi& E) {
    static_assert(!GATHER || SP2, "the gather form is written for the two-super-phase loop only");
    const int tid = threadIdx.x, wid = __builtin_amdgcn_readfirstlane(tid >> 6), lane = tid & 63, wr = wid >> 2, wc = wid & 3, fr = lane & 15, fq = lane >> 4;
    const int K = g.K, nt = K / BK;
    unsigned voffA[2], voffB[2]; int RA[2];
#pragma unroll
    for (int i = 0; i < 2; ++i) { int R, C; stage_rc(tid * 16 + i * 8192, R, C); const int Rb = Epi::PERM ? ((R & ~31) + perm32(R & 31)) : R; RA[i] = R;
        voffA[i] = GATHER ? (unsigned)C * 2u : (unsigned)(R * g.lda + C) * 2u; voffB[i] = (unsigned)Rb * g.brs + (unsigned)(C >> 3) * g.bks; }
    const size_t kstepA = (size_t)(BK * 2), kstepB = (size_t)8 * g.bks;
    const size_t hstepA = (size_t)HALF * g.lda * 2, hstepB = (size_t)HALF * g.brs;
    const unsigned ldsw = (unsigned)wid * 1024u;
    const int aoff = lds_byte(wr * 64 + fr, fq * 8), boff = lds_byte(wc * 32 + fr, fq * 8);
#define PG8_SA(b, h) (((b) * 2 + (h)) * HTB)
#define PG8_SB(b, h) ((4 + (b) * 2 + (h)) * HTB)
#define PG8_STAGE(bufoff, gbase, voff) do { _Pragma("unroll") for (int _i = 0; _i < 2; ++_i) \
        __builtin_amdgcn_global_load_lds((const unsigned*)((const char*)(gbase) + (voff)[_i]), (PG8_LAS unsigned*)(lds + (bufoff) + ldsw + _i * 8192), 16, 0, 0); } while (0)
    unsigned ga[2][2], gn[2][2], gw[2][2];
#define PG8_GLOAD(dst, u) do { if constexpr (GATHER) { const PG8_LAS int* _tm = g.tokmap + 256 * (u).slot; _Pragma("unroll") for (int _h = 0; _h < 2; ++_h) _Pragma("unroll") for (int _i = 0; _i < 2; ++_i) \
        dst[_h][_i] = (unsigned)_tm[128 * _h + RA[_i]] * (unsigned)(g.lda * 2) + voffA[_i]; } } while (0)
#define PG8_STAGE_A(bufoff, gbase, half, GX) do { if constexpr (GATHER) { PG8_STAGE(bufoff, gbase, GX[half]); } else { PG8_STAGE(bufoff, (gbase) + (half) * hstepA, voffA); } } while (0)
#define PG8_LDA(dst, b, h) do { _Pragma("unroll") for (int m = 0; m < 4; ++m) _Pragma("unroll") for (int k = 0; k < 2; ++k) dst[m][k] = *(const PG8_LAS bf16x8*)(lds + PG8_SA(b, h) + aoff + m * 2048 + k * 1024); } while (0)
#define PG8_LDB(dst, b, h) do { _Pragma("unroll") for (int n = 0; n < 2; ++n) _Pragma("unroll") for (int k = 0; k < 2; ++k) dst[n][k] = *(const PG8_LAS bf16x8*)(lds + PG8_SB(b, h) + boff + n * 2048 + k * 1024); } while (0)
#define PG8_MMA(ai, bj, At, Bt) do { __builtin_amdgcn_s_setprio(1); _Pragma("unroll") for (int m = 0; m < 4; ++m) _Pragma("unroll") for (int n = 0; n < 2; ++n) _Pragma("unroll") for (int k = 0; k < 2; ++k) \
        acc[ai][bj][m][n] = __builtin_amdgcn_mfma_f32_16x16x32_bf16(Bt[n][k], At[m][k], acc[ai][bj][m][n], 0, 0, 0); __builtin_amdgcn_s_setprio(0); } while (0)
#define PG8_WAIT_V(n) asm volatile("s_waitcnt vmcnt(" #n ")" ::: "memory")
#define PG8_WAIT_L(n) asm volatile("s_waitcnt lgkmcnt(" #n ")" ::: "memory")
#define PG8_BAR __builtin_amdgcn_s_barrier()
#define PG8_SCHED __builtin_amdgcn_sched_barrier(0)
    Unit cur, nxt; int ui = 0;
    if (!S.next(0, cur)) return;
    f32x4 acc[2][2][4][2];
#pragma unroll
    for (int a = 0; a < 2; ++a)
#pragma unroll
        for (int b = 0; b < 2; ++b)
#pragma unroll
            for (int m = 0; m < 4; ++m)
#pragma unroll
                for (int n = 0; n < 2; ++n) acc[a][b][m][n] = (f32x4){0.f, 0.f, 0.f, 0.f};
    bf16x8 At[4][2], B0[2][2], B1[2][2];
    const char* cA = (const char*)g.A + cur.offA; const char* cB = (const char*)g.Bt + cur.offB;
    S.a_ready(cur);
    if constexpr (SP2) {
        PG8_GLOAD(ga, cur);
        PG8_STAGE(PG8_SB(0, 0), cB, voffB); PG8_STAGE(PG8_SB(0, 1), cB + hstepB, voffB); PG8_STAGE_A(PG8_SA(0, 0), cA, 0, ga); PG8_STAGE_A(PG8_SA(0, 1), cA, 1, ga);
        if (wr == 1) PG8_BAR;
        PG8_WAIT_V(2); PG8_BAR;
        PG8_STAGE(PG8_SB(1, 0), cB + kstepB, voffB); PG8_STAGE_A(PG8_SA(1, 0), cA + kstepA, 0, ga); PG8_STAGE(PG8_SB(1, 1), cB + hstepB + kstepB, voffB);
        PG8_WAIT_V(6); PG8_BAR;
    } else {
        PG8_STAGE(PG8_SB(0, 0), cB, voffB); PG8_STAGE(PG8_SA(0, 0), cA, voffA); PG8_STAGE(PG8_SB(0, 1), cB + hstepB, voffB); PG8_STAGE(PG8_SA(0, 1), cA + hstepA, voffA);
        if (wr == 1) PG8_BAR;
        PG8_WAIT_V(4); PG8_BAR;
        PG8_STAGE(PG8_SB(1, 0), cB + kstepB, voffB); PG8_STAGE(PG8_SA(1, 0), cA + kstepA, voffA); PG8_STAGE(PG8_SB(1, 1), cB + hstepB + kstepB, voffB);
        PG8_WAIT_V(6); PG8_BAR;
    }
    for (;;) {
        const bool has_next = S.next(ui + 1, nxt);
        if constexpr (GATHER) { if (has_next) { PG8_GLOAD(gn, nxt); } else { _Pragma("unroll") for (int _h = 0; _h < 2; ++_h) _Pragma("unroll") for (int _i = 0; _i < 2; ++_i) gn[_h][_i] = ga[_h][_i]; } }
        const char* nA = has_next ? (const char*)g.A + nxt.offA : cA; const char* nB = has_next ? (const char*)g.Bt + nxt.offB : cB;
        for (int t = 0; t < nt; t += 2) {
            const bool last = (t == nt - 2);
            const char* a1 = cA + (size_t)(t + 1) * kstepA;
            const char* a2 = last ? nA : cA + (size_t)(t + 2) * kstepA; const char* b2 = last ? nB : cB + (size_t)(t + 2) * kstepB;
            const char* a3 = a2 + kstepA; const char* b3 = b2 + kstepB;
            if (last && has_next) S.a_ready(nxt);
            if constexpr (GATHER) { _Pragma("unroll") for (int _h = 0; _h < 2; ++_h) _Pragma("unroll") for (int _i = 0; _i < 2; ++_i) gw[_h][_i] = last ? gn[_h][_i] : ga[_h][_i]; }
            if constexpr (SP2) {
            PG8_LDB(B0, 0, 0); PG8_LDB(B1, 0, 1); PG8_SCHED; PG8_LDA(At, 0, 0); PG8_STAGE_A(PG8_SA(1, 1), a1, 1, ga);
            PG8_WAIT_V(8); PG8_WAIT_L(0); PG8_BAR; PG8_MMA(0, 0, At, B0); PG8_MMA(0, 1, At, B1); PG8_BAR; PG8_SCHED;
            PG8_LDA(At, 0, 1); PG8_STAGE(PG8_SB(0, 0), b2, voffB); PG8_STAGE(PG8_SB(0, 1), b2 + hstepB, voffB); PG8_STAGE_A(PG8_SA(0, 0), a2, 0, gw);
            PG8_WAIT_V(8); PG8_WAIT_L(0); PG8_BAR; PG8_MMA(1, 0, At, B0); PG8_MMA(1, 1, At, B1); PG8_BAR; PG8_SCHED;
            PG8_LDB(B0, 1, 0); PG8_LDB(B1, 1, 1); PG8_SCHED; PG8_LDA(At, 1, 0); PG8_STAGE_A(PG8_SA(0, 1), a2, 1, gw);
            PG8_WAIT_V(8); PG8_WAIT_L(0); PG8_BAR; PG8_MMA(0, 0, At, B0); PG8_MMA(0, 1, At, B1); PG8_BAR; PG8_SCHED;
            PG8_LDA(At, 1, 1); PG8_STAGE(PG8_SB(1, 0), b3, voffB); PG8_STAGE(PG8_SB(1, 1), b3 + hstepB, voffB); PG8_STAGE_A(PG8_SA(1, 0), a3, 0, gw);
            PG8_WAIT_V(8); PG8_WAIT_L(0); PG8_BAR; PG8_MMA(1, 0, At, B0); PG8_MMA(1, 1, At, B1); PG8_BAR; PG8_SCHED;
            } else {
            PG8_LDB(B0, 0, 0); PG8_SCHED; PG8_LDA(At, 0, 0); PG8_STAGE(PG8_SA(1, 1), a1 + hstepA, voffA);
            PG8_WAIT_L(8); PG8_BAR; PG8_WAIT_L(0); PG8_MMA(0, 0, At, B0); PG8_BAR; PG8_SCHED;
            PG8_LDB(B1, 0, 1); PG8_STAGE(PG8_SB(0, 0), b2, voffB);
            PG8_BAR; PG8_WAIT_L(0); PG8_MMA(0, 1, At, B1); PG8_BAR;
            PG8_LDA(At, 0, 1); PG8_STAGE(PG8_SA(0, 0), a2, voffA);
            PG8_BAR; PG8_WAIT_L(0); PG8_MMA(1, 0, At, B0); PG8_BAR; PG8_SCHED;
            PG8_STAGE(PG8_SB(0, 1), b2 + hstepB, voffB);
            PG8_WAIT_V(6); PG8_BAR; PG8_MMA(1, 1, At, B1); PG8_BAR;
            PG8_LDB(B0, 1, 0); PG8_SCHED; PG8_LDA(At, 1, 0); PG8_STAGE(PG8_SA(0, 1), a2 + hstepA, voffA);
            PG8_WAIT_L(8); PG8_BAR; PG8_WAIT_L(0); PG8_MMA(0, 0, At, B0); PG8_BAR; PG8_SCHED;
            PG8_LDB(B1, 1, 1); PG8_STAGE(PG8_SB(1, 0), b3, voffB);
            PG8_BAR; PG8_WAIT_L(0); PG8_MMA(0, 1, At, B1); PG8_BAR;
            PG8_LDA(At, 1, 1); PG8_STAGE(PG8_SA(1, 0), a3, voffA);
            PG8_BAR; PG8_WAIT_L(0); PG8_MMA(1, 0, At, B0); PG8_BAR; PG8_SCHED;
            PG8_STAGE(PG8_SB(1, 1), b3 + hstepB, voffB);
            PG8_WAIT_V(6); PG8_BAR; PG8_MMA(1, 1, At, B1); PG8_BAR;
            }
        }
        if constexpr (ALIGN_EPI) { if (wr == 0) PG8_BAR; }
        if constexpr (!Epi::AFTER_DRAIN) { E(acc, cur, wr, wc, fr, fq); S.done(cur); }
        if (!has_next) break;
#pragma unroll
        for (int a = 0; a < 2; ++a)
#pragma unroll
            for (int b = 0; b < 2; ++b)
#pragma unroll
                for (int m = 0; m < 4; ++m)
#pragma unroll
                    for (int n = 0; n < 2; ++n) acc[a][b][m][n] = (f32x4){0.f, 0.f, 0.f, 0.f};
        cur = nxt; cA = nA; cB = nB; ++ui;
        if constexpr (GATHER) { _Pragma("unroll") for (int _h = 0; _h < 2; ++_h) _Pragma("unroll") for (int _i = 0; _i < 2; ++_i) ga[_h][_i] = gn[_h][_i]; }
        if constexpr (ALIGN_EPI) { if (wr == 1) PG8_BAR; }
    }
    PG8_WAIT_V(0);
    if constexpr (!ALIGN_EPI) { if (wr == 0) PG8_BAR; }
    PG8_BAR;
    if constexpr (Epi::AFTER_DRAIN) { E.fused(acc, cur, wr, wc, fr, fq, lds, wid, lane); S.done(cur); }
#undef PG8_SA
#undef PG8_SB
#undef PG8_STAGE
#undef PG8_STAGE_A
#undef PG8_GLOAD
#undef PG8_LDA
#undef PG8_LDB
#undef PG8_MMA
#undef PG8_WAIT_V
#undef PG8_WAIT_L
#undef PG8_BAR
#undef PG8_SCHED
}
}

#ifndef PG8_SP2
#define PG8_SP2 true
#endif
#ifndef PG8_ALIGN
#define PG8_ALIGN true
#endif

constexpr int NWAVES = 8;
#ifndef MK_N_LAUNCHES
#define MK_N_LAUNCHES 1
#endif
#ifndef DBG_MODE
#define DBG_MODE 0
#endif
#ifndef REP_PHASE
#define REP_PHASE -1
#endif
#define NREP(k) ((REP_PHASE) == (k) ? 2 : 1)
#ifndef TIME_LO
#define TIME_LO -1
#endif
#ifndef TIME_HI
#define TIME_HI -1
#endif
#ifndef TIME_BLK
#define TIME_BLK 0
#endif
#define TMARK(j) do { if ((TIME_LO) >= 0 && blockIdx.x == (TIME_BLK) && F.tid == 0) { if ((j) == (TIME_LO)) t_lo_ = __builtin_amdgcn_s_memrealtime(); if ((j) == (TIME_HI)) t_hi_ = __builtin_amdgcn_s_memrealtime(); } } while (0)
constexpr int PER_PHASE = 13;
constexpr int N_LAUNCHES = MK_N_LAUNCHES;

constexpr int BATCH = 2, SEQ = 8192, D = 1024, M = BATCH * SEQ;
constexpr int SBW = 512, NH = 8, HD = 64;
constexpr int SSW = 512, NG = 32, GC = 16, NP = 64;
constexpr int NPROJ = 3 * SBW + SSW;
constexpr int LC = 32, NCHUNK = M / LC, CPB = SEQ / LC;
constexpr int UK = LC * GC + 2 * NP;
constexpr int NE = 32, TOPK = 4, FF = 1024, NASSIGN = M * TOPK;
constexpr int MAXTILES = (NASSIGN + NE * 255) / 256 + 1;
constexpr float EPS = 1e-5f;
constexpr float LOG2E = 1.4426950408889634f;

constexpr size_t MiB = 1u << 20;
constexpr size_t WS_CTL = 0, CTL_ZERO_BYTES = 1 * MiB;
constexpr size_t WS_LAML = 1 * MiB;
constexpr size_t WS_RSTD = 1 * MiB + 32 * 1024;
constexpr size_t WS_GATES = 1 * MiB + 128 * 1024;
constexpr size_t WS_ROWINFO = 1 * MiB + 512 * 1024;
constexpr size_t WS_RWIMG = 3 * MiB;
constexpr size_t WS_LISTS = 507 * MiB;
constexpr size_t WS_X1LO = 331 * MiB, WS_X1HI = 491 * MiB;
constexpr size_t WS_WINT = 4 * MiB, WS_WGLUT = 8 * MiB, WS_WOUTT = 9 * MiB, WS_W1T = 11 * MiB, WS_W2T = 139 * MiB;
constexpr size_t WS_R1 = 203 * MiB, WS_R2 = 347 * MiB, WS_END = 509 * MiB;
constexpr size_t WS_HN = WS_R1, WS_Q = WS_R1 + 32 * MiB, WS_K = WS_R1 + 48 * MiB, WS_V = WS_R1 + 64 * MiB, WS_UCAT = WS_R1 + 80 * MiB,
                 WS_SLOC = WS_R1 + 100 * MiB, WS_YSB = WS_R1 + 108 * MiB, WS_YG = WS_R1 + 124 * MiB;
constexpr size_t WS_YBUF = WS_R1;
constexpr size_t WS_YSSM = WS_R2, WS_MIXED = WS_R2 + 16 * MiB, WS_XN = WS_R1  , WS_WE = WS_R2 + 80 * MiB, WS_TW = WS_R2 + 85 * MiB;
constexpr size_t WS_H = WS_R2;
static_assert(WS_K == WS_Q + (size_t)M * SBW * 2 && WS_V == WS_K + (size_t)M * SBW * 2 && WS_YG + (size_t)M * SSW * 2 <= WS_R2 && WS_TW + (size_t)NG * 512 * UK * 2 <= WS_END, "ws map");
static_assert(WS_YBUF + (size_t)NASSIGN * D * 2 <= WS_X1LO && WS_H + (size_t)(MAXTILES - 1) * 256 * FF * 2 <= WS_END, "ws map 2");
static_assert(WS_ROWINFO + (size_t)MAXTILES * 256 * 16 <= 3 * MiB && WS_X1LO >= WS_YBUF + (size_t)NASSIGN * D * 2 && WS_X1LO + 16 * MiB <= WS_R2 && WS_X1HI >= WS_H + (size_t)(MAXTILES - 1) * 256 * FF * 2 && WS_X1HI + 16 * MiB <= WS_LISTS && WS_LISTS + (size_t)NE * M * 4 <= WS_END, "ws map 3");
constexpr int CW_TMO = 0, CW_CODE = 1;
constexpr int CW_BAR = 4096, CW_BAR2 = 8192;
constexpr int CW_CNT = 16384;
constexpr int CW_Q0 = 16384 + 256, CW_Q1 = 16384 + 512;
constexpr int CW_AQ = 16384 + 320, CW_DONE2 = 16384 + 384, CW_DONE3 = 16384 + 448;

constexpr int RING_OFF = 0, RING_BYTES = 131072;
constexpr int RT_WSTR = 1028;
constexpr int RT_W_BYTES = 2 * NE * RT_WSTR * 2;
constexpr int RT_SCR_OFF = RT_W_BYTES;
constexpr int LDSCTL_OFF = 139264, MISC_OFF = LDSCTL_OFF + 320;
constexpr int TAB_OFF = LDSCTL_OFF + 512;
constexpr int UNITS_OFF = LDSCTL_OFF + 1024;
constexpr int TILEE_OFF = LDSCTL_OFF + 1536;
constexpr int TOKMAP_OFF = LDSCTL_OFF + 4096, TOKMAP_SLOTS = 10;
constexpr int LDS_BYTES = TOKMAP_OFF + TOKMAP_SLOTS * 1024;
static_assert(TILEE_OFF + MAXTILES * 4 <= LDS_BYTES && RT_SCR_OFF + 4096 <= LDSCTL_OFF, "LDS map");

#define GAS __attribute__((address_space(1)))
#define LAS __attribute__((address_space(3)))
typedef unsigned short bf16;
typedef unsigned v4u __attribute__((ext_vector_type(4)));
typedef unsigned v2u __attribute__((ext_vector_type(2)));
typedef float f32x4 __attribute__((ext_vector_type(4)));
typedef float f32x2 __attribute__((ext_vector_type(2)));
typedef _Float16 h16x2 __attribute__((ext_vector_type(2)));
typedef GAS unsigned gu32;
#define RLX_AGENT __ATOMIC_RELAXED, __HIP_MEMORY_SCOPE_AGENT
#define LDS_WAIT() asm volatile("s_waitcnt lgkmcnt(0)" ::: "memory")
#define VM_WAIT() asm volatile("s_waitcnt vmcnt(0)" ::: "memory")
__device__ __forceinline__ unsigned f2bf(float f) { unsigned u = __builtin_bit_cast(unsigned, f); return (u + 0x7fffu + ((u >> 16) & 1u)) >> 16; }
__device__ __forceinline__ unsigned pk2(float lo, float hi) { return f2bf(lo) | (f2bf(hi) << 16); }
__device__ __forceinline__ float bf2f(unsigned short b) { return __builtin_bit_cast(float, (unsigned)b << 16); }
__device__ __forceinline__ float bflo(unsigned w) { return __builtin_bit_cast(float, w << 16); }
__device__ __forceinline__ float bfhi(unsigned w) { return __builtin_bit_cast(float, w & 0xffff0000u); }
__device__ __forceinline__ unsigned pkh2(float lo, float hi) { h16x2 v; v.x = (_Float16)lo; v.y = (_Float16)hi; return __builtin_bit_cast(unsigned, v); }
__device__ __forceinline__ float fexp2(float x) { return __builtin_amdgcn_exp2f(x); }
__device__ __forceinline__ float flog2(float x) { return __builtin_amdgcn_logf(x); }
__device__ __forceinline__ float frcp(float x) { return __builtin_amdgcn_rcpf(x); }
__device__ __forceinline__ float sigmoidf_(float x) { return frcp(1.0f + fexp2(-LOG2E * x)); }
__device__ __forceinline__ float gelu_tanh(float v) { const float u = 0.7978845608028654f * (v + 0.044715f * v * v * v); return v * frcp(1.0f + fexp2(-2.0f * LOG2E * u)); }

__device__ __forceinline__ bf16* x1_row(unsigned char* ws, int m) { return (bf16*)(ws + (m < SEQ ? WS_X1LO : WS_X1HI - (size_t)SEQ * D * 2)) + (size_t)m * D; }
#define XB_TMO      128
#define XB_XCNT(j)  (256  + 64 * (j))
#define XB_XSUB(j)  (1280 + 64 * (j))
#define XB_XGEN(j)  (2304 + 64 * (j))
#define XB_TOP      3328
#define XB_TOPGEN   3392
#define XCD_BAR_WORDS 3456
#define XB_SPIN_CAP (1u << 18)
__device__ __forceinline__ unsigned xb_ld(unsigned* p)              { return __hip_atomic_load(p, __ATOMIC_RELAXED, __HIP_MEMORY_SCOPE_AGENT); }
__device__ __forceinline__ unsigned xb_add(unsigned* p, unsigned v) { return __hip_atomic_fetch_add(p, v, __ATOMIC_RELAXED, __HIP_MEMORY_SCOPE_AGENT); }
__device__ __forceinline__ unsigned xb_xcc_id() { return (unsigned)__builtin_amdgcn_s_getreg((3 << 11) | 20) & 0xFu; }
#define XB_SPIN(cond, bar) do { unsigned _sp = 0; while (cond) { __builtin_amdgcn_s_sleep(1); \
    if ((++_sp & 255u) == 0u) { if (xb_ld(&(bar)[XB_TMO])) break; if (_sp > XB_SPIN_CAP) { atomicAdd(&(bar)[XB_TMO], 1u); break; } } } } while (0)
struct XcdBarrier { unsigned* bar; unsigned x; volatile LAS unsigned* st; unsigned G; };
__device__ __forceinline__ XcdBarrier xcd_barrier_post(unsigned* bar, volatile LAS unsigned* st, unsigned G) {
    XcdBarrier b; b.bar = bar; b.x = xb_xcc_id(); b.st = st; b.G = G;
    if (threadIdx.x == 0) (void)xb_add(&bar[XB_XCNT(b.x)], 1u);
    return b;
}
__device__ __forceinline__ void xcd_barrier_complete(unsigned* bar, unsigned x, unsigned G, unsigned& nloc, unsigned& nx) {
    unsigned sum, cnt, mine, sp = 0u;
    for (;;) {
        sum = 0u; cnt = 0u; mine = 0u;
#pragma unroll
        for (unsigned j = 0; j < 16; ++j) { const unsigned c = xb_ld(&bar[XB_XCNT(j)]); sum += c; cnt += (c > 0u) ? 1u : 0u; mine = (j == x) ? c : mine; }
        if (sum == G) break;
        __builtin_amdgcn_s_sleep(1);
        if ((++sp & 255u) == 0u) { if (xb_ld(&bar[XB_TMO])) break; if (sp > XB_SPIN_CAP) { atomicAdd(&bar[XB_TMO], 1u); break; } }
    }
    nloc = mine > 0u ? mine : 1u; nx = cnt > 0u ? cnt : 1u;
}
__device__ __forceinline__ void xcd_barrier(const XcdBarrier& b) {
    asm volatile("s_waitcnt vmcnt(0)" ::: "memory");
    __syncthreads();
    if (threadIdx.x == 0) {
        unsigned* bar = b.bar;
        __builtin_amdgcn_s_waitcnt(0);
        unsigned nloc = b.st[0], nx = b.st[1];
        if (nloc == 0u) { xcd_barrier_complete(bar, b.x, b.G, nloc, nx); b.st[0] = nloc; b.st[1] = nx; }
        const unsigned old = xb_add(&bar[XB_XSUB(b.x)], 1u);
        const unsigned gen = old / nloc;
        if (old + 1u == (gen + 1u) * nloc) {
            __builtin_amdgcn_fence(__ATOMIC_RELEASE, "agent");
            asm volatile("s_waitcnt vmcnt(0)" ::: "memory");
            const unsigned og = xb_add(&bar[XB_TOP], 1u);
            const unsigned tg = og / nx;
            if (og + 1u == (tg + 1u) * nx) xb_add(&bar[XB_TOPGEN], 1u);
            else XB_SPIN(xb_ld(&bar[XB_TOPGEN]) == tg, bar);
            __builtin_amdgcn_fence(__ATOMIC_ACQUIRE, "agent");
            xb_add(&bar[XB_XGEN(b.x)], 1u);
            asm volatile("s_waitcnt vmcnt(0)" ::: "memory");
        } else {
            XB_SPIN(xb_ld(&bar[XB_XGEN(b.x)]) == gen, bar);
            __builtin_amdgcn_fence(__ATOMIC_ACQUIRE, "agent");
            asm volatile("s_waitcnt vmcnt(0)" ::: "memory");
        }
    }
    __syncthreads();
}

struct Frame {
    LAS unsigned char* lds;
    volatile LAS unsigned* MISC;
    gu32* ctl;
    int tid, lane, wave;
    int vcu, G;
    unsigned char* ws;
    const float* in[25];
    float* out;
};

__device__ __forceinline__ float wave_sum(float v) {
#pragma unroll
    for (int o = 1; o < 64; o <<= 1) v += __shfl_xor(v, o);
    return v;
}

using pg8::Unit;
typedef pg8::f32x4 accv;
struct EpiInProj {
    static constexpr bool PERM = true, AFTER_DRAIN = false;
    unsigned short* QKV; bf16* U; float qscale;
    __device__ __forceinline__ void operator()(const accv (&acc)[2][2][4][2], const Unit& u, int wr, int wc, int fr, int fq) const {
        if (u.e == 1) {
            const int row0 = u.pm * 256 + wr * 64 + fr; const int colt = u.pn * 256 + wc * 32 + 8 * fq;
            _Float16* VT = (_Float16*)(QKV + (size_t)2 * M * SBW);
#pragma unroll
            for (int ai = 0; ai < 2; ++ai)
#pragma unroll
                for (int m = 0; m < 4; ++m) { const int row = row0 + ai * 128 + m * 16;
#pragma unroll
                    for (int bj = 0; bj < 2; ++bj) { const int tok = colt + bj * 128; const accv v0 = acc[ai][bj][m][0], v1 = acc[ai][bj][m][1];
                        const int bb = tok >> 13, sq = tok & (SEQ - 1); const int o = sq & 15;
                        _Float16* p = VT + ((size_t)bb * SBW + row) * SEQ + (sq & ~15) + (o >> 1);
                        v2u w0, w1; w0.x = pkh2(v0[0], v0[1]); w0.y = pkh2(v0[2], v0[3]); w1.x = pkh2(v1[0], v1[1]); w1.y = pkh2(v1[2], v1[3]);
                        *(v2u*)p = w0; *(v2u*)(p + 8) = w1; } }
            return;
        }
        const int kind = u.pn >> 1; const int colt = (u.pn & 1) * 256 + wc * 32 + 8 * fq; const int row0 = u.pm * 256 + wr * 64 + fr;
        unsigned short* T = QKV + (size_t)(kind < 2 ? kind : 0) * ((size_t)M * SBW); const float sc = kind == 0 ? qscale : 1.0f;
#pragma unroll
        for (int ai = 0; ai < 2; ++ai)
#pragma unroll
            for (int m = 0; m < 4; ++m) { const int row = row0 + ai * 128 + m * 16;
#pragma unroll
                for (int bj = 0; bj < 2; ++bj) { const int col = colt + bj * 128; const accv v0 = acc[ai][bj][m][0] * sc, v1 = acc[ai][bj][m][1] * sc; v4u w;
                    if (kind < 2) { w.x = pkh2(v0[0], v0[1]); w.y = pkh2(v0[2], v0[3]); w.z = pkh2(v1[0], v1[1]); w.w = pkh2(v1[2], v1[3]);
                        *(v4u*)(T + (size_t)row * SBW + col) = w; }
                    else { w.x = pg8::cvt_pk_bf16(v0[0], v0[1]); w.y = pg8::cvt_pk_bf16(v0[2], v0[3]); w.z = pg8::cvt_pk_bf16(v1[0], v1[1]); w.w = pg8::cvt_pk_bf16(v1[2], v1[3]);
                        *(v4u*)(U + ((size_t)(row >> 5) * NG + (col >> 4)) * UK + (row & 31) * GC + (col & 15)) = w; } } }
    }
};
struct EpiSloc {
    static constexpr bool PERM = false, AFTER_DRAIN = false;
    float* S;
    __device__ __forceinline__ void operator()(const accv (&acc)[2][2][4][2], const Unit& u, int wr, int wc, int fr, int fq) const {
        const int row0 = u.pm * 256 + wr * 64 + fr; const int col0 = wc * 32 + 4 * fq;
#pragma unroll
        for (int ai = 0; ai < 2; ++ai)
#pragma unroll
            for (int m = 0; m < 4; ++m) { const int row = row0 + ai * 128 + m * 16;
#pragma unroll
                for (int n = 0; n < 2; ++n) *(accv*)(S + ((size_t)row * NG + u.e) * 128 + col0 + 16 * n) = acc[ai][0][m][n]; }
    }
};
struct EpiS3 {
    static constexpr bool PERM = true, AFTER_DRAIN = false;
    bf16* YG;
    __device__ __forceinline__ void operator()(const accv (&acc)[2][2][4][2], const Unit& u, int wr, int wc, int fr, int fq) const {
        const int row0 = u.pm * 256 + wr * 64 + fr; const int colt = u.pn * 256 + wc * 32 + 8 * fq;
#pragma unroll
        for (int ai = 0; ai < 2; ++ai)
#pragma unroll
            for (int m = 0; m < 4; ++m) { const int row = row0 + ai * 128 + m * 16;
#pragma unroll
                for (int bj = 0; bj < 2; ++bj) { const int col = colt + bj * 128; const accv v0 = acc[ai][bj][m][0], v1 = acc[ai][bj][m][1]; v4u w;
                    w.x = pg8::cvt_pk_bf16(gelu_tanh(v0[0]), gelu_tanh(v0[1])); w.y = pg8::cvt_pk_bf16(gelu_tanh(v0[2]), gelu_tanh(v0[3]));
                    w.z = pg8::cvt_pk_bf16(gelu_tanh(v1[0]), gelu_tanh(v1[1])); w.w = pg8::cvt_pk_bf16(gelu_tanh(v1[2]), gelu_tanh(v1[3]));
                    *(v4u*)(YG + ((size_t)row * LC + (col >> 4)) * SSW + u.e * GC + (col & 15)) = w; } }
    }
};
struct EpiGlu {
    static constexpr bool PERM = true, AFTER_DRAIN = false;
    bf16* Y;
    __device__ __forceinline__ void operator()(const accv (&acc)[2][2][4][2], const Unit& u, int wr, int wc, int fr, int fq) const {
        const int row0 = u.pm * 256 + wr * 64 + fr; const int col = u.pn * 128 + wc * 32 + 8 * fq;
#pragma unroll
        for (int ai = 0; ai < 2; ++ai)
#pragma unroll
            for (int m = 0; m < 4; ++m) { const int row = row0 + ai * 128 + m * 16; float r[8];
#pragma unroll
                for (int n = 0; n < 2; ++n)
#pragma unroll
                    for (int j = 0; j < 4; ++j) r[4 * n + j] = acc[ai][0][m][n][j] * sigmoidf_(acc[ai][1][m][n][j]);
                v4u w; w.x = pg8::cvt_pk_bf16(r[0], r[1]); w.y = pg8::cvt_pk_bf16(r[2], r[3]); w.z = pg8::cvt_pk_bf16(r[4], r[5]); w.w = pg8::cvt_pk_bf16(r[6], r[7]);
                *(v4u*)(Y + (size_t)row * SSW + col) = w; }
    }
};
struct EpiOutProj {
    static constexpr bool PERM = true, AFTER_DRAIN = false;
    const float* X; unsigned char* ws;
    __device__ __forceinline__ void operator()(const accv (&acc)[2][2][4][2], const Unit& u, int wr, int wc, int fr, int fq) const {
        const int row0 = u.pm * 256 + wr * 64 + fr; const int col0 = u.pn * 256 + wc * 32 + 8 * fq;
#pragma unroll
        for (int ai = 0; ai < 2; ++ai)
#pragma unroll
            for (int m = 0; m < 4; ++m) { const int row = row0 + ai * 128 + m * 16; const float* xr = X + (size_t)row * D + col0; bf16* orow = x1_row(ws, row) + col0;
#pragma unroll
                for (int bj = 0; bj < 2; ++bj) { const accv x0 = *(const accv*)(xr + bj * 128), x1 = *(const accv*)(xr + bj * 128 + 4); const accv v0 = x0 + acc[ai][bj][m][0], v1 = x1 + acc[ai][bj][m][1];
                    v4u w; w.x = pg8::cvt_pk_bf16(v0[0], v0[1]); w.y = pg8::cvt_pk_bf16(v0[2], v0[3]); w.z = pg8::cvt_pk_bf16(v1[0], v1[1]); w.w = pg8::cvt_pk_bf16(v1[2], v1[3]);
                    *(v4u*)(orow + bj * 128) = w; }
                if (m & 1) asm volatile("" ::: "memory"); }
    }
};
struct EpiMoe1 {
    static constexpr bool PERM = true, AFTER_DRAIN = false;
    bf16* H; const float* bg; const float* bu; const int* rowinfo;
    __device__ __forceinline__ void operator()(const accv (&acc)[2][2][4][2], const Unit& u, int wr, int wc, int fr, int fq) const {
        const int row0 = u.pm * 256 + wr * 64 + fr; const int col = u.pn * 128 + wc * 32 + 8 * fq;
        float bgv[8], buv[8];
#pragma unroll
        for (int n = 0; n < 2; ++n) { const accv a = *(const accv*)(bg + u.e * FF + col + 4 * n), b = *(const accv*)(bu + u.e * FF + col + 4 * n);
#pragma unroll
            for (int j = 0; j < 4; ++j) { bgv[4 * n + j] = a[j]; buv[4 * n + j] = b[j]; } }
        float rsv[2][4];
#pragma unroll
        for (int ai = 0; ai < 2; ++ai)
#pragma unroll
            for (int m = 0; m < 4; ++m) rsv[ai][m] = __builtin_bit_cast(float, rowinfo[4 * (row0 + ai * 128 + m * 16) + 2]);
#pragma unroll
        for (int ai = 0; ai < 2; ++ai)
#pragma unroll
            for (int m = 0; m < 4; ++m) { const int row = row0 + ai * 128 + m * 16; float r[8]; const float rs = rsv[ai][m];
#pragma unroll
                for (int n = 0; n < 2; ++n)
#pragma unroll
                    for (int j = 0; j < 4; ++j) { const float g = fminf(acc[ai][0][m][n][j] * rs + bgv[4 * n + j], 7.0f); const float up = fminf(fmaxf(acc[ai][1][m][n][j] * rs + buv[4 * n + j], -7.0f), 7.0f);
                        r[4 * n + j] = (up + 1.0f) * g * frcp(1.0f + fexp2(-1.702f * LOG2E * g)); }
                v4u w; w.x = pg8::cvt_pk_bf16(r[0], r[1]); w.y = pg8::cvt_pk_bf16(r[2], r[3]); w.z = pg8::cvt_pk_bf16(r[4], r[5]); w.w = pg8::cvt_pk_bf16(r[6], r[7]);
                *(v4u*)(H + (size_t)row * FF + col) = w; }
    }
};
struct EpiMoe2 {
    static constexpr bool PERM = true, AFTER_DRAIN = false;
    bf16* Y; const float* bd; const int* rowinfo;
    __device__ __forceinline__ void operator()(const accv (&acc)[2][2][4][2], const Unit& u, int wr, int wc, int fr, int fq) const {
        const int row0 = u.pm * 256 + wr * 64 + fr; const int colt = u.pn * 256 + wc * 32 + 8 * fq;
        float bv[2][8];
#pragma unroll
        for (int bj = 0; bj < 2; ++bj)
#pragma unroll
            for (int n = 0; n < 2; ++n) { const accv a = *(const accv*)(bd + u.e * D + colt + bj * 128 + 4 * n);
#pragma unroll
                for (int j = 0; j < 4; ++j) bv[bj][4 * n + j] = a[j]; }
        v2u sg[2][4];
#pragma unroll
        for (int ai = 0; ai < 2; ++ai)
#pragma unroll
            for (int m = 0; m < 4; ++m) sg[ai][m] = *(const v2u*)(rowinfo + 4 * (row0 + ai * 128 + m * 16));
#pragma unroll
        for (int ai = 0; ai < 2; ++ai)
#pragma unroll
            for (int m = 0; m < 4; ++m) { const int slot = (int)sg[ai][m].x; const unsigned gbits = sg[ai][m].y; const float gate = __builtin_bit_cast(float, gbits);
                if (slot >= 0) {
#pragma unroll
                    for (int bj = 0; bj < 2; ++bj) { float r[8];
#pragma unroll
                        for (int n = 0; n < 2; ++n)
#pragma unroll
                            for (int j = 0; j < 4; ++j) r[4 * n + j] = (acc[ai][bj][m][n][j] + bv[bj][4 * n + j]) * gate;
                        v4u w; w.x = pg8::cvt_pk_bf16(r[0], r[1]); w.y = pg8::cvt_pk_bf16(r[2], r[3]); w.z = pg8::cvt_pk_bf16(r[4], r[5]); w.w = pg8::cvt_pk_bf16(r[6], r[7]);
                        *(v4u*)(Y + (size_t)slot * D + colt + bj * 128) = w; } } }
    }
};

struct InProjOrder {
    int G, c;
    __device__ bool next(int i, Unit& u) const {
        const int L = i * G + c; if (L >= 512) return false;
        const int s = pg8::xcd_remap(L, 512);
        if (s < 384) { const int grp = s / 48, r = s % 48; u.slot = 0; u.pm = grp * 8 + (r & 7); const int pi = r >> 3; u.pn = pi < 4 ? pi : pi + 2; u.e = 0;
            u.offA = (long)u.pm * 256 * D * 2; u.offB = (long)u.pn * 256 * D * 2; }
        else { const int r = s - 384; u.slot = 0; u.pm = r & 1; u.pn = r >> 1; u.e = 1;
            u.offA = (long)(WS_WINT - WS_HN) + (long)(1024 + u.pm * 256) * D * 2; u.offB = (long)(WS_HN - WS_WINT) + (long)u.pn * 256 * D * 2; }
        return true;
    }
    __device__ __forceinline__ void a_ready(const Unit&) const {}
    __device__ __forceinline__ void done(const Unit&) const {}
};
struct SsmOrder {
    int nwg, G, c, npn, rows_per_g, ldb;
    __device__ bool next(int i, Unit& u) const {
        const int L = i * G + c; if (L >= nwg) return false;
        const int per_g = 2 * npn; const int g = L / per_g, r = L % per_g;
        u.e = g; u.pm = r / npn; u.pn = r % npn; u.slot = 0;
        u.offA = ((long)u.pm * 256 * NG * UK + (long)g * UK) * 2; u.offB = ((long)g * rows_per_g + (long)u.pn * 256) * ldb * 2; return true;
    }
    __device__ __forceinline__ void a_ready(const Unit&) const {}
    __device__ __forceinline__ void done(const Unit&) const {}
};
struct MoeOrder {
    const LAS int* units; long ebytes; int gather;
    __device__ bool next(int i, Unit& u) const {
        if (i >= 32) return false;
        const int v = __builtin_amdgcn_readfirstlane(units[4 * i + 3]); if (!v) return false;
        u.pm = __builtin_amdgcn_readfirstlane(units[4 * i + 0]); u.pn = __builtin_amdgcn_readfirstlane(units[4 * i + 1]); u.e = __builtin_amdgcn_readfirstlane(units[4 * i + 2]);
        u.slot = i; u.offA = gather ? 0l : (long)u.pm * 256 * D * 2; u.offB = (long)u.e * ebytes + (long)u.pn * 256 * 16; return true;
    }
    __device__ __forceinline__ void a_ready(const Unit&) const {}
    __device__ __forceinline__ void done(const Unit&) const {}
};

struct CvItem { const float* src; bf16* dst; int ldw, K, rmul, radd, k0, n0; };
constexpr int CV_I_IN = (D / 64) * (NPROJ / 32), CV_I_GLU = (SSW / 64) * (SSW / 32), CV_I_OUT = (D / 64) * (D / 32), CV_I_E = (D / 64) * (FF / 32);
constexpr int CV_N_EARLY = CV_I_IN + 2 * CV_I_GLU + CV_I_OUT, CV_N_EXP = 3 * NE * (D / 8);
__device__ __forceinline__ void cv_set(CvItem& c, const float* W, int ldw, int K, int N, bf16* WT, int rmul, int radd, int item) {
    const int nblk = N / 32, kb = item / nblk, nb = item % nblk; c.src = W; c.dst = WT; c.ldw = ldw; c.K = K; c.rmul = rmul; c.radd = radd; c.k0 = 64 * kb; c.n0 = 32 * nb;
}
__device__ __forceinline__ void cv_decode_early(Frame& F, int r, CvItem& c) {
    bf16* WinT = (bf16*)(F.ws + WS_WINT); bf16* WgluT = (bf16*)(F.ws + WS_WGLUT); bf16* WoutT = (bf16*)(F.ws + WS_WOUTT);
    if (r < CV_I_IN) { cv_set(c, F.in[2], NPROJ, D, NPROJ, WinT, 1, 0, r); return; } r -= CV_I_IN;
    if (r < CV_I_GLU) { cv_set(c, F.in[11], 2 * SSW, SSW, SSW, WgluT, 2, 0, r); return; } r -= CV_I_GLU;
    if (r < CV_I_GLU) { cv_set(c, F.in[11] + SSW, 2 * SSW, SSW, SSW, WgluT, 2, 128, r); return; } r -= CV_I_GLU;
    cv_set(c, F.in[14], D, D, D, WoutT, 1, 0, r);
}
__device__ __forceinline__ void cv_decode_exp(Frame& F, int r, CvItem& c) {
    bf16* W1T = (bf16*)(F.ws + WS_W1T); bf16* W2T = (bf16*)(F.ws + WS_W2T);
    const int mat = r / CV_I_E, sub = r % CV_I_E, kind = mat / NE, e = mat % NE;
    if (kind == 0) cv_set(c, F.in[18] + (size_t)e * D * FF, FF, D, FF, W1T + (size_t)e * 2 * FF * D, 2, 0, sub);
    else if (kind == 1) cv_set(c, F.in[20] + (size_t)e * D * FF, FF, D, FF, W1T + (size_t)e * 2 * FF * D, 2, 128, sub);
    else cv_set(c, F.in[22] + (size_t)e * FF * D, D, FF, D, W2T + (size_t)e * D * FF, 1, 0, sub);
}
__device__ __forceinline__ void cv_load(const CvItem& c, int lane, float (&v)[32]) {
    const float* p = c.src + (size_t)(c.k0 + (lane >> 5)) * c.ldw + c.n0 + (lane & 31);
#pragma unroll
    for (int i = 0; i < 32; ++i) v[i] = p[(size_t)(2 * i) * c.ldw];
}
__device__ __forceinline__ void cv_store(const CvItem& c, int lane, const float (&v)[32], LAS float* scr) {
#pragma unroll
    for (int i = 0; i < 32; ++i) scr[(2 * i + (lane >> 5)) * 33 + (lane & 31)] = v[i];
    LDS_WAIT(); asm volatile("" ::: "memory");
    const int cc = lane & 7;
#pragma unroll
    for (int j = 0; j < 4; ++j) { const int nl = (lane >> 3) + 8 * j; const int n = c.n0 + nl; const int drow = (n >> 7) * 128 * c.rmul + c.radd + (n & 127); const LAS float* s = scr + (8 * cc) * 33 + nl;
        v4u o; o.x = pg8::cvt_pk_bf16(s[0 * 33], s[1 * 33]); o.y = pg8::cvt_pk_bf16(s[2 * 33], s[3 * 33]); o.z = pg8::cvt_pk_bf16(s[4 * 33], s[5 * 33]); o.w = pg8::cvt_pk_bf16(s[6 * 33], s[7 * 33]);
        *(GAS v4u*)(c.dst + (size_t)drow * c.K + c.k0 + 8 * cc) = o; }
    LDS_WAIT(); asm volatile("" ::: "memory");
}
__device__ __forceinline__ void cv_item_early(Frame& F, int it, LAS float* scr) { CvItem c; float v[32]; cv_decode_early(F, it, c); cv_load(c, F.lane, v); cv_store(c, F.lane, v, scr); }
__device__ __forceinline__ void cv_run_early(Frame& F, int first, int stride, int n, LAS float* scr) {
    CvItem ca, cb; float va[32], vb[32];
    int it = first; if (it >= n) return;
    cv_decode_early(F, it, ca);
    cv_load(ca, F.lane, va);
    for (;;) {
        const int nit = it + stride; const bool more = nit < n;
        if (more) { cv_decode_early(F, nit, cb); cv_load(cb, F.lane, vb); }
        cv_store(ca, F.lane, va, scr);
        if (!more) break;
        ca = cb;
#pragma unroll
        for (int i = 0; i < 32; ++i) va[i] = vb[i];
        it = nit;
    }
}
__device__ __forceinline__ void xv_item(Frame& F, int it) {
    bf16* W1T = (bf16*)(F.ws + WS_W1T); bf16* W2T = (bf16*)(F.ws + WS_W2T);
    const float* w0 = F.in[18]; const float* w1 = F.in[20]; const float* w2 = F.in[22];
    asm volatile("" : "+s"(w0), "+s"(w1), "+s"(w2));
    const int lane = F.lane;
    {
        const int mat = it >> 7, kb = it & 127, kind = mat / NE, e = mat % NE;
        const float* src = (kind == 0 ? w0 : (kind == 1 ? w1 : w2)) + (size_t)e * D * FF + (size_t)(kb * 8) * FF + 4 * lane;
        f32x4 v[8][4];
#pragma unroll
        for (int rr = 0; rr < 8; ++rr)
#pragma unroll
            for (int j = 0; j < 4; ++j) v[rr][j] = *(const GAS f32x4*)(src + (size_t)rr * FF + 256 * j);
        bf16* dst; int cstride;
        if (kind < 2) { dst = W1T + (size_t)e * 2 * FF * D + ((size_t)kb * 2 * FF + (size_t)(lane >> 5) * 256 + (kind == 1 ? 128 : 0) + 4 * (lane & 31)) * 8; cstride = 512 * 8; }
        else { dst = W2T + (size_t)e * D * FF + ((size_t)kb * D + 4 * lane) * 8; cstride = 256 * 8; }
#pragma unroll
        for (int j = 0; j < 4; ++j)
#pragma unroll
            for (int c = 0; c < 4; ++c) { v4u o; o.x = pg8::cvt_pk_bf16(v[0][j][c], v[1][j][c]); o.y = pg8::cvt_pk_bf16(v[2][j][c], v[3][j][c]); o.z = pg8::cvt_pk_bf16(v[4][j][c], v[5][j][c]); o.w = pg8::cvt_pk_bf16(v[6][j][c], v[7][j][c]);
                *(GAS v4u*)(dst + (size_t)j * cstride + c * 8) = o; }
    }
}
__device__ __forceinline__ void rms_row_to_bf16(int lane, const float* xrow, const float* g, bf16* orow) {
    const GAS f32x4* xr = (const GAS f32x4*)xrow + lane; const GAS f32x4* gr = (const GAS f32x4*)g + lane;
    f32x4 v[4]; float s = 0.f;
#pragma unroll
    for (int j = 0; j < 4; ++j) { v[j] = xr[64 * j]; s += (v[j].x * v[j].x + v[j].y * v[j].y) + (v[j].z * v[j].z + v[j].w * v[j].w); }
    const float rstd = 1.0f / sqrtf(wave_sum(s) * (1.f / D) + EPS);
    GAS unsigned long long* o8 = (GAS unsigned long long*)orow + lane;
#pragma unroll
    for (int j = 0; j < 4; ++j) { const f32x4 gg = gr[64 * j]; o8[64 * j] = (unsigned long long)pk2(v[j].x * rstd * gg.x, v[j].y * rstd * gg.y) | ((unsigned long long)pk2(v[j].z * rstd * gg.z, v[j].w * rstd * gg.w) << 32); }
}
__device__ __forceinline__ void sincos_acc(float th, float& s, float& c) {
    const float k = rintf(th * 0.15915494309189535f);
    float r = fmaf(-k, 6.28125f, th); r = fmaf(-k, 1.9353071795864769e-3f, r);
    const float x = 0.25f * r, x2 = x * x;
    float sn = x * (1.0f + x2 * (-1.0f / 6 + x2 * (1.0f / 120 + x2 * (-1.0f / 5040 + x2 * (1.0f / 362880 + x2 * (-1.0f / 39916800))))));
    float cs = 1.0f + x2 * (-0.5f + x2 * (1.0f / 24 + x2 * (-1.0f / 720 + x2 * (1.0f / 40320 + x2 * (-1.0f / 3628800 + x2 * (1.0f / 479001600))))));
#pragma unroll
    for (int i = 0; i < 2; ++i) { const float s2 = 2.0f * sn * cs, c2 = 1.0f - 2.0f * sn * sn; sn = s2; cs = c2; }
    s = sn; c = cs;
}
__device__ __forceinline__ void ssm_tables(Frame& F, int g) {
    constexpr int PT = 36, BS = 17, CS = 68, KT = 324, KC = 20;
    LAS float* pwr = (LAS float*)(F.lds);
    LAS float* pwi = pwr + 64 * PT;
    LAS float* bbr = pwi + 64 * PT;
    LAS float* bbi = bbr + 64 * BS;
    LAS float* ccr = bbi + 64 * BS;
    LAS float* cci = ccr + 16 * CS;
    LAS float* km = cci + 16 * CS;
    const float* lam_re = F.in[3]; const float* lam_im = F.in[4]; const float* log_dt = F.in[5];
    const float* b_re = F.in[6]; const float* b_im = F.in[7]; const float* c_re = F.in[8]; const float* c_im = F.in[9]; const float* dsk = F.in[10];
    float* lamL = (float*)(F.ws + WS_LAML); bf16* WE = (bf16*)(F.ws + WS_WE); bf16* TW = (bf16*)(F.ws + WS_TW);
    const int tid = F.tid;
    if (tid < 64) { const int p = tid;
        const float lr = lam_re[g * NP + p], li = lam_im[g * NP + p], dt = expf(log_dt[g]);
        const float er = expf(lr * dt); float sn, cs; sincos_acc(li * dt, sn, cs);
        const float br = er * cs, bi = er * sn;
        const float nr = br - 1.0f, ni = bi, den = 1.0f / (lr * lr + li * li);
        const float fr = (nr * lr + ni * li) * den, fi = (ni * lr - nr * li) * den;
        float pr = 1.0f, pi = 0.0f;
        for (int n = 0; n <= 32; ++n) { pwr[p * PT + n] = pr; pwi[p * PT + n] = pi; const float t = pr * br - pi * bi; pi = pr * bi + pi * br; pr = t; }
        lamL[(g * 2 + 0) * NP + p] = pwr[p * PT + 32]; lamL[(g * 2 + 1) * NP + p] = pwi[p * PT + 32];
        float xr[GC], xi[GC];
#pragma unroll
        for (int c = 0; c < GC; ++c) { xr[c] = b_re[(g * NP + p) * GC + c]; xi[c] = b_im[(g * NP + p) * GC + c]; }
#pragma unroll
        for (int c = 0; c < GC; ++c) { bbr[p * BS + c] = fr * xr[c] - fi * xi[c]; bbi[p * BS + c] = fr * xi[c] + fi * xr[c]; }
    }
    for (int i = tid; i < 1024; i += NWAVES * 64) { ccr[(i >> 6) * CS + (i & 63)] = c_re[g * 1024 + i]; cci[(i >> 6) * CS + (i & 63)] = c_im[g * 1024 + i]; }
    __syncthreads();
    {
        const int pair = tid & 255, co = pair >> 4, ci = pair & 15, t0 = (tid >> 8) * 16;
        float acc[16];
#pragma unroll
        for (int t = 0; t < 16; ++t) acc[t] = 0.f;
        for (int p = 0; p < NP; ++p) { const float cr = ccr[co * CS + p], cim = cci[co * CS + p], xr = bbr[p * BS + ci], xi = bbi[p * BS + ci];
            const float gr = cr * xr - cim * xi, gi = cr * xi + cim * xr;
#pragma unroll
            for (int t4 = 0; t4 < 4; ++t4) { const f32x4 a = *(const LAS f32x4*)(pwr + p * PT + t0 + 4 * t4), bq = *(const LAS f32x4*)(pwi + p * PT + t0 + 4 * t4);
#pragma unroll
                for (int t = 0; t < 4; ++t) acc[4 * t4 + t] += gr * a[t] - gi * bq[t]; } }
#pragma unroll
        for (int t = 0; t < 16; ++t) km[(t0 + t) * KT + co * KC + ci] = acc[t];
    }
    __syncthreads();
    {
        const int n = tid, i = n >> 4, co = n & 15; const float dv = dsk[g * GC + co];
        bf16* dst = TW + ((size_t)g * 512 + n) * UK;
        for (int j = 0; j < LC; ++j) {
            float v[16];
            const LAS float* kr = km + (j <= i ? i - j : 0) * KT + co * KC;
#pragma unroll
            for (int c4 = 0; c4 < 4; ++c4) { const f32x4 q = *(const LAS f32x4*)(kr + 4 * c4);
#pragma unroll
                for (int t = 0; t < 4; ++t) v[4 * c4 + t] = (j <= i) ? q[t] : 0.f; }
            if (j == i) {
#pragma unroll
                for (int ci = 0; ci < 16; ++ci) v[ci] += (ci == co) ? dv : 0.f; }
            v4u o0, o1; o0.x = pg8::cvt_pk_bf16(v[0], v[1]); o0.y = pg8::cvt_pk_bf16(v[2], v[3]); o0.z = pg8::cvt_pk_bf16(v[4], v[5]); o0.w = pg8::cvt_pk_bf16(v[6], v[7]);
            o1.x = pg8::cvt_pk_bf16(v[8], v[9]); o1.y = pg8::cvt_pk_bf16(v[10], v[11]); o1.z = pg8::cvt_pk_bf16(v[12], v[13]); o1.w = pg8::cvt_pk_bf16(v[14], v[15]);
            *(GAS v4u*)(dst + j * 16) = o0; *(GAS v4u*)(dst + j * 16 + 8) = o1; }
        for (int k8 = 0; k8 < 16; ++k8) { float v[8];
            const int ri = k8 >> 3, p0 = 8 * (k8 & 7);
#pragma unroll
            for (int e = 0; e < 8; ++e) { const int p = p0 + e; const float cr = ccr[co * CS + p], cim = cci[co * CS + p], pr = pwr[p * PT + i + 1], pi = pwi[p * PT + i + 1];
                v[e] = ri == 0 ? (cr * pr - cim * pi) : -(cr * pi + cim * pr); }
            v4u o; o.x = pg8::cvt_pk_bf16(v[0], v[1]); o.y = pg8::cvt_pk_bf16(v[2], v[3]); o.z = pg8::cvt_pk_bf16(v[4], v[5]); o.w = pg8::cvt_pk_bf16(v[6], v[7]);
            *(GAS v4u*)(dst + 512 + k8 * 8) = o; }
    }
    {
        const int row = tid & 127, ri = row >> 6, p = row & 63, kq = tid >> 7;
        bf16* dst = WE + ((size_t)g * 128 + row) * 512 + kq * 128;
        for (int k8 = 0; k8 < 16; ++k8) { float v[8];
#pragma unroll
            for (int e = 0; e < 8; ++e) { const int k = kq * 128 + k8 * 8 + e, j = k >> 4, c = k & 15; const float pr = pwr[p * PT + 31 - j], pi = pwi[p * PT + 31 - j], xr = bbr[p * BS + c], xi = bbi[p * BS + c];
                v[e] = ri == 0 ? (pr * xr - pi * xi) : (pr * xi + pi * xr); }
            v4u o; o.x = pg8::cvt_pk_bf16(v[0], v[1]); o.y = pg8::cvt_pk_bf16(v[2], v[3]); o.z = pg8::cvt_pk_bf16(v[4], v[5]); o.w = pg8::cvt_pk_bf16(v[6], v[7]);
            *(GAS v4u*)(dst + k8 * 8) = o; }
    }
    __syncthreads();
}
__device__ __forceinline__ void rms_rows2_to_bf16(int lane, const float* x0, const float* x1, const float* g, bf16* o0, bf16* o1) {
    const GAS f32x4* xa = (const GAS f32x4*)x0 + lane; const GAS f32x4* xb = (const GAS f32x4*)x1 + lane; const GAS f32x4* gr = (const GAS f32x4*)g + lane;
    f32x4 va[4], vb[4]; float sa = 0.f, sb = 0.f;
#pragma unroll
    for (int j = 0; j < 4; ++j) { va[j] = xa[64 * j]; vb[j] = xb[64 * j]; }
#pragma unroll
    for (int j = 0; j < 4; ++j) { sa += (va[j].x * va[j].x + va[j].y * va[j].y) + (va[j].z * va[j].z + va[j].w * va[j].w); sb += (vb[j].x * vb[j].x + vb[j].y * vb[j].y) + (vb[j].z * vb[j].z + vb[j].w * vb[j].w); }
#pragma unroll
    for (int o = 1; o < 64; o <<= 1) { sa += __shfl_xor(sa, o); sb += __shfl_xor(sb, o); }
    const float ra = 1.0f / sqrtf(sa * (1.f / D) + EPS), rb = 1.0f / sqrtf(sb * (1.f / D) + EPS);
    GAS v2u* pa = (GAS v2u*)o0 + lane; GAS v2u* pb = (GAS v2u*)o1 + lane;
#pragma unroll
    for (int j = 0; j < 4; ++j) { const f32x4 gg = gr[64 * j];
        v2u wa, wb; wa.x = pg8::cvt_pk_bf16(va[j].x * ra * gg.x, va[j].y * ra * gg.y); wa.y = pg8::cvt_pk_bf16(va[j].z * ra * gg.z, va[j].w * ra * gg.w);
        wb.x = pg8::cvt_pk_bf16(vb[j].x * rb * gg.x, vb[j].y * rb * gg.y); wb.y = pg8::cvt_pk_bf16(vb[j].z * rb * gg.z, vb[j].w * rb * gg.w);
        pa[64 * j] = wa; pb[64 * j] = wb; }
}
constexpr int Q0_HN = M / 8, Q0_END = Q0_HN + CV_N_EARLY / 4;
static_assert(Q0_END % 8 == 0 && CV_N_EARLY % 4 == 0, "P0 queue");
__device__ __forceinline__ void p0_prologue(Frame& F, unsigned long long& t_lo_, unsigned long long& t_hi_) {
    TMARK(100);
    LAS float* scr = (LAS float*)(F.lds + RING_OFF + F.wave * 16384);
    unsigned* q = (unsigned*)(F.ctl + CW_Q0); volatile LAS unsigned* slot = F.MISC + 16;
    bf16* HN = (bf16*)(F.ws + WS_HN);
    for (;;) {
        __syncthreads();
        if (F.tid == 0) *slot = __hip_atomic_fetch_add(q, 8u, RLX_AGENT);
        __syncthreads();
        const int base = (int)__builtin_amdgcn_readfirstlane(*slot); if (base >= Q0_END) break;
        const int idx = base + F.wave;
        if (idx < Q0_HN) { const int m0 = idx * 8;
#pragma unroll 1
            for (int j = 0; j < 4; ++j) { const int m = m0 + 2 * j; rms_rows2_to_bf16(F.lane, F.in[0] + (size_t)m * D, F.in[0] + (size_t)(m + 1) * D, F.in[1], HN + (size_t)m * D, HN + (size_t)(m + 1) * D); } }
        else { const int g4 = (idx - Q0_HN) * 4;
#pragma unroll 1
            for (int j = 0; j < 4; ++j) cv_item_early(F, g4 + j, scr); }
    }
    TMARK(104);
}
__device__ __forceinline__ void p1_side(Frame& F, int tabler_idx) {
    if (tabler_idx >= 0) { ssm_tables(F, tabler_idx);
        if (tabler_idx == 0 && F.tid < 128) {
            bf16* WE = (bf16*)(F.ws + WS_WE) + (size_t)NG * 128 * 512;
            for (int i = 0; i < 512 / 8; ++i) *(GAS v4u*)(WE + (size_t)F.tid * 512 + i * 8) = (v4u){0u, 0u, 0u, 0u}; }
        if (tabler_idx == 1) {
            const float* wr = F.in[16]; bf16* img = (bf16*)(F.ws + WS_RWIMG);
            for (int idx = F.tid; idx < D * NE; idx += NWAVES * 64) { const float w = wr[idx]; const unsigned h = f2bf(w); const unsigned l = f2bf(w - bf2f((unsigned short)h)); const int k = idx >> 5, e = idx & 31;
                img[e * RT_WSTR + k] = (bf16)h; img[(NE + e) * RT_WSTR + k] = (bf16)l; }
            if (F.tid < 2 * NE) for (int k = D; k < RT_WSTR; ++k) img[F.tid * RT_WSTR + k] = 0; } }
    unsigned* q = (unsigned*)(F.ctl + CW_Q1); volatile LAS unsigned* slot = F.MISC + 18;
    for (;;) {
        __syncthreads();
        if (F.tid == 0) *slot = __hip_atomic_fetch_add(q, 8u, RLX_AGENT);
        __syncthreads();
        const int base = (int)__builtin_amdgcn_readfirstlane(*slot); if (base >= CV_N_EXP) break;
        xv_item(F, base + F.wave);
    }
}

__device__ __forceinline__ void attn_simple_unit(const unsigned short* Qh, const unsigned short* Kh, const unsigned short* Vh, bf16* Y, int b, int h, int qb, int lane) {
    const int t = qb * 64 + lane; const size_t row = (size_t)b * SEQ + t;
    float q[64], o[64];
    { const v4u* qp = (const v4u*)(Qh + row * SBW + h * HD);
#pragma unroll
      for (int i = 0; i < 8; ++i) { const v4u w = qp[i];
#pragma unroll
          for (int j = 0; j < 4; ++j) { const unsigned wj = w[j]; const h16x2 hv = __builtin_bit_cast(h16x2, wj); q[8 * i + 2 * j] = (float)hv.x; q[8 * i + 2 * j + 1] = (float)hv.y; } } }
#pragma unroll
    for (int d = 0; d < 64; ++d) o[d] = 0.f;
    float cum = 0.f;
    for (int s = qb * 64 + 62; s >= 0; --s) {
        const size_t krow = ((size_t)b * SEQ + s) * SBW + h * HD;
        const v4u* kp = (const v4u*)(Kh + krow); const v4u* vp = (const v4u*)(Vh + krow);
        float z = 0.f;
#pragma unroll
        for (int i = 0; i < 8; ++i) { const v4u w = kp[i];
#pragma unroll
            for (int j = 0; j < 4; ++j) { const unsigned wj = w[j]; const h16x2 hv = __builtin_bit_cast(h16x2, wj); z = fmaf(q[8 * i + 2 * j], (float)hv.x, z); z = fmaf(q[8 * i + 2 * j + 1], (float)hv.y, z); } }
        const bool act = s < t;
        const float t1 = flog2(1.0f + fexp2(-fabsf(z)));
        const float L = act ? -(fmaxf(z, 0.f) + t1) : 0.f;
        const float ls = fminf(z, 0.f) - t1;
        const float p = act ? fexp2(ls + cum) : 0.f;
        cum += L;
#pragma unroll
        for (int i = 0; i < 8; ++i) { const v4u w = vp[i];
#pragma unroll
            for (int j = 0; j < 4; ++j) { const unsigned wj = w[j]; const h16x2 hv = __builtin_bit_cast(h16x2, wj); o[8 * i + 2 * j] = fmaf(p, (float)hv.x, o[8 * i + 2 * j]); o[8 * i + 2 * j + 1] = fmaf(p, (float)hv.y, o[8 * i + 2 * j + 1]); } }
        if (__all(cum < -150.0f)) break;
    }
    bf16* yp = Y + row * SBW + h * HD;
#pragma unroll
    for (int i = 0; i < 8; ++i) { v4u w; w.x = pk2(o[8 * i], o[8 * i + 1]); w.y = pk2(o[8 * i + 2], o[8 * i + 3]); w.z = pk2(o[8 * i + 4], o[8 * i + 5]); w.w = pk2(o[8 * i + 6], o[8 * i + 7]); *(v4u*)(yp + 8 * i) = w; }
}
typedef _Float16 h8v __attribute__((ext_vector_type(8)));
typedef float f16v __attribute__((ext_vector_type(16)));
__device__ __forceinline__ void attn_mfma_unit(const _Float16* Qh, const _Float16* Kh, const _Float16* VT, bf16* Y, int b, int hd, int qb, int lane, h8v tri0, h8v tri1) {
    const int r = lane & 31, hh = lane >> 5, q0 = qb * 32;
    const _Float16* qrow = Qh + ((size_t)b * SEQ + q0 + r) * SBW + hd * HD + 8 * hh;
    h8v qf[4];
#pragma unroll
    for (int kd = 0; kd < 4; ++kd) qf[kd] = *(const h8v*)(qrow + 16 * kd);
    f16v o0, o1;
#pragma unroll
    for (int i = 0; i < 16; ++i) { o0[i] = 0.f; o1[i] = 0.f; }
    float carry = 0.f;
    const _Float16* kbase = Kh + ((size_t)b * SEQ + r) * SBW + hd * HD + 8 * hh;
    const _Float16* vbase = VT + ((size_t)b * SBW + hd * HD + r) * SEQ + 8 * hh;
    h8v kf[4], vf[2][2], kn[4], vn[2][2];
#pragma unroll
    for (int kd = 0; kd < 4; ++kd) kf[kd] = *(const h8v*)(kbase + (size_t)q0 * SBW + 16 * kd);
#pragma unroll
    for (int db = 0; db < 2; ++db)
#pragma unroll
        for (int ss = 0; ss < 2; ++ss) vf[db][ss] = *(const h8v*)(vbase + (size_t)(32 * db) * SEQ + q0 + 16 * ss);
    for (int key0 = q0; key0 >= 0; key0 -= 32) {
        { const int kn0 = key0 >= 32 ? key0 - 32 : key0;
#pragma unroll
          for (int kd = 0; kd < 4; ++kd) kn[kd] = *(const h8v*)(kbase + (size_t)kn0 * SBW + 16 * kd);
#pragma unroll
          for (int db = 0; db < 2; ++db)
#pragma unroll
              for (int ss = 0; ss < 2; ++ss) vn[db][ss] = *(const h8v*)(vbase + (size_t)(32 * db) * SEQ + kn0 + 16 * ss); }
        f16v z;
#pragma unroll
        for (int i = 0; i < 16; ++i) z[i] = 0.f;
#pragma unroll
        for (int kd = 0; kd < 4; ++kd) z = __builtin_amdgcn_mfma_f32_32x32x16_f16(kf[kd], qf[kd], z, 0, 0, 0);
        const bool diag = key0 == q0;
        h8v lh[2], ll[2];
#pragma unroll
        for (int i = 0; i < 16; ++i) { const int koff = (i & 3) + 8 * (i >> 2) + 4 * hh; const bool act = !diag || koff < r;
            const float zi = z[i]; const float t1 = flog2(1.0f + fexp2(-fabsf(zi)));
            const float L = act ? fmaxf(-(fmaxf(zi, 0.f) + t1), -60000.0f) : 0.f;
            const _Float16 hi = (_Float16)L; const _Float16 lo = (_Float16)(L - (float)hi);
            lh[i >> 3][i & 7] = hi; ll[i >> 3][i & 7] = lo; }
        f16v cum;
#pragma unroll
        for (int i = 0; i < 16; ++i) cum[i] = carry;
        cum = __builtin_amdgcn_mfma_f32_32x32x16_f16(tri0, lh[0], cum, 0, 0, 0);
        cum = __builtin_amdgcn_mfma_f32_32x32x16_f16(tri1, lh[1], cum, 0, 0, 0);
        cum = __builtin_amdgcn_mfma_f32_32x32x16_f16(tri0, ll[0], cum, 0, 0, 0);
        cum = __builtin_amdgcn_mfma_f32_32x32x16_f16(tri1, ll[1], cum, 0, 0, 0);
        h8v pf[2];
#pragma unroll
        for (int i = 0; i < 16; ++i) { const int koff = (i & 3) + 8 * (i >> 2) + 4 * hh; const bool act = !diag || koff < r;
            const float p = act ? fexp2(z[i] + cum[i]) : 0.f; pf[i >> 3][i & 7] = (_Float16)p; }
        o0 = __builtin_amdgcn_mfma_f32_32x32x16_f16(vf[0][0], pf[0], o0, 0, 0, 0);
        o0 = __builtin_amdgcn_mfma_f32_32x32x16_f16(vf[0][1], pf[1], o0, 0, 0, 0);
        o1 = __builtin_amdgcn_mfma_f32_32x32x16_f16(vf[1][0], pf[0], o1, 0, 0, 0);
        o1 = __builtin_amdgcn_mfma_f32_32x32x16_f16(vf[1][1], pf[1], o1, 0, 0, 0);
        carry = __shfl(cum[0], r);
        if (__all(carry < -150.0f)) break;
#pragma unroll
        for (int kd = 0; kd < 4; ++kd) kf[kd] = kn[kd];
#pragma unroll
        for (int db = 0; db < 2; ++db)
#pragma unroll
            for (int ss = 0; ss < 2; ++ss) vf[db][ss] = vn[db][ss];
    }
    bf16* yp = Y + ((size_t)b * SEQ + q0 + r) * SBW + hd * HD + 4 * hh;
#pragma unroll
    for (int g4 = 0; g4 < 4; ++g4) { v2u w0, w1; w0.x = pk2(o0[4 * g4], o0[4 * g4 + 1]); w0.y = pk2(o0[4 * g4 + 2], o0[4 * g4 + 3]); w1.x = pk2(o1[4 * g4], o1[4 * g4 + 1]); w1.y = pk2(o1[4 * g4 + 2], o1[4 * g4 + 3]);
        *(v2u*)(yp + 8 * g4) = w0; *(v2u*)(yp + 32 + 8 * g4) = w1; }
}
__device__ __forceinline__ void attn_one(Frame& F, int u) {
    const _Float16* Qh = (const _Float16*)(F.ws + WS_Q); const _Float16* Kh = (const _Float16*)(F.ws + WS_K); const _Float16* VT = (const _Float16*)(F.ws + WS_V);
    bf16* Y = (bf16*)(F.ws + WS_YSB);
    constexpr int NQB = SEQ / 32;
    const int lane = F.lane, r = lane & 31, hh = lane >> 5;
    h8v tri0, tri1;
#pragma unroll
    for (int e = 0; e < 8; ++e) { const int k0 = 8 * (e >> 2) + 4 * hh + (e & 3); tri0[e] = (k0 >= r) ? (_Float16)1.0f : (_Float16)0.0f; tri1[e] = (16 + k0 >= r) ? (_Float16)1.0f : (_Float16)0.0f; }
    const int qb = u % NQB, bh = u / NQB; attn_mfma_unit(Qh, Kh, VT, Y, bh / NH, bh % NH, qb, lane, tri0, tri1);
}

__device__ __forceinline__ void scan_phase(Frame& F) {
    const int task = F.vcu;
    const int b = task / NG, g = task % NG, p = F.lane;
    const float* lamL = (const float*)(F.ws + WS_LAML); const float* S = (const float*)(F.ws + WS_SLOC); bf16* U = (bf16*)(F.ws + WS_UCAT);
    const float lr = lamL[(g * 2 + 0) * NP + p], li = lamL[(g * 2 + 1) * NP + p];
    float xr = 0.f, xi = 0.f;
    for (int c0 = 0; c0 < CPB; c0 += 8) {
        float sr[8], si[8];
#pragma unroll
        for (int j = 0; j < 8; ++j) { const size_t base = ((size_t)(b * CPB + c0 + j) * NG + g) * 128; sr[j] = S[base + p]; si[j] = S[base + 64 + p]; }
#pragma unroll
        for (int j = 0; j < 8; ++j) { bf16* dst = U + ((size_t)(b * CPB + c0 + j) * NG + g) * UK + 512;
            dst[p] = (bf16)f2bf(xr); dst[64 + p] = (bf16)f2bf(xi);
            const float nr = lr * xr - li * xi + sr[j], ni = lr * xi + li * xr + si[j]; xr = nr; xi = ni; }
    }
}

__device__ __forceinline__ void mix_phase(Frame& F) {
    const bf16* YSB = (const bf16*)(F.ws + WS_YSB); const bf16* YSSM = (const bf16*)(F.ws + WS_YSSM); bf16* MX = (bf16*)(F.ws + WS_MIXED);
    const float* g_sb = F.in[12]; const float* g_ssm = F.in[13];
    const int gw = F.vcu * NWAVES + F.wave, NGW = F.G * NWAVES, lane = F.lane;
    f32x4 ga[2], gb[2];
#pragma unroll
    for (int j = 0; j < 2; ++j) { ga[j] = *(const f32x4*)(g_sb + 8 * lane + 4 * j); gb[j] = *(const f32x4*)(g_ssm + 8 * lane + 4 * j); }
    for (int m = gw; m < M; m += NGW) {
        const v4u a = *(const v4u*)(YSB + (size_t)m * SBW + 8 * lane), c = *(const v4u*)(YSSM + (size_t)m * SSW + 8 * lane);
        float av[8], cv[8]; float sa = 0.f, sc = 0.f;
#pragma unroll
        for (int j = 0; j < 4; ++j) { av[2 * j] = bflo(a[j]); av[2 * j + 1] = bfhi(a[j]); cv[2 * j] = bflo(c[j]); cv[2 * j + 1] = bfhi(c[j]); }
#pragma unroll
        for (int j = 0; j < 8; ++j) { sa += av[j] * av[j]; sc += cv[j] * cv[j]; }
        const float ra = 1.0f / sqrtf(wave_sum(sa) * (1.f / SBW) + EPS), rc = 1.0f / sqrtf(wave_sum(sc) * (1.f / SSW) + EPS);
        v4u oa, oc;
#pragma unroll
        for (int j = 0; j < 4; ++j) { oa[j] = pk2(av[2 * j] * ra * ga[j >> 1][(2 * j) & 3], av[2 * j + 1] * ra * ga[j >> 1][(2 * j + 1) & 3]);
                                      oc[j] = pk2(cv[2 * j] * rc * gb[j >> 1][(2 * j) & 3], cv[2 * j + 1] * rc * gb[j >> 1][(2 * j + 1) & 3]); }
        if (DBG_MODE == 3) oa = (v4u){0u, 0u, 0u, 0u};
        if (DBG_MODE == 2) oc = (v4u){0u, 0u, 0u, 0u};
        *(v4u*)(MX + (size_t)m * D + 8 * lane) = oa; *(v4u*)(MX + (size_t)m * D + SBW + 8 * lane) = oc;
    }
}

__device__ __forceinline__ void router_phase(Frame& F) {
    typedef short s8v __attribute__((ext_vector_type(8)));
    typedef float f16v __attribute__((ext_vector_type(16)));
    LAS bf16* wh = (LAS bf16*)F.lds; LAS bf16* wl = wh + NE * RT_WSTR;
    LAS int* lcnt = (LAS int*)(F.lds + RT_SCR_OFF); LAS int* lbase = lcnt + 32; LAS int* asg = lbase + 32;
    const float* wr = F.in[16]; const float* br = F.in[17]; const float* g2 = F.in[15];
    bf16* XG = (bf16*)(F.ws + WS_XN); float* gates = (float*)(F.ws + WS_GATES); int* lists = (int*)(F.ws + WS_LISTS); float* RS = (float*)(F.ws + WS_RSTD);
    unsigned* gcnt = (unsigned*)(F.ctl + CW_CNT);
    const int tid = F.tid, lane = F.lane, r = lane & 31, hh = lane >> 5;
    const int task = F.wave >> 2, kq = F.wave & 3; const int tok = F.vcu * 64 + task * 32 + r;
    const bf16* xp = x1_row(F.ws, tok) + kq * 256 + 8 * hh; bf16* xo = XG + (size_t)tok * D + kq * 256 + 8 * hh;
    v4u xw[16];
#pragma unroll
    for (int ks = 0; ks < 16; ++ks) xw[ks] = *(const v4u*)(xp + 16 * ks);
    { const v4u* src = (const v4u*)(F.ws + WS_RWIMG); LAS v4u* dst = (LAS v4u*)F.lds;
      for (int i = tid; i < RT_W_BYTES / 16; i += NWAVES * 64) dst[i] = src[i]; }
    LAS float* gl = (LAS float*)(F.lds + RT_SCR_OFF + 2048);
    for (int i = tid; i < D / 4; i += NWAVES * 64) ((LAS f32x4*)gl)[i] = ((const f32x4*)g2)[i];
    if (tid < 32) lcnt[tid] = 0;
    __syncthreads();
    f16v acc;
#pragma unroll
    for (int i = 0; i < 16; ++i) acc[i] = 0.f;
    float ss = 0.f;
    const LAS float* gp = gl + kq * 256 + 8 * hh;
    const LAS bf16* whp = wh + r * RT_WSTR + kq * 256 + 8 * hh; const LAS bf16* wlp = wl + r * RT_WSTR + kq * 256 + 8 * hh;
#pragma unroll
    for (int ks = 0; ks < 16; ++ks) {
        const v4u xq = xw[ks]; const f32x4 x0 = (f32x4){bflo(xq.x), bfhi(xq.x), bflo(xq.y), bfhi(xq.y)}, x1 = (f32x4){bflo(xq.z), bfhi(xq.z), bflo(xq.w), bfhi(xq.w)}, g0 = *(const LAS f32x4*)(gp + 16 * ks), g1 = *(const LAS f32x4*)(gp + 16 * ks + 4);
        ss += (x0.x * x0.x + x0.y * x0.y) + (x0.z * x0.z + x0.w * x0.w) + (x1.x * x1.x + x1.y * x1.y) + (x1.z * x1.z + x1.w * x1.w);
        const f32x4 a0 = x0 * g0, a1 = x1 * g1;
        v4u hv, lv;
        hv.x = pg8::cvt_pk_bf16(a0.x, a0.y); hv.y = pg8::cvt_pk_bf16(a0.z, a0.w); hv.z = pg8::cvt_pk_bf16(a1.x, a1.y); hv.w = pg8::cvt_pk_bf16(a1.z, a1.w);
        lv.x = pg8::cvt_pk_bf16(a0.x - bflo(hv.x), a0.y - bfhi(hv.x)); lv.y = pg8::cvt_pk_bf16(a0.z - bflo(hv.y), a0.w - bfhi(hv.y));
        lv.z = pg8::cvt_pk_bf16(a1.x - bflo(hv.z), a1.y - bfhi(hv.z)); lv.w = pg8::cvt_pk_bf16(a1.z - bflo(hv.w), a1.w - bfhi(hv.w));
        *(v4u*)(xo + 16 * ks) = hv;
        const s8v xh = __builtin_bit_cast(s8v, hv), xl = __builtin_bit_cast(s8v, lv);
        v4u ah, al; { const LAS v2u* p = (const LAS v2u*)(whp + 16 * ks); const v2u q0 = p[0], q1 = p[1]; ah.x = q0.x; ah.y = q0.y; ah.z = q1.x; ah.w = q1.y; }
        { const LAS v2u* p = (const LAS v2u*)(wlp + 16 * ks); const v2u q0 = p[0], q1 = p[1]; al.x = q0.x; al.y = q0.y; al.z = q1.x; al.w = q1.y; }
        const s8v wa = __builtin_bit_cast(s8v, ah), wb = __builtin_bit_cast(s8v, al);
        acc = __builtin_amdgcn_mfma_f32_32x32x16_bf16(wa, xh, acc, 0, 0, 0);
        acc = __builtin_amdgcn_mfma_f32_32x32x16_bf16(wb, xh, acc, 0, 0, 0);
        acc = __builtin_amdgcn_mfma_f32_32x32x16_bf16(wa, xl, acc, 0, 0, 0);
    }
    __syncthreads();
    LAS float* part = (LAS float*)F.lds;
#pragma unroll
    for (int i = 0; i < 16; ++i) part[(F.wave * 17 + i) * 64 + lane] = acc[i];
    part[(F.wave * 17 + 16) * 64 + lane] = ss;
    __syncthreads();
    if (kq == 0) {
        float v[32]; float st = 0.f;
#pragma unroll
        for (int w = 0; w < 4; ++w) { const LAS float* pw = part + (size_t)((task * 4 + w) * 17) * 64;
#pragma unroll
            for (int i = 0; i < 16; ++i) { const float t = pw[i * 64 + lane]; v[i] = w == 0 ? t : v[i] + t; }
            st += pw[16 * 64 + lane] + pw[16 * 64 + (lane ^ 32)]; }
        const float rstd = 1.0f / sqrtf(st * (1.f / D) + EPS);
        if (hh == 0) RS[tok] = rstd;
#pragma unroll
        for (int i = 0; i < 16; ++i) { const int e = (i & 3) + 8 * (i >> 2) + 4 * hh; v[i] = v[i] * rstd + br[e]; }
#pragma unroll
        for (int i = 0; i < 16; ++i) v[16 + i] = __shfl_xor(v[i], 32);
        float mx = v[0];
#pragma unroll
        for (int i = 1; i < 32; ++i) mx = fmaxf(mx, v[i]);
        int rk[16]; float es = 0.f;
#pragma unroll
        for (int i = 0; i < 16; ++i) { const int ei = (i & 3) + 8 * (i >> 2) + 4 * hh; int rank = 0;
#pragma unroll
            for (int j = 0; j < 32; ++j) { if (j == i) continue; const int ej = (j & 3) + 8 * ((j & 15) >> 2) + 4 * (j < 16 ? hh : 1 - hh);
                rank += (v[j] > v[i] || (v[j] == v[i] && ej < ei)) ? 1 : 0; }
            rk[i] = rank; if (rank < TOPK) es += fexp2((v[i] - mx) * LOG2E); }
        es += __shfl_xor(es, 32);
        const float inv = 1.0f / es;
#pragma unroll
        for (int i = 0; i < 16; ++i) if (rk[i] < TOPK) { const int ei = (i & 3) + 8 * (i >> 2) + 4 * hh;
            gates[tok * TOPK + rk[i]] = fexp2((v[i] - mx) * LOG2E) * inv;
            const int pos = __hip_atomic_fetch_add(lcnt + ei, 1, __ATOMIC_RELAXED, __HIP_MEMORY_SCOPE_WORKGROUP);
            asg[(task * 32 + r) * 4 + rk[i]] = ei | (pos << 8); }
    }
    __syncthreads();
    if (tid < 32) lbase[tid] = (int)__hip_atomic_fetch_add(gcnt + tid, (unsigned)lcnt[tid], RLX_AGENT);
    __syncthreads();
    if (tid < 64 * TOPK) { const int a = asg[tid], e = a & 255, pos = a >> 8; const int tk = F.vcu * 64 + (tid >> 2);
        lists[e * M + lbase[e] + pos] = tk * TOPK + (tid & 3); }
    __syncthreads();
}

__device__ __forceinline__ void moe_tables(Frame& F) {
    LAS int* tab = (LAS int*)(F.lds + TAB_OFF); LAS int* cnt = tab, * mt = tab + 32, * tbase = tab + 64;
    unsigned* gcnt = (unsigned*)(F.ctl + CW_CNT);
    if (F.tid < 32) { const int c = (int)__hip_atomic_load(gcnt + F.tid, RLX_AGENT); cnt[F.tid] = c; mt[F.tid] = (c + 255) >> 8; }
    __syncthreads();
    if (F.tid == 0) { int s = 0; for (int e = 0; e < NE; ++e) { tbase[e] = s; s += mt[e]; } tbase[NE] = s; }
    __syncthreads();
}
__device__ __forceinline__ void moe_units(Frame& F, int npn, int gpn) {
    LAS int* tab = (LAS int*)(F.lds + TAB_OFF); LAS int* mt = tab + 32, * tbase = tab + 64; LAS int* units = (LAS int*)(F.lds + UNITS_OFF);
    if (F.tid < 32) {
        const int nU = tbase[NE] * npn; const int L = F.tid * F.G + (int)blockIdx.x; int pm = 0, pn = 0, e = 0, valid = 0;
        if (L < nU) { const int seq = pg8::xcd_remap(L, nU); int ee = 0; while (ee < NE - 1 && seq >= tbase[ee + 1] * npn) ++ee;
            const int r = seq - tbase[ee] * npn, m = mt[ee]; const int grp = r / (m * gpn), r2 = r % (m * gpn);
            e = ee; pn = grp * gpn + r2 / m; pm = tbase[ee] + r2 % m; valid = 1; }
        units[4 * F.tid + 0] = pm; units[4 * F.tid + 1] = pn; units[4 * F.tid + 2] = e; units[4 * F.tid + 3] = valid;
    }
    __syncthreads();
}

__device__ __forceinline__ void moe_gather_tables(Frame& F) {
    LAS int* tab = (LAS int*)(F.lds + TAB_OFF); LAS int* cnt = tab, * tbase = tab + 64; LAS int* units = (LAS int*)(F.lds + UNITS_OFF); LAS int* tokmap = (LAS int*)(F.lds + TOKMAP_OFF);
    const float* gates = (const float*)(F.ws + WS_GATES); const int* lists = (const int*)(F.ws + WS_LISTS); const float* RS = (const float*)(F.ws + WS_RSTD); int* rowinfo = (int*)(F.ws + WS_ROWINFO);
    for (int idx = F.tid; idx < TOKMAP_SLOTS * 256; idx += NWAVES * 64) { const int i = idx >> 8, R = idx & 255; int tk = 0;
        if (units[4 * i + 3]) { const int pm = units[4 * i], e = units[4 * i + 2]; const int li = (pm - tbase[e]) * 256 + R;
            v4u ri = (v4u){0xffffffffu, 0u, 0u, 0u};
            if (li < cnt[e]) { const int slot = lists[e * M + li]; tk = slot >> 2; ri = (v4u){(unsigned)slot, __builtin_bit_cast(unsigned, gates[slot]), __builtin_bit_cast(unsigned, RS[tk]), 0u}; }
            *(v4u*)(rowinfo + 4 * (pm * 256 + R)) = ri; }
        tokmap[idx] = tk; }
    asm volatile("s_waitcnt vmcnt(0)" ::: "memory");
    __syncthreads();
}

__device__ __forceinline__ void final_phase(Frame& F) {
    const bf16* YB = (const bf16*)(F.ws + WS_YBUF); const float* gf = F.in[24]; float* O = F.out;
    const int gw = F.vcu * NWAVES + F.wave, NGW = F.G * NWAVES, lane = F.lane;
    f32x4 gg[4];
#pragma unroll
    for (int j = 0; j < 4; ++j) gg[j] = *(const f32x4*)(gf + 4 * lane + 256 * j);
    for (int m = gw; m < M; m += NGW) {
        f32x4 v[4]; float ss = 0.f;
#pragma unroll
        for (int j = 0; j < 4; ++j) { { const v2u xw = *(const v2u*)(x1_row(F.ws, m) + 4 * lane + 256 * j); v[j] = (f32x4){bflo(xw.x), bfhi(xw.x), bflo(xw.y), bfhi(xw.y)}; }
#pragma unroll
            for (int k = 0; k < (DBG_MODE ? 0 : TOPK); ++k) { const v2u w = *(const v2u*)(YB + ((size_t)m * TOPK + k) * D + 4 * lane + 256 * j); v[j].x += bflo(w.x); v[j].y += bfhi(w.x); v[j].z += bflo(w.y); v[j].w += bfhi(w.y); }
            ss += (v[j].x * v[j].x + v[j].y * v[j].y) + (v[j].z * v[j].z + v[j].w * v[j].w); }
        const float rstd = 1.0f / sqrtf(wave_sum(ss) * (1.f / D) + EPS);
#pragma unroll
        for (int j = 0; j < 4; ++j) *(f32x4*)(O + (size_t)m * D + 4 * lane + 256 * j) = v[j] * rstd * gg[j];
    }
}

struct Args { const float* in[25]; float* out; unsigned char* ws; int ph_lo, ph_hi, li, pad; };
__global__ void __launch_bounds__(NWAVES * 64, 2) hyb_fwd(Args args) {
    extern __shared__ __attribute__((aligned(16))) unsigned char lds[];
    Frame F;
    F.lds = (LAS unsigned char*)lds;
    F.MISC = (volatile LAS unsigned*)(F.lds + MISC_OFF);
    F.tid = threadIdx.x; F.lane = F.tid & 63; F.wave = __builtin_amdgcn_readfirstlane(F.tid >> 6);
    F.G = gridDim.x; { const int bx = blockIdx.x; F.vcu = (F.G % 8 == 0) ? (bx % 8) * (F.G / 8) + bx / 8 : bx; }
    F.ws = args.ws; F.ctl = (gu32*)(args.ws + WS_CTL); F.out = args.out;
#pragma unroll
    for (int i = 0; i < 25; ++i) F.in[i] = args.in[i];
    for (int u = F.tid; u < (LDS_BYTES - LDSCTL_OFF) / 4; u += NWAVES * 64) ((LAS unsigned*)(F.lds + LDSCTL_OFF))[u] = 0u;
    __syncthreads();
    XcdBarrier bar; bar.bar = (unsigned*)(F.ctl + CW_BAR); bar.x = 0; bar.st = nullptr; bar.G = gridDim.x;
    if (N_LAUNCHES != PER_PHASE) bar = xcd_barrier_post((unsigned*)(F.ctl + CW_BAR), F.MISC + 8, gridDim.x);
#define GRID_BAR(seam) do { if (N_LAUNCHES == PER_PHASE) { if (F.tid == 0) __hip_atomic_store(F.ctl + CW_TMO, 0xBADBA0u | (unsigned)(seam), RLX_AGENT); } else { xcd_barrier(bar); } } while (0)
    const int lo = args.ph_lo, hi = args.ph_hi;
#define IN(k) (lo <= (k) && (k) < hi)
#define BOTH(k) (IN(k) && IN((k) + 1))
    const pg8::bf16_t* wsb = (const pg8::bf16_t*)args.ws;
#define WSB(off) ((const pg8::bf16_t*)(args.ws + (off)))

    unsigned long long t_lo_ = 0, t_hi_ = 0;
    TMARK(0);
    if (IN(0)) {   }

    TMARK(1);
    if (IN(1)) for (int rep_ = 0; rep_ < NREP(1); ++rep_) {
        const int bx = (int)blockIdx.x; const bool gemm_wg = ((bx >> 3) & 1) == 0;
        pg8::Gemm g = pg8::make_gemm(WSB(WS_HN), WSB(WS_WINT), D, D, D); InProjOrder S{gemm_wg ? F.G / 2 : F.G, gemm_wg ? ((bx >> 4) * 8 + (bx & 7)) : 512};
        EpiInProj E{(unsigned short*)(args.ws + WS_Q), (bf16*)(args.ws + WS_UCAT), LOG2E * 0.125f};
        if (gemm_wg) { XcdBarrier bar2 = xcd_barrier_post((unsigned*)(F.ctl + CW_BAR2), F.MISC + 10, (unsigned)(F.G / 2));
            p0_prologue(F, t_lo_, t_hi_);
            xcd_barrier(bar2); }
        pg8::gemm_phase<EpiInProj, InProjOrder, PG8_ALIGN, PG8_SP2>(F.lds + RING_OFF, g, S, E);
        p1_side(F, (!gemm_wg && ((bx >> 4) & 3) == 0) ? ((bx >> 6) * 8 + (bx & 7)) : -1);
        if (BOTH(1)) GRID_BAR(1);
    }
    TMARK(2);
    if (IN(2)) for (int rep_ = 0; rep_ < NREP(2); ++rep_) {
        pg8::Gemm g = pg8::make_gemm(WSB(WS_UCAT), WSB(WS_WE), NG * UK, 512, 512); SsmOrder S{NG * 2, F.G, (int)blockIdx.x, 1, 128, 512};
        EpiSloc E{(float*)(args.ws + WS_SLOC)};
        pg8::gemm_phase<EpiSloc, SsmOrder, PG8_ALIGN, PG8_SP2>(F.lds + RING_OFF, g, S, E);
        if (blockIdx.x >= NG * 2) attn_one(F, ((int)blockIdx.x - NG * 2) * 8 + F.wave);
        if (BOTH(2)) GRID_BAR(2);
    }
    TMARK(3);
    if (IN(3)) for (int rep_ = 0; rep_ < NREP(3); ++rep_) {
        if (F.vcu < BATCH * NG) { if (F.wave == 0) scan_phase(F); else attn_one(F, 3072 + F.vcu * 7 + F.wave - 1); }
        else attn_one(F, 1536 + (F.vcu - BATCH * NG) * 8 + F.wave);
        if (BOTH(3)) GRID_BAR(3); }
    TMARK(4);
    if (IN(4)) for (int rep_ = 0; rep_ < NREP(4); ++rep_) {
        pg8::Gemm g = pg8::make_gemm(WSB(WS_UCAT), WSB(WS_TW), NG * UK, UK, UK); SsmOrder S{NG * 4, F.G, (int)blockIdx.x, 2, 512, UK};
        EpiS3 E{(bf16*)(args.ws + WS_YG)};
        pg8::gemm_phase<EpiS3, SsmOrder, PG8_ALIGN, PG8_SP2>(F.lds + RING_OFF, g, S, E);
        if (blockIdx.x >= NG * 4 && blockIdx.x < NG * 4 + 72) attn_one(F, 3520 + ((int)blockIdx.x - NG * 4) * 8 + F.wave);
        if (BOTH(4)) GRID_BAR(4);
    }
    TMARK(5);
    if (IN(5)) for (int rep_ = 0; rep_ < NREP(5); ++rep_) {
        pg8::Gemm g = pg8::make_gemm(WSB(WS_YG), WSB(WS_WGLUT), SSW, SSW, SSW); pg8::StaticOrder S; S.init(M, 2 * SSW, F.G, (int)blockIdx.x, SSW, SSW);
        EpiGlu E{(bf16*)(args.ws + WS_YSSM)};
        pg8::gemm_phase<EpiGlu, pg8::StaticOrder, PG8_ALIGN, PG8_SP2>(F.lds + RING_OFF, g, S, E);
        if (BOTH(5)) GRID_BAR(5);
    }
    TMARK(6);
    if (IN(6)) for (int rep_ = 0; rep_ < NREP(6); ++rep_) { mix_phase(F); if (BOTH(6)) GRID_BAR(6); }
    TMARK(7);
    if (IN(7)) for (int rep_ = 0; rep_ < NREP(7); ++rep_) {
        pg8::Gemm g = pg8::make_gemm(WSB(WS_MIXED), WSB(WS_WOUTT), D, D, D); pg8::StaticOrder S; S.init(M, D, F.G, (int)blockIdx.x, D, D);
        EpiOutProj E{F.in[0], args.ws};
        pg8::gemm_phase<EpiOutProj, pg8::StaticOrder, PG8_ALIGN, PG8_SP2>(F.lds + RING_OFF, g, S, E);
        if (BOTH(7)) GRID_BAR(7);
    }
    TMARK(8);
    if (IN(8) && !DBG_MODE) for (int rep_ = 0; rep_ < NREP(8); ++rep_) { router_phase(F); if (BOTH(8)) GRID_BAR(8); }
    TMARK(9);
    if (IN(9) && !DBG_MODE) for (int rep_ = 0; rep_ < NREP(9); ++rep_) {   }
    TMARK(10);
    if (IN(10) && !DBG_MODE) for (int rep_ = 0; rep_ < NREP(10); ++rep_) {
        moe_tables(F); moe_units(F, 8, 4); moe_gather_tables(F);
        pg8::Gemm g = pg8::make_gemm(WSB(WS_XN), WSB(WS_W1T), D, D, D); g.brs = 16u; g.bks = 2u * FF * 16u; g.tokmap = (const PG8_LAS int*)(F.lds + TOKMAP_OFF);
        MoeOrder S{(const LAS int*)(F.lds + UNITS_OFF), (long)2 * FF * D * 2, 1};
        EpiMoe1 E{(bf16*)(args.ws + WS_H), F.in[19], F.in[21], (const int*)(args.ws + WS_ROWINFO)};
        pg8::gemm_phase<EpiMoe1, MoeOrder, PG8_ALIGN, PG8_SP2, true>(F.lds + RING_OFF, g, S, E);
        if (BOTH(10)) GRID_BAR(10);
    }
    TMARK(11);
    if (IN(11) && !DBG_MODE) for (int rep_ = 0; rep_ < NREP(11); ++rep_) {
        moe_tables(F); moe_units(F, 4, 4);
        pg8::Gemm g = pg8::make_gemm(WSB(WS_H), WSB(WS_W2T), FF, FF, FF); g.brs = 16u; g.bks = (unsigned)D * 16u; MoeOrder S{(const LAS int*)(F.lds + UNITS_OFF), (long)D * FF * 2, 0};
        EpiMoe2 E{(bf16*)(args.ws + WS_YBUF), F.in[23], (const int*)(args.ws + WS_ROWINFO)};
        pg8::gemm_phase<EpiMoe2, MoeOrder, PG8_ALIGN, PG8_SP2>(F.lds + RING_OFF, g, S, E);
        if (BOTH(11)) GRID_BAR(11);
    }
    TMARK(12);
    if (IN(12)) for (int rep_ = 0; rep_ < NREP(12); ++rep_) { final_phase(F); }
    TMARK(13);
    if ((TIME_LO) >= 0 && blockIdx.x == (TIME_BLK) && F.tid == 0) { const unsigned long long te = __builtin_amdgcn_s_memrealtime(), dt = 4ull * (t_hi_ - t_lo_); while (__builtin_amdgcn_s_memrealtime() - te < dt) __builtin_amdgcn_s_sleep(32); }
    (void)wsb;
#undef IN
#undef BOTH
}

extern "C" void kernel_launch(void* const* d_in, const int* in_sizes, int n_in, void* d_out, int out_size, void* d_ws, size_t ws_size, hipStream_t stream) {
    static int grid = 0;
    if (grid == 0) {
        if (n_in != 25 || in_sizes[0] != M * D || out_size != M * D || ws_size < WS_END) { fprintf(stderr, "kernel_launch: unexpected shapes: n_in %d in0 %d out %d ws %zu (need %zu); nothing launched\n", n_in, n_in > 0 ? in_sizes[0] : -1, out_size, ws_size, (size_t)WS_END); grid = -1; return; }
        int dev = 0, cus = 0, per_cu = 0;
        if (hipGetDevice(&dev) != hipSuccess || hipDeviceGetAttribute(&cus, hipDeviceAttributeMultiprocessorCount, dev) != hipSuccess) { grid = -1; return; }
        if (hipFuncSetAttribute((const void*)hyb_fwd, hipFuncAttributeMaxDynamicSharedMemorySize, LDS_BYTES) != hipSuccess) { fprintf(stderr, "kernel_launch: hipFuncSetAttribute failed\n"); grid = -1; return; }
        if (hipOccupancyMaxActiveBlocksPerMultiprocessor(&per_cu, (const void*)hyb_fwd, NWAVES * 64, LDS_BYTES) != hipSuccess || per_cu < 1)
            fprintf(stderr, "kernel_launch: note: occupancy query reports %d workgroups per CU\n", per_cu);
        (void)hipGetLastError();
        grid = cus;
        if (grid != 256) fprintf(stderr, "kernel_launch: note: %d CUs (built for 256)\n", grid);
    }
    if (grid < 0) return;
    if (hipMemsetAsync((char*)d_ws + WS_CTL, 0, CTL_ZERO_BYTES, stream) != hipSuccess) { fprintf(stderr, "kernel_launch: memset failed\n"); return; }
    Args a{};
    for (int i = 0; i < 25; ++i) a.in[i] = (const float*)d_in[i];
    a.out = (float*)d_out; a.ws = (unsigned char*)d_ws;
    for (int li = 0; li < N_LAUNCHES; ++li) {
        a.ph_lo = (N_LAUNCHES == PER_PHASE) ? li : 0; a.ph_hi = (N_LAUNCHES == PER_PHASE) ? li + 1 : PER_PHASE; a.li = li;
        hipLaunchKernelGGL(hyb_fwd, dim3(grid), dim3(NWAVES * 64), LDS_BYTES, stream, a);
        const hipError_t le = hipPeekAtLastError();
        if (le != hipSuccess) { fprintf(stderr, "kernel_launch: launch %d failed: %s\n", li, hipGetErrorName(le)); break; }
    }
}
```

```cpp
#include <hip/hip_runtime.h>
#include <cstdio>
#include <cstdint>
namespace pg8 {
#define PG8_LAS __attribute__((address_space(3)))
typedef unsigned short bf16_t;
typedef short bf16x8 __attribute__((ext_vector_type(8)));
typedef float f32x4 __attribute__((ext_vector_type(4)));
typedef unsigned u32x4 __attribute__((ext_vector_type(4)));
constexpr int BM = 256, BK = 64, HALF = 128, HTB = HALF * BK * 2  , STAGE_BYTES = 8 * HTB, NXCD = 8, WGM = 8;

__host__ __device__ __forceinline__ int lds_byte(int r, int c) { const int st = (r >> 4) * 2 + (c >> 5), rr = r & 15, cc = c & 31, ob = rr * 64 + cc * 2; return st * 1024 + (ob ^ (((ob >> 9) & 1) << 5)); }
__host__ __device__ __forceinline__ void stage_rc(int b, int& R, int& C) { const int st = b / 1024, sb = b % 1024, swz = sb ^ (((sb >> 9) & 1) << 5); R = (st >> 1) * 16 + swz / 64; C = (st & 1) * 32 + (swz % 64) / 2; }
__host__ __device__ __forceinline__ int perm32(int rho) { const int n = rho >> 4, i = rho & 15; return 8 * (i >> 2) + 4 * n + (i & 3); }

struct Unit { int pm, pn, e, slot; long offA, offB; };
struct Gemm { const bf16_t* A; const bf16_t* Bt; int lda, K; unsigned brs, bks; const PG8_LAS int* tokmap; };
__host__ __device__ __forceinline__ Gemm make_gemm(const bf16_t* A, const bf16_t* Bt, int lda, int ldb, int K) { Gemm g; g.A = A; g.Bt = Bt; g.lda = lda; g.K = K; g.brs = (unsigned)ldb * 2u; g.bks = 16u; g.tokmap = nullptr; return g; }

__host__ __device__ __forceinline__ int xcd_remap(int wgid, int nwg) { const int q = nwg / NXCD, r = nwg % NXCD, xcd = wgid % NXCD, off = wgid / NXCD; return (xcd < r ? xcd * (q + 1) : r * (q + 1) + (xcd - r) * q) + off; }

struct StaticOrder {
    int nM, nN, nwg, G, c, lda, ldb;
    __host__ __device__ void init(int M, int N, int G_, int c_, int lda_, int ldb_) { nM = M / BM; nN = N / BM; nwg = nM * nN; G = G_; c = c_; lda = lda_; ldb = ldb_; }
    __host__ __device__ __forceinline__ bool next(int i, Unit& u) const {
        const long L = (long)i * G + c; if (L >= nwg) return false;
        const int wgid = xcd_remap((int)L, nwg);
        const int nig = WGM * nN, gid = wgid / nig, fm = gid * WGM, gsz = (nM - fm) < WGM ? (nM - fm) : WGM;
        u.pm = fm + ((wgid % nig) % gsz); u.pn = (wgid % nig) / gsz; u.e = 0; u.slot = 0;
        u.offA = (long)u.pm * BM * lda * 2; u.offB = (long)u.pn * BM * ldb * 2; return true;
    }
    __device__ __forceinline__ void a_ready(const Unit&) const {}
    __device__ __forceinline__ void done(const Unit&) const {}
};

__device__ __forceinline__ unsigned cvt_pk_bf16(float lo, float hi) { unsigned r; asm volatile("v_cvt_pk_bf16_f32 %0, %1, %2" : "=v"(r) : "v"(lo), "v"(hi)); return r; }
typedef float f32x2 __attribute__((ext_vector_type(2)));

template <class Epi, class Sched, bool ALIGN_EPI = false, bool SP2 = false, bool GATHER = false>
__device__ __forceinline__ void gemm_phase(PG8_LAS unsigned char* lds, const Gemm g, const Sched& S, const Epi& E) {
    static_assert(!GATHER || SP2, "the gather form is written for the two-super-phase loop only");
    const int tid = threadIdx.x, wid = __builtin_amdgcn_readfirstlane(tid >> 6), lane = tid & 63, wr = wid >> 2, wc = wid & 3, fr = lane & 15, fq = lane >> 4;
    const int K = g.K, nt = K / BK;
    unsigned voffA[2], voffB[2]; int RA[2];
#pragma unroll
    for (int i = 0; i < 2; ++i) { int R, C; stage_rc(tid * 16 + i * 8192, R, C); const int Rb = Epi::PERM ? ((R & ~31) + perm32(R & 31)) : R; RA[i] = R;
        voffA[i] = GATHER ? (unsigned)C * 2u : (unsigned)(R * g.lda + C) * 2u; voffB[i] = (unsigned)Rb * g.brs + (unsigned)(C >> 3) * g.bks; }
    const size_t kstepA = (size_t)(BK * 2), kstepB = (size_t)8 * g.bks;
    const size_t hstepA = (size_t)HALF * g.lda * 2, hstepB = (size_t)HALF * g.brs;
    const unsigned ldsw = (unsigned)wid * 1024u;
    const int aoff = lds_byte(wr * 64 + fr, fq * 8), boff = lds_byte(wc * 32 + fr, fq * 8);
#define PG8_SA(b, h) (((b) * 2 + (h)) * HTB)
#define PG8_SB(b, h) ((4 + (b) * 2 + (h)) * HTB)
#define PG8_STAGE(bufoff, gbase, voff) do { _Pragma("unroll") for (int _i = 0; _i < 2; ++_i) \
        __builtin_amdgcn_global_load_lds((const unsigned*)((const char*)(gbase) + (voff)[_i]), (PG8_LAS unsigned*)(lds + (bufoff) + ldsw + _i * 8192), 16, 0, 0); } while (0)
    unsigned ga[2][2], gn[2][2], gw[2][2];
#define PG8_GLOAD(dst, u) do { if constexpr (GATHER) { const PG8_LAS int* _tm = g.tokmap + 256 * (u).slot; _Pragma("unroll") for (int _h = 0; _h < 2; ++_h) _Pragma("unroll") for (int _i = 0; _i < 2; ++_i) \
        dst[_h][_i] = (unsigned)_tm[128 * _h + RA[_i]] * (unsigned)(g.lda * 2) + voffA[_i]; } } while (0)
#define PG8_STAGE_A(bufoff, gbase, half, GX) do { if constexpr (GATHER) { PG8_STAGE(bufoff, gbase, GX[half]); } else { PG8_STAGE(bufoff, (gbase) + (half) * hstepA, voffA); } } while (0)
#define PG8_LDA(dst, b, h) do { _Pragma("unroll") for (int m = 0; m < 4; ++m) _Pragma("unroll") for (int k = 0; k < 2; ++k) dst[m][k] = *(const PG8_LAS bf16x8*)(lds + PG8_SA(b, h) + aoff + m * 2048 + k * 1024); } while (0)
#define PG8_LDB(dst, b, h) do { _Pragma("unroll") for (int n = 0; n < 2; ++n) _Pragma("unroll") for (int k = 0; k < 2; ++k) dst[n][k] = *(const PG8_LAS bf16x8*)(lds + PG8_SB(b, h) + boff + n * 2048 + k * 1024); } while (0)
#define PG8_MMA(ai, bj, At, Bt) do { __builtin_amdgcn_s_setprio(1); _Pragma("unroll") for (int m = 0; m < 4; ++m) _Pragma("unroll") for (int n = 0; n < 2; ++n) _Pragma("unroll") for (int k = 0; k < 2; ++k) \
        acc[ai][bj][m][n] = __builtin_amdgcn_mfma_f32_16x16x32_bf16(Bt[n][k], At[m][k], acc[ai][bj][m][n], 0, 0, 0); __builtin_amdgcn_s_setprio(0); } while (0)
#define PG8_WAIT_V(n) asm volatile("s_waitcnt vmcnt(" #n ")" ::: "memory")
#define PG8_WAIT_L(n) asm volatile("s_waitcnt lgkmcnt(" #n ")" ::: "memory")
#define PG8_BAR __builtin_amdgcn_s_barrier()
#define PG8_SCHED __builtin_amdgcn_sched_barrier(0)
    Unit cur, nxt; int ui = 0;
    if (!S.next(0, cur)) return;
    f32x4 acc[2][2][4][2];
#pragma unroll
    for (int a = 0; a < 2; ++a)
#pragma unroll
        for (int b = 0; b < 2; ++b)
#pragma unroll
            for (int m = 0; m < 4; ++m)
#pragma unroll
                for (int n = 0; n < 2; ++n) acc[a][b][m][n] = (f32x4){0.f, 0.f, 0.f, 0.f};
    bf16x8 At[4][2], B0[2][2], B1[2][2];
    const char* cA = (const char*)g.A + cur.offA; const char* cB = (const char*)g.Bt + cur.offB;
    S.a_ready(cur);
    if constexpr (SP2) {
        PG8_GLOAD(ga, cur);
        PG8_STAGE(PG8_SB(0, 0), cB, voffB); PG8_STAGE(PG8_SB(0, 1), cB + hstepB, voffB); PG8_STAGE_A(PG8_SA(0, 0), cA, 0, ga); PG8_STAGE_A(PG8_SA(0, 1), cA, 1, ga);
        if (wr == 1) PG8_BAR;
        PG8_WAIT_V(2); PG8_BAR;
        PG8_STAGE(PG8_SB(1, 0), cB + kstepB, voffB); PG8_STAGE_A(PG8_SA(1, 0), cA + kstepA, 0, ga); PG8_STAGE(PG8_SB(1, 1), cB + hstepB + kstepB, voffB);
        PG8_WAIT_V(6); PG8_BAR;
    } else {
        PG8_STAGE(PG8_SB(0, 0), cB, voffB); PG8_STAGE(PG8_SA(0, 0), cA, voffA); PG8_STAGE(PG8_SB(0, 1), cB + hstepB, voffB); PG8_STAGE(PG8_SA(0, 1), cA + hstepA, voffA);
        if (wr == 1) PG8_BAR;
        PG8_WAIT_V(4); PG8_BAR;
        PG8_STAGE(PG8_SB(1, 0), cB + kstepB, voffB); PG8_STAGE(PG8_SA(1, 0), cA + kstepA, voffA); PG8_STAGE(PG8_SB(1, 1), cB + hstepB + kstepB, voffB);
        PG8_WAIT_V(6); PG8_BAR;
    }
    for (;;) {
        const bool has_next = S.next(ui + 1, nxt);
        if constexpr (GATHER) { if (has_next) { PG8_GLOAD(gn, nxt); } else { _Pragma("unroll") for (int _h = 0; _h < 2; ++_h) _Pragma("unroll") for (int _i = 0; _i < 2; ++_i) gn[_h][_i] = ga[_h][_i]; } }
        const char* nA = has_next ? (const char*)g.A + nxt.offA : cA; const char* nB = has_next ? (const char*)g.Bt + nxt.offB : cB;
        for (int t = 0; t < nt; t += 2) {
            const bool last = (t == nt - 2);
            const char* a1 = cA + (size_t)(t + 1) * kstepA;
            const char* a2 = last ? nA : cA + (size_t)(t + 2) * kstepA; const char* b2 = last ? nB : cB + (size_t)(t + 2) * kstepB;
            const char* a3 = a2 + kstepA; const char* b3 = b2 + kstepB;
            if (last && has_next) S.a_ready(nxt);
            if constexpr (GATHER) { _Pragma("unroll") for (int _h = 0; _h < 2; ++_h) _Pragma("unroll") for (int _i = 0; _i < 2; ++_i) gw[_h][_i] = last ? gn[_h][_i] : ga[_h][_i]; }
            if constexpr (Epi::MIDK) { if (t == nt / 2) E.mid(acc, cur, wr, wc, fr, fq); }
            if constexpr (SP2) {
            PG8_LDB(B0, 0, 0); PG8_LDB(B1, 0, 1); PG8_SCHED; PG8_LDA(At, 0, 0); PG8_STAGE_A(PG8_SA(1, 1), a1, 1, ga);
            PG8_WAIT_V(8); PG8_WAIT_L(0); PG8_BAR; PG8_MMA(0, 0, At, B0); PG8_MMA(0, 1, At, B1); PG8_BAR; PG8_SCHED;
            PG8_LDA(At, 0, 1); PG8_STAGE(PG8_SB(0, 0), b2, voffB); PG8_STAGE(PG8_SB(0, 1), b2 + hstepB, voffB); PG8_STAGE_A(PG8_SA(0, 0), a2, 0, gw);
            PG8_WAIT_V(8); PG8_WAIT_L(0); PG8_BAR; PG8_MMA(1, 0, At, B0); PG8_MMA(1, 1, At, B1); PG8_BAR; PG8_SCHED;
            PG8_LDB(B0, 1, 0); PG8_LDB(B1, 1, 1); PG8_SCHED; PG8_LDA(At, 1, 0); PG8_STAGE_A(PG8_SA(0, 1), a2, 1, gw);
            PG8_WAIT_V(8); PG8_WAIT_L(0); PG8_BAR; PG8_MMA(0, 0, At, B0); PG8_MMA(0, 1, At, B1); PG8_BAR; PG8_SCHED;
            PG8_LDA(At, 1, 1); PG8_STAGE(PG8_SB(1, 0), b3, voffB); PG8_STAGE(PG8_SB(1, 1), b3 + hstepB, voffB); PG8_STAGE_A(PG8_SA(1, 0), a3, 0, gw);
            PG8_WAIT_V(8); PG8_WAIT_L(0); PG8_BAR; PG8_MMA(1, 0, At, B0); PG8_MMA(1, 1, At, B1); PG8_BAR; PG8_SCHED;
            } else {
            PG8_LDB(B0, 0, 0); PG8_SCHED; PG8_LDA(At, 0, 0); PG8_STAGE(PG8_SA(1, 1), a1 + hstepA, voffA);
            PG8_WAIT_L(8); PG8_BAR; PG8_WAIT_L(0); PG8_MMA(0, 0, At, B0); PG8_BAR; PG8_SCHED;
            PG8_LDB(B1, 0, 1); PG8_STAGE(PG8_SB(0, 0), b2, voffB);
            PG8_BAR; PG8_WAIT_L(0); PG8_MMA(0, 1, At, B1); PG8_BAR;
            PG8_LDA(At, 0, 1); PG8_STAGE(PG8_SA(0, 0), a2, voffA);
            PG8_BAR; PG8_WAIT_L(0); PG8_MMA(1, 0, At, B0); PG8_BAR; PG8_SCHED;
            PG8_STAGE(PG8_SB(0, 1), b2 + hstepB, voffB);
            PG8_WAIT_V(6); PG8_BAR; PG8_MMA(1, 1, At, B1); PG8_BAR;
            PG8_LDB(B0, 1, 0); PG8_SCHED; PG8_LDA(At, 1, 0); PG8_STAGE(PG8_SA(0, 1), a2 + hstepA, voffA);
            PG8_WAIT_L(8); PG8_BAR; PG8_WAIT_L(0); PG8_MMA(0, 0, At, B0); PG8_BAR; PG8_SCHED;
            PG8_LDB(B1, 1, 1); PG8_STAGE(PG8_SB(1, 0), b3, voffB);
            PG8_BAR; PG8_WAIT_L(0); PG8_MMA(0, 1, At, B1); PG8_BAR;
            PG8_LDA(At, 1, 1); PG8_STAGE(PG8_SA(1, 0), a3, voffA);
            PG8_BAR; PG8_WAIT_L(0); PG8_MMA(1, 0, At, B0); PG8_BAR; PG8_SCHED;
            PG8_STAGE(PG8_SB(1, 1), b3 + hstepB, voffB);
            PG8_WAIT_V(6); PG8_BAR; PG8_MMA(1, 1, At, B1); PG8_BAR;
            }
        }
        if constexpr (ALIGN_EPI) { if (wr == 0) PG8_BAR; }
        if constexpr (!Epi::AFTER_DRAIN) { E(acc, cur, wr, wc, fr, fq); S.done(cur); }
        if (!has_next) break;
#pragma unroll
        for (int a = 0; a < 2; ++a)
#pragma unroll
            for (int b = 0; b < 2; ++b)
#pragma unroll
                for (int m = 0; m < 4; ++m)
#pragma unroll
                    for (int n = 0; n < 2; ++n) acc[a][b][m][n] = (f32x4){0.f, 0.f, 0.f, 0.f};
        cur = nxt; cA = nA; cB = nB; ++ui;
        if constexpr (GATHER) { _Pragma("unroll") for (int _h = 0; _h < 2; ++_h) _Pragma("unroll") for (int _i = 0; _i < 2; ++_i) ga[_h][_i] = gn[_h][_i]; }
        if constexpr (ALIGN_EPI) { if (wr == 1) PG8_BAR; }
    }
    PG8_WAIT_V(0);
    if constexpr (!ALIGN_EPI) { if (wr == 0) PG8_BAR; }
    PG8_BAR;
    if constexpr (Epi::AFTER_DRAIN) { E.fused(acc, cur, wr, wc, fr, fq, lds, wid, lane); S.done(cur); }
#undef PG8_SA
#undef PG8_SB
#undef PG8_STAGE
#undef PG8_STAGE_A
#undef PG8_GLOAD
#undef PG8_LDA
#undef PG8_LDB
#undef PG8_MMA
#undef PG8_WAIT_V
#undef PG8_WAIT_L
#undef PG8_BAR
#undef PG8_SCHED
}
}

#ifndef PG8_SP2
#define PG8_SP2 true
#endif
#ifndef PG8_ALIGN
#define PG8_ALIGN true
#endif

constexpr int NWAVES = 8;
#ifndef MK_N_LAUNCHES
#define MK_N_LAUNCHES 1
#endif
#ifndef DBG_MODE
#define DBG_MODE 0
#endif
#ifndef REP_PHASE
#define REP_PHASE -1
#endif
#define NREP(k) ((REP_PHASE) == (k) ? 2 : 1)
#ifndef TIME_LO
#define TIME_LO -1
#endif
#ifndef TIME_HI
#define TIME_HI -1
#endif
#ifndef TIME_BLK
#define TIME_BLK 0
#endif
#define TMARK(j) do { if ((TIME_LO) >= 0 && blockIdx.x == (TIME_BLK) && F.tid == 0) { if ((j) == (TIME_LO)) t_lo_ = __builtin_amdgcn_s_memrealtime(); if ((j) == (TIME_HI)) t_hi_ = __builtin_amdgcn_s_memrealtime(); } } while (0)
constexpr int PER_PHASE = 13;
constexpr int N_LAUNCHES = MK_N_LAUNCHES;

constexpr int BATCH = 2, SEQ = 8192, D = 1024, M = BATCH * SEQ;
constexpr int SBW = 512, NH = 8, HD = 64;
constexpr int SSW = 512, NG = 32, GC = 16, NP = 64;
constexpr int NPROJ = 3 * SBW + SSW;
constexpr int LC = 32, NCHUNK = M / LC, CPB = SEQ / LC;
constexpr int UK = LC * GC + 2 * NP;
constexpr int NE = 32, TOPK = 4, FF = 1024, NASSIGN = M * TOPK;
constexpr int MAXTILES = (NASSIGN + NE * 255) / 256 + 1;
constexpr float EPS = 1e-5f;
constexpr float LOG2E = 1.4426950408889634f;

constexpr size_t MiB = 1u << 20;
constexpr size_t WS_CTL = 0, CTL_ZERO_BYTES = 1 * MiB;
constexpr size_t WS_LAML = 1 * MiB;
constexpr size_t WS_RSTD = 1 * MiB + 32 * 1024;
constexpr size_t WS_GATES = 1 * MiB + 128 * 1024;
constexpr size_t WS_ROWINFO = 1 * MiB + 512 * 1024;
constexpr size_t WS_RWIMG = 3 * MiB;
constexpr size_t WS_LISTS = 507 * MiB;
constexpr size_t WS_X1LO = 331 * MiB, WS_X1HI = 491 * MiB;
constexpr size_t WS_WINT = 4 * MiB, WS_WGLUT = 8 * MiB, WS_WOUTT = 9 * MiB, WS_W1T = 11 * MiB, WS_W2T = 139 * MiB;
constexpr size_t WS_R1 = 203 * MiB, WS_R2 = 347 * MiB, WS_END = 509 * MiB;
constexpr size_t WS_HN = WS_R1, WS_Q = WS_R1 + 32 * MiB, WS_K = WS_R1 + 48 * MiB, WS_V = WS_R1 + 64 * MiB, WS_UCAT = WS_R1 + 80 * MiB,
                 WS_SLOC = WS_R1 + 100 * MiB, WS_SSQSB = WS_R1 + 108 * MiB  , WS_SSQSSM = WS_R1 + 109 * MiB  , WS_YG = WS_R1 + 124 * MiB;
constexpr size_t WS_YBUF = WS_R1;
constexpr size_t WS_YCAT = WS_R2 + 16 * MiB  , WS_XN = WS_R1  , WS_WE = WS_R2 + 80 * MiB, WS_TW = WS_R2 + 85 * MiB;
constexpr size_t WS_H = WS_R2;
static_assert(WS_K == WS_Q + (size_t)M * SBW * 2 && WS_V == WS_K + (size_t)M * SBW * 2 && WS_YG + (size_t)M * SSW * 2 <= WS_R2 && WS_TW + (size_t)NG * 512 * UK * 2 <= WS_END, "ws map");
static_assert(WS_YBUF + (size_t)NASSIGN * D * 2 <= WS_X1LO && WS_H + (size_t)(MAXTILES - 1) * 256 * FF * 2 <= WS_END, "ws map 2");
static_assert(WS_ROWINFO + (size_t)MAXTILES * 256 * 16 <= 3 * MiB && WS_X1LO >= WS_YBUF + (size_t)NASSIGN * D * 2 && WS_X1LO + 16 * MiB <= WS_R2 && WS_X1HI >= WS_H + (size_t)(MAXTILES - 1) * 256 * FF * 2 && WS_X1HI + 16 * MiB <= WS_LISTS && WS_LISTS + (size_t)NE * M * 4 <= WS_END, "ws map 3");
constexpr int CW_TMO = 0, CW_CODE = 1;
constexpr int CW_BAR = 4096, CW_BAR2 = 8192;
constexpr int CW_CNT = 16384;
constexpr int CW_Q0 = 16384 + 256, CW_Q1 = 16384 + 512, CW_Q2 = 16384 + 576;
constexpr int CW_AQ = 16384 + 320, CW_DONE2 = 16384 + 384, CW_DONE3 = 16384 + 448;

constexpr int RING_OFF = 0, RING_BYTES = 131072;
constexpr int RT_WSTR = 1028;
constexpr int RT_W_BYTES = 2 * NE * RT_WSTR * 2;
constexpr int RT_SCR_OFF = RT_W_BYTES;
constexpr int LDSCTL_OFF = 139264, MISC_OFF = LDSCTL_OFF + 320;
constexpr int TAB_OFF = LDSCTL_OFF + 512;
constexpr int UNITS_OFF = LDSCTL_OFF + 1024;
constexpr int TILEE_OFF = LDSCTL_OFF + 1536;
constexpr int TOKMAP_OFF = LDSCTL_OFF + 4096, TOKMAP_SLOTS = 10;
constexpr int LDS_BYTES = TOKMAP_OFF + TOKMAP_SLOTS * 1024;
static_assert(TILEE_OFF + MAXTILES * 4 <= LDS_BYTES && RT_SCR_OFF + 4096 <= LDSCTL_OFF, "LDS map");

#define GAS __attribute__((address_space(1)))
#define LAS __attribute__((address_space(3)))
typedef unsigned short bf16;
typedef unsigned v4u __attribute__((ext_vector_type(4)));
typedef unsigned v2u __attribute__((ext_vector_type(2)));
typedef float f32x4 __attribute__((ext_vector_type(4)));
typedef float f32x2 __attribute__((ext_vector_type(2)));
typedef _Float16 h16x2 __attribute__((ext_vector_type(2)));
typedef GAS unsigned gu32;
#define RLX_AGENT __ATOMIC_RELAXED, __HIP_MEMORY_SCOPE_AGENT
#define LDS_WAIT() asm volatile("s_waitcnt lgkmcnt(0)" ::: "memory")
#define VM_WAIT() asm volatile("s_waitcnt vmcnt(0)" ::: "memory")
__device__ __forceinline__ unsigned f2bf(float f) { unsigned u = __builtin_bit_cast(unsigned, f); return (u + 0x7fffu + ((u >> 16) & 1u)) >> 16; }
__device__ __forceinline__ unsigned pk2(float lo, float hi) { return f2bf(lo) | (f2bf(hi) << 16); }
__device__ __forceinline__ float bf2f(unsigned short b) { return __builtin_bit_cast(float, (unsigned)b << 16); }
__device__ __forceinline__ float bflo(unsigned w) { return __builtin_bit_cast(float, w << 16); }
__device__ __forceinline__ float bfhi(unsigned w) { return __builtin_bit_cast(float, w & 0xffff0000u); }
__device__ __forceinline__ unsigned pkh2(float lo, float hi) { h16x2 v; v.x = (_Float16)lo; v.y = (_Float16)hi; return __builtin_bit_cast(unsigned, v); }
__device__ __forceinline__ float fexp2(float x) { return __builtin_amdgcn_exp2f(x); }
__device__ __forceinline__ float flog2(float x) { return __builtin_amdgcn_logf(x); }
__device__ __forceinline__ float frcp(float x) { return __builtin_amdgcn_rcpf(x); }
__device__ __forceinline__ float sigmoidf_(float x) { return frcp(1.0f + fexp2(-LOG2E * x)); }
__device__ __forceinline__ float gelu_tanh(float v) { const float u = 0.7978845608028654f * (v + 0.044715f * v * v * v); return v * frcp(1.0f + fexp2(-2.0f * LOG2E * u)); }

__device__ __forceinline__ bf16* x1_row(unsigned char* ws, int m) { return (bf16*)(ws + (m < SEQ ? WS_X1LO : WS_X1HI - (size_t)SEQ * D * 2)) + (size_t)m * D; }
#define XB_TMO      128
#define XB_XCNT(j)  (256  + 64 * (j))
#define XB_XSUB(j)  (1280 + 64 * (j))
#define XB_XGEN(j)  (2304 + 64 * (j))
#define XB_TOP      3328
#define XB_TOPGEN   3392
#define XCD_BAR_WORDS 3456
#define XB_SPIN_CAP (1u << 18)
__device__ __forceinline__ unsigned xb_ld(unsigned* p)              { return __hip_atomic_load(p, __ATOMIC_RELAXED, __HIP_MEMORY_SCOPE_AGENT); }
__device__ __forceinline__ unsigned xb_add(unsigned* p, unsigned v) { return __hip_atomic_fetch_add(p, v, __ATOMIC_RELAXED, __HIP_MEMORY_SCOPE_AGENT); }
__device__ __forceinline__ unsigned xb_xcc_id() { return (unsigned)__builtin_amdgcn_s_getreg((3 << 11) | 20) & 0xFu; }
#define XB_SPIN(cond, bar) do { unsigned _sp = 0; while (cond) { __builtin_amdgcn_s_sleep(1); \
    if ((++_sp & 255u) == 0u) { if (xb_ld(&(bar)[XB_TMO])) break; if (_sp > XB_SPIN_CAP) { atomicAdd(&(bar)[XB_TMO], 1u); break; } } } } while (0)
struct XcdBarrier { unsigned* bar; unsigned x; volatile LAS unsigned* st; unsigned G; };
__device__ __forceinline__ XcdBarrier xcd_barrier_post(unsigned* bar, volatile LAS unsigned* st, unsigned G) {
    XcdBarrier b; b.bar = bar; b.x = xb_xcc_id(); b.st = st; b.G = G;
    if (threadIdx.x == 0) (void)xb_add(&bar[XB_XCNT(b.x)], 1u);
    return b;
}
__device__ __forceinline__ void xcd_barrier_complete(unsigned* bar, unsigned x, unsigned G, unsigned& nloc, unsigned& nx) {
    unsigned sum, cnt, mine, sp = 0u;
    for (;;) {
        sum = 0u; cnt = 0u; mine = 0u;
#pragma unroll
        for (unsigned j = 0; j < 16; ++j) { const unsigned c = xb_ld(&bar[XB_XCNT(j)]); sum += c; cnt += (c > 0u) ? 1u : 0u; mine = (j == x) ? c : mine; }
        if (sum == G) break;
        __builtin_amdgcn_s_sleep(1);
        if ((++sp & 255u) == 0u) { if (xb_ld(&bar[XB_TMO])) break; if (sp > XB_SPIN_CAP) { atomicAdd(&bar[XB_TMO], 1u); break; } }
    }
    nloc = mine > 0u ? mine : 1u; nx = cnt > 0u ? cnt : 1u;
}
__device__ __forceinline__ void xcd_barrier(const XcdBarrier& b) {
    asm volatile("s_waitcnt vmcnt(0)" ::: "memory");
    __syncthreads();
    if (threadIdx.x == 0) {
        unsigned* bar = b.bar;
        __builtin_amdgcn_s_waitcnt(0);
        unsigned nloc = b.st[0], nx = b.st[1];
        if (nloc == 0u) { xcd_barrier_complete(bar, b.x, b.G, nloc, nx); b.st[0] = nloc; b.st[1] = nx; }
        const unsigned old = xb_add(&bar[XB_XSUB(b.x)], 1u);
        const unsigned gen = old / nloc;
        if (old + 1u == (gen + 1u) * nloc) {
            __builtin_amdgcn_fence(__ATOMIC_RELEASE, "agent");
            asm volatile("s_waitcnt vmcnt(0)" ::: "memory");
            const unsigned og = xb_add(&bar[XB_TOP], 1u);
            const unsigned tg = og / nx;
            if (og + 1u == (tg + 1u) * nx) xb_add(&bar[XB_TOPGEN], 1u);
            else XB_SPIN(xb_ld(&bar[XB_TOPGEN]) == tg, bar);
            __builtin_amdgcn_fence(__ATOMIC_ACQUIRE, "agent");
            xb_add(&bar[XB_XGEN(b.x)], 1u);
            asm volatile("s_waitcnt vmcnt(0)" ::: "memory");
        } else {
            XB_SPIN(xb_ld(&bar[XB_XGEN(b.x)]) == gen, bar);
            __builtin_amdgcn_fence(__ATOMIC_ACQUIRE, "agent");
            asm volatile("s_waitcnt vmcnt(0)" ::: "memory");
        }
    }
    __syncthreads();
}

struct Frame {
    LAS unsigned char* lds;
    volatile LAS unsigned* MISC;
    gu32* ctl;
    int tid, lane, wave;
    int vcu, G;
    unsigned char* ws;
    const float* in[25];
    float* out;
};

__device__ __forceinline__ float wave_sum(float v) {
#pragma unroll
    for (int o = 1; o < 64; o <<= 1) v += __shfl_xor(v, o);
    return v;
}

using pg8::Unit;
typedef pg8::f32x4 accv;
struct EpiInProj {
    static constexpr bool PERM = true, AFTER_DRAIN = false; static constexpr bool MIDK = false;
    unsigned short* QKV; bf16* U; float qscale;
    __device__ __forceinline__ void operator()(const accv (&acc)[2][2][4][2], const Unit& u, int wr, int wc, int fr, int fq) const {
        if (u.e == 1) {
            const int row0 = u.pm * 256 + wr * 64 + fr; const int colt = u.pn * 256 + wc * 32 + 8 * fq;
            _Float16* VT = (_Float16*)(QKV + (size_t)2 * M * SBW);
#pragma unroll
            for (int ai = 0; ai < 2; ++ai)
#pragma unroll
                for (int m = 0; m < 4; ++m) { const int row = row0 + ai * 128 + m * 16;
#pragma unroll
                    for (int bj = 0; bj < 2; ++bj) { const int tok = colt + bj * 128; const accv v0 = acc[ai][bj][m][0], v1 = acc[ai][bj][m][1];
                        const int bb = tok >> 13, sq = tok & (SEQ - 1); const int o = sq & 15;
                        _Float16* p = VT + ((size_t)bb * SBW + row) * SEQ + (sq & ~15) + (o >> 1);
                        v2u w0, w1; w0.x = pkh2(v0[0], v0[1]); w0.y = pkh2(v0[2], v0[3]); w1.x = pkh2(v1[0], v1[1]); w1.y = pkh2(v1[2], v1[3]);
                        *(v2u*)p = w0; *(v2u*)(p + 8) = w1; } }
            return;
        }
        const int kind = u.pn >> 1; const int colt = (u.pn & 1) * 256 + wc * 32 + 8 * fq; const int row0 = u.pm * 256 + wr * 64 + fr;
        unsigned short* T = QKV + (size_t)(kind < 2 ? kind : 0) * ((size_t)M * SBW); const float sc = kind == 0 ? qscale : 1.0f;
#pragma unroll
        for (int ai = 0; ai < 2; ++ai)
#pragma unroll
            for (int m = 0; m < 4; ++m) { const int row = row0 + ai * 128 + m * 16;
#pragma unroll
                for (int bj = 0; bj < 2; ++bj) { const int col = colt + bj * 128; const accv v0 = acc[ai][bj][m][0] * sc, v1 = acc[ai][bj][m][1] * sc; v4u w;
                    if (kind < 2) { w.x = pkh2(v0[0], v0[1]); w.y = pkh2(v0[2], v0[3]); w.z = pkh2(v1[0], v1[1]); w.w = pkh2(v1[2], v1[3]);
                        *(v4u*)(T + (size_t)row * SBW + col) = w; }
                    else { w.x = pg8::cvt_pk_bf16(v0[0], v0[1]); w.y = pg8::cvt_pk_bf16(v0[2], v0[3]); w.z = pg8::cvt_pk_bf16(v1[0], v1[1]); w.w = pg8::cvt_pk_bf16(v1[2], v1[3]);
                        *(v4u*)(U + ((size_t)(row >> 5) * NG + (col >> 4)) * UK + (row & 31) * GC + (col & 15)) = w; } } }
    }
};
struct EpiSloc {
    static constexpr bool PERM = false, AFTER_DRAIN = false; static constexpr bool MIDK = false;
    float* S;
    __device__ __forceinline__ void operator()(const accv (&acc)[2][2][4][2], const Unit& u, int wr, int wc, int fr, int fq) const {
        const int row0 = u.pm * 256 + wr * 64 + fr; const int col0 = wc * 32 + 4 * fq;
#pragma unroll
        for (int ai = 0; ai < 2; ++ai)
#pragma unroll
            for (int m = 0; m < 4; ++m) { const int row = row0 + ai * 128 + m * 16;
#pragma unroll
                for (int n = 0; n < 2; ++n) *(accv*)(S + ((size_t)row * NG + u.e) * 128 + col0 + 16 * n) = acc[ai][0][m][n]; }
    }
};
struct EpiS3 {
    static constexpr bool PERM = true, AFTER_DRAIN = false; static constexpr bool MIDK = false;
    bf16* YG;
    __device__ __forceinline__ void operator()(const accv (&acc)[2][2][4][2], const Unit& u, int wr, int wc, int fr, int fq) const {
        const int row0 = u.pm * 256 + wr * 64 + fr; const int colt = u.pn * 256 + wc * 32 + 8 * fq;
#pragma unroll
        for (int ai = 0; ai < 2; ++ai)
#pragma unroll
            for (int m = 0; m < 4; ++m) { const int row = row0 + ai * 128 + m * 16;
#pragma unroll
                for (int bj = 0; bj < 2; ++bj) { const int col = colt + bj * 128; const accv v0 = acc[ai][bj][m][0], v1 = acc[ai][bj][m][1]; v4u w;
                    w.x = pg8::cvt_pk_bf16(gelu_tanh(v0[0]), gelu_tanh(v0[1])); w.y = pg8::cvt_pk_bf16(gelu_tanh(v0[2]), gelu_tanh(v0[3]));
                    w.z = pg8::cvt_pk_bf16(gelu_tanh(v1[0]), gelu_tanh(v1[1])); w.w = pg8::cvt_pk_bf16(gelu_tanh(v1[2]), gelu_tanh(v1[3]));
                    *(v4u*)(YG + ((size_t)row * LC + (col >> 4)) * SSW + u.e * GC + (col & 15)) = w; } }
    }
};
struct EpiGlu {
    static constexpr bool PERM = true, AFTER_DRAIN = false; static constexpr bool MIDK = false;
    bf16* Y; float* SSQ;
    __device__ __forceinline__ void operator()(const accv (&acc)[2][2][4][2], const Unit& u, int wr, int wc, int fr, int fq) const {
        const int row0 = u.pm * 256 + wr * 64 + fr; const int col = u.pn * 128 + wc * 32 + 8 * fq;
#pragma unroll
        for (int ai = 0; ai < 2; ++ai)
#pragma unroll
            for (int m = 0; m < 4; ++m) { const int row = row0 + ai * 128 + m * 16; float r[8]; float sq = 0.f;
#pragma unroll
                for (int n = 0; n < 2; ++n)
#pragma unroll
                    for (int j = 0; j < 4; ++j) { r[4 * n + j] = acc[ai][0][m][n][j] * sigmoidf_(acc[ai][1][m][n][j]); sq += r[4 * n + j] * r[4 * n + j]; }
                sq += __shfl_xor(sq, 16); sq += __shfl_xor(sq, 32);
                if (fq == 0) SSQ[(size_t)row * 16 + u.pn * 4 + wc] = sq;
                v4u w; w.x = pg8::cvt_pk_bf16(r[0], r[1]); w.y = pg8::cvt_pk_bf16(r[2], r[3]); w.z = pg8::cvt_pk_bf16(r[4], r[5]); w.w = pg8::cvt_pk_bf16(r[6], r[7]);
                *(v4u*)(Y + (size_t)row * D + SBW + col) = w; }
    }
};
struct EpiOutProj {
    static constexpr bool PERM = true, AFTER_DRAIN = false; static constexpr bool MIDK = true;
    const float* X; unsigned char* ws; const LAS float* ratio; const LAS float* fin;
    __device__ __forceinline__ void mid(accv (&acc)[2][2][4][2], const Unit& u, int wr, int wc, int fr, int fq) const {
#pragma unroll
        for (int ai = 0; ai < 2; ++ai)
#pragma unroll
            for (int m = 0; m < 4; ++m) { const float rt = ratio[ai * 128 + wr * 64 + m * 16 + fr];
#pragma unroll
                for (int bj = 0; bj < 2; ++bj)
#pragma unroll
                    for (int n = 0; n < 2; ++n) acc[ai][bj][m][n] *= rt; }
    }
    __device__ __forceinline__ void operator()(const accv (&acc)[2][2][4][2], const Unit& u, int wr, int wc, int fr, int fq) const {
        const int row0 = u.pm * 256 + wr * 64 + fr; const int col0 = u.pn * 256 + wc * 32 + 8 * fq;
#pragma unroll
        for (int ai = 0; ai < 2; ++ai)
#pragma unroll
            for (int m = 0; m < 4; ++m) { const int row = row0 + ai * 128 + m * 16; const float* xr = X + (size_t)row * D + col0; bf16* orow = x1_row(ws, row) + col0; const float fs = fin[ai * 128 + wr * 64 + m * 16 + fr];
#pragma unroll
                for (int bj = 0; bj < 2; ++bj) { const accv x0 = *(const accv*)(xr + bj * 128), x1 = *(const accv*)(xr + bj * 128 + 4); const accv v0 = x0 + acc[ai][bj][m][0] * fs, v1 = x1 + acc[ai][bj][m][1] * fs;
                    v4u w; w.x = pg8::cvt_pk_bf16(v0[0], v0[1]); w.y = pg8::cvt_pk_bf16(v0[2], v0[3]); w.z = pg8::cvt_pk_bf16(v1[0], v1[1]); w.w = pg8::cvt_pk_bf16(v1[2], v1[3]);
                    *(v4u*)(orow + bj * 128) = w; }
                if (m & 1) asm volatile("" ::: "memory"); }
    }
};
struct EpiMoe1 {
    static constexpr bool PERM = true, AFTER_DRAIN = false; static constexpr bool MIDK = false;
    bf16* H; const float* bg; const float* bu; const int* rowinfo;
    __device__ __forceinline__ void operator()(const accv (&acc)[2][2][4][2], const Unit& u, int wr, int wc, int fr, int fq) const {
        const int row0 = u.pm * 256 + wr * 64 + fr; const int col = u.pn * 128 + wc * 32 + 8 * fq;
        float bgv[8], buv[8];
#pragma unroll
        for (int n = 0; n < 2; ++n) { const accv a = *(const accv*)(bg + u.e * FF + col + 4 * n), b = *(const accv*)(bu + u.e * FF + col + 4 * n);
#pragma unroll
            for (int j = 0; j < 4; ++j) { bgv[4 * n + j] = a[j]; buv[4 * n + j] = b[j]; } }
        float rsv[2][4];
#pragma unroll
        for (int ai = 0; ai < 2; ++ai)
#pragma unroll
            for (int m = 0; m < 4; ++m) rsv[ai][m] = __builtin_bit_cast(float, rowinfo[4 * (row0 + ai * 128 + m * 16) + 2]);
#pragma unroll
        for (int ai = 0; ai < 2; ++ai)
#pragma unroll
            for (int m = 0; m < 4; ++m) { const int row = row0 + ai * 128 + m * 16; float r[8]; const float rs = rsv[ai][m];
#pragma unroll
                for (int n = 0; n < 2; ++n)
#pragma unroll
                    for (int j = 0; j < 4; ++j) { const float g = fminf(acc[ai][0][m][n][j] * rs + bgv[4 * n + j], 7.0f); const float up = fminf(fmaxf(acc[ai][1][m][n][j] * rs + buv[4 * n + j], -7.0f), 7.0f);
                        r[4 * n + j] = (up + 1.0f) * g * frcp(1.0f + fexp2(-1.702f * LOG2E * g)); }
                v4u w; w.x = pg8::cvt_pk_bf16(r[0], r[1]); w.y = pg8::cvt_pk_bf16(r[2], r[3]); w.z = pg8::cvt_pk_bf16(r[4], r[5]); w.w = pg8::cvt_pk_bf16(r[6], r[7]);
                *(v4u*)(H + (size_t)row * FF + col) = w; }
    }
};
struct EpiMoe2 {
    static constexpr bool PERM = true, AFTER_DRAIN = false; static constexpr bool MIDK = false;
    bf16* Y; const float* bd; const int* rowinfo;
    __device__ __forceinline__ void operator()(const accv (&acc)[2][2][4][2], const Unit& u, int wr, int wc, int fr, int fq) const {
        const int row0 = u.pm * 256 + wr * 64 + fr; const int colt = u.pn * 256 + wc * 32 + 8 * fq;
        float bv[2][8];
#pragma unroll
        for (int bj = 0; bj < 2; ++bj)
#pragma unroll
            for (int n = 0; n < 2; ++n) { const accv a = *(const accv*)(bd + u.e * D + colt + bj * 128 + 4 * n);
#pragma unroll
                for (int j = 0; j < 4; ++j) bv[bj][4 * n + j] = a[j]; }
        v2u sg[2][4];
#pragma unroll
        for (int ai = 0; ai < 2; ++ai)
#pragma unroll
            for (int m = 0; m < 4; ++m) sg[ai][m] = *(const v2u*)(rowinfo + 4 * (row0 + ai * 128 + m * 16));
#pragma unroll
        for (int ai = 0; ai < 2; ++ai)
#pragma unroll
            for (int m = 0; m < 4; ++m) { const int slot = (int)sg[ai][m].x; const unsigned gbits = sg[ai][m].y; const float gate = __builtin_bit_cast(float, gbits);
                if (slot >= 0) {
#pragma unroll
                    for (int bj = 0; bj < 2; ++bj) { float r[8];
#pragma unroll
                        for (int n = 0; n < 2; ++n)
#pragma unroll
                            for (int j = 0; j < 4; ++j) r[4 * n + j] = (acc[ai][bj][m][n][j] + bv[bj][4 * n + j]) * gate;
                        v4u w; w.x = pg8::cvt_pk_bf16(r[0], r[1]); w.y = pg8::cvt_pk_bf16(r[2], r[3]); w.z = pg8::cvt_pk_bf16(r[4], r[5]); w.w = pg8::cvt_pk_bf16(r[6], r[7]);
                        *(v4u*)(Y + (size_t)slot * D + colt + bj * 128) = w; } } }
    }
};

struct InProjOrder {
    int G, c;
    __device__ bool next(int i, Unit& u) const {
        const int L = i * G + c; if (L >= 512) return false;
        const int s = pg8::xcd_remap(L, 512);
        if (s < 384) { const int grp = s / 48, r = s % 48; u.slot = 0; u.pm = grp * 8 + (r & 7); const int pi = r >> 3; u.pn = pi < 4 ? pi : pi + 2; u.e = 0;
            u.offA = (long)u.pm * 256 * D * 2; u.offB = (long)u.pn * 256 * D * 2; }
        else { const int r = s - 384; u.slot = 0; u.pm = r & 1; u.pn = r >> 1; u.e = 1;
            u.offA = (long)(WS_WINT - WS_HN) + (long)(1024 + u.pm * 256) * D * 2; u.offB = (long)(WS_HN - WS_WINT) + (long)u.pn * 256 * D * 2; }
        return true;
    }
    __device__ __forceinline__ void a_ready(const Unit&) const {}
    __device__ __forceinline__ void done(const Unit&) const {}
};
struct SsmOrder {
    int nwg, G, c, npn, rows_per_g, ldb;
    __device__ bool next(int i, Unit& u) const {
        const int L = i * G + c; if (L >= nwg) return false;
        const int per_g = 2 * npn; const int g = L / per_g, r = L % per_g;
        u.e = g; u.pm = r / npn; u.pn = r % npn; u.slot = 0;
        u.offA = ((long)u.pm * 256 * NG * UK + (long)g * UK) * 2; u.offB = ((long)g * rows_per_g + (long)u.pn * 256) * ldb * 2; return true;
    }
    __device__ __forceinline__ void a_ready(const Unit&) const {}
    __device__ __forceinline__ void done(const Unit&) const {}
};
struct MoeOrder {
    const LAS int* units; long ebytes; int gather;
    __device__ bool next(int i, Unit& u) const {
        if (i >= 32) return false;
        const int v = __builtin_amdgcn_readfirstlane(units[4 * i + 3]); if (!v) return false;
        u.pm = __builtin_amdgcn_readfirstlane(units[4 * i + 0]); u.pn = __builtin_amdgcn_readfirstlane(units[4 * i + 1]); u.e = __builtin_amdgcn_readfirstlane(units[4 * i + 2]);
        u.slot = i; u.offA = gather ? 0l : (long)u.pm * 256 * D * 2; u.offB = (long)u.e * ebytes + (long)u.pn * 256 * 16; return true;
    }
    __device__ __forceinline__ void a_ready(const Unit&) const {}
    __device__ __forceinline__ void done(const Unit&) const {}
};

struct CvItem { const float* src; bf16* dst; const float* kscale; int ldw, K, rmul, radd, k0, n0; };
constexpr int CV_I_IN = (D / 64) * (NPROJ / 32), CV_I_GLU = (SSW / 64) * (SSW / 32), CV_I_OUT = (D / 64) * (D / 32), CV_I_E = (D / 64) * (FF / 32);
constexpr int CV_N_EARLY = CV_I_IN + 2 * CV_I_GLU + CV_I_OUT, CV_N_EXP = 3 * NE * (D / 8);
__device__ __forceinline__ void cv_set(CvItem& c, const float* W, int ldw, int K, int N, bf16* WT, int rmul, int radd, int item) {
    const int nblk = N / 32, kb = item / nblk, nb = item % nblk; c.src = W; c.dst = WT; c.kscale = nullptr; c.ldw = ldw; c.K = K; c.rmul = rmul; c.radd = radd; c.k0 = 64 * kb; c.n0 = 32 * nb;
}
__device__ __forceinline__ void cv_decode_early(Frame& F, int r, CvItem& c) {
    bf16* WinT = (bf16*)(F.ws + WS_WINT); bf16* WgluT = (bf16*)(F.ws + WS_WGLUT); bf16* WoutT = (bf16*)(F.ws + WS_WOUTT);
    if (r < CV_I_IN) { cv_set(c, F.in[2], NPROJ, D, NPROJ, WinT, 1, 0, r); return; } r -= CV_I_IN;
    if (r < CV_I_GLU) { cv_set(c, F.in[11], 2 * SSW, SSW, SSW, WgluT, 2, 0, r); return; } r -= CV_I_GLU;
    if (r < CV_I_GLU) { cv_set(c, F.in[11] + SSW, 2 * SSW, SSW, SSW, WgluT, 2, 128, r); return; } r -= CV_I_GLU;
    cv_set(c, F.in[14], D, D, D, WoutT, 1, 0, r);
    c.kscale = (c.k0 < SBW) ? F.in[12] + c.k0 : F.in[13] + (c.k0 - SBW);
}
__device__ __forceinline__ void cv_decode_exp(Frame& F, int r, CvItem& c) {
    bf16* W1T = (bf16*)(F.ws + WS_W1T); bf16* W2T = (bf16*)(F.ws + WS_W2T);
    const int mat = r / CV_I_E, sub = r % CV_I_E, kind = mat / NE, e = mat % NE;
    if (kind == 0) cv_set(c, F.in[18] + (size_t)e * D * FF, FF, D, FF, W1T + (size_t)e * 2 * FF * D, 2, 0, sub);
    else if (kind == 1) cv_set(c, F.in[20] + (size_t)e * D * FF, FF, D, FF, W1T + (size_t)e * 2 * FF * D, 2, 128, sub);
    else cv_set(c, F.in[22] + (size_t)e * FF * D, D, FF, D, W2T + (size_t)e * D * FF, 1, 0, sub);
}
__device__ __forceinline__ void cv_load(const CvItem& c, int lane, float (&v)[32]) {
    const float* p = c.src + (size_t)(c.k0 + (lane >> 5)) * c.ldw + c.n0 + (lane & 31);
#pragma unroll
    for (int i = 0; i < 32; ++i) v[i] = p[(size_t)(2 * i) * c.ldw];
}
__device__ __forceinline__ void cv_store(const CvItem& c, int lane, const float (&v)[32], LAS float* scr) {
#pragma unroll
    for (int i = 0; i < 32; ++i) scr[(2 * i + (lane >> 5)) * 33 + (lane & 31)] = v[i];
    LDS_WAIT(); asm volatile("" ::: "memory");
    const int cc = lane & 7;
#pragma unroll
    for (int j = 0; j < 4; ++j) { const int nl = (lane >> 3) + 8 * j; const int n = c.n0 + nl; const int drow = (n >> 7) * 128 * c.rmul + c.radd + (n & 127); const LAS float* s = scr + (8 * cc) * 33 + nl;
        float e0 = s[0 * 33], e1 = s[1 * 33], e2 = s[2 * 33], e3 = s[3 * 33], e4 = s[4 * 33], e5 = s[5 * 33], e6 = s[6 * 33], e7 = s[7 * 33];
        if (c.kscale) { const f32x4 ka = *(const f32x4*)(c.kscale + 8 * cc), kb = *(const f32x4*)(c.kscale + 8 * cc + 4); e0 *= ka.x; e1 *= ka.y; e2 *= ka.z; e3 *= ka.w; e4 *= kb.x; e5 *= kb.y; e6 *= kb.z; e7 *= kb.w; }
        v4u o; o.x = pg8::cvt_pk_bf16(e0, e1); o.y = pg8::cvt_pk_bf16(e2, e3); o.z = pg8::cvt_pk_bf16(e4, e5); o.w = pg8::cvt_pk_bf16(e6, e7);
        *(GAS v4u*)(c.dst + (size_t)drow * c.K + c.k0 + 8 * cc) = o; }
    LDS_WAIT(); asm volatile("" ::: "memory");
}
__device__ __forceinline__ void cv_item_early(Frame& F, int it, LAS float* scr) { CvItem c; float v[32]; cv_decode_early(F, it, c); cv_load(c, F.lane, v); cv_store(c, F.lane, v, scr); }
__device__ __forceinline__ void cv_run_early(Frame& F, int first, int stride, int n, LAS float* scr) {
    CvItem ca, cb; float va[32], vb[32];
    int it = first; if (it >= n) return;
    cv_decode_early(F, it, ca);
    cv_load(ca, F.lane, va);
    for (;;) {
        const int nit = it + stride; const bool more = nit < n;
        if (more) { cv_decode_early(F, nit, cb); cv_load(cb, F.lane, vb); }
        cv_store(ca, F.lane, va, scr);
        if (!more) break;
        ca = cb;
#pragma unroll
        for (int i = 0; i < 32; ++i) va[i] = vb[i];
        it = nit;
    }
}
__device__ __forceinline__ void xv_item(Frame& F, int it) {
    bf16* W1T = (bf16*)(F.ws + WS_W1T); bf16* W2T = (bf16*)(F.ws + WS_W2T);
    const float* w0 = F.in[18]; const float* w1 = F.in[20]; const float* w2 = F.in[22];
    asm volatile("" : "+s"(w0), "+s"(w1), "+s"(w2));
    const int lane = F.lane;
    {
        const int mat = it >> 7, kb = it & 127, kind = mat / NE, e = mat % NE;
        const float* src = (kind == 0 ? w0 : (kind == 1 ? w1 : w2)) + (size_t)e * D * FF + (size_t)(kb * 8) * FF + 4 * lane;
        f32x4 v[8][4];
#pragma unroll
        for (int rr = 0; rr < 8; ++rr)
#pragma unroll
            for (int j = 0; j < 4; ++j) v[rr][j] = *(const GAS f32x4*)(src + (size_t)rr * FF + 256 * j);
        bf16* dst; int cstride;
        if (kind < 2) { dst = W1T + (size_t)e * 2 * FF * D + ((size_t)kb * 2 * FF + (size_t)(lane >> 5) * 256 + (kind == 1 ? 128 : 0) + 4 * (lane & 31)) * 8; cstride = 512 * 8; }
        else { dst = W2T + (size_t)e * D * FF + ((size_t)kb * D + 4 * lane) * 8; cstride = 256 * 8; }
#pragma unroll
        for (int j = 0; j < 4; ++j)
#pragma unroll
            for (int c = 0; c < 4; ++c) { v4u o; o.x = pg8::cvt_pk_bf16(v[0][j][c], v[1][j][c]); o.y = pg8::cvt_pk_bf16(v[2][j][c], v[3][j][c]); o.z = pg8::cvt_pk_bf16(v[4][j][c], v[5][j][c]); o.w = pg8::cvt_pk_bf16(v[6][j][c], v[7][j][c]);
                *(GAS v4u*)(dst + (size_t)j * cstride + c * 8) = o; }
    }
}
__device__ __forceinline__ void rms_row_to_bf16(int lane, const float* xrow, const float* g, bf16* orow) {
    const GAS f32x4* xr = (const GAS f32x4*)xrow + lane; const GAS f32x4* gr = (const GAS f32x4*)g + lane;
    f32x4 v[4]; float s = 0.f;
#pragma unroll
    for (int j = 0; j < 4; ++j) { v[j] = xr[64 * j]; s += (v[j].x * v[j].x + v[j].y * v[j].y) + (v[j].z * v[j].z + v[j].w * v[j].w); }
    const float rstd = 1.0f / sqrtf(wave_sum(s) * (1.f / D) + EPS);
    GAS unsigned long long* o8 = (GAS unsigned long long*)orow + lane;
#pragma unroll
    for (int j = 0; j < 4; ++j) { const f32x4 gg = gr[64 * j]; o8[64 * j] = (unsigned long long)pk2(v[j].x * rstd * gg.x, v[j].y * rstd * gg.y) | ((unsigned long long)pk2(v[j].z * rstd * gg.z, v[j].w * rstd * gg.w) << 32); }
}
__device__ __forceinline__ void sincos_acc(float th, float& s, float& c) {
    const float k = rintf(th * 0.15915494309189535f);
    float r = fmaf(-k, 6.28125f, th); r = fmaf(-k, 1.9353071795864769e-3f, r);
    const float x = 0.25f * r, x2 = x * x;
    float sn = x * (1.0f + x2 * (-1.0f / 6 + x2 * (1.0f / 120 + x2 * (-1.0f / 5040 + x2 * (1.0f / 362880 + x2 * (-1.0f / 39916800))))));
    float cs = 1.0f + x2 * (-0.5f + x2 * (1.0f / 24 + x2 * (-1.0f / 720 + x2 * (1.0f / 40320 + x2 * (-1.0f / 3628800 + x2 * (1.0f / 479001600))))));
#pragma unroll
    for (int i = 0; i < 2; ++i) { const float s2 = 2.0f * sn * cs, c2 = 1.0f - 2.0f * sn * sn; sn = s2; cs = c2; }
    s = sn; c = cs;
}
__device__ __forceinline__ void ssm_tables(Frame& F, int g) {
    constexpr int PT = 36, BS = 17, CS = 68, KT = 324, KC = 20;
    LAS float* pwr = (LAS float*)(F.lds);
    LAS float* pwi = pwr + 64 * PT;
    LAS float* bbr = pwi + 64 * PT;
    LAS float* bbi = bbr + 64 * BS;
    LAS float* ccr = bbi + 64 * BS;
    LAS float* cci = ccr + 16 * CS;
    LAS float* km = cci + 16 * CS;
    const float* lam_re = F.in[3]; const float* lam_im = F.in[4]; const float* log_dt = F.in[5];
    const float* b_re = F.in[6]; const float* b_im = F.in[7]; const float* c_re = F.in[8]; const float* c_im = F.in[9]; const float* dsk = F.in[10];
    float* lamL = (float*)(F.ws + WS_LAML); bf16* WE = (bf16*)(F.ws + WS_WE); bf16* TW = (bf16*)(F.ws + WS_TW);
    const int tid = F.tid;
    if (tid < 64) { const int p = tid;
        const float lr = lam_re[g * NP + p], li = lam_im[g * NP + p], dt = expf(log_dt[g]);
        const float er = expf(lr * dt); float sn, cs; sincos_acc(li * dt, sn, cs);
        const float br = er * cs, bi = er * sn;
        const float nr = br - 1.0f, ni = bi, den = 1.0f / (lr * lr + li * li);
        const float fr = (nr * lr + ni * li) * den, fi = (ni * lr - nr * li) * den;
        float pr = 1.0f, pi = 0.0f;
        for (int n = 0; n <= 32; ++n) { pwr[p * PT + n] = pr; pwi[p * PT + n] = pi; const float t = pr * br - pi * bi; pi = pr * bi + pi * br; pr = t; }
        lamL[(g * 2 + 0) * NP + p] = pwr[p * PT + 32]; lamL[(g * 2 + 1) * NP + p] = pwi[p * PT + 32];
        float xr[GC], xi[GC];
#pragma unroll
        for (int c = 0; c < GC; ++c) { xr[c] = b_re[(g * NP + p) * GC + c]; xi[c] = b_im[(g * NP + p) * GC + c]; }
#pragma unroll
        for (int c = 0; c < GC; ++c) { bbr[p * BS + c] = fr * xr[c] - fi * xi[c]; bbi[p * BS + c] = fr * xi[c] + fi * xr[c]; }
    }
    for (int i = tid; i < 1024; i += NWAVES * 64) { ccr[(i >> 6) * CS + (i & 63)] = c_re[g * 1024 + i]; cci[(i >> 6) * CS + (i & 63)] = c_im[g * 1024 + i]; }
    __syncthreads();
    {
        const int pair = tid & 255, co = pair >> 4, ci = pair & 15, t0 = (tid >> 8) * 16;
        float acc[16];
#pragma unroll
        for (int t = 0; t < 16; ++t) acc[t] = 0.f;
        for (int p = 0; p < NP; ++p) { const float cr = ccr[co * CS + p], cim = cci[co * CS + p], xr = bbr[p * BS + ci], xi = bbi[p * BS + ci];
            const float gr = cr * xr - cim * xi, gi = cr * xi + cim * xr;
#pragma unroll
            for (int t4 = 0; t4 < 4; ++t4) { const f32x4 a = *(const LAS f32x4*)(pwr + p * PT + t0 + 4 * t4), bq = *(const LAS f32x4*)(pwi + p * PT + t0 + 4 * t4);
#pragma unroll
                for (int t = 0; t < 4; ++t) acc[4 * t4 + t] += gr * a[t] - gi * bq[t]; } }
#pragma unroll
        for (int t = 0; t < 16; ++t) km[(t0 + t) * KT + co * KC + ci] = acc[t];
    }
    __syncthreads();
    {
        const int n = tid, i = n >> 4, co = n & 15; const float dv = dsk[g * GC + co];
        bf16* dst = TW + ((size_t)g * 512 + n) * UK;
        for (int j = 0; j < LC; ++j) {
            float v[16];
            const LAS float* kr = km + (j <= i ? i - j : 0) * KT + co * KC;
#pragma unroll
            for (int c4 = 0; c4 < 4; ++c4) { const f32x4 q = *(const LAS f32x4*)(kr + 4 * c4);
#pragma unroll
                for (int t = 0; t < 4; ++t) v[4 * c4 + t] = (j <= i) ? q[t] : 0.f; }
            if (j == i) {
#pragma unroll
                for (int ci = 0; ci < 16; ++ci) v[ci] += (ci == co) ? dv : 0.f; }
            v4u o0, o1; o0.x = pg8::cvt_pk_bf16(v[0], v[1]); o0.y = pg8::cvt_pk_bf16(v[2], v[3]); o0.z = pg8::cvt_pk_bf16(v[4], v[5]); o0.w = pg8::cvt_pk_bf16(v[6], v[7]);
            o1.x = pg8::cvt_pk_bf16(v[8], v[9]); o1.y = pg8::cvt_pk_bf16(v[10], v[11]); o1.z = pg8::cvt_pk_bf16(v[12], v[13]); o1.w = pg8::cvt_pk_bf16(v[14], v[15]);
            *(GAS v4u*)(dst + j * 16) = o0; *(GAS v4u*)(dst + j * 16 + 8) = o1; }
        for (int k8 = 0; k8 < 16; ++k8) { float v[8];
            const int ri = k8 >> 3, p0 = 8 * (k8 & 7);
#pragma unroll
            for (int e = 0; e < 8; ++e) { const int p = p0 + e; const float cr = ccr[co * CS + p], cim = cci[co * CS + p], pr = pwr[p * PT + i + 1], pi = pwi[p * PT + i + 1];
                v[e] = ri == 0 ? (cr * pr - cim * pi) : -(cr * pi + cim * pr); }
            v4u o; o.x = pg8::cvt_pk_bf16(v[0], v[1]); o.y = pg8::cvt_pk_bf16(v[2], v[3]); o.z = pg8::cvt_pk_bf16(v[4], v[5]); o.w = pg8::cvt_pk_bf16(v[6], v[7]);
            *(GAS v4u*)(dst + 512 + k8 * 8) = o; }
    }
    {
        const int row = tid & 127, ri = row >> 6, p = row & 63, kq = tid >> 7;
        bf16* dst = WE + ((size_t)g * 128 + row) * 512 + kq * 128;
        for (int k8 = 0; k8 < 16; ++k8) { float v[8];
#pragma unroll
            for (int e = 0; e < 8; ++e) { const int k = kq * 128 + k8 * 8 + e, j = k >> 4, c = k & 15; const float pr = pwr[p * PT + 31 - j], pi = pwi[p * PT + 31 - j], xr = bbr[p * BS + c], xi = bbi[p * BS + c];
                v[e] = ri == 0 ? (pr * xr - pi * xi) : (pr * xi + pi * xr); }
            v4u o; o.x = pg8::cvt_pk_bf16(v[0], v[1]); o.y = pg8::cvt_pk_bf16(v[2], v[3]); o.z = pg8::cvt_pk_bf16(v[4], v[5]); o.w = pg8::cvt_pk_bf16(v[6], v[7]);
            *(GAS v4u*)(dst + k8 * 8) = o; }
    }
    __syncthreads();
}
__device__ __forceinline__ void rms_rows2_to_bf16(int lane, const float* x0, const float* x1, const float* g, bf16* o0, bf16* o1) {
    const GAS f32x4* xa = (const GAS f32x4*)x0 + lane; const GAS f32x4* xb = (const GAS f32x4*)x1 + lane; const GAS f32x4* gr = (const GAS f32x4*)g + lane;
    f32x4 va[4], vb[4]; float sa = 0.f, sb = 0.f;
#pragma unroll
    for (int j = 0; j < 4; ++j) { va[j] = xa[64 * j]; vb[j] = xb[64 * j]; }
#pragma unroll
    for (int j = 0; j < 4; ++j) { sa += (va[j].x * va[j].x + va[j].y * va[j].y) + (va[j].z * va[j].z + va[j].w * va[j].w); sb += (vb[j].x * vb[j].x + vb[j].y * vb[j].y) + (vb[j].z * vb[j].z + vb[j].w * vb[j].w); }
#pragma unroll
    for (int o = 1; o < 64; o <<= 1) { sa += __shfl_xor(sa, o); sb += __shfl_xor(sb, o); }
    const float ra = 1.0f / sqrtf(sa * (1.f / D) + EPS), rb = 1.0f / sqrtf(sb * (1.f / D) + EPS);
    GAS v2u* pa = (GAS v2u*)o0 + lane; GAS v2u* pb = (GAS v2u*)o1 + lane;
#pragma unroll
    for (int j = 0; j < 4; ++j) { const f32x4 gg = gr[64 * j];
        v2u wa, wb; wa.x = pg8::cvt_pk_bf16(va[j].x * ra * gg.x, va[j].y * ra * gg.y); wa.y = pg8::cvt_pk_bf16(va[j].z * ra * gg.z, va[j].w * ra * gg.w);
        wb.x = pg8::cvt_pk_bf16(vb[j].x * rb * gg.x, vb[j].y * rb * gg.y); wb.y = pg8::cvt_pk_bf16(vb[j].z * rb * gg.z, vb[j].w * rb * gg.w);
        pa[64 * j] = wa; pb[64 * j] = wb; }
}
constexpr int CV_N_W1 = 2 * NE * (D / 8);
constexpr int P1_GEMM_WG = 176;
constexpr int Q0_HN = M / 8, Q0_END = Q0_HN + CV_N_EARLY / 4;
static_assert(Q0_END % 8 == 0 && CV_N_EARLY % 4 == 0, "P0 queue");
__device__ __forceinline__ void p0_prologue(Frame& F, unsigned long long& t_lo_, unsigned long long& t_hi_) {
    TMARK(100);
    LAS float* scr = (LAS float*)(F.lds + RING_OFF + F.wave * 16384);
    unsigned* q = (unsigned*)(F.ctl + CW_Q0); volatile LAS unsigned* slot = F.MISC + 16;
    bf16* HN = (bf16*)(F.ws + WS_HN);
    for (;;) {
        __syncthreads();
        if (F.tid == 0) *slot = __hip_atomic_fetch_add(q, 8u, RLX_AGENT);
        __syncthreads();
        const int base = (int)__builtin_amdgcn_readfirstlane(*slot); if (base >= Q0_END) break;
        const int idx = base + F.wave;
        if (idx < Q0_HN) { const int m0 = idx * 8;
#pragma unroll 1
            for (int j = 0; j < 4; ++j) { const int m = m0 + 2 * j; rms_rows2_to_bf16(F.lane, F.in[0] + (size_t)m * D, F.in[0] + (size_t)(m + 1) * D, F.in[1], HN + (size_t)m * D, HN + (size_t)(m + 1) * D); } }
        else { const int g4 = (idx - Q0_HN) * 4;
#pragma unroll 1
            for (int j = 0; j < 4; ++j) cv_item_early(F, g4 + j, scr); }
    }
    TMARK(104);
}
__device__ __forceinline__ void p1_side(Frame& F, int tabler_idx) {
    if (tabler_idx >= 0) { ssm_tables(F, tabler_idx);
        if (tabler_idx == 0 && F.tid < 128) {
            bf16* WE = (bf16*)(F.ws + WS_WE) + (size_t)NG * 128 * 512;
            for (int i = 0; i < 512 / 8; ++i) *(GAS v4u*)(WE + (size_t)F.tid * 512 + i * 8) = (v4u){0u, 0u, 0u, 0u}; }
        if (tabler_idx == 1) {
            const float* wr = F.in[16]; bf16* img = (bf16*)(F.ws + WS_RWIMG);
            for (int idx = F.tid; idx < D * NE; idx += NWAVES * 64) { const float w = wr[idx]; const unsigned h = f2bf(w); const unsigned l = f2bf(w - bf2f((unsigned short)h)); const int k = idx >> 5, e = idx & 31;
                img[e * RT_WSTR + k] = (bf16)h; img[(NE + e) * RT_WSTR + k] = (bf16)l; }
            if (F.tid < 2 * NE) for (int k = D; k < RT_WSTR; ++k) img[F.tid * RT_WSTR + k] = 0; } }
    unsigned* q = (unsigned*)(F.ctl + CW_Q1); volatile LAS unsigned* slot = F.MISC + 18;
    for (;;) {
        __syncthreads();
        if (F.tid == 0) *slot = __hip_atomic_fetch_add(q, 8u, RLX_AGENT);
        __syncthreads();
        const int base = (int)__builtin_amdgcn_readfirstlane(*slot); if (base >= CV_N_W1) break;
        xv_item(F, base + F.wave);
    }
}
__device__ __forceinline__ void w2_drain(Frame& F, int max_claims) {
    unsigned* q = (unsigned*)(F.ctl + CW_Q2); volatile LAS unsigned* slot = F.MISC + 19;
    for (int n = 0; max_claims < 0 || n < max_claims; ++n) {
        __syncthreads();
        if (F.tid == 0) *slot = __hip_atomic_fetch_add(q, 8u, RLX_AGENT);
        __syncthreads();
        const int base = CV_N_W1 + (int)__builtin_amdgcn_readfirstlane(*slot); if (base >= CV_N_EXP) break;
        xv_item(F, base + F.wave);
    }
}

__device__ __forceinline__ void attn_simple_unit(const unsigned short* Qh, const unsigned short* Kh, const unsigned short* Vh, bf16* Y, int b, int h, int qb, int lane) {
    const int t = qb * 64 + lane; const size_t row = (size_t)b * SEQ + t;
    float q[64], o[64];
    { const v4u* qp = (const v4u*)(Qh + row * SBW + h * HD);
#pragma unroll
      for (int i = 0; i < 8; ++i) { const v4u w = qp[i];
#pragma unroll
          for (int j = 0; j < 4; ++j) { const unsigned wj = w[j]; const h16x2 hv = __builtin_bit_cast(h16x2, wj); q[8 * i + 2 * j] = (float)hv.x; q[8 * i + 2 * j + 1] = (float)hv.y; } } }
#pragma unroll
    for (int d = 0; d < 64; ++d) o[d] = 0.f;
    float cum = 0.f;
    for (int s = qb * 64 + 62; s >= 0; --s) {
        const size_t krow = ((size_t)b * SEQ + s) * SBW + h * HD;
        const v4u* kp = (const v4u*)(Kh + krow); const v4u* vp = (const v4u*)(Vh + krow);
        float z = 0.f;
#pragma unroll
        for (int i = 0; i < 8; ++i) { const v4u w = kp[i];
#pragma unroll
            for (int j = 0; j < 4; ++j) { const unsigned wj = w[j]; const h16x2 hv = __builtin_bit_cast(h16x2, wj); z = fmaf(q[8 * i + 2 * j], (float)hv.x, z); z = fmaf(q[8 * i + 2 * j + 1], (float)hv.y, z); } }
        const bool act = s < t;
        const float t1 = flog2(1.0f + fexp2(-fabsf(z)));
        const float L = act ? -(fmaxf(z, 0.f) + t1) : 0.f;
        const float ls = fminf(z, 0.f) - t1;
        const float p = act ? fexp2(ls + cum) : 0.f;
        cum += L;
#pragma unroll
        for (int i = 0; i < 8; ++i) { const v4u w = vp[i];
#pragma unroll
            for (int j = 0; j < 4; ++j) { const unsigned wj = w[j]; const h16x2 hv = __builtin_bit_cast(h16x2, wj); o[8 * i + 2 * j] = fmaf(p, (float)hv.x, o[8 * i + 2 * j]); o[8 * i + 2 * j + 1] = fmaf(p, (float)hv.y, o[8 * i + 2 * j + 1]); } }
        if (__all(cum < -150.0f)) break;
    }
    bf16* yp = Y + row * SBW + h * HD;
#pragma unroll
    for (int i = 0; i < 8; ++i) { v4u w; w.x = pk2(o[8 * i], o[8 * i + 1]); w.y = pk2(o[8 * i + 2], o[8 * i + 3]); w.z = pk2(o[8 * i + 4], o[8 * i + 5]); w.w = pk2(o[8 * i + 6], o[8 * i + 7]); *(v4u*)(yp + 8 * i) = w; }
}
typedef _Float16 h8v __attribute__((ext_vector_type(8)));
typedef float f16v __attribute__((ext_vector_type(16)));
__device__ __forceinline__ void attn_mfma_unit(const _Float16* Qh, const _Float16* Kh, const _Float16* VT, bf16* Y, float* SSQ, int b, int hd, int qb, int lane, h8v tri0, h8v tri1) {
    const int r = lane & 31, hh = lane >> 5, q0 = qb * 32;
    const _Float16* qrow = Qh + ((size_t)b * SEQ + q0 + r) * SBW + hd * HD + 8 * hh;
    h8v qf[4];
#pragma unroll
    for (int kd = 0; kd < 4; ++kd) qf[kd] = *(const h8v*)(qrow + 16 * kd);
    f16v o0, o1;
#pragma unroll
    for (int i = 0; i < 16; ++i) { o0[i] = 0.f; o1[i] = 0.f; }
    float carry = 0.f;
    const _Float16* kbase = Kh + ((size_t)b * SEQ + r) * SBW + hd * HD + 8 * hh;
    const _Float16* vbase = VT + ((size_t)b * SBW + hd * HD + r) * SEQ + 8 * hh;
    h8v kf[4], vf[2][2], kn[4], vn[2][2];
#pragma unroll
    for (int kd = 0; kd < 4; ++kd) kf[kd] = *(const h8v*)(kbase + (size_t)q0 * SBW + 16 * kd);
#pragma unroll
    for (int db = 0; db < 2; ++db)
#pragma unroll
        for (int ss = 0; ss < 2; ++ss) vf[db][ss] = *(const h8v*)(vbase + (size_t)(32 * db) * SEQ + q0 + 16 * ss);
    for (int key0 = q0; key0 >= 0; key0 -= 32) {
        { const int kn0 = key0 >= 32 ? key0 - 32 : key0;
#pragma unroll
          for (int kd = 0; kd < 4; ++kd) kn[kd] = *(const h8v*)(kbase + (size_t)kn0 * SBW + 16 * kd);
#pragma unroll
          for (int db = 0; db < 2; ++db)
#pragma unroll
              for (int ss = 0; ss < 2; ++ss) vn[db][ss] = *(const h8v*)(vbase + (size_t)(32 * db) * SEQ + kn0 + 16 * ss); }
        f16v z;
#pragma unroll
        for (int i = 0; i < 16; ++i) z[i] = 0.f;
#pragma unroll
        for (int kd = 0; kd < 4; ++kd) z = __builtin_amdgcn_mfma_f32_32x32x16_f16(kf[kd], qf[kd], z, 0, 0, 0);
        const bool diag = key0 == q0;
        h8v lh[2], ll[2];
#pragma unroll
        for (int i = 0; i < 16; ++i) { const int koff = (i & 3) + 8 * (i >> 2) + 4 * hh; const bool act = !diag || koff < r;
            const float zi = z[i]; const float t1 = flog2(1.0f + fexp2(-fabsf(zi)));
            const float L = act ? fmaxf(-(fmaxf(zi, 0.f) + t1), -60000.0f) : 0.f;
            const _Float16 hi = (_Float16)L; const _Float16 lo = (_Float16)(L - (float)hi);
            lh[i >> 3][i & 7] = hi; ll[i >> 3][i & 7] = lo; }
        f16v cum;
#pragma unroll
        for (int i = 0; i < 16; ++i) cum[i] = carry;
        cum = __builtin_amdgcn_mfma_f32_32x32x16_f16(tri0, lh[0], cum, 0, 0, 0);
        cum = __builtin_amdgcn_mfma_f32_32x32x16_f16(tri1, lh[1], cum, 0, 0, 0);
        cum = __builtin_amdgcn_mfma_f32_32x32x16_f16(tri0, ll[0], cum, 0, 0, 0);
        cum = __builtin_amdgcn_mfma_f32_32x32x16_f16(tri1, ll[1], cum, 0, 0, 0);
        h8v pf[2];
#pragma unroll
        for (int i = 0; i < 16; ++i) { const int koff = (i & 3) + 8 * (i >> 2) + 4 * hh; const bool act = !diag || koff < r;
            const float p = act ? fexp2(z[i] + cum[i]) : 0.f; pf[i >> 3][i & 7] = (_Float16)p; }
        o0 = __builtin_amdgcn_mfma_f32_32x32x16_f16(vf[0][0], pf[0], o0, 0, 0, 0);
        o0 = __builtin_amdgcn_mfma_f32_32x32x16_f16(vf[0][1], pf[1], o0, 0, 0, 0);
        o1 = __builtin_amdgcn_mfma_f32_32x32x16_f16(vf[1][0], pf[0], o1, 0, 0, 0);
        o1 = __builtin_amdgcn_mfma_f32_32x32x16_f16(vf[1][1], pf[1], o1, 0, 0, 0);
        carry = __shfl(cum[0], r);
        if (__all(carry < -150.0f)) break;
#pragma unroll
        for (int kd = 0; kd < 4; ++kd) kf[kd] = kn[kd];
#pragma unroll
        for (int db = 0; db < 2; ++db)
#pragma unroll
            for (int ss = 0; ss < 2; ++ss) vf[db][ss] = vn[db][ss];
    }
    { float sq = 0.f;
#pragma unroll
      for (int i = 0; i < 16; ++i) sq += o0[i] * o0[i] + o1[i] * o1[i];
      sq += __shfl_xor(sq, 32); if (hh == 0) SSQ[((size_t)b * SEQ + q0 + r) * NH + hd] = sq; }
    bf16* yp = Y + ((size_t)b * SEQ + q0 + r) * D + hd * HD + 4 * hh;
#pragma unroll
    for (int g4 = 0; g4 < 4; ++g4) { v2u w0, w1; w0.x = pk2(o0[4 * g4], o0[4 * g4 + 1]); w0.y = pk2(o0[4 * g4 + 2], o0[4 * g4 + 3]); w1.x = pk2(o1[4 * g4], o1[4 * g4 + 1]); w1.y = pk2(o1[4 * g4 + 2], o1[4 * g4 + 3]);
        *(v2u*)(yp + 8 * g4) = w0; *(v2u*)(yp + 32 + 8 * g4) = w1; }
}
__device__ __forceinline__ void attn_one(Frame& F, int u) {
    const _Float16* Qh = (const _Float16*)(F.ws + WS_Q); const _Float16* Kh = (const _Float16*)(F.ws + WS_K); const _Float16* VT = (const _Float16*)(F.ws + WS_V);
    bf16* Y = (bf16*)(F.ws + WS_YCAT); float* SSQ = (float*)(F.ws + WS_SSQSB);
    constexpr int NQB = SEQ / 32;
    const int lane = F.lane, r = lane & 31, hh = lane >> 5;
    h8v tri0, tri1;
#pragma unroll
    for (int e = 0; e < 8; ++e) { const int k0 = 8 * (e >> 2) + 4 * hh + (e & 3); tri0[e] = (k0 >= r) ? (_Float16)1.0f : (_Float16)0.0f; tri1[e] = (16 + k0 >= r) ? (_Float16)1.0f : (_Float16)0.0f; }
    const int qb = u % NQB, bh = u / NQB; attn_mfma_unit(Qh, Kh, VT, Y, SSQ, bh / NH, bh % NH, qb, lane, tri0, tri1);
}

__device__ __forceinline__ void scan_phase(Frame& F) {
    const int task = F.vcu;
    const int b = task / NG, g = task % NG, p = F.lane;
    const float* lamL = (const float*)(F.ws + WS_LAML); const float* S = (const float*)(F.ws + WS_SLOC); bf16* U = (bf16*)(F.ws + WS_UCAT);
    const float lr = lamL[(g * 2 + 0) * NP + p], li = lamL[(g * 2 + 1) * NP + p];
    float xr = 0.f, xi = 0.f;
    for (int c0 = 0; c0 < CPB; c0 += 8) {
        float sr[8], si[8];
#pragma unroll
        for (int j = 0; j < 8; ++j) { const size_t base = ((size_t)(b * CPB + c0 + j) * NG + g) * 128; sr[j] = S[base + p]; si[j] = S[base + 64 + p]; }
#pragma unroll
        for (int j = 0; j < 8; ++j) { bf16* dst = U + ((size_t)(b * CPB + c0 + j) * NG + g) * UK + 512;
            dst[p] = (bf16)f2bf(xr); dst[64 + p] = (bf16)f2bf(xi);
            const float nr = lr * xr - li * xi + sr[j], ni = lr * xi + li * xr + si[j]; xr = nr; xi = ni; }
    }
}

__device__ __forceinline__ void router_phase(Frame& F) {
    typedef short s8v __attribute__((ext_vector_type(8)));
    typedef float f16v __attribute__((ext_vector_type(16)));
    LAS bf16* wh = (LAS bf16*)F.lds; LAS bf16* wl = wh + NE * RT_WSTR;
    LAS int* lcnt = (LAS int*)(F.lds + RT_SCR_OFF); LAS int* lbase = lcnt + 32; LAS int* asg = lbase + 32;
    const float* wr = F.in[16]; const float* br = F.in[17]; const float* g2 = F.in[15];
    bf16* XG = (bf16*)(F.ws + WS_XN); float* gates = (float*)(F.ws + WS_GATES); int* lists = (int*)(F.ws + WS_LISTS); float* RS = (float*)(F.ws + WS_RSTD);
    unsigned* gcnt = (unsigned*)(F.ctl + CW_CNT);
    const int tid = F.tid, lane = F.lane, r = lane & 31, hh = lane >> 5;
    const int task = F.wave >> 2, kq = F.wave & 3; const int tok = F.vcu * 64 + task * 32 + r;
    const bf16* xp = x1_row(F.ws, tok) + kq * 256 + 8 * hh; bf16* xo = XG + (size_t)tok * D + kq * 256 + 8 * hh;
    v4u xw[16];
#pragma unroll
    for (int ks = 0; ks < 16; ++ks) xw[ks] = *(const v4u*)(xp + 16 * ks);
    { const v4u* src = (const v4u*)(F.ws + WS_RWIMG); LAS v4u* dst = (LAS v4u*)F.lds;
      for (int i = tid; i < RT_W_BYTES / 16; i += NWAVES * 64) dst[i] = src[i]; }
    LAS float* gl = (LAS float*)(F.lds + RT_SCR_OFF + 2048);
    for (int i = tid; i < D / 4; i += NWAVES * 64) ((LAS f32x4*)gl)[i] = ((const f32x4*)g2)[i];
    if (tid < 32) lcnt[tid] = 0;
    __syncthreads();
    f16v acc;
#pragma unroll
    for (int i = 0; i < 16; ++i) acc[i] = 0.f;
    float ss = 0.f;
    const LAS float* gp = gl + kq * 256 + 8 * hh;
    const LAS bf16* whp = wh + r * RT_WSTR + kq * 256 + 8 * hh; const LAS bf16* wlp = wl + r * RT_WSTR + kq * 256 + 8 * hh;
#pragma unroll
    for (int ks = 0; ks < 16; ++ks) {
        const v4u xq = xw[ks]; const f32x4 x0 = (f32x4){bflo(xq.x), bfhi(xq.x), bflo(xq.y), bfhi(xq.y)}, x1 = (f32x4){bflo(xq.z), bfhi(xq.z), bflo(xq.w), bfhi(xq.w)}, g0 = *(const LAS f32x4*)(gp + 16 * ks), g1 = *(const LAS f32x4*)(gp + 16 * ks + 4);
        ss += (x0.x * x0.x + x0.y * x0.y) + (x0.z * x0.z + x0.w * x0.w) + (x1.x * x1.x + x1.y * x1.y) + (x1.z * x1.z + x1.w * x1.w);
        const f32x4 a0 = x0 * g0, a1 = x1 * g1;
        v4u hv, lv;
        hv.x = pg8::cvt_pk_bf16(a0.x, a0.y); hv.y = pg8::cvt_pk_bf16(a0.z, a0.w); hv.z = pg8::cvt_pk_bf16(a1.x, a1.y); hv.w = pg8::cvt_pk_bf16(a1.z, a1.w);
        lv.x = pg8::cvt_pk_bf16(a0.x - bflo(hv.x), a0.y - bfhi(hv.x)); lv.y = pg8::cvt_pk_bf16(a0.z - bflo(hv.y), a0.w - bfhi(hv.y));
        lv.z = pg8::cvt_pk_bf16(a1.x - bflo(hv.z), a1.y - bfhi(hv.z)); lv.w = pg8::cvt_pk_bf16(a1.z - bflo(hv.w), a1.w - bfhi(hv.w));
        *(v4u*)(xo + 16 * ks) = hv;
        const s8v xh = __builtin_bit_cast(s8v, hv), xl = __builtin_bit_cast(s8v, lv);
        v4u ah, al; { const LAS v2u* p = (const LAS v2u*)(whp + 16 * ks); const v2u q0 = p[0], q1 = p[1]; ah.x = q0.x; ah.y = q0.y; ah.z = q1.x; ah.w = q1.y; }
        { const LAS v2u* p = (const LAS v2u*)(wlp + 16 * ks); const v2u q0 = p[0], q1 = p[1]; al.x = q0.x; al.y = q0.y; al.z = q1.x; al.w = q1.y; }
        const s8v wa = __builtin_bit_cast(s8v, ah), wb = __builtin_bit_cast(s8v, al);
        acc = __builtin_amdgcn_mfma_f32_32x32x16_bf16(wa, xh, acc, 0, 0, 0);
        acc = __builtin_amdgcn_mfma_f32_32x32x16_bf16(wb, xh, acc, 0, 0, 0);
        acc = __builtin_amdgcn_mfma_f32_32x32x16_bf16(wa, xl, acc, 0, 0, 0);
    }
    __syncthreads();
    LAS float* part = (LAS float*)F.lds;
#pragma unroll
    for (int i = 0; i < 16; ++i) part[(F.wave * 17 + i) * 64 + lane] = acc[i];
    part[(F.wave * 17 + 16) * 64 + lane] = ss;
    __syncthreads();
    if (kq == 0) {
        float v[32]; float st = 0.f;
#pragma unroll
        for (int w = 0; w < 4; ++w) { const LAS float* pw = part + (size_t)((task * 4 + w) * 17) * 64;
#pragma unroll
            for (int i = 0; i < 16; ++i) { const float t = pw[i * 64 + lane]; v[i] = w == 0 ? t : v[i] + t; }
            st += pw[16 * 64 + lane] + pw[16 * 64 + (lane ^ 32)]; }
        const float rstd = 1.0f / sqrtf(st * (1.f / D) + EPS);
        if (hh == 0) RS[tok] = rstd;
#pragma unroll
        for (int i = 0; i < 16; ++i) { const int e = (i & 3) + 8 * (i >> 2) + 4 * hh; v[i] = v[i] * rstd + br[e]; }
#pragma unroll
        for (int i = 0; i < 16; ++i) v[16 + i] = __shfl_xor(v[i], 32);
        float mx = v[0];
#pragma unroll
        for (int i = 1; i < 32; ++i) mx = fmaxf(mx, v[i]);
        int rk[16]; float es = 0.f;
#pragma unroll
        for (int i = 0; i < 16; ++i) { const int ei = (i & 3) + 8 * (i >> 2) + 4 * hh; int rank = 0;
#pragma unroll
            for (int j = 0; j < 32; ++j) { if (j == i) continue; const int ej = (j & 3) + 8 * ((j & 15) >> 2) + 4 * (j < 16 ? hh : 1 - hh);
                rank += (v[j] > v[i] || (v[j] == v[i] && ej < ei)) ? 1 : 0; }
            rk[i] = rank; if (rank < TOPK) es += fexp2((v[i] - mx) * LOG2E); }
        es += __shfl_xor(es, 32);
        const float inv = 1.0f / es;
#pragma unroll
        for (int i = 0; i < 16; ++i) if (rk[i] < TOPK) { const int ei = (i & 3) + 8 * (i >> 2) + 4 * hh;
            gates[tok * TOPK + rk[i]] = fexp2((v[i] - mx) * LOG2E) * inv;
            const int pos = __hip_atomic_fetch_add(lcnt + ei, 1, __ATOMIC_RELAXED, __HIP_MEMORY_SCOPE_WORKGROUP);
            asg[(task * 32 + r) * 4 + rk[i]] = ei | (pos << 8); }
    }
    __syncthreads();
    if (tid < 32) lbase[tid] = (int)__hip_atomic_fetch_add(gcnt + tid, (unsigned)lcnt[tid], RLX_AGENT);
    __syncthreads();
    if (tid < 64 * TOPK) { const int a = asg[tid], e = a & 255, pos = a >> 8; const int tk = F.vcu * 64 + (tid >> 2);
        lists[e * M + lbase[e] + pos] = tk * TOPK + (tid & 3); }
    __syncthreads();
}

__device__ __forceinline__ void moe_tables(Frame& F) {
    LAS int* tab = (LAS int*)(F.lds + TAB_OFF); LAS int* cnt = tab, * mt = tab + 32, * tbase = tab + 64;
    unsigned* gcnt = (unsigned*)(F.ctl + CW_CNT);
    if (F.tid < 32) { const int c = (int)__hip_atomic_load(gcnt + F.tid, RLX_AGENT); cnt[F.tid] = c; mt[F.tid] = (c + 255) >> 8; }
    __syncthreads();
    if (F.tid == 0) { int s = 0; for (int e = 0; e < NE; ++e) { tbase[e] = s; s += mt[e]; } tbase[NE] = s; }
    __syncthreads();
}
__device__ __forceinline__ void moe_units(Frame& F, int npn, int gpn) {
    LAS int* tab = (LAS int*)(F.lds + TAB_OFF); LAS int* mt = tab + 32, * tbase = tab + 64; LAS int* units = (LAS int*)(F.lds + UNITS_OFF);
    if (F.tid < 32) {
        const int nU = tbase[NE] * npn; const int L = F.tid * F.G + (int)blockIdx.x; int pm = 0, pn = 0, e = 0, valid = 0;
        if (L < nU) { const int seq = pg8::xcd_remap(L, nU); int ee = 0; while (ee < NE - 1 && seq >= tbase[ee + 1] * npn) ++ee;
            const int r = seq - tbase[ee] * npn, m = mt[ee]; const int grp = r / (m * gpn), r2 = r % (m * gpn);
            e = ee; pn = grp * gpn + r2 / m; pm = tbase[ee] + r2 % m; valid = 1; }
        units[4 * F.tid + 0] = pm; units[4 * F.tid + 1] = pn; units[4 * F.tid + 2] = e; units[4 * F.tid + 3] = valid;
    }
    __syncthreads();
}

__device__ __forceinline__ void moe_gather_tables(Frame& F) {
    LAS int* tab = (LAS int*)(F.lds + TAB_OFF); LAS int* cnt = tab, * tbase = tab + 64; LAS int* units = (LAS int*)(F.lds + UNITS_OFF); LAS int* tokmap = (LAS int*)(F.lds + TOKMAP_OFF);
    const float* gates = (const float*)(F.ws + WS_GATES); const int* lists = (const int*)(F.ws + WS_LISTS); const float* RS = (const float*)(F.ws + WS_RSTD); int* rowinfo = (int*)(F.ws + WS_ROWINFO);
    for (int idx = F.tid; idx < TOKMAP_SLOTS * 256; idx += NWAVES * 64) { const int i = idx >> 8, R = idx & 255; int tk = 0;
        if (units[4 * i + 3]) { const int pm = units[4 * i], e = units[4 * i + 2]; const int li = (pm - tbase[e]) * 256 + R;
            v4u ri = (v4u){0xffffffffu, 0u, 0u, 0u};
            if (li < cnt[e]) { const int slot = lists[e * M + li]; tk = slot >> 2; ri = (v4u){(unsigned)slot, __builtin_bit_cast(unsigned, gates[slot]), __builtin_bit_cast(unsigned, RS[tk]), 0u}; }
            *(v4u*)(rowinfo + 4 * (pm * 256 + R)) = ri; }
        tokmap[idx] = tk; }
    asm volatile("s_waitcnt vmcnt(0)" ::: "memory");
    __syncthreads();
}

__device__ __forceinline__ void final_phase(Frame& F) {
    const bf16* YB = (const bf16*)(F.ws + WS_YBUF); const float* gf = F.in[24]; float* O = F.out;
    const int gw = F.vcu * NWAVES + F.wave, NGW = F.G * NWAVES, lane = F.lane;
    f32x4 gg[4];
#pragma unroll
    for (int j = 0; j < 4; ++j) gg[j] = *(const f32x4*)(gf + 4 * lane + 256 * j);
    for (int m = gw; m < M; m += NGW) {
        f32x4 v[4]; float ss = 0.f;
#pragma unroll
        for (int j = 0; j < 4; ++j) { { const v2u xw = *(const v2u*)(x1_row(F.ws, m) + 4 * lane + 256 * j); v[j] = (f32x4){bflo(xw.x), bfhi(xw.x), bflo(xw.y), bfhi(xw.y)}; }
#pragma unroll
            for (int k = 0; k < (DBG_MODE ? 0 : TOPK); ++k) { const v2u w = *(const v2u*)(YB + ((size_t)m * TOPK + k) * D + 4 * lane + 256 * j); v[j].x += bflo(w.x); v[j].y += bfhi(w.x); v[j].z += bflo(w.y); v[j].w += bfhi(w.y); }
            ss += (v[j].x * v[j].x + v[j].y * v[j].y) + (v[j].z * v[j].z + v[j].w * v[j].w); }
        const float rstd = 1.0f / sqrtf(wave_sum(ss) * (1.f / D) + EPS);
#pragma unroll
        for (int j = 0; j < 4; ++j) *(f32x4*)(O + (size_t)m * D + 4 * lane + 256 * j) = v[j] * rstd * gg[j];
    }
}

struct Args { const float* in[25]; float* out; unsigned char* ws; int ph_lo, ph_hi, li, pad; };
__global__ void __launch_bounds__(NWAVES * 64, 2) hyb_fwd(Args args) {
    extern __shared__ __attribute__((aligned(16))) unsigned char lds[];
    Frame F;
    F.lds = (LAS unsigned char*)lds;
    F.MISC = (volatile LAS unsigned*)(F.lds + MISC_OFF);
    F.tid = threadIdx.x; F.lane = F.tid & 63; F.wave = __builtin_amdgcn_readfirstlane(F.tid >> 6);
    F.G = gridDim.x; { const int bx = blockIdx.x; F.vcu = (F.G % 8 == 0) ? (bx % 8) * (F.G / 8) + bx / 8 : bx; }
    F.ws = args.ws; F.ctl = (gu32*)(args.ws + WS_CTL); F.out = args.out;
#pragma unroll
    for (int i = 0; i < 25; ++i) F.in[i] = args.in[i];
    for (int u = F.tid; u < (LDS_BYTES - LDSCTL_OFF) / 4; u += NWAVES * 64) ((LAS unsigned*)(F.lds + LDSCTL_OFF))[u] = 0u;
    __syncthreads();
    XcdBarrier bar; bar.bar = (unsigned*)(F.ctl + CW_BAR); bar.x = 0; bar.st = nullptr; bar.G = gridDim.x;
    if (N_LAUNCHES != PER_PHASE) bar = xcd_barrier_post((unsigned*)(F.ctl + CW_BAR), F.MISC + 8, gridDim.x);
#define GRID_BAR(seam) do { if (N_LAUNCHES == PER_PHASE) { if (F.tid == 0) __hip_atomic_store(F.ctl + CW_TMO, 0xBADBA0u | (unsigned)(seam), RLX_AGENT); } else { xcd_barrier(bar); } } while (0)
    const int lo = args.ph_lo, hi = args.ph_hi;
#define IN(k) (lo <= (k) && (k) < hi)
#define BOTH(k) (IN(k) && IN((k) + 1))
    const pg8::bf16_t* wsb = (const pg8::bf16_t*)args.ws;
#define WSB(off) ((const pg8::bf16_t*)(args.ws + (off)))

    unsigned long long t_lo_ = 0, t_hi_ = 0;
    TMARK(0);
    if (IN(0)) {   }

    TMARK(1);
    if (IN(1)) for (int rep_ = 0; rep_ < NREP(1); ++rep_) {
        const int bx = (int)blockIdx.x; const bool gemm_wg = bx < P1_GEMM_WG;
        pg8::Gemm g = pg8::make_gemm(WSB(WS_HN), WSB(WS_WINT), D, D, D); InProjOrder S{P1_GEMM_WG, gemm_wg ? bx : 512};
        EpiInProj E{(unsigned short*)(args.ws + WS_Q), (bf16*)(args.ws + WS_UCAT), LOG2E * 0.125f};
        if (gemm_wg) { XcdBarrier bar2 = xcd_barrier_post((unsigned*)(F.ctl + CW_BAR2), F.MISC + 10, (unsigned)P1_GEMM_WG);
            p0_prologue(F, t_lo_, t_hi_);
            xcd_barrier(bar2); }
        pg8::gemm_phase<EpiInProj, InProjOrder, PG8_ALIGN, PG8_SP2>(F.lds + RING_OFF, g, S, E);
        p1_side(F, (bx >= P1_GEMM_WG && bx < P1_GEMM_WG + NG) ? bx - P1_GEMM_WG : -1);
        if (BOTH(1)) GRID_BAR(1);
    }
    TMARK(2);
    if (IN(2)) for (int rep_ = 0; rep_ < NREP(2); ++rep_) {
        pg8::Gemm g = pg8::make_gemm(WSB(WS_UCAT), WSB(WS_WE), NG * UK, 512, 512); SsmOrder S{NG * 2, F.G, (int)blockIdx.x, 1, 128, 512};
        EpiSloc E{(float*)(args.ws + WS_SLOC)};
        pg8::gemm_phase<EpiSloc, SsmOrder, PG8_ALIGN, PG8_SP2>(F.lds + RING_OFF, g, S, E);
        if (blockIdx.x >= NG * 2) attn_one(F, ((int)blockIdx.x - NG * 2) * 8 + F.wave);
        if (BOTH(2)) GRID_BAR(2);
    }
    TMARK(3);
    if (IN(3)) for (int rep_ = 0; rep_ < NREP(3); ++rep_) {
        if (F.vcu < BATCH * NG) { if (F.wave == 0) scan_phase(F); else attn_one(F, 3072 + F.vcu * 7 + F.wave - 1); }
        else attn_one(F, 1536 + (F.vcu - BATCH * NG) * 8 + F.wave);
        if (BOTH(3)) GRID_BAR(3); }
    TMARK(4);
    if (IN(4)) for (int rep_ = 0; rep_ < NREP(4); ++rep_) {
        pg8::Gemm g = pg8::make_gemm(WSB(WS_UCAT), WSB(WS_TW), NG * UK, UK, UK); SsmOrder S{NG * 4, F.G, (int)blockIdx.x, 2, 512, UK};
        EpiS3 E{(bf16*)(args.ws + WS_YG)};
        pg8::gemm_phase<EpiS3, SsmOrder, PG8_ALIGN, PG8_SP2>(F.lds + RING_OFF, g, S, E);
        if (blockIdx.x >= NG * 4 && blockIdx.x < NG * 4 + 72) attn_one(F, 3520 + ((int)blockIdx.x - NG * 4) * 8 + F.wave);
        else if (blockIdx.x >= NG * 4 + 72) w2_drain(F, 2);
        if (BOTH(4)) GRID_BAR(4);
    }
    TMARK(5);
    if (IN(5)) for (int rep_ = 0; rep_ < NREP(5); ++rep_) {
        pg8::Gemm g = pg8::make_gemm(WSB(WS_YG), WSB(WS_WGLUT), SSW, SSW, SSW); pg8::StaticOrder S; S.init(M, 2 * SSW, F.G, (int)blockIdx.x, SSW, SSW);
        EpiGlu E{(bf16*)(args.ws + WS_YCAT), (float*)(args.ws + WS_SSQSSM)};
        pg8::gemm_phase<EpiGlu, pg8::StaticOrder, PG8_ALIGN, PG8_SP2>(F.lds + RING_OFF, g, S, E);
        if (BOTH(5)) GRID_BAR(5);
    }
    TMARK(6);
    if (IN(6)) {   }
    TMARK(7);
    if (IN(7)) for (int rep_ = 0; rep_ < NREP(7); ++rep_) {
        pg8::Gemm g = pg8::make_gemm(WSB(WS_YCAT), WSB(WS_WOUTT), D, D, D); pg8::StaticOrder S; S.init(M, D, F.G, (int)blockIdx.x, D, D);
        LAS float* rtab = (LAS float*)(F.lds + TOKMAP_OFF);
        { pg8::Unit u0; if (S.next(0, u0) && F.tid < 256) { const int row = u0.pm * 256 + F.tid; const float* pa = (const float*)(args.ws + WS_SSQSB) + (size_t)row * NH; const float* pb = (const float*)(args.ws + WS_SSQSSM) + (size_t)row * 16;
              float sa = 0.f, sb = 0.f;
#pragma unroll
              for (int i = 0; i < NH; ++i) sa += pa[i];
#pragma unroll
              for (int i = 0; i < 16; ++i) sb += pb[i];
              const float ra = 1.0f / sqrtf(sa * (1.f / SBW) + EPS), rb = 1.0f / sqrtf(sb * (1.f / SSW) + EPS); rtab[F.tid] = ra / rb; rtab[256 + F.tid] = rb; }
          __syncthreads(); }
        EpiOutProj E{F.in[0], args.ws, rtab, rtab + 256};
        pg8::gemm_phase<EpiOutProj, pg8::StaticOrder, PG8_ALIGN, PG8_SP2>(F.lds + RING_OFF, g, S, E);
        if (BOTH(7)) GRID_BAR(7);
    }
    TMARK(8);
    if (IN(8) && !DBG_MODE) for (int rep_ = 0; rep_ < NREP(8); ++rep_) { router_phase(F); if (BOTH(8)) GRID_BAR(8); }
    TMARK(9);
    if (IN(9) && !DBG_MODE) for (int rep_ = 0; rep_ < NREP(9); ++rep_) {   }
    TMARK(10);
    if (IN(10) && !DBG_MODE) for (int rep_ = 0; rep_ < NREP(10); ++rep_) {
        moe_tables(F); moe_units(F, 8, 4); moe_gather_tables(F);
        pg8::Gemm g = pg8::make_gemm(WSB(WS_XN), WSB(WS_W1T), D, D, D); g.brs = 16u; g.bks = 2u * FF * 16u; g.tokmap = (const PG8_LAS int*)(F.lds + TOKMAP_OFF);
        MoeOrder S{(const LAS int*)(F.lds + UNITS_OFF), (long)2 * FF * D * 2, 1};
        EpiMoe1 E{(bf16*)(args.ws + WS_H), F.in[19], F.in[21], (const int*)(args.ws + WS_ROWINFO)};
        pg8::gemm_phase<EpiMoe1, MoeOrder, PG8_ALIGN, PG8_SP2, true>(F.lds + RING_OFF, g, S, E);
        w2_drain(F, -1);
        if (BOTH(10)) GRID_BAR(10);
    }
    TMARK(11);
    if (IN(11) && !DBG_MODE) for (int rep_ = 0; rep_ < NREP(11); ++rep_) {
        moe_tables(F); moe_units(F, 4, 4);
        pg8::Gemm g = pg8::make_gemm(WSB(WS_H), WSB(WS_W2T), FF, FF, FF); g.brs = 16u; g.bks = (unsigned)D * 16u; MoeOrder S{(const LAS int*)(F.lds + UNITS_OFF), (long)D * FF * 2, 0};
        EpiMoe2 E{(bf16*)(args.ws + WS_YBUF), F.in[23], (const int*)(args.ws + WS_ROWINFO)};
        pg8::gemm_phase<EpiMoe2, MoeOrder, PG8_ALIGN, PG8_SP2>(F.lds + RING_OFF, g, S, E);
        if (BOTH(11)) GRID_BAR(11);
    }
    TMARK(12);
    if (IN(12)) for (int rep_ = 0; rep_ < NREP(12); ++rep_) { final_phase(F); }
    TMARK(13);
    if ((TIME_LO) >= 0 && blockIdx.x == (TIME_BLK) && F.tid == 0) { const unsigned long long te = __builtin_amdgcn_s_memrealtime(), dt = 4ull * (t_hi_ - t_lo_); while (__builtin_amdgcn_s_memrealtime() - te < dt) __builtin_amdgcn_s_sleep(32); }
    (void)wsb;
#undef IN
#undef BOTH
}

extern "C" void kernel_launch(void* const* d_in, const int* in_sizes, int n_in, void* d_out, int out_size, void* d_ws, size_t ws_size, hipStream_t stream) {
    static int grid = 0;
    if (grid == 0) {
        if (n_in != 25 || in_sizes[0] != M * D || out_size != M * D || ws_size < WS_END) { fprintf(stderr, "kernel_launch: unexpected shapes: n_in %d in0 %d out %d ws %zu (need %zu); nothing launched\n", n_in, n_in > 0 ? in_sizes[0] : -1, out_size, ws_size, (size_t)WS_END); grid = -1; return; }
        int dev = 0, cus = 0, per_cu = 0;
        if (hipGetDevice(&dev) != hipSuccess || hipDeviceGetAttribute(&cus, hipDeviceAttributeMultiprocessorCount, dev) != hipSuccess) { grid = -1; return; }
        if (hipFuncSetAttribute((const void*)hyb_fwd, hipFuncAttributeMaxDynamicSharedMemorySize, LDS_BYTES) != hipSuccess) { fprintf(stderr, "kernel_launch: hipFuncSetAttribute failed\n"); grid = -1; return; }
        if (hipOccupancyMaxActiveBlocksPerMultiprocessor(&per_cu, (const void*)hyb_fwd, NWAVES * 64, LDS_BYTES) != hipSuccess || per_cu < 1)
            fprintf(stderr, "kernel_launch: note: occupancy query reports %d workgroups per CU\n", per_cu);
        (void)hipGetLastError();
        grid = cus;
        if (grid != 256) fprintf(stderr, "kernel_launch: note: %d CUs (built for 256)\n", grid);
    }
    if (grid < 0) return;
    if (hipMemsetAsync((char*)d_ws + WS_CTL, 0, CTL_ZERO_BYTES, stream) != hipSuccess) { fprintf(stderr, "kernel_launch: memset failed\n"); return; }
    Args a{};
    for (int i = 0; i < 25; ++i) a.in[i] = (const float*)d_in[i];
    a.out = (float*)d_out; a.ws = (unsigned char*)d_ws;
    for (int li = 0; li < N_LAUNCHES; ++li) {
        a.ph_lo = (N_LAUNCHES == PER_PHASE) ? li : 0; a.ph_hi = (N_LAUNCHES == PER_PHASE) ? li + 1 : PER_PHASE; a.li = li;
        hipLaunchKernelGGL(hyb_fwd, dim3(grid), dim3(NWAVES * 64), LDS_BYTES, stream, a);
        const hipError_t le = hipPeekAtLastError();
        if (le != hipSuccess) { fprintf(stderr, "kernel_launch: launch %d failed: %s\n", li, hipGetErrorName(le)); break; }
    }
}
```

```cpp
#include <hip/hip_runtime.h>
#include <cstdio>
#include <cstdint>
namespace pg8 {
#define PG8_LAS __attribute__((address_space(3)))
typedef unsigned short bf16_t;
typedef short bf16x8 __attribute__((ext_vector_type(8)));
typedef float f32x4 __attribute__((ext_vector_type(4)));
typedef unsigned u32x4 __attribute__((ext_vector_type(4)));
constexpr int BM = 256, BK = 64, HALF = 128, HTB = HALF * BK * 2  , STAGE_BYTES = 8 * HTB, NXCD = 8, WGM = 8;

__host__ __device__ __forceinline__ int lds_byte(int r, int c) { const int st = (r >> 4) * 2 + (c >> 5), rr = r & 15, cc = c & 31, ob = rr * 64 + cc * 2; return st * 1024 + (ob ^ (((ob >> 9) & 1) << 5)); }
__host__ __device__ __forceinline__ void stage_rc(int b, int& R, int& C) { const int st = b / 1024, sb = b % 1024, swz = sb ^ (((sb >> 9) & 1) << 5); R = (st >> 1) * 16 + swz / 64; C = (st & 1) * 32 + (swz % 64) / 2; }
__host__ __device__ __forceinline__ int perm32(int rho) { const int n = rho >> 4, i = rho & 15; return 8 * (i >> 2) + 4 * n + (i & 3); }

struct Unit { int pm, pn, e, slot; long offA, offB; };
struct Gemm { const bf16_t* A; const bf16_t* Bt; int lda, K; unsigned brs, bks; const PG8_LAS int* tokmap; };
__host__ __device__ __forceinline__ Gemm make_gemm(const bf16_t* A, const bf16_t* Bt, int lda, int ldb, int K) { Gemm g; g.A = A; g.Bt = Bt; g.lda = lda; g.K = K; g.brs = (unsigned)ldb * 2u; g.bks = 16u; g.tokmap = nullptr; return g; }

__host__ __device__ __forceinline__ int xcd_remap(int wgid, int nwg) { const int q = nwg / NXCD, r = nwg % NXCD, xcd = wgid % NXCD, off = wgid / NXCD; return (xcd < r ? xcd * (q + 1) : r * (q + 1) + (xcd - r) * q) + off; }

struct StaticOrder {
    int nM, nN, nwg, G, c, lda, ldb;
    __host__ __device__ void init(int M, int N, int G_, int c_, int lda_, int ldb_) { nM = M / BM; nN = N / BM; nwg = nM * nN; G = G_; c = c_; lda = lda_; ldb = ldb_; }
    __host__ __device__ __forceinline__ bool next(int i, Unit& u) const {
        const long L = (long)i * G + c; if (L >= nwg) return false;
        const int wgid = xcd_remap((int)L, nwg);
        const int nig = WGM * nN, gid = wgid / nig, fm = gid * WGM, gsz = (nM - fm) < WGM ? (nM - fm) : WGM;
        u.pm = fm + ((wgid % nig) % gsz); u.pn = (wgid % nig) / gsz; u.e = 0; u.slot = 0;
        u.offA = (long)u.pm * BM * lda * 2; u.offB = (long)u.pn * BM * ldb * 2; return true;
    }
    __device__ __forceinline__ void a_ready(const Unit&) const {}
    __device__ __forceinline__ void done(const Unit&) const {}
};

__device__ __forceinline__ unsigned cvt_pk_bf16(float lo, float hi) { unsigned r; asm volatile("v_cvt_pk_bf16_f32 %0, %1, %2" : "=v"(r) : "v"(lo), "v"(hi)); return r; }
typedef float f32x2 __attribute__((ext_vector_type(2)));

template <class Epi, class Sched, bool ALIGN_EPI = false, bool SP2 = false, bool GATHER = false>
__device__ __forceinline__ void gemm_phase(PG8_LAS unsigned char* lds, const Gemm g, const Sched& S, const Epi& E) {
    static_assert(!GATHER || SP2, "the gather form is written for the two-super-phase loop only");
    const int tid = threadIdx.x, wid = __builtin_amdgcn_readfirstlane(tid >> 6), lane = tid & 63, wr = wid >> 2, wc = wid & 3, fr = lane & 15, fq = lane >> 4;
    const int K = g.K, nt = K / BK;
    unsigned voffA[2], voffB[2]; int RA[2];
#pragma unroll
    for (int i = 0; i < 2; ++i) { int R, C; stage_rc(tid * 16 + i * 8192, R, C); const int Rb = Epi::PERM ? ((R & ~31) + perm32(R & 31)) : R; RA[i] = R;
        voffA[i] = GATHER ? (unsigned)C * 2u : (unsigned)(R * g.lda + C) * 2u; voffB[i] = (unsigned)Rb * g.brs + (unsigned)(C >> 3) * g.bks; }
    const size_t kstepA = (size_t)(BK * 2), kstepB = (size_t)8 * g.bks;
    const size_t hstepA = (size_t)HALF * g.lda * 2, hstepB = (size_t)HALF * g.brs;
    const unsigned ldsw = (unsigned)wid * 1024u;
    const int aoff = lds_byte(wr * 64 + fr, fq * 8), boff = lds_byte(wc * 32 + fr, fq * 8);
#define PG8_SA(b, h) (((b) * 2 + (h)) * HTB)
#define PG8_SB(b, h) ((4 + (b) * 2 + (h)) * HTB)
#define PG8_STAGE(bufoff, gbase, voff) do { _Pragma("unroll") for (int _i = 0; _i < 2; ++_i) \
        __builtin_amdgcn_global_load_lds((const unsigned*)((const char*)(gbase) + (voff)[_i]), (PG8_LAS unsigned*)(lds + (bufoff) + ldsw + _i * 8192), 16, 0, 0); } while (0)
    unsigned ga[2][2], gn[2][2], gw[2][2];
#define PG8_GLOAD(dst, u) do { if constexpr (GATHER) { const PG8_LAS int* _tm = g.tokmap + 256 * (u).slot; _Pragma("unroll") for (int _h = 0; _h < 2; ++_h) _Pragma("unroll") for (int _i = 0; _i < 2; ++_i) \
        dst[_h][_i] = (unsigned)_tm[128 * _h + RA[_i]] * (unsigned)(g.lda * 2) + voffA[_i]; } } while (0)
#define PG8_STAGE_A(bufoff, gbase, half, GX) do { if constexpr (GATHER) { PG8_STAGE(bufoff, gbase, GX[half]); } else { PG8_STAGE(bufoff, (gbase) + (half) * hstepA, voffA); } } while (0)
#define PG8_LDA(dst, b, h) do { _Pragma("unroll") for (int m = 0; m < 4; ++m) _Pragma("unroll") for (int k = 0; k < 2; ++k) dst[m][k] = *(const PG8_LAS bf16x8*)(lds + PG8_SA(b, h) + aoff + m * 2048 + k * 1024); } while (0)
#define PG8_LDB(dst, b, h) do { _Pragma("unroll") for (int n = 0; n < 2; ++n) _Pragma("unroll") for (int k = 0; k < 2; ++k) dst[n][k] = *(const PG8_LAS bf16x8*)(lds + PG8_SB(b, h) + boff + n * 2048 + k * 1024); } while (0)
#define PG8_MMA(ai, bj, At, Bt) do { __builtin_amdgcn_s_setprio(1); _Pragma("unroll") for (int m = 0; m < 4; ++m) _Pragma("unroll") for (int n = 0; n < 2; ++n) _Pragma("unroll") for (int k = 0; k < 2; ++k) \
        acc[ai][bj][m][n] = __builtin_amdgcn_mfma_f32_16x16x32_bf16(Bt[n][k], At[m][k], acc[ai][bj][m][n], 0, 0, 0); __builtin_amdgcn_s_setprio(0); } while (0)
#define PG8_WAIT_V(n) asm volatile("s_waitcnt vmcnt(" #n ")" ::: "memory")
#define PG8_WAIT_L(n) asm volatile("s_waitcnt lgkmcnt(" #n ")" ::: "memory")
#define PG8_BAR __builtin_amdgcn_s_barrier()
#define PG8_SCHED __builtin_amdgcn_sched_barrier(0)
    Unit cur, nxt; int ui = 0;
    if (!S.next(0, cur)) return;
    f32x4 acc[2][2][4][2];
#pragma unroll
    for (int a = 0; a < 2; ++a)
#pragma unroll
        for (int b = 0; b < 2; ++b)
#pragma unroll
            for (int m = 0; m < 4; ++m)
#pragma unroll
                for (int n = 0; n < 2; ++n) acc[a][b][m][n] = (f32x4){0.f, 0.f, 0.f, 0.f};
    bf16x8 At[4][2], B0[2][2], B1[2][2];
    const char* cA = (const char*)g.A + cur.offA; const char* cB = (const char*)g.Bt + cur.offB;
    S.a_ready(cur);
    if constexpr (SP2) {
        PG8_GLOAD(ga, cur);
        PG8_STAGE(PG8_SB(0, 0), cB, voffB); PG8_STAGE(PG8_SB(0, 1), cB + hstepB, voffB); PG8_STAGE_A(PG8_SA(0, 0), cA, 0, ga); PG8_STAGE_A(PG8_SA(0, 1), cA, 1, ga);
        if (wr == 1) PG8_BAR;
        PG8_WAIT_V(2); PG8_BAR;
        PG8_STAGE(PG8_SB(1, 0), cB + kstepB, voffB); PG8_STAGE_A(PG8_SA(1, 0), cA + kstepA, 0, ga); PG8_STAGE(PG8_SB(1, 1), cB + hstepB + kstepB, voffB);
        PG8_WAIT_V(6); PG8_BAR;
    } else {
        PG8_STAGE(PG8_SB(0, 0), cB, voffB); PG8_STAGE(PG8_SA(0, 0), cA, voffA); PG8_STAGE(PG8_SB(0, 1), cB + hstepB, voffB); PG8_STAGE(PG8_SA(0, 1), cA + hstepA, voffA);
        if (wr == 1) PG8_BAR;
        PG8_WAIT_V(4); PG8_BAR;
        PG8_STAGE(PG8_SB(1, 0), cB + kstepB, voffB); PG8_STAGE(PG8_SA(1, 0), cA + kstepA, voffA); PG8_STAGE(PG8_SB(1, 1), cB + hstepB + kstepB, voffB);
        PG8_WAIT_V(6); PG8_BAR;
    }
    for (;;) {
        const bool has_next = S.next(ui + 1, nxt);
        if constexpr (GATHER) { if (has_next) { PG8_GLOAD(gn, nxt); } else { _Pragma("unroll") for (int _h = 0; _h < 2; ++_h) _Pragma("unroll") for (int _i = 0; _i < 2; ++_i) gn[_h][_i] = ga[_h][_i]; } }
        const char* nA = has_next ? (const char*)g.A + nxt.offA : cA; const char* nB = has_next ? (const char*)g.Bt + nxt.offB : cB;
        for (int t = 0; t < nt; t += 2) {
            const bool last = (t == nt - 2);
            const char* a1 = cA + (size_t)(t + 1) * kstepA;
            const char* a2 = last ? nA : cA + (size_t)(t + 2) * kstepA; const char* b2 = last ? nB : cB + (size_t)(t + 2) * kstepB;
            const char* a3 = a2 + kstepA; const char* b3 = b2 + kstepB;
            if (last && has_next) S.a_ready(nxt);
            if constexpr (GATHER) { _Pragma("unroll") for (int _h = 0; _h < 2; ++_h) _Pragma("unroll") for (int _i = 0; _i < 2; ++_i) gw[_h][_i] = last ? gn[_h][_i] : ga[_h][_i]; }
            if constexpr (Epi::MIDK) { if (t == nt / 2) E.mid(acc, cur, wr, wc, fr, fq); }
            if constexpr (SP2) {
            PG8_LDB(B0, 0, 0); PG8_LDB(B1, 0, 1); PG8_SCHED; PG8_LDA(At, 0, 0); PG8_STAGE_A(PG8_SA(1, 1), a1, 1, ga);
            PG8_WAIT_V(8); PG8_WAIT_L(0); PG8_BAR; PG8_MMA(0, 0, At, B0); PG8_MMA(0, 1, At, B1); PG8_BAR; PG8_SCHED;
            PG8_LDA(At, 0, 1); PG8_STAGE(PG8_SB(0, 0), b2, voffB); PG8_STAGE(PG8_SB(0, 1), b2 + hstepB, voffB); PG8_STAGE_A(PG8_SA(0, 0), a2, 0, gw);
            PG8_WAIT_V(8); PG8_WAIT_L(0); PG8_BAR; PG8_MMA(1, 0, At, B0); PG8_MMA(1, 1, At, B1); PG8_BAR; PG8_SCHED;
            PG8_LDB(B0, 1, 0); PG8_LDB(B1, 1, 1); PG8_SCHED; PG8_LDA(At, 1, 0); PG8_STAGE_A(PG8_SA(0, 1), a2, 1, gw);
            PG8_WAIT_V(8); PG8_WAIT_L(0); PG8_BAR; PG8_MMA(0, 0, At, B0); PG8_MMA(0, 1, At, B1); PG8_BAR; PG8_SCHED;
            PG8_LDA(At, 1, 1); PG8_STAGE(PG8_SB(1, 0), b3, voffB); PG8_STAGE(PG8_SB(1, 1), b3 + hstepB, voffB); PG8_STAGE_A(PG8_SA(1, 0), a3, 0, gw);
            PG8_WAIT_V(8); PG8_WAIT_L(0); PG8_BAR; PG8_MMA(1, 0, At, B0); PG8_MMA(1, 1, At, B1); PG8_BAR; PG8_SCHED;
            } else {
            PG8_LDB(B0, 0, 0); PG8_SCHED; PG8_LDA(At, 0, 0); PG8_STAGE(PG8_SA(1, 1), a1 + hstepA, voffA);
            PG8_WAIT_L(8); PG8_BAR; PG8_WAIT_L(0); PG8_MMA(0, 0, At, B0); PG8_BAR; PG8_SCHED;
            PG8_LDB(B1, 0, 1); PG8_STAGE(PG8_SB(0, 0), b2, voffB);
            PG8_BAR; PG8_WAIT_L(0); PG8_MMA(0, 1, At, B1); PG8_BAR;
            PG8_LDA(At, 0, 1); PG8_STAGE(PG8_SA(0, 0), a2, voffA);
            PG8_BAR; PG8_WAIT_L(0); PG8_MMA(1, 0, At, B0); PG8_BAR; PG8_SCHED;
            PG8_STAGE(PG8_SB(0, 1), b2 + hstepB, voffB);
            PG8_WAIT_V(6); PG8_BAR; PG8_MMA(1, 1, At, B1); PG8_BAR;
            PG8_LDB(B0, 1, 0); PG8_SCHED; PG8_LDA(At, 1, 0); PG8_STAGE(PG8_SA(0, 1), a2 + hstepA, voffA);
            PG8_WAIT_L(8); PG8_BAR; PG8_WAIT_L(0); PG8_MMA(0, 0, At, B0); PG8_BAR; PG8_SCHED;
            PG8_LDB(B1, 1, 1); PG8_STAGE(PG8_SB(1, 0), b3, voffB);
            PG8_BAR; PG8_WAIT_L(0); PG8_MMA(0, 1, At, B1); PG8_BAR;
            PG8_LDA(At, 1, 1); PG8_STAGE(PG8_SA(1, 0), a3, voffA);
            PG8_BAR; PG8_WAIT_L(0); PG8_MMA(1, 0, At, B0); PG8_BAR; PG8_SCHED;
            PG8_STAGE(PG8_SB(1, 1), b3 + hstepB, voffB);
            PG8_WAIT_V(6); PG8_BAR; PG8_MMA(1, 1, At, B1); PG8_BAR;
            }
        }
        if constexpr (ALIGN_EPI) { if (wr == 0) PG8_BAR; }
        if constexpr (!Epi::AFTER_DRAIN) { E(acc, cur, wr, wc, fr, fq); S.done(cur); }
        if (!has_next) break;
#pragma unroll
        for (int a = 0; a < 2; ++a)
#pragma unroll
            for (int b = 0; b < 2; ++b)
#pragma unroll
                for (int m = 0; m < 4; ++m)
#pragma unroll
                    for (int n = 0; n < 2; ++n) acc[a][b][m][n] = (f32x4){0.f, 0.f, 0.f, 0.f};
        cur = nxt; cA = nA; cB = nB; ++ui;
        if constexpr (GATHER) { _Pragma("unroll") for (int _h = 0; _h < 2; ++_h) _Pragma("unroll") for (int _i = 0; _i < 2; ++_i) ga[_h][_i] = gn[_h][_i]; }
        if constexpr (ALIGN_EPI) { if (wr == 1) PG8_BAR; }
    }
    PG8_WAIT_V(0);
    if constexpr (!ALIGN_EPI) { if (wr == 0) PG8_BAR; }
    PG8_BAR;
    if constexpr (Epi::AFTER_DRAIN) { E.fused(acc, cur, wr, wc, fr, fq, lds, wid, lane); S.done(cur); }
#undef PG8_SA
#undef PG8_SB
#undef PG8_STAGE
#undef PG8_STAGE_A
#undef PG8_GLOAD
#undef PG8_LDA
#undef PG8_LDB
#undef PG8_MMA
#undef PG8_WAIT_V
#undef PG8_WAIT_L
#undef PG8_BAR
#undef PG8_SCHED
}
}

#ifndef PG8_SP2
#define PG8_SP2 true
#endif
#ifndef PG8_ALIGN
#define PG8_ALIGN true
#endif

constexpr int NWAVES = 8;
#ifndef MK_N_LAUNCHES
#define MK_N_LAUNCHES 1
#endif
#ifndef DBG_MODE
#define DBG_MODE 0
#endif
#ifndef REP_PHASE
#define REP_PHASE -1
#endif
#define NREP(k) ((REP_PHASE) == (k) ? 2 : 1)
#ifndef TIME_LO
#define TIME_LO -1
#endif
#ifndef TIME_HI
#define TIME_HI -1
#endif
#ifndef TIME_BLK
#define TIME_BLK 0
#endif
#define TMARK(j) do { if ((TIME_LO) >= 0 && blockIdx.x == (TIME_BLK) && F.tid == 0) { if ((j) == (TIME_LO)) t_lo_ = __builtin_amdgcn_s_memrealtime(); if ((j) == (TIME_HI)) t_hi_ = __builtin_amdgcn_s_memrealtime(); } } while (0)
constexpr int PER_PHASE = 13;
constexpr int N_LAUNCHES = MK_N_LAUNCHES;

constexpr int BATCH = 2, SEQ = 8192, D = 1024, M = BATCH * SEQ;
constexpr int SBW = 512, NH = 8, HD = 64;
constexpr int SSW = 512, NG = 32, GC = 16, NP = 64;
constexpr int NPROJ = 3 * SBW + SSW;
constexpr int LC = 32, NCHUNK = M / LC, CPB = SEQ / LC;
constexpr int UK = LC * GC + 2 * NP;
constexpr int NE = 32, TOPK = 4, FF = 1024, NASSIGN = M * TOPK;
constexpr int MAXTILES = (NASSIGN + NE * 255) / 256 + 1;
constexpr float EPS = 1e-5f;
constexpr float LOG2E = 1.4426950408889634f;

constexpr size_t MiB = 1u << 20;
constexpr size_t WS_CTL = 0, CTL_ZERO_BYTES = 1 * MiB;
constexpr size_t WS_LAML = 1 * MiB;
constexpr size_t WS_RSTD = 1 * MiB + 32 * 1024;
constexpr size_t WS_GATES = 1 * MiB + 128 * 1024;
constexpr size_t WS_ROWINFO = 1 * MiB + 512 * 1024;
constexpr size_t WS_RWIMG = 3 * MiB;
constexpr size_t WS_LISTS = 507 * MiB;
constexpr size_t WS_X1LO = 331 * MiB, WS_X1HI = 491 * MiB;
constexpr size_t WS_WINT = 4 * MiB, WS_WGLUT = 8 * MiB, WS_WOUTT = 9 * MiB, WS_W1T = 11 * MiB, WS_W2T = 139 * MiB;
constexpr size_t WS_R1 = 203 * MiB, WS_R2 = 347 * MiB, WS_END = 509 * MiB;
constexpr size_t WS_HN = WS_R1, WS_Q = WS_R1 + 32 * MiB, WS_K = WS_R1 + 48 * MiB, WS_V = WS_R1 + 64 * MiB, WS_UCAT = WS_R1 + 80 * MiB,
                 WS_SLOC = WS_R1 + 100 * MiB, WS_SSQSB = WS_R1 + 108 * MiB  , WS_SSQSSM = WS_R1 + 109 * MiB  , WS_YG = WS_R1 + 124 * MiB;
constexpr size_t WS_YBUF = WS_R1;
constexpr size_t WS_YCAT = WS_R2 + 16 * MiB  , WS_XN = WS_R1  , WS_WE = WS_R2 + 80 * MiB, WS_TW = WS_R2 + 85 * MiB;
constexpr size_t WS_H = WS_R2;
static_assert(WS_K == WS_Q + (size_t)M * SBW * 2 && WS_V == WS_K + (size_t)M * SBW * 2 && WS_YG + (size_t)M * SSW * 2 <= WS_R2 && WS_TW + (size_t)NG * 512 * UK * 2 <= WS_END, "ws map");
static_assert(WS_YBUF + (size_t)NASSIGN * D * 2 <= WS_X1LO && WS_H + (size_t)(MAXTILES - 1) * 256 * FF * 2 <= WS_END, "ws map 2");
static_assert(WS_ROWINFO + (size_t)MAXTILES * 256 * 16 <= 3 * MiB && WS_X1LO >= WS_YBUF + (size_t)NASSIGN * D * 2 && WS_X1LO + 16 * MiB <= WS_R2 && WS_X1HI >= WS_H + (size_t)(MAXTILES - 1) * 256 * FF * 2 && WS_X1HI + 16 * MiB <= WS_LISTS && WS_LISTS + (size_t)NE * M * 4 <= WS_END, "ws map 3");
constexpr int CW_TMO = 0, CW_CODE = 1;
constexpr int CW_BAR = 4096, CW_BAR2 = 8192, CW_BAR3 = 12288;
constexpr int CW_CNT = 16384;
constexpr int CW_Q0 = 16384 + 256, CW_Q1 = 16384 + 512, CW_Q2 = 16384 + 576;
constexpr int CW_DONE1 = 16384 + 640;
constexpr int CW_AQ = 16384 + 320, CW_DONE2 = 16384 + 384, CW_DONE3 = 16384 + 448;

constexpr int RING_OFF = 0, RING_BYTES = 131072;
constexpr int RT_WSTR = 1028;
constexpr int RT_W_BYTES = 2 * NE * RT_WSTR * 2;
constexpr int RT_SCR_OFF = RT_W_BYTES;
constexpr int LDSCTL_OFF = 139264, MISC_OFF = LDSCTL_OFF + 320;
constexpr int TAB_OFF = LDSCTL_OFF + 512;
constexpr int UNITS_OFF = LDSCTL_OFF + 1024;
constexpr int TILEE_OFF = LDSCTL_OFF + 1536;
constexpr int TOKMAP_OFF = LDSCTL_OFF + 4096, TOKMAP_SLOTS = 10;
constexpr int LDS_BYTES = TOKMAP_OFF + TOKMAP_SLOTS * 1024;
static_assert(TILEE_OFF + MAXTILES * 4 <= LDS_BYTES && RT_SCR_OFF + 4096 <= LDSCTL_OFF, "LDS map");

#define GAS __attribute__((address_space(1)))
#define LAS __attribute__((address_space(3)))
typedef unsigned short bf16;
typedef unsigned v4u __attribute__((ext_vector_type(4)));
typedef unsigned v2u __attribute__((ext_vector_type(2)));
typedef float f32x4 __attribute__((ext_vector_type(4)));
typedef float f32x2 __attribute__((ext_vector_type(2)));
typedef _Float16 h16x2 __attribute__((ext_vector_type(2)));
typedef GAS unsigned gu32;
#define RLX_AGENT __ATOMIC_RELAXED, __HIP_MEMORY_SCOPE_AGENT
#define LDS_WAIT() asm volatile("s_waitcnt lgkmcnt(0)" ::: "memory")
#define VM_WAIT() asm volatile("s_waitcnt vmcnt(0)" ::: "memory")
__device__ __forceinline__ unsigned f2bf(float f) { unsigned u = __builtin_bit_cast(unsigned, f); return (u + 0x7fffu + ((u >> 16) & 1u)) >> 16; }
__device__ __forceinline__ unsigned pk2(float lo, float hi) { return f2bf(lo) | (f2bf(hi) << 16); }
__device__ __forceinline__ float bf2f(unsigned short b) { return __builtin_bit_cast(float, (unsigned)b << 16); }
__device__ __forceinline__ float bflo(unsigned w) { return __builtin_bit_cast(float, w << 16); }
__device__ __forceinline__ float bfhi(unsigned w) { return __builtin_bit_cast(float, w & 0xffff0000u); }
__device__ __forceinline__ unsigned pkh2(float lo, float hi) { h16x2 v; v.x = (_Float16)lo; v.y = (_Float16)hi; return __builtin_bit_cast(unsigned, v); }
__device__ __forceinline__ float fexp2(float x) { return __builtin_amdgcn_exp2f(x); }
__device__ __forceinline__ float flog2(float x) { return __builtin_amdgcn_logf(x); }
__device__ __forceinline__ float frcp(float x) { return __builtin_amdgcn_rcpf(x); }
__device__ __forceinline__ float sigmoidf_(float x) { return frcp(1.0f + fexp2(-LOG2E * x)); }
__device__ __forceinline__ float gelu_tanh(float v) { const float u = 0.7978845608028654f * (v + 0.044715f * v * v * v); return v * frcp(1.0f + fexp2(-2.0f * LOG2E * u)); }

__device__ __forceinline__ bf16* x1_row(unsigned char* ws, int m) { return (bf16*)(ws + (m < SEQ ? WS_X1LO : WS_X1HI - (size_t)SEQ * D * 2)) + (size_t)m * D; }
#define XB_TMO      128
#define XB_XCNT(j)  (256  + 64 * (j))
#define XB_XSUB(j)  (1280 + 64 * (j))
#define XB_XGEN(j)  (2304 + 64 * (j))
#define XB_TOP      3328
#define XB_TOPGEN   3392
#define XCD_BAR_WORDS 3456
#define XB_SPIN_CAP (1u << 18)
__device__ __forceinline__ unsigned xb_ld(unsigned* p)              { return __hip_atomic_load(p, __ATOMIC_RELAXED, __HIP_MEMORY_SCOPE_AGENT); }
__device__ __forceinline__ unsigned xb_add(unsigned* p, unsigned v) { return __hip_atomic_fetch_add(p, v, __ATOMIC_RELAXED, __HIP_MEMORY_SCOPE_AGENT); }
__device__ __forceinline__ unsigned xb_xcc_id() { return (unsigned)__builtin_amdgcn_s_getreg((3 << 11) | 20) & 0xFu; }
#define XB_SPIN(cond, bar) do { unsigned _sp = 0; while (cond) { __builtin_amdgcn_s_sleep(1); \
    if ((++_sp & 255u) == 0u) { if (xb_ld(&(bar)[XB_TMO])) break; if (_sp > XB_SPIN_CAP) { atomicAdd(&(bar)[XB_TMO], 1u); break; } } } } while (0)
struct XcdBarrier { unsigned* bar; unsigned x; volatile LAS unsigned* st; unsigned G; };
__device__ __forceinline__ XcdBarrier xcd_barrier_post(unsigned* bar, volatile LAS unsigned* st, unsigned G) {
    XcdBarrier b; b.bar = bar; b.x = xb_xcc_id(); b.st = st; b.G = G;
    if (threadIdx.x == 0) (void)xb_add(&bar[XB_XCNT(b.x)], 1u);
    return b;
}
__device__ __forceinline__ void xcd_barrier_complete(unsigned* bar, unsigned x, unsigned G, unsigned& nloc, unsigned& nx) {
    unsigned sum, cnt, mine, sp = 0u;
    for (;;) {
        sum = 0u; cnt = 0u; mine = 0u;
#pragma unroll
        for (unsigned j = 0; j < 16; ++j) { const unsigned c = xb_ld(&bar[XB_XCNT(j)]); sum += c; cnt += (c > 0u) ? 1u : 0u; mine = (j == x) ? c : mine; }
        if (sum == G) break;
        __builtin_amdgcn_s_sleep(1);
        if ((++sp & 255u) == 0u) { if (xb_ld(&bar[XB_TMO])) break; if (sp > XB_SPIN_CAP) { atomicAdd(&bar[XB_TMO], 1u); break; } }
    }
    nloc = mine > 0u ? mine : 1u; nx = cnt > 0u ? cnt : 1u;
}
__device__ __forceinline__ void xcd_barrier(const XcdBarrier& b) {
    asm volatile("s_waitcnt vmcnt(0)" ::: "memory");
    __syncthreads();
    if (threadIdx.x == 0) {
        unsigned* bar = b.bar;
        __builtin_amdgcn_s_waitcnt(0);
        unsigned nloc = b.st[0], nx = b.st[1];
        if (nloc == 0u) { xcd_barrier_complete(bar, b.x, b.G, nloc, nx); b.st[0] = nloc; b.st[1] = nx; }
        const unsigned old = xb_add(&bar[XB_XSUB(b.x)], 1u);
        const unsigned gen = old / nloc;
        if (old + 1u == (gen + 1u) * nloc) {
            __builtin_amdgcn_fence(__ATOMIC_RELEASE, "agent");
            asm volatile("s_waitcnt vmcnt(0)" ::: "memory");
            const unsigned og = xb_add(&bar[XB_TOP], 1u);
            const unsigned tg = og / nx;
            if (og + 1u == (tg + 1u) * nx) xb_add(&bar[XB_TOPGEN], 1u);
            else XB_SPIN(xb_ld(&bar[XB_TOPGEN]) == tg, bar);
            __builtin_amdgcn_fence(__ATOMIC_ACQUIRE, "agent");
            xb_add(&bar[XB_XGEN(b.x)], 1u);
            asm volatile("s_waitcnt vmcnt(0)" ::: "memory");
        } else {
            XB_SPIN(xb_ld(&bar[XB_XGEN(b.x)]) == gen, bar);
            __builtin_amdgcn_fence(__ATOMIC_ACQUIRE, "agent");
            asm volatile("s_waitcnt vmcnt(0)" ::: "memory");
        }
    }
    __syncthreads();
}

struct Frame {
    LAS unsigned char* lds;
    volatile LAS unsigned* MISC;
    gu32* ctl;
    int tid, lane, wave;
    int vcu, G;
    unsigned char* ws;
    const float* in[25];
    float* out;
};

__device__ __forceinline__ float wave_sum(float v) {
#pragma unroll
    for (int o = 1; o < 64; o <<= 1) v += __shfl_xor(v, o);
    return v;
}

using pg8::Unit;
typedef pg8::f32x4 accv;
struct EpiInProj {
    static constexpr bool PERM = true, AFTER_DRAIN = false; static constexpr bool MIDK = false;
    unsigned short* QKV; bf16* U; float qscale;
    __device__ __forceinline__ void operator()(const accv (&acc)[2][2][4][2], const Unit& u, int wr, int wc, int fr, int fq) const {
        if (u.e == 1) {
            const int row0 = u.pm * 256 + wr * 64 + fr; const int colt = u.pn * 256 + wc * 32 + 8 * fq;
            _Float16* VT = (_Float16*)(QKV + (size_t)2 * M * SBW);
#pragma unroll
            for (int ai = 0; ai < 2; ++ai)
#pragma unroll
                for (int m = 0; m < 4; ++m) { const int row = row0 + ai * 128 + m * 16;
#pragma unroll
                    for (int bj = 0; bj < 2; ++bj) { const int tok = colt + bj * 128; const accv v0 = acc[ai][bj][m][0], v1 = acc[ai][bj][m][1];
                        const int bb = tok >> 13, sq = tok & (SEQ - 1); const int o = sq & 15;
                        _Float16* p = VT + ((size_t)bb * SBW + row) * SEQ + (sq & ~15) + (o >> 1);
                        v2u w0, w1; w0.x = pkh2(v0[0], v0[1]); w0.y = pkh2(v0[2], v0[3]); w1.x = pkh2(v1[0], v1[1]); w1.y = pkh2(v1[2], v1[3]);
                        *(v2u*)p = w0; *(v2u*)(p + 8) = w1; } }
            return;
        }
        const int kind = u.pn >> 1; const int colt = (u.pn & 1) * 256 + wc * 32 + 8 * fq; const int row0 = u.pm * 256 + wr * 64 + fr;
        unsigned short* T = QKV + (size_t)(kind < 2 ? kind : 0) * ((size_t)M * SBW); const float sc = kind == 0 ? qscale : 1.0f;
#pragma unroll
        for (int ai = 0; ai < 2; ++ai)
#pragma unroll
            for (int m = 0; m < 4; ++m) { const int row = row0 + ai * 128 + m * 16;
#pragma unroll
                for (int bj = 0; bj < 2; ++bj) { const int col = colt + bj * 128; const accv v0 = acc[ai][bj][m][0] * sc, v1 = acc[ai][bj][m][1] * sc; v4u w;
                    if (kind < 2) { w.x = pkh2(v0[0], v0[1]); w.y = pkh2(v0[2], v0[3]); w.z = pkh2(v1[0], v1[1]); w.w = pkh2(v1[2], v1[3]);
                        *(v4u*)(T + (size_t)row * SBW + col) = w; }
                    else { w.x = pg8::cvt_pk_bf16(v0[0], v0[1]); w.y = pg8::cvt_pk_bf16(v0[2], v0[3]); w.z = pg8::cvt_pk_bf16(v1[0], v1[1]); w.w = pg8::cvt_pk_bf16(v1[2], v1[3]);
                        *(v4u*)(U + ((size_t)(row >> 5) * NG + (col >> 4)) * UK + (row & 31) * GC + (col & 15)) = w; } } }
    }
};
struct EpiSloc {
    static constexpr bool PERM = false, AFTER_DRAIN = false; static constexpr bool MIDK = false;
    float* S;
    __device__ __forceinline__ void operator()(const accv (&acc)[2][2][4][2], const Unit& u, int wr, int wc, int fr, int fq) const {
        const int row0 = u.pm * 256 + wr * 64 + fr; const int col0 = wc * 32 + 4 * fq;
#pragma unroll
        for (int ai = 0; ai < 2; ++ai)
#pragma unroll
            for (int m = 0; m < 4; ++m) { const int row = row0 + ai * 128 + m * 16;
#pragma unroll
                for (int n = 0; n < 2; ++n) *(accv*)(S + ((size_t)row * NG + u.e) * 128 + col0 + 16 * n) = acc[ai][0][m][n]; }
    }
};
struct EpiS3 {
    static constexpr bool PERM = true, AFTER_DRAIN = false; static constexpr bool MIDK = false;
    bf16* YG;
    __device__ __forceinline__ void operator()(const accv (&acc)[2][2][4][2], const Unit& u, int wr, int wc, int fr, int fq) const {
        const int row0 = u.pm * 256 + wr * 64 + fr; const int colt = u.pn * 256 + wc * 32 + 8 * fq;
#pragma unroll
        for (int ai = 0; ai < 2; ++ai)
#pragma unroll
            for (int m = 0; m < 4; ++m) { const int row = row0 + ai * 128 + m * 16;
#pragma unroll
                for (int bj = 0; bj < 2; ++bj) { const int col = colt + bj * 128; const accv v0 = acc[ai][bj][m][0], v1 = acc[ai][bj][m][1]; v4u w;
                    w.x = pg8::cvt_pk_bf16(gelu_tanh(v0[0]), gelu_tanh(v0[1])); w.y = pg8::cvt_pk_bf16(gelu_tanh(v0[2]), gelu_tanh(v0[3]));
                    w.z = pg8::cvt_pk_bf16(gelu_tanh(v1[0]), gelu_tanh(v1[1])); w.w = pg8::cvt_pk_bf16(gelu_tanh(v1[2]), gelu_tanh(v1[3]));
                    *(v4u*)(YG + ((size_t)row * LC + (col >> 4)) * SSW + u.e * GC + (col & 15)) = w; } }
    }
};
struct EpiGlu {
    static constexpr bool PERM = true, AFTER_DRAIN = false; static constexpr bool MIDK = false;
    bf16* Y; float* SSQ;
    __device__ __forceinline__ void operator()(const accv (&acc)[2][2][4][2], const Unit& u, int wr, int wc, int fr, int fq) const {
        const int row0 = u.pm * 256 + wr * 64 + fr; const int col = u.pn * 128 + wc * 32 + 8 * fq;
#pragma unroll
        for (int ai = 0; ai < 2; ++ai)
#pragma unroll
            for (int m = 0; m < 4; ++m) { const int row = row0 + ai * 128 + m * 16; float r[8]; float sq = 0.f;
#pragma unroll
                for (int n = 0; n < 2; ++n)
#pragma unroll
                    for (int j = 0; j < 4; ++j) { r[4 * n + j] = acc[ai][0][m][n][j] * sigmoidf_(acc[ai][1][m][n][j]); sq += r[4 * n + j] * r[4 * n + j]; }
                sq += __shfl_xor(sq, 16); sq += __shfl_xor(sq, 32);
                if (fq == 0) SSQ[(size_t)row * 16 + u.pn * 4 + wc] = sq;
                v4u w; w.x = pg8::cvt_pk_bf16(r[0], r[1]); w.y = pg8::cvt_pk_bf16(r[2], r[3]); w.z = pg8::cvt_pk_bf16(r[4], r[5]); w.w = pg8::cvt_pk_bf16(r[6], r[7]);
                *(v4u*)(Y + (size_t)row * D + SBW + col) = w; }
    }
};
struct EpiOutProj {
    static constexpr bool PERM = true, AFTER_DRAIN = false; static constexpr bool MIDK = true;
    const float* X; unsigned char* ws; const LAS float* ratio; const LAS float* fin;
    __device__ __forceinline__ void mid(accv (&acc)[2][2][4][2], const Unit& u, int wr, int wc, int fr, int fq) const {
#pragma unroll
        for (int ai = 0; ai < 2; ++ai)
#pragma unroll
            for (int m = 0; m < 4; ++m) { const float rt = ratio[ai * 128 + wr * 64 + m * 16 + fr];
#pragma unroll
                for (int bj = 0; bj < 2; ++bj)
#pragma unroll
                    for (int n = 0; n < 2; ++n) acc[ai][bj][m][n] *= rt; }
    }
    __device__ __forceinline__ void operator()(const accv (&acc)[2][2][4][2], const Unit& u, int wr, int wc, int fr, int fq) const {
        const int row0 = u.pm * 256 + wr * 64 + fr; const int col0 = u.pn * 256 + wc * 32 + 8 * fq;
#pragma unroll
        for (int ai = 0; ai < 2; ++ai)
#pragma unroll
            for (int m = 0; m < 4; ++m) { const int row = row0 + ai * 128 + m * 16; const float* xr = X + (size_t)row * D + col0; bf16* orow = x1_row(ws, row) + col0; const float fs = fin[ai * 128 + wr * 64 + m * 16 + fr];
#pragma unroll
                for (int bj = 0; bj < 2; ++bj) { const accv x0 = *(const accv*)(xr + bj * 128), x1 = *(const accv*)(xr + bj * 128 + 4); const accv v0 = x0 + acc[ai][bj][m][0] * fs, v1 = x1 + acc[ai][bj][m][1] * fs;
                    v4u w; w.x = pg8::cvt_pk_bf16(v0[0], v0[1]); w.y = pg8::cvt_pk_bf16(v0[2], v0[3]); w.z = pg8::cvt_pk_bf16(v1[0], v1[1]); w.w = pg8::cvt_pk_bf16(v1[2], v1[3]);
                    *(v4u*)(orow + bj * 128) = w; }
                if (m & 1) asm volatile("" ::: "memory"); }
    }
};
struct EpiMoe1 {
    static constexpr bool PERM = true, AFTER_DRAIN = false; static constexpr bool MIDK = false;
    bf16* H; const float* bg; const float* bu; const int* rowinfo;
    __device__ __forceinline__ void operator()(const accv (&acc)[2][2][4][2], const Unit& u, int wr, int wc, int fr, int fq) const {
        const int row0 = u.pm * 256 + wr * 64 + fr; const int col = u.pn * 128 + wc * 32 + 8 * fq;
        float bgv[8], buv[8];
#pragma unroll
        for (int n = 0; n < 2; ++n) { const accv a = *(const accv*)(bg + u.e * FF + col + 4 * n), b = *(const accv*)(bu + u.e * FF + col + 4 * n);
#pragma unroll
            for (int j = 0; j < 4; ++j) { bgv[4 * n + j] = a[j]; buv[4 * n + j] = b[j]; } }
        float rsv[2][4];
#pragma unroll
        for (int ai = 0; ai < 2; ++ai)
#pragma unroll
            for (int m = 0; m < 4; ++m) rsv[ai][m] = __builtin_bit_cast(float, rowinfo[4 * (row0 + ai * 128 + m * 16) + 2]);
#pragma unroll
        for (int ai = 0; ai < 2; ++ai)
#pragma unroll
            for (int m = 0; m < 4; ++m) { const int row = row0 + ai * 128 + m * 16; float r[8]; const float rs = rsv[ai][m];
#pragma unroll
                for (int n = 0; n < 2; ++n)
#pragma unroll
                    for (int j = 0; j < 4; ++j) { const float g = fminf(acc[ai][0][m][n][j] * rs + bgv[4 * n + j], 7.0f); const float up = fminf(fmaxf(acc[ai][1][m][n][j] * rs + buv[4 * n + j], -7.0f), 7.0f);
                        r[4 * n + j] = (up + 1.0f) * g * frcp(1.0f + fexp2(-1.702f * LOG2E * g)); }
                v4u w; w.x = pg8::cvt_pk_bf16(r[0], r[1]); w.y = pg8::cvt_pk_bf16(r[2], r[3]); w.z = pg8::cvt_pk_bf16(r[4], r[5]); w.w = pg8::cvt_pk_bf16(r[6], r[7]);
                *(v4u*)(H + (size_t)row * FF + col) = w; }
    }
};
struct EpiMoe2 {
    static constexpr bool PERM = true, AFTER_DRAIN = false; static constexpr bool MIDK = false;
    bf16* Y; const float* bd; const int* rowinfo;
    __device__ __forceinline__ void operator()(const accv (&acc)[2][2][4][2], const Unit& u, int wr, int wc, int fr, int fq) const {
        const int row0 = u.pm * 256 + wr * 64 + fr; const int colt = u.pn * 256 + wc * 32 + 8 * fq;
        float bv[2][8];
#pragma unroll
        for (int bj = 0; bj < 2; ++bj)
#pragma unroll
            for (int n = 0; n < 2; ++n) { const accv a = *(const accv*)(bd + u.e * D + colt + bj * 128 + 4 * n);
#pragma unroll
                for (int j = 0; j < 4; ++j) bv[bj][4 * n + j] = a[j]; }
        v2u sg[2][4];
#pragma unroll
        for (int ai = 0; ai < 2; ++ai)
#pragma unroll
            for (int m = 0; m < 4; ++m) sg[ai][m] = *(const v2u*)(rowinfo + 4 * (row0 + ai * 128 + m * 16));
#pragma unroll
        for (int ai = 0; ai < 2; ++ai)
#pragma unroll
            for (int m = 0; m < 4; ++m) { const int slot = (int)sg[ai][m].x; const unsigned gbits = sg[ai][m].y; const float gate = __builtin_bit_cast(float, gbits);
                if (slot >= 0) {
#pragma unroll
                    for (int bj = 0; bj < 2; ++bj) { float r[8];
#pragma unroll
                        for (int n = 0; n < 2; ++n)
#pragma unroll
                            for (int j = 0; j < 4; ++j) r[4 * n + j] = (acc[ai][bj][m][n][j] + bv[bj][4 * n + j]) * gate;
                        v4u w; w.x = pg8::cvt_pk_bf16(r[0], r[1]); w.y = pg8::cvt_pk_bf16(r[2], r[3]); w.z = pg8::cvt_pk_bf16(r[4], r[5]); w.w = pg8::cvt_pk_bf16(r[6], r[7]);
                        *(v4u*)(Y + (size_t)slot * D + colt + bj * 128) = w; } } }
    }
};

struct InProjOrder {
    int G, c;
    __device__ bool next(int i, Unit& u) const {
        const int L = i * G + c; if (L >= 512) return false;
        const int s = pg8::xcd_remap(L, 512);
        if (s < 384) { const int grp = s / 48, r = s % 48; u.slot = 0; u.pm = grp * 8 + (r & 7); const int pi = r >> 3; u.pn = pi < 4 ? pi : pi + 2; u.e = 0;
            u.offA = (long)u.pm * 256 * D * 2; u.offB = (long)u.pn * 256 * D * 2; }
        else { const int r = s - 384; u.slot = 0; u.pm = r & 1; u.pn = r >> 1; u.e = 1;
            u.offA = (long)(WS_WINT - WS_HN) + (long)(1024 + u.pm * 256) * D * 2; u.offB = (long)(WS_HN - WS_WINT) + (long)u.pn * 256 * D * 2; }
        return true;
    }
    __device__ __forceinline__ void a_ready(const Unit&) const {}
    __device__ __forceinline__ void done(const Unit&) const {}
};
struct SsmOrder {
    int nwg, G, c, npn, rows_per_g, ldb;
    __device__ bool next(int i, Unit& u) const {
        const int L = i * G + c; if (L >= nwg) return false;
        const int per_g = 2 * npn; const int g = L / per_g, r = L % per_g;
        u.e = g; u.pm = r / npn; u.pn = r % npn; u.slot = 0;
        u.offA = ((long)u.pm * 256 * NG * UK + (long)g * UK) * 2; u.offB = ((long)g * rows_per_g + (long)u.pn * 256) * ldb * 2; return true;
    }
    __device__ __forceinline__ void a_ready(const Unit&) const {}
    __device__ __forceinline__ void done(const Unit&) const {}
};
struct MoeOrder {
    const LAS int* units; long ebytes; int gather;
    __device__ bool next(int i, Unit& u) const {
        if (i >= 32) return false;
        const int v = __builtin_amdgcn_readfirstlane(units[4 * i + 3]); if (!v) return false;
        u.pm = __builtin_amdgcn_readfirstlane(units[4 * i + 0]); u.pn = __builtin_amdgcn_readfirstlane(units[4 * i + 1]); u.e = __builtin_amdgcn_readfirstlane(units[4 * i + 2]);
        u.slot = i; u.offA = gather ? 0l : (long)u.pm * 256 * D * 2; u.offB = (long)u.e * ebytes + (long)u.pn * 256 * 16; return true;
    }
    __device__ __forceinline__ void a_ready(const Unit&) const {}
    __device__ __forceinline__ void done(const Unit&) const {}
};

struct CvItem { const float* src; bf16* dst; const float* kscale; int ldw, K, rmul, radd, k0, n0; };
constexpr int CV_I_IN = (D / 64) * (NPROJ / 32), CV_I_GLU = (SSW / 64) * (SSW / 32), CV_I_OUT = (D / 64) * (D / 32), CV_I_E = (D / 64) * (FF / 32);
constexpr int CV_N_EARLY = CV_I_IN + 2 * CV_I_GLU + CV_I_OUT, CV_N_EXP = 3 * NE * (D / 8);
__device__ __forceinline__ void cv_set(CvItem& c, const float* W, int ldw, int K, int N, bf16* WT, int rmul, int radd, int item) {
    const int nblk = N / 32, kb = item / nblk, nb = item % nblk; c.src = W; c.dst = WT; c.kscale = nullptr; c.ldw = ldw; c.K = K; c.rmul = rmul; c.radd = radd; c.k0 = 64 * kb; c.n0 = 32 * nb;
}
__device__ __forceinline__ void cv_decode_early(Frame& F, int r, CvItem& c) {
    bf16* WinT = (bf16*)(F.ws + WS_WINT); bf16* WgluT = (bf16*)(F.ws + WS_WGLUT); bf16* WoutT = (bf16*)(F.ws + WS_WOUTT);
    if (r < CV_I_IN) { cv_set(c, F.in[2], NPROJ, D, NPROJ, WinT, 1, 0, r); return; } r -= CV_I_IN;
    if (r < CV_I_GLU) { cv_set(c, F.in[11], 2 * SSW, SSW, SSW, WgluT, 2, 0, r); return; } r -= CV_I_GLU;
    if (r < CV_I_GLU) { cv_set(c, F.in[11] + SSW, 2 * SSW, SSW, SSW, WgluT, 2, 128, r); return; } r -= CV_I_GLU;
    cv_set(c, F.in[14], D, D, D, WoutT, 1, 0, r);
    c.kscale = (c.k0 < SBW) ? F.in[12] + c.k0 : F.in[13] + (c.k0 - SBW);
}
__device__ __forceinline__ void cv_decode_exp(Frame& F, int r, CvItem& c) {
    bf16* W1T = (bf16*)(F.ws + WS_W1T); bf16* W2T = (bf16*)(F.ws + WS_W2T);
    const int mat = r / CV_I_E, sub = r % CV_I_E, kind = mat / NE, e = mat % NE;
    if (kind == 0) cv_set(c, F.in[18] + (size_t)e * D * FF, FF, D, FF, W1T + (size_t)e * 2 * FF * D, 2, 0, sub);
    else if (kind == 1) cv_set(c, F.in[20] + (size_t)e * D * FF, FF, D, FF, W1T + (size_t)e * 2 * FF * D, 2, 128, sub);
    else cv_set(c, F.in[22] + (size_t)e * FF * D, D, FF, D, W2T + (size_t)e * D * FF, 1, 0, sub);
}
__device__ __forceinline__ void cv_load(const CvItem& c, int lane, float (&v)[32]) {
    const float* p = c.src + (size_t)(c.k0 + (lane >> 5)) * c.ldw + c.n0 + (lane & 31);
#pragma unroll
    for (int i = 0; i < 32; ++i) v[i] = p[(size_t)(2 * i) * c.ldw];
}
__device__ __forceinline__ void cv_store(const CvItem& c, int lane, const float (&v)[32], LAS float* scr) {
#pragma unroll
    for (int i = 0; i < 32; ++i) scr[(2 * i + (lane >> 5)) * 33 + (lane & 31)] = v[i];
    LDS_WAIT(); asm volatile("" ::: "memory");
    const int cc = lane & 7;
#pragma unroll
    for (int j = 0; j < 4; ++j) { const int nl = (lane >> 3) + 8 * j; const int n = c.n0 + nl; const int drow = (n >> 7) * 128 * c.rmul + c.radd + (n & 127); const LAS float* s = scr + (8 * cc) * 33 + nl;
        float e0 = s[0 * 33], e1 = s[1 * 33], e2 = s[2 * 33], e3 = s[3 * 33], e4 = s[4 * 33], e5 = s[5 * 33], e6 = s[6 * 33], e7 = s[7 * 33];
        if (c.kscale) { const f32x4 ka = *(const f32x4*)(c.kscale + 8 * cc), kb = *(const f32x4*)(c.kscale + 8 * cc + 4); e0 *= ka.x; e1 *= ka.y; e2 *= ka.z; e3 *= ka.w; e4 *= kb.x; e5 *= kb.y; e6 *= kb.z; e7 *= kb.w; }
        v4u o; o.x = pg8::cvt_pk_bf16(e0, e1); o.y = pg8::cvt_pk_bf16(e2, e3); o.z = pg8::cvt_pk_bf16(e4, e5); o.w = pg8::cvt_pk_bf16(e6, e7);
        *(GAS v4u*)(c.dst + (size_t)drow * c.K + c.k0 + 8 * cc) = o; }
    LDS_WAIT(); asm volatile("" ::: "memory");
}
__device__ __forceinline__ void cv_item_early(Frame& F, int it, LAS float* scr) { CvItem c; float v[32]; cv_decode_early(F, it, c); cv_load(c, F.lane, v); cv_store(c, F.lane, v, scr); }
__device__ __forceinline__ void cv_run_early(Frame& F, int first, int stride, int n, LAS float* scr) {
    CvItem ca, cb; float va[32], vb[32];
    int it = first; if (it >= n) return;
    cv_decode_early(F, it, ca);
    cv_load(ca, F.lane, va);
    for (;;) {
        const int nit = it + stride; const bool more = nit < n;
        if (more) { cv_decode_early(F, nit, cb); cv_load(cb, F.lane, vb); }
        cv_store(ca, F.lane, va, scr);
        if (!more) break;
        ca = cb;
#pragma unroll
        for (int i = 0; i < 32; ++i) va[i] = vb[i];
        it = nit;
    }
}
__device__ __forceinline__ void xv_item(Frame& F, int it) {
    bf16* W1T = (bf16*)(F.ws + WS_W1T); bf16* W2T = (bf16*)(F.ws + WS_W2T);
    const float* w0 = F.in[18]; const float* w1 = F.in[20]; const float* w2 = F.in[22];
    asm volatile("" : "+s"(w0), "+s"(w1), "+s"(w2));
    const int lane = F.lane;
    {
        const int mat = it >> 7, kb = it & 127, kind = mat / NE, e = mat % NE;
        const float* src = (kind == 0 ? w0 : (kind == 1 ? w1 : w2)) + (size_t)e * D * FF + (size_t)(kb * 8) * FF + 4 * lane;
        f32x4 v[8][4];
#pragma unroll
        for (int rr = 0; rr < 8; ++rr)
#pragma unroll
            for (int j = 0; j < 4; ++j) v[rr][j] = *(const GAS f32x4*)(src + (size_t)rr * FF + 256 * j);
        bf16* dst; int cstride;
        if (kind < 2) { dst = W1T + (size_t)e * 2 * FF * D + ((size_t)kb * 2 * FF + (size_t)(lane >> 5) * 256 + (kind == 1 ? 128 : 0) + 4 * (lane & 31)) * 8; cstride = 512 * 8; }
        else { dst = W2T + (size_t)e * D * FF + ((size_t)kb * D + 4 * lane) * 8; cstride = 256 * 8; }
#pragma unroll
        for (int j = 0; j < 4; ++j)
#pragma unroll
            for (int c = 0; c < 4; ++c) { v4u o; o.x = pg8::cvt_pk_bf16(v[0][j][c], v[1][j][c]); o.y = pg8::cvt_pk_bf16(v[2][j][c], v[3][j][c]); o.z = pg8::cvt_pk_bf16(v[4][j][c], v[5][j][c]); o.w = pg8::cvt_pk_bf16(v[6][j][c], v[7][j][c]);
                *(GAS v4u*)(dst + (size_t)j * cstride + c * 8) = o; }
    }
}
__device__ __forceinline__ void rms_row_to_bf16(int lane, const float* xrow, const float* g, bf16* orow) {
    const GAS f32x4* xr = (const GAS f32x4*)xrow + lane; const GAS f32x4* gr = (const GAS f32x4*)g + lane;
    f32x4 v[4]; float s = 0.f;
#pragma unroll
    for (int j = 0; j < 4; ++j) { v[j] = xr[64 * j]; s += (v[j].x * v[j].x + v[j].y * v[j].y) + (v[j].z * v[j].z + v[j].w * v[j].w); }
    const float rstd = 1.0f / sqrtf(wave_sum(s) * (1.f / D) + EPS);
    GAS unsigned long long* o8 = (GAS unsigned long long*)orow + lane;
#pragma unroll
    for (int j = 0; j < 4; ++j) { const f32x4 gg = gr[64 * j]; o8[64 * j] = (unsigned long long)pk2(v[j].x * rstd * gg.x, v[j].y * rstd * gg.y) | ((unsigned long long)pk2(v[j].z * rstd * gg.z, v[j].w * rstd * gg.w) << 32); }
}
__device__ __forceinline__ void sincos_acc(float th, float& s, float& c) {
    const float k = rintf(th * 0.15915494309189535f);
    float r = fmaf(-k, 6.28125f, th); r = fmaf(-k, 1.9353071795864769e-3f, r);
    const float x = 0.25f * r, x2 = x * x;
    float sn = x * (1.0f + x2 * (-1.0f / 6 + x2 * (1.0f / 120 + x2 * (-1.0f / 5040 + x2 * (1.0f / 362880 + x2 * (-1.0f / 39916800))))));
    float cs = 1.0f + x2 * (-0.5f + x2 * (1.0f / 24 + x2 * (-1.0f / 720 + x2 * (1.0f / 40320 + x2 * (-1.0f / 3628800 + x2 * (1.0f / 479001600))))));
#pragma unroll
    for (int i = 0; i < 2; ++i) { const float s2 = 2.0f * sn * cs, c2 = 1.0f - 2.0f * sn * sn; sn = s2; cs = c2; }
    s = sn; c = cs;
}
__device__ __forceinline__ void ssm_tables(Frame& F, int g) {
    constexpr int PT = 36, BS = 17, CS = 68, KT = 324, KC = 20;
    LAS float* pwr = (LAS float*)(F.lds);
    LAS float* pwi = pwr + 64 * PT;
    LAS float* bbr = pwi + 64 * PT;
    LAS float* bbi = bbr + 64 * BS;
    LAS float* ccr = bbi + 64 * BS;
    LAS float* cci = ccr + 16 * CS;
    LAS float* km = cci + 16 * CS;
    const float* lam_re = F.in[3]; const float* lam_im = F.in[4]; const float* log_dt = F.in[5];
    const float* b_re = F.in[6]; const float* b_im = F.in[7]; const float* c_re = F.in[8]; const float* c_im = F.in[9]; const float* dsk = F.in[10];
    float* lamL = (float*)(F.ws + WS_LAML); bf16* WE = (bf16*)(F.ws + WS_WE); bf16* TW = (bf16*)(F.ws + WS_TW);
    const int tid = F.tid;
    if (tid < 64) { const int p = tid;
        const float lr = lam_re[g * NP + p], li = lam_im[g * NP + p], dt = expf(log_dt[g]);
        const float er = expf(lr * dt); float sn, cs; sincos_acc(li * dt, sn, cs);
        const float br = er * cs, bi = er * sn;
        const float nr = br - 1.0f, ni = bi, den = 1.0f / (lr * lr + li * li);
        const float fr = (nr * lr + ni * li) * den, fi = (ni * lr - nr * li) * den;
        float pr = 1.0f, pi = 0.0f;
        for (int n = 0; n <= 32; ++n) { pwr[p * PT + n] = pr; pwi[p * PT + n] = pi; const float t = pr * br - pi * bi; pi = pr * bi + pi * br; pr = t; }
        lamL[(g * 2 + 0) * NP + p] = pwr[p * PT + 32]; lamL[(g * 2 + 1) * NP + p] = pwi[p * PT + 32];
        float xr[GC], xi[GC];
#pragma unroll
        for (int c = 0; c < GC; ++c) { xr[c] = b_re[(g * NP + p) * GC + c]; xi[c] = b_im[(g * NP + p) * GC + c]; }
#pragma unroll
        for (int c = 0; c < GC; ++c) { bbr[p * BS + c] = fr * xr[c] - fi * xi[c]; bbi[p * BS + c] = fr * xi[c] + fi * xr[c]; }
    }
    for (int i = tid; i < 1024; i += NWAVES * 64) { ccr[(i >> 6) * CS + (i & 63)] = c_re[g * 1024 + i]; cci[(i >> 6) * CS + (i & 63)] = c_im[g * 1024 + i]; }
    __syncthreads();
    {
        const int pair = tid & 255, co = pair >> 4, ci = pair & 15, t0 = (tid >> 8) * 16;
        float acc[16];
#pragma unroll
        for (int t = 0; t < 16; ++t) acc[t] = 0.f;
        for (int p = 0; p < NP; ++p) { const float cr = ccr[co * CS + p], cim = cci[co * CS + p], xr = bbr[p * BS + ci], xi = bbi[p * BS + ci];
            const float gr = cr * xr - cim * xi, gi = cr * xi + cim * xr;
#pragma unroll
            for (int t4 = 0; t4 < 4; ++t4) { const f32x4 a = *(const LAS f32x4*)(pwr + p * PT + t0 + 4 * t4), bq = *(const LAS f32x4*)(pwi + p * PT + t0 + 4 * t4);
#pragma unroll
                for (int t = 0; t < 4; ++t) acc[4 * t4 + t] += gr * a[t] - gi * bq[t]; } }
#pragma unroll
        for (int t = 0; t < 16; ++t) km[(t0 + t) * KT + co * KC + ci] = acc[t];
    }
    __syncthreads();
    {
        const int n = tid, i = n >> 4, co = n & 15; const float dv = dsk[g * GC + co];
        bf16* dst = TW + ((size_t)g * 512 + n) * UK;
        for (int j = 0; j < LC; ++j) {
            float v[16];
            const LAS float* kr = km + (j <= i ? i - j : 0) * KT + co * KC;
#pragma unroll
            for (int c4 = 0; c4 < 4; ++c4) { const f32x4 q = *(const LAS f32x4*)(kr + 4 * c4);
#pragma unroll
                for (int t = 0; t < 4; ++t) v[4 * c4 + t] = (j <= i) ? q[t] : 0.f; }
            if (j == i) {
#pragma unroll
                for (int ci = 0; ci < 16; ++ci) v[ci] += (ci == co) ? dv : 0.f; }
            v4u o0, o1; o0.x = pg8::cvt_pk_bf16(v[0], v[1]); o0.y = pg8::cvt_pk_bf16(v[2], v[3]); o0.z = pg8::cvt_pk_bf16(v[4], v[5]); o0.w = pg8::cvt_pk_bf16(v[6], v[7]);
            o1.x = pg8::cvt_pk_bf16(v[8], v[9]); o1.y = pg8::cvt_pk_bf16(v[10], v[11]); o1.z = pg8::cvt_pk_bf16(v[12], v[13]); o1.w = pg8::cvt_pk_bf16(v[14], v[15]);
            *(GAS v4u*)(dst + j * 16) = o0; *(GAS v4u*)(dst + j * 16 + 8) = o1; }
        for (int k8 = 0; k8 < 16; ++k8) { float v[8];
            const int ri = k8 >> 3, p0 = 8 * (k8 & 7);
#pragma unroll
            for (int e = 0; e < 8; ++e) { const int p = p0 + e; const float cr = ccr[co * CS + p], cim = cci[co * CS + p], pr = pwr[p * PT + i + 1], pi = pwi[p * PT + i + 1];
                v[e] = ri == 0 ? (cr * pr - cim * pi) : -(cr * pi + cim * pr); }
            v4u o; o.x = pg8::cvt_pk_bf16(v[0], v[1]); o.y = pg8::cvt_pk_bf16(v[2], v[3]); o.z = pg8::cvt_pk_bf16(v[4], v[5]); o.w = pg8::cvt_pk_bf16(v[6], v[7]);
            *(GAS v4u*)(dst + 512 + k8 * 8) = o; }
    }
    {
        const int row = tid & 127, ri = row >> 6, p = row & 63, kq = tid >> 7;
        bf16* dst = WE + ((size_t)g * 128 + row) * 512 + kq * 128;
        for (int k8 = 0; k8 < 16; ++k8) { float v[8];
#pragma unroll
            for (int e = 0; e < 8; ++e) { const int k = kq * 128 + k8 * 8 + e, j = k >> 4, c = k & 15; const float pr = pwr[p * PT + 31 - j], pi = pwi[p * PT + 31 - j], xr = bbr[p * BS + c], xi = bbi[p * BS + c];
                v[e] = ri == 0 ? (pr * xr - pi * xi) : (pr * xi + pi * xr); }
            v4u o; o.x = pg8::cvt_pk_bf16(v[0], v[1]); o.y = pg8::cvt_pk_bf16(v[2], v[3]); o.z = pg8::cvt_pk_bf16(v[4], v[5]); o.w = pg8::cvt_pk_bf16(v[6], v[7]);
            *(GAS v4u*)(dst + k8 * 8) = o; }
    }
    __syncthreads();
}
__device__ __forceinline__ void rms_rows4_to_bf16(int lane, const float* x0, const float* g, bf16* o0) {
    const GAS f32x4* gr = (const GAS f32x4*)g + lane;
    f32x4 v[4][4]; float sq[4];
#pragma unroll
    for (int r = 0; r < 4; ++r)
#pragma unroll
        for (int j = 0; j < 4; ++j) v[r][j] = ((const GAS f32x4*)(x0 + (size_t)r * D) + lane)[64 * j];
#pragma unroll
    for (int r = 0; r < 4; ++r) { sq[r] = 0.f;
#pragma unroll
        for (int j = 0; j < 4; ++j) sq[r] += (v[r][j].x * v[r][j].x + v[r][j].y * v[r][j].y) + (v[r][j].z * v[r][j].z + v[r][j].w * v[r][j].w); }
#pragma unroll
    for (int o = 1; o < 64; o <<= 1) {
#pragma unroll
        for (int r = 0; r < 4; ++r) sq[r] += __shfl_xor(sq[r], o); }
#pragma unroll
    for (int j = 0; j < 4; ++j) { const f32x4 gg = gr[64 * j];
#pragma unroll
        for (int r = 0; r < 4; ++r) { const float rs = 1.0f / sqrtf(sq[r] * (1.f / D) + EPS); v2u w; w.x = pg8::cvt_pk_bf16(v[r][j].x * rs * gg.x, v[r][j].y * rs * gg.y); w.y = pg8::cvt_pk_bf16(v[r][j].z * rs * gg.z, v[r][j].w * rs * gg.w);
            ((GAS v2u*)(o0 + (size_t)r * D) + lane)[64 * j] = w; } }
}
__device__ __forceinline__ void rms_rows2_to_bf16(int lane, const float* x0, const float* x1, const float* g, bf16* o0, bf16* o1) {
    const GAS f32x4* xa = (const GAS f32x4*)x0 + lane; const GAS f32x4* xb = (const GAS f32x4*)x1 + lane; const GAS f32x4* gr = (const GAS f32x4*)g + lane;
    f32x4 va[4], vb[4]; float sa = 0.f, sb = 0.f;
#pragma unroll
    for (int j = 0; j < 4; ++j) { va[j] = xa[64 * j]; vb[j] = xb[64 * j]; }
#pragma unroll
    for (int j = 0; j < 4; ++j) { sa += (va[j].x * va[j].x + va[j].y * va[j].y) + (va[j].z * va[j].z + va[j].w * va[j].w); sb += (vb[j].x * vb[j].x + vb[j].y * vb[j].y) + (vb[j].z * vb[j].z + vb[j].w * vb[j].w); }
#pragma unroll
    for (int o = 1; o < 64; o <<= 1) { sa += __shfl_xor(sa, o); sb += __shfl_xor(sb, o); }
    const float ra = 1.0f / sqrtf(sa * (1.f / D) + EPS), rb = 1.0f / sqrtf(sb * (1.f / D) + EPS);
    GAS v2u* pa = (GAS v2u*)o0 + lane; GAS v2u* pb = (GAS v2u*)o1 + lane;
#pragma unroll
    for (int j = 0; j < 4; ++j) { const f32x4 gg = gr[64 * j];
        v2u wa, wb; wa.x = pg8::cvt_pk_bf16(va[j].x * ra * gg.x, va[j].y * ra * gg.y); wa.y = pg8::cvt_pk_bf16(va[j].z * ra * gg.z, va[j].w * ra * gg.w);
        wb.x = pg8::cvt_pk_bf16(vb[j].x * rb * gg.x, vb[j].y * rb * gg.y); wb.y = pg8::cvt_pk_bf16(vb[j].z * rb * gg.z, vb[j].w * rb * gg.w);
        pa[64 * j] = wa; pb[64 * j] = wb; }
}
constexpr int CV_N_W1 = 2 * NE * (D / 8);
constexpr int P1_GEMM_WG = 176;
constexpr int Q0_HN = M / 8, Q0_END = Q0_HN + CV_N_EARLY / 4;
static_assert(Q0_END % 8 == 0 && CV_N_EARLY % 4 == 0, "P0 queue");
__device__ __forceinline__ void p0_prologue(Frame& F, unsigned long long& t_lo_, unsigned long long& t_hi_) {
    TMARK(100);
    LAS float* scr = (LAS float*)(F.lds + RING_OFF + F.wave * 16384);
    unsigned* q = (unsigned*)(F.ctl + CW_Q0); volatile LAS unsigned* slot = F.MISC + 16;
    bf16* HN = (bf16*)(F.ws + WS_HN);
    for (;;) {
        __syncthreads();
        if (F.tid == 0) *slot = __hip_atomic_fetch_add(q, 8u, RLX_AGENT);
        __syncthreads();
        const int base = (int)__builtin_amdgcn_readfirstlane(*slot); if (base >= Q0_END) break;
        const int idx = base + F.wave;
        if (idx < Q0_HN) { const int m0 = idx * 8;
#pragma unroll 1
            for (int j = 0; j < 2; ++j) { const int m = m0 + 4 * j; rms_rows4_to_bf16(F.lane, F.in[0] + (size_t)m * D, F.in[1], HN + (size_t)m * D); } }
        else { const int g4 = (idx - Q0_HN) * 4;
#pragma unroll 1
            for (int j = 0; j < 4; ++j) cv_item_early(F, g4 + j, scr); }
    }
    TMARK(104);
}
__device__ __forceinline__ void q1_drain(Frame& F, int max_claims, unsigned* stop, unsigned stop_target) {
    unsigned* q = (unsigned*)(F.ctl + CW_Q1); volatile LAS unsigned* slot = F.MISC + 18;
    for (int n = 0; max_claims < 0 || n < max_claims; ++n) {
        __syncthreads();
        if (F.tid == 0) { unsigned v = 0x7fffffffu; if (!(stop_target && __hip_atomic_load(stop, RLX_AGENT) >= stop_target)) v = __hip_atomic_fetch_add(q, 8u, RLX_AGENT); *slot = v; }
        __syncthreads();
        const unsigned base = (unsigned)__builtin_amdgcn_readfirstlane(*slot); if (base >= (unsigned)CV_N_W1) break;
        xv_item(F, (int)base + F.wave);
    }
}
__device__ __forceinline__ void p1_side(Frame& F, int tabler_idx) {
    if (tabler_idx >= 0) { ssm_tables(F, tabler_idx);
        if (tabler_idx == 0 && F.tid < 128) {
            bf16* WE = (bf16*)(F.ws + WS_WE) + (size_t)NG * 128 * 512;
            for (int i = 0; i < 512 / 8; ++i) *(GAS v4u*)(WE + (size_t)F.tid * 512 + i * 8) = (v4u){0u, 0u, 0u, 0u}; }
        if (tabler_idx == 1) {
            const float* wr = F.in[16]; bf16* img = (bf16*)(F.ws + WS_RWIMG);
            for (int idx = F.tid; idx < D * NE; idx += NWAVES * 64) { const float w = wr[idx]; const unsigned h = f2bf(w); const unsigned l = f2bf(w - bf2f((unsigned short)h)); const int k = idx >> 5, e = idx & 31;
                img[e * RT_WSTR + k] = (bf16)h; img[(NE + e) * RT_WSTR + k] = (bf16)l; }
            if (F.tid < 2 * NE) for (int k = D; k < RT_WSTR; ++k) img[F.tid * RT_WSTR + k] = 0; } }
    q1_drain(F, -1, (unsigned*)(F.ctl + CW_DONE1), (unsigned)P1_GEMM_WG);
}
__device__ __forceinline__ void w2_drain(Frame& F, int max_claims) {
    unsigned* q = (unsigned*)(F.ctl + CW_Q2); volatile LAS unsigned* slot = F.MISC + 19;
    for (int n = 0; max_claims < 0 || n < max_claims; ++n) {
        __syncthreads();
        if (F.tid == 0) *slot = __hip_atomic_fetch_add(q, 8u, RLX_AGENT);
        __syncthreads();
        const int base = CV_N_W1 + (int)__builtin_amdgcn_readfirstlane(*slot); if (base >= CV_N_EXP) break;
        xv_item(F, base + F.wave);
    }
}

__device__ __forceinline__ void attn_simple_unit(const unsigned short* Qh, const unsigned short* Kh, const unsigned short* Vh, bf16* Y, int b, int h, int qb, int lane) {
    const int t = qb * 64 + lane; const size_t row = (size_t)b * SEQ + t;
    float q[64], o[64];
    { const v4u* qp = (const v4u*)(Qh + row * SBW + h * HD);
#pragma unroll
      for (int i = 0; i < 8; ++i) { const v4u w = qp[i];
#pragma unroll
          for (int j = 0; j < 4; ++j) { const unsigned wj = w[j]; const h16x2 hv = __builtin_bit_cast(h16x2, wj); q[8 * i + 2 * j] = (float)hv.x; q[8 * i + 2 * j + 1] = (float)hv.y; } } }
#pragma unroll
    for (int d = 0; d < 64; ++d) o[d] = 0.f;
    float cum = 0.f;
    for (int s = qb * 64 + 62; s >= 0; --s) {
        const size_t krow = ((size_t)b * SEQ + s) * SBW + h * HD;
        const v4u* kp = (const v4u*)(Kh + krow); const v4u* vp = (const v4u*)(Vh + krow);
        float z = 0.f;
#pragma unroll
        for (int i = 0; i < 8; ++i) { const v4u w = kp[i];
#pragma unroll
            for (int j = 0; j < 4; ++j) { const unsigned wj = w[j]; const h16x2 hv = __builtin_bit_cast(h16x2, wj); z = fmaf(q[8 * i + 2 * j], (float)hv.x, z); z = fmaf(q[8 * i + 2 * j + 1], (float)hv.y, z); } }
        const bool act = s < t;
        const float t1 = flog2(1.0f + fexp2(-fabsf(z)));
        const float L = act ? -(fmaxf(z, 0.f) + t1) : 0.f;
        const float ls = fminf(z, 0.f) - t1;
        const float p = act ? fexp2(ls + cum) : 0.f;
        cum += L;
#pragma unroll
        for (int i = 0; i < 8; ++i) { const v4u w = vp[i];
#pragma unroll
            for (int j = 0; j < 4; ++j) { const unsigned wj = w[j]; const h16x2 hv = __builtin_bit_cast(h16x2, wj); o[8 * i + 2 * j] = fmaf(p, (float)hv.x, o[8 * i + 2 * j]); o[8 * i + 2 * j + 1] = fmaf(p, (float)hv.y, o[8 * i + 2 * j + 1]); } }
        if (__all(cum < -150.0f)) break;
    }
    bf16* yp = Y + row * SBW + h * HD;
#pragma unroll
    for (int i = 0; i < 8; ++i) { v4u w; w.x = pk2(o[8 * i], o[8 * i + 1]); w.y = pk2(o[8 * i + 2], o[8 * i + 3]); w.z = pk2(o[8 * i + 4], o[8 * i + 5]); w.w = pk2(o[8 * i + 6], o[8 * i + 7]); *(v4u*)(yp + 8 * i) = w; }
}
typedef _Float16 h8v __attribute__((ext_vector_type(8)));
typedef float f16v __attribute__((ext_vector_type(16)));
__device__ __forceinline__ void attn_mfma_unit(const _Float16* Qh, const _Float16* Kh, const _Float16* VT, bf16* Y, float* SSQ, int b, int hd, int qb, int lane, h8v tri0, h8v tri1) {
    const int r = lane & 31, hh = lane >> 5, q0 = qb * 32;
    const _Float16* qrow = Qh + ((size_t)b * SEQ + q0 + r) * SBW + hd * HD + 8 * hh;
    h8v qf[4];
#pragma unroll
    for (int kd = 0; kd < 4; ++kd) qf[kd] = *(const h8v*)(qrow + 16 * kd);
    f16v o0, o1;
#pragma unroll
    for (int i = 0; i < 16; ++i) { o0[i] = 0.f; o1[i] = 0.f; }
    float carry = 0.f;
    const _Float16* kbase = Kh + ((size_t)b * SEQ + r) * SBW + hd * HD + 8 * hh;
    const _Float16* vbase = VT + ((size_t)b * SBW + hd * HD + r) * SEQ + 8 * hh;
    h8v kf[4], vf[2][2], kn[4], vn[2][2];
#pragma unroll
    for (int kd = 0; kd < 4; ++kd) kf[kd] = *(const h8v*)(kbase + (size_t)q0 * SBW + 16 * kd);
#pragma unroll
    for (int db = 0; db < 2; ++db)
#pragma unroll
        for (int ss = 0; ss < 2; ++ss) vf[db][ss] = *(const h8v*)(vbase + (size_t)(32 * db) * SEQ + q0 + 16 * ss);
    for (int key0 = q0; key0 >= 0; key0 -= 32) {
        { const int kn0 = key0 >= 32 ? key0 - 32 : key0;
#pragma unroll
          for (int kd = 0; kd < 4; ++kd) kn[kd] = *(const h8v*)(kbase + (size_t)kn0 * SBW + 16 * kd);
#pragma unroll
          for (int db = 0; db < 2; ++db)
#pragma unroll
              for (int ss = 0; ss < 2; ++ss) vn[db][ss] = *(const h8v*)(vbase + (size_t)(32 * db) * SEQ + kn0 + 16 * ss); }
        f16v z;
#pragma unroll
        for (int i = 0; i < 16; ++i) z[i] = 0.f;
#pragma unroll
        for (int kd = 0; kd < 4; ++kd) z = __builtin_amdgcn_mfma_f32_32x32x16_f16(kf[kd], qf[kd], z, 0, 0, 0);
        const bool diag = key0 == q0;
        h8v lh[2], ll[2];
#pragma unroll
        for (int i = 0; i < 16; ++i) { const int koff = (i & 3) + 8 * (i >> 2) + 4 * hh; const bool act = !diag || koff < r;
            const float zi = z[i]; const float t1 = flog2(1.0f + fexp2(-fabsf(zi)));
            const float L = act ? fmaxf(-(fmaxf(zi, 0.f) + t1), -60000.0f) : 0.f;
            const _Float16 hi = (_Float16)L; const _Float16 lo = (_Float16)(L - (float)hi);
            lh[i >> 3][i & 7] = hi; ll[i >> 3][i & 7] = lo; }
        f16v cum;
#pragma unroll
        for (int i = 0; i < 16; ++i) cum[i] = carry;
        cum = __builtin_amdgcn_mfma_f32_32x32x16_f16(tri0, lh[0], cum, 0, 0, 0);
        cum = __builtin_amdgcn_mfma_f32_32x32x16_f16(tri1, lh[1], cum, 0, 0, 0);
        cum = __builtin_amdgcn_mfma_f32_32x32x16_f16(tri0, ll[0], cum, 0, 0, 0);
        cum = __builtin_amdgcn_mfma_f32_32x32x16_f16(tri1, ll[1], cum, 0, 0, 0);
        h8v pf[2];
#pragma unroll
        for (int i = 0; i < 16; ++i) { const int koff = (i & 3) + 8 * (i >> 2) + 4 * hh; const bool act = !diag || koff < r;
            const float p = act ? fexp2(z[i] + cum[i]) : 0.f; pf[i >> 3][i & 7] = (_Float16)p; }
        o0 = __builtin_amdgcn_mfma_f32_32x32x16_f16(vf[0][0], pf[0], o0, 0, 0, 0);
        o0 = __builtin_amdgcn_mfma_f32_32x32x16_f16(vf[0][1], pf[1], o0, 0, 0, 0);
        o1 = __builtin_amdgcn_mfma_f32_32x32x16_f16(vf[1][0], pf[0], o1, 0, 0, 0);
        o1 = __builtin_amdgcn_mfma_f32_32x32x16_f16(vf[1][1], pf[1], o1, 0, 0, 0);
        carry = __shfl(cum[0], r);
        if (__all(carry < -150.0f)) break;
#pragma unroll
        for (int kd = 0; kd < 4; ++kd) kf[kd] = kn[kd];
#pragma unroll
        for (int db = 0; db < 2; ++db)
#pragma unroll
            for (int ss = 0; ss < 2; ++ss) vf[db][ss] = vn[db][ss];
    }
    { float sq = 0.f;
#pragma unroll
      for (int i = 0; i < 16; ++i) sq += o0[i] * o0[i] + o1[i] * o1[i];
      sq += __shfl_xor(sq, 32); if (hh == 0) SSQ[((size_t)b * SEQ + q0 + r) * NH + hd] = sq; }
    bf16* yp = Y + ((size_t)b * SEQ + q0 + r) * D + hd * HD + 4 * hh;
#pragma unroll
    for (int g4 = 0; g4 < 4; ++g4) { v2u w0, w1; w0.x = pk2(o0[4 * g4], o0[4 * g4 + 1]); w0.y = pk2(o0[4 * g4 + 2], o0[4 * g4 + 3]); w1.x = pk2(o1[4 * g4], o1[4 * g4 + 1]); w1.y = pk2(o1[4 * g4 + 2], o1[4 * g4 + 3]);
        *(v2u*)(yp + 8 * g4) = w0; *(v2u*)(yp + 32 + 8 * g4) = w1; }
}
__device__ __forceinline__ void attn_one(Frame& F, int u) {
    const _Float16* Qh = (const _Float16*)(F.ws + WS_Q); const _Float16* Kh = (const _Float16*)(F.ws + WS_K); const _Float16* VT = (const _Float16*)(F.ws + WS_V);
    bf16* Y = (bf16*)(F.ws + WS_YCAT); float* SSQ = (float*)(F.ws + WS_SSQSB);
    constexpr int NQB = SEQ / 32;
    const int lane = F.lane, r = lane & 31, hh = lane >> 5;
    h8v tri0, tri1;
#pragma unroll
    for (int e = 0; e < 8; ++e) { const int k0 = 8 * (e >> 2) + 4 * hh + (e & 3); tri0[e] = (k0 >= r) ? (_Float16)1.0f : (_Float16)0.0f; tri1[e] = (16 + k0 >= r) ? (_Float16)1.0f : (_Float16)0.0f; }
    const int qb = u % NQB, bh = u / NQB; attn_mfma_unit(Qh, Kh, VT, Y, SSQ, bh / NH, bh % NH, qb, lane, tri0, tri1);
}

__device__ __forceinline__ void scan_phase(Frame& F, int task) {
    const int b = task / NG, g = task % NG, p = F.lane;
    const float* lamL = (const float*)(F.ws + WS_LAML); const float* S = (const float*)(F.ws + WS_SLOC); bf16* U = (bf16*)(F.ws + WS_UCAT);
    const float lr = lamL[(g * 2 + 0) * NP + p], li = lamL[(g * 2 + 1) * NP + p];
    float xr = 0.f, xi = 0.f;
    for (int c0 = 0; c0 < CPB; c0 += 8) {
        float sr[8], si[8];
#pragma unroll
        for (int j = 0; j < 8; ++j) { const size_t base = ((size_t)(b * CPB + c0 + j) * NG + g) * 128; sr[j] = S[base + p]; si[j] = S[base + 64 + p]; }
#pragma unroll
        for (int j = 0; j < 8; ++j) { bf16* dst = U + ((size_t)(b * CPB + c0 + j) * NG + g) * UK + 512;
            dst[p] = (bf16)f2bf(xr); dst[64 + p] = (bf16)f2bf(xi);
            const float nr = lr * xr - li * xi + sr[j], ni = lr * xi + li * xr + si[j]; xr = nr; xi = ni; }
    }
}

__device__ __forceinline__ void router_phase(Frame& F) {
    typedef short s8v __attribute__((ext_vector_type(8)));
    typedef float f16v __attribute__((ext_vector_type(16)));
    LAS bf16* wh = (LAS bf16*)F.lds; LAS bf16* wl = wh + NE * RT_WSTR;
    LAS int* lcnt = (LAS int*)(F.lds + RT_SCR_OFF); LAS int* lbase = lcnt + 32; LAS int* asg = lbase + 32;
    const float* wr = F.in[16]; const float* br = F.in[17]; const float* g2 = F.in[15];
    bf16* XG = (bf16*)(F.ws + WS_XN); float* gates = (float*)(F.ws + WS_GATES); int* lists = (int*)(F.ws + WS_LISTS); float* RS = (float*)(F.ws + WS_RSTD);
    unsigned* gcnt = (unsigned*)(F.ctl + CW_CNT);
    const int tid = F.tid, lane = F.lane, r = lane & 31, hh = lane >> 5;
    const int task = F.wave >> 2, kq = F.wave & 3; const int tok = F.vcu * 64 + task * 32 + r;
    const bf16* xp = x1_row(F.ws, tok) + kq * 256 + 8 * hh; bf16* xo = XG + (size_t)tok * D + kq * 256 + 8 * hh;
    v4u xw[16];
#pragma unroll
    for (int ks = 0; ks < 16; ++ks) xw[ks] = *(const v4u*)(xp + 16 * ks);
    { const v4u* src = (const v4u*)(F.ws + WS_RWIMG); LAS v4u* dst = (LAS v4u*)F.lds;
      for (int i = tid; i < RT_W_BYTES / 16; i += NWAVES * 64) dst[i] = src[i]; }
    LAS float* gl = (LAS float*)(F.lds + RT_SCR_OFF + 2048);
    for (int i = tid; i < D / 4; i += NWAVES * 64) ((LAS f32x4*)gl)[i] = ((const f32x4*)g2)[i];
    if (tid < 32) lcnt[tid] = 0;
    __syncthreads();
    f16v acc;
#pragma unroll
    for (int i = 0; i < 16; ++i) acc[i] = 0.f;
    float ss = 0.f;
    const LAS float* gp = gl + kq * 256 + 8 * hh;
    const LAS bf16* whp = wh + r * RT_WSTR + kq * 256 + 8 * hh; const LAS bf16* wlp = wl + r * RT_WSTR + kq * 256 + 8 * hh;
#pragma unroll
    for (int ks = 0; ks < 16; ++ks) {
        const v4u xq = xw[ks]; const f32x4 x0 = (f32x4){bflo(xq.x), bfhi(xq.x), bflo(xq.y), bfhi(xq.y)}, x1 = (f32x4){bflo(xq.z), bfhi(xq.z), bflo(xq.w), bfhi(xq.w)}, g0 = *(const LAS f32x4*)(gp + 16 * ks), g1 = *(const LAS f32x4*)(gp + 16 * ks + 4);
        ss += (x0.x * x0.x + x0.y * x0.y) + (x0.z * x0.z + x0.w * x0.w) + (x1.x * x1.x + x1.y * x1.y) + (x1.z * x1.z + x1.w * x1.w);
        const f32x4 a0 = x0 * g0, a1 = x1 * g1;
        v4u hv, lv;
        hv.x = pg8::cvt_pk_bf16(a0.x, a0.y); hv.y = pg8::cvt_pk_bf16(a0.z, a0.w); hv.z = pg8::cvt_pk_bf16(a1.x, a1.y); hv.w = pg8::cvt_pk_bf16(a1.z, a1.w);
        lv.x = pg8::cvt_pk_bf16(a0.x - bflo(hv.x), a0.y - bfhi(hv.x)); lv.y = pg8::cvt_pk_bf16(a0.z - bflo(hv.y), a0.w - bfhi(hv.y));
        lv.z = pg8::cvt_pk_bf16(a1.x - bflo(hv.z), a1.y - bfhi(hv.z)); lv.w = pg8::cvt_pk_bf16(a1.z - bflo(hv.w), a1.w - bfhi(hv.w));
        *(v4u*)(xo + 16 * ks) = hv;
        const s8v xh = __builtin_bit_cast(s8v, hv), xl = __builtin_bit_cast(s8v, lv);
        v4u ah, al; { const LAS v2u* p = (const LAS v2u*)(whp + 16 * ks); const v2u q0 = p[0], q1 = p[1]; ah.x = q0.x; ah.y = q0.y; ah.z = q1.x; ah.w = q1.y; }
        { const LAS v2u* p = (const LAS v2u*)(wlp + 16 * ks); const v2u q0 = p[0], q1 = p[1]; al.x = q0.x; al.y = q0.y; al.z = q1.x; al.w = q1.y; }
        const s8v wa = __builtin_bit_cast(s8v, ah), wb = __builtin_bit_cast(s8v, al);
        acc = __builtin_amdgcn_mfma_f32_32x32x16_bf16(wa, xh, acc, 0, 0, 0);
        acc = __builtin_amdgcn_mfma_f32_32x32x16_bf16(wb, xh, acc, 0, 0, 0);
        acc = __builtin_amdgcn_mfma_f32_32x32x16_bf16(wa, xl, acc, 0, 0, 0);
    }
    __syncthreads();
    LAS float* part = (LAS float*)F.lds;
#pragma unroll
    for (int i = 0; i < 16; ++i) part[(F.wave * 17 + i) * 64 + lane] = acc[i];
    part[(F.wave * 17 + 16) * 64 + lane] = ss;
    __syncthreads();
    if (kq == 0) {
        float v[32]; float st = 0.f;
#pragma unroll
        for (int w = 0; w < 4; ++w) { const LAS float* pw = part + (size_t)((task * 4 + w) * 17) * 64;
#pragma unroll
            for (int i = 0; i < 16; ++i) { const float t = pw[i * 64 + lane]; v[i] = w == 0 ? t : v[i] + t; }
            st += pw[16 * 64 + lane] + pw[16 * 64 + (lane ^ 32)]; }
        const float rstd = 1.0f / sqrtf(st * (1.f / D) + EPS);
        if (hh == 0) RS[tok] = rstd;
#pragma unroll
        for (int i = 0; i < 16; ++i) { const int e = (i & 3) + 8 * (i >> 2) + 4 * hh; v[i] = v[i] * rstd + br[e]; }
#pragma unroll
        for (int i = 0; i < 16; ++i) v[16 + i] = __shfl_xor(v[i], 32);
        float mx = v[0];
#pragma unroll
        for (int i = 1; i < 32; ++i) mx = fmaxf(mx, v[i]);
        int rk[16]; float es = 0.f;
#pragma unroll
        for (int i = 0; i < 16; ++i) { const int ei = (i & 3) + 8 * (i >> 2) + 4 * hh; int rank = 0;
#pragma unroll
            for (int j = 0; j < 32; ++j) { if (j == i) continue; const int ej = (j & 3) + 8 * ((j & 15) >> 2) + 4 * (j < 16 ? hh : 1 - hh);
                rank += (v[j] > v[i] || (v[j] == v[i] && ej < ei)) ? 1 : 0; }
            rk[i] = rank; if (rank < TOPK) es += fexp2((v[i] - mx) * LOG2E); }
        es += __shfl_xor(es, 32);
        const float inv = 1.0f / es;
#pragma unroll
        for (int i = 0; i < 16; ++i) if (rk[i] < TOPK) { const int ei = (i & 3) + 8 * (i >> 2) + 4 * hh;
            gates[tok * TOPK + rk[i]] = fexp2((v[i] - mx) * LOG2E) * inv;
            const int pos = __hip_atomic_fetch_add(lcnt + ei, 1, __ATOMIC_RELAXED, __HIP_MEMORY_SCOPE_WORKGROUP);
            asg[(task * 32 + r) * 4 + rk[i]] = ei | (pos << 8); }
    }
    __syncthreads();
    if (tid < 32) lbase[tid] = (int)__hip_atomic_fetch_add(gcnt + tid, (unsigned)lcnt[tid], RLX_AGENT);
    __syncthreads();
    if (tid < 64 * TOPK) { const int a = asg[tid], e = a & 255, pos = a >> 8; const int tk = F.vcu * 64 + (tid >> 2);
        lists[e * M + lbase[e] + pos] = tk * TOPK + (tid & 3); }
    __syncthreads();
}

__device__ __forceinline__ void moe_tables(Frame& F) {
    LAS int* tab = (LAS int*)(F.lds + TAB_OFF); LAS int* cnt = tab, * mt = tab + 32, * tbase = tab + 64;
    unsigned* gcnt = (unsigned*)(F.ctl + CW_CNT);
    if (F.tid < 32) { const int c = (int)__hip_atomic_load(gcnt + F.tid, RLX_AGENT); cnt[F.tid] = c; mt[F.tid] = (c + 255) >> 8; }
    __syncthreads();
    if (F.tid == 0) { int s = 0; for (int e = 0; e < NE; ++e) { tbase[e] = s; s += mt[e]; } tbase[NE] = s; }
    __syncthreads();
}
__device__ __forceinline__ void moe_units(Frame& F, int npn, int gpn) {
    LAS int* tab = (LAS int*)(F.lds + TAB_OFF); LAS int* mt = tab + 32, * tbase = tab + 64; LAS int* units = (LAS int*)(F.lds + UNITS_OFF);
    if (F.tid < 32) {
        const int nU = tbase[NE] * npn; const int L = F.tid * F.G + (int)blockIdx.x; int pm = 0, pn = 0, e = 0, valid = 0;
        if (L < nU) { const int seq = pg8::xcd_remap(L, nU); int ee = 0; while (ee < NE - 1 && seq >= tbase[ee + 1] * npn) ++ee;
            const int r = seq - tbase[ee] * npn, m = mt[ee]; const int grp = r / (m * gpn), r2 = r % (m * gpn);
            e = ee; pn = grp * gpn + r2 / m; pm = tbase[ee] + r2 % m; valid = 1; }
        units[4 * F.tid + 0] = pm; units[4 * F.tid + 1] = pn; units[4 * F.tid + 2] = e; units[4 * F.tid + 3] = valid;
    }
    __syncthreads();
}

__device__ __forceinline__ void moe_gather_tables(Frame& F) {
    LAS int* tab = (LAS int*)(F.lds + TAB_OFF); LAS int* cnt = tab, * tbase = tab + 64; LAS int* units = (LAS int*)(F.lds + UNITS_OFF); LAS int* tokmap = (LAS int*)(F.lds + TOKMAP_OFF);
    const float* gates = (const float*)(F.ws + WS_GATES); const int* lists = (const int*)(F.ws + WS_LISTS); const float* RS = (const float*)(F.ws + WS_RSTD); int* rowinfo = (int*)(F.ws + WS_ROWINFO);
    for (int idx = F.tid; idx < TOKMAP_SLOTS * 256; idx += NWAVES * 64) { const int i = idx >> 8, R = idx & 255; int tk = 0;
        if (units[4 * i + 3]) { const int pm = units[4 * i], e = units[4 * i + 2]; const int li = (pm - tbase[e]) * 256 + R;
            v4u ri = (v4u){0xffffffffu, 0u, 0u, 0u};
            if (li < cnt[e]) { const int slot = lists[e * M + li]; tk = slot >> 2; ri = (v4u){(unsigned)slot, __builtin_bit_cast(unsigned, gates[slot]), __builtin_bit_cast(unsigned, RS[tk]), 0u}; }
            *(v4u*)(rowinfo + 4 * (pm * 256 + R)) = ri; }
        tokmap[idx] = tk; }
    asm volatile("s_waitcnt vmcnt(0)" ::: "memory");
    __syncthreads();
}

__device__ __forceinline__ void final_phase(Frame& F) {
    const bf16* YB = (const bf16*)(F.ws + WS_YBUF); const float* gf = F.in[24]; float* O = F.out;
    const int gw = F.vcu * NWAVES + F.wave, NGW = F.G * NWAVES, lane = F.lane;
    f32x4 gg[4];
#pragma unroll
    for (int j = 0; j < 4; ++j) gg[j] = *(const f32x4*)(gf + 4 * lane + 256 * j);
    for (int m = gw; m < M; m += NGW) {
        f32x4 v[4]; float ss = 0.f;
#pragma unroll
        for (int j = 0; j < 4; ++j) { { const v2u xw = *(const v2u*)(x1_row(F.ws, m) + 4 * lane + 256 * j); v[j] = (f32x4){bflo(xw.x), bfhi(xw.x), bflo(xw.y), bfhi(xw.y)}; }
#pragma unroll
            for (int k = 0; k < (DBG_MODE ? 0 : TOPK); ++k) { const v2u w = *(const v2u*)(YB + ((size_t)m * TOPK + k) * D + 4 * lane + 256 * j); v[j].x += bflo(w.x); v[j].y += bfhi(w.x); v[j].z += bflo(w.y); v[j].w += bfhi(w.y); }
            ss += (v[j].x * v[j].x + v[j].y * v[j].y) + (v[j].z * v[j].z + v[j].w * v[j].w); }
        const float rstd = 1.0f / sqrtf(wave_sum(ss) * (1.f / D) + EPS);
#pragma unroll
        for (int j = 0; j < 4; ++j) *(f32x4*)(O + (size_t)m * D + 4 * lane + 256 * j) = v[j] * rstd * gg[j];
    }
}

struct Args { const float* in[25]; float* out; unsigned char* ws; int ph_lo, ph_hi, li, pad; };
__global__ void __launch_bounds__(NWAVES * 64, 2) hyb_fwd(Args args) {
    extern __shared__ __attribute__((aligned(16))) unsigned char lds[];
    Frame F;
    F.lds = (LAS unsigned char*)lds;
    F.MISC = (volatile LAS unsigned*)(F.lds + MISC_OFF);
    F.tid = threadIdx.x; F.lane = F.tid & 63; F.wave = __builtin_amdgcn_readfirstlane(F.tid >> 6);
    F.G = gridDim.x; { const int bx = blockIdx.x; F.vcu = (F.G % 8 == 0) ? (bx % 8) * (F.G / 8) + bx / 8 : bx; }
    F.ws = args.ws; F.ctl = (gu32*)(args.ws + WS_CTL); F.out = args.out;
#pragma unroll
    for (int i = 0; i < 25; ++i) F.in[i] = args.in[i];
    for (int u = F.tid; u < (LDS_BYTES - LDSCTL_OFF) / 4; u += NWAVES * 64) ((LAS unsigned*)(F.lds + LDSCTL_OFF))[u] = 0u;
    __syncthreads();
    XcdBarrier bar; bar.bar = (unsigned*)(F.ctl + CW_BAR); bar.x = 0; bar.st = nullptr; bar.G = gridDim.x;
    if (N_LAUNCHES != PER_PHASE) bar = xcd_barrier_post((unsigned*)(F.ctl + CW_BAR), F.MISC + 8, gridDim.x);
#define GRID_BAR(seam) do { if (N_LAUNCHES == PER_PHASE) { if (F.tid == 0) __hip_atomic_store(F.ctl + CW_TMO, 0xBADBA0u | (unsigned)(seam), RLX_AGENT); } else { xcd_barrier(bar); } } while (0)
    const int lo = args.ph_lo, hi = args.ph_hi;
#define IN(k) (lo <= (k) && (k) < hi)
#define BOTH(k) (IN(k) && IN((k) + 1))
    const pg8::bf16_t* wsb = (const pg8::bf16_t*)args.ws;
#define WSB(off) ((const pg8::bf16_t*)(args.ws + (off)))

    unsigned long long t_lo_ = 0, t_hi_ = 0;
    TMARK(0);
    if (IN(0)) {   }

    TMARK(1);
    if (IN(1)) for (int rep_ = 0; rep_ < NREP(1); ++rep_) {
        const int bx = (int)blockIdx.x; const bool gemm_wg = bx < P1_GEMM_WG;
        pg8::Gemm g = pg8::make_gemm(WSB(WS_HN), WSB(WS_WINT), D, D, D); InProjOrder S{P1_GEMM_WG, gemm_wg ? bx : 512};
        EpiInProj E{(unsigned short*)(args.ws + WS_Q), (bf16*)(args.ws + WS_UCAT), LOG2E * 0.125f};
        if (gemm_wg) { XcdBarrier bar2 = xcd_barrier_post((unsigned*)(F.ctl + CW_BAR2), F.MISC + 10, (unsigned)P1_GEMM_WG);
            p0_prologue(F, t_lo_, t_hi_);
            xcd_barrier(bar2); }
        pg8::gemm_phase<EpiInProj, InProjOrder, PG8_ALIGN, PG8_SP2>(F.lds + RING_OFF, g, S, E);
        if (gemm_wg && F.tid == 0) __hip_atomic_fetch_add((unsigned*)(F.ctl + CW_DONE1), 1u, RLX_AGENT);
        p1_side(F, (bx >= P1_GEMM_WG && bx < P1_GEMM_WG + NG) ? bx - P1_GEMM_WG : -1);
        if (BOTH(1)) GRID_BAR(1);
    }
    TMARK(2);
    if (IN(2)) for (int rep_ = 0; rep_ < NREP(2); ++rep_) {
        const int bx = (int)blockIdx.x;
        if (bx < NG * 4) {
            XcdBarrier bar3 = xcd_barrier_post((unsigned*)(F.ctl + CW_BAR3), F.MISC + 12, (unsigned)(NG * 4));
            if (bx < NG * 2) { pg8::Gemm g = pg8::make_gemm(WSB(WS_UCAT), WSB(WS_WE), NG * UK, 512, 512); SsmOrder S{NG * 2, F.G, bx, 1, 128, 512};
                EpiSloc E{(float*)(args.ws + WS_SLOC)};
                pg8::gemm_phase<EpiSloc, SsmOrder, PG8_ALIGN, PG8_SP2>(F.lds + RING_OFF, g, S, E); }
            else attn_one(F, (bx - NG * 2) * 8 + F.wave);
            xcd_barrier(bar3);
            if (bx < NG * 2) { if (F.wave == 0) scan_phase(F, bx); else attn_one(F, 512 + bx * 7 + F.wave - 1); }
            else attn_one(F, 512 + 448 + (bx - NG * 2) * 8 + F.wave);
            xcd_barrier(bar3);
            { pg8::Gemm g = pg8::make_gemm(WSB(WS_UCAT), WSB(WS_TW), NG * UK, UK, UK); SsmOrder S{NG * 4, F.G, bx, 2, 512, UK};
              EpiS3 E{(bf16*)(args.ws + WS_YG)};
              pg8::gemm_phase<EpiS3, SsmOrder, PG8_ALIGN, PG8_SP2>(F.lds + RING_OFF, g, S, E); }
        } else {
            const int w = (bx - NG * 4) * 8 + F.wave;
#pragma unroll 1
            for (int j = 0; j < 3; ++j) { const int u = 1472 + w + 1024 * j; if (u < 4096) attn_one(F, u); }
            q1_drain(F, 2, nullptr, 0u);
        }
        if (BOTH(4)) GRID_BAR(4);
    }
    TMARK(3); TMARK(4);
    TMARK(5);
    if (IN(5)) for (int rep_ = 0; rep_ < NREP(5); ++rep_) {
        pg8::Gemm g = pg8::make_gemm(WSB(WS_YG), WSB(WS_WGLUT), SSW, SSW, SSW); pg8::StaticOrder S; S.init(M, 2 * SSW, F.G, (int)blockIdx.x, SSW, SSW);
        EpiGlu E{(bf16*)(args.ws + WS_YCAT), (float*)(args.ws + WS_SSQSSM)};
        pg8::gemm_phase<EpiGlu, pg8::StaticOrder, PG8_ALIGN, PG8_SP2>(F.lds + RING_OFF, g, S, E);
        if (BOTH(5)) GRID_BAR(5);
    }
    TMARK(6);
    if (IN(6)) {   }
    TMARK(7);
    if (IN(7)) for (int rep_ = 0; rep_ < NREP(7); ++rep_) {
        pg8::Gemm g = pg8::make_gemm(WSB(WS_YCAT), WSB(WS_WOUTT), D, D, D); pg8::StaticOrder S; S.init(M, D, F.G, (int)blockIdx.x, D, D);
        LAS float* rtab = (LAS float*)(F.lds + TOKMAP_OFF);
        { pg8::Unit u0; if (S.next(0, u0) && F.tid < 256) { const int row = u0.pm * 256 + F.tid; const float* pa = (const float*)(args.ws + WS_SSQSB) + (size_t)row * NH; const float* pb = (const float*)(args.ws + WS_SSQSSM) + (size_t)row * 16;
              float sa = 0.f, sb = 0.f;
#pragma unroll
              for (int i = 0; i < NH; ++i) sa += pa[i];
#pragma unroll
              for (int i = 0; i < 16; ++i) sb += pb[i];
              const float ra = 1.0f / sqrtf(sa * (1.f / SBW) + EPS), rb = 1.0f / sqrtf(sb * (1.f / SSW) + EPS); rtab[F.tid] = ra / rb; rtab[256 + F.tid] = rb; }
          __syncthreads(); }
        EpiOutProj E{F.in[0], args.ws, rtab, rtab + 256};
        pg8::gemm_phase<EpiOutProj, pg8::StaticOrder, PG8_ALIGN, PG8_SP2>(F.lds + RING_OFF, g, S, E);
        if (BOTH(7)) GRID_BAR(7);
    }
    TMARK(8);
    if (IN(8) && !DBG_MODE) for (int rep_ = 0; rep_ < NREP(8); ++rep_) { router_phase(F); q1_drain(F, -1, nullptr, 0u);
        if (BOTH(8)) GRID_BAR(8); }
    TMARK(9);
    if (IN(9) && !DBG_MODE) for (int rep_ = 0; rep_ < NREP(9); ++rep_) {   }
    TMARK(10);
    if (IN(10) && !DBG_MODE) for (int rep_ = 0; rep_ < NREP(10); ++rep_) {
        moe_tables(F); moe_units(F, 8, 4); moe_gather_tables(F);
        pg8::Gemm g = pg8::make_gemm(WSB(WS_XN), WSB(WS_W1T), D, D, D); g.brs = 16u; g.bks = 2u * FF * 16u; g.tokmap = (const PG8_LAS int*)(F.lds + TOKMAP_OFF);
        MoeOrder S{(const LAS int*)(F.lds + UNITS_OFF), (long)2 * FF * D * 2, 1};
        EpiMoe1 E{(bf16*)(args.ws + WS_H), F.in[19], F.in[21], (const int*)(args.ws + WS_ROWINFO)};
        pg8::gemm_phase<EpiMoe1, MoeOrder, PG8_ALIGN, PG8_SP2, true>(F.lds + RING_OFF, g, S, E);
        w2_drain(F, -1);
        if (BOTH(10)) GRID_BAR(10);
    }
    TMARK(11);
    if (IN(11) && !DBG_MODE) for (int rep_ = 0; rep_ < NREP(11); ++rep_) {
        moe_tables(F); moe_units(F, 4, 4);
        pg8::Gemm g = pg8::make_gemm(WSB(WS_H), WSB(WS_W2T), FF, FF, FF); g.brs = 16u; g.bks = (unsigned)D * 16u; MoeOrder S{(const LAS int*)(F.lds + UNITS_OFF), (long)D * FF * 2, 0};
        EpiMoe2 E{(bf16*)(args.ws + WS_YBUF), F.in[23], (const int*)(args.ws + WS_ROWINFO)};
        pg8::gemm_phase<EpiMoe2, MoeOrder, PG8_ALIGN, PG8_SP2>(F.lds + RING_OFF, g, S, E);
        if (BOTH(11)) GRID_BAR(11);
    }
    TMARK(12);
    if (IN(12)) for (int rep_ = 0; rep_ < NREP(12); ++rep_) { final_phase(F); }
    TMARK(13);
    if ((TIME_LO) >= 0 && blockIdx.x == (TIME_BLK) && F.tid == 0) { const unsigned long long te = __builtin_amdgcn_s_memrealtime(), dt = 4ull * (t_hi_ - t_lo_); while (__builtin_amdgcn_s_memrealtime() - te < dt) __builtin_amdgcn_s_sleep(32); }
    (void)wsb;
#undef IN
#undef BOTH
}

extern "C" void kernel_launch(void* const* d_in, const int* in_sizes, int n_in, void* d_out, int out_size, void* d_ws, size_t ws_size, hipStream_t stream) {
    static int grid = 0;
    if (grid == 0) {
        if (n_in != 25 || in_sizes[0] != M * D || out_size != M * D || ws_size < WS_END) { fprintf(stderr, "kernel_launch: unexpected shapes: n_in %d in0 %d out %d ws %zu (need %zu); nothing launched\n", n_in, n_in > 0 ? in_sizes[0] : -1, out_size, ws_size, (size_t)WS_END); grid = -1; return; }
        int dev = 0, cus = 0, per_cu = 0;
        if (hipGetDevice(&dev) != hipSuccess || hipDeviceGetAttribute(&cus, hipDeviceAttributeMultiprocessorCount, dev) != hipSuccess) { grid = -1; return; }
        if (hipFuncSetAttribute((const void*)hyb_fwd, hipFuncAttributeMaxDynamicSharedMemorySize, LDS_BYTES) != hipSuccess) { fprintf(stderr, "kernel_launch: hipFuncSetAttribute failed\n"); grid = -1; return; }
        if (hipOccupancyMaxActiveBlocksPerMultiprocessor(&per_cu, (const void*)hyb_fwd, NWAVES * 64, LDS_BYTES) != hipSuccess || per_cu < 1)
            fprintf(stderr, "kernel_launch: note: occupancy query reports %d workgroups per CU\n", per_cu);
        (void)hipGetLastError();
        grid = cus;
        if (grid != 256) fprintf(stderr, "kernel_launch: note: %d CUs (built for 256)\n", grid);
    }
    if (grid < 0) return;
    if (hipMemsetAsync((char*)d_ws + WS_CTL, 0, CTL_ZERO_BYTES, stream) != hipSuccess) { fprintf(stderr, "kernel_launch: memset failed\n"); return; }
    Args a{};
    for (int i = 0; i < 25; ++i) a.in[i] = (const float*)d_in[i];
    a.out = (float*)d_out; a.ws = (unsigned char*)d_ws;
    for (int li = 0; li < N_LAUNCHES; ++li) {
        a.ph_lo = (N_LAUNCHES == PER_PHASE) ? li : 0; a.ph_hi = (N_LAUNCHES == PER_PHASE) ? li + 1 : PER_PHASE; a.li = li;
        hipLaunchKernelGGL(hyb_fwd, dim3(grid), dim3(NWAVES * 64), LDS_BYTES, stream, a);
        const hipError_t le = hipPeekAtLastError();
        if (le != hipSuccess) { fprintf(stderr, "kernel_launch: launch %d failed: %s\n", li, hipGetErrorName(le)); break; }
    }
}
```

```cpp
#include <hip/hip_runtime.h>
#include <cstdio>
#include <cstdint>
namespace pg8 {
#define PG8_LAS __attribute__((address_space(3)))
typedef unsigned short bf16_t;
typedef short bf16x8 __attribute__((ext_vector_type(8)));
typedef float f32x4 __attribute__((ext_vector_type(4)));
typedef unsigned u32x4 __attribute__((ext_vector_type(4)));
typedef long l64x2 __attribute__((ext_vector_type(2)));
constexpr int BM = 256, BK = 64, HALF = 128, HTB = HALF * BK * 2  , STAGE_BYTES = 8 * HTB, NXCD = 8, WGM = 8;

__host__ __device__ __forceinline__ int lds_byte(int r, int c) { const int st = (r >> 4) * 2 + (c >> 5), rr = r & 15, cc = c & 31, ob = rr * 64 + cc * 2; return st * 1024 + (ob ^ (((ob >> 9) & 1) << 5)); }
__host__ __device__ __forceinline__ void stage_rc(int b, int& R, int& C) { const int st = b / 1024, sb = b % 1024, swz = sb ^ (((sb >> 9) & 1) << 5); R = (st >> 1) * 16 + swz / 64; C = (st & 1) * 32 + (swz % 64) / 2; }
__host__ __device__ __forceinline__ int perm32(int rho) { const int n = rho >> 4, i = rho & 15; return 8 * (i >> 2) + 4 * n + (i & 3); }

struct Unit { int pm, pn, e, slot; long offA, offB; };
struct Gemm { const bf16_t* A; const bf16_t* Bt; int lda, K; unsigned brs, bks; const PG8_LAS int* tokmap; };
__host__ __device__ __forceinline__ Gemm make_gemm(const bf16_t* A, const bf16_t* Bt, int lda, int ldb, int K) { Gemm g; g.A = A; g.Bt = Bt; g.lda = lda; g.K = K; g.brs = (unsigned)ldb * 2u; g.bks = 16u; g.tokmap = nullptr; return g; }

__host__ __device__ __forceinline__ int xcd_remap(int wgid, int nwg) { const int q = nwg / NXCD, r = nwg % NXCD, xcd = wgid % NXCD, off = wgid / NXCD; return (xcd < r ? xcd * (q + 1) : r * (q + 1) + (xcd - r) * q) + off; }

struct StaticOrder {
    int nM, nN, nwg, G, c, lda, ldb;
    __host__ __device__ void init(int M, int N, int G_, int c_, int lda_, int ldb_) { nM = M / BM; nN = N / BM; nwg = nM * nN; G = G_; c = c_; lda = lda_; ldb = ldb_; }
    __host__ __device__ __forceinline__ bool next(int i, Unit& u) const {
        const long L = (long)i * G + c; if (L >= nwg) return false;
        const int wgid = xcd_remap((int)L, nwg);
        const int nig = WGM * nN, gid = wgid / nig, fm = gid * WGM, gsz = (nM - fm) < WGM ? (nM - fm) : WGM;
        u.pm = fm + ((wgid % nig) % gsz); u.pn = (wgid % nig) / gsz; u.e = 0; u.slot = 0;
        u.offA = (long)u.pm * BM * lda * 2; u.offB = (long)u.pn * BM * ldb * 2; return true;
    }
    __device__ __forceinline__ void a_ready(const Unit&) const {}
    __device__ __forceinline__ void done(const Unit&) const {}
};

__device__ __forceinline__ unsigned cvt_pk_bf16(float lo, float hi) { unsigned r; asm volatile("v_cvt_pk_bf16_f32 %0, %1, %2" : "=v"(r) : "v"(lo), "v"(hi)); return r; }
typedef float f32x2 __attribute__((ext_vector_type(2)));

template <class Epi, class Sched, bool ALIGN_EPI = false, bool SP2 = false, bool GATHER = false, bool FP8 = false>
__device__ __forceinline__ void gemm_phase(PG8_LAS unsigned char* lds, const Gemm g, const Sched& S, const Epi& E) {
    static_assert(!GATHER || SP2, "the gather form is written for the two-super-phase loop only");
    const int tid = threadIdx.x, wid = __builtin_amdgcn_readfirstlane(tid >> 6), lane = tid & 63, wr = wid >> 2, wc = wid & 3, fr = lane & 15, fq = lane >> 4;
    const int K = g.K, nt = K / (FP8 ? 2 * BK : BK);
    unsigned voffA[2], voffB[2]; int RA[2];
#pragma unroll
    for (int i = 0; i < 2; ++i) { int R, C; stage_rc(tid * 16 + i * 8192, R, C); const int Rb = Epi::PERM ? ((R & ~31) + perm32(R & 31)) : R; RA[i] = R;
        voffA[i] = GATHER ? (unsigned)C * 2u : (unsigned)(R * g.lda + C) * 2u; voffB[i] = (unsigned)Rb * g.brs + (unsigned)(C >> 3) * g.bks; }
    const size_t kstepA = (size_t)(BK * 2), kstepB = (size_t)8 * g.bks;
    const size_t hstepA = (size_t)HALF * g.lda * 2, hstepB = (size_t)HALF * g.brs;
    const unsigned ldsw = (unsigned)wid * 1024u;
    const int aoff = lds_byte(wr * 64 + fr, fq * 8), boff = lds_byte(wc * 32 + fr, fq * 8);
#define PG8_SA(b, h) (((b) * 2 + (h)) * HTB)
#define PG8_SB(b, h) ((4 + (b) * 2 + (h)) * HTB)
#define PG8_STAGE(bufoff, gbase, voff) do { _Pragma("unroll") for (int _i = 0; _i < 2; ++_i) \
        __builtin_amdgcn_global_load_lds((const unsigned*)((const char*)(gbase) + (voff)[_i]), (PG8_LAS unsigned*)(lds + (bufoff) + ldsw + _i * 8192), 16, 0, 0); } while (0)
    unsigned ga[2][2], gn[2][2], gw[2][2];
#define PG8_GLOAD(dst, u) do { if constexpr (GATHER) { const PG8_LAS int* _tm = g.tokmap + 256 * (u).slot; _Pragma("unroll") for (int _h = 0; _h < 2; ++_h) _Pragma("unroll") for (int _i = 0; _i < 2; ++_i) \
        dst[_h][_i] = (unsigned)_tm[128 * _h + RA[_i]] * (unsigned)(g.lda * 2) + voffA[_i]; } } while (0)
#define PG8_STAGE_A(bufoff, gbase, half, GX) do { if constexpr (GATHER) { PG8_STAGE(bufoff, gbase, GX[half]); } else { PG8_STAGE(bufoff, (gbase) + (half) * hstepA, voffA); } } while (0)
#define PG8_LDA(dst, b, h) do { _Pragma("unroll") for (int m = 0; m < 4; ++m) _Pragma("unroll") for (int k = 0; k < 2; ++k) dst[m][k] = *(const PG8_LAS bf16x8*)(lds + PG8_SA(b, h) + aoff + m * 2048 + k * 1024); } while (0)
#define PG8_LDB(dst, b, h) do { _Pragma("unroll") for (int n = 0; n < 2; ++n) _Pragma("unroll") for (int k = 0; k < 2; ++k) dst[n][k] = *(const PG8_LAS bf16x8*)(lds + PG8_SB(b, h) + boff + n * 2048 + k * 1024); } while (0)
#define PG8_MMA(ai, bj, At, Bt) do { __builtin_amdgcn_s_setprio(1); _Pragma("unroll") for (int m = 0; m < 4; ++m) _Pragma("unroll") for (int n = 0; n < 2; ++n) _Pragma("unroll") for (int k = 0; k < 2; ++k) { \
        if constexpr (FP8) { const l64x2 _a = __builtin_bit_cast(l64x2, At[m][k]), _b = __builtin_bit_cast(l64x2, Bt[n][k]); const long _a0 = _a.x, _a1 = _a.y, _b0 = _b.x, _b1 = _b.y; \
            acc[ai][bj][m][n] = __builtin_amdgcn_mfma_f32_16x16x32_fp8_fp8(_b0, _a0, acc[ai][bj][m][n], 0, 0, 0); acc[ai][bj][m][n] = __builtin_amdgcn_mfma_f32_16x16x32_fp8_fp8(_b1, _a1, acc[ai][bj][m][n], 0, 0, 0); } \
        else acc[ai][bj][m][n] = __builtin_amdgcn_mfma_f32_16x16x32_bf16(Bt[n][k], At[m][k], acc[ai][bj][m][n], 0, 0, 0); } __builtin_amdgcn_s_setprio(0); } while (0)
#define PG8_WAIT_V(n) asm volatile("s_waitcnt vmcnt(" #n ")" ::: "memory")
#define PG8_WAIT_L(n) asm volatile("s_waitcnt lgkmcnt(" #n ")" ::: "memory")
#define PG8_BAR __builtin_amdgcn_s_barrier()
#define PG8_SCHED __builtin_amdgcn_sched_barrier(0)
    Unit cur, nxt; int ui = 0;
    if (!S.next(0, cur)) return;
    f32x4 acc[2][2][4][2];
#pragma unroll
    for (int a = 0; a < 2; ++a)
#pragma unroll
        for (int b = 0; b < 2; ++b)
#pragma unroll
            for (int m = 0; m < 4; ++m)
#pragma unroll
                for (int n = 0; n < 2; ++n) acc[a][b][m][n] = (f32x4){0.f, 0.f, 0.f, 0.f};
    bf16x8 At[4][2], B0[2][2], B1[2][2];
    const char* cA = (const char*)g.A + cur.offA; const char* cB = (const char*)g.Bt + cur.offB;
    S.a_ready(cur);
    if constexpr (SP2) {
        PG8_GLOAD(ga, cur);
        PG8_STAGE(PG8_SB(0, 0), cB, voffB); PG8_STAGE(PG8_SB(0, 1), cB + hstepB, voffB); PG8_STAGE_A(PG8_SA(0, 0), cA, 0, ga); PG8_STAGE_A(PG8_SA(0, 1), cA, 1, ga);
        if (wr == 1) PG8_BAR;
        PG8_WAIT_V(2); PG8_BAR;
        PG8_STAGE(PG8_SB(1, 0), cB + kstepB, voffB); PG8_STAGE_A(PG8_SA(1, 0), cA + kstepA, 0, ga); PG8_STAGE(PG8_SB(1, 1), cB + hstepB + kstepB, voffB);
        PG8_WAIT_V(6); PG8_BAR;
    } else {
        PG8_STAGE(PG8_SB(0, 0), cB, voffB); PG8_STAGE(PG8_SA(0, 0), cA, voffA); PG8_STAGE(PG8_SB(0, 1), cB + hstepB, voffB); PG8_STAGE(PG8_SA(0, 1), cA + hstepA, voffA);
        if (wr == 1) PG8_BAR;
        PG8_WAIT_V(4); PG8_BAR;
        PG8_STAGE(PG8_SB(1, 0), cB + kstepB, voffB); PG8_STAGE(PG8_SA(1, 0), cA + kstepA, voffA); PG8_STAGE(PG8_SB(1, 1), cB + hstepB + kstepB, voffB);
        PG8_WAIT_V(6); PG8_BAR;
    }
    for (;;) {
        const bool has_next = S.next(ui + 1, nxt);
        if constexpr (GATHER) { if (has_next) { PG8_GLOAD(gn, nxt); } else { _Pragma("unroll") for (int _h = 0; _h < 2; ++_h) _Pragma("unroll") for (int _i = 0; _i < 2; ++_i) gn[_h][_i] = ga[_h][_i]; } }
        const char* nA = has_next ? (const char*)g.A + nxt.offA : cA; const char* nB = has_next ? (const char*)g.Bt + nxt.offB : cB;
        for (int t = 0; t < nt; t += 2) {
            const bool last = (t == nt - 2);
            const char* a1 = cA + (size_t)(t + 1) * kstepA;
            const char* a2 = last ? nA : cA + (size_t)(t + 2) * kstepA; const char* b2 = last ? nB : cB + (size_t)(t + 2) * kstepB;
            const char* a3 = a2 + kstepA; const char* b3 = b2 + kstepB;
            if (last && has_next) S.a_ready(nxt);
            if constexpr (GATHER) { _Pragma("unroll") for (int _h = 0; _h < 2; ++_h) _Pragma("unroll") for (int _i = 0; _i < 2; ++_i) gw[_h][_i] = last ? gn[_h][_i] : ga[_h][_i]; }
            if constexpr (Epi::MIDK) { if (t == nt / 2) E.mid(acc, cur, wr, wc, fr, fq); }
            if constexpr (SP2) {
            PG8_LDB(B0, 0, 0); PG8_LDB(B1, 0, 1); PG8_SCHED; PG8_LDA(At, 0, 0); PG8_STAGE_A(PG8_SA(1, 1), a1, 1, ga);
            PG8_WAIT_V(8); PG8_WAIT_L(0); PG8_BAR; PG8_MMA(0, 0, At, B0); PG8_MMA(0, 1, At, B1); PG8_BAR; PG8_SCHED;
            PG8_LDA(At, 0, 1); PG8_STAGE(PG8_SB(0, 0), b2, voffB); PG8_STAGE(PG8_SB(0, 1), b2 + hstepB, voffB); PG8_STAGE_A(PG8_SA(0, 0), a2, 0, gw);
            PG8_WAIT_V(8); PG8_WAIT_L(0); PG8_BAR; PG8_MMA(1, 0, At, B0); PG8_MMA(1, 1, At, B1); PG8_BAR; PG8_SCHED;
            PG8_LDB(B0, 1, 0); PG8_LDB(B1, 1, 1); PG8_SCHED; PG8_LDA(At, 1, 0); PG8_STAGE_A(PG8_SA(0, 1), a2, 1, gw);
            PG8_WAIT_V(8); PG8_WAIT_L(0); PG8_BAR; PG8_MMA(0, 0, At, B0); PG8_MMA(0, 1, At, B1); PG8_BAR; PG8_SCHED;
            PG8_LDA(At, 1, 1); PG8_STAGE(PG8_SB(1, 0), b3, voffB); PG8_STAGE(PG8_SB(1, 1), b3 + hstepB, voffB); PG8_STAGE_A(PG8_SA(1, 0), a3, 0, gw);
            PG8_WAIT_V(8); PG8_WAIT_L(0); PG8_BAR; PG8_MMA(1, 0, At, B0); PG8_MMA(1, 1, At, B1); PG8_BAR; PG8_SCHED;
            } else {
            PG8_LDB(B0, 0, 0); PG8_SCHED; PG8_LDA(At, 0, 0); PG8_STAGE(PG8_SA(1, 1), a1 + hstepA, voffA);
            PG8_WAIT_L(8); PG8_BAR; PG8_WAIT_L(0); PG8_MMA(0, 0, At, B0); PG8_BAR; PG8_SCHED;
            PG8_LDB(B1, 0, 1); PG8_STAGE(PG8_SB(0, 0), b2, voffB);
            PG8_BAR; PG8_WAIT_L(0); PG8_MMA(0, 1, At, B1); PG8_BAR;
            PG8_LDA(At, 0, 1); PG8_STAGE(PG8_SA(0, 0), a2, voffA);
            PG8_BAR; PG8_WAIT_L(0); PG8_MMA(1, 0, At, B0); PG8_BAR; PG8_SCHED;
            PG8_STAGE(PG8_SB(0, 1), b2 + hstepB, voffB);
            PG8_WAIT_V(6); PG8_BAR; PG8_MMA(1, 1, At, B1); PG8_BAR;
            PG8_LDB(B0, 1, 0); PG8_SCHED; PG8_LDA(At, 1, 0); PG8_STAGE(PG8_SA(0, 1), a2 + hstepA, voffA);
            PG8_WAIT_L(8); PG8_BAR; PG8_WAIT_L(0); PG8_MMA(0, 0, At, B0); PG8_BAR; PG8_SCHED;
            PG8_LDB(B1, 1, 1); PG8_STAGE(PG8_SB(1, 0), b3, voffB);
            PG8_BAR; PG8_WAIT_L(0); PG8_MMA(0, 1, At, B1); PG8_BAR;
            PG8_LDA(At, 1, 1); PG8_STAGE(PG8_SA(1, 0), a3, voffA);
            PG8_BAR; PG8_WAIT_L(0); PG8_MMA(1, 0, At, B0); PG8_BAR; PG8_SCHED;
            PG8_STAGE(PG8_SB(1, 1), b3 + hstepB, voffB);
            PG8_WAIT_V(6); PG8_BAR; PG8_MMA(1, 1, At, B1); PG8_BAR;
            }
        }
        if constexpr (ALIGN_EPI) { if (wr == 0) PG8_BAR; }
        if constexpr (!Epi::AFTER_DRAIN) { E(acc, cur, wr, wc, fr, fq); S.done(cur); }
        if (!has_next) break;
#pragma unroll
        for (int a = 0; a < 2; ++a)
#pragma unroll
            for (int b = 0; b < 2; ++b)
#pragma unroll
                for (int m = 0; m < 4; ++m)
#pragma unroll
                    for (int n = 0; n < 2; ++n) acc[a][b][m][n] = (f32x4){0.f, 0.f, 0.f, 0.f};
        cur = nxt; cA = nA; cB = nB; ++ui;
        if constexpr (GATHER) { _Pragma("unroll") for (int _h = 0; _h < 2; ++_h) _Pragma("unroll") for (int _i = 0; _i < 2; ++_i) ga[_h][_i] = gn[_h][_i]; }
        if constexpr (ALIGN_EPI) { if (wr == 1) PG8_BAR; }
    }
    PG8_WAIT_V(0);
    if constexpr (!ALIGN_EPI) { if (wr == 0) PG8_BAR; }
    PG8_BAR;
    if constexpr (Epi::AFTER_DRAIN) { E.fused(acc, cur, wr, wc, fr, fq, lds, wid, lane); S.done(cur); }
#undef PG8_SA
#undef PG8_SB
#undef PG8_STAGE
#undef PG8_STAGE_A
#undef PG8_GLOAD
#undef PG8_LDA
#undef PG8_LDB
#undef PG8_MMA
#undef PG8_WAIT_V
#undef PG8_WAIT_L
#undef PG8_BAR
#undef PG8_SCHED
}
}

#ifndef PG8_SP2
#define PG8_SP2 true
#endif
#ifndef PG8_ALIGN
#define PG8_ALIGN true
#endif

constexpr int NWAVES = 8;
#ifndef MK_N_LAUNCHES
#define MK_N_LAUNCHES 1
#endif
#ifndef DBG_MODE
#define DBG_MODE 0
#endif
#ifndef REP_PHASE
#define REP_PHASE -1
#endif
#define NREP(k) ((REP_PHASE) == (k) ? 2 : 1)
#ifndef TIME_LO
#define TIME_LO -1
#endif
#ifndef TIME_HI
#define TIME_HI -1
#endif
#ifndef TIME_BLK
#define TIME_BLK 0
#endif
#define TMARK(j) do { if ((TIME_LO) >= 0 && blockIdx.x == (TIME_BLK) && F.tid == 0) { if ((j) == (TIME_LO)) t_lo_ = __builtin_amdgcn_s_memrealtime(); if ((j) == (TIME_HI)) t_hi_ = __builtin_amdgcn_s_memrealtime(); } } while (0)
constexpr int PER_PHASE = 13;
constexpr int N_LAUNCHES = MK_N_LAUNCHES;

constexpr int BATCH = 2, SEQ = 8192, D = 1024, M = BATCH * SEQ;
constexpr int SBW = 512, NH = 8, HD = 64;
constexpr int SSW = 512, NG = 32, GC = 16, NP = 64;
constexpr int NPROJ = 3 * SBW + SSW;
constexpr int LC = 32, NCHUNK = M / LC, CPB = SEQ / LC;
constexpr int UK = LC * GC + 2 * NP;
constexpr int NE = 32, TOPK = 4, FF = 1024, NASSIGN = M * TOPK;
constexpr int MAXTILES = (NASSIGN + NE * 255) / 256 + 1;
constexpr float EPS = 1e-5f;
constexpr float LOG2E = 1.4426950408889634f;

constexpr size_t MiB = 1u << 20;
constexpr size_t WS_CTL = 0, CTL_ZERO_BYTES = 1 * MiB;
constexpr size_t WS_LAML = 1 * MiB;
constexpr size_t WS_RSTD = 1 * MiB + 32 * 1024;
constexpr size_t WS_GATES = 1 * MiB + 128 * 1024;
constexpr size_t WS_ROWINFO = 1 * MiB + 512 * 1024;
constexpr size_t WS_RWIMG = 3 * MiB;
constexpr size_t WS_LISTS = 507 * MiB;
constexpr size_t WS_X1LO = 331 * MiB, WS_X1HI = 491 * MiB;
constexpr size_t WS_WINT = 4 * MiB, WS_WGLUT = 8 * MiB, WS_WOUTT = 9 * MiB, WS_W1T = 11 * MiB, WS_W2T = 139 * MiB;
constexpr size_t WS_R1 = 203 * MiB, WS_R2 = 347 * MiB, WS_END = 509 * MiB;
constexpr size_t WS_HN = WS_R1, WS_Q = WS_R1 + 32 * MiB, WS_K = WS_R1 + 48 * MiB, WS_V = WS_R1 + 64 * MiB, WS_UCAT = WS_R1 + 80 * MiB,
                 WS_SLOC = WS_R1 + 100 * MiB, WS_SSQSB = WS_R1 + 108 * MiB  , WS_SSQSSM = WS_R1 + 109 * MiB  , WS_YG = WS_R1 + 124 * MiB;
constexpr size_t WS_YBUF = WS_R1;
constexpr size_t WS_YCAT = WS_R2 + 16 * MiB  , WS_XN = WS_R1  , WS_WE = WS_R2 + 80 * MiB, WS_TW = WS_R2 + 85 * MiB;
constexpr size_t WS_H = WS_R2;
static_assert(WS_K == WS_Q + (size_t)M * SBW * 2 && WS_V == WS_K + (size_t)M * SBW * 2 && WS_YG + (size_t)M * SSW * 2 <= WS_R2 && WS_TW + (size_t)NG * 512 * UK * 2 <= WS_END, "ws map");
static_assert(WS_YBUF + (size_t)NASSIGN * D * 2 <= WS_X1LO && WS_H + (size_t)(MAXTILES - 1) * 256 * FF * 2 <= WS_END, "ws map 2");
static_assert(WS_ROWINFO + (size_t)MAXTILES * 256 * 16 <= 3 * MiB && WS_X1LO >= WS_YBUF + (size_t)NASSIGN * D * 2 && WS_X1LO + 16 * MiB <= WS_R2 && WS_X1HI >= WS_H + (size_t)(MAXTILES - 1) * 256 * FF * 2 && WS_X1HI + 16 * MiB <= WS_LISTS && WS_LISTS + (size_t)NE * M * 4 <= WS_END, "ws map 3");
constexpr int CW_TMO = 0, CW_CODE = 1;
constexpr int CW_BAR = 4096, CW_BAR2 = 8192, CW_BAR3 = 12288;
constexpr int CW_CNT = 16384;
constexpr int CW_Q0 = 16384 + 256, CW_Q1 = 16384 + 512, CW_Q2 = 16384 + 576;
constexpr int CW_DONE1 = 16384 + 640;
constexpr int CW_AQ = 16384 + 320, CW_DONE2 = 16384 + 384, CW_DONE3 = 16384 + 448;

constexpr int RING_OFF = 0, RING_BYTES = 131072;
constexpr int RT_WSTR = 1028;
constexpr int RT_W_BYTES = 2 * NE * RT_WSTR * 2;
constexpr int RT_SCR_OFF = RT_W_BYTES;
constexpr int LDSCTL_OFF = 139264, MISC_OFF = LDSCTL_OFF + 320;
constexpr int TAB_OFF = LDSCTL_OFF + 512;
constexpr int UNITS_OFF = LDSCTL_OFF + 1024;
constexpr int TILEE_OFF = LDSCTL_OFF + 1536;
constexpr int TOKMAP_OFF = LDSCTL_OFF + 4096, TOKMAP_SLOTS = 10;
constexpr int LDS_BYTES = TOKMAP_OFF + TOKMAP_SLOTS * 1024;
static_assert(TILEE_OFF + MAXTILES * 4 <= LDS_BYTES && RT_SCR_OFF + 4096 <= LDSCTL_OFF, "LDS map");

#define GAS __attribute__((address_space(1)))
#define LAS __attribute__((address_space(3)))
typedef unsigned short bf16;
typedef unsigned v4u __attribute__((ext_vector_type(4)));
typedef unsigned v2u __attribute__((ext_vector_type(2)));
typedef float f32x4 __attribute__((ext_vector_type(4)));
typedef float f32x2 __attribute__((ext_vector_type(2)));
typedef _Float16 h16x2 __attribute__((ext_vector_type(2)));
typedef GAS unsigned gu32;
#define RLX_AGENT __ATOMIC_RELAXED, __HIP_MEMORY_SCOPE_AGENT
#define LDS_WAIT() asm volatile("s_waitcnt lgkmcnt(0)" ::: "memory")
#define VM_WAIT() asm volatile("s_waitcnt vmcnt(0)" ::: "memory")
__device__ __forceinline__ unsigned f2bf(float f) { unsigned u = __builtin_bit_cast(unsigned, f); return (u + 0x7fffu + ((u >> 16) & 1u)) >> 16; }
__device__ __forceinline__ unsigned pk2(float lo, float hi) { return f2bf(lo) | (f2bf(hi) << 16); }
__device__ __forceinline__ float bf2f(unsigned short b) { return __builtin_bit_cast(float, (unsigned)b << 16); }
__device__ __forceinline__ float bflo(unsigned w) { return __builtin_bit_cast(float, w << 16); }
__device__ __forceinline__ float bfhi(unsigned w) { return __builtin_bit_cast(float, w & 0xffff0000u); }
__device__ __forceinline__ unsigned pkh2(float lo, float hi) { h16x2 v; v.x = (_Float16)lo; v.y = (_Float16)hi; return __builtin_bit_cast(unsigned, v); }
__device__ __forceinline__ float fexp2(float x) { return __builtin_amdgcn_exp2f(x); }
__device__ __forceinline__ float flog2(float x) { return __builtin_amdgcn_logf(x); }
__device__ __forceinline__ float frcp(float x) { return __builtin_amdgcn_rcpf(x); }
__device__ __forceinline__ float sigmoidf_(float x) { return frcp(1.0f + fexp2(-LOG2E * x)); }
__device__ __forceinline__ float gelu_tanh(float v) { const float u = 0.7978845608028654f * (v + 0.044715f * v * v * v); return v * frcp(1.0f + fexp2(-2.0f * LOG2E * u)); }

__device__ __forceinline__ bf16* x1_row(unsigned char* ws, int m) { return (bf16*)(ws + (m < SEQ ? WS_X1LO : WS_X1HI - (size_t)SEQ * D * 2)) + (size_t)m * D; }
constexpr float WSCALE = 64.0f;
__device__ __forceinline__ float clamp448(float x) { return fminf(fmaxf(x, -448.0f), 448.0f); }
__device__ __forceinline__ unsigned pk4_fp8(float a, float b, float c, float d) {
    int w = __builtin_amdgcn_cvt_pk_fp8_f32(clamp448(a), clamp448(b), 0, false); w = __builtin_amdgcn_cvt_pk_fp8_f32(clamp448(c), clamp448(d), w, true); return (unsigned)w; }
#define XB_TMO      128
#define XB_XCNT(j)  (256  + 64 * (j))
#define XB_XSUB(j)  (1280 + 64 * (j))
#define XB_XGEN(j)  (2304 + 64 * (j))
#define XB_TOP      3328
#define XB_TOPGEN   3392
#define XCD_BAR_WORDS 3456
#define XB_SPIN_CAP (1u << 18)
__device__ __forceinline__ unsigned xb_ld(unsigned* p)              { return __hip_atomic_load(p, __ATOMIC_RELAXED, __HIP_MEMORY_SCOPE_AGENT); }
__device__ __forceinline__ unsigned xb_add(unsigned* p, unsigned v) { return __hip_atomic_fetch_add(p, v, __ATOMIC_RELAXED, __HIP_MEMORY_SCOPE_AGENT); }
__device__ __forceinline__ unsigned xb_xcc_id() { return (unsigned)__builtin_amdgcn_s_getreg((3 << 11) | 20) & 0xFu; }
#define XB_SPIN(cond, bar) do { unsigned _sp = 0; while (cond) { __builtin_amdgcn_s_sleep(1); \
    if ((++_sp & 255u) == 0u) { if (xb_ld(&(bar)[XB_TMO])) break; if (_sp > XB_SPIN_CAP) { atomicAdd(&(bar)[XB_TMO], 1u); break; } } } } while (0)
struct XcdBarrier { unsigned* bar; unsigned x; volatile LAS unsigned* st; unsigned G; };
__device__ __forceinline__ XcdBarrier xcd_barrier_post(unsigned* bar, volatile LAS unsigned* st, unsigned G) {
    XcdBarrier b; b.bar = bar; b.x = xb_xcc_id(); b.st = st; b.G = G;
    if (threadIdx.x == 0) (void)xb_add(&bar[XB_XCNT(b.x)], 1u);
    return b;
}
__device__ __forceinline__ void xcd_barrier_complete(unsigned* bar, unsigned x, unsigned G, unsigned& nloc, unsigned& nx) {
    unsigned sum, cnt, mine, sp = 0u;
    for (;;) {
        sum = 0u; cnt = 0u; mine = 0u;
#pragma unroll
        for (unsigned j = 0; j < 16; ++j) { const unsigned c = xb_ld(&bar[XB_XCNT(j)]); sum += c; cnt += (c > 0u) ? 1u : 0u; mine = (j == x) ? c : mine; }
        if (sum == G) break;
        __builtin_amdgcn_s_sleep(1);
        if ((++sp & 255u) == 0u) { if (xb_ld(&bar[XB_TMO])) break; if (sp > XB_SPIN_CAP) { atomicAdd(&bar[XB_TMO], 1u); break; } }
    }
    nloc = mine > 0u ? mine : 1u; nx = cnt > 0u ? cnt : 1u;
}
__device__ __forceinline__ void xcd_barrier(const XcdBarrier& b) {
    asm volatile("s_waitcnt vmcnt(0)" ::: "memory");
    __syncthreads();
    if (threadIdx.x == 0) {
        unsigned* bar = b.bar;
        __builtin_amdgcn_s_waitcnt(0);
        unsigned nloc = b.st[0], nx = b.st[1];
        if (nloc == 0u) { xcd_barrier_complete(bar, b.x, b.G, nloc, nx); b.st[0] = nloc; b.st[1] = nx; }
        const unsigned old = xb_add(&bar[XB_XSUB(b.x)], 1u);
        const unsigned gen = old / nloc;
        if (old + 1u == (gen + 1u) * nloc) {
            __builtin_amdgcn_fence(__ATOMIC_RELEASE, "agent");
            asm volatile("s_waitcnt vmcnt(0)" ::: "memory");
            const unsigned og = xb_add(&bar[XB_TOP], 1u);
            const unsigned tg = og / nx;
            if (og + 1u == (tg + 1u) * nx) xb_add(&bar[XB_TOPGEN], 1u);
            else XB_SPIN(xb_ld(&bar[XB_TOPGEN]) == tg, bar);
            __builtin_amdgcn_fence(__ATOMIC_ACQUIRE, "agent");
            xb_add(&bar[XB_XGEN(b.x)], 1u);
            asm volatile("s_waitcnt vmcnt(0)" ::: "memory");
        } else {
            XB_SPIN(xb_ld(&bar[XB_XGEN(b.x)]) == gen, bar);
            __builtin_amdgcn_fence(__ATOMIC_ACQUIRE, "agent");
            asm volatile("s_waitcnt vmcnt(0)" ::: "memory");
        }
    }
    __syncthreads();
}

struct Frame {
    LAS unsigned char* lds;
    volatile LAS unsigned* MISC;
    gu32* ctl;
    int tid, lane, wave;
    int vcu, G;
    unsigned char* ws;
    const float* in[25];
    float* out;
};

__device__ __forceinline__ float wave_sum(float v) {
#pragma unroll
    for (int o = 1; o < 64; o <<= 1) v += __shfl_xor(v, o);
    return v;
}

using pg8::Unit;
typedef pg8::f32x4 accv;
struct EpiInProj {
    static constexpr bool PERM = true, AFTER_DRAIN = false; static constexpr bool MIDK = false;
    unsigned short* QKV; bf16* U; float qscale;
    __device__ __forceinline__ void operator()(const accv (&acc)[2][2][4][2], const Unit& u, int wr, int wc, int fr, int fq) const {
        if (u.e == 1) {
            const int row0 = u.pm * 256 + wr * 64 + fr; const int colt = u.pn * 256 + wc * 32 + 8 * fq;
            _Float16* VT = (_Float16*)(QKV + (size_t)2 * M * SBW);
#pragma unroll
            for (int ai = 0; ai < 2; ++ai)
#pragma unroll
                for (int m = 0; m < 4; ++m) { const int row = row0 + ai * 128 + m * 16;
#pragma unroll
                    for (int bj = 0; bj < 2; ++bj) { const int tok = colt + bj * 128; const accv v0 = acc[ai][bj][m][0], v1 = acc[ai][bj][m][1];
                        const int bb = tok >> 13, sq = tok & (SEQ - 1); const int o = sq & 15;
                        _Float16* p = VT + ((size_t)bb * SBW + row) * SEQ + (sq & ~15) + (o >> 1);
                        v2u w0, w1; w0.x = pkh2(v0[0], v0[1]); w0.y = pkh2(v0[2], v0[3]); w1.x = pkh2(v1[0], v1[1]); w1.y = pkh2(v1[2], v1[3]);
                        *(v2u*)p = w0; *(v2u*)(p + 8) = w1; } }
            return;
        }
        const int kind = u.pn >> 1; const int colt = (u.pn & 1) * 256 + wc * 32 + 8 * fq; const int row0 = u.pm * 256 + wr * 64 + fr;
        unsigned short* T = QKV + (size_t)(kind < 2 ? kind : 0) * ((size_t)M * SBW); const float sc = kind == 0 ? qscale : 1.0f;
#pragma unroll
        for (int ai = 0; ai < 2; ++ai)
#pragma unroll
            for (int m = 0; m < 4; ++m) { const int row = row0 + ai * 128 + m * 16;
#pragma unroll
                for (int bj = 0; bj < 2; ++bj) { const int col = colt + bj * 128; const accv v0 = acc[ai][bj][m][0] * sc, v1 = acc[ai][bj][m][1] * sc; v4u w;
                    if (kind < 2) { w.x = pkh2(v0[0], v0[1]); w.y = pkh2(v0[2], v0[3]); w.z = pkh2(v1[0], v1[1]); w.w = pkh2(v1[2], v1[3]);
                        *(v4u*)(T + (size_t)row * SBW + col) = w; }
                    else { w.x = pg8::cvt_pk_bf16(v0[0], v0[1]); w.y = pg8::cvt_pk_bf16(v0[2], v0[3]); w.z = pg8::cvt_pk_bf16(v1[0], v1[1]); w.w = pg8::cvt_pk_bf16(v1[2], v1[3]);
                        *(v4u*)(U + ((size_t)(row >> 5) * NG + (col >> 4)) * UK + (row & 31) * GC + (col & 15)) = w; } } }
    }
};
struct EpiSloc {
    static constexpr bool PERM = false, AFTER_DRAIN = false; static constexpr bool MIDK = false;
    float* S;
    __device__ __forceinline__ void operator()(const accv (&acc)[2][2][4][2], const Unit& u, int wr, int wc, int fr, int fq) const {
        const int row0 = u.pm * 256 + wr * 64 + fr; const int col0 = wc * 32 + 4 * fq;
#pragma unroll
        for (int ai = 0; ai < 2; ++ai)
#pragma unroll
            for (int m = 0; m < 4; ++m) { const int row = row0 + ai * 128 + m * 16;
#pragma unroll
                for (int n = 0; n < 2; ++n) *(accv*)(S + ((size_t)row * NG + u.e) * 128 + col0 + 16 * n) = acc[ai][0][m][n]; }
    }
};
struct EpiS3 {
    static constexpr bool PERM = true, AFTER_DRAIN = false; static constexpr bool MIDK = false;
    bf16* YG;
    __device__ __forceinline__ void operator()(const accv (&acc)[2][2][4][2], const Unit& u, int wr, int wc, int fr, int fq) const {
        const int row0 = u.pm * 256 + wr * 64 + fr; const int colt = u.pn * 256 + wc * 32 + 8 * fq;
#pragma unroll
        for (int ai = 0; ai < 2; ++ai)
#pragma unroll
            for (int m = 0; m < 4; ++m) { const int row = row0 + ai * 128 + m * 16;
#pragma unroll
                for (int bj = 0; bj < 2; ++bj) { const int col = colt + bj * 128; const accv v0 = acc[ai][bj][m][0], v1 = acc[ai][bj][m][1]; v4u w;
                    w.x = pg8::cvt_pk_bf16(gelu_tanh(v0[0]), gelu_tanh(v0[1])); w.y = pg8::cvt_pk_bf16(gelu_tanh(v0[2]), gelu_tanh(v0[3]));
                    w.z = pg8::cvt_pk_bf16(gelu_tanh(v1[0]), gelu_tanh(v1[1])); w.w = pg8::cvt_pk_bf16(gelu_tanh(v1[2]), gelu_tanh(v1[3]));
                    *(v4u*)(YG + ((size_t)row * LC + (col >> 4)) * SSW + u.e * GC + (col & 15)) = w; } }
    }
};
struct EpiGlu {
    static constexpr bool PERM = true, AFTER_DRAIN = false; static constexpr bool MIDK = false;
    bf16* Y; float* SSQ;
    __device__ __forceinline__ void operator()(const accv (&acc)[2][2][4][2], const Unit& u, int wr, int wc, int fr, int fq) const {
        const int row0 = u.pm * 256 + wr * 64 + fr; const int col = u.pn * 128 + wc * 32 + 8 * fq;
#pragma unroll
        for (int ai = 0; ai < 2; ++ai)
#pragma unroll
            for (int m = 0; m < 4; ++m) { const int row = row0 + ai * 128 + m * 16; float r[8]; float sq = 0.f;
#pragma unroll
                for (int n = 0; n < 2; ++n)
#pragma unroll
                    for (int j = 0; j < 4; ++j) { r[4 * n + j] = acc[ai][0][m][n][j] * sigmoidf_(acc[ai][1][m][n][j]); sq += r[4 * n + j] * r[4 * n + j]; }
                sq += __shfl_xor(sq, 16); sq += __shfl_xor(sq, 32);
                if (fq == 0) SSQ[(size_t)row * 16 + u.pn * 4 + wc] = sq;
                v4u w; w.x = pg8::cvt_pk_bf16(r[0], r[1]); w.y = pg8::cvt_pk_bf16(r[2], r[3]); w.z = pg8::cvt_pk_bf16(r[4], r[5]); w.w = pg8::cvt_pk_bf16(r[6], r[7]);
                *(v4u*)(Y + (size_t)row * D + SBW + col) = w; }
    }
};
struct EpiOutProj {
    static constexpr bool PERM = true, AFTER_DRAIN = false; static constexpr bool MIDK = true;
    const float* X; unsigned char* ws; const LAS float* ratio; const LAS float* fin;
    __device__ __forceinline__ void mid(accv (&acc)[2][2][4][2], const Unit& u, int wr, int wc, int fr, int fq) const {
#pragma unroll
        for (int ai = 0; ai < 2; ++ai)
#pragma unroll
            for (int m = 0; m < 4; ++m) { const float rt = ratio[ai * 128 + wr * 64 + m * 16 + fr];
#pragma unroll
                for (int bj = 0; bj < 2; ++bj)
#pragma unroll
                    for (int n = 0; n < 2; ++n) acc[ai][bj][m][n] *= rt; }
    }
    __device__ __forceinline__ void operator()(const accv (&acc)[2][2][4][2], const Unit& u, int wr, int wc, int fr, int fq) const {
        const int row0 = u.pm * 256 + wr * 64 + fr; const int col0 = u.pn * 256 + wc * 32 + 8 * fq;
#pragma unroll
        for (int ai = 0; ai < 2; ++ai)
#pragma unroll
            for (int m = 0; m < 4; ++m) { const int row = row0 + ai * 128 + m * 16; const float* xr = X + (size_t)row * D + col0; bf16* orow = x1_row(ws, row) + col0; const float fs = fin[ai * 128 + wr * 64 + m * 16 + fr];
#pragma unroll
                for (int bj = 0; bj < 2; ++bj) { const accv x0 = *(const accv*)(xr + bj * 128), x1 = *(const accv*)(xr + bj * 128 + 4); const accv v0 = x0 + acc[ai][bj][m][0] * fs, v1 = x1 + acc[ai][bj][m][1] * fs;
                    v4u w; w.x = pg8::cvt_pk_bf16(v0[0], v0[1]); w.y = pg8::cvt_pk_bf16(v0[2], v0[3]); w.z = pg8::cvt_pk_bf16(v1[0], v1[1]); w.w = pg8::cvt_pk_bf16(v1[2], v1[3]);
                    *(v4u*)(orow + bj * 128) = w; }
                if (m & 1) asm volatile("" ::: "memory"); }
    }
};
struct EpiMoe1 {
    static constexpr bool PERM = true, AFTER_DRAIN = false; static constexpr bool MIDK = false;
    unsigned char* H; const float* bg; const float* bu; const int* rowinfo;
    __device__ __forceinline__ void operator()(const accv (&acc)[2][2][4][2], const Unit& u, int wr, int wc, int fr, int fq) const {
        const int row0 = u.pm * 256 + wr * 64 + fr; const int col = u.pn * 128 + wc * 32 + 8 * fq;
        float bgv[8], buv[8];
#pragma unroll
        for (int n = 0; n < 2; ++n) { const accv a = *(const accv*)(bg + u.e * FF + col + 4 * n), b = *(const accv*)(bu + u.e * FF + col + 4 * n);
#pragma unroll
            for (int j = 0; j < 4; ++j) { bgv[4 * n + j] = a[j]; buv[4 * n + j] = b[j]; } }
        float rsv[2][4];
#pragma unroll
        for (int ai = 0; ai < 2; ++ai)
#pragma unroll
            for (int m = 0; m < 4; ++m) rsv[ai][m] = __builtin_bit_cast(float, rowinfo[4 * (row0 + ai * 128 + m * 16) + 2]);
#pragma unroll
        for (int ai = 0; ai < 2; ++ai)
#pragma unroll
            for (int m = 0; m < 4; ++m) { const int row = row0 + ai * 128 + m * 16; float r[8]; const float rs = rsv[ai][m] * (1.0f / WSCALE);
#pragma unroll
                for (int n = 0; n < 2; ++n)
#pragma unroll
                    for (int j = 0; j < 4; ++j) { const float g = fminf(acc[ai][0][m][n][j] * rs + bgv[4 * n + j], 7.0f); const float up = fminf(fmaxf(acc[ai][1][m][n][j] * rs + buv[4 * n + j], -7.0f), 7.0f);
                        r[4 * n + j] = (up + 1.0f) * g * frcp(1.0f + fexp2(-1.702f * LOG2E * g)); }
                v2u w; w.x = pk4_fp8(r[0], r[1], r[2], r[3]); w.y = pk4_fp8(r[4], r[5], r[6], r[7]);
                *(v2u*)(H + (size_t)row * FF + col) = w; }
    }
};
struct EpiMoe2 {
    static constexpr bool PERM = true, AFTER_DRAIN = false; static constexpr bool MIDK = false;
    bf16* Y; const float* bd; const int* rowinfo;
    __device__ __forceinline__ void operator()(const accv (&acc)[2][2][4][2], const Unit& u, int wr, int wc, int fr, int fq) const {
        const int row0 = u.pm * 256 + wr * 64 + fr; const int colt = u.pn * 256 + wc * 32 + 8 * fq;
        float bv[2][8];
#pragma unroll
        for (int bj = 0; bj < 2; ++bj)
#pragma unroll
            for (int n = 0; n < 2; ++n) { const accv a = *(const accv*)(bd + u.e * D + colt + bj * 128 + 4 * n);
#pragma unroll
                for (int j = 0; j < 4; ++j) bv[bj][4 * n + j] = a[j]; }
        v2u sg[2][4];
#pragma unroll
        for (int ai = 0; ai < 2; ++ai)
#pragma unroll
            for (int m = 0; m < 4; ++m) sg[ai][m] = *(const v2u*)(rowinfo + 4 * (row0 + ai * 128 + m * 16));
#pragma unroll
        for (int ai = 0; ai < 2; ++ai)
#pragma unroll
            for (int m = 0; m < 4; ++m) { const int slot = (int)sg[ai][m].x; const unsigned gbits = sg[ai][m].y; const float gate = __builtin_bit_cast(float, gbits);
                if (slot >= 0) {
#pragma unroll
                    for (int bj = 0; bj < 2; ++bj) { float r[8];
#pragma unroll
                        for (int n = 0; n < 2; ++n)
#pragma unroll
                            for (int j = 0; j < 4; ++j) r[4 * n + j] = (acc[ai][bj][m][n][j] * (1.0f / WSCALE) + bv[bj][4 * n + j]) * gate;
                        v4u w; w.x = pg8::cvt_pk_bf16(r[0], r[1]); w.y = pg8::cvt_pk_bf16(r[2], r[3]); w.z = pg8::cvt_pk_bf16(r[4], r[5]); w.w = pg8::cvt_pk_bf16(r[6], r[7]);
                        *(v4u*)(Y + (size_t)slot * D + colt + bj * 128) = w; } } }
    }
};

struct InProjOrder {
    int G, c;
    __device__ bool next(int i, Unit& u) const {
        const int L = i * G + c; if (L >= 512) return false;
        const int s = pg8::xcd_remap(L, 512);
        if (s < 384) { const int grp = s / 48, r = s % 48; u.slot = 0; u.pm = grp * 8 + (r & 7); const int pi = r >> 3; u.pn = pi < 4 ? pi : pi + 2; u.e = 0;
            u.offA = (long)u.pm * 256 * D * 2; u.offB = (long)u.pn * 256 * D * 2; }
        else { const int r = s - 384; u.slot = 0; u.pm = r & 1; u.pn = r >> 1; u.e = 1;
            u.offA = (long)(WS_WINT - WS_HN) + (long)(1024 + u.pm * 256) * D * 2; u.offB = (long)(WS_HN - WS_WINT) + (long)u.pn * 256 * D * 2; }
        return true;
    }
    __device__ __forceinline__ void a_ready(const Unit&) const {}
    __device__ __forceinline__ void done(const Unit&) const {}
};
struct SsmOrder {
    int nwg, G, c, npn, rows_per_g, ldb;
    __device__ bool next(int i, Unit& u) const {
        const int L = i * G + c; if (L >= nwg) return false;
        const int per_g = 2 * npn; const int g = L / per_g, r = L % per_g;
        u.e = g; u.pm = r / npn; u.pn = r % npn; u.slot = 0;
        u.offA = ((long)u.pm * 256 * NG * UK + (long)g * UK) * 2; u.offB = ((long)g * rows_per_g + (long)u.pn * 256) * ldb * 2; return true;
    }
    __device__ __forceinline__ void a_ready(const Unit&) const {}
    __device__ __forceinline__ void done(const Unit&) const {}
};
struct MoeOrder {
    const LAS int* units; long ebytes; int gather;
    __device__ bool next(int i, Unit& u) const {
        if (i >= 32) return false;
        const int v = __builtin_amdgcn_readfirstlane(units[4 * i + 3]); if (!v) return false;
        u.pm = __builtin_amdgcn_readfirstlane(units[4 * i + 0]); u.pn = __builtin_amdgcn_readfirstlane(units[4 * i + 1]); u.e = __builtin_amdgcn_readfirstlane(units[4 * i + 2]);
        u.slot = i; u.offA = gather ? 0l : (long)u.pm * 256 * D;     u.offB = (long)u.e * ebytes + (long)u.pn * 256 * 16; return true;
    }
    __device__ __forceinline__ void a_ready(const Unit&) const {}
    __device__ __forceinline__ void done(const Unit&) const {}
};

struct CvItem { const float* src; bf16* dst; const float* kscale; int ldw, K, rmul, radd, k0, n0; };
constexpr int CV_I_IN = (D / 64) * (NPROJ / 32), CV_I_GLU = (SSW / 64) * (SSW / 32), CV_I_OUT = (D / 64) * (D / 32), CV_I_E = (D / 64) * (FF / 32);
constexpr int CV_N_EARLY = CV_I_IN + 2 * CV_I_GLU + CV_I_OUT, CV_N_EXP = 3 * NE * (D / 8);
__device__ __forceinline__ void cv_set(CvItem& c, const float* W, int ldw, int K, int N, bf16* WT, int rmul, int radd, int item) {
    const int nblk = N / 32, kb = item / nblk, nb = item % nblk; c.src = W; c.dst = WT; c.kscale = nullptr; c.ldw = ldw; c.K = K; c.rmul = rmul; c.radd = radd; c.k0 = 64 * kb; c.n0 = 32 * nb;
}
__device__ __forceinline__ void cv_decode_early(Frame& F, int r, CvItem& c) {
    bf16* WinT = (bf16*)(F.ws + WS_WINT); bf16* WgluT = (bf16*)(F.ws + WS_WGLUT); bf16* WoutT = (bf16*)(F.ws + WS_WOUTT);
    if (r < CV_I_IN) { cv_set(c, F.in[2], NPROJ, D, NPROJ, WinT, 1, 0, r); return; } r -= CV_I_IN;
    if (r < CV_I_GLU) { cv_set(c, F.in[11], 2 * SSW, SSW, SSW, WgluT, 2, 0, r); return; } r -= CV_I_GLU;
    if (r < CV_I_GLU) { cv_set(c, F.in[11] + SSW, 2 * SSW, SSW, SSW, WgluT, 2, 128, r); return; } r -= CV_I_GLU;
    cv_set(c, F.in[14], D, D, D, WoutT, 1, 0, r);
    c.kscale = (c.k0 < SBW) ? F.in[12] + c.k0 : F.in[13] + (c.k0 - SBW);
}
__device__ __forceinline__ void cv_decode_exp(Frame& F, int r, CvItem& c) {
    bf16* W1T = (bf16*)(F.ws + WS_W1T); bf16* W2T = (bf16*)(F.ws + WS_W2T);
    const int mat = r / CV_I_E, sub = r % CV_I_E, kind = mat / NE, e = mat % NE;
    if (kind == 0) cv_set(c, F.in[18] + (size_t)e * D * FF, FF, D, FF, W1T + (size_t)e * 2 * FF * D, 2, 0, sub);
    else if (kind == 1) cv_set(c, F.in[20] + (size_t)e * D * FF, FF, D, FF, W1T + (size_t)e * 2 * FF * D, 2, 128, sub);
    else cv_set(c, F.in[22] + (size_t)e * FF * D, D, FF, D, W2T + (size_t)e * D * FF, 1, 0, sub);
}
__device__ __forceinline__ void cv_load(const CvItem& c, int lane, float (&v)[32]) {
    const float* p = c.src + (size_t)(c.k0 + (lane >> 5)) * c.ldw + c.n0 + (lane & 31);
#pragma unroll
    for (int i = 0; i < 32; ++i) v[i] = p[(size_t)(2 * i) * c.ldw];
}
__device__ __forceinline__ void cv_store(const CvItem& c, int lane, const float (&v)[32], LAS float* scr) {
#pragma unroll
    for (int i = 0; i < 32; ++i) scr[(2 * i + (lane >> 5)) * 33 + (lane & 31)] = v[i];
    LDS_WAIT(); asm volatile("" ::: "memory");
    const int cc = lane & 7;
#pragma unroll
    for (int j = 0; j < 4; ++j) { const int nl = (lane >> 3) + 8 * j; const int n = c.n0 + nl; const int drow = (n >> 7) * 128 * c.rmul + c.radd + (n & 127); const LAS float* s = scr + (8 * cc) * 33 + nl;
        float e0 = s[0 * 33], e1 = s[1 * 33], e2 = s[2 * 33], e3 = s[3 * 33], e4 = s[4 * 33], e5 = s[5 * 33], e6 = s[6 * 33], e7 = s[7 * 33];
        if (c.kscale) { const f32x4 ka = *(const f32x4*)(c.kscale + 8 * cc), kb = *(const f32x4*)(c.kscale + 8 * cc + 4); e0 *= ka.x; e1 *= ka.y; e2 *= ka.z; e3 *= ka.w; e4 *= kb.x; e5 *= kb.y; e6 *= kb.z; e7 *= kb.w; }
        v4u o; o.x = pg8::cvt_pk_bf16(e0, e1); o.y = pg8::cvt_pk_bf16(e2, e3); o.z = pg8::cvt_pk_bf16(e4, e5); o.w = pg8::cvt_pk_bf16(e6, e7);
        *(GAS v4u*)(c.dst + (size_t)drow * c.K + c.k0 + 8 * cc) = o; }
    LDS_WAIT(); asm volatile("" ::: "memory");
}
__device__ __forceinline__ void cv_item_early(Frame& F, int it, LAS float* scr) { CvItem c; float v[32]; cv_decode_early(F, it, c); cv_load(c, F.lane, v); cv_store(c, F.lane, v, scr); }
__device__ __forceinline__ void cv_run_early(Frame& F, int first, int stride, int n, LAS float* scr) {
    CvItem ca, cb; float va[32], vb[32];
    int it = first; if (it >= n) return;
    cv_decode_early(F, it, ca);
    cv_load(ca, F.lane, va);
    for (;;) {
        const int nit = it + stride; const bool more = nit < n;
        if (more) { cv_decode_early(F, nit, cb); cv_load(cb, F.lane, vb); }
        cv_store(ca, F.lane, va, scr);
        if (!more) break;
        ca = cb;
#pragma unroll
        for (int i = 0; i < 32; ++i) va[i] = vb[i];
        it = nit;
    }
}
__device__ __forceinline__ void xv_item(Frame& F, int it) {
    unsigned char* W1T = F.ws + WS_W1T; unsigned char* W2T = F.ws + WS_W2T;
    const float* w0 = F.in[18]; const float* w1 = F.in[20]; const float* w2 = F.in[22];
    asm volatile("" : "+s"(w0), "+s"(w1), "+s"(w2));
    const int lane = F.lane;
    {
        const int mat = it >> 7, kb = (it & 127) >> 1, half = it & 1, kind = mat / NE, e = mat % NE;
        const float* src = (kind == 0 ? w0 : (kind == 1 ? w1 : w2)) + (size_t)e * D * FF + (size_t)(kb * 16) * FF + half * 512 + 4 * lane;
        f32x4 v[16][2];
#pragma unroll
        for (int rr = 0; rr < 16; ++rr)
#pragma unroll
            for (int j = 0; j < 2; ++j) v[rr][j] = *(const GAS f32x4*)(src + (size_t)rr * FF + 256 * j);
        unsigned char* dst; int jstride;
        if (kind < 2) { dst = W1T + (size_t)e * 2 * FF * D + ((size_t)kb * 2 * FF + (size_t)(half * 4 + (lane >> 5)) * 256 + (kind == 1 ? 128 : 0) + 4 * (lane & 31)) * 16; jstride = 512 * 16; }
        else { dst = W2T + (size_t)e * D * FF + ((size_t)kb * D + half * 512 + 4 * lane) * 16; jstride = 256 * 16; }
#pragma unroll
        for (int j = 0; j < 2; ++j)
#pragma unroll
            for (int c = 0; c < 4; ++c) { v4u o;
                o.x = pk4_fp8(v[0][j][c] * WSCALE, v[1][j][c] * WSCALE, v[2][j][c] * WSCALE, v[3][j][c] * WSCALE); o.y = pk4_fp8(v[4][j][c] * WSCALE, v[5][j][c] * WSCALE, v[6][j][c] * WSCALE, v[7][j][c] * WSCALE);
                o.z = pk4_fp8(v[8][j][c] * WSCALE, v[9][j][c] * WSCALE, v[10][j][c] * WSCALE, v[11][j][c] * WSCALE); o.w = pk4_fp8(v[12][j][c] * WSCALE, v[13][j][c] * WSCALE, v[14][j][c] * WSCALE, v[15][j][c] * WSCALE);
                *(GAS v4u*)(dst + (size_t)j * jstride + c * 16) = o; }
    }
}
__device__ __forceinline__ void rms_row_to_bf16(int lane, const float* xrow, const float* g, bf16* orow) {
    const GAS f32x4* xr = (const GAS f32x4*)xrow + lane; const GAS f32x4* gr = (const GAS f32x4*)g + lane;
    f32x4 v[4]; float s = 0.f;
#pragma unroll
    for (int j = 0; j < 4; ++j) { v[j] = xr[64 * j]; s += (v[j].x * v[j].x + v[j].y * v[j].y) + (v[j].z * v[j].z + v[j].w * v[j].w); }
    const float rstd = 1.0f / sqrtf(wave_sum(s) * (1.f / D) + EPS);
    GAS unsigned long long* o8 = (GAS unsigned long long*)orow + lane;
#pragma unroll
    for (int j = 0; j < 4; ++j) { const f32x4 gg = gr[64 * j]; o8[64 * j] = (unsigned long long)pk2(v[j].x * rstd * gg.x, v[j].y * rstd * gg.y) | ((unsigned long long)pk2(v[j].z * rstd * gg.z, v[j].w * rstd * gg.w) << 32); }
}
__device__ __forceinline__ void sincos_acc(float th, float& s, float& c) {
    const float k = rintf(th * 0.15915494309189535f);
    float r = fmaf(-k, 6.28125f, th); r = fmaf(-k, 1.9353071795864769e-3f, r);
    const float x = 0.25f * r, x2 = x * x;
    float sn = x * (1.0f + x2 * (-1.0f / 6 + x2 * (1.0f / 120 + x2 * (-1.0f / 5040 + x2 * (1.0f / 362880 + x2 * (-1.0f / 39916800))))));
    float cs = 1.0f + x2 * (-0.5f + x2 * (1.0f / 24 + x2 * (-1.0f / 720 + x2 * (1.0f / 40320 + x2 * (-1.0f / 3628800 + x2 * (1.0f / 479001600))))));
#pragma unroll
    for (int i = 0; i < 2; ++i) { const float s2 = 2.0f * sn * cs, c2 = 1.0f - 2.0f * sn * sn; sn = s2; cs = c2; }
    s = sn; c = cs;
}
__device__ __forceinline__ void ssm_tables(Frame& F, int g) {
    constexpr int PT = 36, BS = 17, CS = 68, KT = 324, KC = 20;
    LAS float* pwr = (LAS float*)(F.lds);
    LAS float* pwi = pwr + 64 * PT;
    LAS float* bbr = pwi + 64 * PT;
    LAS float* bbi = bbr + 64 * BS;
    LAS float* ccr = bbi + 64 * BS;
    LAS float* cci = ccr + 16 * CS;
    LAS float* km = cci + 16 * CS;
    const float* lam_re = F.in[3]; const float* lam_im = F.in[4]; const float* log_dt = F.in[5];
    const float* b_re = F.in[6]; const float* b_im = F.in[7]; const float* c_re = F.in[8]; const float* c_im = F.in[9]; const float* dsk = F.in[10];
    float* lamL = (float*)(F.ws + WS_LAML); bf16* WE = (bf16*)(F.ws + WS_WE); bf16* TW = (bf16*)(F.ws + WS_TW);
    const int tid = F.tid;
    if (tid < 64) { const int p = tid;
        const float lr = lam_re[g * NP + p], li = lam_im[g * NP + p], dt = expf(log_dt[g]);
        const float er = expf(lr * dt); float sn, cs; sincos_acc(li * dt, sn, cs);
        const float br = er * cs, bi = er * sn;
        const float nr = br - 1.0f, ni = bi, den = 1.0f / (lr * lr + li * li);
        const float fr = (nr * lr + ni * li) * den, fi = (ni * lr - nr * li) * den;
        float pr = 1.0f, pi = 0.0f;
        for (int n = 0; n <= 32; ++n) { pwr[p * PT + n] = pr; pwi[p * PT + n] = pi; const float t = pr * br - pi * bi; pi = pr * bi + pi * br; pr = t; }
        lamL[(g * 2 + 0) * NP + p] = pwr[p * PT + 32]; lamL[(g * 2 + 1) * NP + p] = pwi[p * PT + 32];
        float xr[GC], xi[GC];
#pragma unroll
        for (int c = 0; c < GC; ++c) { xr[c] = b_re[(g * NP + p) * GC + c]; xi[c] = b_im[(g * NP + p) * GC + c]; }
#pragma unroll
        for (int c = 0; c < GC; ++c) { bbr[p * BS + c] = fr * xr[c] - fi * xi[c]; bbi[p * BS + c] = fr * xi[c] + fi * xr[c]; }
    }
    for (int i = tid; i < 1024; i += NWAVES * 64) { ccr[(i >> 6) * CS + (i & 63)] = c_re[g * 1024 + i]; cci[(i >> 6) * CS + (i & 63)] = c_im[g * 1024 + i]; }
    __syncthreads();
    {
        const int pair = tid & 255, co = pair >> 4, ci = pair & 15, t0 = (tid >> 8) * 16;
        float acc[16];
#pragma unroll
        for (int t = 0; t < 16; ++t) acc[t] = 0.f;
        for (int p = 0; p < NP; ++p) { const float cr = ccr[co * CS + p], cim = cci[co * CS + p], xr = bbr[p * BS + ci], xi = bbi[p * BS + ci];
            const float gr = cr * xr - cim * xi, gi = cr * xi + cim * xr;
#pragma unroll
            for (int t4 = 0; t4 < 4; ++t4) { const f32x4 a = *(const LAS f32x4*)(pwr + p * PT + t0 + 4 * t4), bq = *(const LAS f32x4*)(pwi + p * PT + t0 + 4 * t4);
#pragma unroll
                for (int t = 0; t < 4; ++t) acc[4 * t4 + t] += gr * a[t] - gi * bq[t]; } }
#pragma unroll
        for (int t = 0; t < 16; ++t) km[(t0 + t) * KT + co * KC + ci] = acc[t];
    }
    __syncthreads();
    {
        const int n = tid, i = n >> 4, co = n & 15; const float dv = dsk[g * GC + co];
        bf16* dst = TW + ((size_t)g * 512 + n) * UK;
        for (int j = 0; j < LC; ++j) {
            float v[16];
            const LAS float* kr = km + (j <= i ? i - j : 0) * KT + co * KC;
#pragma unroll
            for (int c4 = 0; c4 < 4; ++c4) { const f32x4 q = *(const LAS f32x4*)(kr + 4 * c4);
#pragma unroll
                for (int t = 0; t < 4; ++t) v[4 * c4 + t] = (j <= i) ? q[t] : 0.f; }
            if (j == i) {
#pragma unroll
                for (int ci = 0; ci < 16; ++ci) v[ci] += (ci == co) ? dv : 0.f; }
            v4u o0, o1; o0.x = pg8::cvt_pk_bf16(v[0], v[1]); o0.y = pg8::cvt_pk_bf16(v[2], v[3]); o0.z = pg8::cvt_pk_bf16(v[4], v[5]); o0.w = pg8::cvt_pk_bf16(v[6], v[7]);
            o1.x = pg8::cvt_pk_bf16(v[8], v[9]); o1.y = pg8::cvt_pk_bf16(v[10], v[11]); o1.z = pg8::cvt_pk_bf16(v[12], v[13]); o1.w = pg8::cvt_pk_bf16(v[14], v[15]);
            *(GAS v4u*)(dst + j * 16) = o0; *(GAS v4u*)(dst + j * 16 + 8) = o1; }
        for (int k8 = 0; k8 < 16; ++k8) { float v[8];
            const int ri = k8 >> 3, p0 = 8 * (k8 & 7);
#pragma unroll
            for (int e = 0; e < 8; ++e) { const int p = p0 + e; const float cr = ccr[co * CS + p], cim = cci[co * CS + p], pr = pwr[p * PT + i + 1], pi = pwi[p * PT + i + 1];
                v[e] = ri == 0 ? (cr * pr - cim * pi) : -(cr * pi + cim * pr); }
            v4u o; o.x = pg8::cvt_pk_bf16(v[0], v[1]); o.y = pg8::cvt_pk_bf16(v[2], v[3]); o.z = pg8::cvt_pk_bf16(v[4], v[5]); o.w = pg8::cvt_pk_bf16(v[6], v[7]);
            *(GAS v4u*)(dst + 512 + k8 * 8) = o; }
    }
    {
        const int row = tid & 127, ri = row >> 6, p = row & 63, kq = tid >> 7;
        bf16* dst = WE + ((size_t)g * 128 + row) * 512 + kq * 128;
        for (int k8 = 0; k8 < 16; ++k8) { float v[8];
#pragma unroll
            for (int e = 0; e < 8; ++e) { const int k = kq * 128 + k8 * 8 + e, j = k >> 4, c = k & 15; const float pr = pwr[p * PT + 31 - j], pi = pwi[p * PT + 31 - j], xr = bbr[p * BS + c], xi = bbi[p * BS + c];
                v[e] = ri == 0 ? (pr * xr - pi * xi) : (pr * xi + pi * xr); }
            v4u o; o.x = pg8::cvt_pk_bf16(v[0], v[1]); o.y = pg8::cvt_pk_bf16(v[2], v[3]); o.z = pg8::cvt_pk_bf16(v[4], v[5]); o.w = pg8::cvt_pk_bf16(v[6], v[7]);
            *(GAS v4u*)(dst + k8 * 8) = o; }
    }
    __syncthreads();
}
__device__ __forceinline__ void rms_rows4_to_bf16(int lane, const float* x0, const float* g, bf16* o0) {
    const GAS f32x4* gr = (const GAS f32x4*)g + lane;
    f32x4 v[4][4]; float sq[4];
#pragma unroll
    for (int r = 0; r < 4; ++r)
#pragma unroll
        for (int j = 0; j < 4; ++j) v[r][j] = ((const GAS f32x4*)(x0 + (size_t)r * D) + lane)[64 * j];
#pragma unroll
    for (int r = 0; r < 4; ++r) { sq[r] = 0.f;
#pragma unroll
        for (int j = 0; j < 4; ++j) sq[r] += (v[r][j].x * v[r][j].x + v[r][j].y * v[r][j].y) + (v[r][j].z * v[r][j].z + v[r][j].w * v[r][j].w); }
#pragma unroll
    for (int o = 1; o < 64; o <<= 1) {
#pragma unroll
        for (int r = 0; r < 4; ++r) sq[r] += __shfl_xor(sq[r], o); }
#pragma unroll
    for (int j = 0; j < 4; ++j) { const f32x4 gg = gr[64 * j];
#pragma unroll
        for (int r = 0; r < 4; ++r) { const float rs = 1.0f / sqrtf(sq[r] * (1.f / D) + EPS); v2u w; w.x = pg8::cvt_pk_bf16(v[r][j].x * rs * gg.x, v[r][j].y * rs * gg.y); w.y = pg8::cvt_pk_bf16(v[r][j].z * rs * gg.z, v[r][j].w * rs * gg.w);
            ((GAS v2u*)(o0 + (size_t)r * D) + lane)[64 * j] = w; } }
}
__device__ __forceinline__ void rms_rows2_to_bf16(int lane, const float* x0, const float* x1, const float* g, bf16* o0, bf16* o1) {
    const GAS f32x4* xa = (const GAS f32x4*)x0 + lane; const GAS f32x4* xb = (const GAS f32x4*)x1 + lane; const GAS f32x4* gr = (const GAS f32x4*)g + lane;
    f32x4 va[4], vb[4]; float sa = 0.f, sb = 0.f;
#pragma unroll
    for (int j = 0; j < 4; ++j) { va[j] = xa[64 * j]; vb[j] = xb[64 * j]; }
#pragma unroll
    for (int j = 0; j < 4; ++j) { sa += (va[j].x * va[j].x + va[j].y * va[j].y) + (va[j].z * va[j].z + va[j].w * va[j].w); sb += (vb[j].x * vb[j].x + vb[j].y * vb[j].y) + (vb[j].z * vb[j].z + vb[j].w * vb[j].w); }
#pragma unroll
    for (int o = 1; o < 64; o <<= 1) { sa += __shfl_xor(sa, o); sb += __shfl_xor(sb, o); }
    const float ra = 1.0f / sqrtf(sa * (1.f / D) + EPS), rb = 1.0f / sqrtf(sb * (1.f / D) + EPS);
    GAS v2u* pa = (GAS v2u*)o0 + lane; GAS v2u* pb = (GAS v2u*)o1 + lane;
#pragma unroll
    for (int j = 0; j < 4; ++j) { const f32x4 gg = gr[64 * j];
        v2u wa, wb; wa.x = pg8::cvt_pk_bf16(va[j].x * ra * gg.x, va[j].y * ra * gg.y); wa.y = pg8::cvt_pk_bf16(va[j].z * ra * gg.z, va[j].w * ra * gg.w);
        wb.x = pg8::cvt_pk_bf16(vb[j].x * rb * gg.x, vb[j].y * rb * gg.y); wb.y = pg8::cvt_pk_bf16(vb[j].z * rb * gg.z, vb[j].w * rb * gg.w);
        pa[64 * j] = wa; pb[64 * j] = wb; }
}
constexpr int CV_N_W1 = 2 * NE * (D / 8);
constexpr int P1_GEMM_WG = 176;
constexpr int Q0_HN = M / 8, Q0_END = Q0_HN + CV_N_EARLY / 4;
static_assert(Q0_END % 8 == 0 && CV_N_EARLY % 4 == 0, "P0 queue");
__device__ __forceinline__ void p0_prologue(Frame& F, unsigned long long& t_lo_, unsigned long long& t_hi_) {
    TMARK(100);
    LAS float* scr = (LAS float*)(F.lds + RING_OFF + F.wave * 16384);
    unsigned* q = (unsigned*)(F.ctl + CW_Q0); volatile LAS unsigned* slot = F.MISC + 16;
    bf16* HN = (bf16*)(F.ws + WS_HN);
    for (;;) {
        __syncthreads();
        if (F.tid == 0) *slot = __hip_atomic_fetch_add(q, 8u, RLX_AGENT);
        __syncthreads();
        const int base = (int)__builtin_amdgcn_readfirstlane(*slot); if (base >= Q0_END) break;
        const int idx = base + F.wave;
        if (idx < Q0_HN) { const int m0 = idx * 8;
#pragma unroll 1
            for (int j = 0; j < 2; ++j) { const int m = m0 + 4 * j; rms_rows4_to_bf16(F.lane, F.in[0] + (size_t)m * D, F.in[1], HN + (size_t)m * D); } }
        else { const int g4 = (idx - Q0_HN) * 4;
#pragma unroll 1
            for (int j = 0; j < 4; ++j) cv_item_early(F, g4 + j, scr); }
    }
    TMARK(104);
}
__device__ __forceinline__ void q1_drain(Frame& F, int max_claims, unsigned* stop, unsigned stop_target) {
    unsigned* q = (unsigned*)(F.ctl + CW_Q1); volatile LAS unsigned* slot = F.MISC + 18;
    for (int n = 0; max_claims < 0 || n < max_claims; ++n) {
        __syncthreads();
        if (F.tid == 0) { unsigned v = 0x7fffffffu; if (!(stop_target && __hip_atomic_load(stop, RLX_AGENT) >= stop_target)) v = __hip_atomic_fetch_add(q, 8u, RLX_AGENT); *slot = v; }
        __syncthreads();
        const unsigned base = (unsigned)__builtin_amdgcn_readfirstlane(*slot); if (base >= (unsigned)CV_N_W1) break;
        xv_item(F, (int)base + F.wave);
    }
}
__device__ __forceinline__ void p1_side(Frame& F, int tabler_idx) {
    if (tabler_idx >= 0) { ssm_tables(F, tabler_idx);
        if (tabler_idx == 0 && F.tid < 128) {
            bf16* WE = (bf16*)(F.ws + WS_WE) + (size_t)NG * 128 * 512;
            for (int i = 0; i < 512 / 8; ++i) *(GAS v4u*)(WE + (size_t)F.tid * 512 + i * 8) = (v4u){0u, 0u, 0u, 0u}; }
        if (tabler_idx == 1) {
            const float* wr = F.in[16]; bf16* img = (bf16*)(F.ws + WS_RWIMG);
            for (int idx = F.tid; idx < D * NE; idx += NWAVES * 64) { const float w = wr[idx]; const unsigned h = f2bf(w); const unsigned l = f2bf(w - bf2f((unsigned short)h)); const int k = idx >> 5, e = idx & 31;
                img[e * RT_WSTR + k] = (bf16)h; img[(NE + e) * RT_WSTR + k] = (bf16)l; }
            if (F.tid < 2 * NE) for (int k = D; k < RT_WSTR; ++k) img[F.tid * RT_WSTR + k] = 0; } }
    q1_drain(F, -1, (unsigned*)(F.ctl + CW_DONE1), (unsigned)P1_GEMM_WG);
}
__device__ __forceinline__ void w2_drain(Frame& F, int max_claims) {
    unsigned* q = (unsigned*)(F.ctl + CW_Q2); volatile LAS unsigned* slot = F.MISC + 19;
    for (int n = 0; max_claims < 0 || n < max_claims; ++n) {
        __syncthreads();
        if (F.tid == 0) *slot = __hip_atomic_fetch_add(q, 8u, RLX_AGENT);
        __syncthreads();
        const int base = CV_N_W1 + (int)__builtin_amdgcn_readfirstlane(*slot); if (base >= CV_N_EXP) break;
        xv_item(F, base + F.wave);
    }
}

__device__ __forceinline__ void attn_simple_unit(const unsigned short* Qh, const unsigned short* Kh, const unsigned short* Vh, bf16* Y, int b, int h, int qb, int lane) {
    const int t = qb * 64 + lane; const size_t row = (size_t)b * SEQ + t;
    float q[64], o[64];
    { const v4u* qp = (const v4u*)(Qh + row * SBW + h * HD);
#pragma unroll
      for (int i = 0; i < 8; ++i) { const v4u w = qp[i];
#pragma unroll
          for (int j = 0; j < 4; ++j) { const unsigned wj = w[j]; const h16x2 hv = __builtin_bit_cast(h16x2, wj); q[8 * i + 2 * j] = (float)hv.x; q[8 * i + 2 * j + 1] = (float)hv.y; } } }
#pragma unroll
    for (int d = 0; d < 64; ++d) o[d] = 0.f;
    float cum = 0.f;
    for (int s = qb * 64 + 62; s >= 0; --s) {
        const size_t krow = ((size_t)b * SEQ + s) * SBW + h * HD;
        const v4u* kp = (const v4u*)(Kh + krow); const v4u* vp = (const v4u*)(Vh + krow);
        float z = 0.f;
#pragma unroll
        for (int i = 0; i < 8; ++i) { const v4u w = kp[i];
#pragma unroll
            for (int j = 0; j < 4; ++j) { const unsigned wj = w[j]; const h16x2 hv = __builtin_bit_cast(h16x2, wj); z = fmaf(q[8 * i + 2 * j], (float)hv.x, z); z = fmaf(q[8 * i + 2 * j + 1], (float)hv.y, z); } }
        const bool act = s < t;
        const float t1 = flog2(1.0f + fexp2(-fabsf(z)));
        const float L = act ? -(fmaxf(z, 0.f) + t1) : 0.f;
        const float ls = fminf(z, 0.f) - t1;
        const float p = act ? fexp2(ls + cum) : 0.f;
        cum += L;
#pragma unroll
        for (int i = 0; i < 8; ++i) { const v4u w = vp[i];
#pragma unroll
            for (int j = 0; j < 4; ++j) { const unsigned wj = w[j]; const h16x2 hv = __builtin_bit_cast(h16x2, wj); o[8 * i + 2 * j] = fmaf(p, (float)hv.x, o[8 * i + 2 * j]); o[8 * i + 2 * j + 1] = fmaf(p, (float)hv.y, o[8 * i + 2 * j + 1]); } }
        if (__all(cum < -150.0f)) break;
    }
    bf16* yp = Y + row * SBW + h * HD;
#pragma unroll
    for (int i = 0; i < 8; ++i) { v4u w; w.x = pk2(o[8 * i], o[8 * i + 1]); w.y = pk2(o[8 * i + 2], o[8 * i + 3]); w.z = pk2(o[8 * i + 4], o[8 * i + 5]); w.w = pk2(o[8 * i + 6], o[8 * i + 7]); *(v4u*)(yp + 8 * i) = w; }
}
typedef _Float16 h8v __attribute__((ext_vector_type(8)));
typedef float f16v __attribute__((ext_vector_type(16)));
__device__ __forceinline__ void attn_mfma_unit(const _Float16* Qh, const _Float16* Kh, const _Float16* VT, bf16* Y, float* SSQ, int b, int hd, int qb, int lane, h8v tri0, h8v tri1) {
    const int r = lane & 31, hh = lane >> 5, q0 = qb * 32;
    const _Float16* qrow = Qh + ((size_t)b * SEQ + q0 + r) * SBW + hd * HD + 8 * hh;
    h8v qf[4];
#pragma unroll
    for (int kd = 0; kd < 4; ++kd) qf[kd] = *(const h8v*)(qrow + 16 * kd);
    f16v o0, o1;
#pragma unroll
    for (int i = 0; i < 16; ++i) { o0[i] = 0.f; o1[i] = 0.f; }
    float carry = 0.f;
    const _Float16* kbase = Kh + ((size_t)b * SEQ + r) * SBW + hd * HD + 8 * hh;
    const _Float16* vbase = VT + ((size_t)b * SBW + hd * HD + r) * SEQ + 8 * hh;
    h8v kf[4], vf[2][2], kn[4], vn[2][2];
#pragma unroll
    for (int kd = 0; kd < 4; ++kd) kf[kd] = *(const h8v*)(kbase + (size_t)q0 * SBW + 16 * kd);
#pragma unroll
    for (int db = 0; db < 2; ++db)
#pragma unroll
        for (int ss = 0; ss < 2; ++ss) vf[db][ss] = *(const h8v*)(vbase + (size_t)(32 * db) * SEQ + q0 + 16 * ss);
    for (int key0 = q0; key0 >= 0; key0 -= 32) {
        { const int kn0 = key0 >= 32 ? key0 - 32 : key0;
#pragma unroll
          for (int kd = 0; kd < 4; ++kd) kn[kd] = *(const h8v*)(kbase + (size_t)kn0 * SBW + 16 * kd);
#pragma unroll
          for (int db = 0; db < 2; ++db)
#pragma unroll
              for (int ss = 0; ss < 2; ++ss) vn[db][ss] = *(const h8v*)(vbase + (size_t)(32 * db) * SEQ + kn0 + 16 * ss); }
        f16v z;
#pragma unroll
        for (int i = 0; i < 16; ++i) z[i] = 0.f;
#pragma unroll
        for (int kd = 0; kd < 4; ++kd) z = __builtin_amdgcn_mfma_f32_32x32x16_f16(kf[kd], qf[kd], z, 0, 0, 0);
        const bool diag = key0 == q0;
        h8v lh[2], ll[2];
#pragma unroll
        for (int i = 0; i < 16; ++i) { const int koff = (i & 3) + 8 * (i >> 2) + 4 * hh; const bool act = !diag || koff < r;
            const float zi = z[i]; const float t1 = flog2(1.0f + fexp2(-fabsf(zi)));
            const float L = act ? fmaxf(-(fmaxf(zi, 0.f) + t1), -60000.0f) : 0.f;
            const _Float16 hi = (_Float16)L; const _Float16 lo = (_Float16)(L - (float)hi);
            lh[i >> 3][i & 7] = hi; ll[i >> 3][i & 7] = lo; }
        f16v cum;
#pragma unroll
        for (int i = 0; i < 16; ++i) cum[i] = carry;
        cum = __builtin_amdgcn_mfma_f32_32x32x16_f16(tri0, lh[0], cum, 0, 0, 0);
        cum = __builtin_amdgcn_mfma_f32_32x32x16_f16(tri1, lh[1], cum, 0, 0, 0);
        cum = __builtin_amdgcn_mfma_f32_32x32x16_f16(tri0, ll[0], cum, 0, 0, 0);
        cum = __builtin_amdgcn_mfma_f32_32x32x16_f16(tri1, ll[1], cum, 0, 0, 0);
        h8v pf[2];
#pragma unroll
        for (int i = 0; i < 16; ++i) { const int koff = (i & 3) + 8 * (i >> 2) + 4 * hh; const bool act = !diag || koff < r;
            const float p = act ? fexp2(z[i] + cum[i]) : 0.f; pf[i >> 3][i & 7] = (_Float16)p; }
        o0 = __builtin_amdgcn_mfma_f32_32x32x16_f16(vf[0][0], pf[0], o0, 0, 0, 0);
        o0 = __builtin_amdgcn_mfma_f32_32x32x16_f16(vf[0][1], pf[1], o0, 0, 0, 0);
        o1 = __builtin_amdgcn_mfma_f32_32x32x16_f16(vf[1][0], pf[0], o1, 0, 0, 0);
        o1 = __builtin_amdgcn_mfma_f32_32x32x16_f16(vf[1][1], pf[1], o1, 0, 0, 0);
        carry = __shfl(cum[0], r);
        if (__all(carry < -150.0f)) break;
#pragma unroll
        for (int kd = 0; kd < 4; ++kd) kf[kd] = kn[kd];
#pragma unroll
        for (int db = 0; db < 2; ++db)
#pragma unroll
            for (int ss = 0; ss < 2; ++ss) vf[db][ss] = vn[db][ss];
    }
    { float sq = 0.f;
#pragma unroll
      for (int i = 0; i < 16; ++i) sq += o0[i] * o0[i] + o1[i] * o1[i];
      sq += __shfl_xor(sq, 32); if (hh == 0) SSQ[((size_t)b * SEQ + q0 + r) * NH + hd] = sq; }
    bf16* yp = Y + ((size_t)b * SEQ + q0 + r) * D + hd * HD + 4 * hh;
#pragma unroll
    for (int g4 = 0; g4 < 4; ++g4) { v2u w0, w1; w0.x = pk2(o0[4 * g4], o0[4 * g4 + 1]); w0.y = pk2(o0[4 * g4 + 2], o0[4 * g4 + 3]); w1.x = pk2(o1[4 * g4], o1[4 * g4 + 1]); w1.y = pk2(o1[4 * g4 + 2], o1[4 * g4 + 3]);
        *(v2u*)(yp + 8 * g4) = w0; *(v2u*)(yp + 32 + 8 * g4) = w1; }
}
__device__ __forceinline__ void attn_one(Frame& F, int u) {
    const _Float16* Qh = (const _Float16*)(F.ws + WS_Q); const _Float16* Kh = (const _Float16*)(F.ws + WS_K); const _Float16* VT = (const _Float16*)(F.ws + WS_V);
    bf16* Y = (bf16*)(F.ws + WS_YCAT); float* SSQ = (float*)(F.ws + WS_SSQSB);
    constexpr int NQB = SEQ / 32;
    const int lane = F.lane, r = lane & 31, hh = lane >> 5;
    h8v tri0, tri1;
#pragma unroll
    for (int e = 0; e < 8; ++e) { const int k0 = 8 * (e >> 2) + 4 * hh + (e & 3); tri0[e] = (k0 >= r) ? (_Float16)1.0f : (_Float16)0.0f; tri1[e] = (16 + k0 >= r) ? (_Float16)1.0f : (_Float16)0.0f; }
    const int qb = u % NQB, bh = u / NQB; attn_mfma_unit(Qh, Kh, VT, Y, SSQ, bh / NH, bh % NH, qb, lane, tri0, tri1);
}

__device__ __forceinline__ void scan_phase(Frame& F, int task) {
    const int b = task / NG, g = task % NG, p = F.lane;
    const float* lamL = (const float*)(F.ws + WS_LAML); const float* S = (const float*)(F.ws + WS_SLOC); bf16* U = (bf16*)(F.ws + WS_UCAT);
    const float lr = lamL[(g * 2 + 0) * NP + p], li = lamL[(g * 2 + 1) * NP + p];
    float xr = 0.f, xi = 0.f;
    for (int c0 = 0; c0 < CPB; c0 += 8) {
        float sr[8], si[8];
#pragma unroll
        for (int j = 0; j < 8; ++j) { const size_t base = ((size_t)(b * CPB + c0 + j) * NG + g) * 128; sr[j] = S[base + p]; si[j] = S[base + 64 + p]; }
#pragma unroll
        for (int j = 0; j < 8; ++j) { bf16* dst = U + ((size_t)(b * CPB + c0 + j) * NG + g) * UK + 512;
            dst[p] = (bf16)f2bf(xr); dst[64 + p] = (bf16)f2bf(xi);
            const float nr = lr * xr - li * xi + sr[j], ni = lr * xi + li * xr + si[j]; xr = nr; xi = ni; }
    }
}

__device__ __forceinline__ void router_phase(Frame& F) {
    typedef short s8v __attribute__((ext_vector_type(8)));
    typedef float f16v __attribute__((ext_vector_type(16)));
    LAS bf16* wh = (LAS bf16*)F.lds; LAS bf16* wl = wh + NE * RT_WSTR;
    LAS int* lcnt = (LAS int*)(F.lds + RT_SCR_OFF); LAS int* lbase = lcnt + 32; LAS int* asg = lbase + 32;
    const float* wr = F.in[16]; const float* br = F.in[17]; const float* g2 = F.in[15];
    bf16* XG = (bf16*)(F.ws + WS_XN); float* gates = (float*)(F.ws + WS_GATES); int* lists = (int*)(F.ws + WS_LISTS); float* RS = (float*)(F.ws + WS_RSTD);
    unsigned* gcnt = (unsigned*)(F.ctl + CW_CNT);
    const int tid = F.tid, lane = F.lane, r = lane & 31, hh = lane >> 5;
    const int task = F.wave >> 2, kq = F.wave & 3; const int tok = F.vcu * 64 + task * 32 + r;
    const bf16* xp = x1_row(F.ws, tok) + kq * 256 + 8 * hh; unsigned char* xo = (unsigned char*)XG + (size_t)tok * D + kq * 256 + 8 * hh;
    v4u xw[16];
#pragma unroll
    for (int ks = 0; ks < 16; ++ks) xw[ks] = *(const v4u*)(xp + 16 * ks);
    { const v4u* src = (const v4u*)(F.ws + WS_RWIMG); LAS v4u* dst = (LAS v4u*)F.lds;
      for (int i = tid; i < RT_W_BYTES / 16; i += NWAVES * 64) dst[i] = src[i]; }
    LAS float* gl = (LAS float*)(F.lds + RT_SCR_OFF + 2048);
    for (int i = tid; i < D / 4; i += NWAVES * 64) ((LAS f32x4*)gl)[i] = ((const f32x4*)g2)[i];
    if (tid < 32) lcnt[tid] = 0;
    __syncthreads();
    f16v acc;
#pragma unroll
    for (int i = 0; i < 16; ++i) acc[i] = 0.f;
    float ss = 0.f;
    const LAS float* gp = gl + kq * 256 + 8 * hh;
    const LAS bf16* whp = wh + r * RT_WSTR + kq * 256 + 8 * hh; const LAS bf16* wlp = wl + r * RT_WSTR + kq * 256 + 8 * hh;
#pragma unroll
    for (int ks = 0; ks < 16; ++ks) {
        const v4u xq = xw[ks]; const f32x4 x0 = (f32x4){bflo(xq.x), bfhi(xq.x), bflo(xq.y), bfhi(xq.y)}, x1 = (f32x4){bflo(xq.z), bfhi(xq.z), bflo(xq.w), bfhi(xq.w)}, g0 = *(const LAS f32x4*)(gp + 16 * ks), g1 = *(const LAS f32x4*)(gp + 16 * ks + 4);
        ss += (x0.x * x0.x + x0.y * x0.y) + (x0.z * x0.z + x0.w * x0.w) + (x1.x * x1.x + x1.y * x1.y) + (x1.z * x1.z + x1.w * x1.w);
        const f32x4 a0 = x0 * g0, a1 = x1 * g1;
        v4u hv, lv;
        hv.x = pg8::cvt_pk_bf16(a0.x, a0.y); hv.y = pg8::cvt_pk_bf16(a0.z, a0.w); hv.z = pg8::cvt_pk_bf16(a1.x, a1.y); hv.w = pg8::cvt_pk_bf16(a1.z, a1.w);
        lv.x = pg8::cvt_pk_bf16(a0.x - bflo(hv.x), a0.y - bfhi(hv.x)); lv.y = pg8::cvt_pk_bf16(a0.z - bflo(hv.y), a0.w - bfhi(hv.y));
        lv.z = pg8::cvt_pk_bf16(a1.x - bflo(hv.z), a1.y - bfhi(hv.z)); lv.w = pg8::cvt_pk_bf16(a1.z - bflo(hv.w), a1.w - bfhi(hv.w));
        { v2u f8; f8.x = pk4_fp8(a0.x, a0.y, a0.z, a0.w); f8.y = pk4_fp8(a1.x, a1.y, a1.z, a1.w); *(v2u*)(xo + 16 * ks) = f8; }
        const s8v xh = __builtin_bit_cast(s8v, hv), xl = __builtin_bit_cast(s8v, lv);
        v4u ah, al; { const LAS v2u* p = (const LAS v2u*)(whp + 16 * ks); const v2u q0 = p[0], q1 = p[1]; ah.x = q0.x; ah.y = q0.y; ah.z = q1.x; ah.w = q1.y; }
        { const LAS v2u* p = (const LAS v2u*)(wlp + 16 * ks); const v2u q0 = p[0], q1 = p[1]; al.x = q0.x; al.y = q0.y; al.z = q1.x; al.w = q1.y; }
        const s8v wa = __builtin_bit_cast(s8v, ah), wb = __builtin_bit_cast(s8v, al);
        acc = __builtin_amdgcn_mfma_f32_32x32x16_bf16(wa, xh, acc, 0, 0, 0);
        acc = __builtin_amdgcn_mfma_f32_32x32x16_bf16(wb, xh, acc, 0, 0, 0);
        acc = __builtin_amdgcn_mfma_f32_32x32x16_bf16(wa, xl, acc, 0, 0, 0);
    }
    __syncthreads();
    LAS float* part = (LAS float*)F.lds;
#pragma unroll
    for (int i = 0; i < 16; ++i) part[(F.wave * 17 + i) * 64 + lane] = acc[i];
    part[(F.wave * 17 + 16) * 64 + lane] = ss;
    __syncthreads();
    if (kq == 0) {
        float v[32]; float st = 0.f;
#pragma unroll
        for (int w = 0; w < 4; ++w) { const LAS float* pw = part + (size_t)((task * 4 + w) * 17) * 64;
#pragma unroll
            for (int i = 0; i < 16; ++i) { const float t = pw[i * 64 + lane]; v[i] = w == 0 ? t : v[i] + t; }
            st += pw[16 * 64 + lane] + pw[16 * 64 + (lane ^ 32)]; }
        const float rstd = 1.0f / sqrtf(st * (1.f / D) + EPS);
        if (hh == 0) RS[tok] = rstd;
#pragma unroll
        for (int i = 0; i < 16; ++i) { const int e = (i & 3) + 8 * (i >> 2) + 4 * hh; v[i] = v[i] * rstd + br[e]; }
#pragma unroll
        for (int i = 0; i < 16; ++i) v[16 + i] = __shfl_xor(v[i], 32);
        float mx = v[0];
#pragma unroll
        for (int i = 1; i < 32; ++i) mx = fmaxf(mx, v[i]);
        int rk[16]; float es = 0.f;
#pragma unroll
        for (int i = 0; i < 16; ++i) { const int ei = (i & 3) + 8 * (i >> 2) + 4 * hh; int rank = 0;
#pragma unroll
            for (int j = 0; j < 32; ++j) { if (j == i) continue; const int ej = (j & 3) + 8 * ((j & 15) >> 2) + 4 * (j < 16 ? hh : 1 - hh);
                rank += (v[j] > v[i] || (v[j] == v[i] && ej < ei)) ? 1 : 0; }
            rk[i] = rank; if (rank < TOPK) es += fexp2((v[i] - mx) * LOG2E); }
        es += __shfl_xor(es, 32);
        const float inv = 1.0f / es;
#pragma unroll
        for (int i = 0; i < 16; ++i) if (rk[i] < TOPK) { const int ei = (i & 3) + 8 * (i >> 2) + 4 * hh;
            gates[tok * TOPK + rk[i]] = fexp2((v[i] - mx) * LOG2E) * inv;
            const int pos = __hip_atomic_fetch_add(lcnt + ei, 1, __ATOMIC_RELAXED, __HIP_MEMORY_SCOPE_WORKGROUP);
            asg[(task * 32 + r) * 4 + rk[i]] = ei | (pos << 8); }
    }
    __syncthreads();
    if (tid < 32) lbase[tid] = (int)__hip_atomic_fetch_add(gcnt + tid, (unsigned)lcnt[tid], RLX_AGENT);
    __syncthreads();
    if (tid < 64 * TOPK) { const int a = asg[tid], e = a & 255, pos = a >> 8; const int tk = F.vcu * 64 + (tid >> 2);
        lists[e * M + lbase[e] + pos] = tk * TOPK + (tid & 3); }
    __syncthreads();
}

__device__ __forceinline__ void moe_tables(Frame& F) {
    LAS int* tab = (LAS int*)(F.lds + TAB_OFF); LAS int* cnt = tab, * mt = tab + 32, * tbase = tab + 64;
    unsigned* gcnt = (unsigned*)(F.ctl + CW_CNT);
    if (F.tid < 32) { const int c = (int)__hip_atomic_load(gcnt + F.tid, RLX_AGENT); cnt[F.tid] = c; mt[F.tid] = (c + 255) >> 8; }
    __syncthreads();
    if (F.tid == 0) { int s = 0; for (int e = 0; e < NE; ++e) { tbase[e] = s; s += mt[e]; } tbase[NE] = s; }
    __syncthreads();
}
__device__ __forceinline__ void moe_units(Frame& F, int npn, int gpn) {
    LAS int* tab = (LAS int*)(F.lds + TAB_OFF); LAS int* mt = tab + 32, * tbase = tab + 64; LAS int* units = (LAS int*)(F.lds + UNITS_OFF);
    if (F.tid < 32) {
        const int nU = tbase[NE] * npn; const int L = F.tid * F.G + (int)blockIdx.x; int pm = 0, pn = 0, e = 0, valid = 0;
        if (L < nU) { const int seq = pg8::xcd_remap(L, nU); int ee = 0; while (ee < NE - 1 && seq >= tbase[ee + 1] * npn) ++ee;
            const int r = seq - tbase[ee] * npn, m = mt[ee]; const int grp = r / (m * gpn), r2 = r % (m * gpn);
            e = ee; pn = grp * gpn + r2 / m; pm = tbase[ee] + r2 % m; valid = 1; }
        units[4 * F.tid + 0] = pm; units[4 * F.tid + 1] = pn; units[4 * F.tid + 2] = e; units[4 * F.tid + 3] = valid;
    }
    __syncthreads();
}

__device__ __forceinline__ void moe_gather_tables(Frame& F) {
    LAS int* tab = (LAS int*)(F.lds + TAB_OFF); LAS int* cnt = tab, * tbase = tab + 64; LAS int* units = (LAS int*)(F.lds + UNITS_OFF); LAS int* tokmap = (LAS int*)(F.lds + TOKMAP_OFF);
    const float* gates = (const float*)(F.ws + WS_GATES); const int* lists = (const int*)(F.ws + WS_LISTS); const float* RS = (const float*)(F.ws + WS_RSTD); int* rowinfo = (int*)(F.ws + WS_ROWINFO);
    for (int idx = F.tid; idx < TOKMAP_SLOTS * 256; idx += NWAVES * 64) { const int i = idx >> 8, R = idx & 255; int tk = 0;
        if (units[4 * i + 3]) { const int pm = units[4 * i], e = units[4 * i + 2]; const int li = (pm - tbase[e]) * 256 + R;
            v4u ri = (v4u){0xffffffffu, 0u, 0u, 0u};
            if (li < cnt[e]) { const int slot = lists[e * M + li]; tk = slot >> 2; ri = (v4u){(unsigned)slot, __builtin_bit_cast(unsigned, gates[slot]), __builtin_bit_cast(unsigned, RS[tk]), 0u}; }
            *(v4u*)(rowinfo + 4 * (pm * 256 + R)) = ri; }
        tokmap[idx] = tk; }
    asm volatile("s_waitcnt vmcnt(0)" ::: "memory");
    __syncthreads();
}

__device__ __forceinline__ void final_phase(Frame& F) {
    const bf16* YB = (const bf16*)(F.ws + WS_YBUF); const float* gf = F.in[24]; float* O = F.out;
    const int gw = F.vcu * NWAVES + F.wave, NGW = F.G * NWAVES, lane = F.lane;
    f32x4 gg[4];
#pragma unroll
    for (int j = 0; j < 4; ++j) gg[j] = *(const f32x4*)(gf + 4 * lane + 256 * j);
    for (int m = gw; m < M; m += NGW) {
        f32x4 v[4]; float ss = 0.f;
#pragma unroll
        for (int j = 0; j < 4; ++j) { { const v2u xw = *(const v2u*)(x1_row(F.ws, m) + 4 * lane + 256 * j); v[j] = (f32x4){bflo(xw.x), bfhi(xw.x), bflo(xw.y), bfhi(xw.y)}; }
#pragma unroll
            for (int k = 0; k < (DBG_MODE ? 0 : TOPK); ++k) { const v2u w = *(const v2u*)(YB + ((size_t)m * TOPK + k) * D + 4 * lane + 256 * j); v[j].x += bflo(w.x); v[j].y += bfhi(w.x); v[j].z += bflo(w.y); v[j].w += bfhi(w.y); }
            ss += (v[j].x * v[j].x + v[j].y * v[j].y) + (v[j].z * v[j].z + v[j].w * v[j].w); }
        const float rstd = 1.0f / sqrtf(wave_sum(ss) * (1.f / D) + EPS);
#pragma unroll
        for (int j = 0; j < 4; ++j) *(f32x4*)(O + (size_t)m * D + 4 * lane + 256 * j) = v[j] * rstd * gg[j];
    }
}

struct Args { const float* in[25]; float* out; unsigned char* ws; int ph_lo, ph_hi, li, pad; };
__global__ void __launch_bounds__(NWAVES * 64, 2) hyb_fwd(Args args) {
    extern __shared__ __attribute__((aligned(16))) unsigned char lds[];
    Frame F;
    F.lds = (LAS unsigned char*)lds;
    F.MISC = (volatile LAS unsigned*)(F.lds + MISC_OFF);
    F.tid = threadIdx.x; F.lane = F.tid & 63; F.wave = __builtin_amdgcn_readfirstlane(F.tid >> 6);
    F.G = gridDim.x; { const int bx = blockIdx.x; F.vcu = (F.G % 8 == 0) ? (bx % 8) * (F.G / 8) + bx / 8 : bx; }
    F.ws = args.ws; F.ctl = (gu32*)(args.ws + WS_CTL); F.out = args.out;
#pragma unroll
    for (int i = 0; i < 25; ++i) F.in[i] = args.in[i];
    for (int u = F.tid; u < (LDS_BYTES - LDSCTL_OFF) / 4; u += NWAVES * 64) ((LAS unsigned*)(F.lds + LDSCTL_OFF))[u] = 0u;
    __syncthreads();
    XcdBarrier bar; bar.bar = (unsigned*)(F.ctl + CW_BAR); bar.x = 0; bar.st = nullptr; bar.G = gridDim.x;
    if (N_LAUNCHES != PER_PHASE) bar = xcd_barrier_post((unsigned*)(F.ctl + CW_BAR), F.MISC + 8, gridDim.x);
#define GRID_BAR(seam) do { if (N_LAUNCHES == PER_PHASE) { if (F.tid == 0) __hip_atomic_store(F.ctl + CW_TMO, 0xBADBA0u | (unsigned)(seam), RLX_AGENT); } else { xcd_barrier(bar); } } while (0)
    const int lo = args.ph_lo, hi = args.ph_hi;
#define IN(k) (lo <= (k) && (k) < hi)
#define BOTH(k) (IN(k) && IN((k) + 1))
    const pg8::bf16_t* wsb = (const pg8::bf16_t*)args.ws;
#define WSB(off) ((const pg8::bf16_t*)(args.ws + (off)))

    unsigned long long t_lo_ = 0, t_hi_ = 0;
    TMARK(0);
    if (IN(0)) {   }

    TMARK(1);
    if (IN(1)) for (int rep_ = 0; rep_ < NREP(1); ++rep_) {
        const int bx = (int)blockIdx.x; const bool gemm_wg = bx < P1_GEMM_WG;
        pg8::Gemm g = pg8::make_gemm(WSB(WS_HN), WSB(WS_WINT), D, D, D); InProjOrder S{P1_GEMM_WG, gemm_wg ? bx : 512};
        EpiInProj E{(unsigned short*)(args.ws + WS_Q), (bf16*)(args.ws + WS_UCAT), LOG2E * 0.125f};
        if (gemm_wg) { XcdBarrier bar2 = xcd_barrier_post((unsigned*)(F.ctl + CW_BAR2), F.MISC + 10, (unsigned)P1_GEMM_WG);
            p0_prologue(F, t_lo_, t_hi_);
            xcd_barrier(bar2); }
        pg8::gemm_phase<EpiInProj, InProjOrder, PG8_ALIGN, PG8_SP2>(F.lds + RING_OFF, g, S, E);
        if (gemm_wg && F.tid == 0) __hip_atomic_fetch_add((unsigned*)(F.ctl + CW_DONE1), 1u, RLX_AGENT);
        p1_side(F, (bx >= P1_GEMM_WG && bx < P1_GEMM_WG + NG) ? bx - P1_GEMM_WG : -1);
        if (BOTH(1)) GRID_BAR(1);
    }
    TMARK(2);
    if (IN(2)) for (int rep_ = 0; rep_ < NREP(2); ++rep_) {
        const int bx = (int)blockIdx.x;
        if (bx < NG * 4) {
            XcdBarrier bar3 = xcd_barrier_post((unsigned*)(F.ctl + CW_BAR3), F.MISC + 12, (unsigned)(NG * 4));
            if (bx < NG * 2) { pg8::Gemm g = pg8::make_gemm(WSB(WS_UCAT), WSB(WS_WE), NG * UK, 512, 512); SsmOrder S{NG * 2, F.G, bx, 1, 128, 512};
                EpiSloc E{(float*)(args.ws + WS_SLOC)};
                pg8::gemm_phase<EpiSloc, SsmOrder, PG8_ALIGN, PG8_SP2>(F.lds + RING_OFF, g, S, E); }
            else attn_one(F, (bx - NG * 2) * 8 + F.wave);
            xcd_barrier(bar3);
            if (bx < NG * 2) { if (F.wave == 0) scan_phase(F, bx); else attn_one(F, 512 + bx * 7 + F.wave - 1); }
            else attn_one(F, 512 + 448 + (bx - NG * 2) * 8 + F.wave);
            xcd_barrier(bar3);
            { pg8::Gemm g = pg8::make_gemm(WSB(WS_UCAT), WSB(WS_TW), NG * UK, UK, UK); SsmOrder S{NG * 4, F.G, bx, 2, 512, UK};
              EpiS3 E{(bf16*)(args.ws + WS_YG)};
              pg8::gemm_phase<EpiS3, SsmOrder, PG8_ALIGN, PG8_SP2>(F.lds + RING_OFF, g, S, E); }
        } else {
            const int w = (bx - NG * 4) * 8 + F.wave;
#pragma unroll 1
            for (int j = 0; j < 3; ++j) { const int u = 1472 + w + 1024 * j; if (u < 4096) attn_one(F, u); }
            q1_drain(F, 2, nullptr, 0u);
        }
        if (BOTH(4)) GRID_BAR(4);
    }
    TMARK(3); TMARK(4);
    TMARK(5);
    if (IN(5)) for (int rep_ = 0; rep_ < NREP(5); ++rep_) {
        pg8::Gemm g = pg8::make_gemm(WSB(WS_YG), WSB(WS_WGLUT), SSW, SSW, SSW); pg8::StaticOrder S; S.init(M, 2 * SSW, F.G, (int)blockIdx.x, SSW, SSW);
        EpiGlu E{(bf16*)(args.ws + WS_YCAT), (float*)(args.ws + WS_SSQSSM)};
        pg8::gemm_phase<EpiGlu, pg8::StaticOrder, PG8_ALIGN, PG8_SP2>(F.lds + RING_OFF, g, S, E);
        if (BOTH(5)) GRID_BAR(5);
    }
    TMARK(6);
    if (IN(6)) {   }
    TMARK(7);
    if (IN(7)) for (int rep_ = 0; rep_ < NREP(7); ++rep_) {
        pg8::Gemm g = pg8::make_gemm(WSB(WS_YCAT), WSB(WS_WOUTT), D, D, D); pg8::StaticOrder S; S.init(M, D, F.G, (int)blockIdx.x, D, D);
        LAS float* rtab = (LAS float*)(F.lds + TOKMAP_OFF);
        { pg8::Unit u0; if (S.next(0, u0) && F.tid < 256) { const int row = u0.pm * 256 + F.tid; const float* pa = (const float*)(args.ws + WS_SSQSB) + (size_t)row * NH; const float* pb = (const float*)(args.ws + WS_SSQSSM) + (size_t)row * 16;
              float sa = 0.f, sb = 0.f;
#pragma unroll
              for (int i = 0; i < NH; ++i) sa += pa[i];
#pragma unroll
              for (int i = 0; i < 16; ++i) sb += pb[i];
              const float ra = 1.0f / sqrtf(sa * (1.f / SBW) + EPS), rb = 1.0f / sqrtf(sb * (1.f / SSW) + EPS); rtab[F.tid] = ra / rb; rtab[256 + F.tid] = rb; }
          __syncthreads(); }
        EpiOutProj E{F.in[0], args.ws, rtab, rtab + 256};
        pg8::gemm_phase<EpiOutProj, pg8::StaticOrder, PG8_ALIGN, PG8_SP2>(F.lds + RING_OFF, g, S, E);
        if (BOTH(7)) GRID_BAR(7);
    }
    TMARK(8);
    if (IN(8) && !DBG_MODE) for (int rep_ = 0; rep_ < NREP(8); ++rep_) { router_phase(F); q1_drain(F, -1, nullptr, 0u);
        if (BOTH(8)) GRID_BAR(8); }
    TMARK(9);
    if (IN(9) && !DBG_MODE) for (int rep_ = 0; rep_ < NREP(9); ++rep_) {   }
    TMARK(10);
    if (IN(10) && !DBG_MODE) for (int rep_ = 0; rep_ < NREP(10); ++rep_) {
        moe_tables(F); moe_units(F, 8, 4); moe_gather_tables(F);
        pg8::Gemm g = pg8::make_gemm(WSB(WS_XN), WSB(WS_W1T), D / 2, D, D); g.brs = 16u; g.bks = 2u * FF * 16u; g.tokmap = (const PG8_LAS int*)(F.lds + TOKMAP_OFF);
        MoeOrder S{(const LAS int*)(F.lds + UNITS_OFF), (long)2 * FF * D, 1};
        EpiMoe1 E{args.ws + WS_H, F.in[19], F.in[21], (const int*)(args.ws + WS_ROWINFO)};
        pg8::gemm_phase<EpiMoe1, MoeOrder, PG8_ALIGN, PG8_SP2, true, true>(F.lds + RING_OFF, g, S, E);
        w2_drain(F, -1);
        if (BOTH(10)) GRID_BAR(10);
    }
    TMARK(11);
    if (IN(11) && !DBG_MODE) for (int rep_ = 0; rep_ < NREP(11); ++rep_) {
        moe_tables(F); moe_units(F, 4, 4);
        pg8::Gemm g = pg8::make_gemm(WSB(WS_H), WSB(WS_W2T), FF / 2, FF, FF); g.brs = 16u; g.bks = (unsigned)D * 16u; MoeOrder S{(const LAS int*)(F.lds + UNITS_OFF), (long)D * FF, 0};
        EpiMoe2 E{(bf16*)(args.ws + WS_YBUF), F.in[23], (const int*)(args.ws + WS_ROWINFO)};
        pg8::gemm_phase<EpiMoe2, MoeOrder, PG8_ALIGN, PG8_SP2, false, true>(F.lds + RING_OFF, g, S, E);
        if (BOTH(11)) GRID_BAR(11);
    }
    TMARK(12);
    if (IN(12)) for (int rep_ = 0; rep_ < NREP(12); ++rep_) { final_phase(F); }
    TMARK(13);
    if ((TIME_LO) >= 0 && blockIdx.x == (TIME_BLK) && F.tid == 0) { const unsigned long long te = __builtin_amdgcn_s_memrealtime(), dt = 4ull * (t_hi_ - t_lo_); while (__builtin_amdgcn_s_memrealtime() - te < dt) __builtin_amdgcn_s_sleep(32); }
    (void)wsb;
#undef IN
#undef BOTH
}

extern "C" void kernel_launch(void* const* d_in, const int* in_sizes, int n_in, void* d_out, int out_size, void* d_ws, size_t ws_size, hipStream_t stream) {
    static int grid = 0;
    if (grid == 0) {
        if (n_in != 25 || in_sizes[0] != M * D || out_size != M * D || ws_size < WS_END) { fprintf(stderr, "kernel_launch: unexpected shapes: n_in %d in0 %d out %d ws %zu (need %zu); nothing launched\n", n_in, n_in > 0 ? in_sizes[0] : -1, out_size, ws_size, (size_t)WS_END); grid = -1; return; }
        int dev = 0, cus = 0, per_cu = 0;
        if (hipGetDevice(&dev) != hipSuccess || hipDeviceGetAttribute(&cus, hipDeviceAttributeMultiprocessorCount, dev) != hipSuccess) { grid = -1; return; }
        if (hipFuncSetAttribute((const void*)hyb_fwd, hipFuncAttributeMaxDynamicSharedMemorySize, LDS_BYTES) != hipSuccess) { fprintf(stderr, "kernel_launch: hipFuncSetAttribute failed\n"); grid = -1; return; }
        if (hipOccupancyMaxActiveBlocksPerMultiprocessor(&per_cu, (const void*)hyb_fwd, NWAVES * 64, LDS_BYTES) != hipSuccess || per_cu < 1)
            fprintf(stderr, "kernel_launch: note: occupancy query reports %d workgroups per CU\n", per_cu);
        (void)hipGetLastError();
        grid = cus;
        if (grid != 256) fprintf(stderr, "kernel_launch: note: %d CUs (built for 256)\n", grid);
    }
    if (grid < 0) return;
    if (hipMemsetAsync((char*)d_ws + WS_CTL, 0, CTL_ZERO_BYTES, stream) != hipSuccess) { fprintf(stderr, "kernel_launch: memset failed\n"); return; }
    Args a{};
    for (int i = 0; i < 25; ++i) a.in[i] = (const float*)d_in[i];
    a.out = (float*)d_out; a.ws = (unsigned char*)d_ws;
    for (int li = 0; li < N_LAUNCHES; ++li) {
        a.ph_lo = (N_LAUNCHES == PER_PHASE) ? li : 0; a.ph_hi = (N_LAUNCHES == PER_PHASE) ? li + 1 : PER_PHASE; a.li = li;
        hipLaunchKernelGGL(hyb_fwd, dim3(grid), dim3(NWAVES * 64), LDS_BYTES, stream, a);
        const hipError_t le = hipPeekAtLastError();
        if (le != hipSuccess) { fprintf(stderr, "kernel_launch: launch %d failed: %s\n", li, hipGetErrorName(le)); break; }
    }
}
```

```cpp
#include <hip/hip_runtime.h>
#include <cstdio>
#include <cstdint>
namespace pg8 {
#define PG8_LAS __attribute__((address_space(3)))
typedef unsigned short bf16_t;
typedef short bf16x8 __attribute__((ext_vector_type(8)));
typedef float f32x4 __attribute__((ext_vector_type(4)));
typedef unsigned u32x4 __attribute__((ext_vector_type(4)));
typedef long l64x2 __attribute__((ext_vector_type(2)));
typedef int i32x4 __attribute__((ext_vector_type(4)));
typedef int i32x8 __attribute__((ext_vector_type(8)));
constexpr int BM = 256, BK = 64, HALF = 128, HTB = HALF * BK * 2  , STAGE_BYTES = 8 * HTB, NXCD = 8, WGM = 8;

__host__ __device__ __forceinline__ int lds_byte(int r, int c) { const int st = (r >> 4) * 2 + (c >> 5), rr = r & 15, cc = c & 31, ob = rr * 64 + cc * 2; return st * 1024 + (ob ^ (((ob >> 9) & 1) << 5)); }
__host__ __device__ __forceinline__ void stage_rc(int b, int& R, int& C) { const int st = b / 1024, sb = b % 1024, swz = sb ^ (((sb >> 9) & 1) << 5); R = (st >> 1) * 16 + swz / 64; C = (st & 1) * 32 + (swz % 64) / 2; }
__host__ __device__ __forceinline__ int perm32(int rho) { const int n = rho >> 4, i = rho & 15; return 8 * (i >> 2) + 4 * n + (i & 3); }

struct Unit { int pm, pn, e, slot; long offA, offB; };
struct Gemm { const bf16_t* A; const bf16_t* Bt; int lda, K; unsigned brs, bks; const PG8_LAS int* tokmap; };
__host__ __device__ __forceinline__ Gemm make_gemm(const bf16_t* A, const bf16_t* Bt, int lda, int ldb, int K) { Gemm g; g.A = A; g.Bt = Bt; g.lda = lda; g.K = K; g.brs = (unsigned)ldb * 2u; g.bks = 16u; g.tokmap = nullptr; return g; }

__host__ __device__ __forceinline__ int xcd_remap(int wgid, int nwg) { const int q = nwg / NXCD, r = nwg % NXCD, xcd = wgid % NXCD, off = wgid / NXCD; return (xcd < r ? xcd * (q + 1) : r * (q + 1) + (xcd - r) * q) + off; }

struct StaticOrder {
    int nM, nN, nwg, G, c, lda, ldb;
    __host__ __device__ void init(int M, int N, int G_, int c_, int lda_, int ldb_) { nM = M / BM; nN = N / BM; nwg = nM * nN; G = G_; c = c_; lda = lda_; ldb = ldb_; }
    __host__ __device__ __forceinline__ bool next(int i, Unit& u) const {
        const long L = (long)i * G + c; if (L >= nwg) return false;
        const int wgid = xcd_remap((int)L, nwg);
        const int nig = WGM * nN, gid = wgid / nig, fm = gid * WGM, gsz = (nM - fm) < WGM ? (nM - fm) : WGM;
        u.pm = fm + ((wgid % nig) % gsz); u.pn = (wgid % nig) / gsz; u.e = 0; u.slot = 0;
        u.offA = (long)u.pm * BM * lda * 2; u.offB = (long)u.pn * BM * ldb * 2; return true;
    }
    __device__ __forceinline__ void a_ready(const Unit&) const {}
    __device__ __forceinline__ void done(const Unit&) const {}
};

__device__ __forceinline__ unsigned cvt_pk_bf16(float lo, float hi) { unsigned r; asm volatile("v_cvt_pk_bf16_f32 %0, %1, %2" : "=v"(r) : "v"(lo), "v"(hi)); return r; }
typedef float f32x2 __attribute__((ext_vector_type(2)));

template <class Epi, class Sched, bool ALIGN_EPI = false, bool SP2 = false, bool GATHER = false, int FP8 = 0>
__device__ __forceinline__ void gemm_phase(PG8_LAS unsigned char* lds, const Gemm g, const Sched& S, const Epi& E) {
    static_assert(!GATHER || SP2, "the gather form is written for the two-super-phase loop only");
    const int tid = threadIdx.x, wid = __builtin_amdgcn_readfirstlane(tid >> 6), lane = tid & 63, wr = wid >> 2, wc = wid & 3, fr = lane & 15, fq = lane >> 4;
    const int K = g.K, nt = K / (FP8 ? 2 * BK : BK);
    unsigned voffA[2], voffB[2]; int RA[2];
#pragma unroll
    for (int i = 0; i < 2; ++i) { int R, C; stage_rc(tid * 16 + i * 8192, R, C); const int Rb = Epi::PERM ? ((R & ~31) + perm32(R & 31)) : R; RA[i] = R;
        voffA[i] = GATHER ? (unsigned)C * 2u : (unsigned)(R * g.lda + C) * 2u; voffB[i] = (unsigned)Rb * g.brs + (unsigned)(C >> 3) * g.bks; }
    const size_t kstepA = (size_t)(BK * 2), kstepB = (size_t)8 * g.bks;
    const size_t hstepA = (size_t)HALF * g.lda * 2, hstepB = (size_t)HALF * g.brs;
    const unsigned ldsw = (unsigned)wid * 1024u;
    const int aoff = lds_byte(wr * 64 + fr, fq * 8), boff = lds_byte(wc * 32 + fr, fq * 8);
#define PG8_SA(b, h) (((b) * 2 + (h)) * HTB)
#define PG8_SB(b, h) ((4 + (b) * 2 + (h)) * HTB)
#define PG8_STAGE(bufoff, gbase, voff) do { _Pragma("unroll") for (int _i = 0; _i < 2; ++_i) \
        __builtin_amdgcn_global_load_lds((const unsigned*)((const char*)(gbase) + (voff)[_i]), (PG8_LAS unsigned*)(lds + (bufoff) + ldsw + _i * 8192), 16, 0, 0); } while (0)
    unsigned ga[2][2], gn[2][2], gw[2][2];
#define PG8_GLOAD(dst, u) do { if constexpr (GATHER) { const PG8_LAS int* _tm = g.tokmap + 256 * (u).slot; _Pragma("unroll") for (int _h = 0; _h < 2; ++_h) _Pragma("unroll") for (int _i = 0; _i < 2; ++_i) \
        dst[_h][_i] = (unsigned)_tm[128 * _h + RA[_i]] * (unsigned)(g.lda * 2) + voffA[_i]; } } while (0)
#define PG8_STAGE_A(bufoff, gbase, half, GX) do { if constexpr (GATHER) { PG8_STAGE(bufoff, gbase, GX[half]); } else { PG8_STAGE(bufoff, (gbase) + (half) * hstepA, voffA); } } while (0)
#define PG8_LDA(dst, b, h) do { _Pragma("unroll") for (int m = 0; m < 4; ++m) { if constexpr (FP8 == 2) { dst##8[m].lo = *(const PG8_LAS i32x4*)(lds + PG8_SA(b, h) + aoff + m * 2048); dst##8[m].hi = *(const PG8_LAS i32x4*)(lds + PG8_SA(b, h) + aoff + m * 2048 + 1024); } \
        else { _Pragma("unroll") for (int k = 0; k < 2; ++k) dst[m][k] = *(const PG8_LAS bf16x8*)(lds + PG8_SA(b, h) + aoff + m * 2048 + k * 1024); } } } while (0)
#define PG8_LDB(dst, b, h) do { _Pragma("unroll") for (int n = 0; n < 2; ++n) { if constexpr (FP8 == 2) { dst##8[n].lo = *(const PG8_LAS i32x4*)(lds + PG8_SB(b, h) + boff + n * 2048); dst##8[n].hi = *(const PG8_LAS i32x4*)(lds + PG8_SB(b, h) + boff + n * 2048 + 1024); } \
        else { _Pragma("unroll") for (int k = 0; k < 2; ++k) dst[n][k] = *(const PG8_LAS bf16x8*)(lds + PG8_SB(b, h) + boff + n * 2048 + k * 1024); } } } while (0)
#define PG8_MMA(ai, bj, At, Bt) do { __builtin_amdgcn_s_setprio(1); \
        if constexpr (FP8 == 2) { _Pragma("unroll") for (int m = 0; m < 4; ++m) _Pragma("unroll") for (int n = 0; n < 2; ++n) \
            acc[ai][bj][m][n] = __builtin_amdgcn_mfma_scale_f32_16x16x128_f8f6f4(Bt##8[n], At##8[m], acc[ai][bj][m][n], 0, 0, 0, 0x7f7f7f7f, 0, 0x7f7f7f7f); } \
        else if constexpr (FP8 == 1) { _Pragma("unroll") for (int k = 0; k < 2; ++k) _Pragma("unroll") for (int hf = 0; hf < 2; ++hf) _Pragma("unroll") for (int m = 0; m < 4; ++m) _Pragma("unroll") for (int n = 0; n < 2; ++n) { \
            const l64x2 _a = __builtin_bit_cast(l64x2, At[m][k]), _b = __builtin_bit_cast(l64x2, Bt[n][k]); const long _a0 = hf ? _a.y : _a.x, _b0 = hf ? _b.y : _b.x; \
            acc[ai][bj][m][n] = __builtin_amdgcn_mfma_f32_16x16x32_fp8_fp8(_b0, _a0, acc[ai][bj][m][n], 0, 0, 0); } } \
        else { _Pragma("unroll") for (int m = 0; m < 4; ++m) _Pragma("unroll") for (int n = 0; n < 2; ++n) _Pragma("unroll") for (int k = 0; k < 2; ++k) \
            acc[ai][bj][m][n] = __builtin_amdgcn_mfma_f32_16x16x32_bf16(Bt[n][k], At[m][k], acc[ai][bj][m][n], 0, 0, 0); } __builtin_amdgcn_s_setprio(0); } while (0)
#define PG8_WAIT_V(n) asm volatile("s_waitcnt vmcnt(" #n ")" ::: "memory")
#define PG8_WAIT_L(n) asm volatile("s_waitcnt lgkmcnt(" #n ")" ::: "memory")
#define PG8_BAR __builtin_amdgcn_s_barrier()
#define PG8_SCHED __builtin_amdgcn_sched_barrier(0)
    Unit cur, nxt; int ui = 0;
    if (!S.next(0, cur)) return;
    f32x4 acc[2][2][4][2];
#pragma unroll
    for (int a = 0; a < 2; ++a)
#pragma unroll
        for (int b = 0; b < 2; ++b)
#pragma unroll
            for (int m = 0; m < 4; ++m)
#pragma unroll
                for (int n = 0; n < 2; ++n) acc[a][b][m][n] = (f32x4){0.f, 0.f, 0.f, 0.f};
    bf16x8 At[4][2], B0[2][2], B1[2][2];
    i32x8 At8[4], B08[2], B18[2];
    const char* cA = (const char*)g.A + cur.offA; const char* cB = (const char*)g.Bt + cur.offB;
    S.a_ready(cur);
    if constexpr (SP2) {
        PG8_GLOAD(ga, cur);
        PG8_STAGE(PG8_SB(0, 0), cB, voffB); PG8_STAGE(PG8_SB(0, 1), cB + hstepB, voffB); PG8_STAGE_A(PG8_SA(0, 0), cA, 0, ga); PG8_STAGE_A(PG8_SA(0, 1), cA, 1, ga);
        if (wr == 1) PG8_BAR;
        PG8_WAIT_V(2); PG8_BAR;
        PG8_STAGE(PG8_SB(1, 0), cB + kstepB, voffB); PG8_STAGE_A(PG8_SA(1, 0), cA + kstepA, 0, ga); PG8_STAGE(PG8_SB(1, 1), cB + hstepB + kstepB, voffB);
        PG8_WAIT_V(6); PG8_BAR;
    } else {
        PG8_STAGE(PG8_SB(0, 0), cB, voffB); PG8_STAGE(PG8_SA(0, 0), cA, voffA); PG8_STAGE(PG8_SB(0, 1), cB + hstepB, voffB); PG8_STAGE(PG8_SA(0, 1), cA + hstepA, voffA);
        if (wr == 1) PG8_BAR;
        PG8_WAIT_V(4); PG8_BAR;
        PG8_STAGE(PG8_SB(1, 0), cB + kstepB, voffB); PG8_STAGE(PG8_SA(1, 0), cA + kstepA, voffA); PG8_STAGE(PG8_SB(1, 1), cB + hstepB + kstepB, voffB);
        PG8_WAIT_V(6); PG8_BAR;
    }
    for (;;) {
        const bool has_next = S.next(ui + 1, nxt);
        if constexpr (GATHER) { if (has_next) { PG8_GLOAD(gn, nxt); } else { _Pragma("unroll") for (int _h = 0; _h < 2; ++_h) _Pragma("unroll") for (int _i = 0; _i < 2; ++_i) gn[_h][_i] = ga[_h][_i]; } }
        const char* nA = has_next ? (const char*)g.A + nxt.offA : cA; const char* nB = has_next ? (const char*)g.Bt + nxt.offB : cB;
        for (int t = 0; t < nt; t += 2) {
            const bool last = (t == nt - 2);
            const char* a1 = cA + (size_t)(t + 1) * kstepA;
            const char* a2 = last ? nA : cA + (size_t)(t + 2) * kstepA; const char* b2 = last ? nB : cB + (size_t)(t + 2) * kstepB;
            const char* a3 = a2 + kstepA; const char* b3 = b2 + kstepB;
            if (last && has_next) S.a_ready(nxt);
            if constexpr (GATHER) { _Pragma("unroll") for (int _h = 0; _h < 2; ++_h) _Pragma("unroll") for (int _i = 0; _i < 2; ++_i) gw[_h][_i] = last ? gn[_h][_i] : ga[_h][_i]; }
            if constexpr (Epi::MIDK) { if (t == nt / 2) E.mid(acc, cur, wr, wc, fr, fq); }
            if constexpr (SP2) {
            PG8_LDB(B0, 0, 0); PG8_LDB(B1, 0, 1); PG8_SCHED; PG8_LDA(At, 0, 0); PG8_STAGE_A(PG8_SA(1, 1), a1, 1, ga);
            PG8_WAIT_V(8); PG8_WAIT_L(0); PG8_BAR; PG8_MMA(0, 0, At, B0); PG8_MMA(0, 1, At, B1); PG8_BAR; PG8_SCHED;
            PG8_LDA(At, 0, 1); PG8_STAGE(PG8_SB(0, 0), b2, voffB); PG8_STAGE(PG8_SB(0, 1), b2 + hstepB, voffB); PG8_STAGE_A(PG8_SA(0, 0), a2, 0, gw);
            PG8_WAIT_V(8); PG8_WAIT_L(0); PG8_BAR; PG8_MMA(1, 0, At, B0); PG8_MMA(1, 1, At, B1); PG8_BAR; PG8_SCHED;
            PG8_LDB(B0, 1, 0); PG8_LDB(B1, 1, 1); PG8_SCHED; PG8_LDA(At, 1, 0); PG8_STAGE_A(PG8_SA(0, 1), a2, 1, gw);
            PG8_WAIT_V(8); PG8_WAIT_L(0); PG8_BAR; PG8_MMA(0, 0, At, B0); PG8_MMA(0, 1, At, B1); PG8_BAR; PG8_SCHED;
            PG8_LDA(At, 1, 1); PG8_STAGE(PG8_SB(1, 0), b3, voffB); PG8_STAGE(PG8_SB(1, 1), b3 + hstepB, voffB); PG8_STAGE_A(PG8_SA(1, 0), a3, 0, gw);
            PG8_WAIT_V(8); PG8_WAIT_L(0); PG8_BAR; PG8_MMA(1, 0, At, B0); PG8_MMA(1, 1, At, B1); PG8_BAR; PG8_SCHED;
            } else {
            PG8_LDB(B0, 0, 0); PG8_SCHED; PG8_LDA(At, 0, 0); PG8_STAGE(PG8_SA(1, 1), a1 + hstepA, voffA);
            PG8_WAIT_L(8); PG8_BAR; PG8_WAIT_L(0); PG8_MMA(0, 0, At, B0); PG8_BAR; PG8_SCHED;
            PG8_LDB(B1, 0, 1); PG8_STAGE(PG8_SB(0, 0), b2, voffB);
            PG8_BAR; PG8_WAIT_L(0); PG8_MMA(0, 1, At, B1); PG8_BAR;
            PG8_LDA(At, 0, 1); PG8_STAGE(PG8_SA(0, 0), a2, voffA);
            PG8_BAR; PG8_WAIT_L(0); PG8_MMA(1, 0, At, B0); PG8_BAR; PG8_SCHED;
            PG8_STAGE(PG8_SB(0, 1), b2 + hstepB, voffB);
            PG8_WAIT_V(6); PG8_BAR; PG8_MMA(1, 1, At, B1); PG8_BAR;
            PG8_LDB(B0, 1, 0); PG8_SCHED; PG8_LDA(At, 1, 0); PG8_STAGE(PG8_SA(0, 1), a2 + hstepA, voffA);
            PG8_WAIT_L(8); PG8_BAR; PG8_WAIT_L(0); PG8_MMA(0, 0, At, B0); PG8_BAR; PG8_SCHED;
            PG8_LDB(B1, 1, 1); PG8_STAGE(PG8_SB(1, 0), b3, voffB);
            PG8_BAR; PG8_WAIT_L(0); PG8_MMA(0, 1, At, B1); PG8_BAR;
            PG8_LDA(At, 1, 1); PG8_STAGE(PG8_SA(1, 0), a3, voffA);
            PG8_BAR; PG8_WAIT_L(0); PG8_MMA(1, 0, At, B0); PG8_BAR; PG8_SCHED;
            PG8_STAGE(PG8_SB(1, 1), b3 + hstepB, voffB);
            PG8_WAIT_V(6); PG8_BAR; PG8_MMA(1, 1, At, B1); PG8_BAR;
            }
        }
        if constexpr (ALIGN_EPI) { if (wr == 0) PG8_BAR; }
        if constexpr (!Epi::AFTER_DRAIN) { E(acc, cur, wr, wc, fr, fq); S.done(cur); }
        if (!has_next) break;
#pragma unroll
        for (int a = 0; a < 2; ++a)
#pragma unroll
            for (int b = 0; b < 2; ++b)
#pragma unroll
                for (int m = 0; m < 4; ++m)
#pragma unroll
                    for (int n = 0; n < 2; ++n) acc[a][b][m][n] = (f32x4){0.f, 0.f, 0.f, 0.f};
        cur = nxt; cA = nA; cB = nB; ++ui;
        if constexpr (GATHER) { _Pragma("unroll") for (int _h = 0; _h < 2; ++_h) _Pragma("unroll") for (int _i = 0; _i < 2; ++_i) ga[_h][_i] = gn[_h][_i]; }
        if constexpr (ALIGN_EPI) { if (wr == 1) PG8_BAR; }
    }
    PG8_WAIT_V(0);
    if constexpr (!ALIGN_EPI) { if (wr == 0) PG8_BAR; }
    PG8_BAR;
    if constexpr (Epi::AFTER_DRAIN) { E.fused(acc, cur, wr, wc, fr, fq, lds, wid, lane); S.done(cur); }
#undef PG8_SA
#undef PG8_SB
#undef PG8_STAGE
#undef PG8_STAGE_A
#undef PG8_GLOAD
#undef PG8_LDA
#undef PG8_LDB
#undef PG8_MMA
#undef PG8_WAIT_V
#undef PG8_WAIT_L
#undef PG8_BAR
#undef PG8_SCHED
}
}

#ifndef PG8_SP2
#define PG8_SP2 true
#endif
#ifndef PG8_ALIGN
#define PG8_ALIGN true
#endif

constexpr int NWAVES = 8;
#ifndef MK_N_LAUNCHES
#define MK_N_LAUNCHES 1
#endif
#ifndef DBG_MODE
#define DBG_MODE 0
#endif
#ifndef REP_PHASE
#define REP_PHASE -1
#endif
#define NREP(k) ((REP_PHASE) == (k) ? 2 : 1)
#ifndef TIME_LO
#define TIME_LO -1
#endif
#ifndef TIME_HI
#define TIME_HI -1
#endif
#ifndef TIME_BLK
#define TIME_BLK 0
#endif
#define TMARK(j) do { if ((TIME_LO) >= 0 && blockIdx.x == (TIME_BLK) && F.tid == 0) { if ((j) == (TIME_LO)) t_lo_ = __builtin_amdgcn_s_memrealtime(); if ((j) == (TIME_HI)) t_hi_ = __builtin_amdgcn_s_memrealtime(); } } while (0)
constexpr int PER_PHASE = 13;
constexpr int N_LAUNCHES = MK_N_LAUNCHES;

constexpr int BATCH = 2, SEQ = 8192, D = 1024, M = BATCH * SEQ;
constexpr int SBW = 512, NH = 8, HD = 64;
constexpr int SSW = 512, NG = 32, GC = 16, NP = 64;
constexpr int NPROJ = 3 * SBW + SSW;
constexpr int LC = 32, NCHUNK = M / LC, CPB = SEQ / LC;
constexpr int UK = LC * GC + 2 * NP;
constexpr int NE = 32, TOPK = 4, FF = 1024, NASSIGN = M * TOPK;
constexpr int MAXTILES = (NASSIGN + NE * 255) / 256 + 1;
constexpr float EPS = 1e-5f;
constexpr float LOG2E = 1.4426950408889634f;

constexpr size_t MiB = 1u << 20;
constexpr size_t WS_CTL = 0, CTL_ZERO_BYTES = 1 * MiB;
constexpr size_t WS_LAML = 1 * MiB;
constexpr size_t WS_RSTD = 1 * MiB + 32 * 1024;
constexpr size_t WS_GATES = 1 * MiB + 128 * 1024;
constexpr size_t WS_ROWINFO = 1 * MiB + 512 * 1024;
constexpr size_t WS_RWIMG = 3 * MiB;
constexpr size_t WS_LISTS = 507 * MiB;
constexpr size_t WS_X1LO = 331 * MiB, WS_X1HI = 491 * MiB;
constexpr size_t WS_WINT = 4 * MiB, WS_WGLUT = 8 * MiB, WS_WOUTT = 9 * MiB, WS_W1T = 11 * MiB, WS_W2T = 139 * MiB;
constexpr size_t WS_R1 = 203 * MiB, WS_R2 = 347 * MiB, WS_END = 509 * MiB;
constexpr size_t WS_HN = WS_R1, WS_Q = WS_R1 + 32 * MiB, WS_K = WS_R1 + 48 * MiB, WS_V = WS_R1 + 64 * MiB, WS_UCAT = WS_R1 + 80 * MiB,
                 WS_SLOC = WS_R1 + 100 * MiB, WS_SSQSB = WS_R1 + 108 * MiB  , WS_SSQSSM = WS_R1 + 109 * MiB  , WS_YG = WS_R1 + 124 * MiB;
constexpr size_t WS_YBUF = WS_R1;
constexpr size_t WS_YCAT = WS_R2 + 16 * MiB  , WS_XN = WS_R1  , WS_WE = WS_R2 + 80 * MiB, WS_TW = WS_R2 + 85 * MiB;
constexpr size_t WS_H = WS_R2;
static_assert(WS_K == WS_Q + (size_t)M * SBW * 2 && WS_V == WS_K + (size_t)M * SBW * 2 && WS_YG + (size_t)M * SSW * 2 <= WS_R2 && WS_TW + (size_t)NG * 512 * UK * 2 <= WS_END, "ws map");
static_assert(WS_YBUF + (size_t)NASSIGN * D * 2 <= WS_X1LO && WS_H + (size_t)(MAXTILES - 1) * 256 * FF * 2 <= WS_END, "ws map 2");
static_assert(WS_ROWINFO + (size_t)MAXTILES * 256 * 16 <= 3 * MiB && WS_X1LO >= WS_YBUF + (size_t)NASSIGN * D * 2 && WS_X1LO + 16 * MiB <= WS_R2 && WS_X1HI >= WS_H + (size_t)(MAXTILES - 1) * 256 * FF * 2 && WS_X1HI + 16 * MiB <= WS_LISTS && WS_LISTS + (size_t)NE * M * 4 <= WS_END, "ws map 3");
constexpr int CW_TMO = 0, CW_CODE = 1;
constexpr int CW_BAR = 4096, CW_BAR2 = 8192, CW_BAR3 = 12288;
constexpr int CW_CNT = 16384;
constexpr int CW_Q0 = 16384 + 256, CW_Q1 = 16384 + 512, CW_Q2 = 16384 + 576;
constexpr int CW_DONE1 = 16384 + 640;
constexpr int CW_AQ = 16384 + 320, CW_DONE2 = 16384 + 384, CW_DONE3 = 16384 + 448;

constexpr int RING_OFF = 0, RING_BYTES = 131072;
constexpr int RT_WSTR = 1028;
constexpr int RT_W_BYTES = 2 * NE * RT_WSTR * 2;
constexpr int RT_SCR_OFF = RT_W_BYTES;
constexpr int LDSCTL_OFF = 139264, MISC_OFF = LDSCTL_OFF + 320;
constexpr int TAB_OFF = LDSCTL_OFF + 512;
constexpr int UNITS_OFF = LDSCTL_OFF + 1024;
constexpr int TILEE_OFF = LDSCTL_OFF + 1536;
constexpr int TOKMAP_OFF = LDSCTL_OFF + 4096, TOKMAP_SLOTS = 10;
constexpr int LDS_BYTES = TOKMAP_OFF + TOKMAP_SLOTS * 1024;
static_assert(TILEE_OFF + MAXTILES * 4 <= LDS_BYTES && RT_SCR_OFF + 4096 <= LDSCTL_OFF, "LDS map");

#define GAS __attribute__((address_space(1)))
#define LAS __attribute__((address_space(3)))
typedef unsigned short bf16;
typedef unsigned v4u __attribute__((ext_vector_type(4)));
typedef unsigned v2u __attribute__((ext_vector_type(2)));
typedef float f32x4 __attribute__((ext_vector_type(4)));
typedef float f32x2 __attribute__((ext_vector_type(2)));
typedef _Float16 h16x2 __attribute__((ext_vector_type(2)));
typedef GAS unsigned gu32;
#define RLX_AGENT __ATOMIC_RELAXED, __HIP_MEMORY_SCOPE_AGENT
#define LDS_WAIT() asm volatile("s_waitcnt lgkmcnt(0)" ::: "memory")
#define VM_WAIT() asm volatile("s_waitcnt vmcnt(0)" ::: "memory")
__device__ __forceinline__ unsigned f2bf(float f) { unsigned u = __builtin_bit_cast(unsigned, f); return (u + 0x7fffu + ((u >> 16) & 1u)) >> 16; }
__device__ __forceinline__ unsigned pk2(float lo, float hi) { return f2bf(lo) | (f2bf(hi) << 16); }
__device__ __forceinline__ float bf2f(unsigned short b) { return __builtin_bit_cast(float, (unsigned)b << 16); }
__device__ __forceinline__ float bflo(unsigned w) { return __builtin_bit_cast(float, w << 16); }
__device__ __forceinline__ float bfhi(unsigned w) { return __builtin_bit_cast(float, w & 0xffff0000u); }
__device__ __forceinline__ unsigned pkh2(float lo, float hi) { h16x2 v; v.x = (_Float16)lo; v.y = (_Float16)hi; return __builtin_bit_cast(unsigned, v); }
__device__ __forceinline__ float fexp2(float x) { return __builtin_amdgcn_exp2f(x); }
__device__ __forceinline__ float flog2(float x) { return __builtin_amdgcn_logf(x); }
__device__ __forceinline__ float frcp(float x) { return __builtin_amdgcn_rcpf(x); }
__device__ __forceinline__ float sigmoidf_(float x) { return frcp(1.0f + fexp2(-LOG2E * x)); }
__device__ __forceinline__ float gelu_tanh(float v) { const float u = 0.7978845608028654f * (v + 0.044715f * v * v * v); return v * frcp(1.0f + fexp2(-2.0f * LOG2E * u)); }

__device__ __forceinline__ bf16* x1_row(unsigned char* ws, int m) { return (bf16*)(ws + (m < SEQ ? WS_X1LO : WS_X1HI - (size_t)SEQ * D * 2)) + (size_t)m * D; }
#ifndef MOE1_MODE
#define MOE1_MODE 1
#endif
#ifndef MOE2_MODE
#define MOE2_MODE 1
#endif
constexpr float WSCALE = 64.0f;
__device__ __forceinline__ float clamp448(float x) { return fminf(fmaxf(x, -448.0f), 448.0f); }
__device__ __forceinline__ unsigned pk4_fp8(float a, float b, float c, float d) {
    int w = __builtin_amdgcn_cvt_pk_fp8_f32(clamp448(a), clamp448(b), 0, false); w = __builtin_amdgcn_cvt_pk_fp8_f32(clamp448(c), clamp448(d), w, true); return (unsigned)w; }
#define XB_TMO      128
#define XB_XCNT(j)  (256  + 64 * (j))
#define XB_XSUB(j)  (1280 + 64 * (j))
#define XB_XGEN(j)  (2304 + 64 * (j))
#define XB_TOP      3328
#define XB_TOPGEN   3392
#define XCD_BAR_WORDS 3456
#define XB_SPIN_CAP (1u << 18)
__device__ __forceinline__ unsigned xb_ld(unsigned* p)              { return __hip_atomic_load(p, __ATOMIC_RELAXED, __HIP_MEMORY_SCOPE_AGENT); }
__device__ __forceinline__ unsigned xb_add(unsigned* p, unsigned v) { return __hip_atomic_fetch_add(p, v, __ATOMIC_RELAXED, __HIP_MEMORY_SCOPE_AGENT); }
__device__ __forceinline__ unsigned xb_xcc_id() { return (unsigned)__builtin_amdgcn_s_getreg((3 << 11) | 20) & 0xFu; }
#define XB_SPIN(cond, bar) do { unsigned _sp = 0; while (cond) { __builtin_amdgcn_s_sleep(1); \
    if ((++_sp & 255u) == 0u) { if (xb_ld(&(bar)[XB_TMO])) break; if (_sp > XB_SPIN_CAP) { atomicAdd(&(bar)[XB_TMO], 1u); break; } } } } while (0)
struct XcdBarrier { unsigned* bar; unsigned x; volatile LAS unsigned* st; unsigned G; };
__device__ __forceinline__ XcdBarrier xcd_barrier_post(unsigned* bar, volatile LAS unsigned* st, unsigned G) {
    XcdBarrier b; b.bar = bar; b.x = xb_xcc_id(); b.st = st; b.G = G;
    if (threadIdx.x == 0) (void)xb_add(&bar[XB_XCNT(b.x)], 1u);
    return b;
}
__device__ __forceinline__ void xcd_barrier_complete(unsigned* bar, unsigned x, unsigned G, unsigned& nloc, unsigned& nx) {
    unsigned sum, cnt, mine, sp = 0u;
    for (;;) {
        sum = 0u; cnt = 0u; mine = 0u;
#pragma unroll
        for (unsigned j = 0; j < 16; ++j) { const unsigned c = xb_ld(&bar[XB_XCNT(j)]); sum += c; cnt += (c > 0u) ? 1u : 0u; mine = (j == x) ? c : mine; }
        if (sum == G) break;
        __builtin_amdgcn_s_sleep(1);
        if ((++sp & 255u) == 0u) { if (xb_ld(&bar[XB_TMO])) break; if (sp > XB_SPIN_CAP) { atomicAdd(&bar[XB_TMO], 1u); break; } }
    }
    nloc = mine > 0u ? mine : 1u; nx = cnt > 0u ? cnt : 1u;
}
__device__ __forceinline__ void xcd_barrier(const XcdBarrier& b) {
    asm volatile("s_waitcnt vmcnt(0)" ::: "memory");
    __syncthreads();
    if (threadIdx.x == 0) {
        unsigned* bar = b.bar;
        __builtin_amdgcn_s_waitcnt(0);
        unsigned nloc = b.st[0], nx = b.st[1];
        if (nloc == 0u) { xcd_barrier_complete(bar, b.x, b.G, nloc, nx); b.st[0] = nloc; b.st[1] = nx; }
        const unsigned old = xb_add(&bar[XB_XSUB(b.x)], 1u);
        const unsigned gen = old / nloc;
        if (old + 1u == (gen + 1u) * nloc) {
            __builtin_amdgcn_fence(__ATOMIC_RELEASE, "agent");
            asm volatile("s_waitcnt vmcnt(0)" ::: "memory");
            const unsigned og = xb_add(&bar[XB_TOP], 1u);
            const unsigned tg = og / nx;
            if (og + 1u == (tg + 1u) * nx) xb_add(&bar[XB_TOPGEN], 1u);
            else XB_SPIN(xb_ld(&bar[XB_TOPGEN]) == tg, bar);
            __builtin_amdgcn_fence(__ATOMIC_ACQUIRE, "agent");
            xb_add(&bar[XB_XGEN(b.x)], 1u);
            asm volatile("s_waitcnt vmcnt(0)" ::: "memory");
        } else {
            XB_SPIN(xb_ld(&bar[XB_XGEN(b.x)]) == gen, bar);
            __builtin_amdgcn_fence(__ATOMIC_ACQUIRE, "agent");
            asm volatile("s_waitcnt vmcnt(0)" ::: "memory");
        }
    }
    __syncthreads();
}

struct Frame {
    LAS unsigned char* lds;
    volatile LAS unsigned* MISC;
    gu32* ctl;
    int tid, lane, wave;
    int vcu, G;
    unsigned char* ws;
    const float* in[25];
    float* out;
};

__device__ __forceinline__ float wave_sum(float v) {
#pragma unroll
    for (int o = 1; o < 64; o <<= 1) v += __shfl_xor(v, o);
    return v;
}

using pg8::Unit;
typedef pg8::f32x4 accv;
struct EpiInProj {
    static constexpr bool PERM = true, AFTER_DRAIN = false; static constexpr bool MIDK = false;
    unsigned short* QKV; bf16* U; float qscale;
    __device__ __forceinline__ void operator()(const accv (&acc)[2][2][4][2], const Unit& u, int wr, int wc, int fr, int fq) const {
        if (u.e == 1) {
            const int row0 = u.pm * 256 + wr * 64 + fr; const int colt = u.pn * 256 + wc * 32 + 8 * fq;
            _Float16* VT = (_Float16*)(QKV + (size_t)2 * M * SBW);
#pragma unroll
            for (int ai = 0; ai < 2; ++ai)
#pragma unroll
                for (int m = 0; m < 4; ++m) { const int row = row0 + ai * 128 + m * 16;
#pragma unroll
                    for (int bj = 0; bj < 2; ++bj) { const int tok = colt + bj * 128; const accv v0 = acc[ai][bj][m][0], v1 = acc[ai][bj][m][1];
                        const int bb = tok >> 13, sq = tok & (SEQ - 1); const int o = sq & 15;
                        _Float16* p = VT + ((size_t)bb * SBW + row) * SEQ + (sq & ~15) + (o >> 1);
                        v2u w0, w1; w0.x = pkh2(v0[0], v0[1]); w0.y = pkh2(v0[2], v0[3]); w1.x = pkh2(v1[0], v1[1]); w1.y = pkh2(v1[2], v1[3]);
                        *(v2u*)p = w0; *(v2u*)(p + 8) = w1; } }
            return;
        }
        const int kind = u.pn >> 1; const int colt = (u.pn & 1) * 256 + wc * 32 + 8 * fq; const int row0 = u.pm * 256 + wr * 64 + fr;
        unsigned short* T = QKV + (size_t)(kind < 2 ? kind : 0) * ((size_t)M * SBW); const float sc = kind == 0 ? qscale : 1.0f;
#pragma unroll
        for (int ai = 0; ai < 2; ++ai)
#pragma unroll
            for (int m = 0; m < 4; ++m) { const int row = row0 + ai * 128 + m * 16;
#pragma unroll
                for (int bj = 0; bj < 2; ++bj) { const int col = colt + bj * 128; const accv v0 = acc[ai][bj][m][0] * sc, v1 = acc[ai][bj][m][1] * sc; v4u w;
                    if (kind < 2) { w.x = pkh2(v0[0], v0[1]); w.y = pkh2(v0[2], v0[3]); w.z = pkh2(v1[0], v1[1]); w.w = pkh2(v1[2], v1[3]);
                        *(v4u*)(T + (size_t)row * SBW + col) = w; }
                    else { w.x = pg8::cvt_pk_bf16(v0[0], v0[1]); w.y = pg8::cvt_pk_bf16(v0[2], v0[3]); w.z = pg8::cvt_pk_bf16(v1[0], v1[1]); w.w = pg8::cvt_pk_bf16(v1[2], v1[3]);
                        *(v4u*)(U + ((size_t)(row >> 5) * NG + (col >> 4)) * UK + (row & 31) * GC + (col & 15)) = w; } } }
    }
};
struct EpiSloc {
    static constexpr bool PERM = false, AFTER_DRAIN = false; static constexpr bool MIDK = false;
    float* S;
    __device__ __forceinline__ void operator()(const accv (&acc)[2][2][4][2], const Unit& u, int wr, int wc, int fr, int fq) const {
        const int row0 = u.pm * 256 + wr * 64 + fr; const int col0 = wc * 32 + 4 * fq;
#pragma unroll
        for (int ai = 0; ai < 2; ++ai)
#pragma unroll
            for (int m = 0; m < 4; ++m) { const int row = row0 + ai * 128 + m * 16;
#pragma unroll
                for (int n = 0; n < 2; ++n) *(accv*)(S + ((size_t)row * NG + u.e) * 128 + col0 + 16 * n) = acc[ai][0][m][n]; }
    }
};
struct EpiS3 {
    static constexpr bool PERM = true, AFTER_DRAIN = false; static constexpr bool MIDK = false;
    bf16* YG;
    __device__ __forceinline__ void operator()(const accv (&acc)[2][2][4][2], const Unit& u, int wr, int wc, int fr, int fq) const {
        const int row0 = u.pm * 256 + wr * 64 + fr; const int colt = u.pn * 256 + wc * 32 + 8 * fq;
#pragma unroll
        for (int ai = 0; ai < 2; ++ai)
#pragma unroll
            for (int m = 0; m < 4; ++m) { const int row = row0 + ai * 128 + m * 16;
#pragma unroll
                for (int bj = 0; bj < 2; ++bj) { const int col = colt + bj * 128; const accv v0 = acc[ai][bj][m][0], v1 = acc[ai][bj][m][1]; v4u w;
                    w.x = pg8::cvt_pk_bf16(gelu_tanh(v0[0]), gelu_tanh(v0[1])); w.y = pg8::cvt_pk_bf16(gelu_tanh(v0[2]), gelu_tanh(v0[3]));
                    w.z = pg8::cvt_pk_bf16(gelu_tanh(v1[0]), gelu_tanh(v1[1])); w.w = pg8::cvt_pk_bf16(gelu_tanh(v1[2]), gelu_tanh(v1[3]));
                    *(v4u*)(YG + ((size_t)row * LC + (col >> 4)) * SSW + u.e * GC + (col & 15)) = w; } }
    }
};
struct EpiGlu {
    static constexpr bool PERM = true, AFTER_DRAIN = false; static constexpr bool MIDK = false;
    bf16* Y; float* SSQ;
    __device__ __forceinline__ void operator()(const accv (&acc)[2][2][4][2], const Unit& u, int wr, int wc, int fr, int fq) const {
        const int row0 = u.pm * 256 + wr * 64 + fr; const int col = u.pn * 128 + wc * 32 + 8 * fq;
#pragma unroll
        for (int ai = 0; ai < 2; ++ai)
#pragma unroll
            for (int m = 0; m < 4; ++m) { const int row = row0 + ai * 128 + m * 16; float r[8]; float sq = 0.f;
#pragma unroll
                for (int n = 0; n < 2; ++n)
#pragma unroll
                    for (int j = 0; j < 4; ++j) { r[4 * n + j] = acc[ai][0][m][n][j] * sigmoidf_(acc[ai][1][m][n][j]); sq += r[4 * n + j] * r[4 * n + j]; }
                sq += __shfl_xor(sq, 16); sq += __shfl_xor(sq, 32);
                if (fq == 0) SSQ[(size_t)row * 16 + u.pn * 4 + wc] = sq;
                v4u w; w.x = pg8::cvt_pk_bf16(r[0], r[1]); w.y = pg8::cvt_pk_bf16(r[2], r[3]); w.z = pg8::cvt_pk_bf16(r[4], r[5]); w.w = pg8::cvt_pk_bf16(r[6], r[7]);
                *(v4u*)(Y + (size_t)row * D + SBW + col) = w; }
    }
};
struct EpiOutProj {
    static constexpr bool PERM = true, AFTER_DRAIN = false; static constexpr bool MIDK = true;
    const float* X; unsigned char* ws; const LAS float* ratio; const LAS float* fin;
    __device__ __forceinline__ void mid(accv (&acc)[2][2][4][2], const Unit& u, int wr, int wc, int fr, int fq) const {
#pragma unroll
        for (int ai = 0; ai < 2; ++ai)
#pragma unroll
            for (int m = 0; m < 4; ++m) { const float rt = ratio[ai * 128 + wr * 64 + m * 16 + fr];
#pragma unroll
                for (int bj = 0; bj < 2; ++bj)
#pragma unroll
                    for (int n = 0; n < 2; ++n) acc[ai][bj][m][n] *= rt; }
    }
    __device__ __forceinline__ void operator()(const accv (&acc)[2][2][4][2], const Unit& u, int wr, int wc, int fr, int fq) const {
        const int row0 = u.pm * 256 + wr * 64 + fr; const int col0 = u.pn * 256 + wc * 32 + 8 * fq;
#pragma unroll
        for (int ai = 0; ai < 2; ++ai)
#pragma unroll
            for (int m = 0; m < 4; ++m) { const int row = row0 + ai * 128 + m * 16; const float* xr = X + (size_t)row * D + col0; bf16* orow = x1_row(ws, row) + col0; const float fs = fin[ai * 128 + wr * 64 + m * 16 + fr];
#pragma unroll
                for (int bj = 0; bj < 2; ++bj) { const accv x0 = *(const accv*)(xr + bj * 128), x1 = *(const accv*)(xr + bj * 128 + 4); const accv v0 = x0 + acc[ai][bj][m][0] * fs, v1 = x1 + acc[ai][bj][m][1] * fs;
                    v4u w; w.x = pg8::cvt_pk_bf16(v0[0], v0[1]); w.y = pg8::cvt_pk_bf16(v0[2], v0[3]); w.z = pg8::cvt_pk_bf16(v1[0], v1[1]); w.w = pg8::cvt_pk_bf16(v1[2], v1[3]);
                    *(v4u*)(orow + bj * 128) = w; }
                if (m & 1) asm volatile("" ::: "memory"); }
    }
};
struct EpiMoe1 {
    static constexpr bool PERM = true, AFTER_DRAIN = false; static constexpr bool MIDK = false;
    unsigned char* H; const float* bg; const float* bu; const int* rowinfo;
    __device__ __forceinline__ void operator()(const accv (&acc)[2][2][4][2], const Unit& u, int wr, int wc, int fr, int fq) const {
        const int row0 = u.pm * 256 + wr * 64 + fr; const int col = u.pn * 128 + wc * 32 + 8 * fq;
        float bgv[8], buv[8];
#pragma unroll
        for (int n = 0; n < 2; ++n) { const accv a = *(const accv*)(bg + u.e * FF + col + 4 * n), b = *(const accv*)(bu + u.e * FF + col + 4 * n);
#pragma unroll
            for (int j = 0; j < 4; ++j) { bgv[4 * n + j] = a[j]; buv[4 * n + j] = b[j]; } }
        float rsv[2][4];
#pragma unroll
        for (int ai = 0; ai < 2; ++ai)
#pragma unroll
            for (int m = 0; m < 4; ++m) rsv[ai][m] = __builtin_bit_cast(float, rowinfo[4 * (row0 + ai * 128 + m * 16) + 2]);
#pragma unroll
        for (int ai = 0; ai < 2; ++ai)
#pragma unroll
            for (int m = 0; m < 4; ++m) { const int row = row0 + ai * 128 + m * 16; float r[8]; const float rs = rsv[ai][m] * (1.0f / WSCALE);
#pragma unroll
                for (int n = 0; n < 2; ++n)
#pragma unroll
                    for (int j = 0; j < 4; ++j) { const float g = fminf(acc[ai][0][m][n][j] * rs + bgv[4 * n + j], 7.0f); const float up = fminf(fmaxf(acc[ai][1][m][n][j] * rs + buv[4 * n + j], -7.0f), 7.0f);
                        r[4 * n + j] = (up + 1.0f) * g * frcp(1.0f + fexp2(-1.702f * LOG2E * g)); }
                v2u w; w.x = pk4_fp8(r[0], r[1], r[2], r[3]); w.y = pk4_fp8(r[4], r[5], r[6], r[7]);
                *(v2u*)(H + (size_t)row * FF + col) = w; }
    }
};
struct EpiMoe2 {
    static constexpr bool PERM = true, AFTER_DRAIN = false; static constexpr bool MIDK = false;
    bf16* Y; const float* bd; const int* rowinfo;
    __device__ __forceinline__ void operator()(const accv (&acc)[2][2][4][2], const Unit& u, int wr, int wc, int fr, int fq) const {
        const int row0 = u.pm * 256 + wr * 64 + fr; const int colt = u.pn * 256 + wc * 32 + 8 * fq;
        float bv[2][8];
#pragma unroll
        for (int bj = 0; bj < 2; ++bj)
#pragma unroll
            for (int n = 0; n < 2; ++n) { const accv a = *(const accv*)(bd + u.e * D + colt + bj * 128 + 4 * n);
#pragma unroll
                for (int j = 0; j < 4; ++j) bv[bj][4 * n + j] = a[j]; }
        v2u sg[2][4];
#pragma unroll
        for (int ai = 0; ai < 2; ++ai)
#pragma unroll
            for (int m = 0; m < 4; ++m) sg[ai][m] = *(const v2u*)(rowinfo + 4 * (row0 + ai * 128 + m * 16));
#pragma unroll
        for (int ai = 0; ai < 2; ++ai)
#pragma unroll
            for (int m = 0; m < 4; ++m) { const int slot = (int)sg[ai][m].x; const unsigned gbits = sg[ai][m].y; const float gate = __builtin_bit_cast(float, gbits);
                if (slot >= 0) {
#pragma unroll
                    for (int bj = 0; bj < 2; ++bj) { float r[8];
#pragma unroll
                        for (int n = 0; n < 2; ++n)
#pragma unroll
                            for (int j = 0; j < 4; ++j) r[4 * n + j] = (acc[ai][bj][m][n][j] * (1.0f / WSCALE) + bv[bj][4 * n + j]) * gate;
                        v4u w; w.x = pg8::cvt_pk_bf16(r[0], r[1]); w.y = pg8::cvt_pk_bf16(r[2], r[3]); w.z = pg8::cvt_pk_bf16(r[4], r[5]); w.w = pg8::cvt_pk_bf16(r[6], r[7]);
                        *(v4u*)(Y + (size_t)slot * D + colt + bj * 128) = w; } } }
    }
};

struct InProjOrder {
    int G, c;
    __device__ bool next(int i, Unit& u) const {
        const int L = i * G + c; if (L >= 512) return false;
        const int s = pg8::xcd_remap(L, 512);
        if (s < 384) { const int grp = s / 48, r = s % 48; u.slot = 0; u.pm = grp * 8 + (r & 7); const int pi = r >> 3; u.pn = pi < 4 ? pi : pi + 2; u.e = 0;
            u.offA = (long)u.pm * 256 * D * 2; u.offB = (long)u.pn * 256 * D * 2; }
        else { const int r = s - 384; u.slot = 0; u.pm = r & 1; u.pn = r >> 1; u.e = 1;
            u.offA = (long)(WS_WINT - WS_HN) + (long)(1024 + u.pm * 256) * D * 2; u.offB = (long)(WS_HN - WS_WINT) + (long)u.pn * 256 * D * 2; }
        return true;
    }
    __device__ __forceinline__ void a_ready(const Unit&) const {}
    __device__ __forceinline__ void done(const Unit&) const {}
};
struct SsmOrder {
    int nwg, G, c, npn, rows_per_g, ldb;
    __device__ bool next(int i, Unit& u) const {
        const int L = i * G + c; if (L >= nwg) return false;
        const int per_g = 2 * npn; const int g = L / per_g, r = L % per_g;
        u.e = g; u.pm = r / npn; u.pn = r % npn; u.slot = 0;
        u.offA = ((long)u.pm * 256 * NG * UK + (long)g * UK) * 2; u.offB = ((long)g * rows_per_g + (long)u.pn * 256) * ldb * 2; return true;
    }
    __device__ __forceinline__ void a_ready(const Unit&) const {}
    __device__ __forceinline__ void done(const Unit&) const {}
};
struct MoeOrder {
    const LAS int* units; long ebytes; int gather;
    __device__ bool next(int i, Unit& u) const {
        if (i >= 32) return false;
        const int v = __builtin_amdgcn_readfirstlane(units[4 * i + 3]); if (!v) return false;
        u.pm = __builtin_amdgcn_readfirstlane(units[4 * i + 0]); u.pn = __builtin_amdgcn_readfirstlane(units[4 * i + 1]); u.e = __builtin_amdgcn_readfirstlane(units[4 * i + 2]);
        u.slot = i; u.offA = gather ? 0l : (long)u.pm * 256 * D;     u.offB = (long)u.e * ebytes + (long)u.pn * 256 * 16; return true;
    }
    __device__ __forceinline__ void a_ready(const Unit&) const {}
    __device__ __forceinline__ void done(const Unit&) const {}
};

struct CvItem { const float* src; bf16* dst; const float* kscale; int ldw, K, rmul, radd, k0, n0; };
constexpr int CV_I_IN = (D / 64) * (NPROJ / 32), CV_I_GLU = (SSW / 64) * (SSW / 32), CV_I_OUT = (D / 64) * (D / 32), CV_I_E = (D / 64) * (FF / 32);
constexpr int CV_N_EARLY = CV_I_IN + 2 * CV_I_GLU + CV_I_OUT, CV_N_EXP = 3 * NE * (D / 8);
__device__ __forceinline__ void cv_set(CvItem& c, const float* W, int ldw, int K, int N, bf16* WT, int rmul, int radd, int item) {
    const int nblk = N / 32, kb = item / nblk, nb = item % nblk; c.src = W; c.dst = WT; c.kscale = nullptr; c.ldw = ldw; c.K = K; c.rmul = rmul; c.radd = radd; c.k0 = 64 * kb; c.n0 = 32 * nb;
}
__device__ __forceinline__ void cv_decode_early(Frame& F, int r, CvItem& c) {
    bf16* WinT = (bf16*)(F.ws + WS_WINT); bf16* WgluT = (bf16*)(F.ws + WS_WGLUT); bf16* WoutT = (bf16*)(F.ws + WS_WOUTT);
    if (r < CV_I_IN) { cv_set(c, F.in[2], NPROJ, D, NPROJ, WinT, 1, 0, r); return; } r -= CV_I_IN;
    if (r < CV_I_GLU) { cv_set(c, F.in[11], 2 * SSW, SSW, SSW, WgluT, 2, 0, r); return; } r -= CV_I_GLU;
    if (r < CV_I_GLU) { cv_set(c, F.in[11] + SSW, 2 * SSW, SSW, SSW, WgluT, 2, 128, r); return; } r -= CV_I_GLU;
    cv_set(c, F.in[14], D, D, D, WoutT, 1, 0, r);
    c.kscale = (c.k0 < SBW) ? F.in[12] + c.k0 : F.in[13] + (c.k0 - SBW);
}
__device__ __forceinline__ void cv_decode_exp(Frame& F, int r, CvItem& c) {
    bf16* W1T = (bf16*)(F.ws + WS_W1T); bf16* W2T = (bf16*)(F.ws + WS_W2T);
    const int mat = r / CV_I_E, sub = r % CV_I_E, kind = mat / NE, e = mat % NE;
    if (kind == 0) cv_set(c, F.in[18] + (size_t)e * D * FF, FF, D, FF, W1T + (size_t)e * 2 * FF * D, 2, 0, sub);
    else if (kind == 1) cv_set(c, F.in[20] + (size_t)e * D * FF, FF, D, FF, W1T + (size_t)e * 2 * FF * D, 2, 128, sub);
    else cv_set(c, F.in[22] + (size_t)e * FF * D, D, FF, D, W2T + (size_t)e * D * FF, 1, 0, sub);
}
__device__ __forceinline__ void cv_load(const CvItem& c, int lane, float (&v)[32]) {
    const float* p = c.src + (size_t)(c.k0 + (lane >> 5)) * c.ldw + c.n0 + (lane & 31);
#pragma unroll
    for (int i = 0; i < 32; ++i) v[i] = p[(size_t)(2 * i) * c.ldw];
}
__device__ __forceinline__ void cv_store(const CvItem& c, int lane, const float (&v)[32], LAS float* scr) {
#pragma unroll
    for (int i = 0; i < 32; ++i) scr[(2 * i + (lane >> 5)) * 33 + (lane & 31)] = v[i];
    LDS_WAIT(); asm volatile("" ::: "memory");
    const int cc = lane & 7;
#pragma unroll
    for (int j = 0; j < 4; ++j) { const int nl = (lane >> 3) + 8 * j; const int n = c.n0 + nl; const int drow = (n >> 7) * 128 * c.rmul + c.radd + (n & 127); const LAS float* s = scr + (8 * cc) * 33 + nl;
        float e0 = s[0 * 33], e1 = s[1 * 33], e2 = s[2 * 33], e3 = s[3 * 33], e4 = s[4 * 33], e5 = s[5 * 33], e6 = s[6 * 33], e7 = s[7 * 33];
        if (c.kscale) { const f32x4 ka = *(const f32x4*)(c.kscale + 8 * cc), kb = *(const f32x4*)(c.kscale + 8 * cc + 4); e0 *= ka.x; e1 *= ka.y; e2 *= ka.z; e3 *= ka.w; e4 *= kb.x; e5 *= kb.y; e6 *= kb.z; e7 *= kb.w; }
        v4u o; o.x = pg8::cvt_pk_bf16(e0, e1); o.y = pg8::cvt_pk_bf16(e2, e3); o.z = pg8::cvt_pk_bf16(e4, e5); o.w = pg8::cvt_pk_bf16(e6, e7);
        *(GAS v4u*)(c.dst + (size_t)drow * c.K + c.k0 + 8 * cc) = o; }
    LDS_WAIT(); asm volatile("" ::: "memory");
}
__device__ __forceinline__ void cv_item_early(Frame& F, int it, LAS float* scr) { CvItem c; float v[32]; cv_decode_early(F, it, c); cv_load(c, F.lane, v); cv_store(c, F.lane, v, scr); }
__device__ __forceinline__ void cv_run_early(Frame& F, int first, int stride, int n, LAS float* scr) {
    CvItem ca, cb; float va[32], vb[32];
    int it = first; if (it >= n) return;
    cv_decode_early(F, it, ca);
    cv_load(ca, F.lane, va);
    for (;;) {
        const int nit = it + stride; const bool more = nit < n;
        if (more) { cv_decode_early(F, nit, cb); cv_load(cb, F.lane, vb); }
        cv_store(ca, F.lane, va, scr);
        if (!more) break;
        ca = cb;
#pragma unroll
        for (int i = 0; i < 32; ++i) va[i] = vb[i];
        it = nit;
    }
}
__device__ __forceinline__ void xv_item(Frame& F, int it) {
    unsigned char* W1T = F.ws + WS_W1T; unsigned char* W2T = F.ws + WS_W2T;
    const float* w0 = F.in[18]; const float* w1 = F.in[20]; const float* w2 = F.in[22];
    asm volatile("" : "+s"(w0), "+s"(w1), "+s"(w2));
    const int lane = F.lane;
    {
        const int mat = it >> 7, kb = (it & 127) >> 1, half = it & 1, kind = mat / NE, e = mat % NE;
        const float* src = (kind == 0 ? w0 : (kind == 1 ? w1 : w2)) + (size_t)e * D * FF + (size_t)(kb * 16) * FF + half * 512 + 4 * lane;
        f32x4 v[16][2];
#pragma unroll
        for (int rr = 0; rr < 16; ++rr)
#pragma unroll
            for (int j = 0; j < 2; ++j) v[rr][j] = *(const GAS f32x4*)(src + (size_t)rr * FF + 256 * j);
        unsigned char* dst; int jstride;
        if (kind < 2) { dst = W1T + (size_t)e * 2 * FF * D + ((size_t)kb * 2 * FF + (size_t)(half * 4 + (lane >> 5)) * 256 + (kind == 1 ? 128 : 0) + 4 * (lane & 31)) * 16; jstride = 512 * 16; }
        else { dst = W2T + (size_t)e * D * FF + ((size_t)kb * D + half * 512 + 4 * lane) * 16; jstride = 256 * 16; }
#pragma unroll
        for (int j = 0; j < 2; ++j)
#pragma unroll
            for (int c = 0; c < 4; ++c) { v4u o;
                o.x = pk4_fp8(v[0][j][c] * WSCALE, v[1][j][c] * WSCALE, v[2][j][c] * WSCALE, v[3][j][c] * WSCALE); o.y = pk4_fp8(v[4][j][c] * WSCALE, v[5][j][c] * WSCALE, v[6][j][c] * WSCALE, v[7][j][c] * WSCALE);
                o.z = pk4_fp8(v[8][j][c] * WSCALE, v[9][j][c] * WSCALE, v[10][j][c] * WSCALE, v[11][j][c] * WSCALE); o.w = pk4_fp8(v[12][j][c] * WSCALE, v[13][j][c] * WSCALE, v[14][j][c] * WSCALE, v[15][j][c] * WSCALE);
                *(GAS v4u*)(dst + (size_t)j * jstride + c * 16) = o; }
    }
}
__device__ __forceinline__ void rms_row_to_bf16(int lane, const float* xrow, const float* g, bf16* orow) {
    const GAS f32x4* xr = (const GAS f32x4*)xrow + lane; const GAS f32x4* gr = (const GAS f32x4*)g + lane;
    f32x4 v[4]; float s = 0.f;
#pragma unroll
    for (int j = 0; j < 4; ++j) { v[j] = xr[64 * j]; s += (v[j].x * v[j].x + v[j].y * v[j].y) + (v[j].z * v[j].z + v[j].w * v[j].w); }
    const float rstd = 1.0f / sqrtf(wave_sum(s) * (1.f / D) + EPS);
    GAS unsigned long long* o8 = (GAS unsigned long long*)orow + lane;
#pragma unroll
    for (int j = 0; j < 4; ++j) { const f32x4 gg = gr[64 * j]; o8[64 * j] = (unsigned long long)pk2(v[j].x * rstd * gg.x, v[j].y * rstd * gg.y) | ((unsigned long long)pk2(v[j].z * rstd * gg.z, v[j].w * rstd * gg.w) << 32); }
}
__device__ __forceinline__ void sincos_acc(float th, float& s, float& c) {
    const float k = rintf(th * 0.15915494309189535f);
    float r = fmaf(-k, 6.28125f, th); r = fmaf(-k, 1.9353071795864769e-3f, r);
    const float x = 0.25f * r, x2 = x * x;
    float sn = x * (1.0f + x2 * (-1.0f / 6 + x2 * (1.0f / 120 + x2 * (-1.0f / 5040 + x2 * (1.0f / 362880 + x2 * (-1.0f / 39916800))))));
    float cs = 1.0f + x2 * (-0.5f + x2 * (1.0f / 24 + x2 * (-1.0f / 720 + x2 * (1.0f / 40320 + x2 * (-1.0f / 3628800 + x2 * (1.0f / 479001600))))));
#pragma unroll
    for (int i = 0; i < 2; ++i) { const float s2 = 2.0f * sn * cs, c2 = 1.0f - 2.0f * sn * sn; sn = s2; cs = c2; }
    s = sn; c = cs;
}
__device__ __forceinline__ void ssm_tables(Frame& F, int g) {
    constexpr int PT = 36, BS = 17, CS = 68, KT = 324, KC = 20;
    LAS float* pwr = (LAS float*)(F.lds);
    LAS float* pwi = pwr + 64 * PT;
    LAS float* bbr = pwi + 64 * PT;
    LAS float* bbi = bbr + 64 * BS;
    LAS float* ccr = bbi + 64 * BS;
    LAS float* cci = ccr + 16 * CS;
    LAS float* km = cci + 16 * CS;
    const float* lam_re = F.in[3]; const float* lam_im = F.in[4]; const float* log_dt = F.in[5];
    const float* b_re = F.in[6]; const float* b_im = F.in[7]; const float* c_re = F.in[8]; const float* c_im = F.in[9]; const float* dsk = F.in[10];
    float* lamL = (float*)(F.ws + WS_LAML); bf16* WE = (bf16*)(F.ws + WS_WE); bf16* TW = (bf16*)(F.ws + WS_TW);
    const int tid = F.tid;
    if (tid < 64) { const int p = tid;
        const float lr = lam_re[g * NP + p], li = lam_im[g * NP + p], dt = expf(log_dt[g]);
        const float er = expf(lr * dt); float sn, cs; sincos_acc(li * dt, sn, cs);
        const float br = er * cs, bi = er * sn;
        const float nr = br - 1.0f, ni = bi, den = 1.0f / (lr * lr + li * li);
        const float fr = (nr * lr + ni * li) * den, fi = (ni * lr - nr * li) * den;
        float pr = 1.0f, pi = 0.0f;
        for (int n = 0; n <= 32; ++n) { pwr[p * PT + n] = pr; pwi[p * PT + n] = pi; const float t = pr * br - pi * bi; pi = pr * bi + pi * br; pr = t; }
        lamL[(g * 2 + 0) * NP + p] = pwr[p * PT + 32]; lamL[(g * 2 + 1) * NP + p] = pwi[p * PT + 32];
        float xr[GC], xi[GC];
#pragma unroll
        for (int c = 0; c < GC; ++c) { xr[c] = b_re[(g * NP + p) * GC + c]; xi[c] = b_im[(g * NP + p) * GC + c]; }
#pragma unroll
        for (int c = 0; c < GC; ++c) { bbr[p * BS + c] = fr * xr[c] - fi * xi[c]; bbi[p * BS + c] = fr * xi[c] + fi * xr[c]; }
    }
    for (int i = tid; i < 1024; i += NWAVES * 64) { ccr[(i >> 6) * CS + (i & 63)] = c_re[g * 1024 + i]; cci[(i >> 6) * CS + (i & 63)] = c_im[g * 1024 + i]; }
    __syncthreads();
    {
        const int pair = tid & 255, co = pair >> 4, ci = pair & 15, t0 = (tid >> 8) * 16;
        float acc[16];
#pragma unroll
        for (int t = 0; t < 16; ++t) acc[t] = 0.f;
        for (int p = 0; p < NP; ++p) { const float cr = ccr[co * CS + p], cim = cci[co * CS + p], xr = bbr[p * BS + ci], xi = bbi[p * BS + ci];
            const float gr = cr * xr - cim * xi, gi = cr * xi + cim * xr;
#pragma unroll
            for (int t4 = 0; t4 < 4; ++t4) { const f32x4 a = *(const LAS f32x4*)(pwr + p * PT + t0 + 4 * t4), bq = *(const LAS f32x4*)(pwi + p * PT + t0 + 4 * t4);
#pragma unroll
                for (int t = 0; t < 4; ++t) acc[4 * t4 + t] += gr * a[t] - gi * bq[t]; } }
#pragma unroll
        for (int t = 0; t < 16; ++t) km[(t0 + t) * KT + co * KC + ci] = acc[t];
    }
    __syncthreads();
    {
        const int n = tid, i = n >> 4, co = n & 15; const float dv = dsk[g * GC + co];
        bf16* dst = TW + ((size_t)g * 512 + n) * UK;
        for (int j = 0; j < LC; ++j) {
            float v[16];
            const LAS float* kr = km + (j <= i ? i - j : 0) * KT + co * KC;
#pragma unroll
            for (int c4 = 0; c4 < 4; ++c4) { const f32x4 q = *(const LAS f32x4*)(kr + 4 * c4);
#pragma unroll
                for (int t = 0; t < 4; ++t) v[4 * c4 + t] = (j <= i) ? q[t] : 0.f; }
            if (j == i) {
#pragma unroll
                for (int ci = 0; ci < 16; ++ci) v[ci] += (ci == co) ? dv : 0.f; }
            v4u o0, o1; o0.x = pg8::cvt_pk_bf16(v[0], v[1]); o0.y = pg8::cvt_pk_bf16(v[2], v[3]); o0.z = pg8::cvt_pk_bf16(v[4], v[5]); o0.w = pg8::cvt_pk_bf16(v[6], v[7]);
            o1.x = pg8::cvt_pk_bf16(v[8], v[9]); o1.y = pg8::cvt_pk_bf16(v[10], v[11]); o1.z = pg8::cvt_pk_bf16(v[12], v[13]); o1.w = pg8::cvt_pk_bf16(v[14], v[15]);
            *(GAS v4u*)(dst + j * 16) = o0; *(GAS v4u*)(dst + j * 16 + 8) = o1; }
        for (int k8 = 0; k8 < 16; ++k8) { float v[8];
            const int ri = k8 >> 3, p0 = 8 * (k8 & 7);
#pragma unroll
            for (int e = 0; e < 8; ++e) { const int p = p0 + e; const float cr = ccr[co * CS + p], cim = cci[co * CS + p], pr = pwr[p * PT + i + 1], pi = pwi[p * PT + i + 1];
                v[e] = ri == 0 ? (cr * pr - cim * pi) : -(cr * pi + cim * pr); }
            v4u o; o.x = pg8::cvt_pk_bf16(v[0], v[1]); o.y = pg8::cvt_pk_bf16(v[2], v[3]); o.z = pg8::cvt_pk_bf16(v[4], v[5]); o.w = pg8::cvt_pk_bf16(v[6], v[7]);
            *(GAS v4u*)(dst + 512 + k8 * 8) = o; }
    }
    {
        const int row = tid & 127, ri = row >> 6, p = row & 63, kq = tid >> 7;
        bf16* dst = WE + ((size_t)g * 128 + row) * 512 + kq * 128;
        for (int k8 = 0; k8 < 16; ++k8) { float v[8];
#pragma unroll
            for (int e = 0; e < 8; ++e) { const int k = kq * 128 + k8 * 8 + e, j = k >> 4, c = k & 15; const float pr = pwr[p * PT + 31 - j], pi = pwi[p * PT + 31 - j], xr = bbr[p * BS + c], xi = bbi[p * BS + c];
                v[e] = ri == 0 ? (pr * xr - pi * xi) : (pr * xi + pi * xr); }
            v4u o; o.x = pg8::cvt_pk_bf16(v[0], v[1]); o.y = pg8::cvt_pk_bf16(v[2], v[3]); o.z = pg8::cvt_pk_bf16(v[4], v[5]); o.w = pg8::cvt_pk_bf16(v[6], v[7]);
            *(GAS v4u*)(dst + k8 * 8) = o; }
    }
    __syncthreads();
}
__device__ __forceinline__ void rms_rows4_to_bf16(int lane, const float* x0, const float* g, bf16* o0) {
    const GAS f32x4* gr = (const GAS f32x4*)g + lane;
    f32x4 v[4][4]; float sq[4];
#pragma unroll
    for (int r = 0; r < 4; ++r)
#pragma unroll
        for (int j = 0; j < 4; ++j) v[r][j] = ((const GAS f32x4*)(x0 + (size_t)r * D) + lane)[64 * j];
#pragma unroll
    for (int r = 0; r < 4; ++r) { sq[r] = 0.f;
#pragma unroll
        for (int j = 0; j < 4; ++j) sq[r] += (v[r][j].x * v[r][j].x + v[r][j].y * v[r][j].y) + (v[r][j].z * v[r][j].z + v[r][j].w * v[r][j].w); }
#pragma unroll
    for (int o = 1; o < 64; o <<= 1) {
#pragma unroll
        for (int r = 0; r < 4; ++r) sq[r] += __shfl_xor(sq[r], o); }
#pragma unroll
    for (int j = 0; j < 4; ++j) { const f32x4 gg = gr[64 * j];
#pragma unroll
        for (int r = 0; r < 4; ++r) { const float rs = 1.0f / sqrtf(sq[r] * (1.f / D) + EPS); v2u w; w.x = pg8::cvt_pk_bf16(v[r][j].x * rs * gg.x, v[r][j].y * rs * gg.y); w.y = pg8::cvt_pk_bf16(v[r][j].z * rs * gg.z, v[r][j].w * rs * gg.w);
            ((GAS v2u*)(o0 + (size_t)r * D) + lane)[64 * j] = w; } }
}
__device__ __forceinline__ void rms_rows2_to_bf16(int lane, const float* x0, const float* x1, const float* g, bf16* o0, bf16* o1) {
    const GAS f32x4* xa = (const GAS f32x4*)x0 + lane; const GAS f32x4* xb = (const GAS f32x4*)x1 + lane; const GAS f32x4* gr = (const GAS f32x4*)g + lane;
    f32x4 va[4], vb[4]; float sa = 0.f, sb = 0.f;
#pragma unroll
    for (int j = 0; j < 4; ++j) { va[j] = xa[64 * j]; vb[j] = xb[64 * j]; }
#pragma unroll
    for (int j = 0; j < 4; ++j) { sa += (va[j].x * va[j].x + va[j].y * va[j].y) + (va[j].z * va[j].z + va[j].w * va[j].w); sb += (vb[j].x * vb[j].x + vb[j].y * vb[j].y) + (vb[j].z * vb[j].z + vb[j].w * vb[j].w); }
#pragma unroll
    for (int o = 1; o < 64; o <<= 1) { sa += __shfl_xor(sa, o); sb += __shfl_xor(sb, o); }
    const float ra = 1.0f / sqrtf(sa * (1.f / D) + EPS), rb = 1.0f / sqrtf(sb * (1.f / D) + EPS);
    GAS v2u* pa = (GAS v2u*)o0 + lane; GAS v2u* pb = (GAS v2u*)o1 + lane;
#pragma unroll
    for (int j = 0; j < 4; ++j) { const f32x4 gg = gr[64 * j];
        v2u wa, wb; wa.x = pg8::cvt_pk_bf16(va[j].x * ra * gg.x, va[j].y * ra * gg.y); wa.y = pg8::cvt_pk_bf16(va[j].z * ra * gg.z, va[j].w * ra * gg.w);
        wb.x = pg8::cvt_pk_bf16(vb[j].x * rb * gg.x, vb[j].y * rb * gg.y); wb.y = pg8::cvt_pk_bf16(vb[j].z * rb * gg.z, vb[j].w * rb * gg.w);
        pa[64 * j] = wa; pb[64 * j] = wb; }
}
constexpr int CV_N_W1 = 2 * NE * (D / 8);
constexpr int P1_GEMM_WG = 176;
constexpr int Q0_HN = M / 8, Q0_END = Q0_HN + CV_N_EARLY / 4;
static_assert(Q0_END % 8 == 0 && CV_N_EARLY % 4 == 0, "P0 queue");
__device__ __forceinline__ void p0_prologue(Frame& F, unsigned long long& t_lo_, unsigned long long& t_hi_) {
    TMARK(100);
    LAS float* scr = (LAS float*)(F.lds + RING_OFF + F.wave * 16384);
    unsigned* q = (unsigned*)(F.ctl + CW_Q0); volatile LAS unsigned* slot = F.MISC + 16;
    bf16* HN = (bf16*)(F.ws + WS_HN);
    for (;;) {
        __syncthreads();
        if (F.tid == 0) *slot = __hip_atomic_fetch_add(q, 8u, RLX_AGENT);
        __syncthreads();
        const int base = (int)__builtin_amdgcn_readfirstlane(*slot); if (base >= Q0_END) break;
        const int idx = base + F.wave;
        if (idx < Q0_HN) { const int m0 = idx * 8;
#pragma unroll 1
            for (int j = 0; j < 2; ++j) { const int m = m0 + 4 * j; rms_rows4_to_bf16(F.lane, F.in[0] + (size_t)m * D, F.in[1], HN + (size_t)m * D); } }
        else { const int g4 = (idx - Q0_HN) * 4;
#pragma unroll 1
            for (int j = 0; j < 4; ++j) cv_item_early(F, g4 + j, scr); }
    }
    TMARK(104);
}
__device__ __forceinline__ void q1_drain(Frame& F, int max_claims, unsigned* stop, unsigned stop_target) {
    unsigned* q = (unsigned*)(F.ctl + CW_Q1); volatile LAS unsigned* slot = F.MISC + 18;
    for (int n = 0; max_claims < 0 || n < max_claims; ++n) {
        __syncthreads();
        if (F.tid == 0) { unsigned v = 0x7fffffffu; if (!(stop_target && __hip_atomic_load(stop, RLX_AGENT) >= stop_target)) v = __hip_atomic_fetch_add(q, 8u, RLX_AGENT); *slot = v; }
        __syncthreads();
        const unsigned base = (unsigned)__builtin_amdgcn_readfirstlane(*slot); if (base >= (unsigned)CV_N_W1) break;
        xv_item(F, (int)base + F.wave);
    }
}
__device__ __forceinline__ void p1_side(Frame& F, int tabler_idx) {
    if (tabler_idx >= 0) { ssm_tables(F, tabler_idx);
        if (tabler_idx == 0 && F.tid < 128) {
            bf16* WE = (bf16*)(F.ws + WS_WE) + (size_t)NG * 128 * 512;
            for (int i = 0; i < 512 / 8; ++i) *(GAS v4u*)(WE + (size_t)F.tid * 512 + i * 8) = (v4u){0u, 0u, 0u, 0u}; }
        if (tabler_idx == 1) {
            const float* wr = F.in[16]; bf16* img = (bf16*)(F.ws + WS_RWIMG);
            for (int idx = F.tid; idx < D * NE; idx += NWAVES * 64) { const float w = wr[idx]; const unsigned h = f2bf(w); const unsigned l = f2bf(w - bf2f((unsigned short)h)); const int k = idx >> 5, e = idx & 31;
                img[e * RT_WSTR + k] = (bf16)h; img[(NE + e) * RT_WSTR + k] = (bf16)l; }
            if (F.tid < 2 * NE) for (int k = D; k < RT_WSTR; ++k) img[F.tid * RT_WSTR + k] = 0; } }
    q1_drain(F, -1, (unsigned*)(F.ctl + CW_DONE1), (unsigned)P1_GEMM_WG);
}
__device__ __forceinline__ void w2_drain(Frame& F, int max_claims) {
    unsigned* q = (unsigned*)(F.ctl + CW_Q2); volatile LAS unsigned* slot = F.MISC + 19;
    for (int n = 0; max_claims < 0 || n < max_claims; ++n) {
        __syncthreads();
        if (F.tid == 0) *slot = __hip_atomic_fetch_add(q, 8u, RLX_AGENT);
        __syncthreads();
        const int base = CV_N_W1 + (int)__builtin_amdgcn_readfirstlane(*slot); if (base >= CV_N_EXP) break;
        xv_item(F, base + F.wave);
    }
}

__device__ __forceinline__ void attn_simple_unit(const unsigned short* Qh, const unsigned short* Kh, const unsigned short* Vh, bf16* Y, int b, int h, int qb, int lane) {
    const int t = qb * 64 + lane; const size_t row = (size_t)b * SEQ + t;
    float q[64], o[64];
    { const v4u* qp = (const v4u*)(Qh + row * SBW + h * HD);
#pragma unroll
      for (int i = 0; i < 8; ++i) { const v4u w = qp[i];
#pragma unroll
          for (int j = 0; j < 4; ++j) { const unsigned wj = w[j]; const h16x2 hv = __builtin_bit_cast(h16x2, wj); q[8 * i + 2 * j] = (float)hv.x; q[8 * i + 2 * j + 1] = (float)hv.y; } } }
#pragma unroll
    for (int d = 0; d < 64; ++d) o[d] = 0.f;
    float cum = 0.f;
    for (int s = qb * 64 + 62; s >= 0; --s) {
        const size_t krow = ((size_t)b * SEQ + s) * SBW + h * HD;
        const v4u* kp = (const v4u*)(Kh + krow); const v4u* vp = (const v4u*)(Vh + krow);
        float z = 0.f;
#pragma unroll
        for (int i = 0; i < 8; ++i) { const v4u w = kp[i];
#pragma unroll
            for (int j = 0; j < 4; ++j) { const unsigned wj = w[j]; const h16x2 hv = __builtin_bit_cast(h16x2, wj); z = fmaf(q[8 * i + 2 * j], (float)hv.x, z); z = fmaf(q[8 * i + 2 * j + 1], (float)hv.y, z); } }
        const bool act = s < t;
        const float t1 = flog2(1.0f + fexp2(-fabsf(z)));
        const float L = act ? -(fmaxf(z, 0.f) + t1) : 0.f;
        const float ls = fminf(z, 0.f) - t1;
        const float p = act ? fexp2(ls + cum) : 0.f;
        cum += L;
#pragma unroll
        for (int i = 0; i < 8; ++i) { const v4u w = vp[i];
#pragma unroll
            for (int j = 0; j < 4; ++j) { const unsigned wj = w[j]; const h16x2 hv = __builtin_bit_cast(h16x2, wj); o[8 * i + 2 * j] = fmaf(p, (float)hv.x, o[8 * i + 2 * j]); o[8 * i + 2 * j + 1] = fmaf(p, (float)hv.y, o[8 * i + 2 * j + 1]); } }
        if (__all(cum < -150.0f)) break;
    }
    bf16* yp = Y + row * SBW + h * HD;
#pragma unroll
    for (int i = 0; i < 8; ++i) { v4u w; w.x = pk2(o[8 * i], o[8 * i + 1]); w.y = pk2(o[8 * i + 2], o[8 * i + 3]); w.z = pk2(o[8 * i + 4], o[8 * i + 5]); w.w = pk2(o[8 * i + 6], o[8 * i + 7]); *(v4u*)(yp + 8 * i) = w; }
}
typedef _Float16 h8v __attribute__((ext_vector_type(8)));
typedef float f16v __attribute__((ext_vector_type(16)));
__device__ __forceinline__ void attn_mfma_unit(const _Float16* Qh, const _Float16* Kh, const _Float16* VT, bf16* Y, float* SSQ, int b, int hd, int qb, int lane, h8v tri0, h8v tri1) {
    const int r = lane & 31, hh = lane >> 5, q0 = qb * 32;
    const _Float16* qrow = Qh + ((size_t)b * SEQ + q0 + r) * SBW + hd * HD + 8 * hh;
    h8v qf[4];
#pragma unroll
    for (int kd = 0; kd < 4; ++kd) qf[kd] = *(const h8v*)(qrow + 16 * kd);
    f16v o0, o1;
#pragma unroll
    for (int i = 0; i < 16; ++i) { o0[i] = 0.f; o1[i] = 0.f; }
    float carry = 0.f;
    const _Float16* kbase = Kh + ((size_t)b * SEQ + r) * SBW + hd * HD + 8 * hh;
    const _Float16* vbase = VT + ((size_t)b * SBW + hd * HD + r) * SEQ + 8 * hh;
    h8v kf[4], vf[2][2], kn[4], vn[2][2];
#pragma unroll
    for (int kd = 0; kd < 4; ++kd) kf[kd] = *(const h8v*)(kbase + (size_t)q0 * SBW + 16 * kd);
#pragma unroll
    for (int db = 0; db < 2; ++db)
#pragma unroll
        for (int ss = 0; ss < 2; ++ss) vf[db][ss] = *(const h8v*)(vbase + (size_t)(32 * db) * SEQ + q0 + 16 * ss);
    for (int key0 = q0; key0 >= 0; key0 -= 32) {
        { const int kn0 = key0 >= 32 ? key0 - 32 : key0;
#pragma unroll
          for (int kd = 0; kd < 4; ++kd) kn[kd] = *(const h8v*)(kbase + (size_t)kn0 * SBW + 16 * kd);
#pragma unroll
          for (int db = 0; db < 2; ++db)
#pragma unroll
              for (int ss = 0; ss < 2; ++ss) vn[db][ss] = *(const h8v*)(vbase + (size_t)(32 * db) * SEQ + kn0 + 16 * ss); }
        f16v z;
#pragma unroll
        for (int i = 0; i < 16; ++i) z[i] = 0.f;
#pragma unroll
        for (int kd = 0; kd < 4; ++kd) z = __builtin_amdgcn_mfma_f32_32x32x16_f16(kf[kd], qf[kd], z, 0, 0, 0);
        const bool diag = key0 == q0;
        h8v lh[2], ll[2];
#pragma unroll
        for (int i = 0; i < 16; ++i) { const int koff = (i & 3) + 8 * (i >> 2) + 4 * hh; const bool act = !diag || koff < r;
            const float zi = z[i]; const float t1 = flog2(1.0f + fexp2(-fabsf(zi)));
            const float L = act ? fmaxf(-(fmaxf(zi, 0.f) + t1), -60000.0f) : 0.f;
            const _Float16 hi = (_Float16)L; const _Float16 lo = (_Float16)(L - (float)hi);
            lh[i >> 3][i & 7] = hi; ll[i >> 3][i & 7] = lo; }
        f16v cum;
#pragma unroll
        for (int i = 0; i < 16; ++i) cum[i] = carry;
        cum = __builtin_amdgcn_mfma_f32_32x32x16_f16(tri0, lh[0], cum, 0, 0, 0);
        cum = __builtin_amdgcn_mfma_f32_32x32x16_f16(tri1, lh[1], cum, 0, 0, 0);
        cum = __builtin_amdgcn_mfma_f32_32x32x16_f16(tri0, ll[0], cum, 0, 0, 0);
        cum = __builtin_amdgcn_mfma_f32_32x32x16_f16(tri1, ll[1], cum, 0, 0, 0);
        h8v pf[2];
#pragma unroll
        for (int i = 0; i < 16; ++i) { const int koff = (i & 3) + 8 * (i >> 2) + 4 * hh; const bool act = !diag || koff < r;
            const float p = act ? fexp2(z[i] + cum[i]) : 0.f; pf[i >> 3][i & 7] = (_Float16)p; }
        o0 = __builtin_amdgcn_mfma_f32_32x32x16_f16(vf[0][0], pf[0], o0, 0, 0, 0);
        o0 = __builtin_amdgcn_mfma_f32_32x32x16_f16(vf[0][1], pf[1], o0, 0, 0, 0);
        o1 = __builtin_amdgcn_mfma_f32_32x32x16_f16(vf[1][0], pf[0], o1, 0, 0, 0);
        o1 = __builtin_amdgcn_mfma_f32_32x32x16_f16(vf[1][1], pf[1], o1, 0, 0, 0);
        carry = __shfl(cum[0], r);
        if (__all(carry < -150.0f)) break;
#pragma unroll
        for (int kd = 0; kd < 4; ++kd) kf[kd] = kn[kd];
#pragma unroll
        for (int db = 0; db < 2; ++db)
#pragma unroll
            for (int ss = 0; ss < 2; ++ss) vf[db][ss] = vn[db][ss];
    }
    { float sq = 0.f;
#pragma unroll
      for (int i = 0; i < 16; ++i) sq += o0[i] * o0[i] + o1[i] * o1[i];
      sq += __shfl_xor(sq, 32); if (hh == 0) SSQ[((size_t)b * SEQ + q0 + r) * NH + hd] = sq; }
    bf16* yp = Y + ((size_t)b * SEQ + q0 + r) * D + hd * HD + 4 * hh;
#pragma unroll
    for (int g4 = 0; g4 < 4; ++g4) { v2u w0, w1; w0.x = pk2(o0[4 * g4], o0[4 * g4 + 1]); w0.y = pk2(o0[4 * g4 + 2], o0[4 * g4 + 3]); w1.x = pk2(o1[4 * g4], o1[4 * g4 + 1]); w1.y = pk2(o1[4 * g4 + 2], o1[4 * g4 + 3]);
        *(v2u*)(yp + 8 * g4) = w0; *(v2u*)(yp + 32 + 8 * g4) = w1; }
}
__device__ __forceinline__ void attn_one(Frame& F, int u) {
    const _Float16* Qh = (const _Float16*)(F.ws + WS_Q); const _Float16* Kh = (const _Float16*)(F.ws + WS_K); const _Float16* VT = (const _Float16*)(F.ws + WS_V);
    bf16* Y = (bf16*)(F.ws + WS_YCAT); float* SSQ = (float*)(F.ws + WS_SSQSB);
    constexpr int NQB = SEQ / 32;
    const int lane = F.lane, r = lane & 31, hh = lane >> 5;
    h8v tri0, tri1;
#pragma unroll
    for (int e = 0; e < 8; ++e) { const int k0 = 8 * (e >> 2) + 4 * hh + (e & 3); tri0[e] = (k0 >= r) ? (_Float16)1.0f : (_Float16)0.0f; tri1[e] = (16 + k0 >= r) ? (_Float16)1.0f : (_Float16)0.0f; }
    const int qb = u % NQB, bh = u / NQB; attn_mfma_unit(Qh, Kh, VT, Y, SSQ, bh / NH, bh % NH, qb, lane, tri0, tri1);
}

__device__ __forceinline__ void scan_phase(Frame& F, int task) {
    static_assert(CPB == 8 * 32, "scan segments");
    const int b = task / NG, g = task % NG, p = F.lane, sg = F.wave;
    const float* lamL = (const float*)(F.ws + WS_LAML); const float* S = (const float*)(F.ws + WS_SLOC); bf16* U = (bf16*)(F.ws + WS_UCAT);
    LAS float* ex = (LAS float*)(F.lds);
    const float lr = lamL[(g * 2 + 0) * NP + p], li = lamL[(g * 2 + 1) * NP + p];
    float sr[32], si[32];
#pragma unroll
    for (int j = 0; j < 32; ++j) { const size_t base = ((size_t)(b * CPB + sg * 32 + j) * NG + g) * 128; sr[j] = S[base + p]; si[j] = S[base + 64 + p]; }
    float er = 0.f, ei = 0.f, qr = 1.f, qi = 0.f;
#pragma unroll
    for (int j = 0; j < 32; ++j) { const float nr = lr * er - li * ei + sr[j], ni = lr * ei + li * er + si[j]; er = nr; ei = ni; const float tr = lr * qr - li * qi; qi = lr * qi + li * qr; qr = tr; }
    ex[(sg * 2 + 0) * 64 + p] = er; ex[(sg * 2 + 1) * 64 + p] = ei;
    __syncthreads();
    float xr = 0.f, xi = 0.f;
    for (int r = 0; r < sg; ++r) { const float tr = qr * xr - qi * xi + ex[(r * 2 + 0) * 64 + p], ti = qr * xi + qi * xr + ex[(r * 2 + 1) * 64 + p]; xr = tr; xi = ti; }
#pragma unroll
    for (int j = 0; j < 32; ++j) { bf16* dst = U + ((size_t)(b * CPB + sg * 32 + j) * NG + g) * UK + 512;
        dst[p] = (bf16)f2bf(xr); dst[64 + p] = (bf16)f2bf(xi);
        const float nr = lr * xr - li * xi + sr[j], ni = lr * xi + li * xr + si[j]; xr = nr; xi = ni; }
    __syncthreads();
}

__device__ __forceinline__ void router_phase(Frame& F) {
    typedef short s8v __attribute__((ext_vector_type(8)));
    typedef float f16v __attribute__((ext_vector_type(16)));
    LAS bf16* wh = (LAS bf16*)F.lds; LAS bf16* wl = wh + NE * RT_WSTR;
    LAS int* lcnt = (LAS int*)(F.lds + RT_SCR_OFF); LAS int* lbase = lcnt + 32; LAS int* asg = lbase + 32;
    const float* wr = F.in[16]; const float* br = F.in[17]; const float* g2 = F.in[15];
    bf16* XG = (bf16*)(F.ws + WS_XN); float* gates = (float*)(F.ws + WS_GATES); int* lists = (int*)(F.ws + WS_LISTS); float* RS = (float*)(F.ws + WS_RSTD);
    unsigned* gcnt = (unsigned*)(F.ctl + CW_CNT);
    const int tid = F.tid, lane = F.lane, r = lane & 31, hh = lane >> 5;
    const int task = F.wave >> 2, kq = F.wave & 3; const int tok = F.vcu * 64 + task * 32 + r;
    const bf16* xp = x1_row(F.ws, tok) + kq * 256 + 8 * hh; unsigned char* xo = (unsigned char*)XG + (size_t)tok * D + kq * 256 + 8 * hh;
    v4u xw[16];
#pragma unroll
    for (int ks = 0; ks < 16; ++ks) xw[ks] = *(const v4u*)(xp + 16 * ks);
    { const v4u* src = (const v4u*)(F.ws + WS_RWIMG); LAS v4u* dst = (LAS v4u*)F.lds;
      for (int i = tid; i < RT_W_BYTES / 16; i += NWAVES * 64) dst[i] = src[i]; }
    LAS float* gl = (LAS float*)(F.lds + RT_SCR_OFF + 2048);
    for (int i = tid; i < D / 4; i += NWAVES * 64) ((LAS f32x4*)gl)[i] = ((const f32x4*)g2)[i];
    if (tid < 32) lcnt[tid] = 0;
    __syncthreads();
    f16v acc;
#pragma unroll
    for (int i = 0; i < 16; ++i) acc[i] = 0.f;
    float ss = 0.f;
    const LAS float* gp = gl + kq * 256 + 8 * hh;
    const LAS bf16* whp = wh + r * RT_WSTR + kq * 256 + 8 * hh; const LAS bf16* wlp = wl + r * RT_WSTR + kq * 256 + 8 * hh;
#pragma unroll
    for (int ks = 0; ks < 16; ++ks) {
        const v4u xq = xw[ks]; const f32x4 x0 = (f32x4){bflo(xq.x), bfhi(xq.x), bflo(xq.y), bfhi(xq.y)}, x1 = (f32x4){bflo(xq.z), bfhi(xq.z), bflo(xq.w), bfhi(xq.w)}, g0 = *(const LAS f32x4*)(gp + 16 * ks), g1 = *(const LAS f32x4*)(gp + 16 * ks + 4);
        ss += (x0.x * x0.x + x0.y * x0.y) + (x0.z * x0.z + x0.w * x0.w) + (x1.x * x1.x + x1.y * x1.y) + (x1.z * x1.z + x1.w * x1.w);
        const f32x4 a0 = x0 * g0, a1 = x1 * g1;
        v4u hv, lv;
        hv.x = pg8::cvt_pk_bf16(a0.x, a0.y); hv.y = pg8::cvt_pk_bf16(a0.z, a0.w); hv.z = pg8::cvt_pk_bf16(a1.x, a1.y); hv.w = pg8::cvt_pk_bf16(a1.z, a1.w);
        lv.x = pg8::cvt_pk_bf16(a0.x - bflo(hv.x), a0.y - bfhi(hv.x)); lv.y = pg8::cvt_pk_bf16(a0.z - bflo(hv.y), a0.w - bfhi(hv.y));
        lv.z = pg8::cvt_pk_bf16(a1.x - bflo(hv.z), a1.y - bfhi(hv.z)); lv.w = pg8::cvt_pk_bf16(a1.z - bflo(hv.w), a1.w - bfhi(hv.w));
        { v2u f8; f8.x = pk4_fp8(a0.x, a0.y, a0.z, a0.w); f8.y = pk4_fp8(a1.x, a1.y, a1.z, a1.w); *(v2u*)(xo + 16 * ks) = f8; }
        const s8v xh = __builtin_bit_cast(s8v, hv), xl = __builtin_bit_cast(s8v, lv);
        v4u ah, al; { const LAS v2u* p = (const LAS v2u*)(whp + 16 * ks); const v2u q0 = p[0], q1 = p[1]; ah.x = q0.x; ah.y = q0.y; ah.z = q1.x; ah.w = q1.y; }
        { const LAS v2u* p = (const LAS v2u*)(wlp + 16 * ks); const v2u q0 = p[0], q1 = p[1]; al.x = q0.x; al.y = q0.y; al.z = q1.x; al.w = q1.y; }
        const s8v wa = __builtin_bit_cast(s8v, ah), wb = __builtin_bit_cast(s8v, al);
        acc = __builtin_amdgcn_mfma_f32_32x32x16_bf16(wa, xh, acc, 0, 0, 0);
        acc = __builtin_amdgcn_mfma_f32_32x32x16_bf16(wb, xh, acc, 0, 0, 0);
        acc = __builtin_amdgcn_mfma_f32_32x32x16_bf16(wa, xl, acc, 0, 0, 0);
    }
    __syncthreads();
    LAS float* part = (LAS float*)F.lds;
#pragma unroll
    for (int i = 0; i < 16; ++i) part[(F.wave * 17 + i) * 64 + lane] = acc[i];
    part[(F.wave * 17 + 16) * 64 + lane] = ss;
    __syncthreads();
    if (kq == 0) {
        float v[32]; float st = 0.f;
#pragma unroll
        for (int w = 0; w < 4; ++w) { const LAS float* pw = part + (size_t)((task * 4 + w) * 17) * 64;
#pragma unroll
            for (int i = 0; i < 16; ++i) { const float t = pw[i * 64 + lane]; v[i] = w == 0 ? t : v[i] + t; }
            st += pw[16 * 64 + lane] + pw[16 * 64 + (lane ^ 32)]; }
        const float rstd = 1.0f / sqrtf(st * (1.f / D) + EPS);
        if (hh == 0) RS[tok] = rstd;
#pragma unroll
        for (int i = 0; i < 16; ++i) { const int e = (i & 3) + 8 * (i >> 2) + 4 * hh; v[i] = v[i] * rstd + br[e]; }
#pragma unroll
        for (int i = 0; i < 16; ++i) v[16 + i] = __shfl_xor(v[i], 32);
        float mx = v[0];
#pragma unroll
        for (int i = 1; i < 32; ++i) mx = fmaxf(mx, v[i]);
        int rk[16]; float es = 0.f;
#pragma unroll
        for (int i = 0; i < 16; ++i) { const int ei = (i & 3) + 8 * (i >> 2) + 4 * hh; int rank = 0;
#pragma unroll
            for (int j = 0; j < 32; ++j) { if (j == i) continue; const int ej = (j & 3) + 8 * ((j & 15) >> 2) + 4 * (j < 16 ? hh : 1 - hh);
                rank += (v[j] > v[i] || (v[j] == v[i] && ej < ei)) ? 1 : 0; }
            rk[i] = rank; if (rank < TOPK) es += fexp2((v[i] - mx) * LOG2E); }
        es += __shfl_xor(es, 32);
        const float inv = 1.0f / es;
#pragma unroll
        for (int i = 0; i < 16; ++i) if (rk[i] < TOPK) { const int ei = (i & 3) + 8 * (i >> 2) + 4 * hh;
            gates[tok * TOPK + rk[i]] = fexp2((v[i] - mx) * LOG2E) * inv;
            const int pos = __hip_atomic_fetch_add(lcnt + ei, 1, __ATOMIC_RELAXED, __HIP_MEMORY_SCOPE_WORKGROUP);
            asg[(task * 32 + r) * 4 + rk[i]] = ei | (pos << 8); }
    }
    __syncthreads();
    if (tid < 32) lbase[tid] = (int)__hip_atomic_fetch_add(gcnt + tid, (unsigned)lcnt[tid], RLX_AGENT);
    __syncthreads();
    if (tid < 64 * TOPK) { const int a = asg[tid], e = a & 255, pos = a >> 8; const int tk = F.vcu * 64 + (tid >> 2);
        lists[e * M + lbase[e] + pos] = tk * TOPK + (tid & 3); }
    __syncthreads();
}

__device__ __forceinline__ void moe_tables(Frame& F) {
    LAS int* tab = (LAS int*)(F.lds + TAB_OFF); LAS int* cnt = tab, * mt = tab + 32, * tbase = tab + 64;
    unsigned* gcnt = (unsigned*)(F.ctl + CW_CNT);
    if (F.tid < 32) { const int c = (int)__hip_atomic_load(gcnt + F.tid, RLX_AGENT); cnt[F.tid] = c; mt[F.tid] = (c + 255) >> 8; }
    __syncthreads();
    if (F.tid == 0) { int s = 0; for (int e = 0; e < NE; ++e) { tbase[e] = s; s += mt[e]; } tbase[NE] = s; }
    __syncthreads();
}
__device__ __forceinline__ void moe_units(Frame& F, int npn, int gpn) {
    LAS int* tab = (LAS int*)(F.lds + TAB_OFF); LAS int* mt = tab + 32, * tbase = tab + 64; LAS int* units = (LAS int*)(F.lds + UNITS_OFF);
    if (F.tid < 32) {
        const int nU = tbase[NE] * npn; const int L = F.tid * F.G + (int)blockIdx.x; int pm = 0, pn = 0, e = 0, valid = 0;
        if (L < nU) { const int seq = pg8::xcd_remap(L, nU); int ee = 0; while (ee < NE - 1 && seq >= tbase[ee + 1] * npn) ++ee;
            const int r = seq - tbase[ee] * npn, m = mt[ee]; const int grp = r / (m * gpn), r2 = r % (m * gpn);
            e = ee; pn = grp * gpn + r2 / m; pm = tbase[ee] + r2 % m; valid = 1; }
        units[4 * F.tid + 0] = pm; units[4 * F.tid + 1] = pn; units[4 * F.tid + 2] = e; units[4 * F.tid + 3] = valid;
    }
    __syncthreads();
}

__device__ __forceinline__ void moe_gather_tables(Frame& F) {
    LAS int* tab = (LAS int*)(F.lds + TAB_OFF); LAS int* cnt = tab, * tbase = tab + 64; LAS int* units = (LAS int*)(F.lds + UNITS_OFF); LAS int* tokmap = (LAS int*)(F.lds + TOKMAP_OFF);
    const float* gates = (const float*)(F.ws + WS_GATES); const int* lists = (const int*)(F.ws + WS_LISTS); const float* RS = (const float*)(F.ws + WS_RSTD); int* rowinfo = (int*)(F.ws + WS_ROWINFO);
    for (int idx = F.tid; idx < TOKMAP_SLOTS * 256; idx += NWAVES * 64) { const int i = idx >> 8, R = idx & 255; int tk = 0;
        if (units[4 * i + 3]) { const int pm = units[4 * i], e = units[4 * i + 2]; const int li = (pm - tbase[e]) * 256 + R;
            v4u ri = (v4u){0xffffffffu, 0u, 0u, 0u};
            if (li < cnt[e]) { const int slot = lists[e * M + li]; tk = slot >> 2; ri = (v4u){(unsigned)slot, __builtin_bit_cast(unsigned, gates[slot]), __builtin_bit_cast(unsigned, RS[tk]), 0u}; }
            *(v4u*)(rowinfo + 4 * (pm * 256 + R)) = ri; }
        tokmap[idx] = tk; }
    asm volatile("s_waitcnt vmcnt(0)" ::: "memory");
    __syncthreads();
}

__device__ __forceinline__ void final_phase(Frame& F) {
    const bf16* YB = (const bf16*)(F.ws + WS_YBUF); const float* gf = F.in[24]; float* O = F.out;
    const int gw = F.vcu * NWAVES + F.wave, NGW = F.G * NWAVES, lane = F.lane;
    f32x4 gg[4];
#pragma unroll
    for (int j = 0; j < 4; ++j) gg[j] = *(const f32x4*)(gf + 4 * lane + 256 * j);
    for (int m = gw; m < M; m += NGW) {
        f32x4 v[4]; float ss = 0.f;
#pragma unroll
        for (int j = 0; j < 4; ++j) { { const v2u xw = *(const v2u*)(x1_row(F.ws, m) + 4 * lane + 256 * j); v[j] = (f32x4){bflo(xw.x), bfhi(xw.x), bflo(xw.y), bfhi(xw.y)}; }
#pragma unroll
            for (int k = 0; k < (DBG_MODE ? 0 : TOPK); ++k) { const v2u w = *(const v2u*)(YB + ((size_t)m * TOPK + k) * D + 4 * lane + 256 * j); v[j].x += bflo(w.x); v[j].y += bfhi(w.x); v[j].z += bflo(w.y); v[j].w += bfhi(w.y); }
            ss += (v[j].x * v[j].x + v[j].y * v[j].y) + (v[j].z * v[j].z + v[j].w * v[j].w); }
        const float rstd = 1.0f / sqrtf(wave_sum(ss) * (1.f / D) + EPS);
#pragma unroll
        for (int j = 0; j < 4; ++j) *(f32x4*)(O + (size_t)m * D + 4 * lane + 256 * j) = v[j] * rstd * gg[j];
    }
}

struct Args { const float* in[25]; float* out; unsigned char* ws; int ph_lo, ph_hi, li, pad; };
__global__ void __launch_bounds__(NWAVES * 64, 2) hyb_fwd(Args args) {
    extern __shared__ __attribute__((aligned(16))) unsigned char lds[];
    Frame F;
    F.lds = (LAS unsigned char*)lds;
    F.MISC = (volatile LAS unsigned*)(F.lds + MISC_OFF);
    F.tid = threadIdx.x; F.lane = F.tid & 63; F.wave = __builtin_amdgcn_readfirstlane(F.tid >> 6);
    F.G = gridDim.x; { const int bx = blockIdx.x; F.vcu = (F.G % 8 == 0) ? (bx % 8) * (F.G / 8) + bx / 8 : bx; }
    F.ws = args.ws; F.ctl = (gu32*)(args.ws + WS_CTL); F.out = args.out;
#pragma unroll
    for (int i = 0; i < 25; ++i) F.in[i] = args.in[i];
    for (int u = F.tid; u < (LDS_BYTES - LDSCTL_OFF) / 4; u += NWAVES * 64) ((LAS unsigned*)(F.lds + LDSCTL_OFF))[u] = 0u;
    __syncthreads();
    XcdBarrier bar; bar.bar = (unsigned*)(F.ctl + CW_BAR); bar.x = 0; bar.st = nullptr; bar.G = gridDim.x;
    if (N_LAUNCHES != PER_PHASE) bar = xcd_barrier_post((unsigned*)(F.ctl + CW_BAR), F.MISC + 8, gridDim.x);
#define GRID_BAR(seam) do { if (N_LAUNCHES == PER_PHASE) { if (F.tid == 0) __hip_atomic_store(F.ctl + CW_TMO, 0xBADBA0u | (unsigned)(seam), RLX_AGENT); } else { xcd_barrier(bar); } } while (0)
    const int lo = args.ph_lo, hi = args.ph_hi;
#define IN(k) (lo <= (k) && (k) < hi)
#define BOTH(k) (IN(k) && IN((k) + 1))
    const pg8::bf16_t* wsb = (const pg8::bf16_t*)args.ws;
#define WSB(off) ((const pg8::bf16_t*)(args.ws + (off)))

    unsigned long long t_lo_ = 0, t_hi_ = 0;
    TMARK(0);
    if (IN(0)) {   }

    TMARK(1);
    if (IN(1)) for (int rep_ = 0; rep_ < NREP(1); ++rep_) {
        const int bx = (int)blockIdx.x; const bool gemm_wg = bx < P1_GEMM_WG;
        pg8::Gemm g = pg8::make_gemm(WSB(WS_HN), WSB(WS_WINT), D, D, D); InProjOrder S{P1_GEMM_WG, gemm_wg ? bx : 512};
        EpiInProj E{(unsigned short*)(args.ws + WS_Q), (bf16*)(args.ws + WS_UCAT), LOG2E * 0.125f};
        if (gemm_wg) { XcdBarrier bar2 = xcd_barrier_post((unsigned*)(F.ctl + CW_BAR2), F.MISC + 10, (unsigned)P1_GEMM_WG);
            p0_prologue(F, t_lo_, t_hi_);
            xcd_barrier(bar2); }
        pg8::gemm_phase<EpiInProj, InProjOrder, PG8_ALIGN, PG8_SP2>(F.lds + RING_OFF, g, S, E);
        if (gemm_wg && F.tid == 0) __hip_atomic_fetch_add((unsigned*)(F.ctl + CW_DONE1), 1u, RLX_AGENT);
        p1_side(F, (bx >= P1_GEMM_WG && bx < P1_GEMM_WG + NG) ? bx - P1_GEMM_WG : -1);
        if (BOTH(1)) GRID_BAR(1);
    }
    TMARK(2);
    if (IN(2)) for (int rep_ = 0; rep_ < NREP(2); ++rep_) {
        const int bx = (int)blockIdx.x;
        if (bx < NG * 4) {
            XcdBarrier bar3 = xcd_barrier_post((unsigned*)(F.ctl + CW_BAR3), F.MISC + 12, (unsigned)(NG * 4));
            if (bx < NG * 2) { pg8::Gemm g = pg8::make_gemm(WSB(WS_UCAT), WSB(WS_WE), NG * UK, 512, 512); SsmOrder S{NG * 2, F.G, bx, 1, 128, 512};
                EpiSloc E{(float*)(args.ws + WS_SLOC)};
                pg8::gemm_phase<EpiSloc, SsmOrder, PG8_ALIGN, PG8_SP2>(F.lds + RING_OFF, g, S, E); }
            else attn_one(F, (bx - NG * 2) * 8 + F.wave);
            xcd_barrier(bar3);
            if (bx < NG * 2) { scan_phase(F, bx); q1_drain(F, 1, nullptr, 0u); } else attn_one(F, 512 + (bx - NG * 2) * 8 + F.wave);
            xcd_barrier(bar3);
            { pg8::Gemm g = pg8::make_gemm(WSB(WS_UCAT), WSB(WS_TW), NG * UK, UK, UK); SsmOrder S{NG * 4, F.G, bx, 2, 512, UK};
              EpiS3 E{(bf16*)(args.ws + WS_YG)};
              pg8::gemm_phase<EpiS3, SsmOrder, PG8_ALIGN, PG8_SP2>(F.lds + RING_OFF, g, S, E); }
        } else {
            const int w = (bx - NG * 4) * 8 + F.wave;
#pragma unroll 1
            for (int j = 0; j < 3; ++j) attn_one(F, 1024 + w + 1024 * j);
            q1_drain(F, 1, nullptr, 0u);
        }
        if (BOTH(4)) GRID_BAR(4);
    }
    TMARK(3); TMARK(4);
    TMARK(5);
    if (IN(5)) for (int rep_ = 0; rep_ < NREP(5); ++rep_) {
        pg8::Gemm g = pg8::make_gemm(WSB(WS_YG), WSB(WS_WGLUT), SSW, SSW, SSW); pg8::StaticOrder S; S.init(M, 2 * SSW, F.G, (int)blockIdx.x, SSW, SSW);
        EpiGlu E{(bf16*)(args.ws + WS_YCAT), (float*)(args.ws + WS_SSQSSM)};
        pg8::gemm_phase<EpiGlu, pg8::StaticOrder, PG8_ALIGN, PG8_SP2>(F.lds + RING_OFF, g, S, E);
        if (BOTH(5)) GRID_BAR(5);
    }
    TMARK(6);
    if (IN(6)) {   }
    TMARK(7);
    if (IN(7)) for (int rep_ = 0; rep_ < NREP(7); ++rep_) {
        pg8::Gemm g = pg8::make_gemm(WSB(WS_YCAT), WSB(WS_WOUTT), D, D, D); pg8::StaticOrder S; S.init(M, D, F.G, (int)blockIdx.x, D, D);
        LAS float* rtab = (LAS float*)(F.lds + TOKMAP_OFF);
        { pg8::Unit u0; if (S.next(0, u0) && F.tid < 256) { const int row = u0.pm * 256 + F.tid; const float* pa = (const float*)(args.ws + WS_SSQSB) + (size_t)row * NH; const float* pb = (const float*)(args.ws + WS_SSQSSM) + (size_t)row * 16;
              float sa = 0.f, sb = 0.f;
#pragma unroll
              for (int i = 0; i < NH; ++i) sa += pa[i];
#pragma unroll
              for (int i = 0; i < 16; ++i) sb += pb[i];
              const float ra = 1.0f / sqrtf(sa * (1.f / SBW) + EPS), rb = 1.0f / sqrtf(sb * (1.f / SSW) + EPS); rtab[F.tid] = ra / rb; rtab[256 + F.tid] = rb; }
          __syncthreads(); }
        EpiOutProj E{F.in[0], args.ws, rtab, rtab + 256};
        pg8::gemm_phase<EpiOutProj, pg8::StaticOrder, PG8_ALIGN, PG8_SP2>(F.lds + RING_OFF, g, S, E);
        if (BOTH(7)) GRID_BAR(7);
    }
    TMARK(8);
    if (IN(8) && !DBG_MODE) for (int rep_ = 0; rep_ < NREP(8); ++rep_) { router_phase(F); q1_drain(F, -1, nullptr, 0u);
        if (BOTH(8)) GRID_BAR(8); }
    TMARK(9);
    if (IN(9) && !DBG_MODE) for (int rep_ = 0; rep_ < NREP(9); ++rep_) {   }
    TMARK(10);
    if (IN(10) && !DBG_MODE) for (int rep_ = 0; rep_ < NREP(10); ++rep_) {
        moe_tables(F); moe_units(F, 8, 4); moe_gather_tables(F);
        pg8::Gemm g = pg8::make_gemm(WSB(WS_XN), WSB(WS_W1T), D / 2, D, D); g.brs = 16u; g.bks = 2u * FF * 16u; g.tokmap = (const PG8_LAS int*)(F.lds + TOKMAP_OFF);
        MoeOrder S{(const LAS int*)(F.lds + UNITS_OFF), (long)2 * FF * D, 1};
        EpiMoe1 E{args.ws + WS_H, F.in[19], F.in[21], (const int*)(args.ws + WS_ROWINFO)};
        pg8::gemm_phase<EpiMoe1, MoeOrder, PG8_ALIGN, PG8_SP2, true, MOE1_MODE>(F.lds + RING_OFF, g, S, E);
        w2_drain(F, -1);
        if (BOTH(10)) GRID_BAR(10);
    }
    TMARK(11);
    if (IN(11) && !DBG_MODE) for (int rep_ = 0; rep_ < NREP(11); ++rep_) {
        moe_tables(F); moe_units(F, 4, 4);
        pg8::Gemm g = pg8::make_gemm(WSB(WS_H), WSB(WS_W2T), FF / 2, FF, FF); g.brs = 16u; g.bks = (unsigned)D * 16u; MoeOrder S{(const LAS int*)(F.lds + UNITS_OFF), (long)D * FF, 0};
        EpiMoe2 E{(bf16*)(args.ws + WS_YBUF), F.in[23], (const int*)(args.ws + WS_ROWINFO)};
        pg8::gemm_phase<EpiMoe2, MoeOrder, PG8_ALIGN, PG8_SP2, false, MOE2_MODE>(F.lds + RING_OFF, g, S, E);
        if (BOTH(11)) GRID_BAR(11);
    }
    TMARK(12);
    if (IN(12)) for (int rep_ = 0; rep_ < NREP(12); ++rep_) { final_phase(F); }
    TMARK(13);
    if ((TIME_LO) >= 0 && blockIdx.x == (TIME_BLK) && F.tid == 0) { const unsigned long long te = __builtin_amdgcn_s_memrealtime(), dt = 4ull * (t_hi_ - t_lo_); while (__builtin_amdgcn_s_memrealtime() - te < dt) __builtin_amdgcn_s_sleep(32); }
    (void)wsb;
#undef IN
#undef BOTH
}

extern "C" void kernel_launch(void* const* d_in, const int* in_sizes, int n_in, void* d_out, int out_size, void* d_ws, size_t ws_size, hipStream_t stream) {
    static int grid = 0;
    if (grid == 0) {
        if (n_in != 25 || in_sizes[0] != M * D || out_size != M * D || ws_size < WS_END) { fprintf(stderr, "kernel_launch: unexpected shapes: n_in %d in0 %d out %d ws %zu (need %zu); nothing launched\n", n_in, n_in > 0 ? in_sizes[0] : -1, out_size, ws_size, (size_t)WS_END); grid = -1; return; }
        int dev = 0, cus = 0, per_cu = 0;
        if (hipGetDevice(&dev) != hipSuccess || hipDeviceGetAttribute(&cus, hipDeviceAttributeMultiprocessorCount, dev) != hipSuccess) { grid = -1; return; }
        if (hipFuncSetAttribute((const void*)hyb_fwd, hipFuncAttributeMaxDynamicSharedMemorySize, LDS_BYTES) != hipSuccess) { fprintf(stderr, "kernel_launch: hipFuncSetAttribute failed\n"); grid = -1; return; }
        if (hipOccupancyMaxActiveBlocksPerMultiprocessor(&per_cu, (const void*)hyb_fwd, NWAVES * 64, LDS_BYTES) != hipSuccess || per_cu < 1)
            fprintf(stderr, "kernel_launch: note: occupancy query reports %d workgroups per CU\n", per_cu);
        (void)hipGetLastError();
        grid = cus;
        if (grid != 256) fprintf(stderr, "kernel_launch: note: %d CUs (built for 256)\n", grid);
    }
    if (grid < 0) return;
    if (hipMemsetAsync((char*)d_ws + WS_CTL, 0, CTL_ZERO_BYTES, stream) != hipSuccess) { fprintf(stderr, "kernel_launch: memset failed\n"); return; }
    Args a{};
    for (int i = 0; i < 25; ++i) a.in[i] = (const float*)d_in[i];
    a.out = (float*)d_out; a.ws = (unsigned char*)d_ws;
    for (int li = 0; li < N_LAUNCHES; ++li) {
        a.ph_lo = (N_LAUNCHES == PER_PHASE) ? li : 0; a.ph_hi = (N_LAUNCHES == PER_PHASE) ? li + 1 : PER_PHASE; a.li = li;
        hipLaunchKernelGGL(hyb_fwd, dim3(grid), dim3(NWAVES * 64), LDS_BYTES, stream, a);
        const hipError_t le = hipPeekAtLastError();
        if (le != hipSuccess) { fprintf(stderr, "kernel_launch: launch %d failed: %s\n", li, hipGetErrorName(le)); break; }
    }
}
```

```cpp
#include <hip/hip_runtime.h>
#include <cstdio>
#include <cstdint>
namespace pg8 {
#define PG8_LAS __attribute__((address_space(3)))
typedef unsigned short bf16_t;
typedef short bf16x8 __attribute__((ext_vector_type(8)));
typedef float f32x4 __attribute__((ext_vector_type(4)));
typedef unsigned u32x4 __attribute__((ext_vector_type(4)));
typedef long l64x2 __attribute__((ext_vector_type(2)));
typedef int i32x4 __attribute__((ext_vector_type(4)));
typedef int i32x8 __attribute__((ext_vector_type(8)));
constexpr int BM = 256, BK = 64, HALF = 128, HTB = HALF * BK * 2  , STAGE_BYTES = 8 * HTB, NXCD = 8, WGM = 8;

__host__ __device__ __forceinline__ int lds_byte(int r, int c) { const int st = (r >> 4) * 2 + (c >> 5), rr = r & 15, cc = c & 31, ob = rr * 64 + cc * 2; return st * 1024 + (ob ^ (((ob >> 9) & 1) << 5)); }
__host__ __device__ __forceinline__ void stage_rc(int b, int& R, int& C) { const int st = b / 1024, sb = b % 1024, swz = sb ^ (((sb >> 9) & 1) << 5); R = (st >> 1) * 16 + swz / 64; C = (st & 1) * 32 + (swz % 64) / 2; }
__host__ __device__ __forceinline__ int perm32(int rho) { const int n = rho >> 4, i = rho & 15; return 8 * (i >> 2) + 4 * n + (i & 3); }

struct Unit { int pm, pn, e, slot; long offA, offB; };
struct Gemm { const bf16_t* A; const bf16_t* Bt; int lda, K; unsigned brs, bks; const PG8_LAS int* tokmap; };
__host__ __device__ __forceinline__ Gemm make_gemm(const bf16_t* A, const bf16_t* Bt, int lda, int ldb, int K) { Gemm g; g.A = A; g.Bt = Bt; g.lda = lda; g.K = K; g.brs = (unsigned)ldb * 2u; g.bks = 16u; g.tokmap = nullptr; return g; }

__host__ __device__ __forceinline__ int xcd_remap(int wgid, int nwg) { const int q = nwg / NXCD, r = nwg % NXCD, xcd = wgid % NXCD, off = wgid / NXCD; return (xcd < r ? xcd * (q + 1) : r * (q + 1) + (xcd - r) * q) + off; }

struct StaticOrder {
    int nM, nN, nwg, G, c, lda, ldb;
    __host__ __device__ void init(int M, int N, int G_, int c_, int lda_, int ldb_) { nM = M / BM; nN = N / BM; nwg = nM * nN; G = G_; c = c_; lda = lda_; ldb = ldb_; }
    __host__ __device__ __forceinline__ bool next(int i, Unit& u) const {
        const long L = (long)i * G + c; if (L >= nwg) return false;
        const int wgid = xcd_remap((int)L, nwg);
        const int nig = WGM * nN, gid = wgid / nig, fm = gid * WGM, gsz = (nM - fm) < WGM ? (nM - fm) : WGM;
        u.pm = fm + ((wgid % nig) % gsz); u.pn = (wgid % nig) / gsz; u.e = 0; u.slot = 0;
        u.offA = (long)u.pm * BM * lda * 2; u.offB = (long)u.pn * BM * ldb * 2; return true;
    }
    __device__ __forceinline__ void a_ready(const Unit&) const {}
    __device__ __forceinline__ void done(const Unit&) const {}
};

__device__ __forceinline__ unsigned cvt_pk_bf16(float lo, float hi) { unsigned r; asm volatile("v_cvt_pk_bf16_f32 %0, %1, %2" : "=v"(r) : "v"(lo), "v"(hi)); return r; }
typedef float f32x2 __attribute__((ext_vector_type(2)));

template <class Epi, class Sched, bool ALIGN_EPI = false, bool SP2 = false, bool GATHER = false, int FP8 = 0>
__device__ __forceinline__ void gemm_phase(PG8_LAS unsigned char* lds, const Gemm g, const Sched& S, const Epi& E) {
    static_assert(!GATHER || SP2, "the gather form is written for the two-super-phase loop only");
    const int tid = threadIdx.x, wid = __builtin_amdgcn_readfirstlane(tid >> 6), lane = tid & 63, wr = wid >> 2, wc = wid & 3, fr = lane & 15, fq = lane >> 4;
    const int K = g.K, nt = K / (FP8 ? 2 * BK : BK);
    unsigned voffA[2], voffB[2]; int RA[2];
#pragma unroll
    for (int i = 0; i < 2; ++i) { int R, C; stage_rc(tid * 16 + i * 8192, R, C); const int Rb = Epi::PERM ? ((R & ~31) + perm32(R & 31)) : R; RA[i] = R;
        voffA[i] = GATHER ? (unsigned)C * 2u : (unsigned)(R * g.lda + C) * 2u; voffB[i] = (unsigned)Rb * g.brs + (unsigned)(C >> 3) * g.bks; }
    const size_t kstepA = (size_t)(BK * 2), kstepB = (size_t)8 * g.bks;
    const size_t hstepA = (size_t)HALF * g.lda * 2, hstepB = (size_t)HALF * g.brs;
    const unsigned ldsw = (unsigned)wid * 1024u;
    const int aoff = lds_byte(wr * 64 + fr, fq * 8), boff = lds_byte(wc * 32 + fr, fq * 8);
#define PG8_SA(b, h) (((b) * 2 + (h)) * HTB)
#define PG8_SB(b, h) ((4 + (b) * 2 + (h)) * HTB)
#define PG8_STAGE(bufoff, gbase, voff) do { _Pragma("unroll") for (int _i = 0; _i < 2; ++_i) \
        __builtin_amdgcn_global_load_lds((const unsigned*)((const char*)(gbase) + (voff)[_i]), (PG8_LAS unsigned*)(lds + (bufoff) + ldsw + _i * 8192), 16, 0, 0); } while (0)
    unsigned ga[2][2], gn[2][2], gw[2][2];
#define PG8_GLOAD(dst, u) do { if constexpr (GATHER) { const PG8_LAS int* _tm = g.tokmap + 256 * (u).slot; _Pragma("unroll") for (int _h = 0; _h < 2; ++_h) _Pragma("unroll") for (int _i = 0; _i < 2; ++_i) \
        dst[_h][_i] = (unsigned)_tm[128 * _h + RA[_i]] * (unsigned)(g.lda * 2) + voffA[_i]; } } while (0)
#define PG8_STAGE_A(bufoff, gbase, half, GX) do { if constexpr (GATHER) { PG8_STAGE(bufoff, gbase, GX[half]); } else { PG8_STAGE(bufoff, (gbase) + (half) * hstepA, voffA); } } while (0)
#define PG8_LDA(dst, b, h) do { _Pragma("unroll") for (int m = 0; m < 4; ++m) { if constexpr (FP8 == 2) { dst##8[m].lo = *(const PG8_LAS i32x4*)(lds + PG8_SA(b, h) + aoff + m * 2048); dst##8[m].hi = *(const PG8_LAS i32x4*)(lds + PG8_SA(b, h) + aoff + m * 2048 + 1024); } \
        else { _Pragma("unroll") for (int k = 0; k < 2; ++k) dst[m][k] = *(const PG8_LAS bf16x8*)(lds + PG8_SA(b, h) + aoff + m * 2048 + k * 1024); } } } while (0)
#define PG8_LDB(dst, b, h) do { _Pragma("unroll") for (int n = 0; n < 2; ++n) { if constexpr (FP8 == 2) { dst##8[n].lo = *(const PG8_LAS i32x4*)(lds + PG8_SB(b, h) + boff + n * 2048); dst##8[n].hi = *(const PG8_LAS i32x4*)(lds + PG8_SB(b, h) + boff + n * 2048 + 1024); } \
        else { _Pragma("unroll") for (int k = 0; k < 2; ++k) dst[n][k] = *(const PG8_LAS bf16x8*)(lds + PG8_SB(b, h) + boff + n * 2048 + k * 1024); } } } while (0)
#define PG8_MMA(ai, bj, At, Bt) do { __builtin_amdgcn_s_setprio(1); \
        if constexpr (FP8 == 2) { _Pragma("unroll") for (int m = 0; m < 4; ++m) _Pragma("unroll") for (int n = 0; n < 2; ++n) \
            acc[ai][bj][m][n] = __builtin_amdgcn_mfma_scale_f32_16x16x128_f8f6f4(Bt##8[n], At##8[m], acc[ai][bj][m][n], 0, 0, 0, 0x7f7f7f7f, 0, 0x7f7f7f7f); } \
        else if constexpr (FP8 == 1) { _Pragma("unroll") for (int k = 0; k < 2; ++k) _Pragma("unroll") for (int hf = 0; hf < 2; ++hf) _Pragma("unroll") for (int m = 0; m < 4; ++m) _Pragma("unroll") for (int n = 0; n < 2; ++n) { \
            const l64x2 _a = __builtin_bit_cast(l64x2, At[m][k]), _b = __builtin_bit_cast(l64x2, Bt[n][k]); const long _a0 = hf ? _a.y : _a.x, _b0 = hf ? _b.y : _b.x; \
            acc[ai][bj][m][n] = __builtin_amdgcn_mfma_f32_16x16x32_fp8_fp8(_b0, _a0, acc[ai][bj][m][n], 0, 0, 0); } } \
        else { _Pragma("unroll") for (int m = 0; m < 4; ++m) _Pragma("unroll") for (int n = 0; n < 2; ++n) _Pragma("unroll") for (int k = 0; k < 2; ++k) \
            acc[ai][bj][m][n] = __builtin_amdgcn_mfma_f32_16x16x32_bf16(Bt[n][k], At[m][k], acc[ai][bj][m][n], 0, 0, 0); } __builtin_amdgcn_s_setprio(0); } while (0)
#define PG8_WAIT_V(n) asm volatile("s_waitcnt vmcnt(" #n ")" ::: "memory")
#define PG8_WAIT_L(n) asm volatile("s_waitcnt lgkmcnt(" #n ")" ::: "memory")
#define PG8_BAR __builtin_amdgcn_s_barrier()
#define PG8_SCHED __builtin_amdgcn_sched_barrier(0)
    Unit cur, nxt; int ui = 0;
    if (!S.next(0, cur)) return;
    f32x4 acc[2][2][4][2];
#pragma unroll
    for (int a = 0; a < 2; ++a)
#pragma unroll
        for (int b = 0; b < 2; ++b)
#pragma unroll
            for (int m = 0; m < 4; ++m)
#pragma unroll
                for (int n = 0; n < 2; ++n) acc[a][b][m][n] = (f32x4){0.f, 0.f, 0.f, 0.f};
    bf16x8 At[4][2], B0[2][2], B1[2][2];
    i32x8 At8[4], B08[2], B18[2];
    const char* cA = (const char*)g.A + cur.offA; const char* cB = (const char*)g.Bt + cur.offB;
    S.a_ready(cur);
    if constexpr (SP2) {
        PG8_GLOAD(ga, cur);
        PG8_STAGE(PG8_SB(0, 0), cB, voffB); PG8_STAGE(PG8_SB(0, 1), cB + hstepB, voffB); PG8_STAGE_A(PG8_SA(0, 0), cA, 0, ga); PG8_STAGE_A(PG8_SA(0, 1), cA, 1, ga);
        if (wr == 1) PG8_BAR;
        PG8_WAIT_V(2); PG8_BAR;
        PG8_STAGE(PG8_SB(1, 0), cB + kstepB, voffB); PG8_STAGE_A(PG8_SA(1, 0), cA + kstepA, 0, ga); PG8_STAGE(PG8_SB(1, 1), cB + hstepB + kstepB, voffB);
        PG8_WAIT_V(6); PG8_BAR;
    } else {
        PG8_STAGE(PG8_SB(0, 0), cB, voffB); PG8_STAGE(PG8_SA(0, 0), cA, voffA); PG8_STAGE(PG8_SB(0, 1), cB + hstepB, voffB); PG8_STAGE(PG8_SA(0, 1), cA + hstepA, voffA);
        if (wr == 1) PG8_BAR;
        PG8_WAIT_V(4); PG8_BAR;
        PG8_STAGE(PG8_SB(1, 0), cB + kstepB, voffB); PG8_STAGE(PG8_SA(1, 0), cA + kstepA, voffA); PG8_STAGE(PG8_SB(1, 1), cB + hstepB + kstepB, voffB);
        PG8_WAIT_V(6); PG8_BAR;
    }
    for (;;) {
        const bool has_next = S.next(ui + 1, nxt);
        if constexpr (GATHER) { if (has_next) { PG8_GLOAD(gn, nxt); } else { _Pragma("unroll") for (int _h = 0; _h < 2; ++_h) _Pragma("unroll") for (int _i = 0; _i < 2; ++_i) gn[_h][_i] = ga[_h][_i]; } }
        const char* nA = has_next ? (const char*)g.A + nxt.offA : cA; const char* nB = has_next ? (const char*)g.Bt + nxt.offB : cB;
        for (int t = 0; t < nt; t += 2) {
            const bool last = (t == nt - 2);
            const char* a1 = cA + (size_t)(t + 1) * kstepA;
            const char* a2 = last ? nA : cA + (size_t)(t + 2) * kstepA; const char* b2 = last ? nB : cB + (size_t)(t + 2) * kstepB;
            const char* a3 = a2 + kstepA; const char* b3 = b2 + kstepB;
            if (last && has_next) S.a_ready(nxt);
            if constexpr (GATHER) { _Pragma("unroll") for (int _h = 0; _h < 2; ++_h) _Pragma("unroll") for (int _i = 0; _i < 2; ++_i) gw[_h][_i] = last ? gn[_h][_i] : ga[_h][_i]; }
            if constexpr (Epi::MIDK) { if (t == nt / 2) E.mid(acc, cur, wr, wc, fr, fq); }
            if constexpr (SP2) {
            PG8_LDB(B0, 0, 0); PG8_LDB(B1, 0, 1); PG8_SCHED; PG8_LDA(At, 0, 0); PG8_STAGE_A(PG8_SA(1, 1), a1, 1, ga);
            PG8_WAIT_V(8); PG8_WAIT_L(0); PG8_BAR; PG8_MMA(0, 0, At, B0); PG8_MMA(0, 1, At, B1); PG8_BAR; PG8_SCHED;
            PG8_LDA(At, 0, 1); PG8_STAGE(PG8_SB(0, 0), b2, voffB); PG8_STAGE(PG8_SB(0, 1), b2 + hstepB, voffB); PG8_STAGE_A(PG8_SA(0, 0), a2, 0, gw);
            PG8_WAIT_V(8); PG8_WAIT_L(0); PG8_BAR; PG8_MMA(1, 0, At, B0); PG8_MMA(1, 1, At, B1); PG8_BAR; PG8_SCHED;
            PG8_LDB(B0, 1, 0); PG8_LDB(B1, 1, 1); PG8_SCHED; PG8_LDA(At, 1, 0); PG8_STAGE_A(PG8_SA(0, 1), a2, 1, gw);
            PG8_WAIT_V(8); PG8_WAIT_L(0); PG8_BAR; PG8_MMA(0, 0, At, B0); PG8_MMA(0, 1, At, B1); PG8_BAR; PG8_SCHED;
            PG8_LDA(At, 1, 1); PG8_STAGE(PG8_SB(1, 0), b3, voffB); PG8_STAGE(PG8_SB(1, 1), b3 + hstepB, voffB); PG8_STAGE_A(PG8_SA(1, 0), a3, 0, gw);
            PG8_WAIT_V(8); PG8_WAIT_L(0); PG8_BAR; PG8_MMA(1, 0, At, B0); PG8_MMA(1, 1, At, B1); PG8_BAR; PG8_SCHED;
            } else {
            PG8_LDB(B0, 0, 0); PG8_SCHED; PG8_LDA(At, 0, 0); PG8_STAGE(PG8_SA(1, 1), a1 + hstepA, voffA);
            PG8_WAIT_L(8); PG8_BAR; PG8_WAIT_L(0); PG8_MMA(0, 0, At, B0); PG8_BAR; PG8_SCHED;
            PG8_LDB(B1, 0, 1); PG8_STAGE(PG8_SB(0, 0), b2, voffB);
            PG8_BAR; PG8_WAIT_L(0); PG8_MMA(0, 1, At, B1); PG8_BAR;
            PG8_LDA(At, 0, 1); PG8_STAGE(PG8_SA(0, 0), a2, voffA);
            PG8_BAR; PG8_WAIT_L(0); PG8_MMA(1, 0, At, B0); PG8_BAR; PG8_SCHED;
            PG8_STAGE(PG8_SB(0, 1), b2 + hstepB, voffB);
            PG8_WAIT_V(6); PG8_BAR; PG8_MMA(1, 1, At, B1); PG8_BAR;
            PG8_LDB(B0, 1, 0); PG8_SCHED; PG8_LDA(At, 1, 0); PG8_STAGE(PG8_SA(0, 1), a2 + hstepA, voffA);
            PG8_WAIT_L(8); PG8_BAR; PG8_WAIT_L(0); PG8_MMA(0, 0, At, B0); PG8_BAR; PG8_SCHED;
            PG8_LDB(B1, 1, 1); PG8_STAGE(PG8_SB(1, 0), b3, voffB);
            PG8_BAR; PG8_WAIT_L(0); PG8_MMA(0, 1, At, B1); PG8_BAR;
            PG8_LDA(At, 1, 1); PG8_STAGE(PG8_SA(1, 0), a3, voffA);
            PG8_BAR; PG8_WAIT_L(0); PG8_MMA(1, 0, At, B0); PG8_BAR; PG8_SCHED;
            PG8_STAGE(PG8_SB(1, 1), b3 + hstepB, voffB);
            PG8_WAIT_V(6); PG8_BAR; PG8_MMA(1, 1, At, B1); PG8_BAR;
            }
        }
        if constexpr (ALIGN_EPI) { if (wr == 0) PG8_BAR; }
        if constexpr (!Epi::AFTER_DRAIN) { E(acc, cur, wr, wc, fr, fq); S.done(cur); }
        if (!has_next) break;
#pragma unroll
        for (int a = 0; a < 2; ++a)
#pragma unroll
            for (int b = 0; b < 2; ++b)
#pragma unroll
                for (int m = 0; m < 4; ++m)
#pragma unroll
                    for (int n = 0; n < 2; ++n) acc[a][b][m][n] = (f32x4){0.f, 0.f, 0.f, 0.f};
        cur = nxt; cA = nA; cB = nB; ++ui;
        if constexpr (GATHER) { _Pragma("unroll") for (int _h = 0; _h < 2; ++_h) _Pragma("unroll") for (int _i = 0; _i < 2; ++_i) ga[_h][_i] = gn[_h][_i]; }
        if constexpr (ALIGN_EPI) { if (wr == 1) PG8_BAR; }
    }
    PG8_WAIT_V(0);
    if constexpr (!ALIGN_EPI) { if (wr == 0) PG8_BAR; }
    PG8_BAR;
    if constexpr (Epi::AFTER_DRAIN) { E.fused(acc, cur, wr, wc, fr, fq, lds, wid, lane); S.done(cur); }
#undef PG8_SA
#undef PG8_SB
#undef PG8_STAGE
#undef PG8_STAGE_A
#undef PG8_GLOAD
#undef PG8_LDA
#undef PG8_LDB
#undef PG8_MMA
#undef PG8_WAIT_V
#undef PG8_WAIT_L
#undef PG8_BAR
#undef PG8_SCHED
}
}

#ifndef PG8_SP2
#define PG8_SP2 true
#endif
#ifndef PG8_ALIGN
#define PG8_ALIGN true
#endif

constexpr int NWAVES = 8;
#ifndef MK_N_LAUNCHES
#define MK_N_LAUNCHES 1
#endif
#ifndef DBG_MODE
#define DBG_MODE 0
#endif
#ifndef REP_PHASE
#define REP_PHASE -1
#endif
#define NREP(k) ((REP_PHASE) == (k) ? 2 : 1)
#ifndef TIME_LO
#define TIME_LO -1
#endif
#ifndef TIME_HI
#define TIME_HI -1
#endif
#ifndef TIME_BLK
#define TIME_BLK 0
#endif
#define TMARK(j) do { if ((TIME_LO) >= 0 && blockIdx.x == (TIME_BLK) && F.tid == 0) { if ((j) == (TIME_LO)) t_lo_ = __builtin_amdgcn_s_memrealtime(); if ((j) == (TIME_HI)) t_hi_ = __builtin_amdgcn_s_memrealtime(); } } while (0)
constexpr int PER_PHASE = 13;
constexpr int N_LAUNCHES = MK_N_LAUNCHES;

constexpr int BATCH = 2, SEQ = 8192, D = 1024, M = BATCH * SEQ;
constexpr int SBW = 512, NH = 8, HD = 64;
constexpr int SSW = 512, NG = 32, GC = 16, NP = 64;
constexpr int NPROJ = 3 * SBW + SSW;
constexpr int LC = 32, NCHUNK = M / LC, CPB = SEQ / LC;
constexpr int UK = LC * GC + 2 * NP;
constexpr int NE = 32, TOPK = 4, FF = 1024, NASSIGN = M * TOPK;
constexpr int MAXTILES = (NASSIGN + NE * 255) / 256 + 1;
constexpr float EPS = 1e-5f;
constexpr float LOG2E = 1.4426950408889634f;

constexpr size_t MiB = 1u << 20;
constexpr size_t WS_CTL = 0, CTL_ZERO_BYTES = 128 * 1024;
constexpr size_t WS_LAML = 1 * MiB;
constexpr size_t WS_RSTD = 1 * MiB + 32 * 1024;
constexpr size_t WS_GATES = 1 * MiB + 128 * 1024;
constexpr size_t WS_ROWINFO = 1 * MiB + 512 * 1024;
constexpr size_t WS_RWIMG = 3 * MiB;
constexpr size_t WS_LISTS = 507 * MiB;
constexpr size_t WS_X1LO = 331 * MiB, WS_X1HI = 491 * MiB;
constexpr size_t WS_WINT = 4 * MiB, WS_WGLUT = 8 * MiB, WS_WOUTT = 9 * MiB, WS_W1T = 11 * MiB, WS_W2T = 139 * MiB;
constexpr size_t WS_R1 = 203 * MiB, WS_R2 = 347 * MiB, WS_END = 509 * MiB;
constexpr size_t WS_HN = WS_R1, WS_Q = WS_R1 + 32 * MiB, WS_K = WS_R1 + 48 * MiB, WS_V = WS_R1 + 64 * MiB, WS_UCAT = WS_R1 + 80 * MiB,
                 WS_SLOC = WS_R1 + 100 * MiB, WS_SSQSB = WS_R1 + 108 * MiB  , WS_SSQSSM = WS_R1 + 109 * MiB  , WS_YG = WS_R1 + 124 * MiB;
constexpr size_t WS_YBUF = WS_R1;
constexpr size_t WS_YCAT = WS_R2 + 16 * MiB  , WS_XN = WS_R1  , WS_WE = WS_R2 + 80 * MiB, WS_TW = WS_R2 + 85 * MiB;
constexpr size_t WS_H = WS_R2;
static_assert(WS_K == WS_Q + (size_t)M * SBW * 2 && WS_V == WS_K + (size_t)M * SBW * 2 && WS_YG + (size_t)M * SSW * 2 <= WS_R2 && WS_TW + (size_t)NG * 512 * UK * 2 <= WS_END, "ws map");
static_assert(WS_YBUF + (size_t)NASSIGN * D * 2 <= WS_X1LO && WS_H + (size_t)(MAXTILES - 1) * 256 * FF * 2 <= WS_END, "ws map 2");
static_assert(WS_ROWINFO + (size_t)MAXTILES * 256 * 16 <= 3 * MiB && WS_X1LO >= WS_YBUF + (size_t)NASSIGN * D * 2 && WS_X1LO + 16 * MiB <= WS_R2 && WS_X1HI >= WS_H + (size_t)(MAXTILES - 1) * 256 * FF * 2 && WS_X1HI + 16 * MiB <= WS_LISTS && WS_LISTS + (size_t)NE * M * 4 <= WS_END, "ws map 3");
constexpr int CW_TMO = 0, CW_CODE = 1;
constexpr int CW_BAR = 4096, CW_BAR2 = 8192, CW_BAR3 = 12288;
constexpr int CW_CNT = 16384;
constexpr int CW_Q0 = 16384 + 256, CW_Q1 = 16384 + 512, CW_Q2 = 16384 + 576;
constexpr int CW_DONE1 = 16384 + 640;
static_assert((16384 + 1024) * 4 <= (int)CTL_ZERO_BYTES, "control words inside the memset region");
constexpr int CW_AQ = 16384 + 320, CW_DONE2 = 16384 + 384, CW_DONE3 = 16384 + 448;

constexpr int RING_OFF = 0, RING_BYTES = 131072;
constexpr int RT_WSTR = 1028;
constexpr int RT_W_BYTES = 2 * NE * RT_WSTR * 2;
constexpr int RT_SCR_OFF = RT_W_BYTES;
constexpr int LDSCTL_OFF = 139264, MISC_OFF = LDSCTL_OFF + 320;
constexpr int TAB_OFF = LDSCTL_OFF + 512;
constexpr int UNITS_OFF = LDSCTL_OFF + 1024;
constexpr int TILEE_OFF = LDSCTL_OFF + 1536;
constexpr int TOKMAP_OFF = LDSCTL_OFF + 4096, TOKMAP_SLOTS = 10;
constexpr int LDS_BYTES = TOKMAP_OFF + TOKMAP_SLOTS * 1024;
static_assert(TILEE_OFF + MAXTILES * 4 <= LDS_BYTES && RT_SCR_OFF + 4096 <= LDSCTL_OFF, "LDS map");

#define GAS __attribute__((address_space(1)))
#define LAS __attribute__((address_space(3)))
typedef unsigned short bf16;
typedef unsigned v4u __attribute__((ext_vector_type(4)));
typedef unsigned v2u __attribute__((ext_vector_type(2)));
typedef float f32x4 __attribute__((ext_vector_type(4)));
typedef float f32x2 __attribute__((ext_vector_type(2)));
typedef _Float16 h16x2 __attribute__((ext_vector_type(2)));
typedef GAS unsigned gu32;
#define RLX_AGENT __ATOMIC_RELAXED, __HIP_MEMORY_SCOPE_AGENT
#define LDS_WAIT() asm volatile("s_waitcnt lgkmcnt(0)" ::: "memory")
#define VM_WAIT() asm volatile("s_waitcnt vmcnt(0)" ::: "memory")
__device__ __forceinline__ unsigned f2bf(float f) { unsigned u = __builtin_bit_cast(unsigned, f); return (u + 0x7fffu + ((u >> 16) & 1u)) >> 16; }
__device__ __forceinline__ unsigned pk2(float lo, float hi) { return f2bf(lo) | (f2bf(hi) << 16); }
__device__ __forceinline__ float bf2f(unsigned short b) { return __builtin_bit_cast(float, (unsigned)b << 16); }
__device__ __forceinline__ float bflo(unsigned w) { return __builtin_bit_cast(float, w << 16); }
__device__ __forceinline__ float bfhi(unsigned w) { return __builtin_bit_cast(float, w & 0xffff0000u); }
__device__ __forceinline__ unsigned pkh2(float lo, float hi) { h16x2 v; v.x = (_Float16)lo; v.y = (_Float16)hi; return __builtin_bit_cast(unsigned, v); }
__device__ __forceinline__ float fexp2(float x) { return __builtin_amdgcn_exp2f(x); }
__device__ __forceinline__ float flog2(float x) { return __builtin_amdgcn_logf(x); }
__device__ __forceinline__ float frcp(float x) { return __builtin_amdgcn_rcpf(x); }
__device__ __forceinline__ float sigmoidf_(float x) { return frcp(1.0f + fexp2(-LOG2E * x)); }
__device__ __forceinline__ float gelu_tanh(float v) { const float u = 0.7978845608028654f * (v + 0.044715f * v * v * v); return v * frcp(1.0f + fexp2(-2.0f * LOG2E * u)); }

__device__ __forceinline__ bf16* x1_row(unsigned char* ws, int m) { return (bf16*)(ws + (m < SEQ ? WS_X1LO : WS_X1HI - (size_t)SEQ * D * 2)) + (size_t)m * D; }
#ifndef MOE1_MODE
#define MOE1_MODE 1
#endif
#ifndef MOE2_MODE
#define MOE2_MODE 1
#endif
constexpr float WSCALE = 64.0f;
__device__ __forceinline__ float clamp448(float x) { return fminf(fmaxf(x, -448.0f), 448.0f); }
__device__ __forceinline__ unsigned pk4_fp8(float a, float b, float c, float d) {
    int w = __builtin_amdgcn_cvt_pk_fp8_f32(clamp448(a), clamp448(b), 0, false); w = __builtin_amdgcn_cvt_pk_fp8_f32(clamp448(c), clamp448(d), w, true); return (unsigned)w; }
#define XB_TMO      128
#define XB_XCNT(j)  (256  + 64 * (j))
#define XB_XSUB(j)  (1280 + 64 * (j))
#define XB_XGEN(j)  (2304 + 64 * (j))
#define XB_TOP      3328
#define XB_TOPGEN   3392
#define XCD_BAR_WORDS 3456
#define XB_SPIN_CAP (1u << 18)
__device__ __forceinline__ unsigned xb_ld(unsigned* p)              { return __hip_atomic_load(p, __ATOMIC_RELAXED, __HIP_MEMORY_SCOPE_AGENT); }
__device__ __forceinline__ unsigned xb_add(unsigned* p, unsigned v) { return __hip_atomic_fetch_add(p, v, __ATOMIC_RELAXED, __HIP_MEMORY_SCOPE_AGENT); }
__device__ __forceinline__ unsigned xb_xcc_id() { return (unsigned)__builtin_amdgcn_s_getreg((3 << 11) | 20) & 0xFu; }
#define XB_SPIN(cond, bar) do { unsigned _sp = 0; while (cond) { __builtin_amdgcn_s_sleep(1); \
    if ((++_sp & 255u) == 0u) { if (xb_ld(&(bar)[XB_TMO])) break; if (_sp > XB_SPIN_CAP) { atomicAdd(&(bar)[XB_TMO], 1u); break; } } } } while (0)
struct XcdBarrier { unsigned* bar; unsigned x; volatile LAS unsigned* st; unsigned G; };
__device__ __forceinline__ XcdBarrier xcd_barrier_post(unsigned* bar, volatile LAS unsigned* st, unsigned G) {
    XcdBarrier b; b.bar = bar; b.x = xb_xcc_id(); b.st = st; b.G = G;
    if (threadIdx.x == 0) (void)xb_add(&bar[XB_XCNT(b.x)], 1u);
    return b;
}
__device__ __forceinline__ void xcd_barrier_complete(unsigned* bar, unsigned x, unsigned G, unsigned& nloc, unsigned& nx) {
    unsigned sum, cnt, mine, sp = 0u;
    for (;;) {
        sum = 0u; cnt = 0u; mine = 0u;
#pragma unroll
        for (unsigned j = 0; j < 16; ++j) { const unsigned c = xb_ld(&bar[XB_XCNT(j)]); sum += c; cnt += (c > 0u) ? 1u : 0u; mine = (j == x) ? c : mine; }
        if (sum == G) break;
        __builtin_amdgcn_s_sleep(1);
        if ((++sp & 255u) == 0u) { if (xb_ld(&bar[XB_TMO])) break; if (sp > XB_SPIN_CAP) { atomicAdd(&bar[XB_TMO], 1u); break; } }
    }
    nloc = mine > 0u ? mine : 1u; nx = cnt > 0u ? cnt : 1u;
}
__device__ __forceinline__ void xcd_barrier(const XcdBarrier& b) {
    asm volatile("s_waitcnt vmcnt(0)" ::: "memory");
    __syncthreads();
    if (threadIdx.x == 0) {
        unsigned* bar = b.bar;
        __builtin_amdgcn_s_waitcnt(0);
        unsigned nloc = b.st[0], nx = b.st[1];
        if (nloc == 0u) { xcd_barrier_complete(bar, b.x, b.G, nloc, nx); b.st[0] = nloc; b.st[1] = nx; }
        const unsigned old = xb_add(&bar[XB_XSUB(b.x)], 1u);
        const unsigned gen = old / nloc;
        if (old + 1u == (gen + 1u) * nloc) {
            __builtin_amdgcn_fence(__ATOMIC_RELEASE, "agent");
            asm volatile("s_waitcnt vmcnt(0)" ::: "memory");
            const unsigned og = xb_add(&bar[XB_TOP], 1u);
            const unsigned tg = og / nx;
            if (og + 1u == (tg + 1u) * nx) xb_add(&bar[XB_TOPGEN], 1u);
            else XB_SPIN(xb_ld(&bar[XB_TOPGEN]) == tg, bar);
            __builtin_amdgcn_fence(__ATOMIC_ACQUIRE, "agent");
            xb_add(&bar[XB_XGEN(b.x)], 1u);
            asm volatile("s_waitcnt vmcnt(0)" ::: "memory");
        } else {
            XB_SPIN(xb_ld(&bar[XB_XGEN(b.x)]) == gen, bar);
            __builtin_amdgcn_fence(__ATOMIC_ACQUIRE, "agent");
            asm volatile("s_waitcnt vmcnt(0)" ::: "memory");
        }
    }
    __syncthreads();
}

struct Frame {
    LAS unsigned char* lds;
    volatile LAS unsigned* MISC;
    gu32* ctl;
    int tid, lane, wave;
    int vcu, G;
    unsigned char* ws;
    const float* in[25];
    float* out;
};

__device__ __forceinline__ float wave_sum(float v) {
#pragma unroll
    for (int o = 1; o < 64; o <<= 1) v += __shfl_xor(v, o);
    return v;
}

using pg8::Unit;
typedef pg8::f32x4 accv;
struct EpiInProj {
    static constexpr bool PERM = true, AFTER_DRAIN = false; static constexpr bool MIDK = false;
    unsigned short* QKV; bf16* U; float qscale;
    __device__ __forceinline__ void operator()(const accv (&acc)[2][2][4][2], const Unit& u, int wr, int wc, int fr, int fq) const {
        if (u.e == 1) {
            const int row0 = u.pm * 256 + wr * 64 + fr; const int colt = u.pn * 256 + wc * 32 + 8 * fq;
            _Float16* VT = (_Float16*)(QKV + (size_t)2 * M * SBW);
#pragma unroll
            for (int ai = 0; ai < 2; ++ai)
#pragma unroll
                for (int m = 0; m < 4; ++m) { const int row = row0 + ai * 128 + m * 16;
#pragma unroll
                    for (int bj = 0; bj < 2; ++bj) { const int tok = colt + bj * 128; const accv v0 = acc[ai][bj][m][0], v1 = acc[ai][bj][m][1];
                        const int bb = tok >> 13, sq = tok & (SEQ - 1); const int o = sq & 15;
                        _Float16* p = VT + ((size_t)bb * SBW + row) * SEQ + (sq & ~15) + (o >> 1);
                        v2u w0, w1; w0.x = pkh2(v0[0], v0[1]); w0.y = pkh2(v0[2], v0[3]); w1.x = pkh2(v1[0], v1[1]); w1.y = pkh2(v1[2], v1[3]);
                        *(v2u*)p = w0; *(v2u*)(p + 8) = w1; } }
            return;
        }
        const int kind = u.pn >> 1; const int colt = (u.pn & 1) * 256 + wc * 32 + 8 * fq; const int row0 = u.pm * 256 + wr * 64 + fr;
        unsigned short* T = QKV + (size_t)(kind < 2 ? kind : 0) * ((size_t)M * SBW); const float sc = kind == 0 ? qscale : 1.0f;
#pragma unroll
        for (int ai = 0; ai < 2; ++ai)
#pragma unroll
            for (int m = 0; m < 4; ++m) { const int row = row0 + ai * 128 + m * 16;
#pragma unroll
                for (int bj = 0; bj < 2; ++bj) { const int col = colt + bj * 128; const accv v0 = acc[ai][bj][m][0] * sc, v1 = acc[ai][bj][m][1] * sc; v4u w;
                    if (kind < 2) { w.x = pkh2(v0[0], v0[1]); w.y = pkh2(v0[2], v0[3]); w.z = pkh2(v1[0], v1[1]); w.w = pkh2(v1[2], v1[3]);
                        *(v4u*)(T + (size_t)row * SBW + col) = w; }
                    else { w.x = pg8::cvt_pk_bf16(v0[0], v0[1]); w.y = pg8::cvt_pk_bf16(v0[2], v0[3]); w.z = pg8::cvt_pk_bf16(v1[0], v1[1]); w.w = pg8::cvt_pk_bf16(v1[2], v1[3]);
                        *(v4u*)(U + ((size_t)(row >> 5) * NG + (col >> 4)) * UK + (row & 31) * GC + (col & 15)) = w; } } }
    }
};
struct EpiSloc {
    static constexpr bool PERM = false, AFTER_DRAIN = false; static constexpr bool MIDK = false;
    float* S;
    __device__ __forceinline__ void operator()(const accv (&acc)[2][2][4][2], const Unit& u, int wr, int wc, int fr, int fq) const {
        const int row0 = u.pm * 256 + wr * 64 + fr; const int col0 = wc * 32 + 4 * fq;
#pragma unroll
        for (int ai = 0; ai < 2; ++ai)
#pragma unroll
            for (int m = 0; m < 4; ++m) { const int row = row0 + ai * 128 + m * 16;
#pragma unroll
                for (int n = 0; n < 2; ++n) *(accv*)(S + ((size_t)row * NG + u.e) * 128 + col0 + 16 * n) = acc[ai][0][m][n]; }
    }
};
struct EpiS3 {
    static constexpr bool PERM = true, AFTER_DRAIN = false; static constexpr bool MIDK = false;
    bf16* YG;
    __device__ __forceinline__ void operator()(const accv (&acc)[2][2][4][2], const Unit& u, int wr, int wc, int fr, int fq) const {
        const int row0 = u.pm * 256 + wr * 64 + fr; const int colt = u.pn * 256 + wc * 32 + 8 * fq;
#pragma unroll
        for (int ai = 0; ai < 2; ++ai)
#pragma unroll
            for (int m = 0; m < 4; ++m) { const int row = row0 + ai * 128 + m * 16;
#pragma unroll
                for (int bj = 0; bj < 2; ++bj) { const int col = colt + bj * 128; const accv v0 = acc[ai][bj][m][0], v1 = acc[ai][bj][m][1]; v4u w;
                    w.x = pg8::cvt_pk_bf16(gelu_tanh(v0[0]), gelu_tanh(v0[1])); w.y = pg8::cvt_pk_bf16(gelu_tanh(v0[2]), gelu_tanh(v0[3]));
                    w.z = pg8::cvt_pk_bf16(gelu_tanh(v1[0]), gelu_tanh(v1[1])); w.w = pg8::cvt_pk_bf16(gelu_tanh(v1[2]), gelu_tanh(v1[3]));
                    *(v4u*)(YG + ((size_t)row * LC + (col >> 4)) * SSW + u.e * GC + (col & 15)) = w; } }
    }
};
struct EpiGlu {
    static constexpr bool PERM = true, AFTER_DRAIN = false; static constexpr bool MIDK = false;
    bf16* Y; float* SSQ;
    __device__ __forceinline__ void operator()(const accv (&acc)[2][2][4][2], const Unit& u, int wr, int wc, int fr, int fq) const {
        const int row0 = u.pm * 256 + wr * 64 + fr; const int col = u.pn * 128 + wc * 32 + 8 * fq;
#pragma unroll
        for (int ai = 0; ai < 2; ++ai)
#pragma unroll
            for (int m = 0; m < 4; ++m) { const int row = row0 + ai * 128 + m * 16; float r[8]; float sq = 0.f;
#pragma unroll
                for (int n = 0; n < 2; ++n)
#pragma unroll
                    for (int j = 0; j < 4; ++j) { r[4 * n + j] = acc[ai][0][m][n][j] * sigmoidf_(acc[ai][1][m][n][j]); sq += r[4 * n + j] * r[4 * n + j]; }
                sq += __shfl_xor(sq, 16); sq += __shfl_xor(sq, 32);
                if (fq == 0) SSQ[(size_t)row * 16 + u.pn * 4 + wc] = sq;
                v4u w; w.x = pg8::cvt_pk_bf16(r[0], r[1]); w.y = pg8::cvt_pk_bf16(r[2], r[3]); w.z = pg8::cvt_pk_bf16(r[4], r[5]); w.w = pg8::cvt_pk_bf16(r[6], r[7]);
                *(v4u*)(Y + (size_t)row * D + SBW + col) = w; }
    }
};
struct EpiOutProj {
    static constexpr bool PERM = true, AFTER_DRAIN = false; static constexpr bool MIDK = true;
    const float* X; unsigned char* ws; const LAS float* ratio; const LAS float* fin;
    __device__ __forceinline__ void mid(accv (&acc)[2][2][4][2], const Unit& u, int wr, int wc, int fr, int fq) const {
#pragma unroll
        for (int ai = 0; ai < 2; ++ai)
#pragma unroll
            for (int m = 0; m < 4; ++m) { const float rt = ratio[ai * 128 + wr * 64 + m * 16 + fr];
#pragma unroll
                for (int bj = 0; bj < 2; ++bj)
#pragma unroll
                    for (int n = 0; n < 2; ++n) acc[ai][bj][m][n] *= rt; }
    }
    __device__ __forceinline__ void operator()(const accv (&acc)[2][2][4][2], const Unit& u, int wr, int wc, int fr, int fq) const {
        const int row0 = u.pm * 256 + wr * 64 + fr; const int col0 = u.pn * 256 + wc * 32 + 8 * fq;
#pragma unroll
        for (int ai = 0; ai < 2; ++ai)
#pragma unroll
            for (int m = 0; m < 4; ++m) { const int row = row0 + ai * 128 + m * 16; const float* xr = X + (size_t)row * D + col0; bf16* orow = x1_row(ws, row) + col0; const float fs = fin[ai * 128 + wr * 64 + m * 16 + fr];
#pragma unroll
                for (int bj = 0; bj < 2; ++bj) { const accv x0 = *(const accv*)(xr + bj * 128), x1 = *(const accv*)(xr + bj * 128 + 4); const accv v0 = x0 + acc[ai][bj][m][0] * fs, v1 = x1 + acc[ai][bj][m][1] * fs;
                    v4u w; w.x = pg8::cvt_pk_bf16(v0[0], v0[1]); w.y = pg8::cvt_pk_bf16(v0[2], v0[3]); w.z = pg8::cvt_pk_bf16(v1[0], v1[1]); w.w = pg8::cvt_pk_bf16(v1[2], v1[3]);
                    *(v4u*)(orow + bj * 128) = w; }
                if (m & 1) asm volatile("" ::: "memory"); }
    }
};
struct EpiMoe1 {
    static constexpr bool PERM = true, AFTER_DRAIN = false; static constexpr bool MIDK = false;
    unsigned char* H; const float* bg; const float* bu; const int* rowinfo;
    __device__ __forceinline__ void operator()(const accv (&acc)[2][2][4][2], const Unit& u, int wr, int wc, int fr, int fq) const {
        const int row0 = u.pm * 256 + wr * 64 + fr; const int col = u.pn * 128 + wc * 32 + 8 * fq;
        float bgv[8], buv[8];
#pragma unroll
        for (int n = 0; n < 2; ++n) { const accv a = *(const accv*)(bg + u.e * FF + col + 4 * n), b = *(const accv*)(bu + u.e * FF + col + 4 * n);
#pragma unroll
            for (int j = 0; j < 4; ++j) { bgv[4 * n + j] = a[j]; buv[4 * n + j] = b[j]; } }
        float rsv[2][4];
#pragma unroll
        for (int ai = 0; ai < 2; ++ai)
#pragma unroll
            for (int m = 0; m < 4; ++m) rsv[ai][m] = __builtin_bit_cast(float, rowinfo[4 * (row0 + ai * 128 + m * 16) + 2]);
#pragma unroll
        for (int ai = 0; ai < 2; ++ai)
#pragma unroll
            for (int m = 0; m < 4; ++m) { const int row = row0 + ai * 128 + m * 16; float r[8]; const float rs = rsv[ai][m] * (1.0f / WSCALE);
#pragma unroll
                for (int n = 0; n < 2; ++n)
#pragma unroll
                    for (int j = 0; j < 4; ++j) { const float g = fminf(acc[ai][0][m][n][j] * rs + bgv[4 * n + j], 7.0f); const float up = fminf(fmaxf(acc[ai][1][m][n][j] * rs + buv[4 * n + j], -7.0f), 7.0f);
                        r[4 * n + j] = (up + 1.0f) * g * frcp(1.0f + fexp2(-1.702f * LOG2E * g)); }
                v2u w; w.x = pk4_fp8(r[0], r[1], r[2], r[3]); w.y = pk4_fp8(r[4], r[5], r[6], r[7]);
                *(v2u*)(H + (size_t)row * FF + col) = w; }
    }
};
struct EpiMoe2 {
    static constexpr bool PERM = true, AFTER_DRAIN = false; static constexpr bool MIDK = false;
    bf16* Y; const float* bd; const int* rowinfo;
    __device__ __forceinline__ void operator()(const accv (&acc)[2][2][4][2], const Unit& u, int wr, int wc, int fr, int fq) const {
        const int row0 = u.pm * 256 + wr * 64 + fr; const int colt = u.pn * 256 + wc * 32 + 8 * fq;
        float bv[2][8];
#pragma unroll
        for (int bj = 0; bj < 2; ++bj)
#pragma unroll
            for (int n = 0; n < 2; ++n) { const accv a = *(const accv*)(bd + u.e * D + colt + bj * 128 + 4 * n);
#pragma unroll
                for (int j = 0; j < 4; ++j) bv[bj][4 * n + j] = a[j]; }
        v2u sg[2][4];
#pragma unroll
        for (int ai = 0; ai < 2; ++ai)
#pragma unroll
            for (int m = 0; m < 4; ++m) sg[ai][m] = *(const v2u*)(rowinfo + 4 * (row0 + ai * 128 + m * 16));
#pragma unroll
        for (int ai = 0; ai < 2; ++ai)
#pragma unroll
            for (int m = 0; m < 4; ++m) { const int slot = (int)sg[ai][m].x; const unsigned gbits = sg[ai][m].y; const float gate = __builtin_bit_cast(float, gbits);
                if (slot >= 0) {
#pragma unroll
                    for (int bj = 0; bj < 2; ++bj) { float r[8];
#pragma unroll
                        for (int n = 0; n < 2; ++n)
#pragma unroll
                            for (int j = 0; j < 4; ++j) r[4 * n + j] = (acc[ai][bj][m][n][j] * (1.0f / WSCALE) + bv[bj][4 * n + j]) * gate;
                        v4u w; w.x = pg8::cvt_pk_bf16(r[0], r[1]); w.y = pg8::cvt_pk_bf16(r[2], r[3]); w.z = pg8::cvt_pk_bf16(r[4], r[5]); w.w = pg8::cvt_pk_bf16(r[6], r[7]);
                        *(v4u*)(Y + (size_t)slot * D + colt + bj * 128) = w; } } }
    }
};

struct InProjOrder {
    int G, c;
    __device__ bool next(int i, Unit& u) const {
        const int L = i * G + c; if (L >= 512) return false;
        const int s = pg8::xcd_remap(L, 512);
        if (s < 384) { const int grp = s / 48, r = s % 48; u.slot = 0; u.pm = grp * 8 + (r & 7); const int pi = r >> 3; u.pn = pi < 4 ? pi : pi + 2; u.e = 0;
            u.offA = (long)u.pm * 256 * D * 2; u.offB = (long)u.pn * 256 * D * 2; }
        else { const int r = s - 384; u.slot = 0; u.pm = r & 1; u.pn = r >> 1; u.e = 1;
            u.offA = (long)(WS_WINT - WS_HN) + (long)(1024 + u.pm * 256) * D * 2; u.offB = (long)(WS_HN - WS_WINT) + (long)u.pn * 256 * D * 2; }
        return true;
    }
    __device__ __forceinline__ void a_ready(const Unit&) const {}
    __device__ __forceinline__ void done(const Unit&) const {}
};
struct SsmOrder {
    int nwg, G, c, npn, rows_per_g, ldb;
    __device__ bool next(int i, Unit& u) const {
        const int L = i * G + c; if (L >= nwg) return false;
        const int per_g = 2 * npn; const int g = L / per_g, r = L % per_g;
        u.e = g; u.pm = r / npn; u.pn = r % npn; u.slot = 0;
        u.offA = ((long)u.pm * 256 * NG * UK + (long)g * UK) * 2; u.offB = ((long)g * rows_per_g + (long)u.pn * 256) * ldb * 2; return true;
    }
    __device__ __forceinline__ void a_ready(const Unit&) const {}
    __device__ __forceinline__ void done(const Unit&) const {}
};
struct MoeOrder {
    const LAS int* units; long ebytes; int gather;
    __device__ bool next(int i, Unit& u) const {
        if (i >= 32) return false;
        const int v = __builtin_amdgcn_readfirstlane(units[4 * i + 3]); if (!v) return false;
        u.pm = __builtin_amdgcn_readfirstlane(units[4 * i + 0]); u.pn = __builtin_amdgcn_readfirstlane(units[4 * i + 1]); u.e = __builtin_amdgcn_readfirstlane(units[4 * i + 2]);
        u.slot = i; u.offA = gather ? 0l : (long)u.pm * 256 * D;     u.offB = (long)u.e * ebytes + (long)u.pn * 256 * 16; return true;
    }
    __device__ __forceinline__ void a_ready(const Unit&) const {}
    __device__ __forceinline__ void done(const Unit&) const {}
};

struct CvItem { const float* src; bf16* dst; const float* kscale; int ldw, K, rmul, radd, k0, n0; };
constexpr int CV_I_IN = (D / 64) * (NPROJ / 32), CV_I_GLU = (SSW / 64) * (SSW / 32), CV_I_OUT = (D / 64) * (D / 32), CV_I_E = (D / 64) * (FF / 32);
constexpr int CV_N_EARLY = CV_I_IN + 2 * CV_I_GLU + CV_I_OUT, CV_N_EXP = 3 * NE * (D / 8);
__device__ __forceinline__ void cv_set(CvItem& c, const float* W, int ldw, int K, int N, bf16* WT, int rmul, int radd, int item) {
    const int nblk = N / 32, kb = item / nblk, nb = item % nblk; c.src = W; c.dst = WT; c.kscale = nullptr; c.ldw = ldw; c.K = K; c.rmul = rmul; c.radd = radd; c.k0 = 64 * kb; c.n0 = 32 * nb;
}
__device__ __forceinline__ void cv_decode_early(Frame& F, int r, CvItem& c) {
    bf16* WinT = (bf16*)(F.ws + WS_WINT); bf16* WgluT = (bf16*)(F.ws + WS_WGLUT); bf16* WoutT = (bf16*)(F.ws + WS_WOUTT);
    if (r < CV_I_IN) { cv_set(c, F.in[2], NPROJ, D, NPROJ, WinT, 1, 0, r); return; } r -= CV_I_IN;
    if (r < CV_I_GLU) { cv_set(c, F.in[11], 2 * SSW, SSW, SSW, WgluT, 2, 0, r); return; } r -= CV_I_GLU;
    if (r < CV_I_GLU) { cv_set(c, F.in[11] + SSW, 2 * SSW, SSW, SSW, WgluT, 2, 128, r); return; } r -= CV_I_GLU;
    cv_set(c, F.in[14], D, D, D, WoutT, 1, 0, r);
    c.kscale = (c.k0 < SBW) ? F.in[12] + c.k0 : F.in[13] + (c.k0 - SBW);
}
__device__ __forceinline__ void cv_load(const CvItem& c, int lane, float (&v)[32]) {
    const float* p = c.src + (size_t)(c.k0 + (lane >> 5)) * c.ldw + c.n0 + (lane & 31);
#pragma unroll
    for (int i = 0; i < 32; ++i) v[i] = p[(size_t)(2 * i) * c.ldw];
}
__device__ __forceinline__ void cv_store(const CvItem& c, int lane, const float (&v)[32], LAS float* scr) {
#pragma unroll
    for (int i = 0; i < 32; ++i) scr[(2 * i + (lane >> 5)) * 33 + (lane & 31)] = v[i];
    LDS_WAIT(); asm volatile("" ::: "memory");
    const int cc = lane & 7;
#pragma unroll
    for (int j = 0; j < 4; ++j) { const int nl = (lane >> 3) + 8 * j; const int n = c.n0 + nl; const int drow = (n >> 7) * 128 * c.rmul + c.radd + (n & 127); const LAS float* s = scr + (8 * cc) * 33 + nl;
        float e0 = s[0 * 33], e1 = s[1 * 33], e2 = s[2 * 33], e3 = s[3 * 33], e4 = s[4 * 33], e5 = s[5 * 33], e6 = s[6 * 33], e7 = s[7 * 33];
        if (c.kscale) { const f32x4 ka = *(const f32x4*)(c.kscale + 8 * cc), kb = *(const f32x4*)(c.kscale + 8 * cc + 4); e0 *= ka.x; e1 *= ka.y; e2 *= ka.z; e3 *= ka.w; e4 *= kb.x; e5 *= kb.y; e6 *= kb.z; e7 *= kb.w; }
        v4u o; o.x = pg8::cvt_pk_bf16(e0, e1); o.y = pg8::cvt_pk_bf16(e2, e3); o.z = pg8::cvt_pk_bf16(e4, e5); o.w = pg8::cvt_pk_bf16(e6, e7);
        *(GAS v4u*)(c.dst + (size_t)drow * c.K + c.k0 + 8 * cc) = o; }
    LDS_WAIT(); asm volatile("" ::: "memory");
}
__device__ __forceinline__ void cv_item_early(Frame& F, int it, LAS float* scr) { CvItem c; float v[32]; cv_decode_early(F, it, c); cv_load(c, F.lane, v); cv_store(c, F.lane, v, scr); }
__device__ __forceinline__ void xv_item(Frame& F, int it) {
    unsigned char* W1T = F.ws + WS_W1T; unsigned char* W2T = F.ws + WS_W2T;
    const float* w0 = F.in[18]; const float* w1 = F.in[20]; const float* w2 = F.in[22];
    asm volatile("" : "+s"(w0), "+s"(w1), "+s"(w2));
    const int lane = F.lane;
    {
        const int mat = it >> 7, kb = (it & 127) >> 1, half = it & 1, kind = mat / NE, e = mat % NE;
        const float* src = (kind == 0 ? w0 : (kind == 1 ? w1 : w2)) + (size_t)e * D * FF + (size_t)(kb * 16) * FF + half * 512 + 4 * lane;
        f32x4 v[16][2];
#pragma unroll
        for (int rr = 0; rr < 16; ++rr)
#pragma unroll
            for (int j = 0; j < 2; ++j) v[rr][j] = *(const GAS f32x4*)(src + (size_t)rr * FF + 256 * j);
        unsigned char* dst; int jstride;
        if (kind < 2) { dst = W1T + (size_t)e * 2 * FF * D + ((size_t)kb * 2 * FF + (size_t)(half * 4 + (lane >> 5)) * 256 + (kind == 1 ? 128 : 0) + 4 * (lane & 31)) * 16; jstride = 512 * 16; }
        else { dst = W2T + (size_t)e * D * FF + ((size_t)kb * D + half * 512 + 4 * lane) * 16; jstride = 256 * 16; }
#pragma unroll
        for (int j = 0; j < 2; ++j)
#pragma unroll
            for (int c = 0; c < 4; ++c) { v4u o;
                o.x = pk4_fp8(v[0][j][c] * WSCALE, v[1][j][c] * WSCALE, v[2][j][c] * WSCALE, v[3][j][c] * WSCALE); o.y = pk4_fp8(v[4][j][c] * WSCALE, v[5][j][c] * WSCALE, v[6][j][c] * WSCALE, v[7][j][c] * WSCALE);
                o.z = pk4_fp8(v[8][j][c] * WSCALE, v[9][j][c] * WSCALE, v[10][j][c] * WSCALE, v[11][j][c] * WSCALE); o.w = pk4_fp8(v[12][j][c] * WSCALE, v[13][j][c] * WSCALE, v[14][j][c] * WSCALE, v[15][j][c] * WSCALE);
                *(GAS v4u*)(dst + (size_t)j * jstride + c * 16) = o; }
    }
}
__device__ __forceinline__ void sincos_acc(float th, float& s, float& c) {
    const float k = rintf(th * 0.15915494309189535f);
    float r = fmaf(-k, 6.28125f, th); r = fmaf(-k, 1.9353071795864769e-3f, r);
    const float x = 0.25f * r, x2 = x * x;
    float sn = x * (1.0f + x2 * (-1.0f / 6 + x2 * (1.0f / 120 + x2 * (-1.0f / 5040 + x2 * (1.0f / 362880 + x2 * (-1.0f / 39916800))))));
    float cs = 1.0f + x2 * (-0.5f + x2 * (1.0f / 24 + x2 * (-1.0f / 720 + x2 * (1.0f / 40320 + x2 * (-1.0f / 3628800 + x2 * (1.0f / 479001600))))));
#pragma unroll
    for (int i = 0; i < 2; ++i) { const float s2 = 2.0f * sn * cs, c2 = 1.0f - 2.0f * sn * sn; sn = s2; cs = c2; }
    s = sn; c = cs;
}
__device__ __forceinline__ void ssm_tables(Frame& F, int g) {
    constexpr int PT = 36, BS = 17, CS = 68, KT = 324, KC = 20;
    LAS float* pwr = (LAS float*)(F.lds);
    LAS float* pwi = pwr + 64 * PT;
    LAS float* bbr = pwi + 64 * PT;
    LAS float* bbi = bbr + 64 * BS;
    LAS float* ccr = bbi + 64 * BS;
    LAS float* cci = ccr + 16 * CS;
    LAS float* km = cci + 16 * CS;
    const float* lam_re = F.in[3]; const float* lam_im = F.in[4]; const float* log_dt = F.in[5];
    const float* b_re = F.in[6]; const float* b_im = F.in[7]; const float* c_re = F.in[8]; const float* c_im = F.in[9]; const float* dsk = F.in[10];
    float* lamL = (float*)(F.ws + WS_LAML); bf16* WE = (bf16*)(F.ws + WS_WE); bf16* TW = (bf16*)(F.ws + WS_TW);
    const int tid = F.tid;
    if (tid < 64) { const int p = tid;
        const float lr = lam_re[g * NP + p], li = lam_im[g * NP + p], dt = expf(log_dt[g]);
        const float er = expf(lr * dt); float sn, cs; sincos_acc(li * dt, sn, cs);
        const float br = er * cs, bi = er * sn;
        const float nr = br - 1.0f, ni = bi, den = 1.0f / (lr * lr + li * li);
        const float fr = (nr * lr + ni * li) * den, fi = (ni * lr - nr * li) * den;
        float pr = 1.0f, pi = 0.0f;
        for (int n = 0; n <= 32; ++n) { pwr[p * PT + n] = pr; pwi[p * PT + n] = pi; const float t = pr * br - pi * bi; pi = pr * bi + pi * br; pr = t; }
        lamL[(g * 2 + 0) * NP + p] = pwr[p * PT + 32]; lamL[(g * 2 + 1) * NP + p] = pwi[p * PT + 32];
        float xr[GC], xi[GC];
#pragma unroll
        for (int c = 0; c < GC; ++c) { xr[c] = b_re[(g * NP + p) * GC + c]; xi[c] = b_im[(g * NP + p) * GC + c]; }
#pragma unroll
        for (int c = 0; c < GC; ++c) { bbr[p * BS + c] = fr * xr[c] - fi * xi[c]; bbi[p * BS + c] = fr * xi[c] + fi * xr[c]; }
    }
    for (int i = tid; i < 1024; i += NWAVES * 64) { ccr[(i >> 6) * CS + (i & 63)] = c_re[g * 1024 + i]; cci[(i >> 6) * CS + (i & 63)] = c_im[g * 1024 + i]; }
    __syncthreads();
    {
        const int pair = tid & 255, co = pair >> 4, ci = pair & 15, t0 = (tid >> 8) * 16;
        float acc[16];
#pragma unroll
        for (int t = 0; t < 16; ++t) acc[t] = 0.f;
        for (int p = 0; p < NP; ++p) { const float cr = ccr[co * CS + p], cim = cci[co * CS + p], xr = bbr[p * BS + ci], xi = bbi[p * BS + ci];
            const float gr = cr * xr - cim * xi, gi = cr * xi + cim * xr;
#pragma unroll
            for (int t4 = 0; t4 < 4; ++t4) { const f32x4 a = *(const LAS f32x4*)(pwr + p * PT + t0 + 4 * t4), bq = *(const LAS f32x4*)(pwi + p * PT + t0 + 4 * t4);
#pragma unroll
                for (int t = 0; t < 4; ++t) acc[4 * t4 + t] += gr * a[t] - gi * bq[t]; } }
#pragma unroll
        for (int t = 0; t < 16; ++t) km[(t0 + t) * KT + co * KC + ci] = acc[t];
    }
    __syncthreads();
    {
        const int n = tid, i = n >> 4, co = n & 15; const float dv = dsk[g * GC + co];
        bf16* dst = TW + ((size_t)g * 512 + n) * UK;
        for (int j = 0; j < LC; ++j) {
            float v[16];
            const LAS float* kr = km + (j <= i ? i - j : 0) * KT + co * KC;
#pragma unroll
            for (int c4 = 0; c4 < 4; ++c4) { const f32x4 q = *(const LAS f32x4*)(kr + 4 * c4);
#pragma unroll
                for (int t = 0; t < 4; ++t) v[4 * c4 + t] = (j <= i) ? q[t] : 0.f; }
            if (j == i) {
#pragma unroll
                for (int ci = 0; ci < 16; ++ci) v[ci] += (ci == co) ? dv : 0.f; }
            v4u o0, o1; o0.x = pg8::cvt_pk_bf16(v[0], v[1]); o0.y = pg8::cvt_pk_bf16(v[2], v[3]); o0.z = pg8::cvt_pk_bf16(v[4], v[5]); o0.w = pg8::cvt_pk_bf16(v[6], v[7]);
            o1.x = pg8::cvt_pk_bf16(v[8], v[9]); o1.y = pg8::cvt_pk_bf16(v[10], v[11]); o1.z = pg8::cvt_pk_bf16(v[12], v[13]); o1.w = pg8::cvt_pk_bf16(v[14], v[15]);
            *(GAS v4u*)(dst + j * 16) = o0; *(GAS v4u*)(dst + j * 16 + 8) = o1; }
        for (int k8 = 0; k8 < 16; ++k8) { float v[8];
            const int ri = k8 >> 3, p0 = 8 * (k8 & 7);
#pragma unroll
            for (int e = 0; e < 8; ++e) { const int p = p0 + e; const float cr = ccr[co * CS + p], cim = cci[co * CS + p], pr = pwr[p * PT + i + 1], pi = pwi[p * PT + i + 1];
                v[e] = ri == 0 ? (cr * pr - cim * pi) : -(cr * pi + cim * pr); }
            v4u o; o.x = pg8::cvt_pk_bf16(v[0], v[1]); o.y = pg8::cvt_pk_bf16(v[2], v[3]); o.z = pg8::cvt_pk_bf16(v[4], v[5]); o.w = pg8::cvt_pk_bf16(v[6], v[7]);
            *(GAS v4u*)(dst + 512 + k8 * 8) = o; }
    }
    {
        const int row = tid & 127, ri = row >> 6, p = row & 63, kq = tid >> 7;
        bf16* dst = WE + ((size_t)g * 128 + row) * 512 + kq * 128;
        for (int k8 = 0; k8 < 16; ++k8) { float v[8];
#pragma unroll
            for (int e = 0; e < 8; ++e) { const int k = kq * 128 + k8 * 8 + e, j = k >> 4, c = k & 15; const float pr = pwr[p * PT + 31 - j], pi = pwi[p * PT + 31 - j], xr = bbr[p * BS + c], xi = bbi[p * BS + c];
                v[e] = ri == 0 ? (pr * xr - pi * xi) : (pr * xi + pi * xr); }
            v4u o; o.x = pg8::cvt_pk_bf16(v[0], v[1]); o.y = pg8::cvt_pk_bf16(v[2], v[3]); o.z = pg8::cvt_pk_bf16(v[4], v[5]); o.w = pg8::cvt_pk_bf16(v[6], v[7]);
            *(GAS v4u*)(dst + k8 * 8) = o; }
    }
    __syncthreads();
}
__device__ __forceinline__ void rms_rows4_to_bf16(int lane, const float* x0, const float* g, bf16* o0) {
    const GAS f32x4* gr = (const GAS f32x4*)g + lane;
    f32x4 v[4][4]; float sq[4];
#pragma unroll
    for (int r = 0; r < 4; ++r)
#pragma unroll
        for (int j = 0; j < 4; ++j) v[r][j] = ((const GAS f32x4*)(x0 + (size_t)r * D) + lane)[64 * j];
#pragma unroll
    for (int r = 0; r < 4; ++r) { sq[r] = 0.f;
#pragma unroll
        for (int j = 0; j < 4; ++j) sq[r] += (v[r][j].x * v[r][j].x + v[r][j].y * v[r][j].y) + (v[r][j].z * v[r][j].z + v[r][j].w * v[r][j].w); }
#pragma unroll
    for (int o = 1; o < 64; o <<= 1) {
#pragma unroll
        for (int r = 0; r < 4; ++r) sq[r] += __shfl_xor(sq[r], o); }
#pragma unroll
    for (int j = 0; j < 4; ++j) { const f32x4 gg = gr[64 * j];
#pragma unroll
        for (int r = 0; r < 4; ++r) { const float rs = 1.0f / sqrtf(sq[r] * (1.f / D) + EPS); v2u w; w.x = pg8::cvt_pk_bf16(v[r][j].x * rs * gg.x, v[r][j].y * rs * gg.y); w.y = pg8::cvt_pk_bf16(v[r][j].z * rs * gg.z, v[r][j].w * rs * gg.w);
            ((GAS v2u*)(o0 + (size_t)r * D) + lane)[64 * j] = w; } }
}
constexpr int CV_N_W1 = 2 * NE * (D / 8);
constexpr int P1_GEMM_WG = 176;
constexpr int Q0_HN = M / 8, Q0_END = Q0_HN + CV_N_EARLY / 4;
static_assert(Q0_END % 8 == 0 && CV_N_EARLY % 4 == 0, "P0 queue");
__device__ __forceinline__ void p0_prologue(Frame& F, unsigned long long& t_lo_, unsigned long long& t_hi_) {
    TMARK(100);
    LAS float* scr = (LAS float*)(F.lds + RING_OFF + F.wave * 16384);
    unsigned* q = (unsigned*)(F.ctl + CW_Q0); volatile LAS unsigned* slot = F.MISC + 16;
    bf16* HN = (bf16*)(F.ws + WS_HN);
    for (;;) {
        __syncthreads();
        if (F.tid == 0) *slot = __hip_atomic_fetch_add(q, 8u, RLX_AGENT);
        __syncthreads();
        const int base = (int)__builtin_amdgcn_readfirstlane(*slot); if (base >= Q0_END) break;
        const int idx = base + F.wave;
        if (idx < Q0_HN) { const int m0 = idx * 8;
#pragma unroll 1
            for (int j = 0; j < 2; ++j) { const int m = m0 + 4 * j; rms_rows4_to_bf16(F.lane, F.in[0] + (size_t)m * D, F.in[1], HN + (size_t)m * D); } }
        else { const int g4 = (idx - Q0_HN) * 4;
#pragma unroll 1
            for (int j = 0; j < 4; ++j) cv_item_early(F, g4 + j, scr); }
    }
    TMARK(104);
}
__device__ __forceinline__ void q1_drain(Frame& F, int max_claims, unsigned* stop, unsigned stop_target) {
    unsigned* q = (unsigned*)(F.ctl + CW_Q1); volatile LAS unsigned* slot = F.MISC + 18;
    for (int n = 0; max_claims < 0 || n < max_claims; ++n) {
        __syncthreads();
        if (F.tid == 0) { unsigned v = 0x7fffffffu; if (!(stop_target && __hip_atomic_load(stop, RLX_AGENT) >= stop_target)) v = __hip_atomic_fetch_add(q, 8u, RLX_AGENT); *slot = v; }
        __syncthreads();
        const unsigned base = (unsigned)__builtin_amdgcn_readfirstlane(*slot); if (base >= (unsigned)CV_N_W1) break;
        xv_item(F, (int)base + F.wave);
    }
}
__device__ __forceinline__ void p1_side(Frame& F, int tabler_idx) {
    if (tabler_idx >= 0) { ssm_tables(F, tabler_idx);
        if (tabler_idx == 0 && F.tid < 128) {
            bf16* WE = (bf16*)(F.ws + WS_WE) + (size_t)NG * 128 * 512;
            for (int i = 0; i < 512 / 8; ++i) *(GAS v4u*)(WE + (size_t)F.tid * 512 + i * 8) = (v4u){0u, 0u, 0u, 0u}; }
        if (tabler_idx == 1) {
            const float* wr = F.in[16]; bf16* img = (bf16*)(F.ws + WS_RWIMG);
            for (int idx = F.tid; idx < D * NE; idx += NWAVES * 64) { const float w = wr[idx]; const unsigned h = f2bf(w); const unsigned l = f2bf(w - bf2f((unsigned short)h)); const int k = idx >> 5, e = idx & 31;
                img[e * RT_WSTR + k] = (bf16)h; img[(NE + e) * RT_WSTR + k] = (bf16)l; }
            if (F.tid < 2 * NE) for (int k = D; k < RT_WSTR; ++k) img[F.tid * RT_WSTR + k] = 0; } }
    q1_drain(F, -1, (unsigned*)(F.ctl + CW_DONE1), (unsigned)P1_GEMM_WG);
}
__device__ __forceinline__ void w2_drain(Frame& F, int max_claims) {
    unsigned* q = (unsigned*)(F.ctl + CW_Q2); volatile LAS unsigned* slot = F.MISC + 19;
    for (int n = 0; max_claims < 0 || n < max_claims; ++n) {
        __syncthreads();
        if (F.tid == 0) *slot = __hip_atomic_fetch_add(q, 8u, RLX_AGENT);
        __syncthreads();
        const int base = CV_N_W1 + (int)__builtin_amdgcn_readfirstlane(*slot); if (base >= CV_N_EXP) break;
        xv_item(F, base + F.wave);
    }
}

typedef _Float16 h8v __attribute__((ext_vector_type(8)));
typedef float f16v __attribute__((ext_vector_type(16)));
__device__ __forceinline__ void attn_mfma_unit(const _Float16* Qh, const _Float16* Kh, const _Float16* VT, bf16* Y, float* SSQ, int b, int hd, int qb, int lane, h8v tri0, h8v tri1) {
    const int r = lane & 31, hh = lane >> 5, q0 = qb * 32;
    const _Float16* qrow = Qh + ((size_t)b * SEQ + q0 + r) * SBW + hd * HD + 8 * hh;
    h8v qf[4];
#pragma unroll
    for (int kd = 0; kd < 4; ++kd) qf[kd] = *(const h8v*)(qrow + 16 * kd);
    f16v o0, o1;
#pragma unroll
    for (int i = 0; i < 16; ++i) { o0[i] = 0.f; o1[i] = 0.f; }
    float carry = 0.f;
    const _Float16* kbase = Kh + ((size_t)b * SEQ + r) * SBW + hd * HD + 8 * hh;
    const _Float16* vbase = VT + ((size_t)b * SBW + hd * HD + r) * SEQ + 8 * hh;
    h8v kf[4], vf[2][2], kn[4], vn[2][2];
#pragma unroll
    for (int kd = 0; kd < 4; ++kd) kf[kd] = *(const h8v*)(kbase + (size_t)q0 * SBW + 16 * kd);
#pragma unroll
    for (int db = 0; db < 2; ++db)
#pragma unroll
        for (int ss = 0; ss < 2; ++ss) vf[db][ss] = *(const h8v*)(vbase + (size_t)(32 * db) * SEQ + q0 + 16 * ss);
    for (int key0 = q0; key0 >= 0; key0 -= 32) {
        { const int kn0 = key0 >= 32 ? key0 - 32 : key0;
#pragma unroll
          for (int kd = 0; kd < 4; ++kd) kn[kd] = *(const h8v*)(kbase + (size_t)kn0 * SBW + 16 * kd);
#pragma unroll
          for (int db = 0; db < 2; ++db)
#pragma unroll
              for (int ss = 0; ss < 2; ++ss) vn[db][ss] = *(const h8v*)(vbase + (size_t)(32 * db) * SEQ + kn0 + 16 * ss); }
        f16v z;
#pragma unroll
        for (int i = 0; i < 16; ++i) z[i] = 0.f;
#pragma unroll
        for (int kd = 0; kd < 4; ++kd) z = __builtin_amdgcn_mfma_f32_32x32x16_f16(kf[kd], qf[kd], z, 0, 0, 0);
        const bool diag = key0 == q0;
        h8v lh[2], ll[2];
#pragma unroll
        for (int i = 0; i < 16; ++i) { const int koff = (i & 3) + 8 * (i >> 2) + 4 * hh; const bool act = !diag || koff < r;
            const float zi = z[i]; const float t1 = flog2(1.0f + fexp2(-fabsf(zi)));
            const float L = act ? fmaxf(-(fmaxf(zi, 0.f) + t1), -60000.0f) : 0.f;
            const _Float16 hi = (_Float16)L; const _Float16 lo = (_Float16)(L - (float)hi);
            lh[i >> 3][i & 7] = hi; ll[i >> 3][i & 7] = lo; }
        f16v cum;
#pragma unroll
        for (int i = 0; i < 16; ++i) cum[i] = carry;
        cum = __builtin_amdgcn_mfma_f32_32x32x16_f16(tri0, lh[0], cum, 0, 0, 0);
        cum = __builtin_amdgcn_mfma_f32_32x32x16_f16(tri1, lh[1], cum, 0, 0, 0);
        cum = __builtin_amdgcn_mfma_f32_32x32x16_f16(tri0, ll[0], cum, 0, 0, 0);
        cum = __builtin_amdgcn_mfma_f32_32x32x16_f16(tri1, ll[1], cum, 0, 0, 0);
        h8v pf[2];
#pragma unroll
        for (int i = 0; i < 16; ++i) { const int koff = (i & 3) + 8 * (i >> 2) + 4 * hh; const bool act = !diag || koff < r;
            const float p = act ? fexp2(z[i] + cum[i]) : 0.f; pf[i >> 3][i & 7] = (_Float16)p; }
        o0 = __builtin_amdgcn_mfma_f32_32x32x16_f16(vf[0][0], pf[0], o0, 0, 0, 0);
        o0 = __builtin_amdgcn_mfma_f32_32x32x16_f16(vf[0][1], pf[1], o0, 0, 0, 0);
        o1 = __builtin_amdgcn_mfma_f32_32x32x16_f16(vf[1][0], pf[0], o1, 0, 0, 0);
        o1 = __builtin_amdgcn_mfma_f32_32x32x16_f16(vf[1][1], pf[1], o1, 0, 0, 0);
        carry = __shfl(cum[0], r);
        if (__all(carry < -150.0f)) break;
#pragma unroll
        for (int kd = 0; kd < 4; ++kd) kf[kd] = kn[kd];
#pragma unroll
        for (int db = 0; db < 2; ++db)
#pragma unroll
            for (int ss = 0; ss < 2; ++ss) vf[db][ss] = vn[db][ss];
    }
    { float sq = 0.f;
#pragma unroll
      for (int i = 0; i < 16; ++i) sq += o0[i] * o0[i] + o1[i] * o1[i];
      sq += __shfl_xor(sq, 32); if (hh == 0) SSQ[((size_t)b * SEQ + q0 + r) * NH + hd] = sq; }
    bf16* yp = Y + ((size_t)b * SEQ + q0 + r) * D + hd * HD + 4 * hh;
#pragma unroll
    for (int g4 = 0; g4 < 4; ++g4) { v2u w0, w1; w0.x = pk2(o0[4 * g4], o0[4 * g4 + 1]); w0.y = pk2(o0[4 * g4 + 2], o0[4 * g4 + 3]); w1.x = pk2(o1[4 * g4], o1[4 * g4 + 1]); w1.y = pk2(o1[4 * g4 + 2], o1[4 * g4 + 3]);
        *(v2u*)(yp + 8 * g4) = w0; *(v2u*)(yp + 32 + 8 * g4) = w1; }
}
__device__ __forceinline__ void attn_one(Frame& F, int u) {
    const _Float16* Qh = (const _Float16*)(F.ws + WS_Q); const _Float16* Kh = (const _Float16*)(F.ws + WS_K); const _Float16* VT = (const _Float16*)(F.ws + WS_V);
    bf16* Y = (bf16*)(F.ws + WS_YCAT); float* SSQ = (float*)(F.ws + WS_SSQSB);
    constexpr int NQB = SEQ / 32;
    const int lane = F.lane, r = lane & 31, hh = lane >> 5;
    h8v tri0, tri1;
#pragma unroll
    for (int e = 0; e < 8; ++e) { const int k0 = 8 * (e >> 2) + 4 * hh + (e & 3); tri0[e] = (k0 >= r) ? (_Float16)1.0f : (_Float16)0.0f; tri1[e] = (16 + k0 >= r) ? (_Float16)1.0f : (_Float16)0.0f; }
    const int qb = u % NQB, bh = u / NQB; attn_mfma_unit(Qh, Kh, VT, Y, SSQ, bh / NH, bh % NH, qb, lane, tri0, tri1);
}

__device__ __forceinline__ void scan_phase(Frame& F, int task) {
    static_assert(CPB == 8 * 32, "scan segments");
    const int b = task / NG, g = task % NG, p = F.lane, sg = F.wave;
    const float* lamL = (const float*)(F.ws + WS_LAML); const float* S = (const float*)(F.ws + WS_SLOC); bf16* U = (bf16*)(F.ws + WS_UCAT);
    LAS float* ex = (LAS float*)(F.lds);
    const float lr = lamL[(g * 2 + 0) * NP + p], li = lamL[(g * 2 + 1) * NP + p];
    float sr[32], si[32];
#pragma unroll
    for (int j = 0; j < 32; ++j) { const size_t base = ((size_t)(b * CPB + sg * 32 + j) * NG + g) * 128; sr[j] = S[base + p]; si[j] = S[base + 64 + p]; }
    float er = 0.f, ei = 0.f, qr = 1.f, qi = 0.f;
#pragma unroll
    for (int j = 0; j < 32; ++j) { const float nr = lr * er - li * ei + sr[j], ni = lr * ei + li * er + si[j]; er = nr; ei = ni; const float tr = lr * qr - li * qi; qi = lr * qi + li * qr; qr = tr; }
    ex[(sg * 2 + 0) * 64 + p] = er; ex[(sg * 2 + 1) * 64 + p] = ei;
    __syncthreads();
    float xr = 0.f, xi = 0.f;
    for (int r = 0; r < sg; ++r) { const float tr = qr * xr - qi * xi + ex[(r * 2 + 0) * 64 + p], ti = qr * xi + qi * xr + ex[(r * 2 + 1) * 64 + p]; xr = tr; xi = ti; }
#pragma unroll
    for (int j = 0; j < 32; ++j) { bf16* dst = U + ((size_t)(b * CPB + sg * 32 + j) * NG + g) * UK + 512;
        dst[p] = (bf16)f2bf(xr); dst[64 + p] = (bf16)f2bf(xi);
        const float nr = lr * xr - li * xi + sr[j], ni = lr * xi + li * xr + si[j]; xr = nr; xi = ni; }
    __syncthreads();
}

__device__ __forceinline__ void router_phase(Frame& F) {
    typedef short s8v __attribute__((ext_vector_type(8)));
    typedef float f16v __attribute__((ext_vector_type(16)));
    LAS bf16* wh = (LAS bf16*)F.lds; LAS bf16* wl = wh + NE * RT_WSTR;
    LAS int* lcnt = (LAS int*)(F.lds + RT_SCR_OFF); LAS int* lbase = lcnt + 32; LAS int* asg = lbase + 32;
    const float* wr = F.in[16]; const float* br = F.in[17]; const float* g2 = F.in[15];
    bf16* XG = (bf16*)(F.ws + WS_XN); float* gates = (float*)(F.ws + WS_GATES); int* lists = (int*)(F.ws + WS_LISTS); float* RS = (float*)(F.ws + WS_RSTD);
    unsigned* gcnt = (unsigned*)(F.ctl + CW_CNT);
    const int tid = F.tid, lane = F.lane, r = lane & 31, hh = lane >> 5;
    const int task = F.wave >> 2, kq = F.wave & 3; const int tok = F.vcu * 64 + task * 32 + r;
    const bf16* xp = x1_row(F.ws, tok) + kq * 256 + 8 * hh; unsigned char* xo = (unsigned char*)XG + (size_t)tok * D + kq * 256 + 8 * hh;
    v4u xw[16];
#pragma unroll
    for (int ks = 0; ks < 16; ++ks) xw[ks] = *(const v4u*)(xp + 16 * ks);
    { const v4u* src = (const v4u*)(F.ws + WS_RWIMG); LAS v4u* dst = (LAS v4u*)F.lds;
      for (int i = tid; i < RT_W_BYTES / 16; i += NWAVES * 64) dst[i] = src[i]; }
    LAS float* gl = (LAS float*)(F.lds + RT_SCR_OFF + 2048);
    for (int i = tid; i < D / 4; i += NWAVES * 64) ((LAS f32x4*)gl)[i] = ((const f32x4*)g2)[i];
    if (tid < 32) lcnt[tid] = 0;
    __syncthreads();
    f16v acc;
#pragma unroll
    for (int i = 0; i < 16; ++i) acc[i] = 0.f;
    float ss = 0.f;
    const LAS float* gp = gl + kq * 256 + 8 * hh;
    const LAS bf16* whp = wh + r * RT_WSTR + kq * 256 + 8 * hh; const LAS bf16* wlp = wl + r * RT_WSTR + kq * 256 + 8 * hh;
#pragma unroll
    for (int ks = 0; ks < 16; ++ks) {
        const v4u xq = xw[ks]; const f32x4 x0 = (f32x4){bflo(xq.x), bfhi(xq.x), bflo(xq.y), bfhi(xq.y)}, x1 = (f32x4){bflo(xq.z), bfhi(xq.z), bflo(xq.w), bfhi(xq.w)}, g0 = *(const LAS f32x4*)(gp + 16 * ks), g1 = *(const LAS f32x4*)(gp + 16 * ks + 4);
        ss += (x0.x * x0.x + x0.y * x0.y) + (x0.z * x0.z + x0.w * x0.w) + (x1.x * x1.x + x1.y * x1.y) + (x1.z * x1.z + x1.w * x1.w);
        const f32x4 a0 = x0 * g0, a1 = x1 * g1;
        v4u hv, lv;
        hv.x = pg8::cvt_pk_bf16(a0.x, a0.y); hv.y = pg8::cvt_pk_bf16(a0.z, a0.w); hv.z = pg8::cvt_pk_bf16(a1.x, a1.y); hv.w = pg8::cvt_pk_bf16(a1.z, a1.w);
        lv.x = pg8::cvt_pk_bf16(a0.x - bflo(hv.x), a0.y - bfhi(hv.x)); lv.y = pg8::cvt_pk_bf16(a0.z - bflo(hv.y), a0.w - bfhi(hv.y));
        lv.z = pg8::cvt_pk_bf16(a1.x - bflo(hv.z), a1.y - bfhi(hv.z)); lv.w = pg8::cvt_pk_bf16(a1.z - bflo(hv.w), a1.w - bfhi(hv.w));
        { v2u f8; f8.x = pk4_fp8(a0.x, a0.y, a0.z, a0.w); f8.y = pk4_fp8(a1.x, a1.y, a1.z, a1.w); *(v2u*)(xo + 16 * ks) = f8; }
        const s8v xh = __builtin_bit_cast(s8v, hv), xl = __builtin_bit_cast(s8v, lv);
        v4u ah, al; { const LAS v2u* p = (const LAS v2u*)(whp + 16 * ks); const v2u q0 = p[0], q1 = p[1]; ah.x = q0.x; ah.y = q0.y; ah.z = q1.x; ah.w = q1.y; }
        { const LAS v2u* p = (const LAS v2u*)(wlp + 16 * ks); const v2u q0 = p[0], q1 = p[1]; al.x = q0.x; al.y = q0.y; al.z = q1.x; al.w = q1.y; }
        const s8v wa = __builtin_bit_cast(s8v, ah), wb = __builtin_bit_cast(s8v, al);
        acc = __builtin_amdgcn_mfma_f32_32x32x16_bf16(wa, xh, acc, 0, 0, 0);
        acc = __builtin_amdgcn_mfma_f32_32x32x16_bf16(wb, xh, acc, 0, 0, 0);
        acc = __builtin_amdgcn_mfma_f32_32x32x16_bf16(wa, xl, acc, 0, 0, 0);
    }
    __syncthreads();
    LAS float* part = (LAS float*)F.lds;
#pragma unroll
    for (int i = 0; i < 16; ++i) part[(F.wave * 17 + i) * 64 + lane] = acc[i];
    part[(F.wave * 17 + 16) * 64 + lane] = ss;
    __syncthreads();
    if (kq == 0) {
        float v[32]; float st = 0.f;
#pragma unroll
        for (int w = 0; w < 4; ++w) { const LAS float* pw = part + (size_t)((task * 4 + w) * 17) * 64;
#pragma unroll
            for (int i = 0; i < 16; ++i) { const float t = pw[i * 64 + lane]; v[i] = w == 0 ? t : v[i] + t; }
            st += pw[16 * 64 + lane] + pw[16 * 64 + (lane ^ 32)]; }
        const float rstd = 1.0f / sqrtf(st * (1.f / D) + EPS);
        if (hh == 0) RS[tok] = rstd;
#pragma unroll
        for (int i = 0; i < 16; ++i) { const int e = (i & 3) + 8 * (i >> 2) + 4 * hh; v[i] = v[i] * rstd + br[e]; }
#pragma unroll
        for (int i = 0; i < 16; ++i) v[16 + i] = __shfl_xor(v[i], 32);
        float mx = v[0];
#pragma unroll
        for (int i = 1; i < 32; ++i) mx = fmaxf(mx, v[i]);
        int rk[16]; float es = 0.f;
#pragma unroll
        for (int i = 0; i < 16; ++i) { const int ei = (i & 3) + 8 * (i >> 2) + 4 * hh; int rank = 0;
#pragma unroll
            for (int j = 0; j < 32; ++j) { if (j == i) continue; const int ej = (j & 3) + 8 * ((j & 15) >> 2) + 4 * (j < 16 ? hh : 1 - hh);
                rank += (v[j] > v[i] || (v[j] == v[i] && ej < ei)) ? 1 : 0; }
            rk[i] = rank; if (rank < TOPK) es += fexp2((v[i] - mx) * LOG2E); }
        es += __shfl_xor(es, 32);
        const float inv = 1.0f / es;
#pragma unroll
        for (int i = 0; i < 16; ++i) if (rk[i] < TOPK) { const int ei = (i & 3) + 8 * (i >> 2) + 4 * hh;
            gates[tok * TOPK + rk[i]] = fexp2((v[i] - mx) * LOG2E) * inv;
            const int pos = __hip_atomic_fetch_add(lcnt + ei, 1, __ATOMIC_RELAXED, __HIP_MEMORY_SCOPE_WORKGROUP);
            asg[(task * 32 + r) * 4 + rk[i]] = ei | (pos << 8); }
    }
    __syncthreads();
    if (tid < 32) lbase[tid] = (int)__hip_atomic_fetch_add(gcnt + tid, (unsigned)lcnt[tid], RLX_AGENT);
    __syncthreads();
    if (tid < 64 * TOPK) { const int a = asg[tid], e = a & 255, pos = a >> 8; const int tk = F.vcu * 64 + (tid >> 2);
        lists[e * M + lbase[e] + pos] = tk * TOPK + (tid & 3); }
    __syncthreads();
}

__device__ __forceinline__ void moe_tables(Frame& F) {
    LAS int* tab = (LAS int*)(F.lds + TAB_OFF); LAS int* cnt = tab, * mt = tab + 32, * tbase = tab + 64;
    unsigned* gcnt = (unsigned*)(F.ctl + CW_CNT);
    if (F.tid < 32) { const int c = (int)__hip_atomic_load(gcnt + F.tid, RLX_AGENT); cnt[F.tid] = c; mt[F.tid] = (c + 255) >> 8; }
    __syncthreads();
    if (F.tid == 0) { int s = 0; for (int e = 0; e < NE; ++e) { tbase[e] = s; s += mt[e]; } tbase[NE] = s; }
    __syncthreads();
}
__device__ __forceinline__ void moe_units(Frame& F, int npn, int gpn) {
    LAS int* tab = (LAS int*)(F.lds + TAB_OFF); LAS int* mt = tab + 32, * tbase = tab + 64; LAS int* units = (LAS int*)(F.lds + UNITS_OFF);
    if (F.tid < 32) {
        const int nU = tbase[NE] * npn; const int L = F.tid * F.G + (int)blockIdx.x; int pm = 0, pn = 0, e = 0, valid = 0;
        if (L < nU) { const int seq = pg8::xcd_remap(L, nU); int ee = 0; while (ee < NE - 1 && seq >= tbase[ee + 1] * npn) ++ee;
            const int r = seq - tbase[ee] * npn, m = mt[ee]; const int grp = r / (m * gpn), r2 = r % (m * gpn);
            e = ee; pn = grp * gpn + r2 / m; pm = tbase[ee] + r2 % m; valid = 1; }
        units[4 * F.tid + 0] = pm; units[4 * F.tid + 1] = pn; units[4 * F.tid + 2] = e; units[4 * F.tid + 3] = valid;
    }
    __syncthreads();
}

__device__ __forceinline__ void moe_gather_tables(Frame& F) {
    LAS int* tab = (LAS int*)(F.lds + TAB_OFF); LAS int* cnt = tab, * tbase = tab + 64; LAS int* units = (LAS int*)(F.lds + UNITS_OFF); LAS int* tokmap = (LAS int*)(F.lds + TOKMAP_OFF);
    const float* gates = (const float*)(F.ws + WS_GATES); const int* lists = (const int*)(F.ws + WS_LISTS); const float* RS = (const float*)(F.ws + WS_RSTD); int* rowinfo = (int*)(F.ws + WS_ROWINFO);
    for (int idx = F.tid; idx < TOKMAP_SLOTS * 256; idx += NWAVES * 64) { const int i = idx >> 8, R = idx & 255; int tk = 0;
        if (units[4 * i + 3]) { const int pm = units[4 * i], e = units[4 * i + 2]; const int li = (pm - tbase[e]) * 256 + R;
            v4u ri = (v4u){0xffffffffu, 0u, 0u, 0u};
            if (li < cnt[e]) { const int slot = lists[e * M + li]; tk = slot >> 2; ri = (v4u){(unsigned)slot, __builtin_bit_cast(unsigned, gates[slot]), __builtin_bit_cast(unsigned, RS[tk]), 0u}; }
            *(v4u*)(rowinfo + 4 * (pm * 256 + R)) = ri; }
        tokmap[idx] = tk; }
    asm volatile("s_waitcnt vmcnt(0)" ::: "memory");
    __syncthreads();
}

__device__ __forceinline__ void final_phase(Frame& F) {
    const bf16* YB = (const bf16*)(F.ws + WS_YBUF); const float* gf = F.in[24]; float* O = F.out;
    const int gw = F.vcu * NWAVES + F.wave, NGW = F.G * NWAVES, lane = F.lane;
    f32x4 gg[4];
#pragma unroll
    for (int j = 0; j < 4; ++j) gg[j] = *(const f32x4*)(gf + 4 * lane + 256 * j);
    for (int m = gw; m < M; m += NGW) {
        f32x4 v[4]; float ss = 0.f;
#pragma unroll
        for (int j = 0; j < 4; ++j) { { const v2u xw = *(const v2u*)(x1_row(F.ws, m) + 4 * lane + 256 * j); v[j] = (f32x4){bflo(xw.x), bfhi(xw.x), bflo(xw.y), bfhi(xw.y)}; }
#pragma unroll
            for (int k = 0; k < (DBG_MODE ? 0 : TOPK); ++k) { const v2u w = *(const v2u*)(YB + ((size_t)m * TOPK + k) * D + 4 * lane + 256 * j); v[j].x += bflo(w.x); v[j].y += bfhi(w.x); v[j].z += bflo(w.y); v[j].w += bfhi(w.y); }
            ss += (v[j].x * v[j].x + v[j].y * v[j].y) + (v[j].z * v[j].z + v[j].w * v[j].w); }
        const float rstd = 1.0f / sqrtf(wave_sum(ss) * (1.f / D) + EPS);
#pragma unroll
        for (int j = 0; j < 4; ++j) *(f32x4*)(O + (size_t)m * D + 4 * lane + 256 * j) = v[j] * rstd * gg[j];
    }
}

struct Args { const float* in[25]; float* out; unsigned char* ws; int ph_lo, ph_hi, li, pad; };
__global__ void __launch_bounds__(NWAVES * 64, 2) hyb_fwd(Args args) {
    extern __shared__ __attribute__((aligned(16))) unsigned char lds[];
    Frame F;
    F.lds = (LAS unsigned char*)lds;
    F.MISC = (volatile LAS unsigned*)(F.lds + MISC_OFF);
    F.tid = threadIdx.x; F.lane = F.tid & 63; F.wave = __builtin_amdgcn_readfirstlane(F.tid >> 6);
    F.G = gridDim.x; { const int bx = blockIdx.x; F.vcu = (F.G % 8 == 0) ? (bx % 8) * (F.G / 8) + bx / 8 : bx; }
    F.ws = args.ws; F.ctl = (gu32*)(args.ws + WS_CTL); F.out = args.out;
#pragma unroll
    for (int i = 0; i < 25; ++i) F.in[i] = args.in[i];
    for (int u = F.tid; u < (LDS_BYTES - LDSCTL_OFF) / 4; u += NWAVES * 64) ((LAS unsigned*)(F.lds + LDSCTL_OFF))[u] = 0u;
    __syncthreads();
    XcdBarrier bar; bar.bar = (unsigned*)(F.ctl + CW_BAR); bar.x = 0; bar.st = nullptr; bar.G = gridDim.x;
    if (N_LAUNCHES != PER_PHASE) bar = xcd_barrier_post((unsigned*)(F.ctl + CW_BAR), F.MISC + 8, gridDim.x);
#define GRID_BAR(seam) do { if (N_LAUNCHES == PER_PHASE) { if (F.tid == 0) __hip_atomic_store(F.ctl + CW_TMO, 0xBADBA0u | (unsigned)(seam), RLX_AGENT); } else { xcd_barrier(bar); } } while (0)
    const int lo = args.ph_lo, hi = args.ph_hi;
#define IN(k) (lo <= (k) && (k) < hi)
#define BOTH(k) (IN(k) && IN((k) + 1))
    const pg8::bf16_t* wsb = (const pg8::bf16_t*)args.ws;
#define WSB(off) ((const pg8::bf16_t*)(args.ws + (off)))

    unsigned long long t_lo_ = 0, t_hi_ = 0;
    TMARK(0);
    if (IN(0)) {   }

    TMARK(1);
    if (IN(1)) for (int rep_ = 0; rep_ < NREP(1); ++rep_) {
        const int bx = (int)blockIdx.x; const bool gemm_wg = bx < P1_GEMM_WG;
        pg8::Gemm g = pg8::make_gemm(WSB(WS_HN), WSB(WS_WINT), D, D, D); InProjOrder S{P1_GEMM_WG, gemm_wg ? bx : 512};
        EpiInProj E{(unsigned short*)(args.ws + WS_Q), (bf16*)(args.ws + WS_UCAT), LOG2E * 0.125f};
        if (gemm_wg) { XcdBarrier bar2 = xcd_barrier_post((unsigned*)(F.ctl + CW_BAR2), F.MISC + 10, (unsigned)P1_GEMM_WG);
            p0_prologue(F, t_lo_, t_hi_);
            xcd_barrier(bar2); }
        pg8::gemm_phase<EpiInProj, InProjOrder, PG8_ALIGN, PG8_SP2>(F.lds + RING_OFF, g, S, E);
        if (gemm_wg && F.tid == 0) __hip_atomic_fetch_add((unsigned*)(F.ctl + CW_DONE1), 1u, RLX_AGENT);
        p1_side(F, (bx >= P1_GEMM_WG && bx < P1_GEMM_WG + NG) ? bx - P1_GEMM_WG : -1);
        if (BOTH(1)) GRID_BAR(1);
    }
    TMARK(2);
    if (IN(2)) for (int rep_ = 0; rep_ < NREP(2); ++rep_) {
        const int bx = (int)blockIdx.x;
        if (bx < NG * 4) {
            XcdBarrier bar3 = xcd_barrier_post((unsigned*)(F.ctl + CW_BAR3), F.MISC + 12, (unsigned)(NG * 4));
            if (bx < NG * 2) { pg8::Gemm g = pg8::make_gemm(WSB(WS_UCAT), WSB(WS_WE), NG * UK, 512, 512); SsmOrder S{NG * 2, F.G, bx, 1, 128, 512};
                EpiSloc E{(float*)(args.ws + WS_SLOC)};
                pg8::gemm_phase<EpiSloc, SsmOrder, PG8_ALIGN, PG8_SP2>(F.lds + RING_OFF, g, S, E); }
            else attn_one(F, (bx - NG * 2) * 8 + F.wave);
            xcd_barrier(bar3);
            if (bx < NG * 2) { scan_phase(F, bx); q1_drain(F, 1, nullptr, 0u); } else attn_one(F, 512 + (bx - NG * 2) * 8 + F.wave);
            xcd_barrier(bar3);
            { pg8::Gemm g = pg8::make_gemm(WSB(WS_UCAT), WSB(WS_TW), NG * UK, UK, UK); SsmOrder S{NG * 4, F.G, bx, 2, 512, UK};
              EpiS3 E{(bf16*)(args.ws + WS_YG)};
              pg8::gemm_phase<EpiS3, SsmOrder, PG8_ALIGN, PG8_SP2>(F.lds + RING_OFF, g, S, E); }
        } else {
            const int w = (bx - NG * 4) * 8 + F.wave;
#pragma unroll 1
            for (int j = 0; j < 3; ++j) attn_one(F, 1024 + w + 1024 * j);
            q1_drain(F, 1, nullptr, 0u);
        }
        if (BOTH(4)) GRID_BAR(4);
    }
    TMARK(3); TMARK(4);
    TMARK(5);
    if (IN(5)) for (int rep_ = 0; rep_ < NREP(5); ++rep_) {
        pg8::Gemm g = pg8::make_gemm(WSB(WS_YG), WSB(WS_WGLUT), SSW, SSW, SSW); pg8::StaticOrder S; S.init(M, 2 * SSW, F.G, (int)blockIdx.x, SSW, SSW);
        EpiGlu E{(bf16*)(args.ws + WS_YCAT), (float*)(args.ws + WS_SSQSSM)};
        pg8::gemm_phase<EpiGlu, pg8::StaticOrder, PG8_ALIGN, PG8_SP2>(F.lds + RING_OFF, g, S, E);
        if (BOTH(5)) GRID_BAR(5);
    }
    TMARK(6);
    if (IN(6)) {   }
    TMARK(7);
    if (IN(7)) for (int rep_ = 0; rep_ < NREP(7); ++rep_) {
        pg8::Gemm g = pg8::make_gemm(WSB(WS_YCAT), WSB(WS_WOUTT), D, D, D); pg8::StaticOrder S; S.init(M, D, F.G, (int)blockIdx.x, D, D);
        LAS float* rtab = (LAS float*)(F.lds + TOKMAP_OFF);
        { pg8::Unit u0; if (S.next(0, u0) && F.tid < 256) { const int row = u0.pm * 256 + F.tid; const float* pa = (const float*)(args.ws + WS_SSQSB) + (size_t)row * NH; const float* pb = (const float*)(args.ws + WS_SSQSSM) + (size_t)row * 16;
              float sa = 0.f, sb = 0.f;
#pragma unroll
              for (int i = 0; i < NH; ++i) sa += pa[i];
#pragma unroll
              for (int i = 0; i < 16; ++i) sb += pb[i];
              const float ra = 1.0f / sqrtf(sa * (1.f / SBW) + EPS), rb = 1.0f / sqrtf(sb * (1.f / SSW) + EPS); rtab[F.tid] = ra / rb; rtab[256 + F.tid] = rb; }
          __syncthreads(); }
        EpiOutProj E{F.in[0], args.ws, rtab, rtab + 256};
        pg8::gemm_phase<EpiOutProj, pg8::StaticOrder, PG8_ALIGN, PG8_SP2>(F.lds + RING_OFF, g, S, E);
        if (BOTH(7)) GRID_BAR(7);
    }
    TMARK(8);
    if (IN(8) && !DBG_MODE) for (int rep_ = 0; rep_ < NREP(8); ++rep_) { router_phase(F); q1_drain(F, -1, nullptr, 0u);
        if (BOTH(8)) GRID_BAR(8); }
    TMARK(9);
    if (IN(9) && !DBG_MODE) for (int rep_ = 0; rep_ < NREP(9); ++rep_) {   }
    TMARK(10);
    if (IN(10) && !DBG_MODE) for (int rep_ = 0; rep_ < NREP(10); ++rep_) {
        moe_tables(F); moe_units(F, 8, 4); moe_gather_tables(F);
        pg8::Gemm g = pg8::make_gemm(WSB(WS_XN), WSB(WS_W1T), D / 2, D, D); g.brs = 16u; g.bks = 2u * FF * 16u; g.tokmap = (const PG8_LAS int*)(F.lds + TOKMAP_OFF);
        MoeOrder S{(const LAS int*)(F.lds + UNITS_OFF), (long)2 * FF * D, 1};
        EpiMoe1 E{args.ws + WS_H, F.in[19], F.in[21], (const int*)(args.ws + WS_ROWINFO)};
        pg8::gemm_phase<EpiMoe1, MoeOrder, PG8_ALIGN, PG8_SP2, true, MOE1_MODE>(F.lds + RING_OFF, g, S, E);
        w2_drain(F, -1);
        if (BOTH(10)) GRID_BAR(10);
    }
    TMARK(11);
    if (IN(11) && !DBG_MODE) for (int rep_ = 0; rep_ < NREP(11); ++rep_) {
        moe_tables(F); moe_units(F, 4, 4);
        pg8::Gemm g = pg8::make_gemm(WSB(WS_H), WSB(WS_W2T), FF / 2, FF, FF); g.brs = 16u; g.bks = (unsigned)D * 16u; MoeOrder S{(const LAS int*)(F.lds + UNITS_OFF), (long)D * FF, 0};
        EpiMoe2 E{(bf16*)(args.ws + WS_YBUF), F.in[23], (const int*)(args.ws + WS_ROWINFO)};
        pg8::gemm_phase<EpiMoe2, MoeOrder, PG8_ALIGN, PG8_SP2, false, MOE2_MODE>(F.lds + RING_OFF, g, S, E);
        if (BOTH(11)) GRID_BAR(11);
    }
    TMARK(12);
    if (IN(12)) for (int rep_ = 0; rep_ < NREP(12); ++rep_) { final_phase(F); }
    TMARK(13);
    if ((TIME_LO) >= 0 && blockIdx.x == (TIME_BLK) && F.tid == 0) { const unsigned long long te = __builtin_amdgcn_s_memrealtime(), dt = 4ull * (t_hi_ - t_lo_); while (__builtin_amdgcn_s_memrealtime() - te < dt) __builtin_amdgcn_s_sleep(32); }
    (void)wsb;
#undef IN
#undef BOTH
}

extern "C" void kernel_launch(void* const* d_in, const int* in_sizes, int n_in, void* d_out, int out_size, void* d_ws, size_t ws_size, hipStream_t stream) {
    static int grid = 0;
    if (grid == 0) {
        if (n_in != 25 || in_sizes[0] != M * D || out_size != M * D || ws_size < WS_END) { fprintf(stderr, "kernel_launch: unexpected shapes: n_in %d in0 %d out %d ws %zu (need %zu); nothing launched\n", n_in, n_in > 0 ? in_sizes[0] : -1, out_size, ws_size, (size_t)WS_END); grid = -1; return; }
        int dev = 0, cus = 0, per_cu = 0;
        if (hipGetDevice(&dev) != hipSuccess || hipDeviceGetAttribute(&cus, hipDeviceAttributeMultiprocessorCount, dev) != hipSuccess) { grid = -1; return; }
        if (hipFuncSetAttribute((const void*)hyb_fwd, hipFuncAttributeMaxDynamicSharedMemorySize, LDS_BYTES) != hipSuccess) { fprintf(stderr, "kernel_launch: hipFuncSetAttribute failed\n"); grid = -1; return; }
        if (hipOccupancyMaxActiveBlocksPerMultiprocessor(&per_cu, (const void*)hyb_fwd, NWAVES * 64, LDS_BYTES) != hipSuccess || per_cu < 1)
            fprintf(stderr, "kernel_launch: note: occupancy query reports %d workgroups per CU\n", per_cu);
        (void)hipGetLastError();
        grid = cus;
        if (grid != 256) fprintf(stderr, "kernel_launch: note: %d CUs (built for 256)\n", grid);
    }
    if (grid < 0) return;
    if (hipMemsetAsync((char*)d_ws + WS_CTL, 0, CTL_ZERO_BYTES, stream) != hipSuccess) { fprintf(stderr, "kernel_launch: memset failed\n"); return; }
    Args a{};
    for (int i = 0; i < 25; ++i) a.in[i] = (const float*)d_in[i];
    a.out = (float*)d_out; a.ws = (unsigned char*)d_ws;
    for (int li = 0; li < N_LAUNCHES; ++li) {
        a.ph_lo = (N_LAUNCHES == PER_PHASE) ? li : 0; a.ph_hi = (N_LAUNCHES == PER_PHASE) ? li + 1 : PER_PHASE; a.li = li;
        hipLaunchKernelGGL(hyb_fwd, dim3(grid), dim3(NWAVES * 64), LDS_BYTES, stream, a);
        const hipError_t le = hipPeekAtLastError();
        if (le != hipSuccess) { fprintf(stderr, "kernel_launch: launch %d failed: %s\n", li, hipGetErrorName(le)); break; }
    }
}
```

```cpp
#include <hip/hip_runtime.h>
#include <cstdio>
#include <cstdint>
namespace pg8 {
#define PG8_LAS __attribute__((address_space(3)))
typedef unsigned short bf16_t;
typedef short bf16x8 __attribute__((ext_vector_type(8)));
typedef float f32x4 __attribute__((ext_vector_type(4)));
typedef unsigned u32x4 __attribute__((ext_vector_type(4)));
typedef long l64x2 __attribute__((ext_vector_type(2)));
typedef int i32x4 __attribute__((ext_vector_type(4)));
typedef int i32x8 __attribute__((ext_vector_type(8)));
constexpr int BM = 256, BK = 64, HALF = 128, HTB = HALF * BK * 2  , STAGE_BYTES = 8 * HTB, NXCD = 8, WGM = 8;

__host__ __device__ __forceinline__ int lds_byte(int r, int c) { const int st = (r >> 4) * 2 + (c >> 5), rr = r & 15, cc = c & 31, ob = rr * 64 + cc * 2; return st * 1024 + (ob ^ (((ob >> 9) & 1) << 5)); }
__host__ __device__ __forceinline__ void stage_rc(int b, int& R, int& C) { const int st = b / 1024, sb = b % 1024, swz = sb ^ (((sb >> 9) & 1) << 5); R = (st >> 1) * 16 + swz / 64; C = (st & 1) * 32 + (swz % 64) / 2; }
__host__ __device__ __forceinline__ int perm32(int rho) { const int n = rho >> 4, i = rho & 15; return 8 * (i >> 2) + 4 * n + (i & 3); }

struct Unit { int pm, pn, e, slot; long offA, offB; };
struct Gemm { const bf16_t* A; const bf16_t* Bt; int lda, K; unsigned brs, bks; const PG8_LAS int* tokmap; };
__host__ __device__ __forceinline__ Gemm make_gemm(const bf16_t* A, const bf16_t* Bt, int lda, int ldb, int K) { Gemm g; g.A = A; g.Bt = Bt; g.lda = lda; g.K = K; g.brs = (unsigned)ldb * 2u; g.bks = 16u; g.tokmap = nullptr; return g; }

__host__ __device__ __forceinline__ int xcd_remap(int wgid, int nwg) { const int q = nwg / NXCD, r = nwg % NXCD, xcd = wgid % NXCD, off = wgid / NXCD; return (xcd < r ? xcd * (q + 1) : r * (q + 1) + (xcd - r) * q) + off; }

struct StaticOrder {
    int nM, nN, nwg, G, c, lda, ldb;
    __host__ __device__ void init(int M, int N, int G_, int c_, int lda_, int ldb_) { nM = M / BM; nN = N / BM; nwg = nM * nN; G = G_; c = c_; lda = lda_; ldb = ldb_; }
    __host__ __device__ __forceinline__ bool next(int i, Unit& u) const {
        const long L = (long)i * G + c; if (L >= nwg) return false;
        const int wgid = xcd_remap((int)L, nwg);
        const int nig = WGM * nN, gid = wgid / nig, fm = gid * WGM, gsz = (nM - fm) < WGM ? (nM - fm) : WGM;
        u.pm = fm + ((wgid % nig) % gsz); u.pn = (wgid % nig) / gsz; u.e = 0; u.slot = 0;
        u.offA = (long)u.pm * BM * lda * 2; u.offB = (long)u.pn * BM * ldb * 2; return true;
    }
    __device__ __forceinline__ void a_ready(const Unit&) const {}
    __device__ __forceinline__ void done(const Unit&) const {}
};

__device__ __forceinline__ unsigned cvt_pk_bf16(float lo, float hi) { unsigned r; asm volatile("v_cvt_pk_bf16_f32 %0, %1, %2" : "=v"(r) : "v"(lo), "v"(hi)); return r; }
typedef float f32x2 __attribute__((ext_vector_type(2)));

template <class Epi, class Sched, bool ALIGN_EPI = false, bool SP2 = false, bool GATHER = false, int FP8 = 0>
__device__ __forceinline__ void gemm_phase(PG8_LAS unsigned char* lds, const Gemm g, const Sched& S, const Epi& E) {
    static_assert(!GATHER || SP2, "the gather form is written for the two-super-phase loop only");
    const int tid = threadIdx.x, wid = __builtin_amdgcn_readfirstlane(tid >> 6), lane = tid & 63, wr = wid >> 2, wc = wid & 3, fr = lane & 15, fq = lane >> 4;
    const int K = g.K, nt = K / (FP8 ? 2 * BK : BK);
    unsigned voffA[2], voffB[2]; int RA[2];
#pragma unroll
    for (int i = 0; i < 2; ++i) { int R, C; stage_rc(tid * 16 + i * 8192, R, C); const int Rb = Epi::PERM ? ((R & ~31) + perm32(R & 31)) : R; RA[i] = R;
        voffA[i] = GATHER ? (unsigned)C * 2u : (unsigned)(R * g.lda + C) * 2u; voffB[i] = (unsigned)Rb * g.brs + (unsigned)(C >> 3) * g.bks; }
    const size_t kstepA = (size_t)(BK * 2), kstepB = (size_t)8 * g.bks;
    const size_t hstepA = (size_t)HALF * g.lda * 2, hstepB = (size_t)HALF * g.brs;
    const unsigned ldsw = (unsigned)wid * 1024u;
    const int aoff = lds_byte(wr * 64 + fr, fq * 8), boff = lds_byte(wc * 32 + fr, fq * 8);
#define PG8_SA(b, h) (((b) * 2 + (h)) * HTB)
#define PG8_SB(b, h) ((4 + (b) * 2 + (h)) * HTB)
#define PG8_STAGE(bufoff, gbase, voff) do { _Pragma("unroll") for (int _i = 0; _i < 2; ++_i) \
        __builtin_amdgcn_global_load_lds((const unsigned*)((const char*)(gbase) + (voff)[_i]), (PG8_LAS unsigned*)(lds + (bufoff) + ldsw + _i * 8192), 16, 0, 0); } while (0)
    unsigned ga[2][2], gn[2][2], gw[2][2];
#define PG8_GLOAD(dst, u) do { if constexpr (GATHER) { const PG8_LAS int* _tm = g.tokmap + 256 * (u).slot; _Pragma("unroll") for (int _h = 0; _h < 2; ++_h) _Pragma("unroll") for (int _i = 0; _i < 2; ++_i) \
        dst[_h][_i] = (unsigned)_tm[128 * _h + RA[_i]] * (unsigned)(g.lda * 2) + voffA[_i]; } } while (0)
#define PG8_STAGE_A(bufoff, gbase, half, GX) do { if constexpr (GATHER) { PG8_STAGE(bufoff, gbase, GX[half]); } else { PG8_STAGE(bufoff, (gbase) + (half) * hstepA, voffA); } } while (0)
#define PG8_LDA(dst, b, h) do { _Pragma("unroll") for (int m = 0; m < 4; ++m) { if constexpr (FP8 == 2) { const i32x4 _lo = *(const PG8_LAS i32x4*)(lds + PG8_SA(b, h) + aoff + m * 2048), _hi = *(const PG8_LAS i32x4*)(lds + PG8_SA(b, h) + aoff + m * 2048 + 1024); dst##8[m] = __builtin_shufflevector(_lo, _hi, 0, 1, 2, 3, 4, 5, 6, 7); } \
        else { _Pragma("unroll") for (int k = 0; k < 2; ++k) dst[m][k] = *(const PG8_LAS bf16x8*)(lds + PG8_SA(b, h) + aoff + m * 2048 + k * 1024); } } } while (0)
#define PG8_LDB(dst, b, h) do { _Pragma("unroll") for (int n = 0; n < 2; ++n) { if constexpr (FP8 == 2) { const i32x4 _lo = *(const PG8_LAS i32x4*)(lds + PG8_SB(b, h) + boff + n * 2048), _hi = *(const PG8_LAS i32x4*)(lds + PG8_SB(b, h) + boff + n * 2048 + 1024); dst##8[n] = __builtin_shufflevector(_lo, _hi, 0, 1, 2, 3, 4, 5, 6, 7); } \
        else { _Pragma("unroll") for (int k = 0; k < 2; ++k) dst[n][k] = *(const PG8_LAS bf16x8*)(lds + PG8_SB(b, h) + boff + n * 2048 + k * 1024); } } } while (0)
#define PG8_MMA(ai, bj, At, Bt) do { __builtin_amdgcn_s_setprio(1); \
        if constexpr (FP8 == 2) { _Pragma("unroll") for (int m = 0; m < 4; ++m) _Pragma("unroll") for (int n = 0; n < 2; ++n) \
            asm volatile("v_mfma_scale_f32_16x16x128_f8f6f4 %0, %1, %2, %0, %3, %3 op_sel_hi:[0,0,0]" : "+v"(acc[ai][bj][m][n]) : "v"(Bt##8[n]), "v"(At##8[m]), "v"(sc127)); } \
        else if constexpr (FP8 == 1) { _Pragma("unroll") for (int k = 0; k < 2; ++k) _Pragma("unroll") for (int hf = 0; hf < 2; ++hf) _Pragma("unroll") for (int m = 0; m < 4; ++m) _Pragma("unroll") for (int n = 0; n < 2; ++n) { \
            const l64x2 _a = __builtin_bit_cast(l64x2, At[m][k]), _b = __builtin_bit_cast(l64x2, Bt[n][k]); const long _a0 = hf ? _a.y : _a.x, _b0 = hf ? _b.y : _b.x; \
            acc[ai][bj][m][n] = __builtin_amdgcn_mfma_f32_16x16x32_fp8_fp8(_b0, _a0, acc[ai][bj][m][n], 0, 0, 0); } } \
        else { _Pragma("unroll") for (int m = 0; m < 4; ++m) _Pragma("unroll") for (int n = 0; n < 2; ++n) _Pragma("unroll") for (int k = 0; k < 2; ++k) \
            acc[ai][bj][m][n] = __builtin_amdgcn_mfma_f32_16x16x32_bf16(Bt[n][k], At[m][k], acc[ai][bj][m][n], 0, 0, 0); } __builtin_amdgcn_s_setprio(0); } while (0)
#define PG8_WAIT_V(n) asm volatile("s_waitcnt vmcnt(" #n ")" ::: "memory")
#define PG8_WAIT_L(n) asm volatile("s_waitcnt lgkmcnt(" #n ")" ::: "memory")
#define PG8_BAR __builtin_amdgcn_s_barrier()
#define PG8_SCHED __builtin_amdgcn_sched_barrier(0)
    Unit cur, nxt; int ui = 0;
    if (!S.next(0, cur)) return;
    f32x4 acc[2][2][4][2];
#pragma unroll
    for (int a = 0; a < 2; ++a)
#pragma unroll
        for (int b = 0; b < 2; ++b)
#pragma unroll
            for (int m = 0; m < 4; ++m)
#pragma unroll
                for (int n = 0; n < 2; ++n) acc[a][b][m][n] = (f32x4){0.f, 0.f, 0.f, 0.f};
    bf16x8 At[4][2], B0[2][2], B1[2][2];
    i32x8 At8[4], B08[2], B18[2]; const int sc127 = 0x7f7f7f7f;
    const char* cA = (const char*)g.A + cur.offA; const char* cB = (const char*)g.Bt + cur.offB;
    S.a_ready(cur);
    if constexpr (SP2) {
        PG8_GLOAD(ga, cur);
        PG8_STAGE(PG8_SB(0, 0), cB, voffB); PG8_STAGE(PG8_SB(0, 1), cB + hstepB, voffB); PG8_STAGE_A(PG8_SA(0, 0), cA, 0, ga); PG8_STAGE_A(PG8_SA(0, 1), cA, 1, ga);
        if (wr == 1) PG8_BAR;
        PG8_WAIT_V(2); PG8_BAR;
        PG8_STAGE(PG8_SB(1, 0), cB + kstepB, voffB); PG8_STAGE_A(PG8_SA(1, 0), cA + kstepA, 0, ga); PG8_STAGE(PG8_SB(1, 1), cB + hstepB + kstepB, voffB);
        PG8_WAIT_V(6); PG8_BAR;
    } else {
        PG8_STAGE(PG8_SB(0, 0), cB, voffB); PG8_STAGE(PG8_SA(0, 0), cA, voffA); PG8_STAGE(PG8_SB(0, 1), cB + hstepB, voffB); PG8_STAGE(PG8_SA(0, 1), cA + hstepA, voffA);
        if (wr == 1) PG8_BAR;
        PG8_WAIT_V(4); PG8_BAR;
        PG8_STAGE(PG8_SB(1, 0), cB + kstepB, voffB); PG8_STAGE(PG8_SA(1, 0), cA + kstepA, voffA); PG8_STAGE(PG8_SB(1, 1), cB + hstepB + kstepB, voffB);
        PG8_WAIT_V(6); PG8_BAR;
    }
    for (;;) {
        const bool has_next = S.next(ui + 1, nxt);
        if constexpr (GATHER) { if (has_next) { PG8_GLOAD(gn, nxt); } else { _Pragma("unroll") for (int _h = 0; _h < 2; ++_h) _Pragma("unroll") for (int _i = 0; _i < 2; ++_i) gn[_h][_i] = ga[_h][_i]; } }
        const char* nA = has_next ? (const char*)g.A + nxt.offA : cA; const char* nB = has_next ? (const char*)g.Bt + nxt.offB : cB;
        for (int t = 0; t < nt; t += 2) {
            const bool last = (t == nt - 2);
            const char* a1 = cA + (size_t)(t + 1) * kstepA;
            const char* a2 = last ? nA : cA + (size_t)(t + 2) * kstepA; const char* b2 = last ? nB : cB + (size_t)(t + 2) * kstepB;
            const char* a3 = a2 + kstepA; const char* b3 = b2 + kstepB;
            if (last && has_next) S.a_ready(nxt);
            if constexpr (GATHER) { _Pragma("unroll") for (int _h = 0; _h < 2; ++_h) _Pragma("unroll") for (int _i = 0; _i < 2; ++_i) gw[_h][_i] = last ? gn[_h][_i] : ga[_h][_i]; }
            if constexpr (Epi::MIDK) { if (t == nt / 2) E.mid(acc, cur, wr, wc, fr, fq); }
            if constexpr (SP2) {
            PG8_LDB(B0, 0, 0); PG8_LDB(B1, 0, 1); PG8_SCHED; PG8_LDA(At, 0, 0); PG8_STAGE_A(PG8_SA(1, 1), a1, 1, ga);
            PG8_WAIT_V(8); PG8_WAIT_L(0); PG8_BAR; PG8_MMA(0, 0, At, B0); PG8_MMA(0, 1, At, B1); PG8_BAR; PG8_SCHED;
            PG8_LDA(At, 0, 1); PG8_STAGE(PG8_SB(0, 0), b2, voffB); PG8_STAGE(PG8_SB(0, 1), b2 + hstepB, voffB); PG8_STAGE_A(PG8_SA(0, 0), a2, 0, gw);
            PG8_WAIT_V(8); PG8_WAIT_L(0); PG8_BAR; PG8_MMA(1, 0, At, B0); PG8_MMA(1, 1, At, B1); PG8_BAR; PG8_SCHED;
            PG8_LDB(B0, 1, 0); PG8_LDB(B1, 1, 1); PG8_SCHED; PG8_LDA(At, 1, 0); PG8_STAGE_A(PG8_SA(0, 1), a2, 1, gw);
            PG8_WAIT_V(8); PG8_WAIT_L(0); PG8_BAR; PG8_MMA(0, 0, At, B0); PG8_MMA(0, 1, At, B1); PG8_BAR; PG8_SCHED;
            PG8_LDA(At, 1, 1); PG8_STAGE(PG8_SB(1, 0), b3, voffB); PG8_STAGE(PG8_SB(1, 1), b3 + hstepB, voffB); PG8_STAGE_A(PG8_SA(1, 0), a3, 0, gw);
            PG8_WAIT_V(8); PG8_WAIT_L(0); PG8_BAR; PG8_MMA(1, 0, At, B0); PG8_MMA(1, 1, At, B1); PG8_BAR; PG8_SCHED;
            } else {
            PG8_LDB(B0, 0, 0); PG8_SCHED; PG8_LDA(At, 0, 0); PG8_STAGE(PG8_SA(1, 1), a1 + hstepA, voffA);
            PG8_WAIT_L(8); PG8_BAR; PG8_WAIT_L(0); PG8_MMA(0, 0, At, B0); PG8_BAR; PG8_SCHED;
            PG8_LDB(B1, 0, 1); PG8_STAGE(PG8_SB(0, 0), b2, voffB);
            PG8_BAR; PG8_WAIT_L(0); PG8_MMA(0, 1, At, B1); PG8_BAR;
            PG8_LDA(At, 0, 1); PG8_STAGE(PG8_SA(0, 0), a2, voffA);
            PG8_BAR; PG8_WAIT_L(0); PG8_MMA(1, 0, At, B0); PG8_BAR; PG8_SCHED;
            PG8_STAGE(PG8_SB(0, 1), b2 + hstepB, voffB);
            PG8_WAIT_V(6); PG8_BAR; PG8_MMA(1, 1, At, B1); PG8_BAR;
            PG8_LDB(B0, 1, 0); PG8_SCHED; PG8_LDA(At, 1, 0); PG8_STAGE(PG8_SA(0, 1), a2 + hstepA, voffA);
            PG8_WAIT_L(8); PG8_BAR; PG8_WAIT_L(0); PG8_MMA(0, 0, At, B0); PG8_BAR; PG8_SCHED;
            PG8_LDB(B1, 1, 1); PG8_STAGE(PG8_SB(1, 0), b3, voffB);
            PG8_BAR; PG8_WAIT_L(0); PG8_MMA(0, 1, At, B1); PG8_BAR;
            PG8_LDA(At, 1, 1); PG8_STAGE(PG8_SA(1, 0), a3, voffA);
            PG8_BAR; PG8_WAIT_L(0); PG8_MMA(1, 0, At, B0); PG8_BAR; PG8_SCHED;
            PG8_STAGE(PG8_SB(1, 1), b3 + hstepB, voffB);
            PG8_WAIT_V(6); PG8_BAR; PG8_MMA(1, 1, At, B1); PG8_BAR;
            }
        }
        if constexpr (FP8 == 2) asm volatile("s_nop 15\n\ts_nop 15\n\ts_nop 15" ::: "memory");
        if constexpr (ALIGN_EPI) { if (wr == 0) PG8_BAR; }
        if constexpr (!Epi::AFTER_DRAIN) { E(acc, cur, wr, wc, fr, fq); S.done(cur); }
        if (!has_next) break;
#pragma unroll
        for (int a = 0; a < 2; ++a)
#pragma unroll
            for (int b = 0; b < 2; ++b)
#pragma unroll
                for (int m = 0; m < 4; ++m)
#pragma unroll
                    for (int n = 0; n < 2; ++n) acc[a][b][m][n] = (f32x4){0.f, 0.f, 0.f, 0.f};
        cur = nxt; cA = nA; cB = nB; ++ui;
        if constexpr (GATHER) { _Pragma("unroll") for (int _h = 0; _h < 2; ++_h) _Pragma("unroll") for (int _i = 0; _i < 2; ++_i) ga[_h][_i] = gn[_h][_i]; }
        if constexpr (ALIGN_EPI) { if (wr == 1) PG8_BAR; }
    }
    PG8_WAIT_V(0);
    if constexpr (!ALIGN_EPI) { if (wr == 0) PG8_BAR; }
    PG8_BAR;
    if constexpr (Epi::AFTER_DRAIN) { E.fused(acc, cur, wr, wc, fr, fq, lds, wid, lane); S.done(cur); }
#undef PG8_SA
#undef PG8_SB
#undef PG8_STAGE
#undef PG8_STAGE_A
#undef PG8_GLOAD
#undef PG8_LDA
#undef PG8_LDB
#undef PG8_MMA
#undef PG8_WAIT_V
#undef PG8_WAIT_L
#undef PG8_BAR
#undef PG8_SCHED
}
}

#ifndef PG8_SP2
#define PG8_SP2 true
#endif
#ifndef PG8_ALIGN
#define PG8_ALIGN true
#endif

constexpr int NWAVES = 8;
#ifndef MK_N_LAUNCHES
#define MK_N_LAUNCHES 1
#endif
#ifndef DBG_MODE
#define DBG_MODE 0
#endif
#ifndef REP_PHASE
#define REP_PHASE -1
#endif
#define NREP(k) ((REP_PHASE) == (k) ? 2 : 1)
#ifndef TIME_LO
#define TIME_LO -1
#endif
#ifndef TIME_HI
#define TIME_HI -1
#endif
#ifndef TIME_BLK
#define TIME_BLK 0
#endif
#define TMARK(j) do { if ((TIME_LO) >= 0 && blockIdx.x == (TIME_BLK) && F.tid == 0) { if ((j) == (TIME_LO)) t_lo_ = __builtin_amdgcn_s_memrealtime(); if ((j) == (TIME_HI)) t_hi_ = __builtin_amdgcn_s_memrealtime(); } } while (0)
constexpr int PER_PHASE = 13;
constexpr int N_LAUNCHES = MK_N_LAUNCHES;

constexpr int BATCH = 2, SEQ = 8192, D = 1024, M = BATCH * SEQ;
constexpr int SBW = 512, NH = 8, HD = 64;
constexpr int SSW = 512, NG = 32, GC = 16, NP = 64;
constexpr int NPROJ = 3 * SBW + SSW;
constexpr int LC = 32, NCHUNK = M / LC, CPB = SEQ / LC;
constexpr int UK = LC * GC + 2 * NP;
constexpr int NE = 32, TOPK = 4, FF = 1024, NASSIGN = M * TOPK;
constexpr int MAXTILES = (NASSIGN + NE * 255) / 256 + 1;
constexpr float EPS = 1e-5f;
constexpr float LOG2E = 1.4426950408889634f;

constexpr size_t MiB = 1u << 20;
constexpr size_t WS_CTL = 0, CTL_ZERO_BYTES = 128 * 1024;
constexpr size_t WS_LAML = 1 * MiB;
constexpr size_t WS_RSTD = 1 * MiB + 32 * 1024;
constexpr size_t WS_GATES = 1 * MiB + 128 * 1024;
constexpr size_t WS_ROWINFO = 1 * MiB + 512 * 1024;
constexpr size_t WS_RWIMG = 3 * MiB;
constexpr size_t WS_LISTS = 507 * MiB;
constexpr size_t WS_X1LO = 331 * MiB, WS_X1HI = 491 * MiB;
constexpr size_t WS_WINT = 4 * MiB, WS_WGLUT = 8 * MiB, WS_WOUTT = 9 * MiB, WS_W1T = 11 * MiB, WS_W2T = 139 * MiB;
constexpr size_t WS_R1 = 203 * MiB, WS_R2 = 347 * MiB, WS_END = 509 * MiB;
constexpr size_t WS_HN = WS_R1, WS_Q = WS_R1 + 32 * MiB, WS_K = WS_R1 + 48 * MiB, WS_V = WS_R1 + 64 * MiB, WS_UCAT = WS_R1 + 80 * MiB,
                 WS_SLOC = WS_R1 + 100 * MiB, WS_SSQSB = WS_R1 + 108 * MiB  , WS_SSQSSM = WS_R1 + 109 * MiB  , WS_YG = WS_R1 + 124 * MiB;
constexpr size_t WS_YBUF = WS_R1;
constexpr size_t WS_YCAT = WS_R2 + 16 * MiB  , WS_XN = WS_R1  , WS_WE = WS_R2 + 80 * MiB, WS_TW = WS_R2 + 85 * MiB;
constexpr size_t WS_H = WS_R2;
static_assert(WS_K == WS_Q + (size_t)M * SBW * 2 && WS_V == WS_K + (size_t)M * SBW * 2 && WS_YG + (size_t)M * SSW * 2 <= WS_R2 && WS_TW + (size_t)NG * 512 * UK * 2 <= WS_END, "ws map");
static_assert(WS_YBUF + (size_t)NASSIGN * D * 2 <= WS_X1LO && WS_H + (size_t)(MAXTILES - 1) * 256 * FF * 2 <= WS_END, "ws map 2");
static_assert(WS_ROWINFO + (size_t)MAXTILES * 256 * 16 <= 3 * MiB && WS_X1LO >= WS_YBUF + (size_t)NASSIGN * D * 2 && WS_X1LO + 16 * MiB <= WS_R2 && WS_X1HI >= WS_H + (size_t)(MAXTILES - 1) * 256 * FF * 2 && WS_X1HI + 16 * MiB <= WS_LISTS && WS_LISTS + (size_t)NE * M * 4 <= WS_END, "ws map 3");
constexpr int CW_TMO = 0, CW_CODE = 1;
constexpr int CW_BAR = 4096, CW_BAR2 = 8192, CW_BAR3 = 12288;
constexpr int CW_CNT = 16384;
constexpr int CW_Q0 = 16384 + 256, CW_Q1 = 16384 + 512, CW_Q2 = 16384 + 576;
constexpr int CW_DONE1 = 16384 + 640;
static_assert((16384 + 1024) * 4 <= (int)CTL_ZERO_BYTES, "control words inside the memset region");
constexpr int CW_AQ = 16384 + 320, CW_DONE2 = 16384 + 384, CW_DONE3 = 16384 + 448;

constexpr int RING_OFF = 0, RING_BYTES = 131072;
constexpr int RT_WSTR = 1028;
constexpr int RT_W_BYTES = 2 * NE * RT_WSTR * 2;
constexpr int RT_SCR_OFF = RT_W_BYTES;
constexpr int LDSCTL_OFF = 139264, MISC_OFF = LDSCTL_OFF + 320;
constexpr int TAB_OFF = LDSCTL_OFF + 512;
constexpr int UNITS_OFF = LDSCTL_OFF + 1024;
constexpr int TILEE_OFF = LDSCTL_OFF + 1536;
constexpr int TOKMAP_OFF = LDSCTL_OFF + 4096, TOKMAP_SLOTS = 10;
constexpr int LDS_BYTES = TOKMAP_OFF + TOKMAP_SLOTS * 1024;
static_assert(TILEE_OFF + MAXTILES * 4 <= LDS_BYTES && RT_SCR_OFF + 4096 <= LDSCTL_OFF, "LDS map");

#define GAS __attribute__((address_space(1)))
#define LAS __attribute__((address_space(3)))
typedef unsigned short bf16;
typedef unsigned v4u __attribute__((ext_vector_type(4)));
typedef unsigned v2u __attribute__((ext_vector_type(2)));
typedef float f32x4 __attribute__((ext_vector_type(4)));
typedef float f32x2 __attribute__((ext_vector_type(2)));
typedef _Float16 h16x2 __attribute__((ext_vector_type(2)));
typedef GAS unsigned gu32;
#define RLX_AGENT __ATOMIC_RELAXED, __HIP_MEMORY_SCOPE_AGENT
#define LDS_WAIT() asm volatile("s_waitcnt lgkmcnt(0)" ::: "memory")
#define VM_WAIT() asm volatile("s_waitcnt vmcnt(0)" ::: "memory")
__device__ __forceinline__ unsigned f2bf(float f) { unsigned u = __builtin_bit_cast(unsigned, f); return (u + 0x7fffu + ((u >> 16) & 1u)) >> 16; }
__device__ __forceinline__ unsigned pk2(float lo, float hi) { return f2bf(lo) | (f2bf(hi) << 16); }
__device__ __forceinline__ float bf2f(unsigned short b) { return __builtin_bit_cast(float, (unsigned)b << 16); }
__device__ __forceinline__ float bflo(unsigned w) { return __builtin_bit_cast(float, w << 16); }
__device__ __forceinline__ float bfhi(unsigned w) { return __builtin_bit_cast(float, w & 0xffff0000u); }
__device__ __forceinline__ unsigned pkh2(float lo, float hi) { h16x2 v; v.x = (_Float16)lo; v.y = (_Float16)hi; return __builtin_bit_cast(unsigned, v); }
__device__ __forceinline__ float fexp2(float x) { return __builtin_amdgcn_exp2f(x); }
__device__ __forceinline__ float flog2(float x) { return __builtin_amdgcn_logf(x); }
__device__ __forceinline__ float frcp(float x) { return __builtin_amdgcn_rcpf(x); }
__device__ __forceinline__ float sigmoidf_(float x) { return frcp(1.0f + fexp2(-LOG2E * x)); }
__device__ __forceinline__ float gelu_tanh(float v) { const float u = 0.7978845608028654f * (v + 0.044715f * v * v * v); return v * frcp(1.0f + fexp2(-2.0f * LOG2E * u)); }

__device__ __forceinline__ bf16* x1_row(unsigned char* ws, int m) { return (bf16*)(ws + (m < SEQ ? WS_X1LO : WS_X1HI - (size_t)SEQ * D * 2)) + (size_t)m * D; }
#ifndef MOE1_MODE
#define MOE1_MODE 2
#endif
#ifndef MOE2_MODE
#define MOE2_MODE 2
#endif
constexpr float WSCALE = 64.0f;
__device__ __forceinline__ float clamp448(float x) { return fminf(fmaxf(x, -448.0f), 448.0f); }
__device__ __forceinline__ unsigned pk4_fp8(float a, float b, float c, float d) {
    int w = __builtin_amdgcn_cvt_pk_fp8_f32(clamp448(a), clamp448(b), 0, false); w = __builtin_amdgcn_cvt_pk_fp8_f32(clamp448(c), clamp448(d), w, true); return (unsigned)w; }
#define XB_TMO      128
#define XB_XCNT(j)  (256  + 64 * (j))
#define XB_XSUB(j)  (1280 + 64 * (j))
#define XB_XGEN(j)  (2304 + 64 * (j))
#define XB_TOP      3328
#define XB_TOPGEN   3392
#define XCD_BAR_WORDS 3456
#define XB_SPIN_CAP (1u << 18)
__device__ __forceinline__ unsigned xb_ld(unsigned* p)              { return __hip_atomic_load(p, __ATOMIC_RELAXED, __HIP_MEMORY_SCOPE_AGENT); }
__device__ __forceinline__ unsigned xb_add(unsigned* p, unsigned v) { return __hip_atomic_fetch_add(p, v, __ATOMIC_RELAXED, __HIP_MEMORY_SCOPE_AGENT); }
__device__ __forceinline__ unsigned xb_xcc_id() { return (unsigned)__builtin_amdgcn_s_getreg((3 << 11) | 20) & 0xFu; }
#define XB_SPIN(cond, bar) do { unsigned _sp = 0; while (cond) { __builtin_amdgcn_s_sleep(1); \
    if ((++_sp & 255u) == 0u) { if (xb_ld(&(bar)[XB_TMO])) break; if (_sp > XB_SPIN_CAP) { atomicAdd(&(bar)[XB_TMO], 1u); break; } } } } while (0)
struct XcdBarrier { unsigned* bar; unsigned x; volatile LAS unsigned* st; unsigned G; };
__device__ __forceinline__ XcdBarrier xcd_barrier_post(unsigned* bar, volatile LAS unsigned* st, unsigned G) {
    XcdBarrier b; b.bar = bar; b.x = xb_xcc_id(); b.st = st; b.G = G;
    if (threadIdx.x == 0) (void)xb_add(&bar[XB_XCNT(b.x)], 1u);
    return b;
}
__device__ __forceinline__ void xcd_barrier_complete(unsigned* bar, unsigned x, unsigned G, unsigned& nloc, unsigned& nx) {
    unsigned sum, cnt, mine, sp = 0u;
    for (;;) {
        sum = 0u; cnt = 0u; mine = 0u;
#pragma unroll
        for (unsigned j = 0; j < 16; ++j) { const unsigned c = xb_ld(&bar[XB_XCNT(j)]); sum += c; cnt += (c > 0u) ? 1u : 0u; mine = (j == x) ? c : mine; }
        if (sum == G) break;
        __builtin_amdgcn_s_sleep(1);
        if ((++sp & 255u) == 0u) { if (xb_ld(&bar[XB_TMO])) break; if (sp > XB_SPIN_CAP) { atomicAdd(&bar[XB_TMO], 1u); break; } }
    }
    nloc = mine > 0u ? mine : 1u; nx = cnt > 0u ? cnt : 1u;
}
__device__ __forceinline__ void xcd_barrier(const XcdBarrier& b) {
    asm volatile("s_waitcnt vmcnt(0)" ::: "memory");
    __syncthreads();
    if (threadIdx.x == 0) {
        unsigned* bar = b.bar;
        __builtin_amdgcn_s_waitcnt(0);
        unsigned nloc = b.st[0], nx = b.st[1];
        if (nloc == 0u) { xcd_barrier_complete(bar, b.x, b.G, nloc, nx); b.st[0] = nloc; b.st[1] = nx; }
        const unsigned old = xb_add(&bar[XB_XSUB(b.x)], 1u);
        const unsigned gen = old / nloc;
        if (old + 1u == (gen + 1u) * nloc) {
            __builtin_amdgcn_fence(__ATOMIC_RELEASE, "agent");
            asm volatile("s_waitcnt vmcnt(0)" ::: "memory");
            const unsigned og = xb_add(&bar[XB_TOP], 1u);
            const unsigned tg = og / nx;
            if (og + 1u == (tg + 1u) * nx) xb_add(&bar[XB_TOPGEN], 1u);
            else XB_SPIN(xb_ld(&bar[XB_TOPGEN]) == tg, bar);
            __builtin_amdgcn_fence(__ATOMIC_ACQUIRE, "agent");
            xb_add(&bar[XB_XGEN(b.x)], 1u);
            asm volatile("s_waitcnt vmcnt(0)" ::: "memory");
        } else {
            XB_SPIN(xb_ld(&bar[XB_XGEN(b.x)]) == gen, bar);
            __builtin_amdgcn_fence(__ATOMIC_ACQUIRE, "agent");
            asm volatile("s_waitcnt vmcnt(0)" ::: "memory");
        }
    }
    __syncthreads();
}

struct Frame {
    LAS unsigned char* lds;
    volatile LAS unsigned* MISC;
    gu32* ctl;
    int tid, lane, wave;
    int vcu, G;
    unsigned char* ws;
    const float* in[25];
    float* out;
};

__device__ __forceinline__ float wave_sum(float v) {
#pragma unroll
    for (int o = 1; o < 64; o <<= 1) v += __shfl_xor(v, o);
    return v;
}

using pg8::Unit;
typedef pg8::f32x4 accv;
struct EpiInProj {
    static constexpr bool PERM = true, AFTER_DRAIN = false; static constexpr bool MIDK = false;
    unsigned short* QKV; bf16* U; float qscale;
    __device__ __forceinline__ void operator()(const accv (&acc)[2][2][4][2], const Unit& u, int wr, int wc, int fr, int fq) const {
        if (u.e == 1) {
            const int row0 = u.pm * 256 + wr * 64 + fr; const int colt = u.pn * 256 + wc * 32 + 8 * fq;
            _Float16* VT = (_Float16*)(QKV + (size_t)2 * M * SBW);
#pragma unroll
            for (int ai = 0; ai < 2; ++ai)
#pragma unroll
                for (int m = 0; m < 4; ++m) { const int row = row0 + ai * 128 + m * 16;
#pragma unroll
                    for (int bj = 0; bj < 2; ++bj) { const int tok = colt + bj * 128; const accv v0 = acc[ai][bj][m][0], v1 = acc[ai][bj][m][1];
                        const int bb = tok >> 13, sq = tok & (SEQ - 1); const int o = sq & 15;
                        _Float16* p = VT + ((size_t)bb * SBW + row) * SEQ + (sq & ~15) + (o >> 1);
                        v2u w0, w1; w0.x = pkh2(v0[0], v0[1]); w0.y = pkh2(v0[2], v0[3]); w1.x = pkh2(v1[0], v1[1]); w1.y = pkh2(v1[2], v1[3]);
                        *(v2u*)p = w0; *(v2u*)(p + 8) = w1; } }
            return;
        }
        const int kind = u.pn >> 1; const int colt = (u.pn & 1) * 256 + wc * 32 + 8 * fq; const int row0 = u.pm * 256 + wr * 64 + fr;
        unsigned short* T = QKV + (size_t)(kind < 2 ? kind : 0) * ((size_t)M * SBW); const float sc = kind == 0 ? qscale : 1.0f;
#pragma unroll
        for (int ai = 0; ai < 2; ++ai)
#pragma unroll
            for (int m = 0; m < 4; ++m) { const int row = row0 + ai * 128 + m * 16;
#pragma unroll
                for (int bj = 0; bj < 2; ++bj) { const int col = colt + bj * 128; const accv v0 = acc[ai][bj][m][0] * sc, v1 = acc[ai][bj][m][1] * sc; v4u w;
                    if (kind < 2) { w.x = pkh2(v0[0], v0[1]); w.y = pkh2(v0[2], v0[3]); w.z = pkh2(v1[0], v1[1]); w.w = pkh2(v1[2], v1[3]);
                        *(v4u*)(T + (size_t)row * SBW + col) = w; }
                    else { w.x = pg8::cvt_pk_bf16(v0[0], v0[1]); w.y = pg8::cvt_pk_bf16(v0[2], v0[3]); w.z = pg8::cvt_pk_bf16(v1[0], v1[1]); w.w = pg8::cvt_pk_bf16(v1[2], v1[3]);
                        *(v4u*)(U + ((size_t)(row >> 5) * NG + (col >> 4)) * UK + (row & 31) * GC + (col & 15)) = w; } } }
    }
};
struct EpiSloc {
    static constexpr bool PERM = false, AFTER_DRAIN = false; static constexpr bool MIDK = false;
    float* S;
    __device__ __forceinline__ void operator()(const accv (&acc)[2][2][4][2], const Unit& u, int wr, int wc, int fr, int fq) const {
        const int row0 = u.pm * 256 + wr * 64 + fr; const int col0 = wc * 32 + 4 * fq;
#pragma unroll
        for (int ai = 0; ai < 2; ++ai)
#pragma unroll
            for (int m = 0; m < 4; ++m) { const int row = row0 + ai * 128 + m * 16;
#pragma unroll
                for (int n = 0; n < 2; ++n) *(accv*)(S + ((size_t)row * NG + u.e) * 128 + col0 + 16 * n) = acc[ai][0][m][n]; }
    }
};
struct EpiS3 {
    static constexpr bool PERM = true, AFTER_DRAIN = false; static constexpr bool MIDK = false;
    bf16* YG;
    __device__ __forceinline__ void operator()(const accv (&acc)[2][2][4][2], const Unit& u, int wr, int wc, int fr, int fq) const {
        const int row0 = u.pm * 256 + wr * 64 + fr; const int colt = u.pn * 256 + wc * 32 + 8 * fq;
#pragma unroll
        for (int ai = 0; ai < 2; ++ai)
#pragma unroll
            for (int m = 0; m < 4; ++m) { const int row = row0 + ai * 128 + m * 16;
#pragma unroll
                for (int bj = 0; bj < 2; ++bj) { const int col = colt + bj * 128; const accv v0 = acc[ai][bj][m][0], v1 = acc[ai][bj][m][1]; v4u w;
                    w.x = pg8::cvt_pk_bf16(gelu_tanh(v0[0]), gelu_tanh(v0[1])); w.y = pg8::cvt_pk_bf16(gelu_tanh(v0[2]), gelu_tanh(v0[3]));
                    w.z = pg8::cvt_pk_bf16(gelu_tanh(v1[0]), gelu_tanh(v1[1])); w.w = pg8::cvt_pk_bf16(gelu_tanh(v1[2]), gelu_tanh(v1[3]));
                    *(v4u*)(YG + ((size_t)row * LC + (col >> 4)) * SSW + u.e * GC + (col & 15)) = w; } }
    }
};
struct EpiGlu {
    static constexpr bool PERM = true, AFTER_DRAIN = false; static constexpr bool MIDK = false;
    bf16* Y; float* SSQ;
    __device__ __forceinline__ void operator()(const accv (&acc)[2][2][4][2], const Unit& u, int wr, int wc, int fr, int fq) const {
        const int row0 = u.pm * 256 + wr * 64 + fr; const int col = u.pn * 128 + wc * 32 + 8 * fq;
#pragma unroll
        for (int ai = 0; ai < 2; ++ai)
#pragma unroll
            for (int m = 0; m < 4; ++m) { const int row = row0 + ai * 128 + m * 16; float r[8]; float sq = 0.f;
#pragma unroll
                for (int n = 0; n < 2; ++n)
#pragma unroll
                    for (int j = 0; j < 4; ++j) { r[4 * n + j] = acc[ai][0][m][n][j] * sigmoidf_(acc[ai][1][m][n][j]); sq += r[4 * n + j] * r[4 * n + j]; }
                sq += __shfl_xor(sq, 16); sq += __shfl_xor(sq, 32);
                if (fq == 0) SSQ[(size_t)row * 16 + u.pn * 4 + wc] = sq;
                v4u w; w.x = pg8::cvt_pk_bf16(r[0], r[1]); w.y = pg8::cvt_pk_bf16(r[2], r[3]); w.z = pg8::cvt_pk_bf16(r[4], r[5]); w.w = pg8::cvt_pk_bf16(r[6], r[7]);
                *(v4u*)(Y + (size_t)row * D + SBW + col) = w; }
    }
};
struct EpiOutProj {
    static constexpr bool PERM = true, AFTER_DRAIN = false; static constexpr bool MIDK = true;
    const float* X; unsigned char* ws; const LAS float* ratio; const LAS float* fin;
    __device__ __forceinline__ void mid(accv (&acc)[2][2][4][2], const Unit& u, int wr, int wc, int fr, int fq) const {
#pragma unroll
        for (int ai = 0; ai < 2; ++ai)
#pragma unroll
            for (int m = 0; m < 4; ++m) { const float rt = ratio[ai * 128 + wr * 64 + m * 16 + fr];
#pragma unroll
                for (int bj = 0; bj < 2; ++bj)
#pragma unroll
                    for (int n = 0; n < 2; ++n) acc[ai][bj][m][n] *= rt; }
    }
    __device__ __forceinline__ void operator()(const accv (&acc)[2][2][4][2], const Unit& u, int wr, int wc, int fr, int fq) const {
        const int row0 = u.pm * 256 + wr * 64 + fr; const int col0 = u.pn * 256 + wc * 32 + 8 * fq;
#pragma unroll
        for (int ai = 0; ai < 2; ++ai)
#pragma unroll
            for (int m = 0; m < 4; ++m) { const int row = row0 + ai * 128 + m * 16; const float* xr = X + (size_t)row * D + col0; bf16* orow = x1_row(ws, row) + col0; const float fs = fin[ai * 128 + wr * 64 + m * 16 + fr];
#pragma unroll
                for (int bj = 0; bj < 2; ++bj) { const accv x0 = *(const accv*)(xr + bj * 128), x1 = *(const accv*)(xr + bj * 128 + 4); const accv v0 = x0 + acc[ai][bj][m][0] * fs, v1 = x1 + acc[ai][bj][m][1] * fs;
                    v4u w; w.x = pg8::cvt_pk_bf16(v0[0], v0[1]); w.y = pg8::cvt_pk_bf16(v0[2], v0[3]); w.z = pg8::cvt_pk_bf16(v1[0], v1[1]); w.w = pg8::cvt_pk_bf16(v1[2], v1[3]);
                    *(v4u*)(orow + bj * 128) = w; }
                if (m & 1) asm volatile("" ::: "memory"); }
    }
};
struct EpiMoe1 {
    static constexpr bool PERM = true, AFTER_DRAIN = false; static constexpr bool MIDK = false;
    unsigned char* H; const float* bg; const float* bu; const int* rowinfo;
    __device__ __forceinline__ void operator()(const accv (&acc)[2][2][4][2], const Unit& u, int wr, int wc, int fr, int fq) const {
        const int row0 = u.pm * 256 + wr * 64 + fr; const int col = u.pn * 128 + wc * 32 + 8 * fq;
        float bgv[8], buv[8];
#pragma unroll
        for (int n = 0; n < 2; ++n) { const accv a = *(const accv*)(bg + u.e * FF + col + 4 * n), b = *(const accv*)(bu + u.e * FF + col + 4 * n);
#pragma unroll
            for (int j = 0; j < 4; ++j) { bgv[4 * n + j] = a[j]; buv[4 * n + j] = b[j]; } }
        float rsv[2][4];
#pragma unroll
        for (int ai = 0; ai < 2; ++ai)
#pragma unroll
            for (int m = 0; m < 4; ++m) rsv[ai][m] = __builtin_bit_cast(float, rowinfo[4 * (row0 + ai * 128 + m * 16) + 2]);
#pragma unroll
        for (int ai = 0; ai < 2; ++ai)
#pragma unroll
            for (int m = 0; m < 4; ++m) { const int row = row0 + ai * 128 + m * 16; float r[8]; const float rs = rsv[ai][m] * (1.0f / WSCALE);
#pragma unroll
                for (int n = 0; n < 2; ++n)
#pragma unroll
                    for (int j = 0; j < 4; ++j) { const float g = fminf(acc[ai][0][m][n][j] * rs + bgv[4 * n + j], 7.0f); const float up = fminf(fmaxf(acc[ai][1][m][n][j] * rs + buv[4 * n + j], -7.0f), 7.0f);
                        r[4 * n + j] = (up + 1.0f) * g * frcp(1.0f + fexp2(-1.702f * LOG2E * g)); }
                v2u w; w.x = pk4_fp8(r[0], r[1], r[2], r[3]); w.y = pk4_fp8(r[4], r[5], r[6], r[7]);
                *(v2u*)(H + (size_t)row * FF + col) = w; }
    }
};
struct EpiMoe2 {
    static constexpr bool PERM = true, AFTER_DRAIN = false; static constexpr bool MIDK = false;
    bf16* Y; const float* bd; const int* rowinfo;
    __device__ __forceinline__ void operator()(const accv (&acc)[2][2][4][2], const Unit& u, int wr, int wc, int fr, int fq) const {
        const int row0 = u.pm * 256 + wr * 64 + fr; const int colt = u.pn * 256 + wc * 32 + 8 * fq;
        float bv[2][8];
#pragma unroll
        for (int bj = 0; bj < 2; ++bj)
#pragma unroll
            for (int n = 0; n < 2; ++n) { const accv a = *(const accv*)(bd + u.e * D + colt + bj * 128 + 4 * n);
#pragma unroll
                for (int j = 0; j < 4; ++j) bv[bj][4 * n + j] = a[j]; }
        v2u sg[2][4];
#pragma unroll
        for (int ai = 0; ai < 2; ++ai)
#pragma unroll
            for (int m = 0; m < 4; ++m) sg[ai][m] = *(const v2u*)(rowinfo + 4 * (row0 + ai * 128 + m * 16));
#pragma unroll
        for (int ai = 0; ai < 2; ++ai)
#pragma unroll
            for (int m = 0; m < 4; ++m) { const int slot = (int)sg[ai][m].x; const unsigned gbits = sg[ai][m].y; const float gate = __builtin_bit_cast(float, gbits);
                if (slot >= 0) {
#pragma unroll
                    for (int bj = 0; bj < 2; ++bj) { float r[8];
#pragma unroll
                        for (int n = 0; n < 2; ++n)
#pragma unroll
                            for (int j = 0; j < 4; ++j) r[4 * n + j] = (acc[ai][bj][m][n][j] * (1.0f / WSCALE) + bv[bj][4 * n + j]) * gate;
                        v4u w; w.x = pg8::cvt_pk_bf16(r[0], r[1]); w.y = pg8::cvt_pk_bf16(r[2], r[3]); w.z = pg8::cvt_pk_bf16(r[4], r[5]); w.w = pg8::cvt_pk_bf16(r[6], r[7]);
                        *(v4u*)(Y + (size_t)slot * D + colt + bj * 128) = w; } } }
    }
};

struct InProjOrder {
    int G, c;
    __device__ bool next(int i, Unit& u) const {
        const int L = i * G + c; if (L >= 512) return false;
        const int s = pg8::xcd_remap(L, 512);
        if (s < 384) { const int grp = s / 48, r = s % 48; u.slot = 0; u.pm = grp * 8 + (r & 7); const int pi = r >> 3; u.pn = pi < 4 ? pi : pi + 2; u.e = 0;
            u.offA = (long)u.pm * 256 * D * 2; u.offB = (long)u.pn * 256 * D * 2; }
        else { const int r = s - 384; u.slot = 0; u.pm = r & 1; u.pn = r >> 1; u.e = 1;
            u.offA = (long)(WS_WINT - WS_HN) + (long)(1024 + u.pm * 256) * D * 2; u.offB = (long)(WS_HN - WS_WINT) + (long)u.pn * 256 * D * 2; }
        return true;
    }
    __device__ __forceinline__ void a_ready(const Unit&) const {}
    __device__ __forceinline__ void done(const Unit&) const {}
};
struct SsmOrder {
    int nwg, G, c, npn, rows_per_g, ldb;
    __device__ bool next(int i, Unit& u) const {
        const int L = i * G + c; if (L >= nwg) return false;
        const int per_g = 2 * npn; const int g = L / per_g, r = L % per_g;
        u.e = g; u.pm = r / npn; u.pn = r % npn; u.slot = 0;
        u.offA = ((long)u.pm * 256 * NG * UK + (long)g * UK) * 2; u.offB = ((long)g * rows_per_g + (long)u.pn * 256) * ldb * 2; return true;
    }
    __device__ __forceinline__ void a_ready(const Unit&) const {}
    __device__ __forceinline__ void done(const Unit&) const {}
};
struct MoeOrder {
    const LAS int* units; long ebytes; int gather;
    __device__ bool next(int i, Unit& u) const {
        if (i >= 32) return false;
        const int v = __builtin_amdgcn_readfirstlane(units[4 * i + 3]); if (!v) return false;
        u.pm = __builtin_amdgcn_readfirstlane(units[4 * i + 0]); u.pn = __builtin_amdgcn_readfirstlane(units[4 * i + 1]); u.e = __builtin_amdgcn_readfirstlane(units[4 * i + 2]);
        u.slot = i; u.offA = gather ? 0l : (long)u.pm * 256 * D;     u.offB = (long)u.e * ebytes + (long)u.pn * 256 * 16; return true;
    }
    __device__ __forceinline__ void a_ready(const Unit&) const {}
    __device__ __forceinline__ void done(const Unit&) const {}
};

struct CvItem { const float* src; bf16* dst; const float* kscale; int ldw, K, rmul, radd, k0, n0; };
constexpr int CV_I_IN = (D / 64) * (NPROJ / 32), CV_I_GLU = (SSW / 64) * (SSW / 32), CV_I_OUT = (D / 64) * (D / 32), CV_I_E = (D / 64) * (FF / 32);
constexpr int CV_N_EARLY = CV_I_IN + 2 * CV_I_GLU + CV_I_OUT, CV_N_EXP = 3 * NE * (D / 8);
__device__ __forceinline__ void cv_set(CvItem& c, const float* W, int ldw, int K, int N, bf16* WT, int rmul, int radd, int item) {
    const int nblk = N / 32, kb = item / nblk, nb = item % nblk; c.src = W; c.dst = WT; c.kscale = nullptr; c.ldw = ldw; c.K = K; c.rmul = rmul; c.radd = radd; c.k0 = 64 * kb; c.n0 = 32 * nb;
}
__device__ __forceinline__ void cv_decode_early(Frame& F, int r, CvItem& c) {
    bf16* WinT = (bf16*)(F.ws + WS_WINT); bf16* WgluT = (bf16*)(F.ws + WS_WGLUT); bf16* WoutT = (bf16*)(F.ws + WS_WOUTT);
    if (r < CV_I_IN) { cv_set(c, F.in[2], NPROJ, D, NPROJ, WinT, 1, 0, r); return; } r -= CV_I_IN;
    if (r < CV_I_GLU) { cv_set(c, F.in[11], 2 * SSW, SSW, SSW, WgluT, 2, 0, r); return; } r -= CV_I_GLU;
    if (r < CV_I_GLU) { cv_set(c, F.in[11] + SSW, 2 * SSW, SSW, SSW, WgluT, 2, 128, r); return; } r -= CV_I_GLU;
    cv_set(c, F.in[14], D, D, D, WoutT, 1, 0, r);
    c.kscale = (c.k0 < SBW) ? F.in[12] + c.k0 : F.in[13] + (c.k0 - SBW);
}
__device__ __forceinline__ void cv_load(const CvItem& c, int lane, float (&v)[32]) {
    const float* p = c.src + (size_t)(c.k0 + (lane >> 5)) * c.ldw + c.n0 + (lane & 31);
#pragma unroll
    for (int i = 0; i < 32; ++i) v[i] = p[(size_t)(2 * i) * c.ldw];
}
__device__ __forceinline__ void cv_store(const CvItem& c, int lane, const float (&v)[32], LAS float* scr) {
#pragma unroll
    for (int i = 0; i < 32; ++i) scr[(2 * i + (lane >> 5)) * 33 + (lane & 31)] = v[i];
    LDS_WAIT(); asm volatile("" ::: "memory");
    const int cc = lane & 7;
#pragma unroll
    for (int j = 0; j < 4; ++j) { const int nl = (lane >> 3) + 8 * j; const int n = c.n0 + nl; const int drow = (n >> 7) * 128 * c.rmul + c.radd + (n & 127); const LAS float* s = scr + (8 * cc) * 33 + nl;
        float e0 = s[0 * 33], e1 = s[1 * 33], e2 = s[2 * 33], e3 = s[3 * 33], e4 = s[4 * 33], e5 = s[5 * 33], e6 = s[6 * 33], e7 = s[7 * 33];
        if (c.kscale) { const f32x4 ka = *(const f32x4*)(c.kscale + 8 * cc), kb = *(const f32x4*)(c.kscale + 8 * cc + 4); e0 *= ka.x; e1 *= ka.y; e2 *= ka.z; e3 *= ka.w; e4 *= kb.x; e5 *= kb.y; e6 *= kb.z; e7 *= kb.w; }
        v4u o; o.x = pg8::cvt_pk_bf16(e0, e1); o.y = pg8::cvt_pk_bf16(e2, e3); o.z = pg8::cvt_pk_bf16(e4, e5); o.w = pg8::cvt_pk_bf16(e6, e7);
        *(GAS v4u*)(c.dst + (size_t)drow * c.K + c.k0 + 8 * cc) = o; }
    LDS_WAIT(); asm volatile("" ::: "memory");
}
__device__ __forceinline__ void cv_item_early(Frame& F, int it, LAS float* scr) { CvItem c; float v[32]; cv_decode_early(F, it, c); cv_load(c, F.lane, v); cv_store(c, F.lane, v, scr); }
__device__ __forceinline__ void xv_item(Frame& F, int it) {
    unsigned char* W1T = F.ws + WS_W1T; unsigned char* W2T = F.ws + WS_W2T;
    const float* w0 = F.in[18]; const float* w1 = F.in[20]; const float* w2 = F.in[22];
    asm volatile("" : "+s"(w0), "+s"(w1), "+s"(w2));
    const int lane = F.lane;
    {
        const int mat = it >> 7, kb = (it & 127) >> 1, half = it & 1, kind = mat / NE, e = mat % NE;
        const float* src = (kind == 0 ? w0 : (kind == 1 ? w1 : w2)) + (size_t)e * D * FF + (size_t)(kb * 16) * FF + half * 512 + 4 * lane;
        f32x4 v[16][2];
#pragma unroll
        for (int rr = 0; rr < 16; ++rr)
#pragma unroll
            for (int j = 0; j < 2; ++j) v[rr][j] = *(const GAS f32x4*)(src + (size_t)rr * FF + 256 * j);
        unsigned char* dst; int jstride;
        if (kind < 2) { dst = W1T + (size_t)e * 2 * FF * D + ((size_t)kb * 2 * FF + (size_t)(half * 4 + (lane >> 5)) * 256 + (kind == 1 ? 128 : 0) + 4 * (lane & 31)) * 16; jstride = 512 * 16; }
        else { dst = W2T + (size_t)e * D * FF + ((size_t)kb * D + half * 512 + 4 * lane) * 16; jstride = 256 * 16; }
#pragma unroll
        for (int j = 0; j < 2; ++j)
#pragma unroll
            for (int c = 0; c < 4; ++c) { v4u o;
                o.x = pk4_fp8(v[0][j][c] * WSCALE, v[1][j][c] * WSCALE, v[2][j][c] * WSCALE, v[3][j][c] * WSCALE); o.y = pk4_fp8(v[4][j][c] * WSCALE, v[5][j][c] * WSCALE, v[6][j][c] * WSCALE, v[7][j][c] * WSCALE);
                o.z = pk4_fp8(v[8][j][c] * WSCALE, v[9][j][c] * WSCALE, v[10][j][c] * WSCALE, v[11][j][c] * WSCALE); o.w = pk4_fp8(v[12][j][c] * WSCALE, v[13][j][c] * WSCALE, v[14][j][c] * WSCALE, v[15][j][c] * WSCALE);
                *(GAS v4u*)(dst + (size_t)j * jstride + c * 16) = o; }
    }
}
__device__ __forceinline__ void sincos_acc(float th, float& s, float& c) {
    const float k = rintf(th * 0.15915494309189535f);
    float r = fmaf(-k, 6.28125f, th); r = fmaf(-k, 1.9353071795864769e-3f, r);
    const float x = 0.25f * r, x2 = x * x;
    float sn = x * (1.0f + x2 * (-1.0f / 6 + x2 * (1.0f / 120 + x2 * (-1.0f / 5040 + x2 * (1.0f / 362880 + x2 * (-1.0f / 39916800))))));
    float cs = 1.0f + x2 * (-0.5f + x2 * (1.0f / 24 + x2 * (-1.0f / 720 + x2 * (1.0f / 40320 + x2 * (-1.0f / 3628800 + x2 * (1.0f / 479001600))))));
#pragma unroll
    for (int i = 0; i < 2; ++i) { const float s2 = 2.0f * sn * cs, c2 = 1.0f - 2.0f * sn * sn; sn = s2; cs = c2; }
    s = sn; c = cs;
}
__device__ __forceinline__ void ssm_tables(Frame& F, int g) {
    constexpr int PT = 36, BS = 17, CS = 68, KT = 324, KC = 20;
    LAS float* pwr = (LAS float*)(F.lds);
    LAS float* pwi = pwr + 64 * PT;
    LAS float* bbr = pwi + 64 * PT;
    LAS float* bbi = bbr + 64 * BS;
    LAS float* ccr = bbi + 64 * BS;
    LAS float* cci = ccr + 16 * CS;
    LAS float* km = cci + 16 * CS;
    const float* lam_re = F.in[3]; const float* lam_im = F.in[4]; const float* log_dt = F.in[5];
    const float* b_re = F.in[6]; const float* b_im = F.in[7]; const float* c_re = F.in[8]; const float* c_im = F.in[9]; const float* dsk = F.in[10];
    float* lamL = (float*)(F.ws + WS_LAML); bf16* WE = (bf16*)(F.ws + WS_WE); bf16* TW = (bf16*)(F.ws + WS_TW);
    const int tid = F.tid;
    if (tid < 64) { const int p = tid;
        const float lr = lam_re[g * NP + p], li = lam_im[g * NP + p], dt = expf(log_dt[g]);
        const float er = expf(lr * dt); float sn, cs; sincos_acc(li * dt, sn, cs);
        const float br = er * cs, bi = er * sn;
        const float nr = br - 1.0f, ni = bi, den = 1.0f / (lr * lr + li * li);
        const float fr = (nr * lr + ni * li) * den, fi = (ni * lr - nr * li) * den;
        float pr = 1.0f, pi = 0.0f;
        for (int n = 0; n <= 32; ++n) { pwr[p * PT + n] = pr; pwi[p * PT + n] = pi; const float t = pr * br - pi * bi; pi = pr * bi + pi * br; pr = t; }
        lamL[(g * 2 + 0) * NP + p] = pwr[p * PT + 32]; lamL[(g * 2 + 1) * NP + p] = pwi[p * PT + 32];
        float xr[GC], xi[GC];
#pragma unroll
        for (int c = 0; c < GC; ++c) { xr[c] = b_re[(g * NP + p) * GC + c]; xi[c] = b_im[(g * NP + p) * GC + c]; }
#pragma unroll
        for (int c = 0; c < GC; ++c) { bbr[p * BS + c] = fr * xr[c] - fi * xi[c]; bbi[p * BS + c] = fr * xi[c] + fi * xr[c]; }
    }
    for (int i = tid; i < 1024; i += NWAVES * 64) { ccr[(i >> 6) * CS + (i & 63)] = c_re[g * 1024 + i]; cci[(i >> 6) * CS + (i & 63)] = c_im[g * 1024 + i]; }
    __syncthreads();
    {
        const int pair = tid & 255, co = pair >> 4, ci = pair & 15, t0 = (tid >> 8) * 16;
        float acc[16];
#pragma unroll
        for (int t = 0; t < 16; ++t) acc[t] = 0.f;
        for (int p = 0; p < NP; ++p) { const float cr = ccr[co * CS + p], cim = cci[co * CS + p], xr = bbr[p * BS + ci], xi = bbi[p * BS + ci];
            const float gr = cr * xr - cim * xi, gi = cr * xi + cim * xr;
#pragma unroll
            for (int t4 = 0; t4 < 4; ++t4) { const f32x4 a = *(const LAS f32x4*)(pwr + p * PT + t0 + 4 * t4), bq = *(const LAS f32x4*)(pwi + p * PT + t0 + 4 * t4);
#pragma unroll
                for (int t = 0; t < 4; ++t) acc[4 * t4 + t] += gr * a[t] - gi * bq[t]; } }
#pragma unroll
        for (int t = 0; t < 16; ++t) km[(t0 + t) * KT + co * KC + ci] = acc[t];
    }
    __syncthreads();
    {
        const int n = tid, i = n >> 4, co = n & 15; const float dv = dsk[g * GC + co];
        bf16* dst = TW + ((size_t)g * 512 + n) * UK;
        for (int j = 0; j < LC; ++j) {
            float v[16];
            const LAS float* kr = km + (j <= i ? i - j : 0) * KT + co * KC;
#pragma unroll
            for (int c4 = 0; c4 < 4; ++c4) { const f32x4 q = *(const LAS f32x4*)(kr + 4 * c4);
#pragma unroll
                for (int t = 0; t < 4; ++t) v[4 * c4 + t] = (j <= i) ? q[t] : 0.f; }
            if (j == i) {
#pragma unroll
                for (int ci = 0; ci < 16; ++ci) v[ci] += (ci == co) ? dv : 0.f; }
            v4u o0, o1; o0.x = pg8::cvt_pk_bf16(v[0], v[1]); o0.y = pg8::cvt_pk_bf16(v[2], v[3]); o0.z = pg8::cvt_pk_bf16(v[4], v[5]); o0.w = pg8::cvt_pk_bf16(v[6], v[7]);
            o1.x = pg8::cvt_pk_bf16(v[8], v[9]); o1.y = pg8::cvt_pk_bf16(v[10], v[11]); o1.z = pg8::cvt_pk_bf16(v[12], v[13]); o1.w = pg8::cvt_pk_bf16(v[14], v[15]);
            *(GAS v4u*)(dst + j * 16) = o0; *(GAS v4u*)(dst + j * 16 + 8) = o1; }
        for (int k8 = 0; k8 < 16; ++k8) { float v[8];
            const int ri = k8 >> 3, p0 = 8 * (k8 & 7);
#pragma unroll
            for (int e = 0; e < 8; ++e) { const int p = p0 + e; const float cr = ccr[co * CS + p], cim = cci[co * CS + p], pr = pwr[p * PT + i + 1], pi = pwi[p * PT + i + 1];
                v[e] = ri == 0 ? (cr * pr - cim * pi) : -(cr * pi + cim * pr); }
            v4u o; o.x = pg8::cvt_pk_bf16(v[0], v[1]); o.y = pg8::cvt_pk_bf16(v[2], v[3]); o.z = pg8::cvt_pk_bf16(v[4], v[5]); o.w = pg8::cvt_pk_bf16(v[6], v[7]);
            *(GAS v4u*)(dst + 512 + k8 * 8) = o; }
    }
    {
        const int row = tid & 127, ri = row >> 6, p = row & 63, kq = tid >> 7;
        bf16* dst = WE + ((size_t)g * 128 + row) * 512 + kq * 128;
        for (int k8 = 0; k8 < 16; ++k8) { float v[8];
#pragma unroll
            for (int e = 0; e < 8; ++e) { const int k = kq * 128 + k8 * 8 + e, j = k >> 4, c = k & 15; const float pr = pwr[p * PT + 31 - j], pi = pwi[p * PT + 31 - j], xr = bbr[p * BS + c], xi = bbi[p * BS + c];
                v[e] = ri == 0 ? (pr * xr - pi * xi) : (pr * xi + pi * xr); }
            v4u o; o.x = pg8::cvt_pk_bf16(v[0], v[1]); o.y = pg8::cvt_pk_bf16(v[2], v[3]); o.z = pg8::cvt_pk_bf16(v[4], v[5]); o.w = pg8::cvt_pk_bf16(v[6], v[7]);
            *(GAS v4u*)(dst + k8 * 8) = o; }
    }
    __syncthreads();
}
__device__ __forceinline__ void rms_rows4_to_bf16(int lane, const float* x0, const float* g, bf16* o0) {
    const GAS f32x4* gr = (const GAS f32x4*)g + lane;
    f32x4 v[4][4]; float sq[4];
#pragma unroll
    for (int r = 0; r < 4; ++r)
#pragma unroll
        for (int j = 0; j < 4; ++j) v[r][j] = ((const GAS f32x4*)(x0 + (size_t)r * D) + lane)[64 * j];
#pragma unroll
    for (int r = 0; r < 4; ++r) { sq[r] = 0.f;
#pragma unroll
        for (int j = 0; j < 4; ++j) sq[r] += (v[r][j].x * v[r][j].x + v[r][j].y * v[r][j].y) + (v[r][j].z * v[r][j].z + v[r][j].w * v[r][j].w); }
#pragma unroll
    for (int o = 1; o < 64; o <<= 1) {
#pragma unroll
        for (int r = 0; r < 4; ++r) sq[r] += __shfl_xor(sq[r], o); }
#pragma unroll
    for (int j = 0; j < 4; ++j) { const f32x4 gg = gr[64 * j];
#pragma unroll
        for (int r = 0; r < 4; ++r) { const float rs = 1.0f / sqrtf(sq[r] * (1.f / D) + EPS); v2u w; w.x = pg8::cvt_pk_bf16(v[r][j].x * rs * gg.x, v[r][j].y * rs * gg.y); w.y = pg8::cvt_pk_bf16(v[r][j].z * rs * gg.z, v[r][j].w * rs * gg.w);
            ((GAS v2u*)(o0 + (size_t)r * D) + lane)[64 * j] = w; } }
}
constexpr int CV_N_W1 = 2 * NE * (D / 8);
constexpr int P1_GEMM_WG = 176;
constexpr int Q0_HN = M / 8, Q0_END = Q0_HN + CV_N_EARLY / 4;
static_assert(Q0_END % 8 == 0 && CV_N_EARLY % 4 == 0, "P0 queue");
__device__ __forceinline__ void p0_prologue(Frame& F, unsigned long long& t_lo_, unsigned long long& t_hi_) {
    TMARK(100);
    LAS float* scr = (LAS float*)(F.lds + RING_OFF + F.wave * 16384);
    unsigned* q = (unsigned*)(F.ctl + CW_Q0); volatile LAS unsigned* slot = F.MISC + 16;
    bf16* HN = (bf16*)(F.ws + WS_HN);
    for (;;) {
        __syncthreads();
        if (F.tid == 0) *slot = __hip_atomic_fetch_add(q, 8u, RLX_AGENT);
        __syncthreads();
        const int base = (int)__builtin_amdgcn_readfirstlane(*slot); if (base >= Q0_END) break;
        const int idx = base + F.wave;
        if (idx < Q0_HN) { const int m0 = idx * 8;
#pragma unroll 1
            for (int j = 0; j < 2; ++j) { const int m = m0 + 4 * j; rms_rows4_to_bf16(F.lane, F.in[0] + (size_t)m * D, F.in[1], HN + (size_t)m * D); } }
        else { const int g4 = (idx - Q0_HN) * 4;
#pragma unroll 1
            for (int j = 0; j < 4; ++j) cv_item_early(F, g4 + j, scr); }
    }
    TMARK(104);
}
__device__ __forceinline__ void q1_drain(Frame& F, int max_claims, unsigned* stop, unsigned stop_target) {
    unsigned* q = (unsigned*)(F.ctl + CW_Q1); volatile LAS unsigned* slot = F.MISC + 18;
    for (int n = 0; max_claims < 0 || n < max_claims; ++n) {
        __syncthreads();
        if (F.tid == 0) { unsigned v = 0x7fffffffu; if (!(stop_target && __hip_atomic_load(stop, RLX_AGENT) >= stop_target)) v = __hip_atomic_fetch_add(q, 8u, RLX_AGENT); *slot = v; }
        __syncthreads();
        const unsigned base = (unsigned)__builtin_amdgcn_readfirstlane(*slot); if (base >= (unsigned)CV_N_W1) break;
        xv_item(F, (int)base + F.wave);
    }
}
__device__ __forceinline__ void p1_side(Frame& F, int tabler_idx) {
    if (tabler_idx >= 0) { ssm_tables(F, tabler_idx);
        if (tabler_idx == 0 && F.tid < 128) {
            bf16* WE = (bf16*)(F.ws + WS_WE) + (size_t)NG * 128 * 512;
            for (int i = 0; i < 512 / 8; ++i) *(GAS v4u*)(WE + (size_t)F.tid * 512 + i * 8) = (v4u){0u, 0u, 0u, 0u}; }
        if (tabler_idx == 1) {
            const float* wr = F.in[16]; bf16* img = (bf16*)(F.ws + WS_RWIMG);
            for (int idx = F.tid; idx < D * NE; idx += NWAVES * 64) { const float w = wr[idx]; const unsigned h = f2bf(w); const unsigned l = f2bf(w - bf2f((unsigned short)h)); const int k = idx >> 5, e = idx & 31;
                img[e * RT_WSTR + k] = (bf16)h; img[(NE + e) * RT_WSTR + k] = (bf16)l; }
            if (F.tid < 2 * NE) for (int k = D; k < RT_WSTR; ++k) img[F.tid * RT_WSTR + k] = 0; } }
    q1_drain(F, -1, (unsigned*)(F.ctl + CW_DONE1), (unsigned)P1_GEMM_WG);
}
__device__ __forceinline__ void w2_drain(Frame& F, int max_claims) {
    unsigned* q = (unsigned*)(F.ctl + CW_Q2); volatile LAS unsigned* slot = F.MISC + 19;
    for (int n = 0; max_claims < 0 || n < max_claims; ++n) {
        __syncthreads();
        if (F.tid == 0) *slot = __hip_atomic_fetch_add(q, 8u, RLX_AGENT);
        __syncthreads();
        const int base = CV_N_W1 + (int)__builtin_amdgcn_readfirstlane(*slot); if (base >= CV_N_EXP) break;
        xv_item(F, base + F.wave);
    }
}

typedef _Float16 h8v __attribute__((ext_vector_type(8)));
typedef float f16v __attribute__((ext_vector_type(16)));
__device__ __forceinline__ void attn_mfma_unit(const _Float16* Qh, const _Float16* Kh, const _Float16* VT, bf16* Y, float* SSQ, int b, int hd, int qb, int lane, h8v tri0, h8v tri1) {
    const int r = lane & 31, hh = lane >> 5, q0 = qb * 32;
    const _Float16* qrow = Qh + ((size_t)b * SEQ + q0 + r) * SBW + hd * HD + 8 * hh;
    h8v qf[4];
#pragma unroll
    for (int kd = 0; kd < 4; ++kd) qf[kd] = *(const h8v*)(qrow + 16 * kd);
    f16v o0, o1;
#pragma unroll
    for (int i = 0; i < 16; ++i) { o0[i] = 0.f; o1[i] = 0.f; }
    float carry = 0.f;
    const _Float16* kbase = Kh + ((size_t)b * SEQ + r) * SBW + hd * HD + 8 * hh;
    const _Float16* vbase = VT + ((size_t)b * SBW + hd * HD + r) * SEQ + 8 * hh;
    h8v kf[4], vf[2][2], kn[4], vn[2][2];
#pragma unroll
    for (int kd = 0; kd < 4; ++kd) kf[kd] = *(const h8v*)(kbase + (size_t)q0 * SBW + 16 * kd);
#pragma unroll
    for (int db = 0; db < 2; ++db)
#pragma unroll
        for (int ss = 0; ss < 2; ++ss) vf[db][ss] = *(const h8v*)(vbase + (size_t)(32 * db) * SEQ + q0 + 16 * ss);
    for (int key0 = q0; key0 >= 0; key0 -= 32) {
        { const int kn0 = key0 >= 32 ? key0 - 32 : key0;
#pragma unroll
          for (int kd = 0; kd < 4; ++kd) kn[kd] = *(const h8v*)(kbase + (size_t)kn0 * SBW + 16 * kd);
#pragma unroll
          for (int db = 0; db < 2; ++db)
#pragma unroll
              for (int ss = 0; ss < 2; ++ss) vn[db][ss] = *(const h8v*)(vbase + (size_t)(32 * db) * SEQ + kn0 + 16 * ss); }
        f16v z;
#pragma unroll
        for (int i = 0; i < 16; ++i) z[i] = 0.f;
#pragma unroll
        for (int kd = 0; kd < 4; ++kd) z = __builtin_amdgcn_mfma_f32_32x32x16_f16(kf[kd], qf[kd], z, 0, 0, 0);
        const bool diag = key0 == q0;
        h8v lh[2], ll[2];
#pragma unroll
        for (int i = 0; i < 16; ++i) { const int koff = (i & 3) + 8 * (i >> 2) + 4 * hh; const bool act = !diag || koff < r;
            const float zi = z[i]; const float t1 = flog2(1.0f + fexp2(-fabsf(zi)));
            const float L = act ? fmaxf(-(fmaxf(zi, 0.f) + t1), -60000.0f) : 0.f;
            const _Float16 hi = (_Float16)L; const _Float16 lo = (_Float16)(L - (float)hi);
            lh[i >> 3][i & 7] = hi; ll[i >> 3][i & 7] = lo; }
        f16v cum;
#pragma unroll
        for (int i = 0; i < 16; ++i) cum[i] = carry;
        cum = __builtin_amdgcn_mfma_f32_32x32x16_f16(tri0, lh[0], cum, 0, 0, 0);
        cum = __builtin_amdgcn_mfma_f32_32x32x16_f16(tri1, lh[1], cum, 0, 0, 0);
        cum = __builtin_amdgcn_mfma_f32_32x32x16_f16(tri0, ll[0], cum, 0, 0, 0);
        cum = __builtin_amdgcn_mfma_f32_32x32x16_f16(tri1, ll[1], cum, 0, 0, 0);
        h8v pf[2];
#pragma unroll
        for (int i = 0; i < 16; ++i) { const int koff = (i & 3) + 8 * (i >> 2) + 4 * hh; const bool act = !diag || koff < r;
            const float p = act ? fexp2(z[i] + cum[i]) : 0.f; pf[i >> 3][i & 7] = (_Float16)p; }
        o0 = __builtin_amdgcn_mfma_f32_32x32x16_f16(vf[0][0], pf[0], o0, 0, 0, 0);
        o0 = __builtin_amdgcn_mfma_f32_32x32x16_f16(vf[0][1], pf[1], o0, 0, 0, 0);
        o1 = __builtin_amdgcn_mfma_f32_32x32x16_f16(vf[1][0], pf[0], o1, 0, 0, 0);
        o1 = __builtin_amdgcn_mfma_f32_32x32x16_f16(vf[1][1], pf[1], o1, 0, 0, 0);
        carry = __shfl(cum[0], r);
        if (__all(carry < -150.0f)) break;
#pragma unroll
        for (int kd = 0; kd < 4; ++kd) kf[kd] = kn[kd];
#pragma unroll
        for (int db = 0; db < 2; ++db)
#pragma unroll
            for (int ss = 0; ss < 2; ++ss) vf[db][ss] = vn[db][ss];
    }
    { float sq = 0.f;
#pragma unroll
      for (int i = 0; i < 16; ++i) sq += o0[i] * o0[i] + o1[i] * o1[i];
      sq += __shfl_xor(sq, 32); if (hh == 0) SSQ[((size_t)b * SEQ + q0 + r) * NH + hd] = sq; }
    bf16* yp = Y + ((size_t)b * SEQ + q0 + r) * D + hd * HD + 4 * hh;
#pragma unroll
    for (int g4 = 0; g4 < 4; ++g4) { v2u w0, w1; w0.x = pk2(o0[4 * g4], o0[4 * g4 + 1]); w0.y = pk2(o0[4 * g4 + 2], o0[4 * g4 + 3]); w1.x = pk2(o1[4 * g4], o1[4 * g4 + 1]); w1.y = pk2(o1[4 * g4 + 2], o1[4 * g4 + 3]);
        *(v2u*)(yp + 8 * g4) = w0; *(v2u*)(yp + 32 + 8 * g4) = w1; }
}
__device__ __forceinline__ void attn_one(Frame& F, int u) {
    const _Float16* Qh = (const _Float16*)(F.ws + WS_Q); const _Float16* Kh = (const _Float16*)(F.ws + WS_K); const _Float16* VT = (const _Float16*)(F.ws + WS_V);
    bf16* Y = (bf16*)(F.ws + WS_YCAT); float* SSQ = (float*)(F.ws + WS_SSQSB);
    constexpr int NQB = SEQ / 32;
    const int lane = F.lane, r = lane & 31, hh = lane >> 5;
    h8v tri0, tri1;
#pragma unroll
    for (int e = 0; e < 8; ++e) { const int k0 = 8 * (e >> 2) + 4 * hh + (e & 3); tri0[e] = (k0 >= r) ? (_Float16)1.0f : (_Float16)0.0f; tri1[e] = (16 + k0 >= r) ? (_Float16)1.0f : (_Float16)0.0f; }
    const int qb = u % NQB, bh = u / NQB; attn_mfma_unit(Qh, Kh, VT, Y, SSQ, bh / NH, bh % NH, qb, lane, tri0, tri1);
}

__device__ __forceinline__ void scan_phase(Frame& F, int task) {
    static_assert(CPB == 8 * 32, "scan segments");
    const int b = task / NG, g = task % NG, p = F.lane, sg = F.wave;
    const float* lamL = (const float*)(F.ws + WS_LAML); const float* S = (const float*)(F.ws + WS_SLOC); bf16* U = (bf16*)(F.ws + WS_UCAT);
    LAS float* ex = (LAS float*)(F.lds);
    const float lr = lamL[(g * 2 + 0) * NP + p], li = lamL[(g * 2 + 1) * NP + p];
    float sr[32], si[32];
#pragma unroll
    for (int j = 0; j < 32; ++j) { const size_t base = ((size_t)(b * CPB + sg * 32 + j) * NG + g) * 128; sr[j] = S[base + p]; si[j] = S[base + 64 + p]; }
    float er = 0.f, ei = 0.f, qr = 1.f, qi = 0.f;
#pragma unroll
    for (int j = 0; j < 32; ++j) { const float nr = lr * er - li * ei + sr[j], ni = lr * ei + li * er + si[j]; er = nr; ei = ni; const float tr = lr * qr - li * qi; qi = lr * qi + li * qr; qr = tr; }
    ex[(sg * 2 + 0) * 64 + p] = er; ex[(sg * 2 + 1) * 64 + p] = ei;
    __syncthreads();
    float xr = 0.f, xi = 0.f;
    for (int r = 0; r < sg; ++r) { const float tr = qr * xr - qi * xi + ex[(r * 2 + 0) * 64 + p], ti = qr * xi + qi * xr + ex[(r * 2 + 1) * 64 + p]; xr = tr; xi = ti; }
#pragma unroll
    for (int j = 0; j < 32; ++j) { bf16* dst = U + ((size_t)(b * CPB + sg * 32 + j) * NG + g) * UK + 512;
        dst[p] = (bf16)f2bf(xr); dst[64 + p] = (bf16)f2bf(xi);
        const float nr = lr * xr - li * xi + sr[j], ni = lr * xi + li * xr + si[j]; xr = nr; xi = ni; }
    __syncthreads();
}

__device__ __forceinline__ void router_phase(Frame& F) {
    typedef short s8v __attribute__((ext_vector_type(8)));
    typedef float f16v __attribute__((ext_vector_type(16)));
    LAS bf16* wh = (LAS bf16*)F.lds; LAS bf16* wl = wh + NE * RT_WSTR;
    LAS int* lcnt = (LAS int*)(F.lds + RT_SCR_OFF); LAS int* lbase = lcnt + 32; LAS int* asg = lbase + 32;
    const float* wr = F.in[16]; const float* br = F.in[17]; const float* g2 = F.in[15];
    bf16* XG = (bf16*)(F.ws + WS_XN); float* gates = (float*)(F.ws + WS_GATES); int* lists = (int*)(F.ws + WS_LISTS); float* RS = (float*)(F.ws + WS_RSTD);
    unsigned* gcnt = (unsigned*)(F.ctl + CW_CNT);
    const int tid = F.tid, lane = F.lane, r = lane & 31, hh = lane >> 5;
    const int task = F.wave >> 2, kq = F.wave & 3; const int tok = F.vcu * 64 + task * 32 + r;
    const bf16* xp = x1_row(F.ws, tok) + kq * 256 + 8 * hh; unsigned char* xo = (unsigned char*)XG + (size_t)tok * D + kq * 256 + 8 * hh;
    v4u xw[16];
#pragma unroll
    for (int ks = 0; ks < 16; ++ks) xw[ks] = *(const v4u*)(xp + 16 * ks);
    { const v4u* src = (const v4u*)(F.ws + WS_RWIMG); LAS v4u* dst = (LAS v4u*)F.lds;
      for (int i = tid; i < RT_W_BYTES / 16; i += NWAVES * 64) dst[i] = src[i]; }
    LAS float* gl = (LAS float*)(F.lds + RT_SCR_OFF + 2048);
    for (int i = tid; i < D / 4; i += NWAVES * 64) ((LAS f32x4*)gl)[i] = ((const f32x4*)g2)[i];
    if (tid < 32) lcnt[tid] = 0;
    __syncthreads();
    f16v acc;
#pragma unroll
    for (int i = 0; i < 16; ++i) acc[i] = 0.f;
    float ss = 0.f;
    const LAS float* gp = gl + kq * 256 + 8 * hh;
    const LAS bf16* whp = wh + r * RT_WSTR + kq * 256 + 8 * hh; const LAS bf16* wlp = wl + r * RT_WSTR + kq * 256 + 8 * hh;
#pragma unroll
    for (int ks = 0; ks < 16; ++ks) {
        const v4u xq = xw[ks]; const f32x4 x0 = (f32x4){bflo(xq.x), bfhi(xq.x), bflo(xq.y), bfhi(xq.y)}, x1 = (f32x4){bflo(xq.z), bfhi(xq.z), bflo(xq.w), bfhi(xq.w)}, g0 = *(const LAS f32x4*)(gp + 16 * ks), g1 = *(const LAS f32x4*)(gp + 16 * ks + 4);
        ss += (x0.x * x0.x + x0.y * x0.y) + (x0.z * x0.z + x0.w * x0.w) + (x1.x * x1.x + x1.y * x1.y) + (x1.z * x1.z + x1.w * x1.w);
        const f32x4 a0 = x0 * g0, a1 = x1 * g1;
        v4u hv, lv;
        hv.x = pg8::cvt_pk_bf16(a0.x, a0.y); hv.y = pg8::cvt_pk_bf16(a0.z, a0.w); hv.z = pg8::cvt_pk_bf16(a1.x, a1.y); hv.w = pg8::cvt_pk_bf16(a1.z, a1.w);
        lv.x = pg8::cvt_pk_bf16(a0.x - bflo(hv.x), a0.y - bfhi(hv.x)); lv.y = pg8::cvt_pk_bf16(a0.z - bflo(hv.y), a0.w - bfhi(hv.y));
        lv.z = pg8::cvt_pk_bf16(a1.x - bflo(hv.z), a1.y - bfhi(hv.z)); lv.w = pg8::cvt_pk_bf16(a1.z - bflo(hv.w), a1.w - bfhi(hv.w));
        { v2u f8; f8.x = pk4_fp8(a0.x, a0.y, a0.z, a0.w); f8.y = pk4_fp8(a1.x, a1.y, a1.z, a1.w); *(v2u*)(xo + 16 * ks) = f8; }
        const s8v xh = __builtin_bit_cast(s8v, hv), xl = __builtin_bit_cast(s8v, lv);
        v4u ah, al; { const LAS v2u* p = (const LAS v2u*)(whp + 16 * ks); const v2u q0 = p[0], q1 = p[1]; ah.x = q0.x; ah.y = q0.y; ah.z = q1.x; ah.w = q1.y; }
        { const LAS v2u* p = (const LAS v2u*)(wlp + 16 * ks); const v2u q0 = p[0], q1 = p[1]; al.x = q0.x; al.y = q0.y; al.z = q1.x; al.w = q1.y; }
        const s8v wa = __builtin_bit_cast(s8v, ah), wb = __builtin_bit_cast(s8v, al);
        acc = __builtin_amdgcn_mfma_f32_32x32x16_bf16(wa, xh, acc, 0, 0, 0);
        acc = __builtin_amdgcn_mfma_f32_32x32x16_bf16(wb, xh, acc, 0, 0, 0);
        acc = __builtin_amdgcn_mfma_f32_32x32x16_bf16(wa, xl, acc, 0, 0, 0);
    }
    __syncthreads();
    LAS float* part = (LAS float*)F.lds;
#pragma unroll
    for (int i = 0; i < 16; ++i) part[(F.wave * 17 + i) * 64 + lane] = acc[i];
    part[(F.wave * 17 + 16) * 64 + lane] = ss;
    __syncthreads();
    if (kq == 0) {
        float v[32]; float st = 0.f;
#pragma unroll
        for (int w = 0; w < 4; ++w) { const LAS float* pw = part + (size_t)((task * 4 + w) * 17) * 64;
#pragma unroll
            for (int i = 0; i < 16; ++i) { const float t = pw[i * 64 + lane]; v[i] = w == 0 ? t : v[i] + t; }
            st += pw[16 * 64 + lane] + pw[16 * 64 + (lane ^ 32)]; }
        const float rstd = 1.0f / sqrtf(st * (1.f / D) + EPS);
        if (hh == 0) RS[tok] = rstd;
#pragma unroll
        for (int i = 0; i < 16; ++i) { const int e = (i & 3) + 8 * (i >> 2) + 4 * hh; v[i] = v[i] * rstd + br[e]; }
#pragma unroll
        for (int i = 0; i < 16; ++i) v[16 + i] = __shfl_xor(v[i], 32);
        float mx = v[0];
#pragma unroll
        for (int i = 1; i < 32; ++i) mx = fmaxf(mx, v[i]);
        int rk[16]; float es = 0.f;
#pragma unroll
        for (int i = 0; i < 16; ++i) { const int ei = (i & 3) + 8 * (i >> 2) + 4 * hh; int rank = 0;
#pragma unroll
            for (int j = 0; j < 32; ++j) { if (j == i) continue; const int ej = (j & 3) + 8 * ((j & 15) >> 2) + 4 * (j < 16 ? hh : 1 - hh);
                rank += (v[j] > v[i] || (v[j] == v[i] && ej < ei)) ? 1 : 0; }
            rk[i] = rank; if (rank < TOPK) es += fexp2((v[i] - mx) * LOG2E); }
        es += __shfl_xor(es, 32);
        const float inv = 1.0f / es;
#pragma unroll
        for (int i = 0; i < 16; ++i) if (rk[i] < TOPK) { const int ei = (i & 3) + 8 * (i >> 2) + 4 * hh;
            gates[tok * TOPK + rk[i]] = fexp2((v[i] - mx) * LOG2E) * inv;
            const int pos = __hip_atomic_fetch_add(lcnt + ei, 1, __ATOMIC_RELAXED, __HIP_MEMORY_SCOPE_WORKGROUP);
            asg[(task * 32 + r) * 4 + rk[i]] = ei | (pos << 8); }
    }
    __syncthreads();
    if (tid < 32) lbase[tid] = (int)__hip_atomic_fetch_add(gcnt + tid, (unsigned)lcnt[tid], RLX_AGENT);
    __syncthreads();
    if (tid < 64 * TOPK) { const int a = asg[tid], e = a & 255, pos = a >> 8; const int tk = F.vcu * 64 + (tid >> 2);
        lists[e * M + lbase[e] + pos] = tk * TOPK + (tid & 3); }
    __syncthreads();
}

__device__ __forceinline__ void moe_tables(Frame& F) {
    LAS int* tab = (LAS int*)(F.lds + TAB_OFF); LAS int* cnt = tab, * mt = tab + 32, * tbase = tab + 64;
    unsigned* gcnt = (unsigned*)(F.ctl + CW_CNT);
    if (F.tid < 32) { const int c = (int)__hip_atomic_load(gcnt + F.tid, RLX_AGENT); cnt[F.tid] = c; mt[F.tid] = (c + 255) >> 8; }
    __syncthreads();
    if (F.tid == 0) { int s = 0; for (int e = 0; e < NE; ++e) { tbase[e] = s; s += mt[e]; } tbase[NE] = s; }
    __syncthreads();
}
__device__ __forceinline__ void moe_units(Frame& F, int npn, int gpn) {
    LAS int* tab = (LAS int*)(F.lds + TAB_OFF); LAS int* mt = tab + 32, * tbase = tab + 64; LAS int* units = (LAS int*)(F.lds + UNITS_OFF);
    if (F.tid < 32) {
        const int nU = tbase[NE] * npn; const int L = F.tid * F.G + (int)blockIdx.x; int pm = 0, pn = 0, e = 0, valid = 0;
        if (L < nU) { const int seq = pg8::xcd_remap(L, nU); int ee = 0; while (ee < NE - 1 && seq >= tbase[ee + 1] * npn) ++ee;
            const int r = seq - tbase[ee] * npn, m = mt[ee]; const int grp = r / (m * gpn), r2 = r % (m * gpn);
            e = ee; pn = grp * gpn + r2 / m; pm = tbase[ee] + r2 % m; valid = 1; }
        units[4 * F.tid + 0] = pm; units[4 * F.tid + 1] = pn; units[4 * F.tid + 2] = e; units[4 * F.tid + 3] = valid;
    }
    __syncthreads();
}

__device__ __forceinline__ void moe_gather_tables(Frame& F) {
    LAS int* tab = (LAS int*)(F.lds + TAB_OFF); LAS int* cnt = tab, * tbase = tab + 64; LAS int* units = (LAS int*)(F.lds + UNITS_OFF); LAS int* tokmap = (LAS int*)(F.lds + TOKMAP_OFF);
    const float* gates = (const float*)(F.ws + WS_GATES); const int* lists = (const int*)(F.ws + WS_LISTS); const float* RS = (const float*)(F.ws + WS_RSTD); int* rowinfo = (int*)(F.ws + WS_ROWINFO);
    for (int idx = F.tid; idx < TOKMAP_SLOTS * 256; idx += NWAVES * 64) { const int i = idx >> 8, R = idx & 255; int tk = 0;
        if (units[4 * i + 3]) { const int pm = units[4 * i], e = units[4 * i + 2]; const int li = (pm - tbase[e]) * 256 + R;
            v4u ri = (v4u){0xffffffffu, 0u, 0u, 0u};
            if (li < cnt[e]) { const int slot = lists[e * M + li]; tk = slot >> 2; ri = (v4u){(unsigned)slot, __builtin_bit_cast(unsigned, gates[slot]), __builtin_bit_cast(unsigned, RS[tk]), 0u}; }
            *(v4u*)(rowinfo + 4 * (pm * 256 + R)) = ri; }
        tokmap[idx] = tk; }
    asm volatile("s_waitcnt vmcnt(0)" ::: "memory");
    __syncthreads();
}

__device__ __forceinline__ void final_phase(Frame& F) {
    const bf16* YB = (const bf16*)(F.ws + WS_YBUF); const float* gf = F.in[24]; float* O = F.out;
    const int gw = F.vcu * NWAVES + F.wave, NGW = F.G * NWAVES, lane = F.lane;
    f32x4 gg[4];
#pragma unroll
    for (int j = 0; j < 4; ++j) gg[j] = *(const f32x4*)(gf + 4 * lane + 256 * j);
    for (int m = gw; m < M; m += NGW) {
        f32x4 v[4]; float ss = 0.f;
#pragma unroll
        for (int j = 0; j < 4; ++j) { { const v2u xw = *(const v2u*)(x1_row(F.ws, m) + 4 * lane + 256 * j); v[j] = (f32x4){bflo(xw.x), bfhi(xw.x), bflo(xw.y), bfhi(xw.y)}; }
#pragma unroll
            for (int k = 0; k < (DBG_MODE ? 0 : TOPK); ++k) { const v2u w = *(const v2u*)(YB + ((size_t)m * TOPK + k) * D + 4 * lane + 256 * j); v[j].x += bflo(w.x); v[j].y += bfhi(w.x); v[j].z += bflo(w.y); v[j].w += bfhi(w.y); }
            ss += (v[j].x * v[j].x + v[j].y * v[j].y) + (v[j].z * v[j].z + v[j].w * v[j].w); }
        const float rstd = 1.0f / sqrtf(wave_sum(ss) * (1.f / D) + EPS);
#pragma unroll
        for (int j = 0; j < 4; ++j) *(f32x4*)(O + (size_t)m * D + 4 * lane + 256 * j) = v[j] * rstd * gg[j];
    }
}

struct Args { const float* in[25]; float* out; unsigned char* ws; int ph_lo, ph_hi, li, pad; };
__global__ void __launch_bounds__(NWAVES * 64, 2) hyb_fwd(Args args) {
    extern __shared__ __attribute__((aligned(16))) unsigned char lds[];
    Frame F;
    F.lds = (LAS unsigned char*)lds;
    F.MISC = (volatile LAS unsigned*)(F.lds + MISC_OFF);
    F.tid = threadIdx.x; F.lane = F.tid & 63; F.wave = __builtin_amdgcn_readfirstlane(F.tid >> 6);
    F.G = gridDim.x; { const int bx = blockIdx.x; F.vcu = (F.G % 8 == 0) ? (bx % 8) * (F.G / 8) + bx / 8 : bx; }
    F.ws = args.ws; F.ctl = (gu32*)(args.ws + WS_CTL); F.out = args.out;
#pragma unroll
    for (int i = 0; i < 25; ++i) F.in[i] = args.in[i];
    for (int u = F.tid; u < (LDS_BYTES - LDSCTL_OFF) / 4; u += NWAVES * 64) ((LAS unsigned*)(F.lds + LDSCTL_OFF))[u] = 0u;
    __syncthreads();
    XcdBarrier bar; bar.bar = (unsigned*)(F.ctl + CW_BAR); bar.x = 0; bar.st = nullptr; bar.G = gridDim.x;
    if (N_LAUNCHES != PER_PHASE) bar = xcd_barrier_post((unsigned*)(F.ctl + CW_BAR), F.MISC + 8, gridDim.x);
#define GRID_BAR(seam) do { if (N_LAUNCHES == PER_PHASE) { if (F.tid == 0) __hip_atomic_store(F.ctl + CW_TMO, 0xBADBA0u | (unsigned)(seam), RLX_AGENT); } else { xcd_barrier(bar); } } while (0)
    const int lo = args.ph_lo, hi = args.ph_hi;
#define IN(k) (lo <= (k) && (k) < hi)
#define BOTH(k) (IN(k) && IN((k) + 1))
    const pg8::bf16_t* wsb = (const pg8::bf16_t*)args.ws;
#define WSB(off) ((const pg8::bf16_t*)(args.ws + (off)))

    unsigned long long t_lo_ = 0, t_hi_ = 0;
    TMARK(0);
    if (IN(0)) {   }

    TMARK(1);
    if (IN(1)) for (int rep_ = 0; rep_ < NREP(1); ++rep_) {
        const int bx = (int)blockIdx.x; const bool gemm_wg = bx < P1_GEMM_WG;
        pg8::Gemm g = pg8::make_gemm(WSB(WS_HN), WSB(WS_WINT), D, D, D); InProjOrder S{P1_GEMM_WG, gemm_wg ? bx : 512};
        EpiInProj E{(unsigned short*)(args.ws + WS_Q), (bf16*)(args.ws + WS_UCAT), LOG2E * 0.125f};
        if (gemm_wg) { XcdBarrier bar2 = xcd_barrier_post((unsigned*)(F.ctl + CW_BAR2), F.MISC + 10, (unsigned)P1_GEMM_WG);
            p0_prologue(F, t_lo_, t_hi_);
            xcd_barrier(bar2); }
        pg8::gemm_phase<EpiInProj, InProjOrder, PG8_ALIGN, PG8_SP2>(F.lds + RING_OFF, g, S, E);
        if (gemm_wg && F.tid == 0) __hip_atomic_fetch_add((unsigned*)(F.ctl + CW_DONE1), 1u, RLX_AGENT);
        p1_side(F, (bx >= P1_GEMM_WG && bx < P1_GEMM_WG + NG) ? bx - P1_GEMM_WG : -1);
        if (BOTH(1)) GRID_BAR(1);
    }
    TMARK(2);
    if (IN(2)) for (int rep_ = 0; rep_ < NREP(2); ++rep_) {
        const int bx = (int)blockIdx.x;
        if (bx < NG * 4) {
            XcdBarrier bar3 = xcd_barrier_post((unsigned*)(F.ctl + CW_BAR3), F.MISC + 12, (unsigned)(NG * 4));
            if (bx < NG * 2) { pg8::Gemm g = pg8::make_gemm(WSB(WS_UCAT), WSB(WS_WE), NG * UK, 512, 512); SsmOrder S{NG * 2, F.G, bx, 1, 128, 512};
                EpiSloc E{(float*)(args.ws + WS_SLOC)};
                pg8::gemm_phase<EpiSloc, SsmOrder, PG8_ALIGN, PG8_SP2>(F.lds + RING_OFF, g, S, E); }
            else attn_one(F, (bx - NG * 2) * 8 + F.wave);
            xcd_barrier(bar3);
            if (bx < NG * 2) { scan_phase(F, bx); q1_drain(F, 1, nullptr, 0u); } else attn_one(F, 512 + (bx - NG * 2) * 8 + F.wave);
            xcd_barrier(bar3);
            { pg8::Gemm g = pg8::make_gemm(WSB(WS_UCAT), WSB(WS_TW), NG * UK, UK, UK); SsmOrder S{NG * 4, F.G, bx, 2, 512, UK};
              EpiS3 E{(bf16*)(args.ws + WS_YG)};
              pg8::gemm_phase<EpiS3, SsmOrder, PG8_ALIGN, PG8_SP2>(F.lds + RING_OFF, g, S, E); }
        } else {
            const int w = (bx - NG * 4) * 8 + F.wave;
#pragma unroll 1
            for (int j = 0; j < 3; ++j) attn_one(F, 1024 + w + 1024 * j);
            q1_drain(F, 1, nullptr, 0u);
        }
        if (BOTH(4)) GRID_BAR(4);
    }
    TMARK(3); TMARK(4);
    TMARK(5);
    if (IN(5)) for (int rep_ = 0; rep_ < NREP(5); ++rep_) {
        pg8::Gemm g = pg8::make_gemm(WSB(WS_YG), WSB(WS_WGLUT), SSW, SSW, SSW); pg8::StaticOrder S; S.init(M, 2 * SSW, F.G, (int)blockIdx.x, SSW, SSW);
        EpiGlu E{(bf16*)(args.ws + WS_YCAT), (float*)(args.ws + WS_SSQSSM)};
        pg8::gemm_phase<EpiGlu, pg8::StaticOrder, PG8_ALIGN, PG8_SP2>(F.lds + RING_OFF, g, S, E);
        if (BOTH(5)) GRID_BAR(5);
    }
    TMARK(6);
    if (IN(6)) {   }
    TMARK(7);
    if (IN(7)) for (int rep_ = 0; rep_ < NREP(7); ++rep_) {
        pg8::Gemm g = pg8::make_gemm(WSB(WS_YCAT), WSB(WS_WOUTT), D, D, D); pg8::StaticOrder S; S.init(M, D, F.G, (int)blockIdx.x, D, D);
        LAS float* rtab = (LAS float*)(F.lds + TOKMAP_OFF);
        { pg8::Unit u0; if (S.next(0, u0) && F.tid < 256) { const int row = u0.pm * 256 + F.tid; const float* pa = (const float*)(args.ws + WS_SSQSB) + (size_t)row * NH; const float* pb = (const float*)(args.ws + WS_SSQSSM) + (size_t)row * 16;
              float sa = 0.f, sb = 0.f;
#pragma unroll
              for (int i = 0; i < NH; ++i) sa += pa[i];
#pragma unroll
              for (int i = 0; i < 16; ++i) sb += pb[i];
              const float ra = 1.0f / sqrtf(sa * (1.f / SBW) + EPS), rb = 1.0f / sqrtf(sb * (1.f / SSW) + EPS); rtab[F.tid] = ra / rb; rtab[256 + F.tid] = rb; }
          __syncthreads(); }
        EpiOutProj E{F.in[0], args.ws, rtab, rtab + 256};
        pg8::gemm_phase<EpiOutProj, pg8::StaticOrder, PG8_ALIGN, PG8_SP2>(F.lds + RING_OFF, g, S, E);
        if (BOTH(7)) GRID_BAR(7);
    }
    TMARK(8);
    if (IN(8) && !DBG_MODE) for (int rep_ = 0; rep_ < NREP(8); ++rep_) { router_phase(F); q1_drain(F, -1, nullptr, 0u);
        if (BOTH(8)) GRID_BAR(8); }
    TMARK(9);
    if (IN(9) && !DBG_MODE) for (int rep_ = 0; rep_ < NREP(9); ++rep_) {   }
    TMARK(10);
    if (IN(10) && !DBG_MODE) for (int rep_ = 0; rep_ < NREP(10); ++rep_) {
        moe_tables(F); moe_units(F, 8, 4); moe_gather_tables(F);
        pg8::Gemm g = pg8::make_gemm(WSB(WS_XN), WSB(WS_W1T), D / 2, D, D); g.brs = 16u; g.bks = 2u * FF * 16u; g.tokmap = (const PG8_LAS int*)(F.lds + TOKMAP_OFF);
        MoeOrder S{(const LAS int*)(F.lds + UNITS_OFF), (long)2 * FF * D, 1};
        EpiMoe1 E{args.ws + WS_H, F.in[19], F.in[21], (const int*)(args.ws + WS_ROWINFO)};
        pg8::gemm_phase<EpiMoe1, MoeOrder, PG8_ALIGN, PG8_SP2, true, MOE1_MODE>(F.lds + RING_OFF, g, S, E);
        w2_drain(F, -1);
        if (BOTH(10)) GRID_BAR(10);
    }
    TMARK(11);
    if (IN(11) && !DBG_MODE) for (int rep_ = 0; rep_ < NREP(11); ++rep_) {
        moe_tables(F); moe_units(F, 4, 4);
        pg8::Gemm g = pg8::make_gemm(WSB(WS_H), WSB(WS_W2T), FF / 2, FF, FF); g.brs = 16u; g.bks = (unsigned)D * 16u; MoeOrder S{(const LAS int*)(F.lds + UNITS_OFF), (long)D * FF, 0};
        EpiMoe2 E{(bf16*)(args.ws + WS_YBUF), F.in[23], (const int*)(args.ws + WS_ROWINFO)};
        pg8::gemm_phase<EpiMoe2, MoeOrder, PG8_ALIGN, PG8_SP2, false, MOE2_MODE>(F.lds + RING_OFF, g, S, E);
        if (BOTH(11)) GRID_BAR(11);
    }
    TMARK(12);
    if (IN(12)) for (int rep_ = 0; rep_ < NREP(12); ++rep_) { final_phase(F); }
    TMARK(13);
    if ((TIME_LO) >= 0 && blockIdx.x == (TIME_BLK) && F.tid == 0) { const unsigned long long te = __builtin_amdgcn_s_memrealtime(), dt = 4ull * (t_hi_ - t_lo_); while (__builtin_amdgcn_s_memrealtime() - te < dt) __builtin_amdgcn_s_sleep(32); }
    (void)wsb;
#undef IN
#undef BOTH
}

extern "C" void kernel_launch(void* const* d_in, const int* in_sizes, int n_in, void* d_out, int out_size, void* d_ws, size_t ws_size, hipStream_t stream) {
    static int grid = 0;
    if (grid == 0) {
        if (n_in != 25 || in_sizes[0] != M * D || out_size != M * D || ws_size < WS_END) { fprintf(stderr, "kernel_launch: unexpected shapes: n_in %d in0 %d out %d ws %zu (need %zu); nothing launched\n", n_in, n_in > 0 ? in_sizes[0] : -1, out_size, ws_size, (size_t)WS_END); grid = -1; return; }
        int dev = 0, cus = 0, per_cu = 0;
        if (hipGetDevice(&dev) != hipSuccess || hipDeviceGetAttribute(&cus, hipDeviceAttributeMultiprocessorCount, dev) != hipSuccess) { grid = -1; return; }
        if (hipFuncSetAttribute((const void*)hyb_fwd, hipFuncAttributeMaxDynamicSharedMemorySize, LDS_BYTES) != hipSuccess) { fprintf(stderr, "kernel_launch: hipFuncSetAttribute failed\n"); grid = -1; return; }
        if (hipOccupancyMaxActiveBlocksPerMultiprocessor(&per_cu, (const void*)hyb_fwd, NWAVES * 64, LDS_BYTES) != hipSuccess || per_cu < 1)
            fprintf(stderr, "kernel_launch: note: occupancy query reports %d workgroups per CU\n", per_cu);
        (void)hipGetLastError();
        grid = cus;
        if (grid != 256) fprintf(stderr, "kernel_launch: note: %d CUs (built for 256)\n", grid);
    }
    if (grid < 0) return;
    if (hipMemsetAsync((char*)d_ws + WS_CTL, 0, CTL_ZERO_BYTES, stream) != hipSuccess) { fprintf(stderr, "kernel_launch: memset failed\n"); return; }
    Args a{};
    for (int i = 0; i < 25; ++i) a.in[i] = (const float*)d_in[i];
    a.out = (float*)d_out; a.ws = (unsigned char*)d_ws;
    for (int li = 0; li < N_LAUNCHES; ++li) {
        a.ph_lo = (N_LAUNCHES == PER_PHASE) ? li : 0; a.ph_hi = (N_LAUNCHES == PER_PHASE) ? li + 1 : PER_PHASE; a.li = li;
        hipLaunchKernelGGL(hyb_fwd, dim3(grid), dim3(NWAVES * 64), LDS_BYTES, stream, a);
        const hipError_t le = hipPeekAtLastError();
        if (le != hipSuccess) { fprintf(stderr, "kernel_launch: launch %d failed: %s\n", li, hipGetErrorName(le)); break; }
    }
}
```

```cpp
#include <hip/hip_runtime.h>
#include <cstdio>
#include <cstdint>
namespace pg8 {
#define PG8_LAS __attribute__((address_space(3)))
typedef unsigned short bf16_t;
typedef short bf16x8 __attribute__((ext_vector_type(8)));
typedef float f32x4 __attribute__((ext_vector_type(4)));
typedef unsigned u32x4 __attribute__((ext_vector_type(4)));
typedef long l64x2 __attribute__((ext_vector_type(2)));
typedef int i32x4 __attribute__((ext_vector_type(4)));
typedef int i32x8 __attribute__((ext_vector_type(8)));
constexpr int BM = 256, BK = 64, HALF = 128, HTB = HALF * BK * 2  , STAGE_BYTES = 8 * HTB, NXCD = 8, WGM = 8;

__host__ __device__ __forceinline__ int lds_byte(int r, int c) { const int st = (r >> 4) * 2 + (c >> 5), rr = r & 15, cc = c & 31, ob = rr * 64 + cc * 2; return st * 1024 + (ob ^ (((ob >> 9) & 1) << 5)); }
__host__ __device__ __forceinline__ void stage_rc(int b, int& R, int& C) { const int st = b / 1024, sb = b % 1024, swz = sb ^ (((sb >> 9) & 1) << 5); R = (st >> 1) * 16 + swz / 64; C = (st & 1) * 32 + (swz % 64) / 2; }
__host__ __device__ __forceinline__ int perm32(int rho) { const int n = rho >> 4, i = rho & 15; return 8 * (i >> 2) + 4 * n + (i & 3); }

struct Unit { int pm, pn, e, slot; long offA, offB; };
struct Gemm { const bf16_t* A; const bf16_t* Bt; int lda, K; unsigned brs, bks; const PG8_LAS int* tokmap; };
__host__ __device__ __forceinline__ Gemm make_gemm(const bf16_t* A, const bf16_t* Bt, int lda, int ldb, int K) { Gemm g; g.A = A; g.Bt = Bt; g.lda = lda; g.K = K; g.brs = (unsigned)ldb * 2u; g.bks = 16u; g.tokmap = nullptr; return g; }

__host__ __device__ __forceinline__ int xcd_remap(int wgid, int nwg) { const int q = nwg / NXCD, r = nwg % NXCD, xcd = wgid % NXCD, off = wgid / NXCD; return (xcd < r ? xcd * (q + 1) : r * (q + 1) + (xcd - r) * q) + off; }

struct StaticOrder {
    int nM, nN, nwg, G, c, lda, ldb;
    __host__ __device__ void init(int M, int N, int G_, int c_, int lda_, int ldb_) { nM = M / BM; nN = N / BM; nwg = nM * nN; G = G_; c = c_; lda = lda_; ldb = ldb_; }
    __host__ __device__ __forceinline__ bool next(int i, Unit& u) const {
        const long L = (long)i * G + c; if (L >= nwg) return false;
        const int wgid = xcd_remap((int)L, nwg);
        const int nig = WGM * nN, gid = wgid / nig, fm = gid * WGM, gsz = (nM - fm) < WGM ? (nM - fm) : WGM;
        u.pm = fm + ((wgid % nig) % gsz); u.pn = (wgid % nig) / gsz; u.e = 0; u.slot = 0;
        u.offA = (long)u.pm * BM * lda * 2; u.offB = (long)u.pn * BM * ldb * 2; return true;
    }
    __device__ __forceinline__ void a_ready(const Unit&) const {}
    __device__ __forceinline__ void done(const Unit&) const {}
};

__device__ __forceinline__ unsigned cvt_pk_bf16(float lo, float hi) { unsigned r; asm volatile("v_cvt_pk_bf16_f32 %0, %1, %2" : "=v"(r) : "v"(lo), "v"(hi)); return r; }
typedef float f32x2 __attribute__((ext_vector_type(2)));

template <class Epi, class Sched, bool ALIGN_EPI = false, bool SP2 = false, bool GATHER = false, int FP8 = 0>
__device__ __forceinline__ void gemm_phase(PG8_LAS unsigned char* lds, const Gemm g, const Sched& S, const Epi& E) {
    static_assert(!GATHER || SP2, "the gather form is written for the two-super-phase loop only");
    const int tid = threadIdx.x, wid = __builtin_amdgcn_readfirstlane(tid >> 6), lane = tid & 63, wr = wid >> 2, wc = wid & 3, fr = lane & 15, fq = lane >> 4;
    const int K = g.K, nt = K / (FP8 ? 2 * BK : BK);
    unsigned voffA[2], voffB[2]; int RA[2];
#pragma unroll
    for (int i = 0; i < 2; ++i) { int R, C; stage_rc(tid * 16 + i * 8192, R, C); const int Rb = Epi::PERM ? ((R & ~31) + perm32(R & 31)) : R; RA[i] = R;
        voffA[i] = GATHER ? (unsigned)C * 2u : (unsigned)(R * g.lda + C) * 2u; voffB[i] = (unsigned)Rb * g.brs + (unsigned)(C >> 3) * g.bks; }
    const size_t kstepA = (size_t)(BK * 2), kstepB = (size_t)8 * g.bks;
    const size_t hstepA = (size_t)HALF * g.lda * 2, hstepB = (size_t)HALF * g.brs;
    const unsigned ldsw = (unsigned)wid * 1024u;
    const int aoff = lds_byte(wr * 64 + fr, fq * 8), boff = lds_byte(wc * 32 + fr, fq * 8);
#define PG8_SA(b, h) (((b) * 2 + (h)) * HTB)
#define PG8_SB(b, h) ((4 + (b) * 2 + (h)) * HTB)
#define PG8_STAGE(bufoff, gbase, voff) do { _Pragma("unroll") for (int _i = 0; _i < 2; ++_i) \
        __builtin_amdgcn_global_load_lds((const unsigned*)((const char*)(gbase) + (voff)[_i]), (PG8_LAS unsigned*)(lds + (bufoff) + ldsw + _i * 8192), 16, 0, 0); } while (0)
    unsigned ga[2][2], gn[2][2], gw[2][2];
#define PG8_GLOAD(dst, u) do { if constexpr (GATHER) { const PG8_LAS int* _tm = g.tokmap + 256 * (u).slot; _Pragma("unroll") for (int _h = 0; _h < 2; ++_h) _Pragma("unroll") for (int _i = 0; _i < 2; ++_i) \
        dst[_h][_i] = (unsigned)_tm[128 * _h + RA[_i]] * (unsigned)(g.lda * 2) + voffA[_i]; } } while (0)
#define PG8_STAGE_A(bufoff, gbase, half, GX) do { if constexpr (GATHER) { PG8_STAGE(bufoff, gbase, GX[half]); } else { PG8_STAGE(bufoff, (gbase) + (half) * hstepA, voffA); } } while (0)
#define PG8_LDA(dst, b, h) do { _Pragma("unroll") for (int m = 0; m < 4; ++m) { if constexpr (FP8 == 2) { const i32x4 _lo = *(const PG8_LAS i32x4*)(lds + PG8_SA(b, h) + aoff + m * 2048), _hi = *(const PG8_LAS i32x4*)(lds + PG8_SA(b, h) + aoff + m * 2048 + 1024); dst##8[m] = __builtin_shufflevector(_lo, _hi, 0, 1, 2, 3, 4, 5, 6, 7); } \
        else { _Pragma("unroll") for (int k = 0; k < 2; ++k) dst[m][k] = *(const PG8_LAS bf16x8*)(lds + PG8_SA(b, h) + aoff + m * 2048 + k * 1024); } } } while (0)
#define PG8_LDB(dst, b, h) do { _Pragma("unroll") for (int n = 0; n < 2; ++n) { if constexpr (FP8 == 2) { const i32x4 _lo = *(const PG8_LAS i32x4*)(lds + PG8_SB(b, h) + boff + n * 2048), _hi = *(const PG8_LAS i32x4*)(lds + PG8_SB(b, h) + boff + n * 2048 + 1024); dst##8[n] = __builtin_shufflevector(_lo, _hi, 0, 1, 2, 3, 4, 5, 6, 7); } \
        else { _Pragma("unroll") for (int k = 0; k < 2; ++k) dst[n][k] = *(const PG8_LAS bf16x8*)(lds + PG8_SB(b, h) + boff + n * 2048 + k * 1024); } } } while (0)
#define PG8_MMA(ai, bj, At, Bt) do { __builtin_amdgcn_s_setprio(1); \
        if constexpr (FP8 == 2) { _Pragma("unroll") for (int m = 0; m < 4; ++m) _Pragma("unroll") for (int n = 0; n < 2; ++n) \
            asm volatile("v_mfma_scale_f32_16x16x128_f8f6f4 %0, %1, %2, %0, %3, %3 op_sel_hi:[0,0,0]" : "+v"(acc[ai][bj][m][n]) : "v"(Bt##8[n]), "v"(At##8[m]), "v"(sc127)); } \
        else if constexpr (FP8 == 1) { _Pragma("unroll") for (int k = 0; k < 2; ++k) _Pragma("unroll") for (int hf = 0; hf < 2; ++hf) _Pragma("unroll") for (int m = 0; m < 4; ++m) _Pragma("unroll") for (int n = 0; n < 2; ++n) { \
            const l64x2 _a = __builtin_bit_cast(l64x2, At[m][k]), _b = __builtin_bit_cast(l64x2, Bt[n][k]); const long _a0 = hf ? _a.y : _a.x, _b0 = hf ? _b.y : _b.x; \
            acc[ai][bj][m][n] = __builtin_amdgcn_mfma_f32_16x16x32_fp8_fp8(_b0, _a0, acc[ai][bj][m][n], 0, 0, 0); } } \
        else { _Pragma("unroll") for (int m = 0; m < 4; ++m) _Pragma("unroll") for (int n = 0; n < 2; ++n) _Pragma("unroll") for (int k = 0; k < 2; ++k) \
            acc[ai][bj][m][n] = __builtin_amdgcn_mfma_f32_16x16x32_bf16(Bt[n][k], At[m][k], acc[ai][bj][m][n], 0, 0, 0); } __builtin_amdgcn_s_setprio(0); } while (0)
#define PG8_MMA_Z(ai, bj, At, Bt) do { __builtin_amdgcn_s_setprio(1); \
        if constexpr (FP8 == 2) { _Pragma("unroll") for (int m = 0; m < 4; ++m) _Pragma("unroll") for (int n = 0; n < 2; ++n) \
            asm volatile("v_mfma_scale_f32_16x16x128_f8f6f4 %0, %1, %2, 0, %3, %3 op_sel_hi:[0,0,0]" : "=v"(acc[ai][bj][m][n]) : "v"(Bt##8[n]), "v"(At##8[m]), "v"(sc127)); } \
        else if constexpr (FP8 == 1) { _Pragma("unroll") for (int m = 0; m < 4; ++m) _Pragma("unroll") for (int n = 0; n < 2; ++n) { acc[ai][bj][m][n] = (f32x4){0.f, 0.f, 0.f, 0.f}; \
            _Pragma("unroll") for (int k = 0; k < 2; ++k) _Pragma("unroll") for (int hf = 0; hf < 2; ++hf) { \
            const l64x2 _a = __builtin_bit_cast(l64x2, At[m][k]), _b = __builtin_bit_cast(l64x2, Bt[n][k]); const long _a0 = hf ? _a.y : _a.x, _b0 = hf ? _b.y : _b.x; \
            acc[ai][bj][m][n] = __builtin_amdgcn_mfma_f32_16x16x32_fp8_fp8(_b0, _a0, acc[ai][bj][m][n], 0, 0, 0); } } } \
        else { _Pragma("unroll") for (int m = 0; m < 4; ++m) _Pragma("unroll") for (int n = 0; n < 2; ++n) { \
            acc[ai][bj][m][n] = __builtin_amdgcn_mfma_f32_16x16x32_bf16(Bt[n][0], At[m][0], (f32x4){0.f, 0.f, 0.f, 0.f}, 0, 0, 0); \
            acc[ai][bj][m][n] = __builtin_amdgcn_mfma_f32_16x16x32_bf16(Bt[n][1], At[m][1], acc[ai][bj][m][n], 0, 0, 0); } } __builtin_amdgcn_s_setprio(0); } while (0)
#define PG8_WAIT_V(n) asm volatile("s_waitcnt vmcnt(" #n ")" ::: "memory")
#define PG8_WAIT_L(n) asm volatile("s_waitcnt lgkmcnt(" #n ")" ::: "memory")
#define PG8_BAR __builtin_amdgcn_s_barrier()
#define PG8_SCHED __builtin_amdgcn_sched_barrier(0)
    Unit cur, nxt; int ui = 0;
    if (!S.next(0, cur)) return;
    f32x4 acc[2][2][4][2];
    if constexpr (!(SP2 && FP8 == 2)) {
#pragma unroll
    for (int a = 0; a < 2; ++a)
#pragma unroll
        for (int b = 0; b < 2; ++b)
#pragma unroll
            for (int m = 0; m < 4; ++m)
#pragma unroll
                for (int n = 0; n < 2; ++n) acc[a][b][m][n] = (f32x4){0.f, 0.f, 0.f, 0.f};
    }
    bf16x8 At[4][2], B0[2][2], B1[2][2];
    i32x8 At8[4], B08[2], B18[2]; const int sc127 = 0x7f7f7f7f;
    const char* cA = (const char*)g.A + cur.offA; const char* cB = (const char*)g.Bt + cur.offB;
    S.a_ready(cur);
    if constexpr (SP2) {
        PG8_GLOAD(ga, cur);
        PG8_STAGE(PG8_SB(0, 0), cB, voffB); PG8_STAGE(PG8_SB(0, 1), cB + hstepB, voffB); PG8_STAGE_A(PG8_SA(0, 0), cA, 0, ga); PG8_STAGE_A(PG8_SA(0, 1), cA, 1, ga);
        if (wr == 1) PG8_BAR;
        PG8_WAIT_V(2); PG8_BAR;
        PG8_STAGE(PG8_SB(1, 0), cB + kstepB, voffB); PG8_STAGE_A(PG8_SA(1, 0), cA + kstepA, 0, ga); PG8_STAGE(PG8_SB(1, 1), cB + hstepB + kstepB, voffB);
        PG8_WAIT_V(6); PG8_BAR;
    } else {
        PG8_STAGE(PG8_SB(0, 0), cB, voffB); PG8_STAGE(PG8_SA(0, 0), cA, voffA); PG8_STAGE(PG8_SB(0, 1), cB + hstepB, voffB); PG8_STAGE(PG8_SA(0, 1), cA + hstepA, voffA);
        if (wr == 1) PG8_BAR;
        PG8_WAIT_V(4); PG8_BAR;
        PG8_STAGE(PG8_SB(1, 0), cB + kstepB, voffB); PG8_STAGE(PG8_SA(1, 0), cA + kstepA, voffA); PG8_STAGE(PG8_SB(1, 1), cB + hstepB + kstepB, voffB);
        PG8_WAIT_V(6); PG8_BAR;
    }
    for (;;) {
        const bool has_next = S.next(ui + 1, nxt);
        if constexpr (GATHER) { if (has_next) { PG8_GLOAD(gn, nxt); } else { _Pragma("unroll") for (int _h = 0; _h < 2; ++_h) _Pragma("unroll") for (int _i = 0; _i < 2; ++_i) gn[_h][_i] = ga[_h][_i]; } }
        const char* nA = has_next ? (const char*)g.A + nxt.offA : cA; const char* nB = has_next ? (const char*)g.Bt + nxt.offB : cB;
        for (int t = 0; t < nt; t += 2) {
            const bool last = (t == nt - 2);
            const char* a1 = cA + (size_t)(t + 1) * kstepA;
            const char* a2 = last ? nA : cA + (size_t)(t + 2) * kstepA; const char* b2 = last ? nB : cB + (size_t)(t + 2) * kstepB;
            const char* a3 = a2 + kstepA; const char* b3 = b2 + kstepB;
            if (last && has_next) S.a_ready(nxt);
            if constexpr (GATHER) { _Pragma("unroll") for (int _h = 0; _h < 2; ++_h) _Pragma("unroll") for (int _i = 0; _i < 2; ++_i) gw[_h][_i] = last ? gn[_h][_i] : ga[_h][_i]; }
            if constexpr (Epi::MIDK) { if (t == nt / 2) E.mid(acc, cur, wr, wc, fr, fq); }
            if constexpr (SP2) {
            PG8_LDB(B0, 0, 0); PG8_LDB(B1, 0, 1); PG8_SCHED; PG8_LDA(At, 0, 0); PG8_STAGE_A(PG8_SA(1, 1), a1, 1, ga);
            PG8_WAIT_V(8); PG8_WAIT_L(0); PG8_BAR; if (FP8 == 2 && t == 0) { PG8_MMA_Z(0, 0, At, B0); PG8_MMA_Z(0, 1, At, B1); } else { PG8_MMA(0, 0, At, B0); PG8_MMA(0, 1, At, B1); } PG8_BAR; PG8_SCHED;
            PG8_LDA(At, 0, 1); PG8_STAGE(PG8_SB(0, 0), b2, voffB); PG8_STAGE(PG8_SB(0, 1), b2 + hstepB, voffB); PG8_STAGE_A(PG8_SA(0, 0), a2, 0, gw);
            PG8_WAIT_V(8); PG8_WAIT_L(0); PG8_BAR; if (FP8 == 2 && t == 0) { PG8_MMA_Z(1, 0, At, B0); PG8_MMA_Z(1, 1, At, B1); } else { PG8_MMA(1, 0, At, B0); PG8_MMA(1, 1, At, B1); } PG8_BAR; PG8_SCHED;
            PG8_LDB(B0, 1, 0); PG8_LDB(B1, 1, 1); PG8_SCHED; PG8_LDA(At, 1, 0); PG8_STAGE_A(PG8_SA(0, 1), a2, 1, gw);
            PG8_WAIT_V(8); PG8_WAIT_L(0); PG8_BAR; PG8_MMA(0, 0, At, B0); PG8_MMA(0, 1, At, B1); PG8_BAR; PG8_SCHED;
            PG8_LDA(At, 1, 1); PG8_STAGE(PG8_SB(1, 0), b3, voffB); PG8_STAGE(PG8_SB(1, 1), b3 + hstepB, voffB); PG8_STAGE_A(PG8_SA(1, 0), a3, 0, gw);
            PG8_WAIT_V(8); PG8_WAIT_L(0); PG8_BAR; PG8_MMA(1, 0, At, B0); PG8_MMA(1, 1, At, B1); PG8_BAR; PG8_SCHED;
            } else {
            PG8_LDB(B0, 0, 0); PG8_SCHED; PG8_LDA(At, 0, 0); PG8_STAGE(PG8_SA(1, 1), a1 + hstepA, voffA);
            PG8_WAIT_L(8); PG8_BAR; PG8_WAIT_L(0); PG8_MMA(0, 0, At, B0); PG8_BAR; PG8_SCHED;
            PG8_LDB(B1, 0, 1); PG8_STAGE(PG8_SB(0, 0), b2, voffB);
            PG8_BAR; PG8_WAIT_L(0); PG8_MMA(0, 1, At, B1); PG8_BAR;
            PG8_LDA(At, 0, 1); PG8_STAGE(PG8_SA(0, 0), a2, voffA);
            PG8_BAR; PG8_WAIT_L(0); PG8_MMA(1, 0, At, B0); PG8_BAR; PG8_SCHED;
            PG8_STAGE(PG8_SB(0, 1), b2 + hstepB, voffB);
            PG8_WAIT_V(6); PG8_BAR; PG8_MMA(1, 1, At, B1); PG8_BAR;
            PG8_LDB(B0, 1, 0); PG8_SCHED; PG8_LDA(At, 1, 0); PG8_STAGE(PG8_SA(0, 1), a2 + hstepA, voffA);
            PG8_WAIT_L(8); PG8_BAR; PG8_WAIT_L(0); PG8_MMA(0, 0, At, B0); PG8_BAR; PG8_SCHED;
            PG8_LDB(B1, 1, 1); PG8_STAGE(PG8_SB(1, 0), b3, voffB);
            PG8_BAR; PG8_WAIT_L(0); PG8_MMA(0, 1, At, B1); PG8_BAR;
            PG8_LDA(At, 1, 1); PG8_STAGE(PG8_SA(1, 0), a3, voffA);
            PG8_BAR; PG8_WAIT_L(0); PG8_MMA(1, 0, At, B0); PG8_BAR; PG8_SCHED;
            PG8_STAGE(PG8_SB(1, 1), b3 + hstepB, voffB);
            PG8_WAIT_V(6); PG8_BAR; PG8_MMA(1, 1, At, B1); PG8_BAR;
            }
        }
        if constexpr (FP8 == 2) asm volatile("s_nop 15\n\ts_nop 15\n\ts_nop 15" ::: "memory");
        if constexpr (ALIGN_EPI) { if (wr == 0) PG8_BAR; }
        if constexpr (!Epi::AFTER_DRAIN) { if constexpr (Epi::NEEDS_NEXT) E(acc, cur, nxt, has_next, wr, wc, fr, fq); else E(acc, cur, wr, wc, fr, fq); S.done(cur); }
        if (!has_next) break;
        if constexpr (!(SP2 && FP8 == 2)) {
#pragma unroll
        for (int a = 0; a < 2; ++a)
#pragma unroll
            for (int b = 0; b < 2; ++b)
#pragma unroll
                for (int m = 0; m < 4; ++m)
#pragma unroll
                    for (int n = 0; n < 2; ++n) acc[a][b][m][n] = (f32x4){0.f, 0.f, 0.f, 0.f};
        }
        cur = nxt; cA = nA; cB = nB; ++ui;
        if constexpr (GATHER) { _Pragma("unroll") for (int _h = 0; _h < 2; ++_h) _Pragma("unroll") for (int _i = 0; _i < 2; ++_i) ga[_h][_i] = gn[_h][_i]; }
        if constexpr (ALIGN_EPI) { if (wr == 1) PG8_BAR; }
    }
    PG8_WAIT_V(0);
    if constexpr (!ALIGN_EPI) { if (wr == 0) PG8_BAR; }
    PG8_BAR;
    if constexpr (Epi::AFTER_DRAIN) { E.fused(acc, cur, wr, wc, fr, fq, lds, wid, lane); S.done(cur); }
#undef PG8_SA
#undef PG8_SB
#undef PG8_STAGE
#undef PG8_STAGE_A
#undef PG8_MMA_Z
#undef PG8_GLOAD
#undef PG8_LDA
#undef PG8_LDB
#undef PG8_MMA
#undef PG8_WAIT_V
#undef PG8_WAIT_L
#undef PG8_BAR
#undef PG8_SCHED
}
}

#ifndef PG8_SP2
#define PG8_SP2 true
#endif
#ifndef PG8_ALIGN
#define PG8_ALIGN true
#endif

constexpr int NWAVES = 8;
#ifndef MK_N_LAUNCHES
#define MK_N_LAUNCHES 1
#endif
#ifndef DBG_MODE
#define DBG_MODE 0
#endif
#ifndef REP_PHASE
#define REP_PHASE -1
#endif
#define NREP(k) ((REP_PHASE) == (k) ? 2 : 1)
#ifndef TIME_LO
#define TIME_LO -1
#endif
#ifndef TIME_HI
#define TIME_HI -1
#endif
#ifndef TIME_BLK
#define TIME_BLK 0
#endif
#define TMARK(j) do { if ((TIME_LO) >= 0 && blockIdx.x == (TIME_BLK) && F.tid == 0) { if ((j) == (TIME_LO)) t_lo_ = __builtin_amdgcn_s_memrealtime(); if ((j) == (TIME_HI)) t_hi_ = __builtin_amdgcn_s_memrealtime(); } } while (0)
constexpr int PER_PHASE = 13;
constexpr int N_LAUNCHES = MK_N_LAUNCHES;

constexpr int BATCH = 2, SEQ = 8192, D = 1024, M = BATCH * SEQ;
constexpr int SBW = 512, NH = 8, HD = 64;
constexpr int SSW = 512, NG = 32, GC = 16, NP = 64;
constexpr int NPROJ = 3 * SBW + SSW;
constexpr int LC = 32, NCHUNK = M / LC, CPB = SEQ / LC;
constexpr int UK = LC * GC + 2 * NP;
constexpr int NE = 32, TOPK = 4, FF = 1024, NASSIGN = M * TOPK;
constexpr int MAXTILES = (NASSIGN + NE * 255) / 256 + 1;
constexpr float EPS = 1e-5f;
constexpr float LOG2E = 1.4426950408889634f;

constexpr size_t MiB = 1u << 20;
constexpr size_t WS_CTL = 0, CTL_ZERO_BYTES = 128 * 1024;
constexpr size_t WS_LAML = 1 * MiB;
constexpr size_t WS_RSTD = 1 * MiB + 32 * 1024;
constexpr size_t WS_GATES = 1 * MiB + 128 * 1024;
constexpr size_t WS_ROWINFO = 1 * MiB + 512 * 1024;
constexpr size_t WS_RWIMG = 3 * MiB;
constexpr size_t WS_LISTS = 507 * MiB;
constexpr size_t WS_X1LO = 331 * MiB, WS_X1HI = 491 * MiB;
constexpr size_t WS_WINT = 4 * MiB, WS_WGLUT = 8 * MiB, WS_WOUTT = 9 * MiB, WS_W1T = 11 * MiB, WS_W2T = 139 * MiB;
constexpr size_t WS_R1 = 203 * MiB, WS_R2 = 347 * MiB, WS_END = 509 * MiB;
constexpr size_t WS_HN = WS_R1, WS_Q = WS_R1 + 32 * MiB, WS_K = WS_R1 + 48 * MiB, WS_V = WS_R1 + 64 * MiB, WS_UCAT = WS_R1 + 80 * MiB,
                 WS_SLOC = WS_R1 + 100 * MiB, WS_SSQSB = WS_R1 + 108 * MiB  , WS_SSQSSM = WS_R1 + 109 * MiB  , WS_YG = WS_R1 + 124 * MiB;
constexpr size_t WS_YBUF = WS_R1;
constexpr size_t WS_YCAT = WS_R2 + 16 * MiB  , WS_XN = WS_R1  , WS_WE = WS_R2 + 80 * MiB, WS_TW = WS_R2 + 85 * MiB;
constexpr size_t WS_H = WS_R2;
static_assert(WS_K == WS_Q + (size_t)M * SBW * 2 && WS_V == WS_K + (size_t)M * SBW * 2 && WS_YG + (size_t)M * SSW * 2 <= WS_R2 && WS_TW + (size_t)NG * 512 * UK * 2 <= WS_END, "ws map");
static_assert(WS_YBUF + (size_t)NASSIGN * D * 2 <= WS_X1LO && WS_H + (size_t)(MAXTILES - 1) * 256 * FF * 2 <= WS_END, "ws map 2");
static_assert(WS_ROWINFO + (size_t)MAXTILES * 256 * 16 <= 3 * MiB && WS_X1LO >= WS_YBUF + (size_t)NASSIGN * D * 2 && WS_X1LO + 16 * MiB <= WS_R2 && WS_X1HI >= WS_H + (size_t)(MAXTILES - 1) * 256 * FF * 2 && WS_X1HI + 16 * MiB <= WS_LISTS && WS_LISTS + (size_t)NE * M * 4 <= WS_END, "ws map 3");
constexpr int CW_TMO = 0, CW_CODE = 1;
constexpr int CW_BAR = 4096, CW_BAR2 = 8192, CW_BAR3 = 12288;
constexpr int CW_PANEL = 24576, CW_PXCC = 28672;
constexpr int CW_CNT = 20480, CNT_STRIDE = 32;
constexpr int CW_Q0 = 16384 + 256, CW_Q1 = 16384 + 512, CW_Q2 = 16384 + 576;
constexpr int CW_DONE1 = 16384 + 640;
static_assert((28672 + 256) * 4 <= (int)CTL_ZERO_BYTES && 24576 + 2 * 64 * 32 <= 28672 && (20480 + 32 * 32) * 4 <= (int)CTL_ZERO_BYTES, "control words inside the memset region");
constexpr int CW_AQ = 16384 + 320, CW_DONE2 = 16384 + 384, CW_DONE3 = 16384 + 448;

constexpr int RING_OFF = 0, RING_BYTES = 131072;
constexpr int RT_WSTR = 1028;
constexpr int RT_W_BYTES = 2 * NE * RT_WSTR * 2;
constexpr int RT_SCR_OFF = RT_W_BYTES;
constexpr int LDSCTL_OFF = 139264, MISC_OFF = LDSCTL_OFF + 320;
constexpr int EPI_STG_OFF = RING_BYTES;
constexpr int TAB_OFF = LDSCTL_OFF + 512;
constexpr int UNITS_OFF = LDSCTL_OFF + 1024;
constexpr int TILEE_OFF = LDSCTL_OFF + 1536;
constexpr int TOKMAP_OFF = LDSCTL_OFF + 4096, TOKMAP_SLOTS = 10;
constexpr int LDS_BYTES = TOKMAP_OFF + TOKMAP_SLOTS * 1024;
static_assert(TILEE_OFF + MAXTILES * 4 <= LDS_BYTES && RT_SCR_OFF + 4096 <= LDSCTL_OFF, "LDS map");

#define GAS __attribute__((address_space(1)))
#define LAS __attribute__((address_space(3)))
typedef unsigned short bf16;
typedef unsigned v4u __attribute__((ext_vector_type(4)));
typedef unsigned v2u __attribute__((ext_vector_type(2)));
typedef float f32x4 __attribute__((ext_vector_type(4)));
typedef float f32x2 __attribute__((ext_vector_type(2)));
typedef _Float16 h16x2 __attribute__((ext_vector_type(2)));
typedef GAS unsigned gu32;
#define RLX_AGENT __ATOMIC_RELAXED, __HIP_MEMORY_SCOPE_AGENT
#define LDS_WAIT() asm volatile("s_waitcnt lgkmcnt(0)" ::: "memory")
#define VM_WAIT() asm volatile("s_waitcnt vmcnt(0)" ::: "memory")
__device__ __forceinline__ unsigned f2bf(float f) { unsigned u = __builtin_bit_cast(unsigned, f); return (u + 0x7fffu + ((u >> 16) & 1u)) >> 16; }
__device__ __forceinline__ unsigned pk2(float lo, float hi) { return f2bf(lo) | (f2bf(hi) << 16); }
__device__ __forceinline__ float bf2f(unsigned short b) { return __builtin_bit_cast(float, (unsigned)b << 16); }
__device__ __forceinline__ float bflo(unsigned w) { return __builtin_bit_cast(float, w << 16); }
__device__ __forceinline__ float bfhi(unsigned w) { return __builtin_bit_cast(float, w & 0xffff0000u); }
__device__ __forceinline__ unsigned pkh2(float lo, float hi) { h16x2 v; v.x = (_Float16)lo; v.y = (_Float16)hi; return __builtin_bit_cast(unsigned, v); }
__device__ __forceinline__ float fexp2(float x) { return __builtin_amdgcn_exp2f(x); }
__device__ __forceinline__ float flog2(float x) { return __builtin_amdgcn_logf(x); }
__device__ __forceinline__ float frcp(float x) { return __builtin_amdgcn_rcpf(x); }
__device__ __forceinline__ float sigmoidf_(float x) { return frcp(1.0f + fexp2(-LOG2E * x)); }
__device__ __forceinline__ float gelu_tanh(float v) { const float u = 0.7978845608028654f * (v + 0.044715f * v * v * v); return v * frcp(1.0f + fexp2(-2.0f * LOG2E * u)); }

__device__ __forceinline__ bf16* x1_row(unsigned char* ws, int m) { return (bf16*)(ws + (m < SEQ ? WS_X1LO : WS_X1HI - (size_t)SEQ * D * 2)) + (size_t)m * D; }
#ifndef MOE1_MODE
#define MOE1_MODE 2
#endif
#ifndef MOE2_MODE
#define MOE2_MODE 2
#endif
constexpr float WSCALE = 64.0f;
constexpr float YSCALE = 16.0f;
__device__ __forceinline__ float clamp448(float x) { return fminf(fmaxf(x, -448.0f), 448.0f); }
__device__ __forceinline__ unsigned pk4_fp8(float a, float b, float c, float d) {
    int w = __builtin_amdgcn_cvt_pk_fp8_f32(clamp448(a), clamp448(b), 0, false); w = __builtin_amdgcn_cvt_pk_fp8_f32(clamp448(c), clamp448(d), w, true); return (unsigned)w; }
__device__ __forceinline__ unsigned pk4_fp8_nc(float a, float b, float c, float d) {
    int w = __builtin_amdgcn_cvt_pk_fp8_f32(a, b, 0, false); w = __builtin_amdgcn_cvt_pk_fp8_f32(c, d, w, true); return (unsigned)w; }
#define XB_TMO      128
#define XB_XCNT(j)  (256  + 64 * (j))
#define XB_XSUB(j)  (1280 + 64 * (j))
#define XB_XGEN(j)  (2304 + 64 * (j))
#define XB_TOP      3328
#define XB_TOPGEN   3392
#define XCD_BAR_WORDS 3456
#define XB_SPIN_CAP (1u << 18)
__device__ __forceinline__ unsigned xb_ld(unsigned* p)              { return __hip_atomic_load(p, __ATOMIC_RELAXED, __HIP_MEMORY_SCOPE_AGENT); }
__device__ __forceinline__ unsigned xb_add(unsigned* p, unsigned v) { return __hip_atomic_fetch_add(p, v, __ATOMIC_RELAXED, __HIP_MEMORY_SCOPE_AGENT); }
__device__ __forceinline__ unsigned xb_xcc_id() { return (unsigned)__builtin_amdgcn_s_getreg((3 << 11) | 20) & 0xFu; }
#define XB_SPIN(cond, bar) do { unsigned _sp = 0; while (cond) { __builtin_amdgcn_s_sleep(1); \
    if ((++_sp & 255u) == 0u) { if (xb_ld(&(bar)[XB_TMO])) break; if (_sp > XB_SPIN_CAP) { atomicAdd(&(bar)[XB_TMO], 1u); break; } } } } while (0)
struct XcdBarrier { unsigned* bar; unsigned x; volatile LAS unsigned* st; unsigned G; };
__device__ __forceinline__ XcdBarrier xcd_barrier_post(unsigned* bar, volatile LAS unsigned* st, unsigned G) {
    XcdBarrier b; b.bar = bar; b.x = xb_xcc_id(); b.st = st; b.G = G;
    if (threadIdx.x == 0) (void)xb_add(&bar[XB_XCNT(b.x)], 1u);
    return b;
}
__device__ __forceinline__ void xcd_barrier_complete(unsigned* bar, unsigned x, unsigned G, unsigned& nloc, unsigned& nx) {
    unsigned sum, cnt, mine, sp = 0u;
    for (;;) {
        sum = 0u; cnt = 0u; mine = 0u;
#pragma unroll
        for (unsigned j = 0; j < 16; ++j) { const unsigned c = xb_ld(&bar[XB_XCNT(j)]); sum += c; cnt += (c > 0u) ? 1u : 0u; mine = (j == x) ? c : mine; }
        if (sum == G) break;
        __builtin_amdgcn_s_sleep(1);
        if ((++sp & 255u) == 0u) { if (xb_ld(&bar[XB_TMO])) break; if (sp > XB_SPIN_CAP) { atomicAdd(&bar[XB_TMO], 1u); break; } }
    }
    nloc = mine > 0u ? mine : 1u; nx = cnt > 0u ? cnt : 1u;
}
__device__ __forceinline__ void xcd_barrier(const XcdBarrier& b) {
    asm volatile("s_waitcnt vmcnt(0)" ::: "memory");
    __syncthreads();
    if (threadIdx.x == 0) {
        unsigned* bar = b.bar;
        __builtin_amdgcn_s_waitcnt(0);
        unsigned nloc = b.st[0], nx = b.st[1];
        if (nloc == 0u) { xcd_barrier_complete(bar, b.x, b.G, nloc, nx); b.st[0] = nloc; b.st[1] = nx; }
        const unsigned old = xb_add(&bar[XB_XSUB(b.x)], 1u);
        const unsigned gen = old / nloc;
        if (old + 1u == (gen + 1u) * nloc) {
            __builtin_amdgcn_fence(__ATOMIC_RELEASE, "agent");
            asm volatile("s_waitcnt vmcnt(0)" ::: "memory");
            const unsigned og = xb_add(&bar[XB_TOP], 1u);
            const unsigned tg = og / nx;
            if (og + 1u == (tg + 1u) * nx) xb_add(&bar[XB_TOPGEN], 1u);
            else XB_SPIN(xb_ld(&bar[XB_TOPGEN]) == tg, bar);
            __builtin_amdgcn_fence(__ATOMIC_ACQUIRE, "agent");
            xb_add(&bar[XB_XGEN(b.x)], 1u);
            asm volatile("s_waitcnt vmcnt(0)" ::: "memory");
        } else {
            XB_SPIN(xb_ld(&bar[XB_XGEN(b.x)]) == gen, bar);
            __builtin_amdgcn_fence(__ATOMIC_ACQUIRE, "agent");
            asm volatile("s_waitcnt vmcnt(0)" ::: "memory");
        }
    }
    __syncthreads();
}

struct Frame {
    LAS unsigned char* lds;
    volatile LAS unsigned* MISC;
    gu32* ctl;
    int tid, lane, wave;
    int vcu, G;
    unsigned char* ws;
    const float* in[25];
    float* out;
};

__device__ __forceinline__ void panel_barrier(Frame& F, unsigned* cnt, unsigned target, bool same_xcd) {
    asm volatile("s_waitcnt vmcnt(0)" ::: "memory");
    __syncthreads();
    if (F.tid == 0) {
        if (!same_xcd) { __builtin_amdgcn_fence(__ATOMIC_RELEASE, "agent"); asm volatile("s_waitcnt vmcnt(0)" ::: "memory"); }
        __hip_atomic_fetch_add(cnt, 1u, __ATOMIC_RELAXED, __HIP_MEMORY_SCOPE_AGENT);
        unsigned sp = 0u;
        while (__hip_atomic_load(cnt, __ATOMIC_RELAXED, __HIP_MEMORY_SCOPE_AGENT) < target) { __builtin_amdgcn_s_sleep(1); if (++sp > (1u << 24)) break; }
        __builtin_amdgcn_fence(__ATOMIC_ACQUIRE, "agent");
        asm volatile("s_waitcnt vmcnt(0)" ::: "memory");
    }
    __syncthreads();
}
__device__ __forceinline__ float wave_sum(float v) {
#pragma unroll
    for (int o = 1; o < 64; o <<= 1) v += __shfl_xor(v, o);
    return v;
}

using pg8::Unit;
typedef pg8::f32x4 accv;
struct EpiInProj {
    static constexpr bool PERM = true, AFTER_DRAIN = false; static constexpr bool MIDK = false; static constexpr bool NEEDS_NEXT = false;
    unsigned short* QKV; bf16* U; float qscale;
    __device__ __forceinline__ void operator()(const accv (&acc)[2][2][4][2], const Unit& u, int wr, int wc, int fr, int fq) const {
        if (u.e == 1) {
            const int row0 = u.pm * 256 + wr * 64 + fr; const int colt = u.pn * 256 + wc * 32 + 8 * fq;
            _Float16* VT = (_Float16*)(QKV + (size_t)2 * M * SBW);
#pragma unroll
            for (int ai = 0; ai < 2; ++ai)
#pragma unroll
                for (int m = 0; m < 4; ++m) { const int row = row0 + ai * 128 + m * 16;
#pragma unroll
                    for (int bj = 0; bj < 2; ++bj) { const int tok = colt + bj * 128; const accv v0 = acc[ai][bj][m][0], v1 = acc[ai][bj][m][1];
                        const int bb = tok >> 13, sq = tok & (SEQ - 1); const int o = sq & 15;
                        _Float16* p = VT + ((size_t)bb * SBW + row) * SEQ + (sq & ~15) + o;
                        v2u w0, w1; w0.x = pkh2(v0[0], v0[1]); w0.y = pkh2(v0[2], v0[3]); w1.x = pkh2(v1[0], v1[1]); w1.y = pkh2(v1[2], v1[3]);
                        const auto sx = __builtin_amdgcn_permlane16_swap(w0.x, w1.x, false, false), sy = __builtin_amdgcn_permlane16_swap(w0.y, w1.y, false, false);
                        v4u ow; ow.x = sx[0]; ow.y = sy[0]; ow.z = sx[1]; ow.w = sy[1];
                        *(v4u*)p = ow; } }
            return;
        }
        const int kind = u.pn >> 1; const int colt = (u.pn & 1) * 256 + wc * 32 + 8 * fq; const int row0 = u.pm * 256 + wr * 64 + fr;
        unsigned short* T = QKV + (size_t)(kind < 2 ? kind : 0) * ((size_t)M * SBW); const float sc = kind == 0 ? qscale : 1.0f;
#pragma unroll
        for (int ai = 0; ai < 2; ++ai)
#pragma unroll
            for (int m = 0; m < 4; ++m) { const int row = row0 + ai * 128 + m * 16;
#pragma unroll
                for (int bj = 0; bj < 2; ++bj) { const int col = colt + bj * 128; const accv v0 = acc[ai][bj][m][0] * sc, v1 = acc[ai][bj][m][1] * sc; v4u w;
                    if (kind < 2) { w.x = pkh2(v0[0], v0[1]); w.y = pkh2(v0[2], v0[3]); w.z = pkh2(v1[0], v1[1]); w.w = pkh2(v1[2], v1[3]);
                        *(v4u*)(T + (size_t)row * SBW + col) = w; }
                    else { w.x = pg8::cvt_pk_bf16(v0[0], v0[1]); w.y = pg8::cvt_pk_bf16(v0[2], v0[3]); w.z = pg8::cvt_pk_bf16(v1[0], v1[1]); w.w = pg8::cvt_pk_bf16(v1[2], v1[3]);
                        *(v4u*)(U + ((size_t)(row >> 5) * NG + (col >> 4)) * UK + (row & 31) * GC + (col & 15)) = w; } } }
    }
};
struct EpiSloc {
    static constexpr bool PERM = false, AFTER_DRAIN = false; static constexpr bool MIDK = false; static constexpr bool NEEDS_NEXT = false;
    float* S;
    __device__ __forceinline__ void operator()(const accv (&acc)[2][2][4][2], const Unit& u, int wr, int wc, int fr, int fq) const {
        const int row0 = u.pm * 256 + wr * 64 + fr; const int col0 = wc * 32 + 4 * fq;
#pragma unroll
        for (int ai = 0; ai < 2; ++ai)
#pragma unroll
            for (int m = 0; m < 4; ++m) { const int row = row0 + ai * 128 + m * 16;
#pragma unroll
                for (int n = 0; n < 2; ++n) *(accv*)(S + ((size_t)row * NG + u.e) * 128 + col0 + 16 * n) = acc[ai][0][m][n]; }
    }
};
struct EpiS3 {
    static constexpr bool PERM = true, AFTER_DRAIN = false; static constexpr bool MIDK = false; static constexpr bool NEEDS_NEXT = false;
    bf16* YG;
    __device__ __forceinline__ void operator()(const accv (&acc)[2][2][4][2], const Unit& u, int wr, int wc, int fr, int fq) const {
        const int row0 = u.pm * 256 + wr * 64 + fr; const int colt = u.pn * 256 + wc * 32 + 8 * fq;
#pragma unroll
        for (int ai = 0; ai < 2; ++ai)
#pragma unroll
            for (int m = 0; m < 4; ++m) { const int row = row0 + ai * 128 + m * 16;
#pragma unroll
                for (int bj = 0; bj < 2; ++bj) { const int col = colt + bj * 128; const accv v0 = acc[ai][bj][m][0], v1 = acc[ai][bj][m][1]; v4u w;
                    w.x = pg8::cvt_pk_bf16(gelu_tanh(v0[0]), gelu_tanh(v0[1])); w.y = pg8::cvt_pk_bf16(gelu_tanh(v0[2]), gelu_tanh(v0[3]));
                    w.z = pg8::cvt_pk_bf16(gelu_tanh(v1[0]), gelu_tanh(v1[1])); w.w = pg8::cvt_pk_bf16(gelu_tanh(v1[2]), gelu_tanh(v1[3]));
                    *(v4u*)(YG + ((size_t)row * LC + (col >> 4)) * SSW + u.e * GC + (col & 15)) = w; } }
    }
};
struct EpiGlu {
    static constexpr bool PERM = true, AFTER_DRAIN = false; static constexpr bool MIDK = false; static constexpr bool NEEDS_NEXT = false;
    bf16* Y; float* SSQ;
    __device__ __forceinline__ void operator()(const accv (&acc)[2][2][4][2], const Unit& u, int wr, int wc, int fr, int fq) const {
        const int row0 = u.pm * 256 + wr * 64 + fr; const int col = u.pn * 128 + wc * 32 + 8 * fq;
#pragma unroll
        for (int ai = 0; ai < 2; ++ai)
#pragma unroll
            for (int m = 0; m < 4; ++m) { const int row = row0 + ai * 128 + m * 16; float r[8]; float sq = 0.f;
#pragma unroll
                for (int n = 0; n < 2; ++n)
#pragma unroll
                    for (int j = 0; j < 4; ++j) { r[4 * n + j] = acc[ai][0][m][n][j] * sigmoidf_(acc[ai][1][m][n][j]); sq += r[4 * n + j] * r[4 * n + j]; }
                sq += __shfl_xor(sq, 16); sq += __shfl_xor(sq, 32);
                if (fq == 0) SSQ[(size_t)row * 16 + u.pn * 4 + wc] = sq;
                v4u w; w.x = pg8::cvt_pk_bf16(r[0], r[1]); w.y = pg8::cvt_pk_bf16(r[2], r[3]); w.z = pg8::cvt_pk_bf16(r[4], r[5]); w.w = pg8::cvt_pk_bf16(r[6], r[7]);
                *(v4u*)(Y + (size_t)row * D + SBW + col) = w; }
    }
};
struct EpiOutProj {
    static constexpr bool PERM = true, AFTER_DRAIN = false; static constexpr bool MIDK = true; static constexpr bool NEEDS_NEXT = false;
    const float* X; unsigned char* ws; const LAS float* ratio; const LAS float* fin;
    __device__ __forceinline__ void mid(accv (&acc)[2][2][4][2], const Unit& u, int wr, int wc, int fr, int fq) const {
#pragma unroll
        for (int ai = 0; ai < 2; ++ai)
#pragma unroll
            for (int m = 0; m < 4; ++m) { const float rt = ratio[ai * 128 + wr * 64 + m * 16 + fr];
#pragma unroll
                for (int bj = 0; bj < 2; ++bj)
#pragma unroll
                    for (int n = 0; n < 2; ++n) acc[ai][bj][m][n] *= rt; }
    }
    __device__ __forceinline__ void operator()(const accv (&acc)[2][2][4][2], const Unit& u, int wr, int wc, int fr, int fq) const {
        const int row0 = u.pm * 256 + wr * 64 + fr; const int col0 = u.pn * 256 + wc * 32 + 8 * fq;
#pragma unroll
        for (int ai = 0; ai < 2; ++ai)
#pragma unroll
            for (int m = 0; m < 4; ++m) { const int row = row0 + ai * 128 + m * 16; const float* xr = X + (size_t)row * D + col0; bf16* orow = x1_row(ws, row) + col0; const float fs = fin[ai * 128 + wr * 64 + m * 16 + fr];
#pragma unroll
                for (int bj = 0; bj < 2; ++bj) { const accv x0 = __builtin_nontemporal_load((const accv*)(xr + bj * 128)), x1 = __builtin_nontemporal_load((const accv*)(xr + bj * 128 + 4));     const accv v0 = x0 + acc[ai][bj][m][0] * fs, v1 = x1 + acc[ai][bj][m][1] * fs;
                    v4u w; w.x = pg8::cvt_pk_bf16(v0[0], v0[1]); w.y = pg8::cvt_pk_bf16(v0[2], v0[3]); w.z = pg8::cvt_pk_bf16(v1[0], v1[1]); w.w = pg8::cvt_pk_bf16(v1[2], v1[3]);
                    *(v4u*)(orow + bj * 128) = w; }
                if (m & 1) asm volatile("" ::: "memory"); }
    }
};
__device__ __forceinline__ void w2mini_load(f32x4 (&v)[8], const float* w2, int mi, int wid, int lane) {
    const int e = mi >> 6, kb = mi & 63, kh = lane >> 5, n = wid * 128 + (lane & 31) * 4;
    const float* src = w2 + (size_t)e * FF * D + (size_t)(kb * 16 + kh * 8) * D + n;
#pragma unroll
    for (int r = 0; r < 8; ++r) v[r] = __builtin_nontemporal_load((const GAS f32x4*)(src + (size_t)r * D));
}
__device__ __forceinline__ void w2mini_pack(const f32x4 (&v)[8], v4u (&g)[2]) {
#pragma unroll
    for (int cp = 0; cp < 2; ++cp) { v2u o[2];
#pragma unroll
        for (int cc = 0; cc < 2; ++cc) { const int c = 2 * cp + cc; o[cc].x = pk4_fp8(v[0][c] * WSCALE, v[1][c] * WSCALE, v[2][c] * WSCALE, v[3][c] * WSCALE); o[cc].y = pk4_fp8(v[4][c] * WSCALE, v[5][c] * WSCALE, v[6][c] * WSCALE, v[7][c] * WSCALE); }
        const auto sx = __builtin_amdgcn_permlane32_swap(o[0].x, o[1].x, false, false), sy = __builtin_amdgcn_permlane32_swap(o[0].y, o[1].y, false, false);
        g[cp].x = sx[0]; g[cp].y = sy[0]; g[cp].z = sx[1]; g[cp].w = sy[1]; }
}
__device__ __forceinline__ void w2mini_put(const v4u (&g)[2], unsigned char* W2T, int mi, int wid, int lane) {
    const int e = mi >> 6, kb = mi & 63, kh = lane >> 5, n = wid * 128 + (lane & 31) * 4;
    unsigned char* dst = W2T + (size_t)e * D * FF + ((size_t)kb * D + n) * 16;
#pragma unroll
    for (int cp = 0; cp < 2; ++cp) *(GAS v4u*)(dst + (2 * cp + kh) * 16) = g[cp];
}
__device__ __forceinline__ void w2mini_store(const f32x4 (&v)[8], unsigned char* W2T, int mi, int wid, int lane) { v4u g[2]; w2mini_pack(v, g); w2mini_put(g, W2T, mi, wid, lane); }
struct EpiMoe1 {
    static constexpr bool PERM = true, AFTER_DRAIN = false; static constexpr bool MIDK = false; static constexpr bool NEEDS_NEXT = true;
    unsigned char* H; const float* bg; const float* bu; const int* rowinfo; const float* w2; unsigned char* W2T; LAS float* stg;
    __device__ __forceinline__ float fetch(const Unit& u, int tid) const {
        const int j = tid - 256; const float* pr = (const float*)(rowinfo + 4 * (u.pm * 256 + tid) + 2); const float* pg = bg + u.e * FF + u.pn * 128 + j; const float* pu = bu + u.e * FF + u.pn * 128 + (j - 128);
        const float* p = tid < 256 ? pr : (j < 128 ? pg : pu);
        return *p;
    }
    __device__ __forceinline__ float fin(float v, int tid) const { return tid >= 384 ? v + 1.0f : v; }
    __device__ __forceinline__ void fill_first(const Unit& u0, int tid) const { stg[tid] = fin(fetch(u0, tid), tid); }
    __device__ __forceinline__ void operator()(const accv (&acc)[2][2][4][2], const Unit& u, const Unit& nx, bool has_next, int wr, int wc, int fr, int fq) const {
        const int row0 = u.pm * 256 + wr * 64 + fr; const int col = u.pn * 128 + wc * 32 + 8 * fq;
        const int wid = wr * 4 + wc, lane = fq * 16 + fr, tidw = wid * 64 + lane; v2u wprev = (v2u){0u, 0u}; v4u hw[4];
        float nv = 0.f; if (has_next) nv = fetch(nx, tidw);
        const LAS float* sp = stg + (u.slot & 1) * 512;
        f32x2 bgv[4], buv[4];
#pragma unroll
        for (int n = 0; n < 2; ++n) { const f32x4 a = *(const LAS f32x4*)(sp + 256 + wc * 32 + 8 * fq + 4 * n), b = *(const LAS f32x4*)(sp + 384 + wc * 32 + 8 * fq + 4 * n);
            bgv[2 * n] = (f32x2){a[0], a[1]}; bgv[2 * n + 1] = (f32x2){a[2], a[3]}; buv[2 * n] = (f32x2){b[0], b[1]}; buv[2 * n + 1] = (f32x2){b[2], b[3]}; }
        float rsv[2][4];
#pragma unroll
        for (int ai = 0; ai < 2; ++ai)
#pragma unroll
            for (int m = 0; m < 4; ++m) rsv[ai][m] = sp[wr * 64 + fr + ai * 128 + m * 16];
        const bool conv = u.slot < 8; const int mi = u.slot * 256 + (int)blockIdx.x; f32x4 wv[8];
        if (conv) w2mini_load(wv, w2, mi, wid, lane);
        __builtin_amdgcn_sched_barrier(0);
#pragma unroll
        for (int ai = 0; ai < 2; ++ai)
#pragma unroll
            for (int m = 0; m < 4; ++m) { float r[8]; const float rs = rsv[ai][m] * (1.0f / WSCALE); const f32x2 rs2 = (f32x2){rs, rs};
#pragma unroll
                for (int n = 0; n < 2; ++n)
#pragma unroll
                    for (int jj = 0; jj < 2; ++jj) {
                        f32x2 g = (f32x2){acc[ai][0][m][n][2 * jj], acc[ai][0][m][n][2 * jj + 1]} * rs2 + bgv[2 * n + jj];
                        f32x2 up = (f32x2){acc[ai][1][m][n][2 * jj], acc[ai][1][m][n][2 * jj + 1]} * rs2 + buv[2 * n + jj];
                        g.x = fminf(g.x, 7.0f); g.y = fminf(g.y, 7.0f); up.x = __builtin_amdgcn_fmed3f(up.x, -6.0f, 8.0f); up.y = __builtin_amdgcn_fmed3f(up.y, -6.0f, 8.0f);
                        const f32x2 t = g * (f32x2){-1.702f * LOG2E, -1.702f * LOG2E};
                        f32x2 d = (f32x2){fexp2(t.x), fexp2(t.y)} + (f32x2){1.0f, 1.0f};
                        d.x = frcp(d.x); d.y = frcp(d.y);
                        const f32x2 o = (up * g) * d; r[4 * n + 2 * jj] = o.x; r[4 * n + 2 * jj + 1] = o.y; }
                v2u w; w.x = pk4_fp8_nc(r[0], r[1], r[2], r[3]); w.y = pk4_fp8_nc(r[4], r[5], r[6], r[7]);
                if (m & 1) { const auto sx = __builtin_amdgcn_permlane16_swap(wprev.x, w.x, false, false), sy = __builtin_amdgcn_permlane16_swap(wprev.y, w.y, false, false);
                    v4u o; o.x = sx[0]; o.y = sy[0]; o.z = sx[1]; o.w = sy[1]; hw[ai * 2 + (m >> 1)] = o; }
                else wprev = w; }
        __builtin_amdgcn_sched_barrier(0);
        if (has_next) stg[((u.slot + 1) & 1) * 512 + tidw] = fin(nv, tidw);
        v4u g2[2]; if (conv) w2mini_pack(wv, g2);
        __builtin_amdgcn_sched_barrier(0);
#pragma unroll
        for (int ai = 0; ai < 2; ++ai)
#pragma unroll
            for (int mp = 0; mp < 2; ++mp) { const int row = row0 + ai * 128 + (2 * mp + (fq & 1)) * 16; *(v4u*)(H + (size_t)row * FF + (col - 8 * (fq & 1))) = hw[ai * 2 + mp]; }
        if (conv) w2mini_put(g2, W2T, mi, wid, lane);
    }
};
struct EpiMoe2 {
    static constexpr bool PERM = true, AFTER_DRAIN = false; static constexpr bool MIDK = false; static constexpr bool NEEDS_NEXT = true;
    unsigned char* Y; const float* bd; const int* rowinfo; LAS unsigned char* stg;
    __device__ __forceinline__ v2u fetch(const Unit& u, int tid) const {
        const unsigned* pr = (const unsigned*)(rowinfo + 4 * (u.pm * 256 + tid)); const unsigned* pb = (const unsigned*)(bd + u.e * D + u.pn * 256 + ((tid - 256) & 254));
        const unsigned* p = tid < 256 ? pr : pb; return *(const v2u*)p;
    }
    __device__ __forceinline__ void put(int p, int tid, v2u v) const { if (tid < 256) *(LAS v2u*)(stg + p * 3072 + 8 * tid) = v; else { const unsigned vx = v.x, vy = v.y; *(LAS unsigned*)(stg + p * 3072 + 2048 + 4 * (tid - 256)) = (tid & 1) ? vy : vx; } }
    __device__ __forceinline__ void fill_first(const Unit& u0, int tid) const { put(0, tid, fetch(u0, tid)); }
    __device__ __forceinline__ void operator()(const accv (&acc)[2][2][4][2], const Unit& u, const Unit& nx, bool has_next, int wr, int wc, int fr, int fq) const {
        const int row0 = u.pm * 256 + wr * 64 + fr; const int colt = u.pn * 256 + wc * 32 + 8 * fq;
        const int tidw = (wr * 4 + wc) * 64 + fq * 16 + fr;
        pg8::Unit fu = u; if (has_next) fu = nx; const v2u nv = fetch(fu, tidw);
        __builtin_amdgcn_sched_barrier(0);
        const LAS unsigned char* sp = stg + (u.slot & 1) * 3072;
        v4u yw[8]; int ys[4];
        float bv[2][8];
#pragma unroll
        for (int bj = 0; bj < 2; ++bj)
#pragma unroll
            for (int n = 0; n < 2; ++n) { const f32x4 a = *(const LAS f32x4*)(sp + 2048 + 4 * (bj * 128 + wc * 32 + 8 * fq + 4 * n));
#pragma unroll
                for (int j = 0; j < 4; ++j) bv[bj][4 * n + j] = a[j]; }
        v2u sg[2][4];
#pragma unroll
        for (int ai = 0; ai < 2; ++ai)
#pragma unroll
            for (int m = 0; m < 4; ++m) sg[ai][m] = *(const LAS v2u*)(sp + 8 * (wr * 64 + fr + ai * 128 + m * 16));
#pragma unroll
        for (int ai = 0; ai < 2; ++ai)
#pragma unroll
            for (int mp = 0; mp < 2; ++mp) {
                v2u w[2][2];
#pragma unroll
                for (int mm = 0; mm < 2; ++mm) { const int m = 2 * mp + mm; const unsigned gbits = sg[ai][m].y; const float gate = __builtin_bit_cast(float, gbits) * YSCALE;
                    const f32x2 g2 = (f32x2){gate, gate}, gs2 = (f32x2){gate * (1.0f / WSCALE), gate * (1.0f / WSCALE)};
#pragma unroll
                    for (int bj = 0; bj < 2; ++bj) { float r[8];
#pragma unroll
                        for (int n = 0; n < 2; ++n)
#pragma unroll
                            for (int jj = 0; jj < 2; ++jj) {
                                const f32x2 o2 = (f32x2){acc[ai][bj][m][n][2 * jj], acc[ai][bj][m][n][2 * jj + 1]} * gs2 + (f32x2){bv[bj][4 * n + 2 * jj], bv[bj][4 * n + 2 * jj + 1]} * g2;
                                r[4 * n + 2 * jj] = o2.x; r[4 * n + 2 * jj + 1] = o2.y; }
                        w[mm][bj].x = pk4_fp8(r[0], r[1], r[2], r[3]); w[mm][bj].y = pk4_fp8(r[4], r[5], r[6], r[7]); } }
                const unsigned s0 = sg[ai][2 * mp].x, s1 = sg[ai][2 * mp + 1].x; const int slot = (int)((fq & 1) ? s1 : s0);
#pragma unroll
                for (int bj = 0; bj < 2; ++bj) { const auto sx = __builtin_amdgcn_permlane16_swap(w[0][bj].x, w[1][bj].x, false, false), sy = __builtin_amdgcn_permlane16_swap(w[0][bj].y, w[1][bj].y, false, false);
                    v4u o; o.x = sx[0]; o.y = sy[0]; o.z = sx[1]; o.w = sy[1]; yw[(ai * 2 + mp) * 2 + bj] = o; }
                ys[ai * 2 + mp] = slot; }
        if (has_next) put((u.slot + 1) & 1, tidw, nv);
        __builtin_amdgcn_sched_barrier(0);
#pragma unroll
        for (int i = 0; i < 4; ++i)
#pragma unroll
            for (int bj = 0; bj < 2; ++bj) if (ys[i] >= 0) *(v4u*)(Y + (size_t)ys[i] * D + (colt - 8 * (fq & 1)) + bj * 128) = yw[i * 2 + bj];
    }
};

struct InProjOrder {
    int G, c;
    __device__ bool next(int i, Unit& u) const {
        const int L = i * G + c; if (L >= 512) return false;
        const int R0 = 2 * G < 384 ? 2 * G : 384; int s;
        if (L < R0) s = pg8::xcd_remap(L, R0); else if (L < R0 + 128) s = 384 + pg8::xcd_remap(L - R0, 128); else s = L - 128;
        if (s < 384) { const int grp = s / 48, r = s % 48; u.slot = 0; u.pm = grp * 8 + (r & 7); const int pi = r >> 3; u.pn = pi < 4 ? pi : pi + 2; u.e = 0;
            u.offA = (long)u.pm * 256 * D * 2; u.offB = (long)u.pn * 256 * D * 2; }
        else { const int r = s - 384; u.slot = 0; u.pm = r & 1; u.pn = r >> 1; u.e = 1;
            u.offA = (long)(WS_WINT - WS_HN) + (long)(1024 + u.pm * 256) * D * 2; u.offB = (long)(WS_HN - WS_WINT) + (long)u.pn * 256 * D * 2; }
        return true;
    }
    __device__ __forceinline__ void a_ready(const Unit&) const {}
    __device__ __forceinline__ void done(const Unit&) const {}
};
struct SsmOrder {
    int nwg, G, c, npn, rows_per_g, ldb;
    __device__ bool next(int i, Unit& u) const {
        const int L = i * G + c; if (L >= nwg) return false;
        const int per_g = 2 * npn; const int g = L / per_g, r = L % per_g;
        u.e = g; u.pm = r / npn; u.pn = r % npn; u.slot = 0;
        u.offA = ((long)u.pm * 256 * NG * UK + (long)g * UK) * 2; u.offB = ((long)g * rows_per_g + (long)u.pn * 256) * ldb * 2; return true;
    }
    __device__ __forceinline__ void a_ready(const Unit&) const {}
    __device__ __forceinline__ void done(const Unit&) const {}
};
struct MoeOrder {
    const LAS int* units; long ebytes; int gather;
    __device__ __forceinline__ bool next(int i, Unit& u) const {
        if (i >= 32) return false;
        const int v = __builtin_amdgcn_readfirstlane(units[4 * i + 3]); if (!v) return false;
        u.pm = __builtin_amdgcn_readfirstlane(units[4 * i + 0]); u.pn = __builtin_amdgcn_readfirstlane(units[4 * i + 1]); u.e = __builtin_amdgcn_readfirstlane(units[4 * i + 2]);
        u.slot = i; u.offA = gather ? 0l : (long)u.pm * 256 * D;     u.offB = (long)u.e * ebytes + (long)u.pn * 256 * 16; return true;
    }
    __device__ __forceinline__ void a_ready(const Unit&) const {}
    __device__ __forceinline__ void done(const Unit&) const {}
};

struct CvItem { const float* src; bf16* dst; const float* kscale; int ldw, K, rmul, radd, k0, n0; };
constexpr int CV_I_IN = (D / 64) * (NPROJ / 32), CV_I_GLU = (SSW / 64) * (SSW / 32), CV_I_OUT = (D / 64) * (D / 32), CV_I_E = (D / 64) * (FF / 32);
constexpr int CV_N_EARLY = CV_I_IN + 2 * CV_I_GLU + CV_I_OUT, CV_N_EXP = 3 * NE * (D / 8);
__device__ __forceinline__ void cv_set(CvItem& c, const float* W, int ldw, int K, int N, bf16* WT, int rmul, int radd, int item) {
    const int nblk = N / 32, kb = item / nblk, nb = item % nblk; c.src = W; c.dst = WT; c.kscale = nullptr; c.ldw = ldw; c.K = K; c.rmul = rmul; c.radd = radd; c.k0 = 64 * kb; c.n0 = 32 * nb;
}
__device__ __forceinline__ void cv_decode_early(Frame& F, int r, CvItem& c) {
    bf16* WinT = (bf16*)(F.ws + WS_WINT); bf16* WgluT = (bf16*)(F.ws + WS_WGLUT); bf16* WoutT = (bf16*)(F.ws + WS_WOUTT);
    if (r < CV_I_IN) { cv_set(c, F.in[2], NPROJ, D, NPROJ, WinT, 1, 0, r); return; } r -= CV_I_IN;
    if (r < CV_I_GLU) { cv_set(c, F.in[11], 2 * SSW, SSW, SSW, WgluT, 2, 0, r); return; } r -= CV_I_GLU;
    if (r < CV_I_GLU) { cv_set(c, F.in[11] + SSW, 2 * SSW, SSW, SSW, WgluT, 2, 128, r); return; } r -= CV_I_GLU;
    cv_set(c, F.in[14], D, D, D, WoutT, 1, 0, r);
    c.kscale = (c.k0 < SBW) ? F.in[12] + c.k0 : F.in[13] + (c.k0 - SBW);
}
__device__ __forceinline__ void cv_load(const CvItem& c, int lane, float (&v)[32]) {
    const float* p = c.src + (size_t)(c.k0 + (lane >> 5)) * c.ldw + c.n0 + (lane & 31);
#pragma unroll
    for (int i = 0; i < 32; ++i) v[i] = __builtin_nontemporal_load(p + (size_t)(2 * i) * c.ldw);
}
__device__ __forceinline__ void cv_store(const CvItem& c, int lane, const float (&v)[32], LAS float* scr) {
#pragma unroll
    for (int i = 0; i < 32; ++i) scr[(2 * i + (lane >> 5)) * 33 + (lane & 31)] = v[i];
    LDS_WAIT(); asm volatile("" ::: "memory");
    const int cc = lane & 7;
#pragma unroll
    for (int j = 0; j < 4; ++j) { const int nl = (lane >> 3) + 8 * j; const int n = c.n0 + nl; const int drow = (n >> 7) * 128 * c.rmul + c.radd + (n & 127); const LAS float* s = scr + (8 * cc) * 33 + nl;
        float e0 = s[0 * 33], e1 = s[1 * 33], e2 = s[2 * 33], e3 = s[3 * 33], e4 = s[4 * 33], e5 = s[5 * 33], e6 = s[6 * 33], e7 = s[7 * 33];
        if (c.kscale) { const f32x4 ka = *(const f32x4*)(c.kscale + 8 * cc), kb = *(const f32x4*)(c.kscale + 8 * cc + 4); e0 *= ka.x; e1 *= ka.y; e2 *= ka.z; e3 *= ka.w; e4 *= kb.x; e5 *= kb.y; e6 *= kb.z; e7 *= kb.w; }
        v4u o; o.x = pg8::cvt_pk_bf16(e0, e1); o.y = pg8::cvt_pk_bf16(e2, e3); o.z = pg8::cvt_pk_bf16(e4, e5); o.w = pg8::cvt_pk_bf16(e6, e7);
        *(GAS v4u*)(c.dst + (size_t)drow * c.K + c.k0 + 8 * cc) = o; }
    LDS_WAIT(); asm volatile("" ::: "memory");
}
__device__ __forceinline__ void cv_item_early(Frame& F, int it, LAS float* scr) { CvItem c; float v[32]; cv_decode_early(F, it, c); cv_load(c, F.lane, v); cv_store(c, F.lane, v, scr); }
__device__ __forceinline__ void xv_item(Frame& F, int it) {
    unsigned char* W1T = F.ws + WS_W1T; unsigned char* W2T = F.ws + WS_W2T;
    const float* w0 = F.in[18]; const float* w1 = F.in[20]; const float* w2 = F.in[22];
    asm volatile("" : "+s"(w0), "+s"(w1), "+s"(w2));
    const int lane = F.lane;
    {
        const int mat = it >> 7, kb = (it & 127) >> 1, half = it & 1, kind = mat / NE, e = mat % NE;
        const float* src = (kind == 0 ? w0 : (kind == 1 ? w1 : w2)) + (size_t)e * D * FF + (size_t)(kb * 16) * FF + half * 512 + 4 * lane;
        f32x4 v[16][2];
#pragma unroll
        for (int rr = 0; rr < 16; ++rr)
#pragma unroll
            for (int j = 0; j < 2; ++j) v[rr][j] = __builtin_nontemporal_load((const GAS f32x4*)(src + (size_t)rr * FF + 256 * j));
        unsigned char* dst; int jstride;
        if (kind < 2) { dst = W1T + (size_t)e * 2 * FF * D + ((size_t)kb * 2 * FF + (size_t)(half * 4 + (lane >> 5)) * 256 + (kind == 1 ? 128 : 0) + 4 * (lane & 31)) * 16; jstride = 512 * 16; }
        else { dst = W2T + (size_t)e * D * FF + ((size_t)kb * D + half * 512 + 4 * lane) * 16; jstride = 256 * 16; }
#pragma unroll
        for (int j = 0; j < 2; ++j)
#pragma unroll
            for (int c = 0; c < 4; ++c) { v4u o;
                o.x = pk4_fp8(v[0][j][c] * WSCALE, v[1][j][c] * WSCALE, v[2][j][c] * WSCALE, v[3][j][c] * WSCALE); o.y = pk4_fp8(v[4][j][c] * WSCALE, v[5][j][c] * WSCALE, v[6][j][c] * WSCALE, v[7][j][c] * WSCALE);
                o.z = pk4_fp8(v[8][j][c] * WSCALE, v[9][j][c] * WSCALE, v[10][j][c] * WSCALE, v[11][j][c] * WSCALE); o.w = pk4_fp8(v[12][j][c] * WSCALE, v[13][j][c] * WSCALE, v[14][j][c] * WSCALE, v[15][j][c] * WSCALE);
                *(GAS v4u*)(dst + (size_t)j * jstride + c * 16) = o; }
    }
}
__device__ __forceinline__ void sincos_acc(float th, float& s, float& c) {
    const float k = rintf(th * 0.15915494309189535f);
    float r = fmaf(-k, 6.28125f, th); r = fmaf(-k, 1.9353071795864769e-3f, r);
    const float x = 0.25f * r, x2 = x * x;
    float sn = x * (1.0f + x2 * (-1.0f / 6 + x2 * (1.0f / 120 + x2 * (-1.0f / 5040 + x2 * (1.0f / 362880 + x2 * (-1.0f / 39916800))))));
    float cs = 1.0f + x2 * (-0.5f + x2 * (1.0f / 24 + x2 * (-1.0f / 720 + x2 * (1.0f / 40320 + x2 * (-1.0f / 3628800 + x2 * (1.0f / 479001600))))));
#pragma unroll
    for (int i = 0; i < 2; ++i) { const float s2 = 2.0f * sn * cs, c2 = 1.0f - 2.0f * sn * sn; sn = s2; cs = c2; }
    s = sn; c = cs;
}
__device__ __forceinline__ void ssm_tables(Frame& F, int g) {
    constexpr int PT = 36, BS = 17, CS = 68, KT = 324, KC = 20;
    LAS float* pwr = (LAS float*)(F.lds);
    LAS float* pwi = pwr + 64 * PT;
    LAS float* bbr = pwi + 64 * PT;
    LAS float* bbi = bbr + 64 * BS;
    LAS float* ccr = bbi + 64 * BS;
    LAS float* cci = ccr + 16 * CS;
    LAS float* km = cci + 16 * CS;
    const float* lam_re = F.in[3]; const float* lam_im = F.in[4]; const float* log_dt = F.in[5];
    const float* b_re = F.in[6]; const float* b_im = F.in[7]; const float* c_re = F.in[8]; const float* c_im = F.in[9]; const float* dsk = F.in[10];
    float* lamL = (float*)(F.ws + WS_LAML); bf16* WE = (bf16*)(F.ws + WS_WE); bf16* TW = (bf16*)(F.ws + WS_TW);
    const int tid = F.tid;
    if (tid < 64) { const int p = tid;
        const float lr = lam_re[g * NP + p], li = lam_im[g * NP + p], dt = expf(log_dt[g]);
        const float er = expf(lr * dt); float sn, cs; sincos_acc(li * dt, sn, cs);
        const float br = er * cs, bi = er * sn;
        const float nr = br - 1.0f, ni = bi, den = 1.0f / (lr * lr + li * li);
        const float fr = (nr * lr + ni * li) * den, fi = (ni * lr - nr * li) * den;
        float pr = 1.0f, pi = 0.0f;
        for (int n = 0; n <= 32; ++n) { pwr[p * PT + n] = pr; pwi[p * PT + n] = pi; const float t = pr * br - pi * bi; pi = pr * bi + pi * br; pr = t; }
        lamL[(g * 2 + 0) * NP + p] = pwr[p * PT + 32]; lamL[(g * 2 + 1) * NP + p] = pwi[p * PT + 32];
        float xr[GC], xi[GC];
#pragma unroll
        for (int c = 0; c < GC; ++c) { xr[c] = b_re[(g * NP + p) * GC + c]; xi[c] = b_im[(g * NP + p) * GC + c]; }
#pragma unroll
        for (int c = 0; c < GC; ++c) { bbr[p * BS + c] = fr * xr[c] - fi * xi[c]; bbi[p * BS + c] = fr * xi[c] + fi * xr[c]; }
    }
    for (int i = tid; i < 1024; i += NWAVES * 64) { ccr[(i >> 6) * CS + (i & 63)] = c_re[g * 1024 + i]; cci[(i >> 6) * CS + (i & 63)] = c_im[g * 1024 + i]; }
    __syncthreads();
    {
        const int pair = tid & 255, co = pair >> 4, ci = pair & 15, t0 = (tid >> 8) * 16;
        float acc[16];
#pragma unroll
        for (int t = 0; t < 16; ++t) acc[t] = 0.f;
        for (int p = 0; p < NP; ++p) { const float cr = ccr[co * CS + p], cim = cci[co * CS + p], xr = bbr[p * BS + ci], xi = bbi[p * BS + ci];
            const float gr = cr * xr - cim * xi, gi = cr * xi + cim * xr;
#pragma unroll
            for (int t4 = 0; t4 < 4; ++t4) { const f32x4 a = *(const LAS f32x4*)(pwr + p * PT + t0 + 4 * t4), bq = *(const LAS f32x4*)(pwi + p * PT + t0 + 4 * t4);
#pragma unroll
                for (int t = 0; t < 4; ++t) acc[4 * t4 + t] += gr * a[t] - gi * bq[t]; } }
#pragma unroll
        for (int t = 0; t < 16; ++t) km[(t0 + t) * KT + co * KC + ci] = acc[t];
    }
    __syncthreads();
    {
        const int n = tid, i = n >> 4, co = n & 15; const float dv = dsk[g * GC + co];
        bf16* dst = TW + ((size_t)g * 512 + n) * UK;
        for (int j = 0; j < LC; ++j) {
            float v[16];
            const LAS float* kr = km + (j <= i ? i - j : 0) * KT + co * KC;
#pragma unroll
            for (int c4 = 0; c4 < 4; ++c4) { const f32x4 q = *(const LAS f32x4*)(kr + 4 * c4);
#pragma unroll
                for (int t = 0; t < 4; ++t) v[4 * c4 + t] = (j <= i) ? q[t] : 0.f; }
            if (j == i) {
#pragma unroll
                for (int ci = 0; ci < 16; ++ci) v[ci] += (ci == co) ? dv : 0.f; }
            v4u o0, o1; o0.x = pg8::cvt_pk_bf16(v[0], v[1]); o0.y = pg8::cvt_pk_bf16(v[2], v[3]); o0.z = pg8::cvt_pk_bf16(v[4], v[5]); o0.w = pg8::cvt_pk_bf16(v[6], v[7]);
            o1.x = pg8::cvt_pk_bf16(v[8], v[9]); o1.y = pg8::cvt_pk_bf16(v[10], v[11]); o1.z = pg8::cvt_pk_bf16(v[12], v[13]); o1.w = pg8::cvt_pk_bf16(v[14], v[15]);
            *(GAS v4u*)(dst + j * 16) = o0; *(GAS v4u*)(dst + j * 16 + 8) = o1; }
        for (int k8 = 0; k8 < 16; ++k8) { float v[8];
            const int ri = k8 >> 3, p0 = 8 * (k8 & 7);
#pragma unroll
            for (int e = 0; e < 8; ++e) { const int p = p0 + e; const float cr = ccr[co * CS + p], cim = cci[co * CS + p], pr = pwr[p * PT + i + 1], pi = pwi[p * PT + i + 1];
                v[e] = ri == 0 ? (cr * pr - cim * pi) : -(cr * pi + cim * pr); }
            v4u o; o.x = pg8::cvt_pk_bf16(v[0], v[1]); o.y = pg8::cvt_pk_bf16(v[2], v[3]); o.z = pg8::cvt_pk_bf16(v[4], v[5]); o.w = pg8::cvt_pk_bf16(v[6], v[7]);
            *(GAS v4u*)(dst + 512 + k8 * 8) = o; }
    }
    {
        const int row = tid & 127, ri = row >> 6, p = row & 63, kq = tid >> 7;
        bf16* dst = WE + ((size_t)g * 128 + row) * 512 + kq * 128;
        for (int k8 = 0; k8 < 16; ++k8) { float v[8];
#pragma unroll
            for (int e = 0; e < 8; ++e) { const int k = kq * 128 + k8 * 8 + e, j = k >> 4, c = k & 15; const float pr = pwr[p * PT + 31 - j], pi = pwi[p * PT + 31 - j], xr = bbr[p * BS + c], xi = bbi[p * BS + c];
                v[e] = ri == 0 ? (pr * xr - pi * xi) : (pr * xi + pi * xr); }
            v4u o; o.x = pg8::cvt_pk_bf16(v[0], v[1]); o.y = pg8::cvt_pk_bf16(v[2], v[3]); o.z = pg8::cvt_pk_bf16(v[4], v[5]); o.w = pg8::cvt_pk_bf16(v[6], v[7]);
            *(GAS v4u*)(dst + k8 * 8) = o; }
    }
    __syncthreads();
}
__device__ __forceinline__ void rms_rows4_to_bf16(int lane, const float* x0, const float* g, bf16* o0) {
    const GAS f32x4* gr = (const GAS f32x4*)g + lane;
    f32x4 v[4][4]; float sq[4];
#pragma unroll
    for (int r = 0; r < 4; ++r)
#pragma unroll
        for (int j = 0; j < 4; ++j) v[r][j] = __builtin_nontemporal_load(((const GAS f32x4*)(x0 + (size_t)r * D) + lane) + 64 * j);
#pragma unroll
    for (int r = 0; r < 4; ++r) { sq[r] = 0.f;
#pragma unroll
        for (int j = 0; j < 4; ++j) sq[r] += (v[r][j].x * v[r][j].x + v[r][j].y * v[r][j].y) + (v[r][j].z * v[r][j].z + v[r][j].w * v[r][j].w); }
#pragma unroll
    for (int o = 1; o < 64; o <<= 1) {
#pragma unroll
        for (int r = 0; r < 4; ++r) sq[r] += __shfl_xor(sq[r], o); }
    const bool odd = lane & 1;
#pragma unroll
    for (int jp = 0; jp < 2; ++jp) { const f32x4 g0 = gr[64 * (2 * jp)], g1 = gr[64 * (2 * jp + 1)];
#pragma unroll
        for (int r = 0; r < 4; ++r) { const float rs = 1.0f / sqrtf(sq[r] * (1.f / D) + EPS); const f32x4 a = v[r][2 * jp], b = v[r][2 * jp + 1]; v2u wa, wb;
            wa.x = pg8::cvt_pk_bf16(a.x * rs * g0.x, a.y * rs * g0.y); wa.y = pg8::cvt_pk_bf16(a.z * rs * g0.z, a.w * rs * g0.w);
            wb.x = pg8::cvt_pk_bf16(b.x * rs * g1.x, b.y * rs * g1.y); wb.y = pg8::cvt_pk_bf16(b.z * rs * g1.z, b.w * rs * g1.w);
            const unsigned gx = odd ? wa.x : wb.x, gy = odd ? wa.y : wb.y;
            const unsigned rx = (unsigned)__builtin_amdgcn_update_dpp(0, (int)gx, 0xB1, 0xF, 0xF, false), ry = (unsigned)__builtin_amdgcn_update_dpp(0, (int)gy, 0xB1, 0xF, 0xF, false);
            v4u o; o.x = odd ? rx : wa.x; o.y = odd ? ry : wa.y; o.z = odd ? wb.x : rx; o.w = odd ? wb.y : ry;
            *(GAS v4u*)(o0 + (size_t)r * D + 256 * (2 * jp + (odd ? 1 : 0)) + 4 * (lane & ~1)) = o; } }
}
constexpr int CV_N_W1 = 2 * NE * (D / 8);
constexpr int P1_GEMM_WG = 176;
constexpr int Q0_HN = M / 8, Q0_END = Q0_HN + CV_N_EARLY / 4;
static_assert(Q0_END % 8 == 0 && CV_N_EARLY % 4 == 0, "P0 queue");
__device__ __forceinline__ void p0_prologue(Frame& F, unsigned long long& t_lo_, unsigned long long& t_hi_) {
    TMARK(100);
    LAS float* scr = (LAS float*)(F.lds + RING_OFF + F.wave * 16384);
    unsigned* q = (unsigned*)(F.ctl + CW_Q0); volatile LAS unsigned* slot = F.MISC + 16;
    bf16* HN = (bf16*)(F.ws + WS_HN);
    for (int n = 0;; ++n) {
        int base = (int)blockIdx.x * 8;
        if (n > 0) { __syncthreads();
            if (F.tid == 0) *slot = (unsigned)(P1_GEMM_WG * 8) + __hip_atomic_fetch_add(q, 8u, RLX_AGENT);
            __syncthreads();
            base = (int)__builtin_amdgcn_readfirstlane(*slot); }
        if (base >= Q0_END) break;
        const int idx = base + F.wave;
        if (idx < Q0_HN) { const int m0 = idx * 8;
#pragma unroll 1
            for (int j = 0; j < 2; ++j) { const int m = m0 + 4 * j; rms_rows4_to_bf16(F.lane, F.in[0] + (size_t)m * D, F.in[1], HN + (size_t)m * D); } }
        else { const int g4 = (idx - Q0_HN) * 4;
#pragma unroll 1
            for (int j = 0; j < 4; ++j) cv_item_early(F, g4 + j, scr); }
    }
    TMARK(104);
}
__device__ __forceinline__ void q1_drain(Frame& F, int max_claims, unsigned* stop, unsigned stop_target) {
    unsigned* q = (unsigned*)(F.ctl + CW_Q1); volatile LAS unsigned* slot = F.MISC + 18;
    for (int n = 0; max_claims < 0 || n < max_claims; ++n) {
        __syncthreads();
        if (F.tid == 0) { unsigned v = 0x7fffffffu; if (!(stop_target && __hip_atomic_load(stop, RLX_AGENT) >= stop_target)) v = __hip_atomic_fetch_add(q, 8u, RLX_AGENT); *slot = v; }
        __syncthreads();
        const unsigned base = (unsigned)__builtin_amdgcn_readfirstlane(*slot); if (base >= (unsigned)CV_N_W1) break;
        xv_item(F, (int)base + F.wave);
    }
}
__device__ __forceinline__ void p1_side(Frame& F, int tabler_idx) {
    if (tabler_idx >= 0) { ssm_tables(F, tabler_idx);
        if (tabler_idx == 0 && F.tid < 128) {
            bf16* WE = (bf16*)(F.ws + WS_WE) + (size_t)NG * 128 * 512;
            for (int i = 0; i < 512 / 8; ++i) *(GAS v4u*)(WE + (size_t)F.tid * 512 + i * 8) = (v4u){0u, 0u, 0u, 0u}; }
        if (tabler_idx == 1) {
            const float* wr = F.in[16]; bf16* img = (bf16*)(F.ws + WS_RWIMG);
            for (int idx = F.tid; idx < D * NE; idx += NWAVES * 64) { const float w = wr[idx]; const unsigned h = f2bf(w); const unsigned l = f2bf(w - bf2f((unsigned short)h)); const int k = idx >> 5, e = idx & 31;
                img[e * RT_WSTR + k] = (bf16)h; img[(NE + e) * RT_WSTR + k] = (bf16)l; }
            if (F.tid < 2 * NE) for (int k = D; k < RT_WSTR; ++k) img[F.tid * RT_WSTR + k] = 0; } }
    q1_drain(F, -1, (unsigned*)(F.ctl + CW_DONE1), (unsigned)P1_GEMM_WG);
}
__device__ __forceinline__ void w2_drain(Frame& F, int max_claims) {
    unsigned* q = (unsigned*)(F.ctl + CW_Q2); volatile LAS unsigned* slot = F.MISC + 19;
    for (int n = 0; max_claims < 0 || n < max_claims; ++n) {
        __syncthreads();
        if (F.tid == 0) *slot = __hip_atomic_fetch_add(q, 8u, RLX_AGENT);
        __syncthreads();
        const int base = CV_N_W1 + (int)__builtin_amdgcn_readfirstlane(*slot); if (base >= CV_N_EXP) break;
        xv_item(F, base + F.wave);
    }
}

typedef _Float16 h8v __attribute__((ext_vector_type(8)));
typedef float f16v __attribute__((ext_vector_type(16)));
__device__ __forceinline__ void attn_mfma_unit(const _Float16* Qh, const _Float16* Kh, const _Float16* VT, bf16* Y, float* SSQ, int b, int hd, int qb, int lane, h8v tri0, h8v tri1) {
    const int r = lane & 31, hh = lane >> 5, q0 = qb * 32;
    const _Float16* qrow = Qh + ((size_t)b * SEQ + q0 + r) * SBW + hd * HD + 8 * hh;
    h8v qf[4];
#pragma unroll
    for (int kd = 0; kd < 4; ++kd) qf[kd] = __builtin_nontemporal_load((const h8v*)(qrow + 16 * kd));
    f16v o0, o1;
#pragma unroll
    for (int i = 0; i < 16; ++i) { o0[i] = 0.f; o1[i] = 0.f; }
    float carry = 0.f;
    const _Float16* kbase = Kh + ((size_t)b * SEQ + r) * SBW + hd * HD + 8 * hh;
    const _Float16* vbase = VT + ((size_t)b * SBW + hd * HD + r) * SEQ + 8 * hh;
    h8v kf[4], vf[2][2], kn[4], vn[2][2];
#pragma unroll
    for (int kd = 0; kd < 4; ++kd) kf[kd] = *(const h8v*)(kbase + (size_t)q0 * SBW + 16 * kd);
#pragma unroll
    for (int db = 0; db < 2; ++db)
#pragma unroll
        for (int ss = 0; ss < 2; ++ss) vf[db][ss] = *(const h8v*)(vbase + (size_t)(32 * db) * SEQ + q0 + 16 * ss);
    for (int key0 = q0; key0 >= 0; key0 -= 32) {
        { const int kn0 = key0 >= 32 ? key0 - 32 : key0;
#pragma unroll
          for (int kd = 0; kd < 4; ++kd) kn[kd] = *(const h8v*)(kbase + (size_t)kn0 * SBW + 16 * kd);
#pragma unroll
          for (int db = 0; db < 2; ++db)
#pragma unroll
              for (int ss = 0; ss < 2; ++ss) vn[db][ss] = *(const h8v*)(vbase + (size_t)(32 * db) * SEQ + kn0 + 16 * ss); }
        f16v z;
#pragma unroll
        for (int i = 0; i < 16; ++i) z[i] = 0.f;
#pragma unroll
        for (int kd = 0; kd < 4; ++kd) z = __builtin_amdgcn_mfma_f32_32x32x16_f16(kf[kd], qf[kd], z, 0, 0, 0);
        h8v lh[2], pf[2]; f16v cum;
#pragma unroll
        for (int i = 0; i < 16; ++i) cum[i] = carry;
        if (key0 == q0) {
#pragma unroll
            for (int i = 0; i < 16; ++i) { const int koff = (i & 3) + 8 * (i >> 2) + 4 * hh; const bool act = koff < r;
                const float zi = z[i]; const float t1 = flog2(1.0f + fexp2(-fabsf(zi)));
                const float L = act ? fmaxf(-(__builtin_amdgcn_fmed3f(zi, 0.f, 3.0e38f) + t1), -60000.0f) : 0.f; lh[i >> 3][i & 7] = (_Float16)L; }
            cum = __builtin_amdgcn_mfma_f32_32x32x16_f16(tri0, lh[0], cum, 0, 0, 0);
            cum = __builtin_amdgcn_mfma_f32_32x32x16_f16(tri1, lh[1], cum, 0, 0, 0);
#pragma unroll
            for (int i = 0; i < 16; ++i) { const int koff = (i & 3) + 8 * (i >> 2) + 4 * hh; const float p = (koff < r) ? fexp2(z[i] + cum[i]) : 0.f; pf[i >> 3][i & 7] = (_Float16)p; }
        } else {
#pragma unroll
            for (int i = 0; i < 16; ++i) { const float zi = z[i]; const float t1 = flog2(1.0f + fexp2(-fabsf(zi)));
                lh[i >> 3][i & 7] = (_Float16)fmaxf(-(__builtin_amdgcn_fmed3f(zi, 0.f, 3.0e38f) + t1), -60000.0f); }
            cum = __builtin_amdgcn_mfma_f32_32x32x16_f16(tri0, lh[0], cum, 0, 0, 0);
            cum = __builtin_amdgcn_mfma_f32_32x32x16_f16(tri1, lh[1], cum, 0, 0, 0);
#pragma unroll
            for (int i = 0; i < 16; ++i) pf[i >> 3][i & 7] = (_Float16)fexp2(z[i] + cum[i]);
        }
        o0 = __builtin_amdgcn_mfma_f32_32x32x16_f16(vf[0][0], pf[0], o0, 0, 0, 0);
        o0 = __builtin_amdgcn_mfma_f32_32x32x16_f16(vf[0][1], pf[1], o0, 0, 0, 0);
        o1 = __builtin_amdgcn_mfma_f32_32x32x16_f16(vf[1][0], pf[0], o1, 0, 0, 0);
        o1 = __builtin_amdgcn_mfma_f32_32x32x16_f16(vf[1][1], pf[1], o1, 0, 0, 0);
        carry = __shfl(cum[0], r);
        if (__all(carry < -150.0f)) break;
#pragma unroll
        for (int kd = 0; kd < 4; ++kd) kf[kd] = kn[kd];
#pragma unroll
        for (int db = 0; db < 2; ++db)
#pragma unroll
            for (int ss = 0; ss < 2; ++ss) vf[db][ss] = vn[db][ss];
    }
    { float sq = 0.f;
#pragma unroll
      for (int i = 0; i < 16; ++i) sq += o0[i] * o0[i] + o1[i] * o1[i];
      sq += __shfl_xor(sq, 32); if (hh == 0) SSQ[((size_t)b * SEQ + q0 + r) * NH + hd] = sq; }
    bf16* yp = Y + ((size_t)b * SEQ + q0 + r) * D + hd * HD + 4 * hh;
#pragma unroll
    for (int g4 = 0; g4 < 4; ++g4) { v2u w0, w1; w0.x = pk2(o0[4 * g4], o0[4 * g4 + 1]); w0.y = pk2(o0[4 * g4 + 2], o0[4 * g4 + 3]); w1.x = pk2(o1[4 * g4], o1[4 * g4 + 1]); w1.y = pk2(o1[4 * g4 + 2], o1[4 * g4 + 3]);
        *(v2u*)(yp + 8 * g4) = w0; *(v2u*)(yp + 32 + 8 * g4) = w1; }
}
__device__ __forceinline__ void attn_one(Frame& F, int u) {
    const _Float16* Qh = (const _Float16*)(F.ws + WS_Q); const _Float16* Kh = (const _Float16*)(F.ws + WS_K); const _Float16* VT = (const _Float16*)(F.ws + WS_V);
    bf16* Y = (bf16*)(F.ws + WS_YCAT); float* SSQ = (float*)(F.ws + WS_SSQSB);
    constexpr int NQB = SEQ / 32;
    const int lane = F.lane, r = lane & 31, hh = lane >> 5;
    h8v tri0, tri1;
#pragma unroll
    for (int e = 0; e < 8; ++e) { const int k0 = 8 * (e >> 2) + 4 * hh + (e & 3); tri0[e] = (k0 >= r) ? (_Float16)1.0f : (_Float16)0.0f; tri1[e] = (16 + k0 >= r) ? (_Float16)1.0f : (_Float16)0.0f; }
    const int qb = u % NQB, bh = u / NQB; attn_mfma_unit(Qh, Kh, VT, Y, SSQ, bh / NH, bh % NH, qb, lane, tri0, tri1);
}

__device__ __forceinline__ void scan_phase(Frame& F, int task) {
    static_assert(CPB == 8 * 32, "scan segments");
    const int b = task / NG, g = task % NG, p = F.lane, sg = F.wave;
    const float* lamL = (const float*)(F.ws + WS_LAML); const float* S = (const float*)(F.ws + WS_SLOC); bf16* U = (bf16*)(F.ws + WS_UCAT);
    LAS float* ex = (LAS float*)(F.lds);
    const float lr = lamL[(g * 2 + 0) * NP + p], li = lamL[(g * 2 + 1) * NP + p];
    float sr[32], si[32];
#pragma unroll
    for (int j = 0; j < 32; ++j) { const size_t base = ((size_t)(b * CPB + sg * 32 + j) * NG + g) * 128; sr[j] = S[base + p]; si[j] = S[base + 64 + p]; }
    float er = 0.f, ei = 0.f, qr = 1.f, qi = 0.f;
#pragma unroll
    for (int j = 0; j < 32; ++j) { const float nr = lr * er - li * ei + sr[j], ni = lr * ei + li * er + si[j]; er = nr; ei = ni; const float tr = lr * qr - li * qi; qi = lr * qi + li * qr; qr = tr; }
    ex[(sg * 2 + 0) * 64 + p] = er; ex[(sg * 2 + 1) * 64 + p] = ei;
    __syncthreads();
    float xr = 0.f, xi = 0.f;
    for (int r = 0; r < sg; ++r) { const float tr = qr * xr - qi * xi + ex[(r * 2 + 0) * 64 + p], ti = qr * xi + qi * xr + ex[(r * 2 + 1) * 64 + p]; xr = tr; xi = ti; }
#pragma unroll
    for (int j = 0; j < 32; ++j) { bf16* dst = U + ((size_t)(b * CPB + sg * 32 + j) * NG + g) * UK + 512;
        dst[p] = (bf16)f2bf(xr); dst[64 + p] = (bf16)f2bf(xi);
        const float nr = lr * xr - li * xi + sr[j], ni = lr * xi + li * xr + si[j]; xr = nr; xi = ni; }
    __syncthreads();
}

__device__ __forceinline__ void router_phase(Frame& F, const int tb) {
    typedef short s8v __attribute__((ext_vector_type(8)));
    typedef float f16v __attribute__((ext_vector_type(16)));
    LAS bf16* wh = (LAS bf16*)F.lds; LAS bf16* wl = wh + NE * RT_WSTR;
    LAS int* lcnt = (LAS int*)(F.lds + RT_SCR_OFF); LAS int* lbase = lcnt + 32; LAS int* asg = lbase + 32;
    const float* wr = F.in[16]; const float* br = F.in[17]; const float* g2 = F.in[15];
    bf16* XG = (bf16*)(F.ws + WS_XN); float* gates = (float*)(F.ws + WS_GATES); int* lists = (int*)(F.ws + WS_LISTS); float* RS = (float*)(F.ws + WS_RSTD);
    unsigned* gcnt = (unsigned*)(F.ctl + CW_CNT);
    const int tid = F.tid, lane = F.lane, r = lane & 31, hh = lane >> 5;
    const int task = F.wave >> 2, kq = F.wave & 3; const int tok = tb + task * 32 + r;
    const bf16* xp = x1_row(F.ws, tok) + kq * 256 + 8 * hh; unsigned char* xo = (unsigned char*)XG + (size_t)tok * D + kq * 256 + 8 * hh;
    v4u xw[16];
#pragma unroll
    for (int ks = 0; ks < 16; ++ks) xw[ks] = __builtin_nontemporal_load((const v4u*)(xp + 16 * ks));
    { const unsigned char* src = F.ws + WS_RWIMG;
      static_assert(RT_W_BYTES / 1024 == NWAVES * 16 && RT_W_BYTES % 1024 == 512, "w image pieces");
#pragma unroll
      for (int j = 0; j < 16; ++j) { const int piece = F.wave * 16 + j;
          __builtin_amdgcn_global_load_lds((const unsigned*)(src + (size_t)piece * 1024 + lane * 16), (LAS unsigned*)(F.lds + piece * 1024), 16, 0, 0); }
      if (tid < 32) ((LAS v4u*)F.lds)[NWAVES * 16 * 64 + tid] = ((const v4u*)src)[NWAVES * 16 * 64 + tid];
      asm volatile("s_waitcnt vmcnt(0)" ::: "memory"); }
    LAS float* gl = (LAS float*)(F.lds + RT_SCR_OFF + 2048);
    for (int i = tid; i < D / 4; i += NWAVES * 64) ((LAS f32x4*)gl)[i] = ((const f32x4*)g2)[i];
    if (tid < 32) lcnt[tid] = 0;
    __syncthreads();
    f16v acc;
#pragma unroll
    for (int i = 0; i < 16; ++i) acc[i] = 0.f;
    float ss = 0.f;
    const LAS float* gp = gl + kq * 256 + 8 * hh;
    const LAS bf16* whp = wh + r * RT_WSTR + kq * 256 + 8 * hh; const LAS bf16* wlp = wl + r * RT_WSTR + kq * 256 + 8 * hh;
#pragma unroll
    for (int ks = 0; ks < 16; ++ks) {
        const v4u xq = xw[ks]; const f32x4 x0 = (f32x4){bflo(xq.x), bfhi(xq.x), bflo(xq.y), bfhi(xq.y)}, x1 = (f32x4){bflo(xq.z), bfhi(xq.z), bflo(xq.w), bfhi(xq.w)}, g0 = *(const LAS f32x4*)(gp + 16 * ks), g1 = *(const LAS f32x4*)(gp + 16 * ks + 4);
        ss += (x0.x * x0.x + x0.y * x0.y) + (x0.z * x0.z + x0.w * x0.w) + (x1.x * x1.x + x1.y * x1.y) + (x1.z * x1.z + x1.w * x1.w);
        const f32x4 a0 = x0 * g0, a1 = x1 * g1;
        v4u hv, lv;
        hv.x = pg8::cvt_pk_bf16(a0.x, a0.y); hv.y = pg8::cvt_pk_bf16(a0.z, a0.w); hv.z = pg8::cvt_pk_bf16(a1.x, a1.y); hv.w = pg8::cvt_pk_bf16(a1.z, a1.w);
        lv.x = pg8::cvt_pk_bf16(a0.x - bflo(hv.x), a0.y - bfhi(hv.x)); lv.y = pg8::cvt_pk_bf16(a0.z - bflo(hv.y), a0.w - bfhi(hv.y));
        lv.z = pg8::cvt_pk_bf16(a1.x - bflo(hv.z), a1.y - bfhi(hv.z)); lv.w = pg8::cvt_pk_bf16(a1.z - bflo(hv.w), a1.w - bfhi(hv.w));
        { v2u f8; f8.x = pk4_fp8(a0.x, a0.y, a0.z, a0.w); f8.y = pk4_fp8(a1.x, a1.y, a1.z, a1.w); *(v2u*)(xo + 16 * ks) = f8; }
        const s8v xh = __builtin_bit_cast(s8v, hv), xl = __builtin_bit_cast(s8v, lv);
        v4u ah, al; { const LAS v2u* p = (const LAS v2u*)(whp + 16 * ks); const v2u q0 = p[0], q1 = p[1]; ah.x = q0.x; ah.y = q0.y; ah.z = q1.x; ah.w = q1.y; }
        { const LAS v2u* p = (const LAS v2u*)(wlp + 16 * ks); const v2u q0 = p[0], q1 = p[1]; al.x = q0.x; al.y = q0.y; al.z = q1.x; al.w = q1.y; }
        const s8v wa = __builtin_bit_cast(s8v, ah), wb = __builtin_bit_cast(s8v, al);
        acc = __builtin_amdgcn_mfma_f32_32x32x16_bf16(wa, xh, acc, 0, 0, 0);
        acc = __builtin_amdgcn_mfma_f32_32x32x16_bf16(wb, xh, acc, 0, 0, 0);
        acc = __builtin_amdgcn_mfma_f32_32x32x16_bf16(wa, xl, acc, 0, 0, 0);
    }
    __syncthreads();
    LAS float* part = (LAS float*)F.lds;
#pragma unroll
    for (int i = 0; i < 16; ++i) part[(F.wave * 17 + i) * 64 + lane] = acc[i];
    part[(F.wave * 17 + 16) * 64 + lane] = ss;
    __syncthreads();
    {
        float v[32]; float st = 0.f;
#pragma unroll
        for (int w = 0; w < 4; ++w) { const LAS float* pw = part + (size_t)((task * 4 + w) * 17) * 64;
#pragma unroll
            for (int i = 0; i < 16; ++i) { const float t = pw[i * 64 + lane]; v[i] = w == 0 ? t : v[i] + t; }
            st += pw[16 * 64 + lane] + pw[16 * 64 + (lane ^ 32)]; }
        const float rstd = 1.0f / sqrtf(st * (1.f / D) + EPS);
        if (kq == 0 && hh == 0) RS[tok] = rstd;
#pragma unroll
        for (int i = 0; i < 16; ++i) { const int e = (i & 3) + 8 * (i >> 2) + 4 * hh; v[i] = v[i] * rstd + br[e]; }
#pragma unroll
        for (int i = 0; i < 16; ++i) v[16 + i] = __shfl_xor(v[i], 32);
        float mx = v[0];
#pragma unroll
        for (int i = 1; i < 32; ++i) mx = fmaxf(mx, v[i]);
        int rk[4]; float ex[4]; float es = 0.f;
#pragma unroll
        for (int ii = 0; ii < 4; ++ii) {
            float vi = 0.f; int rank = 0;
#pragma unroll
            for (int q = 0; q < 4; ++q) if (q == kq) vi = v[4 * q + ii];
#pragma unroll
            for (int q = 0; q < 4; ++q) if (q == kq) { const int i = 4 * q + ii; const int ei = (i & 3) + 8 * (i >> 2) + 4 * hh; int rr = 0;
#pragma unroll
                for (int j = 0; j < 32; ++j) { if (j == i) continue; const int ej = (j & 3) + 8 * ((j & 15) >> 2) + 4 * (j < 16 ? hh : 1 - hh);
                    rr += (v[j] > vi || (v[j] == vi && ej < ei)) ? 1 : 0; }
                rank = rr; }
            rk[ii] = rank; ex[ii] = fexp2((vi - mx) * LOG2E); if (rank < TOPK) es += ex[ii]; }
        LAS float* esp = part + 8 * 17 * 64;
        esp[(task * 4 + kq) * 64 + lane] = es;
        __syncthreads();
        float et = 0.f;
#pragma unroll
        for (int q = 0; q < 4; ++q) et += esp[(task * 4 + q) * 64 + lane] + esp[(task * 4 + q) * 64 + (lane ^ 32)];
        const float inv = 1.0f / et;
#pragma unroll
        for (int ii = 0; ii < 4; ++ii) if (rk[ii] < TOPK) { const int i = 4 * kq + ii; const int ei = (i & 3) + 8 * (i >> 2) + 4 * hh;
            gates[tok * TOPK + rk[ii]] = ex[ii] * inv;
            const int pos = __hip_atomic_fetch_add(lcnt + ei, 1, __ATOMIC_RELAXED, __HIP_MEMORY_SCOPE_WORKGROUP);
            asg[(task * 32 + r) * 4 + rk[ii]] = ei | (pos << 8); }
    }
    __syncthreads();
    if (tid < 32) lbase[tid] = (int)__hip_atomic_fetch_add(gcnt + tid * CNT_STRIDE, (unsigned)lcnt[tid], RLX_AGENT);
    __syncthreads();
    if (tid < 64 * TOPK) { const int a = asg[tid], e = a & 255, pos = a >> 8; const int tk = tb + (tid >> 2);
        lists[e * M + lbase[e] + pos] = tk * TOPK + (tid & 3); }
    __syncthreads();
}

__device__ __forceinline__ void moe_tables(Frame& F) {
    LAS int* tab = (LAS int*)(F.lds + TAB_OFF); LAS int* cnt = tab, * mt = tab + 32, * tbase = tab + 64;
    unsigned* gcnt = (unsigned*)(F.ctl + CW_CNT);
    if (F.tid < 64) {
        const int e = F.tid; const int c = e < NE ? (int)__hip_atomic_load(gcnt + e * CNT_STRIDE, RLX_AGENT) : 0; const int m = (c + 255) >> 8;
        int s = m;
#pragma unroll
        for (int o = 1; o < 32; o <<= 1) { const int t = __shfl_up(s, o); if (e >= o) s += t; }
        if (e < NE) { cnt[e] = c; mt[e] = m; tbase[e] = s - m; }
        if (e == NE - 1) tbase[NE] = s; }
    __syncthreads();
}
__device__ __forceinline__ void moe_units(Frame& F, int npn, int gpn) {
    LAS int* tab = (LAS int*)(F.lds + TAB_OFF); LAS int* mt = tab + 32, * tbase = tab + 64; LAS int* units = (LAS int*)(F.lds + UNITS_OFF);
    if (F.tid < 32) {
        const int nU = tbase[NE] * npn; const int L = F.tid * F.G + (int)blockIdx.x; int pm = 0, pn = 0, e = 0, valid = 0;
        if (L < nU) { const int seq = pg8::xcd_remap(L, nU); int ee = 0;
#pragma unroll
            for (int st = 16; st >= 1; st >>= 1) { if (seq >= tbase[ee + st] * npn) ee += st; }
            const int r = seq - tbase[ee] * npn, m = mt[ee]; const int grp = r / (m * gpn), r2 = r % (m * gpn);
            e = ee; pn = grp * gpn + r2 / m; pm = tbase[ee] + r2 % m; valid = 1; }
        units[4 * F.tid + 0] = pm; units[4 * F.tid + 1] = pn; units[4 * F.tid + 2] = e; units[4 * F.tid + 3] = valid;
    }
    __syncthreads();
}

__device__ __forceinline__ void moe_gather_tables(Frame& F) {
    LAS int* tab = (LAS int*)(F.lds + TAB_OFF); LAS int* cnt = tab, * tbase = tab + 64; LAS int* units = (LAS int*)(F.lds + UNITS_OFF); LAS int* tokmap = (LAS int*)(F.lds + TOKMAP_OFF);
    const float* gates = (const float*)(F.ws + WS_GATES); const int* lists = (const int*)(F.ws + WS_LISTS); const float* RS = (const float*)(F.ws + WS_RSTD); int* rowinfo = (int*)(F.ws + WS_ROWINFO);
    for (int idx = F.tid; idx < TOKMAP_SLOTS * 256; idx += NWAVES * 64) { const int i = idx >> 8, R = idx & 255; int tk = 0;
        if (units[4 * i + 3]) { const int pm = units[4 * i], e = units[4 * i + 2]; const int li = (pm - tbase[e]) * 256 + R;
            v4u ri = (v4u){0xffffffffu, 0u, 0u, 0u};
            if (li < cnt[e]) { const int slot = lists[e * M + li]; tk = slot >> 2; ri = (v4u){(unsigned)slot, __builtin_bit_cast(unsigned, gates[slot]), __builtin_bit_cast(unsigned, RS[tk]), 0u}; }
            *(v4u*)(rowinfo + 4 * (pm * 256 + R)) = ri; }
        tokmap[idx] = tk; }
    asm volatile("s_waitcnt vmcnt(0)" ::: "memory");
    __syncthreads();
}

__device__ __forceinline__ void final_phase(Frame& F) {
    const unsigned char* YB = F.ws + WS_YBUF; const float* gf = F.in[24]; float* O = F.out;
    const int gw = F.vcu * NWAVES + F.wave, NGW = F.G * NWAVES, lane = F.lane;
    f32x4 gg[4];
#pragma unroll
    for (int j = 0; j < 4; ++j) gg[j] = *(const f32x4*)(gf + 4 * lane + 256 * j);
    for (int m0 = 2 * gw; m0 < M; m0 += 2 * NGW) {
        v2u xw[2][4]; int yw[2][4][TOPK];
#pragma unroll
        for (int t = 0; t < 2; ++t)
#pragma unroll
            for (int j = 0; j < 4; ++j) { xw[t][j] = __builtin_nontemporal_load((const v2u*)(x1_row(F.ws, m0 + t) + 4 * lane + 256 * j));
#pragma unroll
                for (int k = 0; k < TOPK; ++k) yw[t][j][k] = __builtin_nontemporal_load((const int*)(YB + ((size_t)(m0 + t) * TOPK + k) * D + 4 * lane + 256 * j)); }
#pragma unroll
        for (int t = 0; t < 2; ++t) { f32x4 v[4]; float ss = 0.f;
#pragma unroll
            for (int j = 0; j < 4; ++j) { const v2u xq = xw[t][j]; v[j] = (f32x4){bflo(xq.x), bfhi(xq.x), bflo(xq.y), bfhi(xq.y)};
#pragma unroll
                for (int k = 0; k < (DBG_MODE ? 0 : TOPK); ++k) { const int w = yw[t][j][k]; const f32x2 lo = __builtin_amdgcn_cvt_pk_f32_fp8(w, false), hi = __builtin_amdgcn_cvt_pk_f32_fp8(w, true);
                    v[j].x += lo.x * (1.0f / YSCALE); v[j].y += lo.y * (1.0f / YSCALE); v[j].z += hi.x * (1.0f / YSCALE); v[j].w += hi.y * (1.0f / YSCALE); }
                ss += (v[j].x * v[j].x + v[j].y * v[j].y) + (v[j].z * v[j].z + v[j].w * v[j].w); }
            const float rstd = 1.0f / sqrtf(wave_sum(ss) * (1.f / D) + EPS);
#pragma unroll
            for (int j = 0; j < 4; ++j) __builtin_nontemporal_store(v[j] * rstd * gg[j], (f32x4*)(O + (size_t)(m0 + t) * D + 4 * lane + 256 * j)); }
    }
}

struct Args { const float* in[25]; float* out; unsigned char* ws; int ph_lo, ph_hi, li, pad; };
__global__ void __launch_bounds__(NWAVES * 64, 2) hyb_fwd(Args args) {
    extern __shared__ __attribute__((aligned(16))) unsigned char lds[];
    Frame F;
    F.lds = (LAS unsigned char*)lds;
    F.MISC = (volatile LAS unsigned*)(F.lds + MISC_OFF);
    F.tid = threadIdx.x; F.lane = F.tid & 63; F.wave = __builtin_amdgcn_readfirstlane(F.tid >> 6);
    F.G = gridDim.x; { const int bx = blockIdx.x; F.vcu = (F.G % 8 == 0) ? (bx % 8) * (F.G / 8) + bx / 8 : bx; }
    F.ws = args.ws; F.ctl = (gu32*)(args.ws + WS_CTL); F.out = args.out;
#pragma unroll
    for (int i = 0; i < 25; ++i) F.in[i] = args.in[i];
    for (int u = F.tid; u < (LDS_BYTES - LDSCTL_OFF) / 4; u += NWAVES * 64) ((LAS unsigned*)(F.lds + LDSCTL_OFF))[u] = 0u;
    __syncthreads();
    XcdBarrier bar; bar.bar = (unsigned*)(F.ctl + CW_BAR); bar.x = 0; bar.st = nullptr; bar.G = gridDim.x;
    if (N_LAUNCHES != PER_PHASE) bar = xcd_barrier_post((unsigned*)(F.ctl + CW_BAR), F.MISC + 8, gridDim.x);
#define GRID_BAR(seam) do { if (N_LAUNCHES == PER_PHASE) { if (F.tid == 0) __hip_atomic_store(F.ctl + CW_TMO, 0xBADBA0u | (unsigned)(seam), RLX_AGENT); } else { xcd_barrier(bar); } } while (0)
    const int lo = args.ph_lo, hi = args.ph_hi;
    int pan_pm = 0, pan_pn = 0;
    { pg8::StaticOrder S0; S0.init(M, D, F.G, (int)blockIdx.x, D, D); pg8::Unit u0; if (S0.next(0, u0)) { pan_pm = u0.pm; pan_pn = u0.pn; }
      if (F.tid == 0 && F.G == (M / 256) * 4) __hip_atomic_store((unsigned*)(F.ctl + CW_PXCC) + pan_pm * 4 + pan_pn, xb_xcc_id() + 1u, RLX_AGENT); }
#define IN(k) (lo <= (k) && (k) < hi)
#define BOTH(k) (IN(k) && IN((k) + 1))
    const pg8::bf16_t* wsb = (const pg8::bf16_t*)args.ws;
#define WSB(off) ((const pg8::bf16_t*)(args.ws + (off)))

    unsigned long long t_lo_ = 0, t_hi_ = 0;
    TMARK(0);
    if (IN(0)) {   }

    TMARK(1);
    if (IN(1)) for (int rep_ = 0; rep_ < NREP(1); ++rep_) {
        const int bx = (int)blockIdx.x; const bool gemm_wg = bx < P1_GEMM_WG;
        pg8::Gemm g = pg8::make_gemm(WSB(WS_HN), WSB(WS_WINT), D, D, D); InProjOrder S{P1_GEMM_WG, gemm_wg ? bx : 512};
        EpiInProj E{(unsigned short*)(args.ws + WS_Q), (bf16*)(args.ws + WS_UCAT), LOG2E * 0.125f};
        if (gemm_wg) { XcdBarrier bar2 = xcd_barrier_post((unsigned*)(F.ctl + CW_BAR2), F.MISC + 10, (unsigned)P1_GEMM_WG);
            p0_prologue(F, t_lo_, t_hi_);
            xcd_barrier(bar2); }
        pg8::gemm_phase<EpiInProj, InProjOrder, PG8_ALIGN, PG8_SP2>(F.lds + RING_OFF, g, S, E);
        if (gemm_wg && F.tid == 0) __hip_atomic_fetch_add((unsigned*)(F.ctl + CW_DONE1), 1u, RLX_AGENT);
        if (!gemm_wg) p1_side(F, (bx < P1_GEMM_WG + NG) ? bx - P1_GEMM_WG : -1);
        if (BOTH(1)) GRID_BAR(1);
    }
    TMARK(2);
    if (IN(2)) for (int rep_ = 0; rep_ < NREP(2); ++rep_) {
        const int bx = (int)blockIdx.x;
        if (bx < NG * 4) {
            XcdBarrier bar3 = xcd_barrier_post((unsigned*)(F.ctl + CW_BAR3), F.MISC + 12, (unsigned)(NG * 4));
            if (bx < NG * 2) { pg8::Gemm g = pg8::make_gemm(WSB(WS_UCAT), WSB(WS_WE), NG * UK, 512, 512); SsmOrder S{NG * 2, F.G, bx, 1, 128, 512};
                EpiSloc E{(float*)(args.ws + WS_SLOC)};
                pg8::gemm_phase<EpiSloc, SsmOrder, PG8_ALIGN, PG8_SP2>(F.lds + RING_OFF, g, S, E); }
            else attn_one(F, (bx - NG * 2) * 8 + F.wave);
            xcd_barrier(bar3);
            if (bx < NG * 2) { scan_phase(F, bx); q1_drain(F, 1, nullptr, 0u); } else attn_one(F, 512 + (bx - NG * 2) * 8 + F.wave);
            xcd_barrier(bar3);
            { pg8::Gemm g = pg8::make_gemm(WSB(WS_UCAT), WSB(WS_TW), NG * UK, UK, UK); SsmOrder S{NG * 4, F.G, bx, 2, 512, UK};
              EpiS3 E{(bf16*)(args.ws + WS_YG)};
              pg8::gemm_phase<EpiS3, SsmOrder, PG8_ALIGN, PG8_SP2>(F.lds + RING_OFF, g, S, E); }
        } else {
            const int w = (bx - NG * 4) * 8 + F.wave;
#pragma unroll 1
            for (int j = 0; j < 3; ++j) attn_one(F, 1024 + w + 1024 * j);
            q1_drain(F, -1, nullptr, 0u);
        }
        if (BOTH(4)) GRID_BAR(4);
    }
    TMARK(3); TMARK(4);
    const bool panel_ok = (N_LAUNCHES != PER_PHASE) && F.G == (M / 256) * 4 && !((REP_PHASE) >= 5 && (REP_PHASE) <= 8) && lo == 0 && hi >= 9;
    bool pan_same = false; unsigned* pan_cnt = (unsigned*)(F.ctl + CW_PANEL) + pan_pm * 32;
    if (panel_ok) { const unsigned* px = (const unsigned*)(F.ctl + CW_PXCC) + pan_pm * 4;
        const unsigned x0 = __hip_atomic_load(px, RLX_AGENT), x1 = __hip_atomic_load(px + 1, RLX_AGENT), x2 = __hip_atomic_load(px + 2, RLX_AGENT), x3 = __hip_atomic_load(px + 3, RLX_AGENT);
        pan_same = x0 != 0u && x0 == x1 && x0 == x2 && x0 == x3; }
    TMARK(5);
    if (IN(5)) for (int rep_ = 0; rep_ < NREP(5); ++rep_) {
        pg8::Gemm g = pg8::make_gemm(WSB(WS_YG), WSB(WS_WGLUT), SSW, SSW, SSW); pg8::StaticOrder S; S.init(M, 2 * SSW, F.G, (int)blockIdx.x, SSW, SSW);
        EpiGlu E{(bf16*)(args.ws + WS_YCAT), (float*)(args.ws + WS_SSQSSM)};
        pg8::gemm_phase<EpiGlu, pg8::StaticOrder, PG8_ALIGN, PG8_SP2>(F.lds + RING_OFF, g, S, E);
        if (BOTH(5)) { if (panel_ok) panel_barrier(F, pan_cnt, 4u, pan_same); else GRID_BAR(5); }
    }
    TMARK(6);
    if (IN(6)) {   }
    TMARK(7);
    if (IN(7)) for (int rep_ = 0; rep_ < NREP(7); ++rep_) {
        pg8::Gemm g = pg8::make_gemm(WSB(WS_YCAT), WSB(WS_WOUTT), D, D, D); pg8::StaticOrder S; S.init(M, D, F.G, (int)blockIdx.x, D, D);
        LAS float* rtab = (LAS float*)(F.lds + TOKMAP_OFF);
        { pg8::Unit u0; if (S.next(0, u0) && F.tid < 256) { const int row = u0.pm * 256 + F.tid; const float* pa = (const float*)(args.ws + WS_SSQSB) + (size_t)row * NH; const float* pb = (const float*)(args.ws + WS_SSQSSM) + (size_t)row * 16;
              float sa = 0.f, sb = 0.f;
#pragma unroll
              for (int i = 0; i < NH; ++i) sa += pa[i];
#pragma unroll
              for (int i = 0; i < 16; ++i) sb += pb[i];
              const float ra = 1.0f / sqrtf(sa * (1.f / SBW) + EPS), rb = 1.0f / sqrtf(sb * (1.f / SSW) + EPS); rtab[F.tid] = ra / rb; rtab[256 + F.tid] = rb; }
          __syncthreads(); }
        EpiOutProj E{F.in[0], args.ws, rtab, rtab + 256};
        pg8::gemm_phase<EpiOutProj, pg8::StaticOrder, PG8_ALIGN, PG8_SP2>(F.lds + RING_OFF, g, S, E);
        if (BOTH(7)) { if (panel_ok) panel_barrier(F, pan_cnt + 64 * 32, 4u, pan_same); else GRID_BAR(7); }
    }
    TMARK(8);
    if (IN(8) && !DBG_MODE) for (int rep_ = 0; rep_ < NREP(8); ++rep_) {
        if (F.tid == 0) F.MISC[22] = __hip_atomic_load((unsigned*)(F.ctl + CW_Q1), RLX_AGENT);
        router_phase(F, panel_ok ? (pan_pm * 4 + pan_pn) * 64 : F.vcu * 64);
        if ((unsigned)__builtin_amdgcn_readfirstlane(F.MISC[22]) < (unsigned)CV_N_W1) q1_drain(F, -1, nullptr, 0u);
        if (BOTH(8)) GRID_BAR(8); }
    TMARK(9);
    if (IN(9) && !DBG_MODE) for (int rep_ = 0; rep_ < NREP(9); ++rep_) {   }
    TMARK(10);
    if (IN(10) && !DBG_MODE) for (int rep_ = 0; rep_ < NREP(10); ++rep_) {
        moe_tables(F); moe_units(F, 8, 4); moe_gather_tables(F);
        pg8::Gemm g = pg8::make_gemm(WSB(WS_XN), WSB(WS_W1T), D / 2, D, D); g.brs = 16u; g.bks = 2u * FF * 16u; g.tokmap = (const PG8_LAS int*)(F.lds + TOKMAP_OFF);
        MoeOrder S{(const LAS int*)(F.lds + UNITS_OFF), (long)2 * FF * D, 1};
        EpiMoe1 E{args.ws + WS_H, F.in[19], F.in[21], (const int*)(args.ws + WS_ROWINFO), F.in[22], args.ws + WS_W2T, (LAS float*)(F.lds + EPI_STG_OFF)};
        { pg8::Unit u0; if (S.next(0, u0)) E.fill_first(u0, F.tid); __syncthreads(); }
        pg8::gemm_phase<EpiMoe1, MoeOrder, PG8_ALIGN, PG8_SP2, true, MOE1_MODE>(F.lds + RING_OFF, g, S, E);
        { const LAS int* ul = (const LAS int*)(F.lds + UNITS_OFF); int nu = 0; while (nu < 8 && __builtin_amdgcn_readfirstlane(ul[4 * nu + 3])) ++nu;
          for (; nu < 8; ++nu) { f32x4 wv[8]; const int mi = nu * 256 + (int)blockIdx.x; w2mini_load(wv, F.in[22], mi, F.wave, F.lane); w2mini_store(wv, args.ws + WS_W2T, mi, F.wave, F.lane); } }
        if (BOTH(10)) GRID_BAR(10);
    }
    TMARK(11);
    if (IN(11) && !DBG_MODE) for (int rep_ = 0; rep_ < NREP(11); ++rep_) {
        moe_tables(F); moe_units(F, 4, 4);
        pg8::Gemm g = pg8::make_gemm(WSB(WS_H), WSB(WS_W2T), FF / 2, FF, FF); g.brs = 16u; g.bks = (unsigned)D * 16u; MoeOrder S{(const LAS int*)(F.lds + UNITS_OFF), (long)D * FF, 0};
        EpiMoe2 E{args.ws + WS_YBUF, F.in[23], (const int*)(args.ws + WS_ROWINFO), F.lds + EPI_STG_OFF};
        { pg8::Unit u0; if (S.next(0, u0)) E.fill_first(u0, F.tid); __syncthreads(); }
        pg8::gemm_phase<EpiMoe2, MoeOrder, PG8_ALIGN, PG8_SP2, false, MOE2_MODE>(F.lds + RING_OFF, g, S, E);
        if (BOTH(11)) GRID_BAR(11);
    }
    TMARK(12);
    if (IN(12)) for (int rep_ = 0; rep_ < NREP(12); ++rep_) { final_phase(F); }
    TMARK(13);
    if ((TIME_LO) >= 0 && blockIdx.x == (TIME_BLK) && F.tid == 0) { const unsigned long long te = __builtin_amdgcn_s_memrealtime(), dt = 4ull * (t_hi_ - t_lo_); while (__builtin_amdgcn_s_memrealtime() - te < dt) __builtin_amdgcn_s_sleep(32); }
    (void)wsb;
#undef IN
#undef BOTH
}

extern "C" void kernel_launch(void* const* d_in, const int* in_sizes, int n_in, void* d_out, int out_size, void* d_ws, size_t ws_size, hipStream_t stream) {
    static int grid = 0;
    if (grid == 0) {
        if (n_in != 25 || in_sizes[0] != M * D || out_size != M * D || ws_size < WS_END) { fprintf(stderr, "kernel_launch: unexpected shapes: n_in %d in0 %d out %d ws %zu (need %zu); nothing launched\n", n_in, n_in > 0 ? in_sizes[0] : -1, out_size, ws_size, (size_t)WS_END); grid = -1; return; }
        int dev = 0, cus = 0, per_cu = 0;
        if (hipGetDevice(&dev) != hipSuccess || hipDeviceGetAttribute(&cus, hipDeviceAttributeMultiprocessorCount, dev) != hipSuccess) { grid = -1; return; }
        if (hipFuncSetAttribute((const void*)hyb_fwd, hipFuncAttributeMaxDynamicSharedMemorySize, LDS_BYTES) != hipSuccess) { fprintf(stderr, "kernel_launch: hipFuncSetAttribute failed\n"); grid = -1; return; }
        if (hipOccupancyMaxActiveBlocksPerMultiprocessor(&per_cu, (const void*)hyb_fwd, NWAVES * 64, LDS_BYTES) != hipSuccess || per_cu < 1)
            fprintf(stderr, "kernel_launch: note: occupancy query reports %d workgroups per CU\n", per_cu);
        (void)hipGetLastError();
        grid = cus;
        if (grid != 256) fprintf(stderr, "kernel_launch: note: %d CUs (built for 256)\n", grid);
    }
    if (grid < 0) return;
    if (hipMemsetAsync((char*)d_ws + WS_CTL, 0, CTL_ZERO_BYTES, stream) != hipSuccess) { fprintf(stderr, "kernel_launch: memset failed\n"); return; }
    Args a{};
    for (int i = 0; i < 25; ++i) a.in[i] = (const float*)d_in[i];
    a.out = (float*)d_out; a.ws = (unsigned char*)d_ws;
    for (int li = 0; li < N_LAUNCHES; ++li) {
        a.ph_lo = (N_LAUNCHES == PER_PHASE) ? li : 0; a.ph_hi = (N_LAUNCHES == PER_PHASE) ? li + 1 : PER_PHASE; a.li = li;
        hipLaunchKernelGGL(hyb_fwd, dim3(grid), dim3(NWAVES * 64), LDS_BYTES, stream, a);
        const hipError_t le = hipPeekAtLastError();
        if (le != hipSuccess) { fprintf(stderr, "kernel_launch: launch %d failed: %s\n", li, hipGetErrorName(le)); break; }
    }
}
```
